# Optimizing an MI355X kernel written in HIP

```python
import jax
import jax.numpy as jnp
from jax import lax
import numpy as np

D_MODEL = 1024
BATCH = 2
SEQ = 16384
DEPTH = 2

GRID_W = 64
CTX_LEN = 256
N_MIXERS = 2
N_POOL_LAYERS = (DEPTH + N_MIXERS - 1) // N_MIXERS
N_RWKV_LAYERS = DEPTH // N_MIXERS
N_MOD = 6
NORM_EPS = 1e-6
POOL_WINDOWS = (2, 4, 8, 16)
POOL_GROUP = D_MODEL // len(POOL_WINDOWS)
RWKV_HEAD = 64
RWKV_HEADS = D_MODEL // RWKV_HEAD
DECAY_LORA = 64
ICL_LORA = 64
GATE_LORA = 128
GN_EPS = 64e-5
N_EXPERTS = 32
TOP_K = 4
D_EXPERT = D_MODEL
SWIGLU_ALPHA = 1.702
SWIGLU_LIMIT = 7.0
MOE_BLOCK = 256

kernel_name = 'hybrid_pool_rwkv7_moe_dit'


def rms_norm(x, g):
    xf = x.astype(jnp.float32)
    y = xf * lax.rsqrt(jnp.mean(xf * xf, axis=-1, keepdims=True) + NORM_EPS)
    return (y * g.astype(jnp.float32)).astype(x.dtype)


def ada_params(cond, w, b):
    m = jax.nn.silu(cond) @ w + b
    return m.reshape(m.shape[:-1] + (N_MOD, D_MODEL))


def pre(stream, g, shift, scale):
    return rms_norm(stream, g) * (1 + scale) + shift


def pool_mixer(h, w_pool, ls):
    L = h.shape[2]
    hf = h.astype(jnp.float32)
    prefix = jnp.pad(jnp.cumsum(hf, axis=2), ((0, 0), (0, 0), (1, 0), (0, 0)))
    pos = jnp.arange(L)
    diffs = []
    for gi, win in enumerate(POOL_WINDOWS):
        lo = jnp.clip(pos - win // 2, 0, L - 1)
        hi = jnp.clip(pos + win // 2 - 1, 0, L - 1)
        cnt = (hi - lo + 1).astype(jnp.float32)[:, None]
        sl = slice(gi * POOL_GROUP, (gi + 1) * POOL_GROUP)
        p = prefix[..., sl]
        diffs.append((p[:, :, hi + 1] - p[:, :, lo]) / cnt - hf[..., sl])
    d = jnp.stack(diffs, axis=-2).astype(h.dtype)
    y = jnp.einsum('brlgc,gce->brlge', d, w_pool).reshape(h.shape)
    return y * ls


def centred_shift(h):
    hp = jnp.pad(h, ((0, 0), (1, 1), (0, 0)))
    return 0.5 * (hp[:, :-2] + hp[:, 2:])


def to_heads_tm(a):
    B, T, _ = a.shape
    return a.reshape(B, T, RWKV_HEADS, RWKV_HEAD).transpose(1, 0, 2, 3)


def rwkv_features(h, mu, w_rkv, w0, w1, w2, a0, a1, a2, g1, g2, k_k, k_a, readout):
    B, T, D = h.shape
    f32 = jnp.float32
    xx = centred_shift(h) - h
    k = ((h + xx * mu[2]) @ w_rkv[1]).astype(f32)
    v = ((h + xx * mu[3]) @ w_rkv[2]).astype(f32)
    lw = jnp.tanh(jnp.einsum('btc,dcr->dbtr', h + xx * mu[1], w1))
    zw = (w0[:, None, None, :] + jnp.einsum('dbtr,drc->dbtc', lw, w2)).astype(f32)
    decay = jnp.exp(-jnp.exp(-jax.nn.softplus(-zw) - 0.5))
    la = jnp.einsum('btc,dcr->dbtr', h + xx * mu[4], a1)
    icl = jax.nn.sigmoid((a0[:, None, None, :] + jnp.einsum('dbtr,drc->dbtc', la, a2)).astype(f32))
    kk = (k * k_k.astype(f32)).reshape(B, T, RWKV_HEADS, RWKV_HEAD)
    kk = (kk / jnp.maximum(jnp.linalg.norm(kk, axis=-1, keepdims=True), 1e-12)).reshape(B, T, D)
    k_dir = k * (1.0 + (icl - 1.0) * k_a.astype(f32))
    if readout:
        r = ((h + xx * mu[0]) @ w_rkv[0]).astype(f32)
        g = jax.nn.sigmoid((h + xx * mu[5]) @ g1) @ g2
        return (decay, icl, k_dir, v, kk, r, g)
    return (decay, icl, k_dir, v, kk)


def scan_inputs(feat, d):
    decay, icl, k_dir, v, kk = feat[:5]
    xs = (to_heads_tm(decay[d]), to_heads_tm(k_dir[d]), to_heads_tm(v),
          to_heads_tm(kk), to_heads_tm(kk * icl[d]))
    if len(feat) > 5:
        xs = xs + (to_heads_tm(feat[5]),)
    return xs


def wkv_scan(s0, xs, reverse):
    emit = len(xs) == 6

    def step(S, inp):
        w_t, k_t, v_t, kk_t, b_t = inp[:5]
        S = (S * w_t[:, :, None, :]
             - jnp.einsum('bhvk,bhk->bhv', S, kk_t)[..., None] * b_t[:, :, None, :]
             + v_t[..., None] * k_t[:, :, None, :])
        return S, (jnp.einsum('bhvk,bhk->bhv', S, inp[5]) if emit else None)

    return lax.scan(step, s0, xs, reverse=reverse)


def rwkv_readout(y_tm, feat, r_k, ln_g, ln_b, w_o, dtype):
    _, _, k_dir, v, _, r, g = feat
    T, B, H, K = y_tm.shape
    y = y_tm.transpose(1, 0, 2, 3)
    m = jnp.mean(y, axis=-1, keepdims=True)
    var = jnp.mean(jnp.square(y - m), axis=-1, keepdims=True)
    yn = ((y - m) * lax.rsqrt(var + GN_EPS)).reshape(B, T, H * K) * ln_g + ln_b
    hd = lambda a: a.reshape(B, T, H, K)
    bonus = jnp.sum(hd(r) * hd(k_dir[0] + k_dir[1]) * r_k, axis=-1, keepdims=True) * hd(v)
    out = (yn + bonus.reshape(B, T, H * K)) * g
    return out.astype(dtype) @ w_o


def rwkv_mixer(h_lat, h_ctx, mu, w_rkv, w0, w1, w2, a0, a1, a2, g1, g2, k_k, k_a,
               r_k, ln_g, ln_b, w_o, ctx_readout):
    par = (mu, w_rkv, w0, w1, w2, a0, a1, a2, g1, g2, k_k, k_a)
    fc = rwkv_features(h_ctx, *par, readout=ctx_readout)
    fl = rwkv_features(h_lat, *par, readout=True)
    s0 = jnp.zeros((h_lat.shape[0], RWKV_HEADS, RWKV_HEAD, RWKV_HEAD), jnp.float32)
    ys_lat, ys_ctx = [], []
    for d, rev in enumerate((False, True)):
        s_ctx, yc = wkv_scan(s0, scan_inputs(fc, d), rev)
        _, yl = wkv_scan(s_ctx, scan_inputs(fl, d), rev)
        ys_lat.append(yl)
        ys_ctx.append(yc)
    out_lat = rwkv_readout(ys_lat[0] + ys_lat[1], fl, r_k, ln_g, ln_b, w_o, h_lat.dtype)
    out_ctx = (rwkv_readout(ys_ctx[0] + ys_ctx[1], fc, r_k, ln_g, ln_b, w_o, h_ctx.dtype)
               if ctx_readout else None)
    return out_lat, out_ctx


def moe(h, router_w, router_b, w_gu, b_gu, w_down, b_down):
    B, T, D = h.shape
    N = B * T
    A = N * TOP_K
    t = h.reshape(N, D)
    logits = (t @ router_w).astype(jnp.float32) + router_b.astype(jnp.float32)
    top_v, top_e = lax.top_k(logits, TOP_K)
    gates = jax.nn.softmax(top_v, axis=-1)
    e_flat = top_e.reshape(A)
    tok_flat = jnp.arange(A, dtype=jnp.int32) // TOP_K
    order = jnp.argsort(e_flat)
    e_s, tok_s, g_s = e_flat[order], tok_flat[order], gates.reshape(A)[order]
    counts = jnp.bincount(e_flat, length=N_EXPERTS)
    start = jnp.cumsum(counts) - counts
    padded = (counts + MOE_BLOCK - 1) // MOE_BLOCK * MOE_BLOCK
    pend = jnp.cumsum(padded)
    pstart = pend - padded
    dest = pstart[e_s] + jnp.arange(A) - start[e_s]
    nb = -(-A // MOE_BLOCK) + N_EXPERTS
    R = nb * MOE_BLOCK
    tok_buf = jnp.full((R,), N, jnp.int32).at[dest].set(tok_s)
    g_buf = jnp.zeros((R,), jnp.float32).at[dest].set(g_s)
    blk_e = jnp.minimum(jnp.searchsorted(pend, jnp.arange(nb) * MOE_BLOCK, side='right'), N_EXPERTS - 1)
    t_pad = jnp.concatenate([t, jnp.zeros((1, D), t.dtype)], axis=0)
    xb = t_pad[tok_buf].reshape(nb, MOE_BLOCK, D)

    def expert_block(args):
        xblk, e = args
        gu = xblk @ w_gu[e] + b_gu[e]
        gate, up = gu[:, :D_EXPERT], gu[:, D_EXPERT:]
        gate = jnp.minimum(gate, SWIGLU_LIMIT)
        up = jnp.clip(up, -SWIGLU_LIMIT, SWIGLU_LIMIT)
        glu = gate * jax.nn.sigmoid(SWIGLU_ALPHA * gate)
        return ((up + 1) * glu) @ w_down[e] + b_down[e]

    yb = lax.map(expert_block, (xb, blk_e))
    out = jax.ops.segment_sum(yb.reshape(R, D).astype(jnp.float32) * g_buf[:, None],
                              tok_buf, num_segments=N + 1)[:N]
    return out.reshape(B, T, D).astype(h.dtype)


def setup_inputs(seed: int = 0) -> dict:
    key = jax.random.key(seed)
    ks = iter(jax.random.split(key, 40))
    nrm = lambda shape, s: jax.random.normal(next(ks), shape, jnp.float32) * s
    uni = lambda shape: jax.random.uniform(next(ks), shape, jnp.float32)
    D, F, E = D_MODEL, D_EXPERT, N_EXPERTS
    NP, NR = N_POOL_LAYERS, N_RWKV_LAYERS
    return {
        'x': nrm((BATCH, SEQ, D), 1.0),
        'c': nrm((BATCH, D), 1.0),
        'ctx': nrm((BATCH, CTX_LEN, D), 1.0),
        'c_ctx': nrm((D,), 1.0),
        'norm_g': 1.0 + nrm((DEPTH, 2, D), 0.02),
        'ada_w': nrm((DEPTH, D, N_MOD * D), 0.5 * D ** -0.5),
        'ada_b': nrm((DEPTH, N_MOD * D), 0.02),
        'pool_w': nrm((NP, len(POOL_WINDOWS), POOL_GROUP, POOL_GROUP), POOL_GROUP ** -0.5),
        'pool_ls': 1.0 + nrm((NP, D), 0.1),
        'rwkv_mu': uni((NR, 6, D)),
        'rwkv_w_rkv': nrm((NR, 3, D, D), D ** -0.5),
        'rwkv_w0': -6.5 + 5.0 * uni((NR, 2, D)),
        'rwkv_w1': nrm((NR, 2, D, DECAY_LORA), D ** -0.5),
        'rwkv_w2': nrm((NR, 2, DECAY_LORA, D), 0.5 * DECAY_LORA ** -0.5),
        'rwkv_a0': nrm((NR, 2, D), 0.1),
        'rwkv_a1': nrm((NR, 2, D, ICL_LORA), D ** -0.5),
        'rwkv_a2': nrm((NR, 2, ICL_LORA, D), 0.5 * ICL_LORA ** -0.5),
        'rwkv_g1': nrm((NR, D, GATE_LORA), D ** -0.5),
        'rwkv_g2': nrm((NR, GATE_LORA, D), GATE_LORA ** -0.5),
        'rwkv_k_k': 0.85 + nrm((NR, D), 0.05),
        'rwkv_k_a': 1.0 + nrm((NR, D), 0.05),
        'rwkv_r_k': nrm((NR, RWKV_HEADS, RWKV_HEAD), 0.05),
        'rwkv_ln_g': 1.0 + nrm((NR, D), 0.02),
        'rwkv_ln_b': nrm((NR, D), 0.02),
        'rwkv_w_o': nrm((NR, D, D), D ** -0.5),
        'moe_router_w': nrm((DEPTH, D, E), D ** -0.5),
        'moe_router_b': nrm((DEPTH, E), 0.01),
        'moe_w_gu': nrm((DEPTH, E, D, 2 * F), D ** -0.5),
        'moe_b_gu': nrm((DEPTH, E, 2 * F), 0.02),
        'moe_w_down': nrm((DEPTH, E, F, D), F ** -0.5),
        'moe_b_down': nrm((DEPTH, E, D), 0.02),
        'final_g': 1.0 + nrm((D,), 0.02),
    }


def reference(x, c, ctx, c_ctx, norm_g, ada_w, ada_b, pool_w, pool_ls,
              rwkv_mu, rwkv_w_rkv, rwkv_w0, rwkv_w1, rwkv_w2, rwkv_a0, rwkv_a1, rwkv_a2,
              rwkv_g1, rwkv_g2, rwkv_k_k, rwkv_k_a, rwkv_r_k, rwkv_ln_g, rwkv_ln_b, rwkv_w_o,
              moe_router_w, moe_router_b, moe_w_gu, moe_b_gu, moe_w_down, moe_b_down, final_g):
    B, L, D = x.shape
    rows = L // GRID_W
    n_ctx = ctx.shape[1]
    for i in range(DEPTH):
        last = i == DEPTH - 1
        j = i // N_MIXERS
        m_lat = ada_params(c, ada_w[i], ada_b[i])[:, :, None, :]
        m_ctx = ada_params(c_ctx, ada_w[i], ada_b[i])
        h_lat = pre(x, norm_g[i, 0], m_lat[:, 0], m_lat[:, 1])
        y_ctx = None
        if i % N_MIXERS == 0:
            y_lat = pool_mixer(h_lat.reshape(B, rows, GRID_W, D), pool_w[j], pool_ls[j]).reshape(B, L, D)
            if not last:
                h_ctx = pre(ctx, norm_g[i, 0], m_ctx[0], m_ctx[1])
                y_ctx = pool_mixer(h_ctx[:, None], pool_w[j], pool_ls[j])[:, 0]
        else:
            h_ctx = pre(ctx, norm_g[i, 0], m_ctx[0], m_ctx[1])
            y_lat, y_ctx = rwkv_mixer(h_lat, h_ctx, rwkv_mu[j], rwkv_w_rkv[j], rwkv_w0[j], rwkv_w1[j],
                                      rwkv_w2[j], rwkv_a0[j], rwkv_a1[j], rwkv_a2[j], rwkv_g1[j],
                                      rwkv_g2[j], rwkv_k_k[j], rwkv_k_a[j], rwkv_r_k[j], rwkv_ln_g[j],
                                      rwkv_ln_b[j], rwkv_w_o[j], ctx_readout=not last)
        x = x + m_lat[:, 2] * y_lat
        h2_lat = pre(x, norm_g[i, 1], m_lat[:, 3], m_lat[:, 4])
        moe_w = (moe_router_w[i], moe_router_b[i], moe_w_gu[i], moe_b_gu[i], moe_w_down[i], moe_b_down[i])
        if last:
            x = x + m_lat[:, 5] * moe(h2_lat, *moe_w)
        else:
            ctx = ctx + m_ctx[2] * y_ctx
            h2_ctx = pre(ctx, norm_g[i, 1], m_ctx[3], m_ctx[4])
            f = moe(jnp.concatenate([h2_ctx, h2_lat], axis=1), *moe_w)
            ctx = ctx + m_ctx[5] * f[:, :n_ctx]
            x = x + m_lat[:, 5] * f[:, n_ctx:]
    return rms_norm(x, final_g)
```

```cpp
#include <hip/hip_runtime.h>
#include <cstdio>
#include <cstdint>

#define LAS __attribute__((address_space(3)))
#define GAS __attribute__((address_space(1)))
typedef unsigned short bf16_t;
typedef short bf16x8 __attribute__((ext_vector_type(8)));
typedef float f32x4 __attribute__((ext_vector_type(4)));
typedef float f32x2 __attribute__((ext_vector_type(2)));
typedef float f32x16 __attribute__((ext_vector_type(16)));
typedef unsigned u32x4 __attribute__((ext_vector_type(4)));
typedef unsigned u32x2 __attribute__((ext_vector_type(2)));

#ifndef N_LAUNCH_MODE
#define N_LAUNCH_MODE 0
#endif
#ifndef LAST_PHASE
#define LAST_PHASE 99
#endif

constexpr int D = 1024, NB = 2, TSEQ = 16384, CT = 256, NL = NB * TSEQ, NC = NB * CT, NTOK = NL + NC;
constexpr int NE = 32, TOPK = 4, NMOD = 6;
constexpr int NWAVES = 8, NTHREADS = 512;
constexpr int MAXSLOT = ((NTOK * TOPK + 255) / 256 + NE) * 256;
constexpr float NORM_EPS = 1e-6f, GN_EPS = 64e-5f;

constexpr size_t AL(size_t x) { return (x + 255) & ~(size_t)255; }
constexpr size_t WS_CTL = 0, CTL_BYTES = 32768;
constexpr size_t CTL_CNT = 16384;
constexpr size_t WS_MOD = WS_CTL + CTL_BYTES;
constexpr size_t WS_LIST = AL(WS_MOD + 2 * 3 * 6144 * 4);
constexpr size_t WS_TINFO = AL(WS_LIST + (size_t)2 * NE * NTOK * 4);
constexpr size_t WS_TGATE = AL(WS_TINFO + (size_t)2 * NTOK * 4 * 4);
constexpr size_t WS_WGU = AL(WS_TGATE + (size_t)2 * NTOK * 4 * 4);
constexpr size_t WS_WDN = AL(WS_WGU + (size_t)2 * NE * 2048 * 1024 * 2);
constexpr size_t WS_WRKV = AL(WS_WDN + (size_t)2 * NE * 1024 * 1024 * 2);
constexpr size_t WS_WO = AL(WS_WRKV + (size_t)3 * 1024 * 1024 * 2);
constexpr size_t WS_WL1 = AL(WS_WO + (size_t)1024 * 1024 * 2);
constexpr size_t WS_WL2 = AL(WS_WL1 + (size_t)3 * 256 * 1024 * 2);
constexpr size_t WS_WPOOL = AL(WS_WL2 + (size_t)5 * 1024 * 128 * 2);
constexpr size_t WS_XS0 = AL(WS_WPOOL + (size_t)4 * 256 * 256 * 2);
constexpr size_t WS_XS1 = AL(WS_XS0 + (size_t)NTOK * D * 4);
constexpr size_t WS_T = AL(WS_XS1 + (size_t)NTOK * D * 4);
constexpr size_t ACTB = (size_t)NTOK * D * 2;
constexpr size_t TA = WS_T;
constexpr size_t TA_BYTES = (size_t)432 << 20;
constexpr size_t WS_DBUF = TA, WS_H2 = TA + ACTB, WS_ACT = TA + 2 * ACTB;
constexpr size_t WS_MIX = TA;
constexpr size_t WS_KDIR = TA, WS_BV = TA + 2 * ACTB, WS_KK = TA + 4 * ACTB;
constexpr size_t TB = TA + TA_BYTES;
constexpr size_t TB_BYTES = (size_t)290 << 20;
constexpr size_t WS_Y2 = TB, WS_RKV = TB;
constexpr size_t TC = TB + TB_BYTES;
constexpr size_t WS_DEC = TC, WS_RO = TC;
constexpr size_t TD = AL(TC + (size_t)2 * NTOK * D * 4);
constexpr size_t WS_ICL = TD, WS_YD = TD;
constexpr size_t TE = AL(TD + 2 * ACTB);
constexpr size_t WS_G = TE;
constexpr size_t TF = AL(TE + ACTB);
constexpr size_t WS_LACT = TF;
constexpr size_t WS_END = AL(TF + (size_t)3 * NTOK * 128 * 2);
static_assert(WS_ACT + (size_t)MAXSLOT * D * 2 <= TA + TA_BYTES, "ACT overflows TA");
static_assert((size_t)MAXSLOT * D * 2 <= TB_BYTES, "Y2 overflows TB");
static_assert(WS_END <= ((size_t)2048 << 20), "workspace too large");

constexpr int MISC_OFF = 0, SCR_OFF = 1024, SCR_BYTES = 147456, LDS_BYTES = SCR_OFF + SCR_BYTES;

__device__ __forceinline__ unsigned cvt_pk_bf16(float lo, float hi) { unsigned r; asm volatile("v_cvt_pk_bf16_f32 %0, %1, %2" : "=v"(r) : "v"(lo), "v"(hi)); return r; }
__device__ __forceinline__ float bf_lo(unsigned w) { return __uint_as_float(w << 16); }
__device__ __forceinline__ float bf_hi(unsigned w) { return __uint_as_float(w & 0xffff0000u); }
__device__ __forceinline__ float bf2f(bf16_t b) { return __uint_as_float(((unsigned)b) << 16); }
__device__ __forceinline__ float wave_sum(float v) {
#pragma unroll
    for (int o = 1; o < 64; o <<= 1) v += __shfl_xor(v, o);
    return v;
}
__device__ __forceinline__ float sigmoidf_(float x) { return 1.0f / (1.0f + __expf(-x)); }
#define LDS_WAIT() asm volatile("s_waitcnt lgkmcnt(0)" ::: "memory")
#define VM_WAIT() asm volatile("s_waitcnt vmcnt(0)" ::: "memory")

#define XB_TMO      128
#define XB_XCNT(j)  (256  + 64 * (j))
#define XB_XSUB(j)  (1280 + 64 * (j))
#define XB_XGEN(j)  (2304 + 64 * (j))
#define XB_TOP      3328
#define XB_TOPGEN   3392
#define XCD_BAR_WORDS 3456
#define XB_SPIN_CAP (1u << 22)
__device__ __forceinline__ unsigned xb_ld(unsigned* p)              { return __hip_atomic_load(p, __ATOMIC_RELAXED, __HIP_MEMORY_SCOPE_AGENT); }
__device__ __forceinline__ unsigned xb_add(unsigned* p, unsigned v) { return __hip_atomic_fetch_add(p, v, __ATOMIC_RELAXED, __HIP_MEMORY_SCOPE_AGENT); }
__device__ __forceinline__ unsigned xb_xcc_id() { return (unsigned)__builtin_amdgcn_s_getreg((3 << 11) | 20) & 0xFu; }
#define XB_SPIN(cond, bar) do { unsigned _sp = 0; while (cond) { __builtin_amdgcn_s_sleep(1); \
    if ((++_sp & 255u) == 0u) { if (xb_ld(&(bar)[XB_TMO])) break; if (_sp > XB_SPIN_CAP) { atomicAdd(&(bar)[XB_TMO], 1u); break; } } } } while (0)
struct XcdBarrier { unsigned* bar; unsigned x; volatile LAS unsigned* st; };
__device__ __forceinline__ XcdBarrier xcd_barrier_post(unsigned* bar, volatile LAS unsigned* st) {
    XcdBarrier b; b.bar = bar; b.x = xb_xcc_id(); b.st = st;
    if (threadIdx.x == 0) (void)xb_add(&bar[XB_XCNT(b.x)], 1u);
    return b;
}
__device__ __forceinline__ void xcd_barrier_complete(unsigned* bar, unsigned x, unsigned& nloc, unsigned& nx) {
    const unsigned G = gridDim.x * gridDim.y * gridDim.z;
    unsigned sum, cnt, mine, sp = 0u;
    for (;;) {
        sum = 0u; cnt = 0u; mine = 0u;
#pragma unroll
        for (unsigned j = 0; j < 16; ++j) { const unsigned c = xb_ld(&bar[XB_XCNT(j)]); sum += c; cnt += (c > 0u) ? 1u : 0u; mine = (j == x) ? c : mine; }
        if (sum == G) break;
        __builtin_amdgcn_s_sleep(1);
        if ((++sp & 255u) == 0u) { if (xb_ld(&bar[XB_TMO])) break; if (sp > XB_SPIN_CAP) { atomicAdd(&bar[XB_TMO], 1u); break; } }
    }
    nloc = mine > 0u ? mine : 1u; nx = cnt > 0u ? cnt : 1u;
}
__device__ __forceinline__ void xcd_barrier(const XcdBarrier& b) {
    asm volatile("s_waitcnt vmcnt(0)" ::: "memory");
    __syncthreads();
    if (threadIdx.x == 0) {
        unsigned* bar = b.bar;
        __builtin_amdgcn_s_waitcnt(0);
        unsigned nloc = b.st[0], nx = b.st[1];
        if (nloc == 0u) { xcd_barrier_complete(bar, b.x, nloc, nx); b.st[0] = nloc; b.st[1] = nx; }
        const unsigned old = xb_add(&bar[XB_XSUB(b.x)], 1u);
        const unsigned gen = old / nloc;
        if (old + 1u == (gen + 1u) * nloc) {
            __builtin_amdgcn_fence(__ATOMIC_RELEASE, "agent");
            asm volatile("s_waitcnt vmcnt(0)" ::: "memory");
            const unsigned og = xb_add(&bar[XB_TOP], 1u);
            const unsigned tg = og / nx;
            if (og + 1u == (tg + 1u) * nx) xb_add(&bar[XB_TOPGEN], 1u);
            else XB_SPIN(xb_ld(&bar[XB_TOPGEN]) == tg, bar);
            __builtin_amdgcn_fence(__ATOMIC_ACQUIRE, "agent");
            xb_add(&bar[XB_XGEN(b.x)], 1u);
            asm volatile("s_waitcnt vmcnt(0)" ::: "memory");
        } else {
            XB_SPIN(xb_ld(&bar[XB_XGEN(b.x)]) == gen, bar);
            __builtin_amdgcn_fence(__ATOMIC_ACQUIRE, "agent");
            asm volatile("s_waitcnt vmcnt(0)" ::: "memory");
        }
    }
    __syncthreads();
}

namespace pg8 {
constexpr int BM = 256, BK = 64, HALF = 128, HTB = HALF * BK * 2, STAGE_BYTES = 8 * HTB;
__host__ __device__ __forceinline__ int lds_byte(int r, int c) { const int st = (r >> 4) * 2 + (c >> 5), rr = r & 15, cc = c & 31, ob = rr * 64 + cc * 2; return st * 1024 + (ob ^ (((ob >> 9) & 1) << 5)); }
__host__ __device__ __forceinline__ void stage_rc(int b, int& R, int& C) { const int st = b / 1024, sb = b % 1024, swz = sb ^ (((sb >> 9) & 1) << 5); R = (st >> 1) * 16 + swz / 64; C = (st & 1) * 32 + (swz % 64) / 2; }
__host__ __device__ __forceinline__ int perm32(int rho) { const int n = rho >> 4, i = rho & 15; return 8 * (i >> 2) + 4 * n + (i & 3); }

struct GU { const char* a; const char* b; int i0, i1, i2, i3; };

template <class Epi, class Sched>
__device__ __forceinline__ void gemm_phase(LAS unsigned char* lds, const Sched& S, const Epi& E) {
    const int tid = threadIdx.x, wid = __builtin_amdgcn_readfirstlane(tid >> 6), lane = tid & 63, wr = wid >> 2, wc = wid & 3, fr = lane & 15, fq = lane >> 4;
    const int nt = S.nt;
    int Rr[2], Cc[2]; unsigned voffB[2];
#pragma unroll
    for (int i = 0; i < 2; ++i) { int R, C; stage_rc(tid * 16 + i * 8192, R, C); Rr[i] = R; Cc[i] = C; const int Rb = Epi::PERM ? ((R & ~31) + perm32(R & 31)) : R;
        voffB[i] = (unsigned)(Rb * S.ldb + C) * 2u; }
    const size_t kstep = (size_t)(BK * 2);
    const size_t hstepB = (size_t)HALF * S.ldb * 2;
    const unsigned ldsw = (unsigned)wid * 1024u;
    const int aoff = lds_byte(wr * 64 + fr, fq * 8), boff = lds_byte(wc * 32 + fr, fq * 8);
#define PG8_SA(b, h) (((b) * 2 + (h)) * HTB)
#define PG8_SB(b, h) ((4 + (b) * 2 + (h)) * HTB)
#define PG8_STAGE(bufoff, gbase, voff) do { _Pragma("unroll") for (int _i = 0; _i < 2; ++_i) \
        __builtin_amdgcn_global_load_lds((const unsigned*)((const char*)(gbase) + (voff)[_i]), (LAS unsigned*)(lds + (bufoff) + ldsw + _i * 8192), 16, 0, 0); } while (0)
#define PG8_LDA(dst, b, h) do { _Pragma("unroll") for (int m = 0; m < 4; ++m) _Pragma("unroll") for (int k = 0; k < 2; ++k) dst[m][k] = *(const LAS bf16x8*)(lds + PG8_SA(b, h) + aoff + m * 2048 + k * 1024); } while (0)
#define PG8_LDB(dst, b, h) do { _Pragma("unroll") for (int n = 0; n < 2; ++n) _Pragma("unroll") for (int k = 0; k < 2; ++k) dst[n][k] = *(const LAS bf16x8*)(lds + PG8_SB(b, h) + boff + n * 2048 + k * 1024); } while (0)
#define PG8_MMA(ai, bj, At, Bt) do { __builtin_amdgcn_s_setprio(1); _Pragma("unroll") for (int m = 0; m < 4; ++m) _Pragma("unroll") for (int n = 0; n < 2; ++n) _Pragma("unroll") for (int k = 0; k < 2; ++k) \
        acc[ai][bj][m][n] = __builtin_amdgcn_mfma_f32_16x16x32_bf16(Bt[n][k], At[m][k], acc[ai][bj][m][n], 0, 0, 0); __builtin_amdgcn_s_setprio(0); } while (0)
#define PG8_WAIT_V(n) asm volatile("s_waitcnt vmcnt(" #n ")" ::: "memory")
#define PG8_WAIT_L(n) asm volatile("s_waitcnt lgkmcnt(" #n ")" ::: "memory")
#define PG8_BAR __builtin_amdgcn_s_barrier()
#define PG8_SCHED __builtin_amdgcn_sched_barrier(0)
    GU cur, nxt; int ui = 0;
    if (!S.next(0, cur)) return;
    f32x4 acc[2][2][4][2];
#pragma unroll
    for (int a = 0; a < 2; ++a)
#pragma unroll
        for (int b = 0; b < 2; ++b)
#pragma unroll
            for (int m = 0; m < 4; ++m)
#pragma unroll
                for (int n = 0; n < 2; ++n) acc[a][b][m][n] = (f32x4){0.f, 0.f, 0.f, 0.f};
    bf16x8 At[4][2], B0[2][2], B1[2][2];
    unsigned vA[2][2], nvA[2][2];
    S.aoff(cur, Rr, Cc, vA);
    const char* cA = cur.a; const char* cB = cur.b;
    PG8_STAGE(PG8_SB(0, 0), cB, voffB); PG8_STAGE(PG8_SB(0, 1), cB + hstepB, voffB); PG8_STAGE(PG8_SA(0, 0), cA, vA[0]); PG8_STAGE(PG8_SA(0, 1), cA, vA[1]);
    if (wr == 1) PG8_BAR;
    PG8_WAIT_V(2); PG8_BAR;
    PG8_STAGE(PG8_SB(1, 0), cB + kstep, voffB); PG8_STAGE(PG8_SA(1, 0), cA + kstep, vA[0]); PG8_STAGE(PG8_SB(1, 1), cB + hstepB + kstep, voffB);
    PG8_WAIT_V(6); PG8_BAR;
    for (;;) {
        const bool has_next = S.next(ui + 1, nxt);
        const char* nA = has_next ? nxt.a : cA; const char* nB = has_next ? nxt.b : cB;
        if (has_next) S.aoff(nxt, Rr, Cc, nvA);
        else { nvA[0][0] = vA[0][0]; nvA[0][1] = vA[0][1]; nvA[1][0] = vA[1][0]; nvA[1][1] = vA[1][1]; }
#pragma unroll 1
        for (int t = 0; t < nt; t += 2) {
            const bool last = (t == nt - 2);
            const char* a1 = cA + (size_t)(t + 1) * kstep;
            const char* a2 = last ? nA : cA + (size_t)(t + 2) * kstep; const char* b2 = last ? nB : cB + (size_t)(t + 2) * kstep;
            const char* a3 = a2 + kstep; const char* b3 = b2 + kstep;
            unsigned w0[2], w1[2];
            w0[0] = last ? nvA[0][0] : vA[0][0]; w0[1] = last ? nvA[0][1] : vA[0][1]; w1[0] = last ? nvA[1][0] : vA[1][0]; w1[1] = last ? nvA[1][1] : vA[1][1];
            PG8_LDB(B0, 0, 0); PG8_LDB(B1, 0, 1); PG8_SCHED; PG8_LDA(At, 0, 0); PG8_STAGE(PG8_SA(1, 1), a1, vA[1]);
            PG8_WAIT_V(8); PG8_WAIT_L(0); PG8_BAR; PG8_MMA(0, 0, At, B0); PG8_MMA(0, 1, At, B1); PG8_BAR; PG8_SCHED;
            PG8_LDA(At, 0, 1); PG8_STAGE(PG8_SB(0, 0), b2, voffB); PG8_STAGE(PG8_SB(0, 1), b2 + hstepB, voffB); PG8_STAGE(PG8_SA(0, 0), a2, w0);
            PG8_WAIT_V(8); PG8_WAIT_L(0); PG8_BAR; PG8_MMA(1, 0, At, B0); PG8_MMA(1, 1, At, B1); PG8_BAR; PG8_SCHED;
            PG8_LDB(B0, 1, 0); PG8_LDB(B1, 1, 1); PG8_SCHED; PG8_LDA(At, 1, 0); PG8_STAGE(PG8_SA(0, 1), a2, w1);
            PG8_WAIT_V(8); PG8_WAIT_L(0); PG8_BAR; PG8_MMA(0, 0, At, B0); PG8_MMA(0, 1, At, B1); PG8_BAR; PG8_SCHED;
            PG8_LDA(At, 1, 1); PG8_STAGE(PG8_SB(1, 0), b3, voffB); PG8_STAGE(PG8_SB(1, 1), b3 + hstepB, voffB); PG8_STAGE(PG8_SA(1, 0), a3, w0);
            PG8_WAIT_V(8); PG8_WAIT_L(0); PG8_BAR; PG8_MMA(1, 0, At, B0); PG8_MMA(1, 1, At, B1); PG8_BAR; PG8_SCHED;
        }
        if (wr == 0) PG8_BAR;
        E(acc, cur, wr, wc, fr, fq);
        if (!has_next) break;
#pragma unroll
        for (int a = 0; a < 2; ++a)
#pragma unroll
            for (int b = 0; b < 2; ++b)
#pragma unroll
                for (int m = 0; m < 4; ++m)
#pragma unroll
                    for (int n = 0; n < 2; ++n) acc[a][b][m][n] = (f32x4){0.f, 0.f, 0.f, 0.f};
        cur = nxt; cA = nA; cB = nB; ++ui;
        vA[0][0] = nvA[0][0]; vA[0][1] = nvA[0][1]; vA[1][0] = nvA[1][0]; vA[1][1] = nvA[1][1];
        if (wr == 1) PG8_BAR;
    }
    PG8_WAIT_V(0);
    PG8_BAR;
#undef PG8_SA
#undef PG8_SB
#undef PG8_STAGE
#undef PG8_LDA
#undef PG8_LDB
#undef PG8_MMA
#undef PG8_WAIT_V
#undef PG8_WAIT_L
#undef PG8_BAR
#undef PG8_SCHED
}
}
using pg8::GU;

struct Args { const float* in[32]; float* out; unsigned char* ws; int ph_lo, ph_hi; };
struct Frame {
    LAS unsigned char* lds;
    LAS unsigned char* scr;
    unsigned char* ws;
    int tid, lane, wave, G, vcu;
};
enum { I_X = 0, I_C, I_CTX, I_CCTX, I_NORMG, I_ADAW, I_ADAB, I_POOLW, I_POOLLS, I_MU, I_WRKV, I_W0, I_W1, I_W2, I_A0, I_A1, I_A2, I_G1, I_G2, I_KK, I_KA, I_RK, I_LNG, I_LNB, I_WO,
       I_RW, I_RB, I_WGU, I_BGU, I_WDN, I_BDN, I_FINALG };

__device__ __forceinline__ const float* modp(const Frame& F, int layer, int row, int k) { return (const float*)(F.ws + WS_MOD) + ((size_t)(layer * 3 + row) * NMOD + k) * D; }
__device__ __forceinline__ int mrow_of(int n) { return n < NL ? (n >> 14) : 2; }

__device__ __forceinline__ void transpose_tile(const float* W, int ldw, int k0, int n0, bf16_t* WT, size_t dst_row0, int ldk, int kdst0, LAS float* scr, int lane) {
    const int c4 = lane & 15, kr = lane >> 4;
#pragma unroll 4
    for (int it = 0; it < 16; ++it) { const int kk = 4 * it + kr; const f32x4 v = *(const GAS f32x4*)(W + (size_t)(k0 + kk) * ldw + n0 + 4 * c4);
        LAS float* s = scr + kk * 65 + 4 * c4; s[0] = v[0]; s[1] = v[1]; s[2] = v[2]; s[3] = v[3]; }
    LDS_WAIT(); asm volatile("" ::: "memory");
    const int c = lane & 7;
#pragma unroll
    for (int j = 0; j < 8; ++j) { const int n = (lane >> 3) + 8 * j; const LAS float* s = scr + (8 * c) * 65 + n;
        u32x4 o; o.x = cvt_pk_bf16(s[0 * 65], s[1 * 65]); o.y = cvt_pk_bf16(s[2 * 65], s[3 * 65]); o.z = cvt_pk_bf16(s[4 * 65], s[5 * 65]); o.w = cvt_pk_bf16(s[6 * 65], s[7 * 65]);
        *(GAS u32x4*)(WT + (dst_row0 + n) * (size_t)ldk + kdst0 + k0 + 8 * c) = o; }
    LDS_WAIT(); asm volatile("" ::: "memory");
}

__device__ __forceinline__ void phase_prep(const Frame& F, const Args& A) {
    unsigned char* ws = F.ws;
    if (blockIdx.x < 192) {
        const int l = blockIdx.x / 96, cc = blockIdx.x % 96, c4 = F.tid & 15, kq = F.tid >> 4;
        const float* w = A.in[I_ADAW] + (size_t)l * D * (NMOD * D) + cc * 64 + 4 * c4;
        f32x4 a0 = {0, 0, 0, 0}, a1 = {0, 0, 0, 0}, a2 = {0, 0, 0, 0};
        for (int i = 0; i < 32; ++i) { const int k = kq + 32 * i;
            const f32x4 wv = *(const GAS f32x4*)(w + (size_t)k * (NMOD * D));
            float c0 = A.in[I_C][k], c1 = A.in[I_C][D + k], c2 = A.in[I_CCTX][k];
            c0 = c0 * sigmoidf_(c0); c1 = c1 * sigmoidf_(c1); c2 = c2 * sigmoidf_(c2);
            a0 += wv * c0; a1 += wv * c1; a2 += wv * c2; }
        LAS f32x4* red = (LAS f32x4*)F.scr;
        red[(kq * 3 + 0) * 16 + c4] = a0; red[(kq * 3 + 1) * 16 + c4] = a1; red[(kq * 3 + 2) * 16 + c4] = a2;
        __syncthreads();
        if (F.tid < 192) { const int r = F.tid / 64, c = F.tid % 64; float s = 0.f;
            for (int q = 0; q < 32; ++q) s += ((LAS float*)F.scr)[((q * 3 + r) * 16) * 4 + c];
            const int col = cc * 64 + c;
            ((float*)(ws + WS_MOD))[(size_t)(l * 3 + r) * (NMOD * D) + col] = s + A.in[I_ADAB][(size_t)l * NMOD * D + col]; }
        __syncthreads();
    }
    { bf16_t* w2p = (bf16_t*)(ws + WS_WL2);
      for (int i = blockIdx.x * NTHREADS + F.tid; i < 4 * 1024 * 8; i += F.G * NTHREADS) { const int o = i / 8192, c = (i / 8) % 1024, q = i % 8, d = o & 1;
          *(GAS u32x4*)(w2p + ((size_t)o * 1024 + c) * 128 + (1 - d) * 64 + q * 8) = (u32x4){0u, 0u, 0u, 0u}; } }
    LAS float* scr = (LAS float*)(F.scr) + F.wave * (64 * 65 + 63);
    const int gw = F.vcu * NWAVES + F.wave, NGW = F.G * NWAVES;
    constexpr int T_GU = 2 * NE * 16 * 32, T_DN = 2 * NE * 16 * 16, T_RKV = 3 * 256, T_WO = 256, T_L1 = 2 * 16 + 2 * 16 + 32, T_L2 = 2 * 16 + 2 * 16 + 2 * 16, T_PW = 4 * 16;
    constexpr int T_ALL = T_GU + T_DN + T_RKV + T_WO + T_L1 + T_L2 + T_PW;
    for (int it = gw; it < T_ALL; it += NGW) {
        int r = it;
        if (r < T_GU) { const int le = r / 512, q = r % 512, kb = q / 32, nb = q % 32; const int n0 = nb * 64;
            const int drow = (n0 < 1024) ? ((n0 >> 7) * 256 + (n0 & 127)) : (((n0 - 1024) >> 7) * 256 + 128 + ((n0 - 1024) & 127));
            transpose_tile(A.in[I_WGU] + (size_t)le * 1024 * 2048, 2048, kb * 64, n0, (bf16_t*)(ws + WS_WGU), (size_t)le * 2048 + drow, 1024, 0, scr, F.lane); continue; } r -= T_GU;
        if (r < T_DN) { const int le = r / 256, q = r % 256, kb = q / 16, nb = q % 16;
            transpose_tile(A.in[I_WDN] + (size_t)le * 1024 * 1024, 1024, kb * 64, nb * 64, (bf16_t*)(ws + WS_WDN), (size_t)le * 1024 + nb * 64, 1024, 0, scr, F.lane); continue; } r -= T_DN;
        if (r < T_RKV) { const int p = r / 256, q = r % 256, kb = q / 16, nb = q % 16;
            transpose_tile(A.in[I_WRKV] + (size_t)p * 1024 * 1024, 1024, kb * 64, nb * 64, (bf16_t*)(ws + WS_WRKV), (size_t)p * 1024 + nb * 64, 1024, 0, scr, F.lane); continue; } r -= T_RKV;
        if (r < T_WO) { const int kb = r / 16, nb = r % 16;
            transpose_tile(A.in[I_WO], 1024, kb * 64, nb * 64, (bf16_t*)(ws + WS_WO), (size_t)nb * 64, 1024, 0, scr, F.lane); continue; } r -= T_WO;
        if (r < T_L1) {
            if (r < 32) { const int d = r / 16, kb = r % 16; transpose_tile(A.in[I_W1] + (size_t)d * 1024 * 64, 64, kb * 64, 0, (bf16_t*)(ws + WS_WL1), (size_t)0 * 256 + d * 64, 1024, 0, scr, F.lane); continue; }
            r -= 32;
            if (r < 32) { const int d = r / 16, kb = r % 16; transpose_tile(A.in[I_A1] + (size_t)d * 1024 * 64, 64, kb * 64, 0, (bf16_t*)(ws + WS_WL1), (size_t)1 * 256 + d * 64, 1024, 0, scr, F.lane); continue; }
            r -= 32;
            { const int kb = r / 2, nb = r % 2; transpose_tile(A.in[I_G1], 128, kb * 64, nb * 64, (bf16_t*)(ws + WS_WL1), (size_t)2 * 256 + nb * 64, 1024, 0, scr, F.lane); continue; }
        } r -= T_L1;
        if (r < T_L2) {
            if (r < 32) { const int d = r / 16, nb = r % 16; transpose_tile(A.in[I_W2] + (size_t)d * 64 * 1024, 1024, 0, nb * 64, (bf16_t*)(ws + WS_WL2), (size_t)d * 1024 + nb * 64, 128, d * 64, scr, F.lane); continue; }
            r -= 32;
            if (r < 32) { const int d = r / 16, nb = r % 16; transpose_tile(A.in[I_A2] + (size_t)d * 64 * 1024, 1024, 0, nb * 64, (bf16_t*)(ws + WS_WL2), (size_t)(2 + d) * 1024 + nb * 64, 128, d * 64, scr, F.lane); continue; }
            r -= 32;
            { const int kb = r / 16, nb = r % 16; transpose_tile(A.in[I_G2], 1024, kb * 64, nb * 64, (bf16_t*)(ws + WS_WL2), (size_t)4 * 1024 + nb * 64, 128, 0, scr, F.lane); continue; }
        } r -= T_L2;
        { const int g = r / 16, q = r % 16, kb = q / 4, nb = q % 4;
          transpose_tile(A.in[I_POOLW] + (size_t)g * 256 * 256, 256, kb * 64, nb * 64, (bf16_t*)(ws + WS_WPOOL), (size_t)g * 256 + nb * 64, 256, 0, scr, F.lane); }
    }
}

__device__ __forceinline__ void phase_pre0(const Frame& F, const Args& A) {
    LAS float* hb = (LAS float*)F.scr;
    LAS float* rs = hb + 80 * 258;
    LAS float* gsc = rs + 80;
    LAS float* gsh = gsc + 256;
    bf16_t* dbuf = (bf16_t*)(F.ws + WS_DBUF);
    const float* ng = A.in[I_NORMG];
    for (int u = blockIdx.x; u < 520; u += F.G) {
        int tok0, nown = 64, hl = 0, hr = 0, L, pos0, row; const float* xsrc;
        if (u < 512) { tok0 = u * 64; L = 64; pos0 = 0; row = tok0 >> 14; xsrc = A.in[I_X] + (size_t)tok0 * D; }
        else { const int b = (u - 512) >> 2, q = (u - 512) & 3; tok0 = NL + b * CT + q * 64; L = CT; pos0 = q * 64; hl = q > 0 ? 8 : 0; hr = q < 3 ? 8 : 0; row = 2;
               xsrc = A.in[I_CTX] + (size_t)(b * CT + q * 64) * D; }
        const int nt = nown + hl + hr;
        for (int j = F.wave; j < nt; j += NWAVES) { const float* xr = xsrc + (ptrdiff_t)(j - hl) * D; float s = 0.f;
#pragma unroll
            for (int q = 0; q < 4; ++q) { const f32x4 v = *(const GAS f32x4*)(xr + 4 * F.lane + 256 * q); s += v[0] * v[0] + v[1] * v[1] + v[2] * v[2] + v[3] * v[3]; }
            s = wave_sum(s); if (F.lane == 0) rs[j] = 1.0f / sqrtf(s * (1.0f / D) + NORM_EPS); }
        for (int g = 0; g < 4; ++g) {
            __syncthreads();
            if (F.tid < 256) { const int c = g * 256 + F.tid; gsc[F.tid] = ng[c] * (1.0f + modp(F, 0, row, 1)[c]); gsh[F.tid] = modp(F, 0, row, 0)[c]; }
            __syncthreads();
            for (int i = F.tid; i < nt * 64; i += NTHREADS) { const int j = i >> 6, c4 = i & 63; const f32x4 v = *(const GAS f32x4*)(xsrc + (ptrdiff_t)(j - hl) * D + g * 256 + 4 * c4);
                const float r = rs[j]; LAS float* h = hb + j * 258 + 4 * c4;
                h[0] = v[0] * r * gsc[4 * c4 + 0] + gsh[4 * c4 + 0]; h[1] = v[1] * r * gsc[4 * c4 + 1] + gsh[4 * c4 + 1];
                h[2] = v[2] * r * gsc[4 * c4 + 2] + gsh[4 * c4 + 2]; h[3] = v[3] * r * gsc[4 * c4 + 3] + gsh[4 * c4 + 3]; }
            __syncthreads();
            const int win = 2 << g, hw = win >> 1;
            for (int i = F.tid; i < 64 * 128; i += NTHREADS) { const int cp = i & 127, t = i >> 7; const int p = pos0 + t;
                int lo = p - hw, hi = p + hw - 1; lo = lo < 0 ? 0 : lo; hi = hi > L - 1 ? L - 1 : hi;
                const int jlo = lo - (pos0 - hl), jhi = hi - (pos0 - hl);
                float s0 = 0.f, s1 = 0.f;
                for (int j = jlo; j <= jhi; ++j) { const f32x2 v = *(const LAS f32x2*)(hb + j * 258 + 2 * cp); s0 += v[0]; s1 += v[1]; }
                const float ic = 1.0f / (float)(hi - lo + 1); const f32x2 hv = *(const LAS f32x2*)(hb + (t + hl) * 258 + 2 * cp);
                *(GAS unsigned*)(dbuf + (size_t)(tok0 + t) * D + g * 256 + 2 * cp) = cvt_pk_bf16(s0 * ic - hv[0], s1 * ic - hv[1]); }
        }
        __syncthreads();
    }
}

struct SchedPool {
    const char* dbuf; const char* wpool; int G, vcu; int nt; unsigned ldb;
    __device__ __forceinline__ bool next(int i, GU& u) const { const int L = i * G + vcu; if (L >= 130 * 4) return false; const int pm = L >> 2, g = L & 3;
        u.a = dbuf + ((size_t)pm * 256 * D + g * 256) * 2; u.b = wpool + (size_t)g * 256 * 256 * 2; u.i0 = pm; u.i1 = g; u.i2 = 0; u.i3 = 0; return true; }
    __device__ __forceinline__ void aoff(const GU&, const int (&R)[2], const int (&C)[2], unsigned (&v)[2][2]) const {
#pragma unroll
        for (int h = 0; h < 2; ++h)
#pragma unroll
            for (int i = 0; i < 2; ++i) v[h][i] = (unsigned)((h * 128 + R[i]) * D + C[i]) * 2u; }
};
struct EpiPool {
    static constexpr bool PERM = false;
    const float* x; const float* ctx; const float* ls; const float* gate_base; float* xs;
    __device__ __forceinline__ void operator()(const f32x4 (&acc)[2][2][4][2], const GU& u, int wr, int wc, int fr, int fq) const {
        const int pm = u.i0, g = u.i1; const int mrow = pm < 128 ? (pm >> 6) : 2;
        const float* gate = gate_base + (size_t)mrow * NMOD * D;
        const float* src = pm < 128 ? x + (size_t)pm * 256 * D : ctx + (size_t)(pm - 128) * 256 * D;
        const int col0 = g * 256 + wc * 32 + 4 * fq;
        f32x4 gl[2][2];
#pragma unroll
        for (int bj = 0; bj < 2; ++bj)
#pragma unroll
            for (int n = 0; n < 2; ++n) { const int c = col0 + bj * 128 + n * 16; gl[bj][n] = *(const GAS f32x4*)(gate + c) * *(const GAS f32x4*)(ls + c); }
#pragma unroll
        for (int ai = 0; ai < 2; ++ai)
#pragma unroll
            for (int m = 0; m < 4; ++m) { const int r = ai * 128 + wr * 64 + m * 16 + fr; const float* sp = src + (size_t)r * D + col0; float* op = xs + ((size_t)pm * 256 + r) * D + col0;
#pragma unroll
                for (int bj = 0; bj < 2; ++bj)
#pragma unroll
                    for (int n = 0; n < 2; ++n) *(GAS f32x4*)(op + bj * 128 + n * 16) = *(const GAS f32x4*)(sp + bj * 128 + n * 16) + gl[bj][n] * acc[ai][bj][m][n]; }
    }
};

__device__ __forceinline__ void phase_final_plain(const Frame& F, const Args& A, const float* xs) {
    const int gw = blockIdx.x * NWAVES + F.wave, NGW = F.G * NWAVES;
    for (int n = gw; n < NL; n += NGW) { const float* xr = xs + (size_t)n * D; f32x4 v[4]; float s = 0.f;
#pragma unroll
        for (int q = 0; q < 4; ++q) { v[q] = *(const GAS f32x4*)(xr + 4 * F.lane + 256 * q); s += v[q][0] * v[q][0] + v[q][1] * v[q][1] + v[q][2] * v[q][2] + v[q][3] * v[q][3]; }
        s = wave_sum(s); const float r = 1.0f / sqrtf(s * (1.0f / D) + NORM_EPS);
#pragma unroll
        for (int q = 0; q < 4; ++q) { const f32x4 g = *(const GAS f32x4*)(A.in[I_FINALG] + 4 * F.lane + 256 * q); *(GAS f32x4*)(A.out + (size_t)n * D + 4 * F.lane + 256 * q) = v[q] * r * g; }
    }
}


__device__ __forceinline__ int* cnt_word(const Frame& F, int l, int e) { return (int*)(F.ws + WS_CTL + CTL_CNT) + (l * NE + e) * 64; }
__device__ __forceinline__ void phase_post(const Frame& F, const Args& A, int l, const float* xs, int ntok) {
    LAS float* h2s = (LAS float*)F.scr;
    LAS float* part = (LAS float*)F.scr;
    LAS float* lgs = (LAS float*)(F.scr + 32 * 1028 * 4);
    LAS int* hist = (LAS int*)(lgs + 32 * 33);
    LAS int* base = hist + 32;
    LAS int* sel = base + 32;
    LAS int* lrank = sel + 128;
    bf16_t* H2 = (bf16_t*)(F.ws + WS_H2);
    int* list = (int*)(F.ws + WS_LIST) + (size_t)l * NE * NTOK;
    int* tinfo = (int*)(F.ws + WS_TINFO) + (size_t)l * NTOK * 4;
    float* tgate = (float*)(F.ws + WS_TGATE) + (size_t)l * NTOK * 4;
    const float* ng = A.in[I_NORMG] + (size_t)(l * 2 + 1) * D;
    const float* rw = A.in[I_RW] + (size_t)l * D * NE;
    const float* rb = A.in[I_RB] + (size_t)l * NE;
    const int ntiles = ntok / 32;
    for (int tile = blockIdx.x; tile < ntiles; tile += F.G) {
        const int n0 = tile * 32, mrow = mrow_of(n0);
        const float* sc = modp(F, l, mrow, 4); const float* sh = modp(F, l, mrow, 3);
        if (F.tid < 32) hist[F.tid] = 0;
#pragma unroll 1
        for (int q = 0; q < 4; ++q) { const int tt = F.wave * 4 + q, n = n0 + tt; const float* xr = xs + (size_t)n * D; f32x4 v[4]; float s = 0.f;
#pragma unroll
            for (int jj = 0; jj < 4; ++jj) { v[jj] = *(const GAS f32x4*)(xr + 4 * F.lane + 256 * jj); s += v[jj][0] * v[jj][0] + v[jj][1] * v[jj][1] + v[jj][2] * v[jj][2] + v[jj][3] * v[jj][3]; }
            s = wave_sum(s); const float r = 1.0f / sqrtf(s * (1.0f / D) + NORM_EPS);
#pragma unroll
            for (int jj = 0; jj < 4; ++jj) { const int c = 4 * F.lane + 256 * jj; const f32x4 g = *(const GAS f32x4*)(ng + c), a = *(const GAS f32x4*)(sc + c), b = *(const GAS f32x4*)(sh + c);
                const f32x4 h = v[jj] * r * g * (a + 1.0f) + b;
                *(LAS f32x4*)(h2s + tt * 1028 + c) = h;
                u32x2 w; w.x = cvt_pk_bf16(h[0], h[1]); w.y = cvt_pk_bf16(h[2], h[3]); *(GAS u32x2*)(H2 + (size_t)n * D + c) = w; } }
        __syncthreads();
        f32x16 acc;
#pragma unroll
        for (int i = 0; i < 16; ++i) acc[i] = 0.f;
        { const int r = F.lane & 31, h = F.lane >> 5;
#pragma unroll 4
          for (int q = 0; q < 16; ++q) { const int kb = 128 * F.wave + 8 * q + 4 * h; const f32x4 a = *(const LAS f32x4*)(h2s + r * 1028 + kb);
              const float b0 = rw[(size_t)(kb + 0) * NE + r], b1 = rw[(size_t)(kb + 1) * NE + r], b2 = rw[(size_t)(kb + 2) * NE + r], b3 = rw[(size_t)(kb + 3) * NE + r];
              acc = __builtin_amdgcn_mfma_f32_32x32x2f32(a[0], b0, acc, 0, 0, 0); acc = __builtin_amdgcn_mfma_f32_32x32x2f32(a[1], b1, acc, 0, 0, 0);
              acc = __builtin_amdgcn_mfma_f32_32x32x2f32(a[2], b2, acc, 0, 0, 0); acc = __builtin_amdgcn_mfma_f32_32x32x2f32(a[3], b3, acc, 0, 0, 0); } }
        __syncthreads();
#pragma unroll
        for (int i = 0; i < 16; ++i) { const int row = (i & 3) + 8 * (i >> 2) + 4 * (F.lane >> 5), col = F.lane & 31; part[(F.wave * 32 + row) * 32 + col] = acc[i]; }
        __syncthreads();
        for (int i = F.tid; i < 1024; i += NTHREADS) { const int row = i >> 5, col = i & 31; float s = rb[col];
#pragma unroll
            for (int w = 0; w < 8; ++w) s += part[(w * 32 + row) * 32 + col];
            lgs[row * 33 + col] = s; }
        __syncthreads();
        if (F.tid < 32) { const int t = F.tid; float lv[32];
#pragma unroll
            for (int e = 0; e < 32; ++e) lv[e] = lgs[t * 33 + e];
            float tv[4]; int te[4];
#pragma unroll
            for (int j = 0; j < 4; ++j) { float best = -3.0e38f; int be = 0;
#pragma unroll
                for (int e = 0; e < 32; ++e) { const bool gt = lv[e] > best; best = gt ? lv[e] : best; be = gt ? e : be; }
                tv[j] = best; te[j] = be;
#pragma unroll
                for (int e = 0; e < 32; ++e) lv[e] = (e == be) ? -3.0e38f : lv[e]; }
            const float e1 = __expf(tv[1] - tv[0]), e2 = __expf(tv[2] - tv[0]), e3 = __expf(tv[3] - tv[0]); const float inv = 1.0f / (1.0f + e1 + e2 + e3);
            const float gt[4] = {inv, e1 * inv, e2 * inv, e3 * inv};
#pragma unroll
            for (int j = 0; j < 4; ++j) { sel[t * 4 + j] = te[j]; lrank[t * 4 + j] = __hip_atomic_fetch_add(&hist[te[j]], 1, __ATOMIC_RELAXED, __HIP_MEMORY_SCOPE_WORKGROUP);
                tgate[(size_t)(n0 + t) * 4 + j] = gt[j]; } }
        __syncthreads();
        if (F.tid < 32) { const int c = hist[F.tid]; base[F.tid] = c > 0 ? __hip_atomic_fetch_add(cnt_word(F, l, F.tid), c, __ATOMIC_RELAXED, __HIP_MEMORY_SCOPE_AGENT) : 0; }
        __syncthreads();
        if (F.tid < 128) { const int t = F.tid >> 2, e = sel[F.tid], pos = base[e] + lrank[F.tid]; list[(size_t)e * NTOK + pos] = n0 + t; tinfo[(size_t)(n0 + t) * 4 + (F.tid & 3)] = (e << 16) | pos; }
        __syncthreads();
    }
}

__device__ __forceinline__ void moe_prefix(const Frame& F, int l) {
    volatile LAS int* M = (volatile LAS int*)(F.lds + MISC_OFF);
    __syncthreads();
    if (F.tid == 0) { int acc = 0; for (int e = 0; e < NE; ++e) { const int c = __hip_atomic_load(cnt_word(F, l, e), __ATOMIC_RELAXED, __HIP_MEMORY_SCOPE_AGENT); M[64 + e] = c; M[16 + e] = acc; acc += (c + 255) >> 8; } M[16 + NE] = acc; }
    __syncthreads();
}

struct SchedMoe1 {
    const LAS int* M; const int* list; const char* h2; const char* w; int G, vcu; int nt; unsigned ldb;
    __device__ __forceinline__ bool next(int i, GU& u) const { const int L = i * G + vcu; const int tt = M[16 + NE]; if (L >= tt * 8) return false; const int mt = L >> 3, pn = L & 7;
        int e = 0; while (M[16 + e + 1] <= mt) ++e;
        u.a = h2; u.b = w + ((size_t)e * 2048 + pn * 256) * 1024 * 2; u.i0 = e; u.i1 = mt; u.i2 = pn; u.i3 = 0; return true; }
    __device__ __forceinline__ void aoff(const GU& u, const int (&R)[2], const int (&C)[2], unsigned (&v)[2][2]) const {
        const int e = u.i0, row0 = (u.i1 - M[16 + e]) * 256, nv = M[64 + e] - row0; const int* lp = list + (size_t)e * NTOK + row0;
#pragma unroll
        for (int h = 0; h < 2; ++h)
#pragma unroll
            for (int i = 0; i < 2; ++i) { const int r = h * 128 + R[i]; const int tok = lp[r < nv ? r : 0]; v[h][i] = (unsigned)(tok * D + C[i]) * 2u; } }
};
struct EpiMoe1 {
    static constexpr bool PERM = true;
    const float* bgu; bf16_t* act;
    __device__ __forceinline__ void operator()(const f32x4 (&acc)[2][2][4][2], const GU& u, int wr, int wc, int fr, int fq) const {
        const int e = u.i0, mt = u.i1, pn = u.i2; const int col0 = pn * 128 + wc * 32 + 8 * fq;
        f32x4 bg[2], bu[2];
#pragma unroll
        for (int n = 0; n < 2; ++n) { bg[n] = *(const GAS f32x4*)(bgu + (size_t)e * 2048 + col0 + 4 * n); bu[n] = *(const GAS f32x4*)(bgu + (size_t)e * 2048 + 1024 + col0 + 4 * n); }
#pragma unroll
        for (int ai = 0; ai < 2; ++ai)
#pragma unroll
            for (int m = 0; m < 4; ++m) { const size_t slot = (size_t)mt * 256 + ai * 128 + wr * 64 + m * 16 + fr; float o[8];
#pragma unroll
                for (int n = 0; n < 2; ++n)
#pragma unroll
                    for (int j = 0; j < 4; ++j) { float g = acc[ai][0][m][n][j] + bg[n][j], up = acc[ai][1][m][n][j] + bu[n][j];
                        g = fminf(g, 7.0f); up = fminf(fmaxf(up, -7.0f), 7.0f); o[4 * n + j] = (up + 1.0f) * (g / (1.0f + __expf(-1.702f * g))); }
                u32x4 w; w.x = cvt_pk_bf16(o[0], o[1]); w.y = cvt_pk_bf16(o[2], o[3]); w.z = cvt_pk_bf16(o[4], o[5]); w.w = cvt_pk_bf16(o[6], o[7]);
                *(GAS u32x4*)(act + slot * D + col0) = w; }
    }
};
struct SchedMoe2 {
    const LAS int* M; const char* act; const char* w; int G, vcu; int nt; unsigned ldb;
    __device__ __forceinline__ bool next(int i, GU& u) const { const int L = i * G + vcu; const int tt = M[16 + NE]; if (L >= tt * 4) return false; const int mt = L >> 2, pn = L & 3;
        int e = 0; while (M[16 + e + 1] <= mt) ++e;
        u.a = act + (size_t)mt * 256 * D * 2; u.b = w + ((size_t)e * 1024 + pn * 256) * 1024 * 2; u.i0 = e; u.i1 = mt; u.i2 = pn; u.i3 = 0; return true; }
    __device__ __forceinline__ void aoff(const GU&, const int (&R)[2], const int (&C)[2], unsigned (&v)[2][2]) const {
#pragma unroll
        for (int h = 0; h < 2; ++h)
#pragma unroll
            for (int i = 0; i < 2; ++i) v[h][i] = (unsigned)((h * 128 + R[i]) * D + C[i]) * 2u; }
};
struct EpiMoe2 {
    static constexpr bool PERM = true;
    const float* bdn; bf16_t* y2;
    __device__ __forceinline__ void operator()(const f32x4 (&acc)[2][2][4][2], const GU& u, int wr, int wc, int fr, int fq) const {
        const int e = u.i0, mt = u.i1, pn = u.i2; const int col0 = pn * 256 + wc * 32 + 8 * fq;
        f32x4 bv[2][2];
#pragma unroll
        for (int bj = 0; bj < 2; ++bj)
#pragma unroll
            for (int n = 0; n < 2; ++n) bv[bj][n] = *(const GAS f32x4*)(bdn + (size_t)e * D + col0 + bj * 128 + 4 * n);
#pragma unroll
        for (int ai = 0; ai < 2; ++ai)
#pragma unroll
            for (int m = 0; m < 4; ++m) { const size_t slot = (size_t)mt * 256 + ai * 128 + wr * 64 + m * 16 + fr;
#pragma unroll
                for (int bj = 0; bj < 2; ++bj) { const f32x4 v0 = acc[ai][bj][m][0] + bv[bj][0], v1 = acc[ai][bj][m][1] + bv[bj][1];
                    u32x4 w; w.x = cvt_pk_bf16(v0[0], v0[1]); w.y = cvt_pk_bf16(v0[2], v0[3]); w.z = cvt_pk_bf16(v1[0], v1[1]); w.w = cvt_pk_bf16(v1[2], v1[3]);
                    *(GAS u32x4*)(y2 + slot * D + col0 + bj * 128) = w; } }
    }
};
__device__ __forceinline__ void phase_moe1(const Frame& F, const Args& A, int l) {
    moe_prefix(F, l);
    SchedMoe1 S{(const LAS int*)(F.lds + MISC_OFF), (const int*)(F.ws + WS_LIST) + (size_t)l * NE * NTOK, (const char*)(F.ws + WS_H2), (const char*)(F.ws + WS_WGU) + (size_t)l * NE * 2048 * 1024 * 2, F.G, F.vcu, 16, 1024u};
    EpiMoe1 E{A.in[I_BGU] + (size_t)l * NE * 2048, (bf16_t*)(F.ws + WS_ACT)};
    pg8::gemm_phase<EpiMoe1, SchedMoe1>(F.scr, S, E);
}
__device__ __forceinline__ void phase_moe2(const Frame& F, const Args& A, int l) {
    moe_prefix(F, l);
    SchedMoe2 S{(const LAS int*)(F.lds + MISC_OFF), (const char*)(F.ws + WS_ACT), (const char*)(F.ws + WS_WDN) + (size_t)l * NE * 1024 * 1024 * 2, F.G, F.vcu, 16, 1024u};
    EpiMoe2 E{A.in[I_BDN] + (size_t)l * NE * D, (bf16_t*)(F.ws + WS_Y2)};
    pg8::gemm_phase<EpiMoe2, SchedMoe2>(F.scr, S, E);
}
__device__ __forceinline__ void moe_combine_row(const Frame& F, int l, int n, f32x4 (&o)[4]) {
    const volatile LAS int* M = (const volatile LAS int*)(F.lds + MISC_OFF);
    const int* ti = (const int*)(F.ws + WS_TINFO) + ((size_t)l * NTOK + n) * 4; const float* tg = (const float*)(F.ws + WS_TGATE) + ((size_t)l * NTOK + n) * 4;
    const bf16_t* y2 = (const bf16_t*)(F.ws + WS_Y2);
#pragma unroll
    for (int q = 0; q < 4; ++q) o[q] = (f32x4){0.f, 0.f, 0.f, 0.f};
#pragma unroll
    for (int j = 0; j < 4; ++j) { const int inf = ti[j]; const float g = tg[j]; const int e = inf >> 16, pos = inf & 0xffff; const size_t slot = (size_t)M[16 + e] * 256 + pos;
#pragma unroll
        for (int q = 0; q < 4; ++q) { const u32x2 w = *(const GAS u32x2*)(y2 + slot * D + 4 * F.lane + 256 * q);
            o[q] += (f32x4){bf_lo(w.x), bf_hi(w.x), bf_lo(w.y), bf_hi(w.y)} * g; } }
}
__device__ __forceinline__ void phase_final(const Frame& F, const Args& A, int l, const float* xs) {
    moe_prefix(F, l);
    const int gw = blockIdx.x * NWAVES + F.wave, NGW = F.G * NWAVES;
    for (int n = gw; n < NL; n += NGW) { const float* xr = xs + (size_t)n * D; const float* gate = modp(F, l, n >> 14, 5); f32x4 v[4], mo[4]; float s = 0.f;
        moe_combine_row(F, l, n, mo);
#pragma unroll
        for (int q = 0; q < 4; ++q) { const int c = 4 * F.lane + 256 * q; v[q] = *(const GAS f32x4*)(xr + c) + *(const GAS f32x4*)(gate + c) * mo[q]; s += v[q][0] * v[q][0] + v[q][1] * v[q][1] + v[q][2] * v[q][2] + v[q][3] * v[q][3]; }
        s = wave_sum(s); const float r = 1.0f / sqrtf(s * (1.0f / D) + NORM_EPS);
#pragma unroll
        for (int q = 0; q < 4; ++q) { const f32x4 g = *(const GAS f32x4*)(A.in[I_FINALG] + 4 * F.lane + 256 * q); *(GAS f32x4*)(A.out + (size_t)n * D + 4 * F.lane + 256 * q) = v[q] * r * g; }
    }
}


__device__ __forceinline__ void phase_pre1(const Frame& F, const Args& A) {
    moe_prefix(F, 0);
    LAS float* hs = (LAS float*)F.scr;
    const float* xs0 = (const float*)(F.ws + WS_XS0); float* xs1 = (float*)(F.ws + WS_XS1);
    const float* ng = A.in[I_NORMG] + (size_t)(1 * 2 + 0) * D;
    for (int tile = blockIdx.x; tile < NTOK / 32; tile += F.G) {
        const int n0 = tile * 32, mrow = mrow_of(n0);
        const int sbeg = n0 < NL ? (n0 & ~(TSEQ - 1)) : (NL + ((n0 - NL) & ~(CT - 1))), send = sbeg + (n0 < NL ? TSEQ : CT);
        const float* gate5 = modp(F, 0, mrow, 5); const float* sc = modp(F, 1, mrow, 1); const float* sh = modp(F, 1, mrow, 0);
        for (int j = F.wave; j < 34; j += NWAVES) { const int n = n0 - 1 + j;
            if (n < sbeg || n >= send) {
#pragma unroll
                for (int q = 0; q < 4; ++q) *(LAS f32x4*)(hs + j * 1028 + 4 * F.lane + 256 * q) = (f32x4){0.f, 0.f, 0.f, 0.f};
                continue; }
            f32x4 mo[4], v[4]; float s = 0.f; moe_combine_row(F, 0, n, mo);
#pragma unroll
            for (int q = 0; q < 4; ++q) { const int c = 4 * F.lane + 256 * q; v[q] = *(const GAS f32x4*)(xs0 + (size_t)n * D + c) + *(const GAS f32x4*)(gate5 + c) * mo[q];
                s += v[q][0] * v[q][0] + v[q][1] * v[q][1] + v[q][2] * v[q][2] + v[q][3] * v[q][3]; }
            if (j >= 1 && j <= 32) {
#pragma unroll
                for (int q = 0; q < 4; ++q) *(GAS f32x4*)(xs1 + (size_t)n * D + 4 * F.lane + 256 * q) = v[q]; }
            s = wave_sum(s); const float r = 1.0f / sqrtf(s * (1.0f / D) + NORM_EPS);
#pragma unroll
            for (int q = 0; q < 4; ++q) { const int c = 4 * F.lane + 256 * q; const f32x4 g = *(const GAS f32x4*)(ng + c), a = *(const GAS f32x4*)(sc + c), b = *(const GAS f32x4*)(sh + c);
                *(LAS f32x4*)(hs + j * 1028 + c) = v[q] * r * g * (a + 1.0f) + b; } }
        __syncthreads();
#pragma unroll 1
        for (int q4 = 0; q4 < 4; ++q4) { const int t = F.wave * 4 + q4, j = t + 1, n = n0 + t;
#pragma unroll
            for (int q = 0; q < 4; ++q) { const int c = 4 * F.lane + 256 * q;
                const f32x4 hm = *(const LAS f32x4*)(hs + (j - 1) * 1028 + c), h0 = *(const LAS f32x4*)(hs + j * 1028 + c), hp = *(const LAS f32x4*)(hs + (j + 1) * 1028 + c);
                const f32x4 xx = (hm + hp) * 0.5f - h0;
#pragma unroll
                for (int i = 0; i < 6; ++i) { const f32x4 mu = *(const GAS f32x4*)(A.in[I_MU] + (size_t)i * D + c); const f32x4 o = h0 + xx * mu;
                    u32x2 w; w.x = cvt_pk_bf16(o[0], o[1]); w.y = cvt_pk_bf16(o[2], o[3]);
                    *(GAS u32x2*)((bf16_t*)(F.ws + WS_MIX + (size_t)i * ACTB) + (size_t)n * D + c) = w; } } }
        __syncthreads();
    }
}

struct SchedProj {
    const char* ws; int G, vcu; int nt; unsigned ldb;
    __device__ __forceinline__ bool next(int i, GU& u) const { int L = i * G + vcu; if (L >= 1940) return false;
        int kind, mi, wi, pm, pn;
        if (L < 512) { kind = 0; mi = 0; wi = 0; pm = L >> 2; pn = L & 3; }
        else if (L < 1032) { L -= 512; kind = 0; mi = 2; wi = 1; pm = L >> 2; pn = L & 3; }
        else if (L < 1552) { L -= 1032; kind = 0; mi = 3; wi = 2; pm = L >> 2; pn = L & 3; }
        else if (L < 1682) { L -= 1552; kind = 1; mi = 1; wi = 0; pm = L; pn = 0; }
        else if (L < 1812) { L -= 1682; kind = 2; mi = 4; wi = 1; pm = L; pn = 0; }
        else { L -= 1812; kind = 3; mi = 5; wi = 2; pm = L; pn = 0; }
        u.a = ws + WS_MIX + (size_t)mi * ACTB + (size_t)pm * 256 * D * 2;
        u.b = kind == 0 ? ws + WS_WRKV + ((size_t)wi * 1024 + pn * 256) * 1024 * 2 : ws + WS_WL1 + (size_t)wi * 256 * 1024 * 2;
        u.i0 = pm; u.i1 = pn; u.i2 = kind; u.i3 = wi; return true; }
    __device__ __forceinline__ void aoff(const GU&, const int (&R)[2], const int (&C)[2], unsigned (&v)[2][2]) const {
#pragma unroll
        for (int h = 0; h < 2; ++h)
#pragma unroll
            for (int i = 0; i < 2; ++i) v[h][i] = (unsigned)((h * 128 + R[i]) * D + C[i]) * 2u; }
};
struct EpiProj {
    static constexpr bool PERM = true;
    unsigned char* ws;
    __device__ __forceinline__ void operator()(const f32x4 (&acc)[2][2][4][2], const GU& u, int wr, int wc, int fr, int fq) const {
        const int pm = u.i0, pn = u.i1, kind = u.i2, wi = u.i3;
        if (kind == 0) { bf16_t* o = (bf16_t*)(ws + WS_RKV + (size_t)wi * ACTB); const int col0 = pn * 256 + wc * 32 + 8 * fq;
#pragma unroll
            for (int ai = 0; ai < 2; ++ai)
#pragma unroll
                for (int m = 0; m < 4; ++m) { const size_t n = (size_t)pm * 256 + ai * 128 + wr * 64 + m * 16 + fr;
#pragma unroll
                    for (int bj = 0; bj < 2; ++bj) { const f32x4 v0 = acc[ai][bj][m][0], v1 = acc[ai][bj][m][1];
                        u32x4 w; w.x = cvt_pk_bf16(v0[0], v0[1]); w.y = cvt_pk_bf16(v0[2], v0[3]); w.z = cvt_pk_bf16(v1[0], v1[1]); w.w = cvt_pk_bf16(v1[2], v1[3]);
                        *(GAS u32x4*)(o + n * D + col0 + bj * 128) = w; } }
        } else { bf16_t* o = (bf16_t*)(ws + WS_LACT + (size_t)(kind - 1) * NTOK * 128 * 2); const int col0 = wc * 32 + 8 * fq;
#pragma unroll
            for (int ai = 0; ai < 2; ++ai)
#pragma unroll
                for (int m = 0; m < 4; ++m) { const size_t n = (size_t)pm * 256 + ai * 128 + wr * 64 + m * 16 + fr; float t[8];
#pragma unroll
                    for (int nn = 0; nn < 2; ++nn)
#pragma unroll
                        for (int j = 0; j < 4; ++j) { const float x = acc[ai][0][m][nn][j]; t[4 * nn + j] = kind == 1 ? tanhf(x) : (kind == 2 ? x : sigmoidf_(x)); }
                    u32x4 w; w.x = cvt_pk_bf16(t[0], t[1]); w.y = cvt_pk_bf16(t[2], t[3]); w.z = cvt_pk_bf16(t[4], t[5]); w.w = cvt_pk_bf16(t[6], t[7]);
                    *(GAS u32x4*)(o + n * 128 + col0) = w; } }
    }
};
struct SchedLora2 {
    const char* ws; int G, vcu; int nt; unsigned ldb;
    __device__ __forceinline__ bool next(int i, GU& u) const { int L = i * G + vcu; if (L >= 4 * 520 + 512) return false;
        const int o = L < 2080 ? L / 520 : 4; L -= o * 520; const int pm = L >> 2, pn = L & 3; const int oa = o < 4 ? (o >> 1) : 2;
        u.a = ws + WS_LACT + (size_t)oa * NTOK * 128 * 2 + (size_t)pm * 256 * 128 * 2; u.b = ws + WS_WL2 + ((size_t)o * 1024 + pn * 256) * 128 * 2;
        u.i0 = pm; u.i1 = pn; u.i2 = o; u.i3 = 0; return true; }
    __device__ __forceinline__ void aoff(const GU&, const int (&R)[2], const int (&C)[2], unsigned (&v)[2][2]) const {
#pragma unroll
        for (int h = 0; h < 2; ++h)
#pragma unroll
            for (int i = 0; i < 2; ++i) v[h][i] = (unsigned)((h * 128 + R[i]) * 128 + C[i]) * 2u; }
};
struct EpiLora2 {
    static constexpr bool PERM = false;
    unsigned char* ws; const float* w0; const float* a0;
    __device__ __forceinline__ void operator()(const f32x4 (&acc)[2][2][4][2], const GU& u, int wr, int wc, int fr, int fq) const {
        const int pm = u.i0, pn = u.i1, o = u.i2; const int col0 = pn * 256 + wc * 32 + 4 * fq;
        const float* bp = (o < 2 ? w0 + (size_t)o * D : a0 + (size_t)(o & 1) * D) + col0; const float bsc = o < 4 ? 1.0f : 0.0f;
        f32x4 bv[2][2];
#pragma unroll
        for (int bj = 0; bj < 2; ++bj)
#pragma unroll
            for (int n = 0; n < 2; ++n) bv[bj][n] = *(const GAS f32x4*)(bp + bj * 128 + n * 16) * bsc;
        const size_t row0 = (size_t)pm * 256 + wr * 64 + fr;
        if (o < 2) { float* dst = (float*)(ws + WS_DEC) + ((size_t)o * NTOK + row0) * D + col0;
#pragma unroll
            for (int ai = 0; ai < 2; ++ai)
#pragma unroll
                for (int m = 0; m < 4; ++m)
#pragma unroll
                    for (int bj = 0; bj < 2; ++bj)
#pragma unroll
                        for (int nn = 0; nn < 2; ++nn) { const f32x4 z = acc[ai][bj][m][nn] + bv[bj][nn]; f32x4 d;
#pragma unroll
                            for (int j = 0; j < 4; ++j) d[j] = __expf(-0.60653066f * sigmoidf_(z[j]));
                            *(GAS f32x4*)(dst + (size_t)(ai * 128 + m * 16) * D + bj * 128 + nn * 16) = d; }
        } else { bf16_t* dst = (o < 4 ? (bf16_t*)(ws + WS_ICL + (size_t)(o - 2) * ACTB) : (bf16_t*)(ws + WS_G)) + row0 * D + col0; const bool sg = o < 4;
#pragma unroll
            for (int ai = 0; ai < 2; ++ai)
#pragma unroll
                for (int m = 0; m < 4; ++m)
#pragma unroll
                    for (int bj = 0; bj < 2; ++bj)
#pragma unroll
                        for (int nn = 0; nn < 2; ++nn) { f32x4 z = acc[ai][bj][m][nn] + bv[bj][nn];
#pragma unroll
                            for (int j = 0; j < 4; ++j) z[j] = sg ? sigmoidf_(z[j]) : z[j];
                            u32x2 w; w.x = cvt_pk_bf16(z[0], z[1]); w.y = cvt_pk_bf16(z[2], z[3]);
                            *(GAS u32x2*)(dst + (size_t)(ai * 128 + m * 16) * D + bj * 128 + nn * 16) = w; }
        }
    }
};
__device__ __forceinline__ void ld16bf(const bf16_t* p, float (&o)[16]) { const u32x4 a = *(const GAS u32x4*)p, b = *(const GAS u32x4*)(p + 8);
    o[0] = bf_lo(a.x); o[1] = bf_hi(a.x); o[2] = bf_lo(a.y); o[3] = bf_hi(a.y); o[4] = bf_lo(a.z); o[5] = bf_hi(a.z); o[6] = bf_lo(a.w); o[7] = bf_hi(a.w);
    o[8] = bf_lo(b.x); o[9] = bf_hi(b.x); o[10] = bf_lo(b.y); o[11] = bf_hi(b.y); o[12] = bf_lo(b.z); o[13] = bf_hi(b.z); o[14] = bf_lo(b.w); o[15] = bf_hi(b.w); }
__device__ __forceinline__ void st16bf(bf16_t* p, const float (&o)[16]) { u32x4 a, b;
    a.x = cvt_pk_bf16(o[0], o[1]); a.y = cvt_pk_bf16(o[2], o[3]); a.z = cvt_pk_bf16(o[4], o[5]); a.w = cvt_pk_bf16(o[6], o[7]);
    b.x = cvt_pk_bf16(o[8], o[9]); b.y = cvt_pk_bf16(o[10], o[11]); b.z = cvt_pk_bf16(o[12], o[13]); b.w = cvt_pk_bf16(o[14], o[15]);
    *(GAS u32x4*)p = a; *(GAS u32x4*)(p + 8) = b; }
__device__ __forceinline__ void ld16f(const float* p, float (&o)[16]) {
#pragma unroll
    for (int q = 0; q < 4; ++q) { const f32x4 v = *(const GAS f32x4*)(p + 4 * q); o[4 * q] = v[0]; o[4 * q + 1] = v[1]; o[4 * q + 2] = v[2]; o[4 * q + 3] = v[3]; } }
__device__ __forceinline__ void phase_fin(const Frame& F, const Args& A) {
    const int gw = blockIdx.x * NWAVES + F.wave, NGW = F.G * NWAVES; const int c0 = 16 * F.lane;
    float kkw[16], kaw[16]; ld16f(A.in[I_KK] + c0, kkw); ld16f(A.in[I_KA] + c0, kaw);
    const bf16_t* Kp = (const bf16_t*)(F.ws + WS_RKV + 1 * ACTB);
    for (int n = gw; n < NTOK; n += NGW) { const size_t off = (size_t)n * D + c0; float k[16], i0[16], i1[16], kk[16], o[16];
        ld16bf(Kp + off, k); ld16bf((const bf16_t*)(F.ws + WS_ICL) + off, i0); ld16bf((const bf16_t*)(F.ws + WS_ICL + ACTB) + off, i1);
        float ss = 0.f;
#pragma unroll
        for (int j = 0; j < 16; ++j) { kk[j] = k[j] * kkw[j]; ss += kk[j] * kk[j]; }
        ss += __shfl_xor(ss, 1); ss += __shfl_xor(ss, 2);
        const float inv = 1.0f / fmaxf(sqrtf(ss), 1e-12f);
#pragma unroll
        for (int j = 0; j < 16; ++j) kk[j] *= inv;
        st16bf((bf16_t*)(F.ws + WS_KK) + off, kk);
#pragma unroll
        for (int j = 0; j < 16; ++j) o[j] = k[j] * (1.0f + (i0[j] - 1.0f) * kaw[j]);
        st16bf((bf16_t*)(F.ws + WS_KDIR) + off, o);
#pragma unroll
        for (int j = 0; j < 16; ++j) o[j] = k[j] * (1.0f + (i1[j] - 1.0f) * kaw[j]);
        st16bf((bf16_t*)(F.ws + WS_KDIR + ACTB) + off, o);
#pragma unroll
        for (int j = 0; j < 16; ++j) o[j] = kk[j] * i0[j];
        st16bf((bf16_t*)(F.ws + WS_BV) + off, o);
#pragma unroll
        for (int j = 0; j < 16; ++j) o[j] = kk[j] * i1[j];
        st16bf((bf16_t*)(F.ws + WS_BV + ACTB) + off, o);
    }
}
__device__ __forceinline__ float dpp_add(float v, const int ctrl_sel) {
    const int x = __builtin_bit_cast(int, v); int y;
    if (ctrl_sel == 0) y = __builtin_amdgcn_update_dpp(0, x, 0xB1, 0xF, 0xF, true);
    else if (ctrl_sel == 1) y = __builtin_amdgcn_update_dpp(0, x, 0x4E, 0xF, 0xF, true);
    else if (ctrl_sel == 2) y = __builtin_amdgcn_update_dpp(0, x, 0x141, 0xF, 0xF, true);
    else y = __builtin_amdgcn_update_dpp(0, x, 0x140, 0xF, 0xF, true);
    return v + __builtin_bit_cast(float, y);
}
__device__ __forceinline__ float red16(float v) { v = dpp_add(v, 0); v = dpp_add(v, 1); v = dpp_add(v, 2); v = dpp_add(v, 3); return v; }
constexpr int SCS = 32, SNS = CT + TSEQ, SNCH = SNS / SCS;
constexpr int SBUF_FLOATS = 5 * SCS * 64 + SCS * 16 + SCS * 16;
__device__ __forceinline__ int scan_token(int sg, int d, int b) { if (sg < CT) { const int t = d ? (CT - 1 - sg) : sg; return NL + b * CT + t; } const int u = sg - CT; const int t = d ? (TSEQ - 1 - u) : u; return b * TSEQ + t; }
__device__ __forceinline__ void scan_load_chunk(const Frame& F, LAS float* buf, int ch, int d, int b, int hd, int rq) {
    const int lt = F.tid - 256, s = lt >> 3, p = lt & 7; const int sg = ch * SCS + s; const int n = scan_token(sg, d, b); const size_t off = (size_t)n * D + hd * 64 + 8 * p;
    { const float* dp = (const float*)(F.ws + WS_DEC) + (size_t)d * NTOK * D + off; const f32x4 a = *(const GAS f32x4*)dp, c = *(const GAS f32x4*)(dp + 4);
      LAS float* o = buf + (0 * SCS + s) * 64 + 8 * p; *(LAS f32x4*)o = a; *(LAS f32x4*)(o + 4) = c; }
    const bf16_t* srcs[4] = { (const bf16_t*)(F.ws + WS_KDIR + (size_t)d * ACTB), (const bf16_t*)(F.ws + WS_KK), (const bf16_t*)(F.ws + WS_BV + (size_t)d * ACTB), (const bf16_t*)(F.ws + WS_RKV) };
#pragma unroll
    for (int v = 0; v < 4; ++v) { u32x4 w = (u32x4){0u, 0u, 0u, 0u}; if (v < 3 || sg >= CT) w = *(const GAS u32x4*)(srcs[v] + off);
        LAS float* o = buf + ((v + 1) * SCS + s) * 64 + 8 * p;
        *(LAS f32x4*)o = (f32x4){bf_lo(w.x), bf_hi(w.x), bf_lo(w.y), bf_hi(w.y)}; *(LAS f32x4*)(o + 4) = (f32x4){bf_lo(w.z), bf_hi(w.z), bf_lo(w.w), bf_hi(w.w)}; }
    if (p < 2) { const u32x4 w = *(const GAS u32x4*)((const bf16_t*)(F.ws + WS_RKV + 2 * ACTB) + (size_t)n * D + hd * 64 + rq * 16 + 8 * p);
        LAS float* o = buf + 5 * SCS * 64 + s * 16 + 8 * p;
        *(LAS f32x4*)o = (f32x4){bf_lo(w.x), bf_hi(w.x), bf_lo(w.y), bf_hi(w.y)}; *(LAS f32x4*)(o + 4) = (f32x4){bf_lo(w.z), bf_hi(w.z), bf_lo(w.w), bf_hi(w.w)}; }
}
__device__ __forceinline__ void scan_store_chunk(const Frame& F, const LAS float* buf, int ch, int d, int b, int hd, int rq) {
    const int lt = F.tid - 256, s = lt >> 3, p = lt & 7; const int sg = ch * SCS + s; if (sg < CT) return;
    const int n = scan_token(sg, d, b); const LAS float* y = buf + 5 * SCS * 64 + SCS * 16 + s * 16 + 2 * p;
    *(GAS unsigned*)((bf16_t*)(F.ws + WS_YD + (size_t)d * NL * D * 2) + (size_t)n * D + hd * 64 + rq * 16 + 2 * p) = cvt_pk_bf16(y[0], y[1]);
}
__device__ __forceinline__ void phase_scan(const Frame& F, const Args& A) {
    LAS float* bufs = (LAS float*)F.scr;
    for (int job = F.vcu; job < 256; job += F.G) {
        const int sd = job >> 2, rq = job & 3, d = sd & 1, bh = sd >> 1, b = bh >> 4, hd = bh & 15;
        const int kg = F.lane & 15, rho = F.lane >> 4;
        f32x2 s01 = {0.f, 0.f}, s23 = {0.f, 0.f};
        __syncthreads();
        if (F.tid >= 256) scan_load_chunk(F, bufs, 0, d, b, hd, rq);
        __syncthreads();
        for (int ch = 0; ch < SNCH; ++ch) {
            LAS float* buf = bufs + (ch & 1) * SBUF_FLOATS;
            if (F.tid >= 256) {
                if (ch > 0) scan_store_chunk(F, bufs + ((ch - 1) & 1) * SBUF_FLOATS, ch - 1, d, b, hd, rq);
                if (ch + 1 < SNCH) scan_load_chunk(F, bufs + ((ch + 1) & 1) * SBUF_FLOATS, ch + 1, d, b, hd, rq);
            } else {
                const LAS float* vb = buf + 5 * SCS * 64 + 4 * F.wave + rho; LAS float* yb = buf + 5 * SCS * 64 + SCS * 16 + 4 * F.wave + rho;
#pragma unroll 4
                for (int s = 0; s < SCS; ++s) {
                    const f32x4 w = *(const LAS f32x4*)(buf + (0 * SCS + s) * 64 + 4 * kg), kd = *(const LAS f32x4*)(buf + (1 * SCS + s) * 64 + 4 * kg),
                                kk = *(const LAS f32x4*)(buf + (2 * SCS + s) * 64 + 4 * kg), bv = *(const LAS f32x4*)(buf + (3 * SCS + s) * 64 + 4 * kg),
                                r = *(const LAS f32x4*)(buf + (4 * SCS + s) * 64 + 4 * kg);
                    const float v = vb[s * 16];
                    f32x2 p = s01 * (f32x2){kk[0], kk[1]} + s23 * (f32x2){kk[2], kk[3]};
                    const float sa = red16(p[0] + p[1]);
                    const f32x2 t01 = (f32x2){kd[0], kd[1]} * v - (f32x2){bv[0], bv[1]} * sa, t23 = (f32x2){kd[2], kd[3]} * v - (f32x2){bv[2], bv[3]} * sa;
                    s01 = s01 * (f32x2){w[0], w[1]} + t01; s23 = s23 * (f32x2){w[2], w[3]} + t23;
                    f32x2 q = s01 * (f32x2){r[0], r[1]} + s23 * (f32x2){r[2], r[3]};
                    const float y = red16(q[0] + q[1]);
                    if (kg == 0) yb[s * 16] = y;
                }
            }
            __syncthreads();
        }
        if (F.tid >= 256) scan_store_chunk(F, bufs + ((SNCH - 1) & 1) * SBUF_FLOATS, SNCH - 1, d, b, hd, rq);
    }
}
__device__ __forceinline__ void phase_readout(const Frame& F, const Args& A) {
    const int gw = blockIdx.x * NWAVES + F.wave, NGW = F.G * NWAVES; const int c0 = 16 * F.lane;
    float lng[16], lnb[16], rk[16]; ld16f(A.in[I_LNG] + c0, lng); ld16f(A.in[I_LNB] + c0, lnb); ld16f(A.in[I_RK] + c0, rk);
    for (int n = gw; n < NL; n += NGW) { const size_t off = (size_t)n * D + c0; float y[16], t[16], r[16], kd[16], v[16], g[16], o[16];
        ld16bf((const bf16_t*)(F.ws + WS_YD) + off, y); ld16bf((const bf16_t*)(F.ws + WS_YD + (size_t)NL * D * 2) + off, t);
        float s = 0.f;
#pragma unroll
        for (int j = 0; j < 16; ++j) { y[j] += t[j]; s += y[j]; }
        s += __shfl_xor(s, 1); s += __shfl_xor(s, 2); const float m = s * (1.0f / 64.0f); float q = 0.f;
#pragma unroll
        for (int j = 0; j < 16; ++j) { y[j] -= m; q += y[j] * y[j]; }
        q += __shfl_xor(q, 1); q += __shfl_xor(q, 2); const float rs = 1.0f / sqrtf(q * (1.0f / 64.0f) + GN_EPS);
        ld16bf((const bf16_t*)(F.ws + WS_RKV) + off, r); ld16bf((const bf16_t*)(F.ws + WS_KDIR) + off, kd); ld16bf((const bf16_t*)(F.ws + WS_KDIR + ACTB) + off, t);
        float bs = 0.f;
#pragma unroll
        for (int j = 0; j < 16; ++j) bs += r[j] * (kd[j] + t[j]) * rk[j];
        bs += __shfl_xor(bs, 1); bs += __shfl_xor(bs, 2);
        ld16bf((const bf16_t*)(F.ws + WS_RKV + 2 * ACTB) + off, v); ld16bf((const bf16_t*)(F.ws + WS_G) + off, g);
#pragma unroll
        for (int j = 0; j < 16; ++j) o[j] = (y[j] * rs * lng[j] + lnb[j] + bs * v[j]) * g[j];
        st16bf((bf16_t*)(F.ws + WS_RO) + off, o);
    }
}
struct SchedWo {
    const char* ws; int G, vcu; int nt; unsigned ldb;
    __device__ __forceinline__ bool next(int i, GU& u) const { const int L = i * G + vcu; if (L >= 512) return false; const int pm = L >> 2, pn = L & 3;
        u.a = ws + WS_RO + (size_t)pm * 256 * D * 2; u.b = ws + WS_WO + (size_t)pn * 256 * 1024 * 2; u.i0 = pm; u.i1 = pn; u.i2 = 0; u.i3 = 0; return true; }
    __device__ __forceinline__ void aoff(const GU&, const int (&R)[2], const int (&C)[2], unsigned (&v)[2][2]) const {
#pragma unroll
        for (int h = 0; h < 2; ++h)
#pragma unroll
            for (int i = 0; i < 2; ++i) v[h][i] = (unsigned)((h * 128 + R[i]) * D + C[i]) * 2u; }
};
struct EpiWo {
    static constexpr bool PERM = false;
    const float* xin; float* xout; const float* gate_base;
    __device__ __forceinline__ void operator()(const f32x4 (&acc)[2][2][4][2], const GU& u, int wr, int wc, int fr, int fq) const {
        const int pm = u.i0, pn = u.i1; const float* gate = gate_base + (size_t)(pm >> 6) * NMOD * D; const int col0 = pn * 256 + wc * 32 + 4 * fq;
        f32x4 gl[2][2];
#pragma unroll
        for (int bj = 0; bj < 2; ++bj)
#pragma unroll
            for (int n = 0; n < 2; ++n) gl[bj][n] = *(const GAS f32x4*)(gate + col0 + bj * 128 + n * 16);
#pragma unroll
        for (int ai = 0; ai < 2; ++ai)
#pragma unroll
            for (int m = 0; m < 4; ++m) { const size_t off = ((size_t)pm * 256 + ai * 128 + wr * 64 + m * 16 + fr) * D + col0;
#pragma unroll
                for (int bj = 0; bj < 2; ++bj)
#pragma unroll
                    for (int n = 0; n < 2; ++n) *(GAS f32x4*)(xout + off + bj * 128 + n * 16) = *(const GAS f32x4*)(xin + off + bj * 128 + n * 16) + gl[bj][n] * acc[ai][bj][m][n]; }
    }
};

constexpr int NPHASES = 3;
__global__ void __launch_bounds__(NTHREADS, 2) fwd_kernel(Args args) {
    extern __shared__ __attribute__((aligned(16))) unsigned char lds_raw[];
    Frame F;
    F.lds = (LAS unsigned char*)lds_raw; F.scr = F.lds + SCR_OFF; F.ws = args.ws;
    F.tid = threadIdx.x; F.lane = F.tid & 63; F.wave = __builtin_amdgcn_readfirstlane(F.tid >> 6);
    F.G = gridDim.x; { const int bx = blockIdx.x; F.vcu = (F.G % 8 == 0) ? (bx % 8) * (F.G / 8) + bx / 8 : bx; }
    volatile LAS unsigned* MISC = (volatile LAS unsigned*)(F.lds + MISC_OFF);
    if (F.tid < 64) MISC[F.tid] = 0u;
    __syncthreads();
    const int lo = args.ph_lo, hi = args.ph_hi;
    XcdBarrier bar; bar.bar = (unsigned*)(F.ws + WS_CTL); bar.x = 0; bar.st = MISC + 8;
    if (hi - lo > 1) bar = xcd_barrier_post((unsigned*)(F.ws + WS_CTL), MISC + 8);
#define IN(k) (lo <= (k) && (k) < hi)
#define SEAM(k) do { if (IN(k) && IN((k) + 1)) xcd_barrier(bar); } while (0)
    if (IN(0)) { phase_prep(F, args); } SEAM(0);
    if (IN(1)) { phase_pre0(F, args); } SEAM(1);
    if (IN(2)) { SchedPool S{(const char*)(F.ws + WS_DBUF), (const char*)(F.ws + WS_WPOOL), F.G, F.vcu, 4, 256u};
                 EpiPool E{args.in[I_X], args.in[I_CTX], args.in[I_POOLLS], modp(F, 0, 0, 2), (float*)(F.ws + WS_XS0)};
                 pg8::gemm_phase<EpiPool, SchedPool>(F.scr, S, E); } SEAM(2);
    if (IN(3)) { phase_post(F, args, 0, (const float*)(F.ws + WS_XS0), NTOK); } SEAM(3);
    if (IN(4)) { phase_moe1(F, args, 0); } SEAM(4);
    if (IN(5)) { phase_moe2(F, args, 0); } SEAM(5);
    if (IN(6)) { phase_pre1(F, args); } SEAM(6);
    if (IN(7)) { SchedProj S{(const char*)F.ws, F.G, F.vcu, 16, 1024u}; EpiProj E{F.ws}; pg8::gemm_phase<EpiProj, SchedProj>(F.scr, S, E); } SEAM(7);
    if (IN(8)) { SchedLora2 S{(const char*)F.ws, F.G, F.vcu, 2, 128u}; EpiLora2 E{F.ws, args.in[I_W0], args.in[I_A0]}; pg8::gemm_phase<EpiLora2, SchedLora2>(F.scr, S, E); } SEAM(8);
    if (IN(9)) { phase_fin(F, args); } SEAM(9);
    if (IN(10)) { phase_scan(F, args); } SEAM(10);
    if (IN(11)) { phase_readout(F, args); } SEAM(11);
    if (IN(12)) { SchedWo S{(const char*)F.ws, F.G, F.vcu, 16, 1024u}; EpiWo E{(const float*)(F.ws + WS_XS1), (float*)(F.ws + WS_XS0), modp(F, 1, 0, 2)}; pg8::gemm_phase<EpiWo, SchedWo>(F.scr, S, E); } SEAM(12);
    if (IN(13)) { phase_post(F, args, 1, (const float*)(F.ws + WS_XS0), NL); } SEAM(13);
    if (IN(14)) { phase_moe1(F, args, 1); } SEAM(14);
    if (IN(15)) { phase_moe2(F, args, 1); } SEAM(15);
    if (IN(16)) { phase_final(F, args, 1, (const float*)(F.ws + WS_XS0)); }
#undef IN
#undef SEAM
}

extern "C" void kernel_launch(void* const* d_in, const int* in_sizes, int n_in, void* d_out, int out_size, void* d_ws, size_t ws_size, hipStream_t stream) {
    static int grid = 0;
    if (grid == 0) {
        if (n_in != 32 || ws_size < WS_END) { fprintf(stderr, "kernel_launch: unexpected n_in %d / ws %zu (need %zu)\n", n_in, ws_size, (size_t)WS_END); grid = -1; return; }
        int dev = 0, cus = 0;
        if (hipGetDevice(&dev) != hipSuccess || hipDeviceGetAttribute(&cus, hipDeviceAttributeMultiprocessorCount, dev) != hipSuccess) { grid = -1; return; }
        if (hipFuncSetAttribute((const void*)fwd_kernel, hipFuncAttributeMaxDynamicSharedMemorySize, LDS_BYTES) != hipSuccess) { fprintf(stderr, "kernel_launch: hipFuncSetAttribute failed\n"); grid = -1; return; }
        (void)hipGetLastError();
        grid = cus;
    }
    if (grid < 0) return;
    (void)hipMemsetAsync((char*)d_ws + WS_CTL, 0, CTL_BYTES, stream);
    Args a{};
    for (int i = 0; i < 32; ++i) a.in[i] = (const float*)d_in[i];
    a.out = (float*)d_out; a.ws = (unsigned char*)d_ws;
    const int last = 16;
#if N_LAUNCH_MODE == 1
    a.ph_lo = 0; a.ph_hi = last + 1;
    hipLaunchKernelGGL(fwd_kernel, dim3(grid), dim3(NTHREADS), LDS_BYTES, stream, a);
#else
    for (int p = 0; p <= last; ++p) { a.ph_lo = p; a.ph_hi = p + 1; hipLaunchKernelGGL(fwd_kernel, dim3(grid), dim3(NTHREADS), LDS_BYTES, stream, a); }
#endif
}
```

```cpp
#include <hip/hip_runtime.h>
#include <cstdio>
#include <cstdint>

#define LAS __attribute__((address_space(3)))
#define GAS __attribute__((address_space(1)))
typedef unsigned short bf16_t;
typedef short bf16x8 __attribute__((ext_vector_type(8)));
typedef float f32x4 __attribute__((ext_vector_type(4)));
typedef float f32x2 __attribute__((ext_vector_type(2)));
typedef float f32x16 __attribute__((ext_vector_type(16)));
typedef unsigned u32x4 __attribute__((ext_vector_type(4)));
typedef unsigned u32x2 __attribute__((ext_vector_type(2)));

#ifndef N_LAUNCH_MODE
#define N_LAUNCH_MODE 1
#endif
#ifndef LAST_PHASE
#define LAST_PHASE 99
#endif

constexpr int D = 1024, NB = 2, TSEQ = 16384, CT = 256, NL = NB * TSEQ, NC = NB * CT, NTOK = NL + NC;
constexpr int NE = 32, TOPK = 4, NMOD = 6;
constexpr int NWAVES = 8, NTHREADS = 512;
constexpr int MAXSLOT = ((NTOK * TOPK + 255) / 256 + NE) * 256;
constexpr float NORM_EPS = 1e-6f, GN_EPS = 64e-5f;

constexpr size_t AL(size_t x) { return (x + 255) & ~(size_t)255; }
constexpr size_t WS_CTL = 0, CTL_BYTES = 32768;
constexpr size_t CTL_CNT = 16384;
constexpr size_t WS_MOD = WS_CTL + CTL_BYTES;
constexpr size_t WS_LIST = AL(WS_MOD + 2 * 3 * 6144 * 4);
constexpr size_t WS_TINFO = AL(WS_LIST + (size_t)2 * NE * NTOK * 4);
constexpr size_t WS_TGATE = AL(WS_TINFO + (size_t)2 * NTOK * 4 * 4);
constexpr size_t WS_WGU = AL(WS_TGATE + (size_t)2 * NTOK * 4 * 4);
constexpr size_t WS_WDN = AL(WS_WGU + (size_t)2 * NE * 2048 * 1024 * 2);
constexpr size_t WS_WRKV = AL(WS_WDN + (size_t)2 * NE * 1024 * 1024 * 2);
constexpr size_t WS_WO = AL(WS_WRKV + (size_t)3 * 1024 * 1024 * 2);
constexpr size_t WS_WL1 = AL(WS_WO + (size_t)1024 * 1024 * 2);
constexpr size_t WS_WL2 = AL(WS_WL1 + (size_t)3 * 256 * 1024 * 2);
constexpr size_t WS_WPOOL = AL(WS_WL2 + (size_t)5 * 1024 * 128 * 2);
constexpr size_t WS_XS0 = AL(WS_WPOOL + (size_t)4 * 256 * 256 * 2);
constexpr size_t WS_XS1 = AL(WS_XS0 + (size_t)NTOK * D * 4);
constexpr size_t WS_T = AL(WS_XS1 + (size_t)NTOK * D * 4);
constexpr size_t ACTB = (size_t)NTOK * D * 2;
constexpr size_t TA = WS_T;
constexpr size_t TA_BYTES = (size_t)432 << 20;
constexpr size_t WS_DBUF = TA, WS_H2 = TA + ACTB, WS_ACT = TA + 2 * ACTB;
constexpr size_t WS_MIX = TA;
constexpr size_t WS_KDIR = TA, WS_BV = TA + 2 * ACTB, WS_KK = TA + 4 * ACTB;
constexpr size_t TB = TA + TA_BYTES;
constexpr size_t TB_BYTES = (size_t)290 << 20;
constexpr size_t WS_Y2 = TB, WS_RKV = TB;
constexpr size_t TC = TB + TB_BYTES;
constexpr size_t WS_DEC = TC, WS_RO = TC;
constexpr size_t TD = AL(TC + (size_t)2 * NTOK * D * 4);
constexpr size_t WS_ICL = TD, WS_YD = TD;
constexpr size_t TE = AL(TD + 2 * ACTB);
constexpr size_t WS_G = TE;
constexpr size_t TF = AL(TE + ACTB);
constexpr size_t WS_LACT = TF;
constexpr size_t WS_END = AL(TF + (size_t)3 * NTOK * 128 * 2);
static_assert(WS_ACT + (size_t)MAXSLOT * D * 2 <= TA + TA_BYTES, "ACT overflows TA");
static_assert((size_t)MAXSLOT * D * 2 <= TB_BYTES, "Y2 overflows TB");
static_assert(WS_END <= ((size_t)2048 << 20), "workspace too large");

constexpr int MISC_OFF = 0, SCR_OFF = 1024, SCR_BYTES = 147456, LDS_BYTES = SCR_OFF + SCR_BYTES;

__device__ __forceinline__ unsigned cvt_pk_bf16(float lo, float hi) { unsigned r; asm volatile("v_cvt_pk_bf16_f32 %0, %1, %2" : "=v"(r) : "v"(lo), "v"(hi)); return r; }
__device__ __forceinline__ float bf_lo(unsigned w) { return __uint_as_float(w << 16); }
__device__ __forceinline__ float bf_hi(unsigned w) { return __uint_as_float(w & 0xffff0000u); }
__device__ __forceinline__ float bf2f(bf16_t b) { return __uint_as_float(((unsigned)b) << 16); }
__device__ __forceinline__ float wave_sum(float v) {
#pragma unroll
    for (int o = 1; o < 64; o <<= 1) v += __shfl_xor(v, o);
    return v;
}
__device__ __forceinline__ float sigmoidf_(float x) { return 1.0f / (1.0f + __expf(-x)); }
#define LDS_WAIT() asm volatile("s_waitcnt lgkmcnt(0)" ::: "memory")
#define VM_WAIT() asm volatile("s_waitcnt vmcnt(0)" ::: "memory")

#define XB_TMO      128
#define XB_XCNT(j)  (256  + 64 * (j))
#define XB_XSUB(j)  (1280 + 64 * (j))
#define XB_XGEN(j)  (2304 + 64 * (j))
#define XB_TOP      3328
#define XB_TOPGEN   3392
#define XCD_BAR_WORDS 3456
#define XB_SPIN_CAP (1u << 22)
__device__ __forceinline__ unsigned xb_ld(unsigned* p)              { return __hip_atomic_load(p, __ATOMIC_RELAXED, __HIP_MEMORY_SCOPE_AGENT); }
__device__ __forceinline__ unsigned xb_add(unsigned* p, unsigned v) { return __hip_atomic_fetch_add(p, v, __ATOMIC_RELAXED, __HIP_MEMORY_SCOPE_AGENT); }
__device__ __forceinline__ unsigned xb_xcc_id() { return (unsigned)__builtin_amdgcn_s_getreg((3 << 11) | 20) & 0xFu; }
#define XB_SPIN(cond, bar) do { unsigned _sp = 0; while (cond) { __builtin_amdgcn_s_sleep(1); \
    if ((++_sp & 255u) == 0u) { if (xb_ld(&(bar)[XB_TMO])) break; if (_sp > XB_SPIN_CAP) { atomicAdd(&(bar)[XB_TMO], 1u); break; } } } } while (0)
struct XcdBarrier { unsigned* bar; unsigned x; volatile LAS unsigned* st; };
__device__ __forceinline__ XcdBarrier xcd_barrier_post(unsigned* bar, volatile LAS unsigned* st) {
    XcdBarrier b; b.bar = bar; b.x = xb_xcc_id(); b.st = st;
    if (threadIdx.x == 0) (void)xb_add(&bar[XB_XCNT(b.x)], 1u);
    return b;
}
__device__ __forceinline__ void xcd_barrier_complete(unsigned* bar, unsigned x, unsigned& nloc, unsigned& nx) {
    const unsigned G = gridDim.x * gridDim.y * gridDim.z;
    unsigned sum, cnt, mine, sp = 0u;
    for (;;) {
        sum = 0u; cnt = 0u; mine = 0u;
#pragma unroll
        for (unsigned j = 0; j < 16; ++j) { const unsigned c = xb_ld(&bar[XB_XCNT(j)]); sum += c; cnt += (c > 0u) ? 1u : 0u; mine = (j == x) ? c : mine; }
        if (sum == G) break;
        __builtin_amdgcn_s_sleep(1);
        if ((++sp & 255u) == 0u) { if (xb_ld(&bar[XB_TMO])) break; if (sp > XB_SPIN_CAP) { atomicAdd(&bar[XB_TMO], 1u); break; } }
    }
    nloc = mine > 0u ? mine : 1u; nx = cnt > 0u ? cnt : 1u;
}
__device__ __forceinline__ void xcd_barrier(const XcdBarrier& b) {
    asm volatile("s_waitcnt vmcnt(0)" ::: "memory");
    __syncthreads();
    if (threadIdx.x == 0) {
        unsigned* bar = b.bar;
        __builtin_amdgcn_s_waitcnt(0);
        unsigned nloc = b.st[0], nx = b.st[1];
        if (nloc == 0u) { xcd_barrier_complete(bar, b.x, nloc, nx); b.st[0] = nloc; b.st[1] = nx; }
        const unsigned old = xb_add(&bar[XB_XSUB(b.x)], 1u);
        const unsigned gen = old / nloc;
        if (old + 1u == (gen + 1u) * nloc) {
            __builtin_amdgcn_fence(__ATOMIC_RELEASE, "agent");
            asm volatile("s_waitcnt vmcnt(0)" ::: "memory");
            const unsigned og = xb_add(&bar[XB_TOP], 1u);
            const unsigned tg = og / nx;
            if (og + 1u == (tg + 1u) * nx) xb_add(&bar[XB_TOPGEN], 1u);
            else XB_SPIN(xb_ld(&bar[XB_TOPGEN]) == tg, bar);
            __builtin_amdgcn_fence(__ATOMIC_ACQUIRE, "agent");
            xb_add(&bar[XB_XGEN(b.x)], 1u);
            asm volatile("s_waitcnt vmcnt(0)" ::: "memory");
        } else {
            XB_SPIN(xb_ld(&bar[XB_XGEN(b.x)]) == gen, bar);
            __builtin_amdgcn_fence(__ATOMIC_ACQUIRE, "agent");
            asm volatile("s_waitcnt vmcnt(0)" ::: "memory");
        }
    }
    __syncthreads();
}

namespace pg8 {
constexpr int BM = 256, BK = 64, HALF = 128, HTB = HALF * BK * 2, STAGE_BYTES = 8 * HTB;
__host__ __device__ __forceinline__ int lds_byte(int r, int c) { const int st = (r >> 4) * 2 + (c >> 5), rr = r & 15, cc = c & 31, ob = rr * 64 + cc * 2; return st * 1024 + (ob ^ (((ob >> 9) & 1) << 5)); }
__host__ __device__ __forceinline__ void stage_rc(int b, int& R, int& C) { const int st = b / 1024, sb = b % 1024, swz = sb ^ (((sb >> 9) & 1) << 5); R = (st >> 1) * 16 + swz / 64; C = (st & 1) * 32 + (swz % 64) / 2; }
__host__ __device__ __forceinline__ int perm32(int rho) { const int n = rho >> 4, i = rho & 15; return 8 * (i >> 2) + 4 * n + (i & 3); }

struct GU { const char* a; const char* b; int i0, i1, i2, i3; };

template <class Epi, class Sched>
__device__ __forceinline__ void gemm_phase(LAS unsigned char* lds, const Sched& S, const Epi& E) {
    const int tid = threadIdx.x, wid = __builtin_amdgcn_readfirstlane(tid >> 6), lane = tid & 63, wr = wid >> 2, wc = wid & 3, fr = lane & 15, fq = lane >> 4;
    const int nt = S.nt;
    int Rr[2], Cc[2]; unsigned voffB[2];
#pragma unroll
    for (int i = 0; i < 2; ++i) { int R, C; stage_rc(tid * 16 + i * 8192, R, C); Rr[i] = R; Cc[i] = C; const int Rb = Epi::PERM ? ((R & ~31) + perm32(R & 31)) : R;
        voffB[i] = (unsigned)(Rb * S.ldb + C) * 2u; }
    const size_t kstep = (size_t)(BK * 2);
    const size_t hstepB = (size_t)HALF * S.ldb * 2;
    const unsigned ldsw = (unsigned)wid * 1024u;
    const int aoff = lds_byte(wr * 64 + fr, fq * 8), boff = lds_byte(wc * 32 + fr, fq * 8);
#define PG8_SA(b, h) (((b) * 2 + (h)) * HTB)
#define PG8_SB(b, h) ((4 + (b) * 2 + (h)) * HTB)
#define PG8_STAGE(bufoff, gbase, voff) do { _Pragma("unroll") for (int _i = 0; _i < 2; ++_i) \
        __builtin_amdgcn_global_load_lds((const unsigned*)((const char*)(gbase) + (voff)[_i]), (LAS unsigned*)(lds + (bufoff) + ldsw + _i * 8192), 16, 0, 0); } while (0)
#define PG8_LDA(dst, b, h) do { _Pragma("unroll") for (int m = 0; m < 4; ++m) _Pragma("unroll") for (int k = 0; k < 2; ++k) dst[m][k] = *(const LAS bf16x8*)(lds + PG8_SA(b, h) + aoff + m * 2048 + k * 1024); } while (0)
#define PG8_LDB(dst, b, h) do { _Pragma("unroll") for (int n = 0; n < 2; ++n) _Pragma("unroll") for (int k = 0; k < 2; ++k) dst[n][k] = *(const LAS bf16x8*)(lds + PG8_SB(b, h) + boff + n * 2048 + k * 1024); } while (0)
#define PG8_MMA(ai, bj, At, Bt) do { __builtin_amdgcn_s_setprio(1); _Pragma("unroll") for (int m = 0; m < 4; ++m) _Pragma("unroll") for (int n = 0; n < 2; ++n) _Pragma("unroll") for (int k = 0; k < 2; ++k) \
        acc[ai][bj][m][n] = __builtin_amdgcn_mfma_f32_16x16x32_bf16(Bt[n][k], At[m][k], acc[ai][bj][m][n], 0, 0, 0); __builtin_amdgcn_s_setprio(0); } while (0)
#define PG8_WAIT_V(n) asm volatile("s_waitcnt vmcnt(" #n ")" ::: "memory")
#define PG8_WAIT_L(n) asm volatile("s_waitcnt lgkmcnt(" #n ")" ::: "memory")
#define PG8_BAR __builtin_amdgcn_s_barrier()
#define PG8_SCHED __builtin_amdgcn_sched_barrier(0)
    GU cur, nxt; int ui = 0;
    if (!S.next(0, cur)) return;
    f32x4 acc[2][2][4][2];
#pragma unroll
    for (int a = 0; a < 2; ++a)
#pragma unroll
        for (int b = 0; b < 2; ++b)
#pragma unroll
            for (int m = 0; m < 4; ++m)
#pragma unroll
                for (int n = 0; n < 2; ++n) acc[a][b][m][n] = (f32x4){0.f, 0.f, 0.f, 0.f};
    bf16x8 At[4][2], B0[2][2], B1[2][2];
    unsigned vA[2][2], nvA[2][2];
    S.aoff(cur, Rr, Cc, vA);
    const char* cA = cur.a; const char* cB = cur.b;
    PG8_STAGE(PG8_SB(0, 0), cB, voffB); PG8_STAGE(PG8_SB(0, 1), cB + hstepB, voffB); PG8_STAGE(PG8_SA(0, 0), cA, vA[0]); PG8_STAGE(PG8_SA(0, 1), cA, vA[1]);
    if (wr == 1) PG8_BAR;
    PG8_WAIT_V(2); PG8_BAR;
    PG8_STAGE(PG8_SB(1, 0), cB + kstep, voffB); PG8_STAGE(PG8_SA(1, 0), cA + kstep, vA[0]); PG8_STAGE(PG8_SB(1, 1), cB + hstepB + kstep, voffB);
    PG8_WAIT_V(6); PG8_BAR;
    for (;;) {
        const bool has_next = S.next(ui + 1, nxt);
        const char* nA = has_next ? nxt.a : cA; const char* nB = has_next ? nxt.b : cB;
        if (has_next) S.aoff(nxt, Rr, Cc, nvA);
        else { nvA[0][0] = vA[0][0]; nvA[0][1] = vA[0][1]; nvA[1][0] = vA[1][0]; nvA[1][1] = vA[1][1]; }
#pragma unroll 1
        for (int t = 0; t < nt; t += 2) {
            const bool last = (t == nt - 2);
            const char* a1 = cA + (size_t)(t + 1) * kstep;
            const char* a2 = last ? nA : cA + (size_t)(t + 2) * kstep; const char* b2 = last ? nB : cB + (size_t)(t + 2) * kstep;
            const char* a3 = a2 + kstep; const char* b3 = b2 + kstep;
            unsigned w0[2], w1[2];
            w0[0] = last ? nvA[0][0] : vA[0][0]; w0[1] = last ? nvA[0][1] : vA[0][1]; w1[0] = last ? nvA[1][0] : vA[1][0]; w1[1] = last ? nvA[1][1] : vA[1][1];
            PG8_LDB(B0, 0, 0); PG8_LDB(B1, 0, 1); PG8_SCHED; PG8_LDA(At, 0, 0); PG8_STAGE(PG8_SA(1, 1), a1, vA[1]);
            PG8_WAIT_V(8); PG8_WAIT_L(0); PG8_BAR; PG8_MMA(0, 0, At, B0); PG8_MMA(0, 1, At, B1); PG8_BAR; PG8_SCHED;
            PG8_LDA(At, 0, 1); PG8_STAGE(PG8_SB(0, 0), b2, voffB); PG8_STAGE(PG8_SB(0, 1), b2 + hstepB, voffB); PG8_STAGE(PG8_SA(0, 0), a2, w0);
            PG8_WAIT_V(8); PG8_WAIT_L(0); PG8_BAR; PG8_MMA(1, 0, At, B0); PG8_MMA(1, 1, At, B1); PG8_BAR; PG8_SCHED;
            PG8_LDB(B0, 1, 0); PG8_LDB(B1, 1, 1); PG8_SCHED; PG8_LDA(At, 1, 0); PG8_STAGE(PG8_SA(0, 1), a2, w1);
            PG8_WAIT_V(8); PG8_WAIT_L(0); PG8_BAR; PG8_MMA(0, 0, At, B0); PG8_MMA(0, 1, At, B1); PG8_BAR; PG8_SCHED;
            PG8_LDA(At, 1, 1); PG8_STAGE(PG8_SB(1, 0), b3, voffB); PG8_STAGE(PG8_SB(1, 1), b3 + hstepB, voffB); PG8_STAGE(PG8_SA(1, 0), a3, w0);
            PG8_WAIT_V(8); PG8_WAIT_L(0); PG8_BAR; PG8_MMA(1, 0, At, B0); PG8_MMA(1, 1, At, B1); PG8_BAR; PG8_SCHED;
        }
        if (wr == 0) PG8_BAR;
        E(acc, cur, wr, wc, fr, fq);
        if (!has_next) break;
#pragma unroll
        for (int a = 0; a < 2; ++a)
#pragma unroll
            for (int b = 0; b < 2; ++b)
#pragma unroll
                for (int m = 0; m < 4; ++m)
#pragma unroll
                    for (int n = 0; n < 2; ++n) acc[a][b][m][n] = (f32x4){0.f, 0.f, 0.f, 0.f};
        cur = nxt; cA = nA; cB = nB; ++ui;
        vA[0][0] = nvA[0][0]; vA[0][1] = nvA[0][1]; vA[1][0] = nvA[1][0]; vA[1][1] = nvA[1][1];
        if (wr == 1) PG8_BAR;
    }
    PG8_WAIT_V(0);
    PG8_BAR;
#undef PG8_SA
#undef PG8_SB
#undef PG8_STAGE
#undef PG8_LDA
#undef PG8_LDB
#undef PG8_MMA
#undef PG8_WAIT_V
#undef PG8_WAIT_L
#undef PG8_BAR
#undef PG8_SCHED
}
}
using pg8::GU;

struct Args { const float* in[32]; float* out; unsigned char* ws; int ph_lo, ph_hi; };
struct Frame {
    LAS unsigned char* lds;
    LAS unsigned char* scr;
    unsigned char* ws;
    int tid, lane, wave, G, vcu;
};
enum { I_X = 0, I_C, I_CTX, I_CCTX, I_NORMG, I_ADAW, I_ADAB, I_POOLW, I_POOLLS, I_MU, I_WRKV, I_W0, I_W1, I_W2, I_A0, I_A1, I_A2, I_G1, I_G2, I_KK, I_KA, I_RK, I_LNG, I_LNB, I_WO,
       I_RW, I_RB, I_WGU, I_BGU, I_WDN, I_BDN, I_FINALG };

__device__ __forceinline__ const float* modp(const Frame& F, int layer, int row, int k) { return (const float*)(F.ws + WS_MOD) + ((size_t)(layer * 3 + row) * NMOD + k) * D; }
__device__ __forceinline__ int mrow_of(int n) { return n < NL ? (n >> 14) : 2; }

__device__ __forceinline__ void transpose_tile(const float* W, int ldw, int k0, int n0, bf16_t* WT, size_t dst_row0, int ldk, int kdst0, LAS float* scr, int lane) {
    const int c4 = lane & 15, kr = lane >> 4;
#pragma unroll 4
    for (int it = 0; it < 16; ++it) { const int kk = 4 * it + kr; const f32x4 v = *(const GAS f32x4*)(W + (size_t)(k0 + kk) * ldw + n0 + 4 * c4);
        LAS float* s = scr + kk * 65 + 4 * c4; s[0] = v[0]; s[1] = v[1]; s[2] = v[2]; s[3] = v[3]; }
    LDS_WAIT(); asm volatile("" ::: "memory");
    const int c = lane & 7;
#pragma unroll
    for (int j = 0; j < 8; ++j) { const int n = (lane >> 3) + 8 * j; const LAS float* s = scr + (8 * c) * 65 + n;
        u32x4 o; o.x = cvt_pk_bf16(s[0 * 65], s[1 * 65]); o.y = cvt_pk_bf16(s[2 * 65], s[3 * 65]); o.z = cvt_pk_bf16(s[4 * 65], s[5 * 65]); o.w = cvt_pk_bf16(s[6 * 65], s[7 * 65]);
        *(GAS u32x4*)(WT + (dst_row0 + n) * (size_t)ldk + kdst0 + k0 + 8 * c) = o; }
    LDS_WAIT(); asm volatile("" ::: "memory");
}

__device__ __forceinline__ void phase_prep(const Frame& F, const Args& A) {
    unsigned char* ws = F.ws;
    if (blockIdx.x < 192) {
        const int l = blockIdx.x / 96, cc = blockIdx.x % 96, c4 = F.tid & 15, kq = F.tid >> 4;
        const float* w = A.in[I_ADAW] + (size_t)l * D * (NMOD * D) + cc * 64 + 4 * c4;
        f32x4 a0 = {0, 0, 0, 0}, a1 = {0, 0, 0, 0}, a2 = {0, 0, 0, 0};
        for (int i = 0; i < 32; ++i) { const int k = kq + 32 * i;
            const f32x4 wv = *(const GAS f32x4*)(w + (size_t)k * (NMOD * D));
            float c0 = A.in[I_C][k], c1 = A.in[I_C][D + k], c2 = A.in[I_CCTX][k];
            c0 = c0 * sigmoidf_(c0); c1 = c1 * sigmoidf_(c1); c2 = c2 * sigmoidf_(c2);
            a0 += wv * c0; a1 += wv * c1; a2 += wv * c2; }
        LAS f32x4* red = (LAS f32x4*)F.scr;
        red[(kq * 3 + 0) * 16 + c4] = a0; red[(kq * 3 + 1) * 16 + c4] = a1; red[(kq * 3 + 2) * 16 + c4] = a2;
        __syncthreads();
        if (F.tid < 192) { const int r = F.tid / 64, c = F.tid % 64; float s = 0.f;
            for (int q = 0; q < 32; ++q) s += ((LAS float*)F.scr)[((q * 3 + r) * 16) * 4 + c];
            const int col = cc * 64 + c;
            ((float*)(ws + WS_MOD))[(size_t)(l * 3 + r) * (NMOD * D) + col] = s + A.in[I_ADAB][(size_t)l * NMOD * D + col]; }
        __syncthreads();
    }
    { bf16_t* w2p = (bf16_t*)(ws + WS_WL2);
      for (int i = blockIdx.x * NTHREADS + F.tid; i < 4 * 1024 * 8; i += F.G * NTHREADS) { const int o = i / 8192, c = (i / 8) % 1024, q = i % 8, d = o & 1;
          *(GAS u32x4*)(w2p + ((size_t)o * 1024 + c) * 128 + (1 - d) * 64 + q * 8) = (u32x4){0u, 0u, 0u, 0u}; } }
    LAS float* scr = (LAS float*)(F.scr) + F.wave * (64 * 65 + 63);
    const int gw = F.vcu * NWAVES + F.wave, NGW = F.G * NWAVES;
    constexpr int T_GU = 2 * NE * 16 * 32, T_DN = 2 * NE * 16 * 16, T_RKV = 3 * 256, T_WO = 256, T_L1 = 2 * 16 + 2 * 16 + 32, T_L2 = 2 * 16 + 2 * 16 + 2 * 16, T_PW = 4 * 16;
    constexpr int T_ALL = T_GU + T_DN + T_RKV + T_WO + T_L1 + T_L2 + T_PW;
    for (int it = gw; it < T_ALL; it += NGW) {
        int r = it;
        if (r < T_GU) { const int le = r / 512, q = r % 512, kb = q / 32, nb = q % 32; const int n0 = nb * 64;
            const int drow = (n0 < 1024) ? ((n0 >> 7) * 256 + (n0 & 127)) : (((n0 - 1024) >> 7) * 256 + 128 + ((n0 - 1024) & 127));
            transpose_tile(A.in[I_WGU] + (size_t)le * 1024 * 2048, 2048, kb * 64, n0, (bf16_t*)(ws + WS_WGU), (size_t)le * 2048 + drow, 1024, 0, scr, F.lane); continue; } r -= T_GU;
        if (r < T_DN) { const int le = r / 256, q = r % 256, kb = q / 16, nb = q % 16;
            transpose_tile(A.in[I_WDN] + (size_t)le * 1024 * 1024, 1024, kb * 64, nb * 64, (bf16_t*)(ws + WS_WDN), (size_t)le * 1024 + nb * 64, 1024, 0, scr, F.lane); continue; } r -= T_DN;
        if (r < T_RKV) { const int p = r / 256, q = r % 256, kb = q / 16, nb = q % 16;
            transpose_tile(A.in[I_WRKV] + (size_t)p * 1024 * 1024, 1024, kb * 64, nb * 64, (bf16_t*)(ws + WS_WRKV), (size_t)p * 1024 + nb * 64, 1024, 0, scr, F.lane); continue; } r -= T_RKV;
        if (r < T_WO) { const int kb = r / 16, nb = r % 16;
            transpose_tile(A.in[I_WO], 1024, kb * 64, nb * 64, (bf16_t*)(ws + WS_WO), (size_t)nb * 64, 1024, 0, scr, F.lane); continue; } r -= T_WO;
        if (r < T_L1) {
            if (r < 32) { const int d = r / 16, kb = r % 16; transpose_tile(A.in[I_W1] + (size_t)d * 1024 * 64, 64, kb * 64, 0, (bf16_t*)(ws + WS_WL1), (size_t)0 * 256 + d * 64, 1024, 0, scr, F.lane); continue; }
            r -= 32;
            if (r < 32) { const int d = r / 16, kb = r % 16; transpose_tile(A.in[I_A1] + (size_t)d * 1024 * 64, 64, kb * 64, 0, (bf16_t*)(ws + WS_WL1), (size_t)1 * 256 + d * 64, 1024, 0, scr, F.lane); continue; }
            r -= 32;
            { const int kb = r / 2, nb = r % 2; transpose_tile(A.in[I_G1], 128, kb * 64, nb * 64, (bf16_t*)(ws + WS_WL1), (size_t)2 * 256 + nb * 64, 1024, 0, scr, F.lane); continue; }
        } r -= T_L1;
        if (r < T_L2) {
            if (r < 32) { const int d = r / 16, nb = r % 16; transpose_tile(A.in[I_W2] + (size_t)d * 64 * 1024, 1024, 0, nb * 64, (bf16_t*)(ws + WS_WL2), (size_t)d * 1024 + nb * 64, 128, d * 64, scr, F.lane); continue; }
            r -= 32;
            if (r < 32) { const int d = r / 16, nb = r % 16; transpose_tile(A.in[I_A2] + (size_t)d * 64 * 1024, 1024, 0, nb * 64, (bf16_t*)(ws + WS_WL2), (size_t)(2 + d) * 1024 + nb * 64, 128, d * 64, scr, F.lane); continue; }
            r -= 32;
            { const int kb = r / 16, nb = r % 16; transpose_tile(A.in[I_G2], 1024, kb * 64, nb * 64, (bf16_t*)(ws + WS_WL2), (size_t)4 * 1024 + nb * 64, 128, 0, scr, F.lane); continue; }
        } r -= T_L2;
        { const int g = r / 16, q = r % 16, kb = q / 4, nb = q % 4;
          transpose_tile(A.in[I_POOLW] + (size_t)g * 256 * 256, 256, kb * 64, nb * 64, (bf16_t*)(ws + WS_WPOOL), (size_t)g * 256 + nb * 64, 256, 0, scr, F.lane); }
    }
}

__device__ __forceinline__ void phase_pre0(const Frame& F, const Args& A) {
    LAS float* hb = (LAS float*)F.scr;
    LAS float* rs = hb + 80 * 258;
    LAS float* gsc = rs + 80;
    LAS float* gsh = gsc + 256;
    bf16_t* dbuf = (bf16_t*)(F.ws + WS_DBUF);
    const float* ng = A.in[I_NORMG];
    for (int u = blockIdx.x; u < 520; u += F.G) {
        int tok0, nown = 64, hl = 0, hr = 0, L, pos0, row; const float* xsrc;
        if (u < 512) { tok0 = u * 64; L = 64; pos0 = 0; row = tok0 >> 14; xsrc = A.in[I_X] + (size_t)tok0 * D; }
        else { const int b = (u - 512) >> 2, q = (u - 512) & 3; tok0 = NL + b * CT + q * 64; L = CT; pos0 = q * 64; hl = q > 0 ? 8 : 0; hr = q < 3 ? 8 : 0; row = 2;
               xsrc = A.in[I_CTX] + (size_t)(b * CT + q * 64) * D; }
        const int nt = nown + hl + hr;
        for (int j = F.wave; j < nt; j += NWAVES) { const float* xr = xsrc + (ptrdiff_t)(j - hl) * D; float s = 0.f;
#pragma unroll
            for (int q = 0; q < 4; ++q) { const f32x4 v = *(const GAS f32x4*)(xr + 4 * F.lane + 256 * q); s += v[0] * v[0] + v[1] * v[1] + v[2] * v[2] + v[3] * v[3]; }
            s = wave_sum(s); if (F.lane == 0) rs[j] = 1.0f / sqrtf(s * (1.0f / D) + NORM_EPS); }
        for (int g = 0; g < 4; ++g) {
            __syncthreads();
            if (F.tid < 256) { const int c = g * 256 + F.tid; gsc[F.tid] = ng[c] * (1.0f + modp(F, 0, row, 1)[c]); gsh[F.tid] = modp(F, 0, row, 0)[c]; }
            __syncthreads();
            for (int i = F.tid; i < nt * 64; i += NTHREADS) { const int j = i >> 6, c4 = i & 63; const f32x4 v = *(const GAS f32x4*)(xsrc + (ptrdiff_t)(j - hl) * D + g * 256 + 4 * c4);
                const float r = rs[j]; LAS float* h = hb + j * 258 + 4 * c4;
                h[0] = v[0] * r * gsc[4 * c4 + 0] + gsh[4 * c4 + 0]; h[1] = v[1] * r * gsc[4 * c4 + 1] + gsh[4 * c4 + 1];
                h[2] = v[2] * r * gsc[4 * c4 + 2] + gsh[4 * c4 + 2]; h[3] = v[3] * r * gsc[4 * c4 + 3] + gsh[4 * c4 + 3]; }
            __syncthreads();
            const int win = 2 << g, hw = win >> 1;
            for (int i = F.tid; i < 64 * 128; i += NTHREADS) { const int cp = i & 127, t = i >> 7; const int p = pos0 + t;
                int lo = p - hw, hi = p + hw - 1; lo = lo < 0 ? 0 : lo; hi = hi > L - 1 ? L - 1 : hi;
                const int jlo = lo - (pos0 - hl), jhi = hi - (pos0 - hl);
                float s0 = 0.f, s1 = 0.f;
                for (int j = jlo; j <= jhi; ++j) { const f32x2 v = *(const LAS f32x2*)(hb + j * 258 + 2 * cp); s0 += v[0]; s1 += v[1]; }
                const float ic = 1.0f / (float)(hi - lo + 1); const f32x2 hv = *(const LAS f32x2*)(hb + (t + hl) * 258 + 2 * cp);
                *(GAS unsigned*)(dbuf + (size_t)(tok0 + t) * D + g * 256 + 2 * cp) = cvt_pk_bf16(s0 * ic - hv[0], s1 * ic - hv[1]); }
        }
        __syncthreads();
    }
}

struct SchedPool {
    const char* dbuf; const char* wpool; int G, vcu; int nt; unsigned ldb;
    __device__ __forceinline__ bool next(int i, GU& u) const { const int L = i * G + vcu; if (L >= 130 * 4) return false; const int pm = L >> 2, g = L & 3;
        u.a = dbuf + ((size_t)pm * 256 * D + g * 256) * 2; u.b = wpool + (size_t)g * 256 * 256 * 2; u.i0 = pm; u.i1 = g; u.i2 = 0; u.i3 = 0; return true; }
    __device__ __forceinline__ void aoff(const GU&, const int (&R)[2], const int (&C)[2], unsigned (&v)[2][2]) const {
#pragma unroll
        for (int h = 0; h < 2; ++h)
#pragma unroll
            for (int i = 0; i < 2; ++i) v[h][i] = (unsigned)((h * 128 + R[i]) * D + C[i]) * 2u; }
};
struct EpiPool {
    static constexpr bool PERM = false;
    const float* x; const float* ctx; const float* ls; const float* gate_base; float* xs;
    __device__ __forceinline__ void operator()(const f32x4 (&acc)[2][2][4][2], const GU& u, int wr, int wc, int fr, int fq) const {
        const int pm = u.i0, g = u.i1; const int mrow = pm < 128 ? (pm >> 6) : 2;
        const float* gate = gate_base + (size_t)mrow * NMOD * D;
        const float* src = pm < 128 ? x + (size_t)pm * 256 * D : ctx + (size_t)(pm - 128) * 256 * D;
        const int col0 = g * 256 + wc * 32 + 4 * fq;
        f32x4 gl[2][2];
#pragma unroll
        for (int bj = 0; bj < 2; ++bj)
#pragma unroll
            for (int n = 0; n < 2; ++n) { const int c = col0 + bj * 128 + n * 16; gl[bj][n] = *(const GAS f32x4*)(gate + c) * *(const GAS f32x4*)(ls + c); }
#pragma unroll
        for (int ai = 0; ai < 2; ++ai)
#pragma unroll
            for (int m = 0; m < 4; ++m) { const int r = ai * 128 + wr * 64 + m * 16 + fr; const float* sp = src + (size_t)r * D + col0; float* op = xs + ((size_t)pm * 256 + r) * D + col0;
#pragma unroll
                for (int bj = 0; bj < 2; ++bj)
#pragma unroll
                    for (int n = 0; n < 2; ++n) *(GAS f32x4*)(op + bj * 128 + n * 16) = *(const GAS f32x4*)(sp + bj * 128 + n * 16) + gl[bj][n] * acc[ai][bj][m][n]; }
    }
};

__device__ __forceinline__ void phase_final_plain(const Frame& F, const Args& A, const float* xs) {
    const int gw = blockIdx.x * NWAVES + F.wave, NGW = F.G * NWAVES;
    for (int n = gw; n < NL; n += NGW) { const float* xr = xs + (size_t)n * D; f32x4 v[4]; float s = 0.f;
#pragma unroll
        for (int q = 0; q < 4; ++q) { v[q] = *(const GAS f32x4*)(xr + 4 * F.lane + 256 * q); s += v[q][0] * v[q][0] + v[q][1] * v[q][1] + v[q][2] * v[q][2] + v[q][3] * v[q][3]; }
        s = wave_sum(s); const float r = 1.0f / sqrtf(s * (1.0f / D) + NORM_EPS);
#pragma unroll
        for (int q = 0; q < 4; ++q) { const f32x4 g = *(const GAS f32x4*)(A.in[I_FINALG] + 4 * F.lane + 256 * q); *(GAS f32x4*)(A.out + (size_t)n * D + 4 * F.lane + 256 * q) = v[q] * r * g; }
    }
}


__device__ __forceinline__ int* cnt_word(const Frame& F, int l, int e) { return (int*)(F.ws + WS_CTL + CTL_CNT) + (l * NE + e) * 64; }
__device__ __forceinline__ void phase_post(const Frame& F, const Args& A, int l, const float* xs, int ntok) {
    LAS float* h2s = (LAS float*)F.scr;
    LAS float* part = (LAS float*)F.scr;
    LAS float* lgs = (LAS float*)(F.scr + 32 * 1028 * 4);
    LAS int* hist = (LAS int*)(lgs + 32 * 33);
    LAS int* base = hist + 32;
    LAS int* sel = base + 32;
    LAS int* lrank = sel + 128;
    bf16_t* H2 = (bf16_t*)(F.ws + WS_H2);
    int* list = (int*)(F.ws + WS_LIST) + (size_t)l * NE * NTOK;
    int* tinfo = (int*)(F.ws + WS_TINFO) + (size_t)l * NTOK * 4;
    float* tgate = (float*)(F.ws + WS_TGATE) + (size_t)l * NTOK * 4;
    const float* ng = A.in[I_NORMG] + (size_t)(l * 2 + 1) * D;
    const float* rw = A.in[I_RW] + (size_t)l * D * NE;
    const float* rb = A.in[I_RB] + (size_t)l * NE;
    const int ntiles = ntok / 32;
    for (int tile = blockIdx.x; tile < ntiles; tile += F.G) {
        const int n0 = tile * 32, mrow = mrow_of(n0);
        const float* sc = modp(F, l, mrow, 4); const float* sh = modp(F, l, mrow, 3);
        if (F.tid < 32) hist[F.tid] = 0;
#pragma unroll 1
        for (int q = 0; q < 4; ++q) { const int tt = F.wave * 4 + q, n = n0 + tt; const float* xr = xs + (size_t)n * D; f32x4 v[4]; float s = 0.f;
#pragma unroll
            for (int jj = 0; jj < 4; ++jj) { v[jj] = *(const GAS f32x4*)(xr + 4 * F.lane + 256 * jj); s += v[jj][0] * v[jj][0] + v[jj][1] * v[jj][1] + v[jj][2] * v[jj][2] + v[jj][3] * v[jj][3]; }
            s = wave_sum(s); const float r = 1.0f / sqrtf(s * (1.0f / D) + NORM_EPS);
#pragma unroll
            for (int jj = 0; jj < 4; ++jj) { const int c = 4 * F.lane + 256 * jj; const f32x4 g = *(const GAS f32x4*)(ng + c), a = *(const GAS f32x4*)(sc + c), b = *(const GAS f32x4*)(sh + c);
                const f32x4 h = v[jj] * r * g * (a + 1.0f) + b;
                *(LAS f32x4*)(h2s + tt * 1028 + c) = h;
                u32x2 w; w.x = cvt_pk_bf16(h[0], h[1]); w.y = cvt_pk_bf16(h[2], h[3]); *(GAS u32x2*)(H2 + (size_t)n * D + c) = w; } }
        __syncthreads();
        f32x16 acc;
#pragma unroll
        for (int i = 0; i < 16; ++i) acc[i] = 0.f;
        { const int r = F.lane & 31, h = F.lane >> 5;
#pragma unroll 4
          for (int q = 0; q < 16; ++q) { const int kb = 128 * F.wave + 8 * q + 4 * h; const f32x4 a = *(const LAS f32x4*)(h2s + r * 1028 + kb);
              const float b0 = rw[(size_t)(kb + 0) * NE + r], b1 = rw[(size_t)(kb + 1) * NE + r], b2 = rw[(size_t)(kb + 2) * NE + r], b3 = rw[(size_t)(kb + 3) * NE + r];
              acc = __builtin_amdgcn_mfma_f32_32x32x2f32(a[0], b0, acc, 0, 0, 0); acc = __builtin_amdgcn_mfma_f32_32x32x2f32(a[1], b1, acc, 0, 0, 0);
              acc = __builtin_amdgcn_mfma_f32_32x32x2f32(a[2], b2, acc, 0, 0, 0); acc = __builtin_amdgcn_mfma_f32_32x32x2f32(a[3], b3, acc, 0, 0, 0); } }
        __syncthreads();
#pragma unroll
        for (int i = 0; i < 16; ++i) { const int row = (i & 3) + 8 * (i >> 2) + 4 * (F.lane >> 5), col = F.lane & 31; part[(F.wave * 32 + row) * 32 + col] = acc[i]; }
        __syncthreads();
        for (int i = F.tid; i < 1024; i += NTHREADS) { const int row = i >> 5, col = i & 31; float s = rb[col];
#pragma unroll
            for (int w = 0; w < 8; ++w) s += part[(w * 32 + row) * 32 + col];
            lgs[row * 33 + col] = s; }
        __syncthreads();
        if (F.tid < 32) { const int t = F.tid; float lv[32];
#pragma unroll
            for (int e = 0; e < 32; ++e) lv[e] = lgs[t * 33 + e];
            float tv[4]; int te[4];
#pragma unroll
            for (int j = 0; j < 4; ++j) { float best = -3.0e38f; int be = 0;
#pragma unroll
                for (int e = 0; e < 32; ++e) { const bool gt = lv[e] > best; best = gt ? lv[e] : best; be = gt ? e : be; }
                tv[j] = best; te[j] = be;
#pragma unroll
                for (int e = 0; e < 32; ++e) lv[e] = (e == be) ? -3.0e38f : lv[e]; }
            const float e1 = __expf(tv[1] - tv[0]), e2 = __expf(tv[2] - tv[0]), e3 = __expf(tv[3] - tv[0]); const float inv = 1.0f / (1.0f + e1 + e2 + e3);
            const float gt[4] = {inv, e1 * inv, e2 * inv, e3 * inv};
#pragma unroll
            for (int j = 0; j < 4; ++j) { sel[t * 4 + j] = te[j]; lrank[t * 4 + j] = __hip_atomic_fetch_add(&hist[te[j]], 1, __ATOMIC_RELAXED, __HIP_MEMORY_SCOPE_WORKGROUP);
                tgate[(size_t)(n0 + t) * 4 + j] = gt[j]; } }
        __syncthreads();
        if (F.tid < 32) { const int c = hist[F.tid]; base[F.tid] = c > 0 ? __hip_atomic_fetch_add(cnt_word(F, l, F.tid), c, __ATOMIC_RELAXED, __HIP_MEMORY_SCOPE_AGENT) : 0; }
        __syncthreads();
        if (F.tid < 128) { const int t = F.tid >> 2, e = sel[F.tid], pos = base[e] + lrank[F.tid]; list[(size_t)e * NTOK + pos] = n0 + t; tinfo[(size_t)(n0 + t) * 4 + (F.tid & 3)] = (e << 16) | pos; }
        __syncthreads();
    }
}

__device__ __forceinline__ void moe_prefix(const Frame& F, int l) {
    volatile LAS int* M = (volatile LAS int*)(F.lds + MISC_OFF);
    __syncthreads();
    if (F.tid == 0) { int acc = 0; for (int e = 0; e < NE; ++e) { const int c = __hip_atomic_load(cnt_word(F, l, e), __ATOMIC_RELAXED, __HIP_MEMORY_SCOPE_AGENT); M[64 + e] = c; M[16 + e] = acc; acc += (c + 255) >> 8; } M[16 + NE] = acc; }
    __syncthreads();
}

struct SchedMoe1 {
    const LAS int* M; const int* list; const char* h2; const char* w; int G, vcu; int nt; unsigned ldb;
    __device__ __forceinline__ bool next(int i, GU& u) const { const int L = i * G + vcu; const int tt = M[16 + NE]; if (L >= tt * 8) return false; const int mt = L >> 3, pn = L & 7;
        int e = 0; while (M[16 + e + 1] <= mt) ++e;
        u.a = h2; u.b = w + ((size_t)e * 2048 + pn * 256) * 1024 * 2; u.i0 = e; u.i1 = mt; u.i2 = pn; u.i3 = 0; return true; }
    __device__ __forceinline__ void aoff(const GU& u, const int (&R)[2], const int (&C)[2], unsigned (&v)[2][2]) const {
        const int e = u.i0, row0 = (u.i1 - M[16 + e]) * 256, nv = M[64 + e] - row0; const int* lp = list + (size_t)e * NTOK + row0;
#pragma unroll
        for (int h = 0; h < 2; ++h)
#pragma unroll
            for (int i = 0; i < 2; ++i) { const int r = h * 128 + R[i]; const int tok = lp[r < nv ? r : 0]; v[h][i] = (unsigned)(tok * D + C[i]) * 2u; } }
};
struct EpiMoe1 {
    static constexpr bool PERM = true;
    const float* bgu; bf16_t* act;
    __device__ __forceinline__ void operator()(const f32x4 (&acc)[2][2][4][2], const GU& u, int wr, int wc, int fr, int fq) const {
        const int e = u.i0, mt = u.i1, pn = u.i2; const int col0 = pn * 128 + wc * 32 + 8 * fq;
        f32x4 bg[2], bu[2];
#pragma unroll
        for (int n = 0; n < 2; ++n) { bg[n] = *(const GAS f32x4*)(bgu + (size_t)e * 2048 + col0 + 4 * n); bu[n] = *(const GAS f32x4*)(bgu + (size_t)e * 2048 + 1024 + col0 + 4 * n); }
#pragma unroll
        for (int ai = 0; ai < 2; ++ai)
#pragma unroll
            for (int m = 0; m < 4; ++m) { const size_t slot = (size_t)mt * 256 + ai * 128 + wr * 64 + m * 16 + fr; float o[8];
#pragma unroll
                for (int n = 0; n < 2; ++n)
#pragma unroll
                    for (int j = 0; j < 4; ++j) { float g = acc[ai][0][m][n][j] + bg[n][j], up = acc[ai][1][m][n][j] + bu[n][j];
                        g = fminf(g, 7.0f); up = fminf(fmaxf(up, -7.0f), 7.0f); o[4 * n + j] = (up + 1.0f) * (g / (1.0f + __expf(-1.702f * g))); }
                u32x4 w; w.x = cvt_pk_bf16(o[0], o[1]); w.y = cvt_pk_bf16(o[2], o[3]); w.z = cvt_pk_bf16(o[4], o[5]); w.w = cvt_pk_bf16(o[6], o[7]);
                *(GAS u32x4*)(act + slot * D + col0) = w; }
    }
};
struct SchedMoe2 {
    const LAS int* M; const char* act; const char* w; int G, vcu; int nt; unsigned ldb;
    __device__ __forceinline__ bool next(int i, GU& u) const { const int L = i * G + vcu; const int tt = M[16 + NE]; if (L >= tt * 4) return false; const int mt = L >> 2, pn = L & 3;
        int e = 0; while (M[16 + e + 1] <= mt) ++e;
        u.a = act + (size_t)mt * 256 * D * 2; u.b = w + ((size_t)e * 1024 + pn * 256) * 1024 * 2; u.i0 = e; u.i1 = mt; u.i2 = pn; u.i3 = 0; return true; }
    __device__ __forceinline__ void aoff(const GU&, const int (&R)[2], const int (&C)[2], unsigned (&v)[2][2]) const {
#pragma unroll
        for (int h = 0; h < 2; ++h)
#pragma unroll
            for (int i = 0; i < 2; ++i) v[h][i] = (unsigned)((h * 128 + R[i]) * D + C[i]) * 2u; }
};
struct EpiMoe2 {
    static constexpr bool PERM = true;
    const float* bdn; bf16_t* y2;
    __device__ __forceinline__ void operator()(const f32x4 (&acc)[2][2][4][2], const GU& u, int wr, int wc, int fr, int fq) const {
        const int e = u.i0, mt = u.i1, pn = u.i2; const int col0 = pn * 256 + wc * 32 + 8 * fq;
        f32x4 bv[2][2];
#pragma unroll
        for (int bj = 0; bj < 2; ++bj)
#pragma unroll
            for (int n = 0; n < 2; ++n) bv[bj][n] = *(const GAS f32x4*)(bdn + (size_t)e * D + col0 + bj * 128 + 4 * n);
#pragma unroll
        for (int ai = 0; ai < 2; ++ai)
#pragma unroll
            for (int m = 0; m < 4; ++m) { const size_t slot = (size_t)mt * 256 + ai * 128 + wr * 64 + m * 16 + fr;
#pragma unroll
                for (int bj = 0; bj < 2; ++bj) { const f32x4 v0 = acc[ai][bj][m][0] + bv[bj][0], v1 = acc[ai][bj][m][1] + bv[bj][1];
                    u32x4 w; w.x = cvt_pk_bf16(v0[0], v0[1]); w.y = cvt_pk_bf16(v0[2], v0[3]); w.z = cvt_pk_bf16(v1[0], v1[1]); w.w = cvt_pk_bf16(v1[2], v1[3]);
                    *(GAS u32x4*)(y2 + slot * D + col0 + bj * 128) = w; } }
    }
};
__device__ __forceinline__ void phase_moe1(const Frame& F, const Args& A, int l) {
    moe_prefix(F, l);
    SchedMoe1 S{(const LAS int*)(F.lds + MISC_OFF), (const int*)(F.ws + WS_LIST) + (size_t)l * NE * NTOK, (const char*)(F.ws + WS_H2), (const char*)(F.ws + WS_WGU) + (size_t)l * NE * 2048 * 1024 * 2, F.G, F.vcu, 16, 1024u};
    EpiMoe1 E{A.in[I_BGU] + (size_t)l * NE * 2048, (bf16_t*)(F.ws + WS_ACT)};
    pg8::gemm_phase<EpiMoe1, SchedMoe1>(F.scr, S, E);
}
__device__ __forceinline__ void phase_moe2(const Frame& F, const Args& A, int l) {
    moe_prefix(F, l);
    SchedMoe2 S{(const LAS int*)(F.lds + MISC_OFF), (const char*)(F.ws + WS_ACT), (const char*)(F.ws + WS_WDN) + (size_t)l * NE * 1024 * 1024 * 2, F.G, F.vcu, 16, 1024u};
    EpiMoe2 E{A.in[I_BDN] + (size_t)l * NE * D, (bf16_t*)(F.ws + WS_Y2)};
    pg8::gemm_phase<EpiMoe2, SchedMoe2>(F.scr, S, E);
}
__device__ __forceinline__ void moe_combine_row(const Frame& F, int l, int n, f32x4 (&o)[4]) {
    const volatile LAS int* M = (const volatile LAS int*)(F.lds + MISC_OFF);
    const int* ti = (const int*)(F.ws + WS_TINFO) + ((size_t)l * NTOK + n) * 4; const float* tg = (const float*)(F.ws + WS_TGATE) + ((size_t)l * NTOK + n) * 4;
    const bf16_t* y2 = (const bf16_t*)(F.ws + WS_Y2);
#pragma unroll
    for (int q = 0; q < 4; ++q) o[q] = (f32x4){0.f, 0.f, 0.f, 0.f};
#pragma unroll
    for (int j = 0; j < 4; ++j) { const int inf = ti[j]; const float g = tg[j]; const int e = inf >> 16, pos = inf & 0xffff; const size_t slot = (size_t)M[16 + e] * 256 + pos;
#pragma unroll
        for (int q = 0; q < 4; ++q) { const u32x2 w = *(const GAS u32x2*)(y2 + slot * D + 4 * F.lane + 256 * q);
            o[q] += (f32x4){bf_lo(w.x), bf_hi(w.x), bf_lo(w.y), bf_hi(w.y)} * g; } }
}
__device__ __forceinline__ void phase_final(const Frame& F, const Args& A, int l, const float* xs) {
    moe_prefix(F, l);
    const int gw = blockIdx.x * NWAVES + F.wave, NGW = F.G * NWAVES;
    for (int n = gw; n < NL; n += NGW) { const float* xr = xs + (size_t)n * D; const float* gate = modp(F, l, n >> 14, 5); f32x4 v[4], mo[4]; float s = 0.f;
        moe_combine_row(F, l, n, mo);
#pragma unroll
        for (int q = 0; q < 4; ++q) { const int c = 4 * F.lane + 256 * q; v[q] = *(const GAS f32x4*)(xr + c) + *(const GAS f32x4*)(gate + c) * mo[q]; s += v[q][0] * v[q][0] + v[q][1] * v[q][1] + v[q][2] * v[q][2] + v[q][3] * v[q][3]; }
        s = wave_sum(s); const float r = 1.0f / sqrtf(s * (1.0f / D) + NORM_EPS);
#pragma unroll
        for (int q = 0; q < 4; ++q) { const f32x4 g = *(const GAS f32x4*)(A.in[I_FINALG] + 4 * F.lane + 256 * q); *(GAS f32x4*)(A.out + (size_t)n * D + 4 * F.lane + 256 * q) = v[q] * r * g; }
    }
}


__device__ __forceinline__ void phase_pre1(const Frame& F, const Args& A) {
    moe_prefix(F, 0);
    LAS float* hs = (LAS float*)F.scr;
    const float* xs0 = (const float*)(F.ws + WS_XS0); float* xs1 = (float*)(F.ws + WS_XS1);
    const float* ng = A.in[I_NORMG] + (size_t)(1 * 2 + 0) * D;
    for (int tile = blockIdx.x; tile < NTOK / 32; tile += F.G) {
        const int n0 = tile * 32, mrow = mrow_of(n0);
        const int sbeg = n0 < NL ? (n0 & ~(TSEQ - 1)) : (NL + ((n0 - NL) & ~(CT - 1))), send = sbeg + (n0 < NL ? TSEQ : CT);
        const float* gate5 = modp(F, 0, mrow, 5); const float* sc = modp(F, 1, mrow, 1); const float* sh = modp(F, 1, mrow, 0);
        for (int j = F.wave; j < 34; j += NWAVES) { const int n = n0 - 1 + j;
            if (n < sbeg || n >= send) {
#pragma unroll
                for (int q = 0; q < 4; ++q) *(LAS f32x4*)(hs + j * 1028 + 4 * F.lane + 256 * q) = (f32x4){0.f, 0.f, 0.f, 0.f};
                continue; }
            f32x4 mo[4], v[4]; float s = 0.f; moe_combine_row(F, 0, n, mo);
#pragma unroll
            for (int q = 0; q < 4; ++q) { const int c = 4 * F.lane + 256 * q; v[q] = *(const GAS f32x4*)(xs0 + (size_t)n * D + c) + *(const GAS f32x4*)(gate5 + c) * mo[q];
                s += v[q][0] * v[q][0] + v[q][1] * v[q][1] + v[q][2] * v[q][2] + v[q][3] * v[q][3]; }
            if (j >= 1 && j <= 32) {
#pragma unroll
                for (int q = 0; q < 4; ++q) *(GAS f32x4*)(xs1 + (size_t)n * D + 4 * F.lane + 256 * q) = v[q]; }
            s = wave_sum(s); const float r = 1.0f / sqrtf(s * (1.0f / D) + NORM_EPS);
#pragma unroll
            for (int q = 0; q < 4; ++q) { const int c = 4 * F.lane + 256 * q; const f32x4 g = *(const GAS f32x4*)(ng + c), a = *(const GAS f32x4*)(sc + c), b = *(const GAS f32x4*)(sh + c);
                *(LAS f32x4*)(hs + j * 1028 + c) = v[q] * r * g * (a + 1.0f) + b; } }
        __syncthreads();
#pragma unroll 1
        for (int q4 = 0; q4 < 4; ++q4) { const int t = F.wave * 4 + q4, j = t + 1, n = n0 + t;
#pragma unroll
            for (int q = 0; q < 4; ++q) { const int c = 4 * F.lane + 256 * q;
                const f32x4 hm = *(const LAS f32x4*)(hs + (j - 1) * 1028 + c), h0 = *(const LAS f32x4*)(hs + j * 1028 + c), hp = *(const LAS f32x4*)(hs + (j + 1) * 1028 + c);
                const f32x4 xx = (hm + hp) * 0.5f - h0;
#pragma unroll
                for (int i = 0; i < 6; ++i) { const f32x4 mu = *(const GAS f32x4*)(A.in[I_MU] + (size_t)i * D + c); const f32x4 o = h0 + xx * mu;
                    u32x2 w; w.x = cvt_pk_bf16(o[0], o[1]); w.y = cvt_pk_bf16(o[2], o[3]);
                    *(GAS u32x2*)((bf16_t*)(F.ws + WS_MIX + (size_t)i * ACTB) + (size_t)n * D + c) = w; } } }
        __syncthreads();
    }
}

struct SchedProj {
    const char* ws; int G, vcu; int nt; unsigned ldb;
    __device__ __forceinline__ bool next(int i, GU& u) const { int L = i * G + vcu; if (L >= 1940) return false;
        int kind, mi, wi, pm, pn;
        if (L < 512) { kind = 0; mi = 0; wi = 0; pm = L >> 2; pn = L & 3; }
        else if (L < 1032) { L -= 512; kind = 0; mi = 2; wi = 1; pm = L >> 2; pn = L & 3; }
        else if (L < 1552) { L -= 1032; kind = 0; mi = 3; wi = 2; pm = L >> 2; pn = L & 3; }
        else if (L < 1682) { L -= 1552; kind = 1; mi = 1; wi = 0; pm = L; pn = 0; }
        else if (L < 1812) { L -= 1682; kind = 2; mi = 4; wi = 1; pm = L; pn = 0; }
        else { L -= 1812; kind = 3; mi = 5; wi = 2; pm = L; pn = 0; }
        u.a = ws + WS_MIX + (size_t)mi * ACTB + (size_t)pm * 256 * D * 2;
        u.b = kind == 0 ? ws + WS_WRKV + ((size_t)wi * 1024 + pn * 256) * 1024 * 2 : ws + WS_WL1 + (size_t)wi * 256 * 1024 * 2;
        u.i0 = pm; u.i1 = pn; u.i2 = kind; u.i3 = wi; return true; }
    __device__ __forceinline__ void aoff(const GU&, const int (&R)[2], const int (&C)[2], unsigned (&v)[2][2]) const {
#pragma unroll
        for (int h = 0; h < 2; ++h)
#pragma unroll
            for (int i = 0; i < 2; ++i) v[h][i] = (unsigned)((h * 128 + R[i]) * D + C[i]) * 2u; }
};
struct EpiProj {
    static constexpr bool PERM = true;
    unsigned char* ws;
    __device__ __forceinline__ void operator()(const f32x4 (&acc)[2][2][4][2], const GU& u, int wr, int wc, int fr, int fq) const {
        const int pm = u.i0, pn = u.i1, kind = u.i2, wi = u.i3;
        if (kind == 0) { bf16_t* o = (bf16_t*)(ws + WS_RKV + (size_t)wi * ACTB); const int col0 = pn * 256 + wc * 32 + 8 * fq;
#pragma unroll
            for (int ai = 0; ai < 2; ++ai)
#pragma unroll
                for (int m = 0; m < 4; ++m) { const size_t n = (size_t)pm * 256 + ai * 128 + wr * 64 + m * 16 + fr;
#pragma unroll
                    for (int bj = 0; bj < 2; ++bj) { const f32x4 v0 = acc[ai][bj][m][0], v1 = acc[ai][bj][m][1];
                        u32x4 w; w.x = cvt_pk_bf16(v0[0], v0[1]); w.y = cvt_pk_bf16(v0[2], v0[3]); w.z = cvt_pk_bf16(v1[0], v1[1]); w.w = cvt_pk_bf16(v1[2], v1[3]);
                        *(GAS u32x4*)(o + n * D + col0 + bj * 128) = w; } }
        } else { bf16_t* o = (bf16_t*)(ws + WS_LACT + (size_t)(kind - 1) * NTOK * 128 * 2); const int col0 = wc * 32 + 8 * fq;
#pragma unroll
            for (int ai = 0; ai < 2; ++ai)
#pragma unroll
                for (int m = 0; m < 4; ++m) { const size_t n = (size_t)pm * 256 + ai * 128 + wr * 64 + m * 16 + fr; float t[8];
#pragma unroll
                    for (int nn = 0; nn < 2; ++nn)
#pragma unroll
                        for (int j = 0; j < 4; ++j) { const float x = acc[ai][0][m][nn][j]; t[4 * nn + j] = kind == 1 ? tanhf(x) : (kind == 2 ? x : sigmoidf_(x)); }
                    u32x4 w; w.x = cvt_pk_bf16(t[0], t[1]); w.y = cvt_pk_bf16(t[2], t[3]); w.z = cvt_pk_bf16(t[4], t[5]); w.w = cvt_pk_bf16(t[6], t[7]);
                    *(GAS u32x4*)(o + n * 128 + col0) = w; } }
    }
};
struct SchedLora2 {
    const char* ws; int G, vcu; int nt; unsigned ldb;
    __device__ __forceinline__ bool next(int i, GU& u) const { int L = i * G + vcu; if (L >= 4 * 520 + 512) return false;
        const int o = L < 2080 ? L / 520 : 4; L -= o * 520; const int pm = L >> 2, pn = L & 3; const int oa = o < 4 ? (o >> 1) : 2;
        u.a = ws + WS_LACT + (size_t)oa * NTOK * 128 * 2 + (size_t)pm * 256 * 128 * 2; u.b = ws + WS_WL2 + ((size_t)o * 1024 + pn * 256) * 128 * 2;
        u.i0 = pm; u.i1 = pn; u.i2 = o; u.i3 = 0; return true; }
    __device__ __forceinline__ void aoff(const GU&, const int (&R)[2], const int (&C)[2], unsigned (&v)[2][2]) const {
#pragma unroll
        for (int h = 0; h < 2; ++h)
#pragma unroll
            for (int i = 0; i < 2; ++i) v[h][i] = (unsigned)((h * 128 + R[i]) * 128 + C[i]) * 2u; }
};
struct EpiLora2 {
    static constexpr bool PERM = false;
    unsigned char* ws; const float* w0; const float* a0;
    __device__ __forceinline__ void operator()(const f32x4 (&acc)[2][2][4][2], const GU& u, int wr, int wc, int fr, int fq) const {
        const int pm = u.i0, pn = u.i1, o = u.i2; const int col0 = pn * 256 + wc * 32 + 4 * fq;
        const float* bp = (o < 2 ? w0 + (size_t)o * D : a0 + (size_t)(o & 1) * D) + col0; const float bsc = o < 4 ? 1.0f : 0.0f;
        f32x4 bv[2][2];
#pragma unroll
        for (int bj = 0; bj < 2; ++bj)
#pragma unroll
            for (int n = 0; n < 2; ++n) bv[bj][n] = *(const GAS f32x4*)(bp + bj * 128 + n * 16) * bsc;
        const size_t row0 = (size_t)pm * 256 + wr * 64 + fr;
        if (o < 2) { float* dst = (float*)(ws + WS_DEC) + ((size_t)o * NTOK + row0) * D + col0;
#pragma unroll
            for (int ai = 0; ai < 2; ++ai)
#pragma unroll
                for (int m = 0; m < 4; ++m)
#pragma unroll
                    for (int bj = 0; bj < 2; ++bj)
#pragma unroll
                        for (int nn = 0; nn < 2; ++nn) { const f32x4 z = acc[ai][bj][m][nn] + bv[bj][nn]; f32x4 d;
#pragma unroll
                            for (int j = 0; j < 4; ++j) d[j] = __expf(-0.60653066f * sigmoidf_(z[j]));
                            *(GAS f32x4*)(dst + (size_t)(ai * 128 + m * 16) * D + bj * 128 + nn * 16) = d; }
        } else { bf16_t* dst = (o < 4 ? (bf16_t*)(ws + WS_ICL + (size_t)(o - 2) * ACTB) : (bf16_t*)(ws + WS_G)) + row0 * D + col0; const bool sg = o < 4;
#pragma unroll
            for (int ai = 0; ai < 2; ++ai)
#pragma unroll
                for (int m = 0; m < 4; ++m)
#pragma unroll
                    for (int bj = 0; bj < 2; ++bj)
#pragma unroll
                        for (int nn = 0; nn < 2; ++nn) { f32x4 z = acc[ai][bj][m][nn] + bv[bj][nn];
#pragma unroll
                            for (int j = 0; j < 4; ++j) z[j] = sg ? sigmoidf_(z[j]) : z[j];
                            u32x2 w; w.x = cvt_pk_bf16(z[0], z[1]); w.y = cvt_pk_bf16(z[2], z[3]);
                            *(GAS u32x2*)(dst + (size_t)(ai * 128 + m * 16) * D + bj * 128 + nn * 16) = w; }
        }
    }
};
__device__ __forceinline__ void ld16bf(const bf16_t* p, float (&o)[16]) { const u32x4 a = *(const GAS u32x4*)p, b = *(const GAS u32x4*)(p + 8);
    o[0] = bf_lo(a.x); o[1] = bf_hi(a.x); o[2] = bf_lo(a.y); o[3] = bf_hi(a.y); o[4] = bf_lo(a.z); o[5] = bf_hi(a.z); o[6] = bf_lo(a.w); o[7] = bf_hi(a.w);
    o[8] = bf_lo(b.x); o[9] = bf_hi(b.x); o[10] = bf_lo(b.y); o[11] = bf_hi(b.y); o[12] = bf_lo(b.z); o[13] = bf_hi(b.z); o[14] = bf_lo(b.w); o[15] = bf_hi(b.w); }
__device__ __forceinline__ void st16bf(bf16_t* p, const float (&o)[16]) { u32x4 a, b;
    a.x = cvt_pk_bf16(o[0], o[1]); a.y = cvt_pk_bf16(o[2], o[3]); a.z = cvt_pk_bf16(o[4], o[5]); a.w = cvt_pk_bf16(o[6], o[7]);
    b.x = cvt_pk_bf16(o[8], o[9]); b.y = cvt_pk_bf16(o[10], o[11]); b.z = cvt_pk_bf16(o[12], o[13]); b.w = cvt_pk_bf16(o[14], o[15]);
    *(GAS u32x4*)p = a; *(GAS u32x4*)(p + 8) = b; }
__device__ __forceinline__ void ld16f(const float* p, float (&o)[16]) {
#pragma unroll
    for (int q = 0; q < 4; ++q) { const f32x4 v = *(const GAS f32x4*)(p + 4 * q); o[4 * q] = v[0]; o[4 * q + 1] = v[1]; o[4 * q + 2] = v[2]; o[4 * q + 3] = v[3]; } }
__device__ __forceinline__ void phase_fin(const Frame& F, const Args& A) {
    const int gw = blockIdx.x * NWAVES + F.wave, NGW = F.G * NWAVES; const int c0 = 16 * F.lane;
    float kkw[16], kaw[16]; ld16f(A.in[I_KK] + c0, kkw); ld16f(A.in[I_KA] + c0, kaw);
    const bf16_t* Kp = (const bf16_t*)(F.ws + WS_RKV + 1 * ACTB);
    for (int n = gw; n < NTOK; n += NGW) { const size_t off = (size_t)n * D + c0; float k[16], i0[16], i1[16], kk[16], o[16];
        ld16bf(Kp + off, k); ld16bf((const bf16_t*)(F.ws + WS_ICL) + off, i0); ld16bf((const bf16_t*)(F.ws + WS_ICL + ACTB) + off, i1);
        float ss = 0.f;
#pragma unroll
        for (int j = 0; j < 16; ++j) { kk[j] = k[j] * kkw[j]; ss += kk[j] * kk[j]; }
        ss += __shfl_xor(ss, 1); ss += __shfl_xor(ss, 2);
        const float inv = 1.0f / fmaxf(sqrtf(ss), 1e-12f);
#pragma unroll
        for (int j = 0; j < 16; ++j) kk[j] *= inv;
        st16bf((bf16_t*)(F.ws + WS_KK) + off, kk);
#pragma unroll
        for (int j = 0; j < 16; ++j) o[j] = k[j] * (1.0f + (i0[j] - 1.0f) * kaw[j]);
        st16bf((bf16_t*)(F.ws + WS_KDIR) + off, o);
#pragma unroll
        for (int j = 0; j < 16; ++j) o[j] = k[j] * (1.0f + (i1[j] - 1.0f) * kaw[j]);
        st16bf((bf16_t*)(F.ws + WS_KDIR + ACTB) + off, o);
#pragma unroll
        for (int j = 0; j < 16; ++j) o[j] = kk[j] * i0[j];
        st16bf((bf16_t*)(F.ws + WS_BV) + off, o);
#pragma unroll
        for (int j = 0; j < 16; ++j) o[j] = kk[j] * i1[j];
        st16bf((bf16_t*)(F.ws + WS_BV + ACTB) + off, o);
    }
}
__device__ __forceinline__ float dpp_add(float v, const int ctrl_sel) {
    const int x = __builtin_bit_cast(int, v); int y;
    if (ctrl_sel == 0) y = __builtin_amdgcn_update_dpp(0, x, 0xB1, 0xF, 0xF, true);
    else if (ctrl_sel == 1) y = __builtin_amdgcn_update_dpp(0, x, 0x4E, 0xF, 0xF, true);
    else if (ctrl_sel == 2) y = __builtin_amdgcn_update_dpp(0, x, 0x141, 0xF, 0xF, true);
    else y = __builtin_amdgcn_update_dpp(0, x, 0x140, 0xF, 0xF, true);
    return v + __builtin_bit_cast(float, y);
}
__device__ __forceinline__ float red16(float v) { v = dpp_add(v, 0); v = dpp_add(v, 1); v = dpp_add(v, 2); v = dpp_add(v, 3); return v; }
constexpr int SCS = 32, SNS = CT + TSEQ, SNCH = SNS / SCS;
constexpr int SBUF_FLOATS = 5 * SCS * 64 + SCS * 16 + SCS * 16;
__device__ __forceinline__ int scan_token(int sg, int d, int b) { if (sg < CT) { const int t = d ? (CT - 1 - sg) : sg; return NL + b * CT + t; } const int u = sg - CT; const int t = d ? (TSEQ - 1 - u) : u; return b * TSEQ + t; }
__device__ __forceinline__ void scan_load_chunk(const Frame& F, LAS float* buf, int ch, int d, int b, int hd, int rq) {
    const int lt = F.tid - 256, s = lt >> 3, p = lt & 7; const int sg = ch * SCS + s; const int n = scan_token(sg, d, b); const size_t off = (size_t)n * D + hd * 64 + 8 * p;
    { const float* dp = (const float*)(F.ws + WS_DEC) + (size_t)d * NTOK * D + off; const f32x4 a = *(const GAS f32x4*)dp, c = *(const GAS f32x4*)(dp + 4);
      LAS float* o = buf + (0 * SCS + s) * 64 + 8 * p; *(LAS f32x4*)o = a; *(LAS f32x4*)(o + 4) = c; }
    const bf16_t* srcs[4] = { (const bf16_t*)(F.ws + WS_KDIR + (size_t)d * ACTB), (const bf16_t*)(F.ws + WS_KK), (const bf16_t*)(F.ws + WS_BV + (size_t)d * ACTB), (const bf16_t*)(F.ws + WS_RKV) };
#pragma unroll
    for (int v = 0; v < 4; ++v) { u32x4 w = (u32x4){0u, 0u, 0u, 0u}; if (v < 3 || sg >= CT) w = *(const GAS u32x4*)(srcs[v] + off);
        LAS float* o = buf + ((v + 1) * SCS + s) * 64 + 8 * p;
        *(LAS f32x4*)o = (f32x4){bf_lo(w.x), bf_hi(w.x), bf_lo(w.y), bf_hi(w.y)}; *(LAS f32x4*)(o + 4) = (f32x4){bf_lo(w.z), bf_hi(w.z), bf_lo(w.w), bf_hi(w.w)}; }
    if (p < 2) { const u32x4 w = *(const GAS u32x4*)((const bf16_t*)(F.ws + WS_RKV + 2 * ACTB) + (size_t)n * D + hd * 64 + rq * 16 + 8 * p);
        LAS float* o = buf + 5 * SCS * 64 + s * 16 + 8 * p;
        *(LAS f32x4*)o = (f32x4){bf_lo(w.x), bf_hi(w.x), bf_lo(w.y), bf_hi(w.y)}; *(LAS f32x4*)(o + 4) = (f32x4){bf_lo(w.z), bf_hi(w.z), bf_lo(w.w), bf_hi(w.w)}; }
}
__device__ __forceinline__ void scan_store_chunk(const Frame& F, const LAS float* buf, int ch, int d, int b, int hd, int rq) {
    const int lt = F.tid - 256, s = lt >> 3, p = lt & 7; const int sg = ch * SCS + s; if (sg < CT) return;
    const int n = scan_token(sg, d, b); const LAS float* y = buf + 5 * SCS * 64 + SCS * 16 + s * 16 + 2 * p;
    *(GAS unsigned*)((bf16_t*)(F.ws + WS_YD + (size_t)d * NL * D * 2) + (size_t)n * D + hd * 64 + rq * 16 + 2 * p) = cvt_pk_bf16(y[0], y[1]);
}
__device__ __forceinline__ void phase_scan(const Frame& F, const Args& A) {
    LAS float* bufs = (LAS float*)F.scr;
    for (int job = F.vcu; job < 256; job += F.G) {
        const int sd = job >> 2, rq = job & 3, d = sd & 1, bh = sd >> 1, b = bh >> 4, hd = bh & 15;
        const int kg = F.lane & 15, rho = F.lane >> 4;
        f32x2 s01 = {0.f, 0.f}, s23 = {0.f, 0.f};
        __syncthreads();
        if (F.tid >= 256) scan_load_chunk(F, bufs, 0, d, b, hd, rq);
        __syncthreads();
        for (int ch = 0; ch < SNCH; ++ch) {
            LAS float* buf = bufs + (ch & 1) * SBUF_FLOATS;
            if (F.tid >= 256) {
                if (ch > 0) scan_store_chunk(F, bufs + ((ch - 1) & 1) * SBUF_FLOATS, ch - 1, d, b, hd, rq);
                if (ch + 1 < SNCH) scan_load_chunk(F, bufs + ((ch + 1) & 1) * SBUF_FLOATS, ch + 1, d, b, hd, rq);
            } else {
                const LAS float* vb = buf + 5 * SCS * 64 + 4 * F.wave + rho; LAS float* yb = buf + 5 * SCS * 64 + SCS * 16 + 4 * F.wave + rho;
#pragma unroll 4
                for (int s = 0; s < SCS; ++s) {
                    const f32x4 w = *(const LAS f32x4*)(buf + (0 * SCS + s) * 64 + 4 * kg), kd = *(const LAS f32x4*)(buf + (1 * SCS + s) * 64 + 4 * kg),
                                kk = *(const LAS f32x4*)(buf + (2 * SCS + s) * 64 + 4 * kg), bv = *(const LAS f32x4*)(buf + (3 * SCS + s) * 64 + 4 * kg),
                                r = *(const LAS f32x4*)(buf + (4 * SCS + s) * 64 + 4 * kg);
                    const float v = vb[s * 16];
                    f32x2 p = s01 * (f32x2){kk[0], kk[1]} + s23 * (f32x2){kk[2], kk[3]};
                    const float sa = red16(p[0] + p[1]);
                    const f32x2 t01 = (f32x2){kd[0], kd[1]} * v - (f32x2){bv[0], bv[1]} * sa, t23 = (f32x2){kd[2], kd[3]} * v - (f32x2){bv[2], bv[3]} * sa;
                    s01 = s01 * (f32x2){w[0], w[1]} + t01; s23 = s23 * (f32x2){w[2], w[3]} + t23;
                    f32x2 q = s01 * (f32x2){r[0], r[1]} + s23 * (f32x2){r[2], r[3]};
                    const float y = red16(q[0] + q[1]);
                    if (kg == 0) yb[s * 16] = y;
                }
            }
            __syncthreads();
        }
        if (F.tid >= 256) scan_store_chunk(F, bufs + ((SNCH - 1) & 1) * SBUF_FLOATS, SNCH - 1, d, b, hd, rq);
    }
}
__device__ __forceinline__ void phase_readout(const Frame& F, const Args& A) {
    const int gw = blockIdx.x * NWAVES + F.wave, NGW = F.G * NWAVES; const int c0 = 16 * F.lane;
    float lng[16], lnb[16], rk[16]; ld16f(A.in[I_LNG] + c0, lng); ld16f(A.in[I_LNB] + c0, lnb); ld16f(A.in[I_RK] + c0, rk);
    for (int n = gw; n < NL; n += NGW) { const size_t off = (size_t)n * D + c0; float y[16], t[16], r[16], kd[16], v[16], g[16], o[16];
        ld16bf((const bf16_t*)(F.ws + WS_YD) + off, y); ld16bf((const bf16_t*)(F.ws + WS_YD + (size_t)NL * D * 2) + off, t);
        float s = 0.f;
#pragma unroll
        for (int j = 0; j < 16; ++j) { y[j] += t[j]; s += y[j]; }
        s += __shfl_xor(s, 1); s += __shfl_xor(s, 2); const float m = s * (1.0f / 64.0f); float q = 0.f;
#pragma unroll
        for (int j = 0; j < 16; ++j) { y[j] -= m; q += y[j] * y[j]; }
        q += __shfl_xor(q, 1); q += __shfl_xor(q, 2); const float rs = 1.0f / sqrtf(q * (1.0f / 64.0f) + GN_EPS);
        ld16bf((const bf16_t*)(F.ws + WS_RKV) + off, r); ld16bf((const bf16_t*)(F.ws + WS_KDIR) + off, kd); ld16bf((const bf16_t*)(F.ws + WS_KDIR + ACTB) + off, t);
        float bs = 0.f;
#pragma unroll
        for (int j = 0; j < 16; ++j) bs += r[j] * (kd[j] + t[j]) * rk[j];
        bs += __shfl_xor(bs, 1); bs += __shfl_xor(bs, 2);
        ld16bf((const bf16_t*)(F.ws + WS_RKV + 2 * ACTB) + off, v); ld16bf((const bf16_t*)(F.ws + WS_G) + off, g);
#pragma unroll
        for (int j = 0; j < 16; ++j) o[j] = (y[j] * rs * lng[j] + lnb[j] + bs * v[j]) * g[j];
        st16bf((bf16_t*)(F.ws + WS_RO) + off, o);
    }
}
struct SchedWo {
    const char* ws; int G, vcu; int nt; unsigned ldb;
    __device__ __forceinline__ bool next(int i, GU& u) const { const int L = i * G + vcu; if (L >= 512) return false; const int pm = L >> 2, pn = L & 3;
        u.a = ws + WS_RO + (size_t)pm * 256 * D * 2; u.b = ws + WS_WO + (size_t)pn * 256 * 1024 * 2; u.i0 = pm; u.i1 = pn; u.i2 = 0; u.i3 = 0; return true; }
    __device__ __forceinline__ void aoff(const GU&, const int (&R)[2], const int (&C)[2], unsigned (&v)[2][2]) const {
#pragma unroll
        for (int h = 0; h < 2; ++h)
#pragma unroll
            for (int i = 0; i < 2; ++i) v[h][i] = (unsigned)((h * 128 + R[i]) * D + C[i]) * 2u; }
};
struct EpiWo {
    static constexpr bool PERM = false;
    const float* xin; float* xout; const float* gate_base;
    __device__ __forceinline__ void operator()(const f32x4 (&acc)[2][2][4][2], const GU& u, int wr, int wc, int fr, int fq) const {
        const int pm = u.i0, pn = u.i1; const float* gate = gate_base + (size_t)(pm >> 6) * NMOD * D; const int col0 = pn * 256 + wc * 32 + 4 * fq;
        f32x4 gl[2][2];
#pragma unroll
        for (int bj = 0; bj < 2; ++bj)
#pragma unroll
            for (int n = 0; n < 2; ++n) gl[bj][n] = *(const GAS f32x4*)(gate + col0 + bj * 128 + n * 16);
#pragma unroll
        for (int ai = 0; ai < 2; ++ai)
#pragma unroll
            for (int m = 0; m < 4; ++m) { const size_t off = ((size_t)pm * 256 + ai * 128 + wr * 64 + m * 16 + fr) * D + col0;
#pragma unroll
                for (int bj = 0; bj < 2; ++bj)
#pragma unroll
                    for (int n = 0; n < 2; ++n) *(GAS f32x4*)(xout + off + bj * 128 + n * 16) = *(const GAS f32x4*)(xin + off + bj * 128 + n * 16) + gl[bj][n] * acc[ai][bj][m][n]; }
    }
};

constexpr int NPHASES = 3;
__global__ void __launch_bounds__(NTHREADS, 2) fwd_kernel(Args args) {
    extern __shared__ __attribute__((aligned(16))) unsigned char lds_raw[];
    Frame F;
    F.lds = (LAS unsigned char*)lds_raw; F.scr = F.lds + SCR_OFF; F.ws = args.ws;
    F.tid = threadIdx.x; F.lane = F.tid & 63; F.wave = __builtin_amdgcn_readfirstlane(F.tid >> 6);
    F.G = gridDim.x; { const int bx = blockIdx.x; F.vcu = (F.G % 8 == 0) ? (bx % 8) * (F.G / 8) + bx / 8 : bx; }
    volatile LAS unsigned* MISC = (volatile LAS unsigned*)(F.lds + MISC_OFF);
    if (F.tid < 64) MISC[F.tid] = 0u;
    __syncthreads();
    const int lo = args.ph_lo, hi = args.ph_hi;
    XcdBarrier bar; bar.bar = (unsigned*)(F.ws + WS_CTL); bar.x = 0; bar.st = MISC + 8;
    if (hi - lo > 1) bar = xcd_barrier_post((unsigned*)(F.ws + WS_CTL), MISC + 8);
#define IN(k) (lo <= (k) && (k) < hi)
#define SEAM(k) do { if (IN(k) && IN((k) + 1)) xcd_barrier(bar); } while (0)
    if (IN(0)) { phase_prep(F, args); } SEAM(0);
    if (IN(1)) { phase_pre0(F, args); } SEAM(1);
    if (IN(2)) { SchedPool S{(const char*)(F.ws + WS_DBUF), (const char*)(F.ws + WS_WPOOL), F.G, F.vcu, 4, 256u};
                 EpiPool E{args.in[I_X], args.in[I_CTX], args.in[I_POOLLS], modp(F, 0, 0, 2), (float*)(F.ws + WS_XS0)};
                 pg8::gemm_phase<EpiPool, SchedPool>(F.scr, S, E); } SEAM(2);
    if (IN(3)) { phase_post(F, args, 0, (const float*)(F.ws + WS_XS0), NTOK); } SEAM(3);
    if (IN(4)) { phase_moe1(F, args, 0); } SEAM(4);
    if (IN(5)) { phase_moe2(F, args, 0); } SEAM(5);
    if (IN(6)) { phase_pre1(F, args); } SEAM(6);
    if (IN(7)) { SchedProj S{(const char*)F.ws, F.G, F.vcu, 16, 1024u}; EpiProj E{F.ws}; pg8::gemm_phase<EpiProj, SchedProj>(F.scr, S, E); } SEAM(7);
    if (IN(8)) { SchedLora2 S{(const char*)F.ws, F.G, F.vcu, 2, 128u}; EpiLora2 E{F.ws, args.in[I_W0], args.in[I_A0]}; pg8::gemm_phase<EpiLora2, SchedLora2>(F.scr, S, E); } SEAM(8);
    if (IN(9)) { phase_fin(F, args); } SEAM(9);
    if (IN(10)) { phase_scan(F, args); } SEAM(10);
    if (IN(11)) { phase_readout(F, args); } SEAM(11);
    if (IN(12)) { SchedWo S{(const char*)F.ws, F.G, F.vcu, 16, 1024u}; EpiWo E{(const float*)(F.ws + WS_XS1), (float*)(F.ws + WS_XS0), modp(F, 1, 0, 2)}; pg8::gemm_phase<EpiWo, SchedWo>(F.scr, S, E); } SEAM(12);
    if (IN(13)) { phase_post(F, args, 1, (const float*)(F.ws + WS_XS0), NL); } SEAM(13);
    if (IN(14)) { phase_moe1(F, args, 1); } SEAM(14);
    if (IN(15)) { phase_moe2(F, args, 1); } SEAM(15);
    if (IN(16)) { phase_final(F, args, 1, (const float*)(F.ws + WS_XS0)); }
#undef IN
#undef SEAM
}

extern "C" void kernel_launch(void* const* d_in, const int* in_sizes, int n_in, void* d_out, int out_size, void* d_ws, size_t ws_size, hipStream_t stream) {
    static int grid = 0;
    if (grid == 0) {
        if (n_in != 32 || ws_size < WS_END) { fprintf(stderr, "kernel_launch: unexpected n_in %d / ws %zu (need %zu)\n", n_in, ws_size, (size_t)WS_END); grid = -1; return; }
        int dev = 0, cus = 0;
        if (hipGetDevice(&dev) != hipSuccess || hipDeviceGetAttribute(&cus, hipDeviceAttributeMultiprocessorCount, dev) != hipSuccess) { grid = -1; return; }
        if (hipFuncSetAttribute((const void*)fwd_kernel, hipFuncAttributeMaxDynamicSharedMemorySize, LDS_BYTES) != hipSuccess) { fprintf(stderr, "kernel_launch: hipFuncSetAttribute failed\n"); grid = -1; return; }
        (void)hipGetLastError();
        grid = cus;
    }
    if (grid < 0) return;
    (void)hipMemsetAsync((char*)d_ws + WS_CTL, 0, CTL_BYTES, stream);
    Args a{};
    for (int i = 0; i < 32; ++i) a.in[i] = (const float*)d_in[i];
    a.out = (float*)d_out; a.ws = (unsigned char*)d_ws;
    const int last = 16;
#if N_LAUNCH_MODE == 1
    a.ph_lo = 0; a.ph_hi = last + 1;
    hipLaunchKernelGGL(fwd_kernel, dim3(grid), dim3(NTHREADS), LDS_BYTES, stream, a);
#else
    for (int p = 0; p <= last; ++p) { a.ph_lo = p; a.ph_hi = p + 1; hipLaunchKernelGGL(fwd_kernel, dim3(grid), dim3(NTHREADS), LDS_BYTES, stream, a); }
#endif
}
```

```cpp
#include <hip/hip_runtime.h>
#include <cstdio>
#include <cstdint>

#define LAS __attribute__((address_space(3)))
#define GAS __attribute__((address_space(1)))
typedef unsigned short bf16_t;
typedef short bf16x8 __attribute__((ext_vector_type(8)));
typedef float f32x4 __attribute__((ext_vector_type(4)));
typedef float f32x2 __attribute__((ext_vector_type(2)));
typedef float f32x16 __attribute__((ext_vector_type(16)));
typedef unsigned u32x4 __attribute__((ext_vector_type(4)));
typedef unsigned u32x2 __attribute__((ext_vector_type(2)));

#ifndef N_LAUNCH_MODE
#define N_LAUNCH_MODE 1
#endif
#ifndef REPEAT_MASK
#define REPEAT_MASK 0
#endif

constexpr int D = 1024, NB = 2, TSEQ = 16384, CT = 256, NL = NB * TSEQ, NC = NB * CT, NTOK = NL + NC;
constexpr int NE = 32, TOPK = 4, NMOD = 6;
constexpr int NWAVES = 8, NTHREADS = 512;
constexpr int MAXSLOT = ((NTOK * TOPK + 255) / 256 + NE) * 256;
constexpr float NORM_EPS = 1e-6f, GN_EPS = 64e-5f;

constexpr size_t AL(size_t x) { return (x + 255) & ~(size_t)255; }
constexpr size_t WS_CTL = 0, CTL_BYTES = 32768;
constexpr size_t CTL_CNT = 16384;
constexpr size_t WS_MOD = WS_CTL + CTL_BYTES;
constexpr size_t WS_LIST = AL(WS_MOD + 2 * 3 * 6144 * 4);
constexpr size_t WS_TINFO = AL(WS_LIST + (size_t)2 * NE * NTOK * 4);
constexpr size_t WS_TGATE = AL(WS_TINFO + (size_t)2 * NTOK * 4 * 4);
constexpr size_t WS_WGU = AL(WS_TGATE + (size_t)2 * NTOK * 4 * 4);
constexpr size_t WS_WDN = AL(WS_WGU + (size_t)2 * NE * 2048 * 1024 * 2);
constexpr size_t WS_WRKV = AL(WS_WDN + (size_t)2 * NE * 1024 * 1024 * 2);
constexpr size_t WS_WO = AL(WS_WRKV + (size_t)3 * 1024 * 1024 * 2);
constexpr size_t WS_WL1 = AL(WS_WO + (size_t)1024 * 1024 * 2);
constexpr size_t WS_WL2 = AL(WS_WL1 + (size_t)3 * 256 * 1024 * 2);
constexpr size_t WS_WPOOL = AL(WS_WL2 + (size_t)5 * 1024 * 128 * 2);
constexpr size_t WS_XS0 = AL(WS_WPOOL + (size_t)4 * 256 * 256 * 2);
constexpr size_t WS_XS1 = AL(WS_XS0 + (size_t)NTOK * D * 4);
constexpr size_t WS_T = AL(WS_XS1 + (size_t)NTOK * D * 4);
constexpr size_t ACTB = (size_t)NTOK * D * 2;
constexpr size_t TA = WS_T;
constexpr size_t TA_BYTES = (size_t)432 << 20;
constexpr size_t WS_DBUF = TA, WS_H2 = TA + ACTB, WS_ACT = TA + 2 * ACTB;
constexpr size_t WS_MIX = TA;
constexpr size_t WS_KDIR = TA, WS_BV = TA + 2 * ACTB, WS_KK = TA + 4 * ACTB;
constexpr size_t TB = TA + TA_BYTES;
constexpr size_t TB_BYTES = (size_t)290 << 20;
constexpr size_t WS_Y2 = TB, WS_RKV = TB;
constexpr size_t TC = TB + TB_BYTES;
constexpr size_t WS_DEC = TC, WS_RO = TC;
constexpr size_t TD = AL(TC + (size_t)2 * NTOK * D * 4);
constexpr size_t WS_ICL = TD, WS_YD = TD;
constexpr size_t TE = AL(TD + 2 * ACTB);
constexpr size_t WS_G = TE;
constexpr size_t TF = AL(TE + ACTB);
constexpr size_t WS_LACT = TF;
constexpr size_t WS_END = AL(TF + (size_t)3 * NTOK * 128 * 2);
static_assert(WS_ACT + (size_t)MAXSLOT * D * 2 <= TA + TA_BYTES, "ACT overflows TA");
static_assert((size_t)MAXSLOT * D * 2 <= TB_BYTES, "Y2 overflows TB");
static_assert(WS_END <= ((size_t)2048 << 20), "workspace too large");

constexpr int MISC_OFF = 0, SCR_OFF = 1024, SCR_BYTES = 147456, LDS_BYTES = SCR_OFF + SCR_BYTES;

__device__ __forceinline__ unsigned cvt_pk_bf16(float lo, float hi) { unsigned r; asm volatile("v_cvt_pk_bf16_f32 %0, %1, %2" : "=v"(r) : "v"(lo), "v"(hi)); return r; }
__device__ __forceinline__ float bf_lo(unsigned w) { return __uint_as_float(w << 16); }
__device__ __forceinline__ float bf_hi(unsigned w) { return __uint_as_float(w & 0xffff0000u); }
__device__ __forceinline__ float bf2f(bf16_t b) { return __uint_as_float(((unsigned)b) << 16); }
__device__ __forceinline__ float wave_sum(float v) {
#pragma unroll
    for (int o = 1; o < 64; o <<= 1) v += __shfl_xor(v, o);
    return v;
}
__device__ __forceinline__ float sigmoidf_(float x) { return 1.0f / (1.0f + __expf(-x)); }
#define LDS_WAIT() asm volatile("s_waitcnt lgkmcnt(0)" ::: "memory")
#define VM_WAIT() asm volatile("s_waitcnt vmcnt(0)" ::: "memory")

#define XB_TMO      128
#define XB_XCNT(j)  (256  + 64 * (j))
#define XB_XSUB(j)  (1280 + 64 * (j))
#define XB_XGEN(j)  (2304 + 64 * (j))
#define XB_TOP      3328
#define XB_TOPGEN   3392
#define XCD_BAR_WORDS 3456
#define XB_SPIN_CAP (1u << 22)
__device__ __forceinline__ unsigned xb_ld(unsigned* p)              { return __hip_atomic_load(p, __ATOMIC_RELAXED, __HIP_MEMORY_SCOPE_AGENT); }
__device__ __forceinline__ unsigned xb_add(unsigned* p, unsigned v) { return __hip_atomic_fetch_add(p, v, __ATOMIC_RELAXED, __HIP_MEMORY_SCOPE_AGENT); }
__device__ __forceinline__ unsigned xb_xcc_id() { return (unsigned)__builtin_amdgcn_s_getreg((3 << 11) | 20) & 0xFu; }
#define XB_SPIN(cond, bar) do { unsigned _sp = 0; while (cond) { __builtin_amdgcn_s_sleep(1); \
    if ((++_sp & 255u) == 0u) { if (xb_ld(&(bar)[XB_TMO])) break; if (_sp > XB_SPIN_CAP) { atomicAdd(&(bar)[XB_TMO], 1u); break; } } } } while (0)
struct XcdBarrier { unsigned* bar; unsigned x; volatile LAS unsigned* st; };
__device__ __forceinline__ XcdBarrier xcd_barrier_post(unsigned* bar, volatile LAS unsigned* st) {
    XcdBarrier b; b.bar = bar; b.x = xb_xcc_id(); b.st = st;
    if (threadIdx.x == 0) (void)xb_add(&bar[XB_XCNT(b.x)], 1u);
    return b;
}
__device__ __forceinline__ void xcd_barrier_complete(unsigned* bar, unsigned x, unsigned& nloc, unsigned& nx) {
    const unsigned G = gridDim.x * gridDim.y * gridDim.z;
    unsigned sum, cnt, mine, sp = 0u;
    for (;;) {
        sum = 0u; cnt = 0u; mine = 0u;
#pragma unroll
        for (unsigned j = 0; j < 16; ++j) { const unsigned c = xb_ld(&bar[XB_XCNT(j)]); sum += c; cnt += (c > 0u) ? 1u : 0u; mine = (j == x) ? c : mine; }
        if (sum == G) break;
        __builtin_amdgcn_s_sleep(1);
        if ((++sp & 255u) == 0u) { if (xb_ld(&bar[XB_TMO])) break; if (sp > XB_SPIN_CAP) { atomicAdd(&bar[XB_TMO], 1u); break; } }
    }
    nloc = mine > 0u ? mine : 1u; nx = cnt > 0u ? cnt : 1u;
}
__device__ __forceinline__ void xcd_barrier(const XcdBarrier& b) {
    asm volatile("s_waitcnt vmcnt(0)" ::: "memory");
    __syncthreads();
    if (threadIdx.x == 0) {
        unsigned* bar = b.bar;
        __builtin_amdgcn_s_waitcnt(0);
        unsigned nloc = b.st[0], nx = b.st[1];
        if (nloc == 0u) { xcd_barrier_complete(bar, b.x, nloc, nx); b.st[0] = nloc; b.st[1] = nx; }
        const unsigned old = xb_add(&bar[XB_XSUB(b.x)], 1u);
        const unsigned gen = old / nloc;
        if (old + 1u == (gen + 1u) * nloc) {
            __builtin_amdgcn_fence(__ATOMIC_RELEASE, "agent");
            asm volatile("s_waitcnt vmcnt(0)" ::: "memory");
            const unsigned og = xb_add(&bar[XB_TOP], 1u);
            const unsigned tg = og / nx;
            if (og + 1u == (tg + 1u) * nx) xb_add(&bar[XB_TOPGEN], 1u);
            else XB_SPIN(xb_ld(&bar[XB_TOPGEN]) == tg, bar);
            __builtin_amdgcn_fence(__ATOMIC_ACQUIRE, "agent");
            xb_add(&bar[XB_XGEN(b.x)], 1u);
            asm volatile("s_waitcnt vmcnt(0)" ::: "memory");
        } else {
            XB_SPIN(xb_ld(&bar[XB_XGEN(b.x)]) == gen, bar);
            __builtin_amdgcn_fence(__ATOMIC_ACQUIRE, "agent");
            asm volatile("s_waitcnt vmcnt(0)" ::: "memory");
        }
    }
    __syncthreads();
}

namespace pg8 {
constexpr int BM = 256, BK = 64, HALF = 128, HTB = HALF * BK * 2, STAGE_BYTES = 8 * HTB;
__host__ __device__ __forceinline__ int lds_byte(int r, int c) { const int st = (r >> 4) * 2 + (c >> 5), rr = r & 15, cc = c & 31, ob = rr * 64 + cc * 2; return st * 1024 + (ob ^ (((ob >> 9) & 1) << 5)); }
__host__ __device__ __forceinline__ void stage_rc(int b, int& R, int& C) { const int st = b / 1024, sb = b % 1024, swz = sb ^ (((sb >> 9) & 1) << 5); R = (st >> 1) * 16 + swz / 64; C = (st & 1) * 32 + (swz % 64) / 2; }
__host__ __device__ __forceinline__ int perm32(int rho) { const int n = rho >> 4, i = rho & 15; return 8 * (i >> 2) + 4 * n + (i & 3); }

struct GU { unsigned a, b; int i0, i1, i2, i3; };
typedef int v8i __attribute__((ext_vector_type(8)));
typedef int v4i __attribute__((ext_vector_type(4)));
__device__ __forceinline__ bf16x8 half8(v8i v, int h) { const v4i a = h ? __builtin_shufflevector(v, v, 4, 5, 6, 7) : __builtin_shufflevector(v, v, 0, 1, 2, 3); return __builtin_bit_cast(bf16x8, a); }
__device__ __forceinline__ v8i cat8(bf16x8 lo, bf16x8 hi) { const v4i a = __builtin_bit_cast(v4i, lo), b = __builtin_bit_cast(v4i, hi); return __builtin_shufflevector(a, b, 0, 1, 2, 3, 4, 5, 6, 7); }

template <class Epi, class Sched>
__device__ __forceinline__ void gemm_phase(LAS unsigned char* lds, unsigned char* wsbase, const Sched& S, const Epi& E) {
    const int tid = threadIdx.x, wid = __builtin_amdgcn_readfirstlane(tid >> 6), lane = tid & 63, wr = wid >> 2, wc = wid & 3, fr = lane & 15, fq = lane >> 4;
    const int nt = S.nt;
    const __amdgpu_buffer_rsrc_t rsrc = __builtin_amdgcn_make_buffer_rsrc((void*)wsbase, 0, 0xffffffff, 0x00020000);
    int Rr[2], Cc[2]; unsigned voffB[2];
#pragma unroll
    for (int i = 0; i < 2; ++i) { int R, C; stage_rc(tid * 16 + i * 8192, R, C); Rr[i] = R; Cc[i] = C; const int Rb = Epi::PERM ? ((R & ~31) + perm32(R & 31)) : R;
        voffB[i] = (unsigned)Rb * S.ldb + 2u * (unsigned)C; }
    const unsigned kstep = 128u;
    const unsigned hstepB = (unsigned)HALF * S.ldb;
    const unsigned ldsw = (unsigned)wid * 1024u;
    const int aoff = lds_byte(wr * 64 + fr, fq * 8), boff = lds_byte(wc * 32 + fr, fq * 8);
#define PG8_SA(b, h) (((b) * 2 + (h)) * HTB)
#define PG8_SB(b, h) ((4 + (b) * 2 + (h)) * HTB)
#define PG8_STAGE(bufoff, soff, voff) do { _Pragma("unroll") for (int _i = 0; _i < 2; ++_i) \
        __builtin_amdgcn_raw_ptr_buffer_load_lds(rsrc, (LAS void*)(lds + (bufoff) + ldsw + _i * 8192), 16, (int)(voff)[_i], (int)(soff), 0, 0); } while (0)
#define PG8_LDA(dst, b, h) do { _Pragma("unroll") for (int m = 0; m < 4; ++m) dst[m] = cat8(*(const LAS bf16x8*)(lds + PG8_SA(b, h) + aoff + m * 2048), *(const LAS bf16x8*)(lds + PG8_SA(b, h) + aoff + m * 2048 + 1024)); } while (0)
#define PG8_LDB(dst, b, h) do { _Pragma("unroll") for (int n = 0; n < 2; ++n) dst[n] = cat8(*(const LAS bf16x8*)(lds + PG8_SB(b, h) + boff + n * 2048), *(const LAS bf16x8*)(lds + PG8_SB(b, h) + boff + n * 2048 + 1024)); } while (0)
#define PG8_MMA(ai, bj, At, Bt) do { __builtin_amdgcn_s_setprio(1); _Pragma("unroll") for (int m = 0; m < 4; ++m) _Pragma("unroll") for (int n = 0; n < 2; ++n) { \
        if constexpr (Epi::FP8) { asm volatile("v_mfma_scale_f32_16x16x128_f8f6f4 %0, %1, %2, %0, %3, %4 op_sel_hi:[0,0,0]" : "+v"(acc[ai][bj][m][n]) : "v"(Bt[n]), "v"(At[m]), "v"(sc_w), "v"(sc_a)); } \
        else { acc[ai][bj][m][n] = __builtin_amdgcn_mfma_f32_16x16x32_bf16(half8(Bt[n], 0), half8(At[m], 0), acc[ai][bj][m][n], 0, 0, 0); \
               acc[ai][bj][m][n] = __builtin_amdgcn_mfma_f32_16x16x32_bf16(half8(Bt[n], 1), half8(At[m], 1), acc[ai][bj][m][n], 0, 0, 0); } } \
        __builtin_amdgcn_s_setprio(0); } while (0)
#define PG8_WAIT_V(n) asm volatile("s_waitcnt vmcnt(" #n ")" ::: "memory")
#define PG8_WAIT_L(n) asm volatile("s_waitcnt lgkmcnt(" #n ")" ::: "memory")
#define PG8_BAR __builtin_amdgcn_s_barrier()
#define PG8_SCHED __builtin_amdgcn_sched_barrier(0)
#define PG8_RC() do { _Pragma("unroll") for (int i = 0; i < 2; ++i) { int R, C; stage_rc((int)threadIdx.x * 16 + i * 8192, R, C); Rr[i] = R; Cc[i] = C; } } while (0)
    GU cur, nxt; int ui = 0;
    if (!S.next(0, cur)) return;
    f32x4 acc[2][2][4][2];
#pragma unroll
    for (int a = 0; a < 2; ++a)
#pragma unroll
        for (int b = 0; b < 2; ++b)
#pragma unroll
            for (int m = 0; m < 4; ++m)
#pragma unroll
                for (int n = 0; n < 2; ++n) acc[a][b][m][n] = (f32x4){0.f, 0.f, 0.f, 0.f};
    v8i At[4], B0[2], B1[2];
    int sc_w = 0x7a7a7a7a, sc_a = 0x7f7f7f7f; asm volatile("" : "+v"(sc_w), "+v"(sc_a));
    unsigned vA[2][2], nvA[2][2];
    S.aoff(cur, Rr, Cc, vA);
    unsigned cA = __builtin_amdgcn_readfirstlane(cur.a), cB = __builtin_amdgcn_readfirstlane(cur.b);
    PG8_STAGE(PG8_SB(0, 0), cB, voffB); PG8_STAGE(PG8_SB(0, 1), cB + hstepB, voffB); PG8_STAGE(PG8_SA(0, 0), cA, vA[0]); PG8_STAGE(PG8_SA(0, 1), cA, vA[1]);
    if (wr == 1) PG8_BAR;
    PG8_WAIT_V(2); PG8_BAR;
    PG8_STAGE(PG8_SB(1, 0), cB + kstep, voffB); PG8_STAGE(PG8_SA(1, 0), cA + kstep, vA[0]); PG8_STAGE(PG8_SB(1, 1), cB + hstepB + kstep, voffB);
    PG8_WAIT_V(6); PG8_BAR;
    for (;;) {
        const bool has_next = S.next(ui + 1, nxt);
        const unsigned nA = has_next ? __builtin_amdgcn_readfirstlane(nxt.a) : cA, nB = has_next ? __builtin_amdgcn_readfirstlane(nxt.b) : cB;
        if constexpr (Sched::GATHER) {
            if (has_next) { PG8_RC(); S.aoff(nxt, Rr, Cc, nvA); }
            else { nvA[0][0] = vA[0][0]; nvA[0][1] = vA[0][1]; nvA[1][0] = vA[1][0]; nvA[1][1] = vA[1][1]; }
        }
#pragma unroll 1
        for (int t = 0; t < nt; t += 2) {
            const bool last = (t == nt - 2);
            const unsigned a1 = cA + (unsigned)(t + 1) * kstep;
            const unsigned a2 = last ? nA : cA + (unsigned)(t + 2) * kstep, b2 = last ? nB : cB + (unsigned)(t + 2) * kstep;
            const unsigned a3 = a2 + kstep, b3 = b2 + kstep;
            unsigned w0[2], w1[2];
            if constexpr (Sched::GATHER) { w0[0] = last ? nvA[0][0] : vA[0][0]; w0[1] = last ? nvA[0][1] : vA[0][1]; w1[0] = last ? nvA[1][0] : vA[1][0]; w1[1] = last ? nvA[1][1] : vA[1][1]; }
            else { w0[0] = vA[0][0]; w0[1] = vA[0][1]; w1[0] = vA[1][0]; w1[1] = vA[1][1]; }
            PG8_LDB(B0, 0, 0); PG8_LDB(B1, 0, 1); PG8_SCHED; PG8_LDA(At, 0, 0); PG8_STAGE(PG8_SA(1, 1), a1, vA[1]);
            PG8_WAIT_V(8); PG8_WAIT_L(0); PG8_BAR; PG8_MMA(0, 0, At, B0); PG8_MMA(0, 1, At, B1); PG8_BAR; PG8_SCHED;
            PG8_LDA(At, 0, 1); PG8_STAGE(PG8_SB(0, 0), b2, voffB); PG8_STAGE(PG8_SB(0, 1), b2 + hstepB, voffB); PG8_STAGE(PG8_SA(0, 0), a2, w0);
            PG8_WAIT_V(8); PG8_WAIT_L(0); PG8_BAR; PG8_MMA(1, 0, At, B0); PG8_MMA(1, 1, At, B1); PG8_BAR; PG8_SCHED;
            PG8_LDB(B0, 1, 0); PG8_LDB(B1, 1, 1); PG8_SCHED; PG8_LDA(At, 1, 0); PG8_STAGE(PG8_SA(0, 1), a2, w1);
            PG8_WAIT_V(8); PG8_WAIT_L(0); PG8_BAR; PG8_MMA(0, 0, At, B0); PG8_MMA(0, 1, At, B1); PG8_BAR; PG8_SCHED;
            PG8_LDA(At, 1, 1); PG8_STAGE(PG8_SB(1, 0), b3, voffB); PG8_STAGE(PG8_SB(1, 1), b3 + hstepB, voffB); PG8_STAGE(PG8_SA(1, 0), a3, w0);
            PG8_WAIT_V(8); PG8_WAIT_L(0); PG8_BAR; PG8_MMA(1, 0, At, B0); PG8_MMA(1, 1, At, B1); PG8_BAR; PG8_SCHED;
        }
        if (wr == 0) PG8_BAR;
        if constexpr (Epi::FP8) asm volatile("s_nop 15\n\ts_nop 7" ::: "memory");
        { int fr_ = fr, fq_ = fq; asm volatile("" : "+v"(fr_), "+v"(fq_)); E(acc, cur, wr, wc, fr_, fq_); }
        if (!has_next) break;
#pragma unroll
        for (int a = 0; a < 2; ++a)
#pragma unroll
            for (int b = 0; b < 2; ++b)
#pragma unroll
                for (int m = 0; m < 4; ++m)
#pragma unroll
                    for (int n = 0; n < 2; ++n) acc[a][b][m][n] = (f32x4){0.f, 0.f, 0.f, 0.f};
        cur = nxt; cA = nA; cB = nB; ++ui;
        if constexpr (Sched::GATHER) { vA[0][0] = nvA[0][0]; vA[0][1] = nvA[0][1]; vA[1][0] = nvA[1][0]; vA[1][1] = nvA[1][1]; }
        if (wr == 1) PG8_BAR;
    }
    PG8_WAIT_V(0);
    PG8_BAR;
#undef PG8_RC
#undef PG8_SA
#undef PG8_SB
#undef PG8_STAGE
#undef PG8_LDA
#undef PG8_LDB
#undef PG8_MMA
#undef PG8_WAIT_V
#undef PG8_WAIT_L
#undef PG8_BAR
#undef PG8_SCHED
}
}
using pg8::GU;

struct Args { const float* in[32]; float* out; unsigned char* ws; int ph_lo, ph_hi; };
struct Frame {
    LAS unsigned char* lds;
    LAS unsigned char* scr;
    unsigned char* ws;
    int tid, lane, wave, G, vcu;
};
enum { I_X = 0, I_C, I_CTX, I_CCTX, I_NORMG, I_ADAW, I_ADAB, I_POOLW, I_POOLLS, I_MU, I_WRKV, I_W0, I_W1, I_W2, I_A0, I_A1, I_A2, I_G1, I_G2, I_KK, I_KA, I_RK, I_LNG, I_LNB, I_WO,
       I_RW, I_RB, I_WGU, I_BGU, I_WDN, I_BDN, I_FINALG };

__device__ __forceinline__ const float* modp(const Frame& F, int layer, int row, int k) { return (const float*)(F.ws + WS_MOD) + ((size_t)(layer * 3 + row) * NMOD + k) * D; }
__device__ __forceinline__ int mrow_of(int n) { return n < NL ? (n >> 14) : 2; }

__device__ __forceinline__ void transpose_tile(const float* W, int ldw, int k0, int n0, bf16_t* WT, size_t dst_row0, int ldk, int kdst0, LAS float* scr, int lane) {
    const int c4 = lane & 15, kr = lane >> 4;
#pragma unroll 4
    for (int it = 0; it < 16; ++it) { const int kk = 4 * it + kr; const f32x4 v = *(const GAS f32x4*)(W + (size_t)(k0 + kk) * ldw + n0 + 4 * c4);
        LAS float* s = scr + kk * 65 + 4 * c4; s[0] = v[0]; s[1] = v[1]; s[2] = v[2]; s[3] = v[3]; }
    LDS_WAIT(); asm volatile("" ::: "memory");
    const int c = lane & 7;
#pragma unroll
    for (int j = 0; j < 8; ++j) { const int n = (lane >> 3) + 8 * j; const LAS float* s = scr + (8 * c) * 65 + n;
        u32x4 o; o.x = cvt_pk_bf16(s[0 * 65], s[1 * 65]); o.y = cvt_pk_bf16(s[2 * 65], s[3 * 65]); o.z = cvt_pk_bf16(s[4 * 65], s[5 * 65]); o.w = cvt_pk_bf16(s[6 * 65], s[7 * 65]);
        *(GAS u32x4*)(WT + (dst_row0 + n) * (size_t)ldk + kdst0 + k0 + 8 * c) = o; }
    LDS_WAIT(); asm volatile("" ::: "memory");
}

__device__ __forceinline__ unsigned pk4_fp8(float a, float b, float c, float d) { int w = 0; w = __builtin_amdgcn_cvt_pk_fp8_f32(a, b, w, false); w = __builtin_amdgcn_cvt_pk_fp8_f32(c, d, w, true); return (unsigned)w; }
__device__ __forceinline__ void transpose_tile_fp8(const float* W, int ldw, int k0, int n0, unsigned char* WT, size_t dst_row0, int ldk, float scale, LAS float* scr, int lane) {
    const int c4 = lane & 15, kr = lane >> 4;
#pragma unroll 4
    for (int it = 0; it < 16; ++it) { const int kk = 4 * it + kr; const f32x4 v = *(const GAS f32x4*)(W + (size_t)(k0 + kk) * ldw + n0 + 4 * c4);
        LAS float* s = scr + kk * 65 + 4 * c4; s[0] = v[0] * scale; s[1] = v[1] * scale; s[2] = v[2] * scale; s[3] = v[3] * scale; }
    LDS_WAIT(); asm volatile("" ::: "memory");
    const int c = lane & 3;
#pragma unroll
    for (int j = 0; j < 4; ++j) { const int n = (lane >> 2) + 16 * j; const LAS float* s = scr + (16 * c) * 65 + n;
        u32x4 o; o.x = pk4_fp8(s[0 * 65], s[1 * 65], s[2 * 65], s[3 * 65]); o.y = pk4_fp8(s[4 * 65], s[5 * 65], s[6 * 65], s[7 * 65]);
        o.z = pk4_fp8(s[8 * 65], s[9 * 65], s[10 * 65], s[11 * 65]); o.w = pk4_fp8(s[12 * 65], s[13 * 65], s[14 * 65], s[15 * 65]);
        *(GAS u32x4*)(WT + (dst_row0 + n) * (size_t)ldk + k0 + 16 * c) = o; }
    LDS_WAIT(); asm volatile("" ::: "memory");
}
__device__ __forceinline__ void phase_prep(const Frame& F, const Args& A) {
    unsigned char* ws = F.ws;
    if (blockIdx.x < 192) {
        const int l = blockIdx.x / 96, cc = blockIdx.x % 96, c4 = F.tid & 15, kq = F.tid >> 4;
        const float* w = A.in[I_ADAW] + (size_t)l * D * (NMOD * D) + cc * 64 + 4 * c4;
        f32x4 a0 = {0, 0, 0, 0}, a1 = {0, 0, 0, 0}, a2 = {0, 0, 0, 0};
        for (int i = 0; i < 32; ++i) { const int k = kq + 32 * i;
            const f32x4 wv = *(const GAS f32x4*)(w + (size_t)k * (NMOD * D));
            float c0 = A.in[I_C][k], c1 = A.in[I_C][D + k], c2 = A.in[I_CCTX][k];
            c0 = c0 * sigmoidf_(c0); c1 = c1 * sigmoidf_(c1); c2 = c2 * sigmoidf_(c2);
            a0 += wv * c0; a1 += wv * c1; a2 += wv * c2; }
        LAS f32x4* red = (LAS f32x4*)F.scr;
        red[(kq * 3 + 0) * 16 + c4] = a0; red[(kq * 3 + 1) * 16 + c4] = a1; red[(kq * 3 + 2) * 16 + c4] = a2;
        __syncthreads();
        if (F.tid < 192) { const int r = F.tid / 64, c = F.tid % 64; float s = 0.f;
            for (int q = 0; q < 32; ++q) s += ((LAS float*)F.scr)[((q * 3 + r) * 16) * 4 + c];
            const int col = cc * 64 + c;
            ((float*)(ws + WS_MOD))[(size_t)(l * 3 + r) * (NMOD * D) + col] = s + A.in[I_ADAB][(size_t)l * NMOD * D + col]; }
        __syncthreads();
    }
    { bf16_t* w2p = (bf16_t*)(ws + WS_WL2);
      for (int i = blockIdx.x * NTHREADS + F.tid; i < 4 * 1024 * 8; i += F.G * NTHREADS) { const int o = i / 8192, c = (i / 8) % 1024, q = i % 8, d = o & 1;
          *(GAS u32x4*)(w2p + ((size_t)o * 1024 + c) * 128 + (1 - d) * 64 + q * 8) = (u32x4){0u, 0u, 0u, 0u}; } }
    LAS float* scr = (LAS float*)(F.scr) + F.wave * (64 * 65 + 63);
    const int gw = F.vcu * NWAVES + F.wave, NGW = F.G * NWAVES;
    constexpr int T_GU = 2 * NE * 16 * 32, T_DN = 2 * NE * 16 * 16, T_RKV = 3 * 256, T_WO = 256, T_L1 = 2 * 16 + 2 * 16 + 32, T_L2 = 2 * 16 + 2 * 16 + 2 * 16, T_PW = 4 * 16;
    constexpr int T_ALL = T_GU + T_DN + T_RKV + T_WO + T_L1 + T_L2 + T_PW;
    for (int it = gw; it < T_ALL; it += NGW) {
        int r = it;
        if (r < T_GU) { const int le = r / 512, q = r % 512, kb = q / 32, nb = q % 32; const int n0 = nb * 64;
            const int drow = (n0 < 1024) ? ((n0 >> 7) * 256 + (n0 & 127)) : (((n0 - 1024) >> 7) * 256 + 128 + ((n0 - 1024) & 127));
            transpose_tile_fp8(A.in[I_WGU] + (size_t)le * 1024 * 2048, 2048, kb * 64, n0, ws + WS_WGU, (size_t)le * 2048 + drow, 1024, 32.0f, scr, F.lane); continue; } r -= T_GU;
        if (r < T_DN) { const int le = r / 256, q = r % 256, kb = q / 16, nb = q % 16;
            transpose_tile_fp8(A.in[I_WDN] + (size_t)le * 1024 * 1024, 1024, kb * 64, nb * 64, ws + WS_WDN, (size_t)le * 1024 + nb * 64, 1024, 32.0f, scr, F.lane); continue; } r -= T_DN;
        if (r < T_RKV) { const int p = r / 256, q = r % 256, kb = q / 16, nb = q % 16;
            transpose_tile(A.in[I_WRKV] + (size_t)p * 1024 * 1024, 1024, kb * 64, nb * 64, (bf16_t*)(ws + WS_WRKV), (size_t)p * 1024 + nb * 64, 1024, 0, scr, F.lane); continue; } r -= T_RKV;
        if (r < T_WO) { const int kb = r / 16, nb = r % 16;
            transpose_tile(A.in[I_WO], 1024, kb * 64, nb * 64, (bf16_t*)(ws + WS_WO), (size_t)nb * 64, 1024, 0, scr, F.lane); continue; } r -= T_WO;
        if (r < T_L1) {
            if (r < 32) { const int d = r / 16, kb = r % 16; transpose_tile(A.in[I_W1] + (size_t)d * 1024 * 64, 64, kb * 64, 0, (bf16_t*)(ws + WS_WL1), (size_t)0 * 256 + d * 64, 1024, 0, scr, F.lane); continue; }
            r -= 32;
            if (r < 32) { const int d = r / 16, kb = r % 16; transpose_tile(A.in[I_A1] + (size_t)d * 1024 * 64, 64, kb * 64, 0, (bf16_t*)(ws + WS_WL1), (size_t)1 * 256 + d * 64, 1024, 0, scr, F.lane); continue; }
            r -= 32;
            { const int kb = r / 2, nb = r % 2; transpose_tile(A.in[I_G1], 128, kb * 64, nb * 64, (bf16_t*)(ws + WS_WL1), (size_t)2 * 256 + nb * 64, 1024, 0, scr, F.lane); continue; }
        } r -= T_L1;
        if (r < T_L2) {
            if (r < 32) { const int d = r / 16, nb = r % 16; transpose_tile(A.in[I_W2] + (size_t)d * 64 * 1024, 1024, 0, nb * 64, (bf16_t*)(ws + WS_WL2), (size_t)d * 1024 + nb * 64, 128, d * 64, scr, F.lane); continue; }
            r -= 32;
            if (r < 32) { const int d = r / 16, nb = r % 16; transpose_tile(A.in[I_A2] + (size_t)d * 64 * 1024, 1024, 0, nb * 64, (bf16_t*)(ws + WS_WL2), (size_t)(2 + d) * 1024 + nb * 64, 128, d * 64, scr, F.lane); continue; }
            r -= 32;
            { const int kb = r / 16, nb = r % 16; transpose_tile(A.in[I_G2], 1024, kb * 64, nb * 64, (bf16_t*)(ws + WS_WL2), (size_t)4 * 1024 + nb * 64, 128, 0, scr, F.lane); continue; }
        } r -= T_L2;
        { const int g = r / 16, q = r % 16, kb = q / 4, nb = q % 4;
          transpose_tile(A.in[I_POOLW] + (size_t)g * 256 * 256, 256, kb * 64, nb * 64, (bf16_t*)(ws + WS_WPOOL), (size_t)g * 256 + nb * 64, 256, 0, scr, F.lane); }
    }
}

__device__ __forceinline__ void phase_pre0(const Frame& F, const Args& A) {
    LAS float* hb = (LAS float*)F.scr;
    LAS float* rs = hb + 80 * 258;
    LAS float* gsc = rs + 80;
    LAS float* gsh = gsc + 256;
    bf16_t* dbuf = (bf16_t*)(F.ws + WS_DBUF);
    const float* ng = A.in[I_NORMG];
    for (int u = blockIdx.x; u < 520; u += F.G) {
        int tok0, nown = 64, hl = 0, hr = 0, L, pos0, row; const float* xsrc;
        if (u < 512) { tok0 = u * 64; L = 64; pos0 = 0; row = tok0 >> 14; xsrc = A.in[I_X] + (size_t)tok0 * D; }
        else { const int b = (u - 512) >> 2, q = (u - 512) & 3; tok0 = NL + b * CT + q * 64; L = CT; pos0 = q * 64; hl = q > 0 ? 8 : 0; hr = q < 3 ? 8 : 0; row = 2;
               xsrc = A.in[I_CTX] + (size_t)(b * CT + q * 64) * D; }
        const int nt = nown + hl + hr;
        for (int j = F.wave; j < nt; j += NWAVES) { const float* xr = xsrc + (ptrdiff_t)(j - hl) * D; float s = 0.f;
#pragma unroll
            for (int q = 0; q < 4; ++q) { const f32x4 v = *(const GAS f32x4*)(xr + 4 * F.lane + 256 * q); s += v[0] * v[0] + v[1] * v[1] + v[2] * v[2] + v[3] * v[3]; }
            s = wave_sum(s); if (F.lane == 0) rs[j] = 1.0f / sqrtf(s * (1.0f / D) + NORM_EPS); }
        for (int g = 0; g < 4; ++g) {
            __syncthreads();
            if (F.tid < 256) { const int c = g * 256 + F.tid; gsc[F.tid] = ng[c] * (1.0f + modp(F, 0, row, 1)[c]); gsh[F.tid] = modp(F, 0, row, 0)[c]; }
            __syncthreads();
            for (int i = F.tid; i < nt * 64; i += NTHREADS) { const int j = i >> 6, c4 = i & 63; const f32x4 v = *(const GAS f32x4*)(xsrc + (ptrdiff_t)(j - hl) * D + g * 256 + 4 * c4);
                const float r = rs[j]; LAS float* h = hb + j * 258 + 4 * c4;
                h[0] = v[0] * r * gsc[4 * c4 + 0] + gsh[4 * c4 + 0]; h[1] = v[1] * r * gsc[4 * c4 + 1] + gsh[4 * c4 + 1];
                h[2] = v[2] * r * gsc[4 * c4 + 2] + gsh[4 * c4 + 2]; h[3] = v[3] * r * gsc[4 * c4 + 3] + gsh[4 * c4 + 3]; }
            __syncthreads();
            const int win = 2 << g, hw = win >> 1;
            for (int i = F.tid; i < 64 * 128; i += NTHREADS) { const int cp = i & 127, t = i >> 7; const int p = pos0 + t;
                int lo = p - hw, hi = p + hw - 1; lo = lo < 0 ? 0 : lo; hi = hi > L - 1 ? L - 1 : hi;
                const int jlo = lo - (pos0 - hl), jhi = hi - (pos0 - hl);
                float s0 = 0.f, s1 = 0.f;
                for (int j = jlo; j <= jhi; ++j) { const f32x2 v = *(const LAS f32x2*)(hb + j * 258 + 2 * cp); s0 += v[0]; s1 += v[1]; }
                const float ic = 1.0f / (float)(hi - lo + 1); const f32x2 hv = *(const LAS f32x2*)(hb + (t + hl) * 258 + 2 * cp);
                *(GAS unsigned*)(dbuf + (size_t)(tok0 + t) * D + g * 256 + 2 * cp) = cvt_pk_bf16(s0 * ic - hv[0], s1 * ic - hv[1]); }
        }
        __syncthreads();
    }
}

struct SchedPool {
    static constexpr bool GATHER = false;
    int G, vcu; int nt; unsigned ldb;
    __device__ __forceinline__ bool next(int i, GU& u) const { const int L = i * G + vcu; if (L >= 130 * 4) return false; const int pm = L >> 2, g = L & 3;
        u.a = (unsigned)(WS_DBUF + ((size_t)pm * 256 * D + g * 256) * 2); u.b = (unsigned)(WS_WPOOL + (size_t)g * 256 * 256 * 2); u.i0 = pm; u.i1 = g; u.i2 = 0; u.i3 = 0; return true; }
    __device__ __forceinline__ void aoff(const GU&, const int (&R)[2], const int (&C)[2], unsigned (&v)[2][2]) const {
#pragma unroll
        for (int h = 0; h < 2; ++h)
#pragma unroll
            for (int i = 0; i < 2; ++i) v[h][i] = (unsigned)((h * 128 + R[i]) * D + C[i]) * 2u; }
};
struct EpiPool {
    static constexpr bool FP8 = false; static constexpr bool PERM = false;
    const float* x; const float* ctx; const float* ls; const float* gate_base; float* xs;
    __device__ __forceinline__ void operator()(const f32x4 (&acc)[2][2][4][2], const GU& u, int wr, int wc, int fr, int fq) const {
        const int pm = u.i0, g = u.i1; const int mrow = pm < 128 ? (pm >> 6) : 2;
        const float* gate = gate_base + (size_t)mrow * NMOD * D;
        const float* src = pm < 128 ? x + (size_t)pm * 256 * D : ctx + (size_t)(pm - 128) * 256 * D;
        const int col0 = g * 256 + wc * 32 + 4 * fq;
        f32x4 gl[2][2];
#pragma unroll
        for (int bj = 0; bj < 2; ++bj)
#pragma unroll
            for (int n = 0; n < 2; ++n) { const int c = col0 + bj * 128 + n * 16; gl[bj][n] = *(const GAS f32x4*)(gate + c) * *(const GAS f32x4*)(ls + c); }
#pragma unroll
        for (int ai = 0; ai < 2; ++ai)
#pragma unroll
            for (int m = 0; m < 4; ++m) { const int r = ai * 128 + wr * 64 + m * 16 + fr; const float* sp = src + (size_t)r * D + col0; float* op = xs + ((size_t)pm * 256 + r) * D + col0;
#pragma unroll
                for (int bj = 0; bj < 2; ++bj)
#pragma unroll
                    for (int n = 0; n < 2; ++n) *(GAS f32x4*)(op + bj * 128 + n * 16) = *(const GAS f32x4*)(sp + bj * 128 + n * 16) + gl[bj][n] * acc[ai][bj][m][n]; }
    }
};

__device__ __forceinline__ void phase_final_plain(const Frame& F, const Args& A, const float* xs) {
    const int gw = blockIdx.x * NWAVES + F.wave, NGW = F.G * NWAVES;
    for (int n = gw; n < NL; n += NGW) { const float* xr = xs + (size_t)n * D; f32x4 v[4]; float s = 0.f;
#pragma unroll
        for (int q = 0; q < 4; ++q) { v[q] = *(const GAS f32x4*)(xr + 4 * F.lane + 256 * q); s += v[q][0] * v[q][0] + v[q][1] * v[q][1] + v[q][2] * v[q][2] + v[q][3] * v[q][3]; }
        s = wave_sum(s); const float r = 1.0f / sqrtf(s * (1.0f / D) + NORM_EPS);
#pragma unroll
        for (int q = 0; q < 4; ++q) { const f32x4 g = *(const GAS f32x4*)(A.in[I_FINALG] + 4 * F.lane + 256 * q); *(GAS f32x4*)(A.out + (size_t)n * D + 4 * F.lane + 256 * q) = v[q] * r * g; }
    }
}


__device__ __forceinline__ int* cnt_word(const Frame& F, int l, int e) { return (int*)(F.ws + WS_CTL + CTL_CNT) + (l * NE + e) * 64; }
__device__ __forceinline__ void phase_post(const Frame& F, const Args& A, int l, const float* xs, int ntok) {
    LAS float* h2s = (LAS float*)F.scr;
    LAS float* part = (LAS float*)F.scr;
    LAS float* lgs = (LAS float*)(F.scr + 32 * 1028 * 4);
    LAS int* hist = (LAS int*)(lgs + 32 * 33);
    LAS int* base = hist + 32;
    LAS int* sel = base + 32;
    LAS int* lrank = sel + 128;
    unsigned char* H2 = F.ws + WS_H2;
    int* list = (int*)(F.ws + WS_LIST) + (size_t)l * NE * NTOK;
    int* tinfo = (int*)(F.ws + WS_TINFO) + (size_t)l * NTOK * 4;
    float* tgate = (float*)(F.ws + WS_TGATE) + (size_t)l * NTOK * 4;
    const float* ng = A.in[I_NORMG] + (size_t)(l * 2 + 1) * D;
    const float* rw = A.in[I_RW] + (size_t)l * D * NE;
    const float* rb = A.in[I_RB] + (size_t)l * NE;
    const int ntiles = ntok / 32;
    for (int tile = blockIdx.x; tile < ntiles; tile += F.G) {
        const int n0 = tile * 32, mrow = mrow_of(n0);
        const float* sc = modp(F, l, mrow, 4); const float* sh = modp(F, l, mrow, 3);
        if (F.tid < 32) hist[F.tid] = 0;
#pragma unroll 1
        for (int q = 0; q < 4; ++q) { const int tt = F.wave * 4 + q, n = n0 + tt; const float* xr = xs + (size_t)n * D; f32x4 v[4]; float s = 0.f;
#pragma unroll
            for (int jj = 0; jj < 4; ++jj) { v[jj] = *(const GAS f32x4*)(xr + 4 * F.lane + 256 * jj); s += v[jj][0] * v[jj][0] + v[jj][1] * v[jj][1] + v[jj][2] * v[jj][2] + v[jj][3] * v[jj][3]; }
            s = wave_sum(s); const float r = 1.0f / sqrtf(s * (1.0f / D) + NORM_EPS);
#pragma unroll
            for (int jj = 0; jj < 4; ++jj) { const int c = 4 * F.lane + 256 * jj; const f32x4 g = *(const GAS f32x4*)(ng + c), a = *(const GAS f32x4*)(sc + c), b = *(const GAS f32x4*)(sh + c);
                const f32x4 h = v[jj] * r * g * (a + 1.0f) + b;
                *(LAS f32x4*)(h2s + tt * 1028 + c) = h;
                *(GAS unsigned*)(H2 + (size_t)n * D + c) = pk4_fp8(h[0], h[1], h[2], h[3]); } }
        __syncthreads();
        f32x16 acc;
#pragma unroll
        for (int i = 0; i < 16; ++i) acc[i] = 0.f;
        { const int r = F.lane & 31, h = F.lane >> 5;
#pragma unroll 4
          for (int q = 0; q < 16; ++q) { const int kb = 128 * F.wave + 8 * q + 4 * h; const f32x4 a = *(const LAS f32x4*)(h2s + r * 1028 + kb);
              const float b0 = rw[(size_t)(kb + 0) * NE + r], b1 = rw[(size_t)(kb + 1) * NE + r], b2 = rw[(size_t)(kb + 2) * NE + r], b3 = rw[(size_t)(kb + 3) * NE + r];
              acc = __builtin_amdgcn_mfma_f32_32x32x2f32(a[0], b0, acc, 0, 0, 0); acc = __builtin_amdgcn_mfma_f32_32x32x2f32(a[1], b1, acc, 0, 0, 0);
              acc = __builtin_amdgcn_mfma_f32_32x32x2f32(a[2], b2, acc, 0, 0, 0); acc = __builtin_amdgcn_mfma_f32_32x32x2f32(a[3], b3, acc, 0, 0, 0); } }
        __syncthreads();
#pragma unroll
        for (int i = 0; i < 16; ++i) { const int row = (i & 3) + 8 * (i >> 2) + 4 * (F.lane >> 5), col = F.lane & 31; part[(F.wave * 32 + row) * 32 + col] = acc[i]; }
        __syncthreads();
        for (int i = F.tid; i < 1024; i += NTHREADS) { const int row = i >> 5, col = i & 31; float s = rb[col];
#pragma unroll
            for (int w = 0; w < 8; ++w) s += part[(w * 32 + row) * 32 + col];
            lgs[row * 33 + col] = s; }
        __syncthreads();
        if (F.tid < 32) { const int t = F.tid; float lv[32];
#pragma unroll
            for (int e = 0; e < 32; ++e) lv[e] = lgs[t * 33 + e];
            float tv[4]; int te[4];
#pragma unroll
            for (int j = 0; j < 4; ++j) { float best = -3.0e38f; int be = 0;
#pragma unroll
                for (int e = 0; e < 32; ++e) { const bool gt = lv[e] > best; best = gt ? lv[e] : best; be = gt ? e : be; }
                tv[j] = best; te[j] = be;
#pragma unroll
                for (int e = 0; e < 32; ++e) lv[e] = (e == be) ? -3.0e38f : lv[e]; }
            const float e1 = __expf(tv[1] - tv[0]), e2 = __expf(tv[2] - tv[0]), e3 = __expf(tv[3] - tv[0]); const float inv = 1.0f / (1.0f + e1 + e2 + e3);
            const float gt[4] = {inv, e1 * inv, e2 * inv, e3 * inv};
#pragma unroll
            for (int j = 0; j < 4; ++j) { sel[t * 4 + j] = te[j]; lrank[t * 4 + j] = __hip_atomic_fetch_add(&hist[te[j]], 1, __ATOMIC_RELAXED, __HIP_MEMORY_SCOPE_WORKGROUP);
                tgate[(size_t)(n0 + t) * 4 + j] = gt[j]; } }
        __syncthreads();
        if (F.tid < 32) { const int c = hist[F.tid]; base[F.tid] = c > 0 ? __hip_atomic_fetch_add(cnt_word(F, l, F.tid), c, __ATOMIC_RELAXED, __HIP_MEMORY_SCOPE_AGENT) : 0; }
        __syncthreads();
        if (F.tid < 128) { const int t = F.tid >> 2, e = sel[F.tid], pos = base[e] + lrank[F.tid]; list[(size_t)e * NTOK + pos] = n0 + t; tinfo[(size_t)(n0 + t) * 4 + (F.tid & 3)] = (e << 16) | pos; }
        __syncthreads();
    }
}

__device__ __forceinline__ void moe_prefix(const Frame& F, int l) {
    volatile LAS int* M = (volatile LAS int*)(F.lds + MISC_OFF);
    __syncthreads();
    if (F.tid == 0) { int acc = 0; for (int e = 0; e < NE; ++e) { const int c = __hip_atomic_load(cnt_word(F, l, e), __ATOMIC_RELAXED, __HIP_MEMORY_SCOPE_AGENT); M[64 + e] = c; M[16 + e] = acc; acc += (c + 255) >> 8; } M[16 + NE] = acc; }
    __syncthreads();
}

struct SchedMoe1 {
    static constexpr bool GATHER = true;
    const LAS int* M; const int* list; unsigned h2; unsigned w; int G, vcu; int nt; unsigned ldb;
    __device__ __forceinline__ bool next(int i, GU& u) const { const int L = i * G + vcu; const int tt = M[16 + NE]; if (L >= tt * 8) return false; const int mt = L >> 3, pn = L & 7;
        int e = 0; while (M[16 + e + 1] <= mt) ++e;
        u.a = h2; u.b = w + (unsigned)(((size_t)e * 2048 + pn * 256) * 1024); u.i0 = e; u.i1 = mt; u.i2 = pn; u.i3 = 0; return true; }
    __device__ __forceinline__ void aoff(const GU& u, const int (&R)[2], const int (&C)[2], unsigned (&v)[2][2]) const {
        const int e = u.i0, row0 = (u.i1 - M[16 + e]) * 256, nv = M[64 + e] - row0; const int* lp = list + (size_t)e * NTOK + row0;
#pragma unroll
        for (int h = 0; h < 2; ++h)
#pragma unroll
            for (int i = 0; i < 2; ++i) { const int r = h * 128 + R[i]; const int tok = lp[r < nv ? r : 0]; v[h][i] = (unsigned)(tok * D + 2 * C[i]); } }
};
struct EpiMoe1 {
    static constexpr bool FP8 = true; static constexpr bool PERM = true;
    const float* bgu; unsigned char* act;
    __device__ __forceinline__ void operator()(const f32x4 (&acc)[2][2][4][2], const GU& u, int wr, int wc, int fr, int fq) const {
        const int e = u.i0, mt = u.i1, pn = u.i2; const int col0 = pn * 128 + wc * 32 + 8 * fq;
        f32x4 bg[2], bu[2];
#pragma unroll
        for (int n = 0; n < 2; ++n) { bg[n] = *(const GAS f32x4*)(bgu + (size_t)e * 2048 + col0 + 4 * n); bu[n] = *(const GAS f32x4*)(bgu + (size_t)e * 2048 + 1024 + col0 + 4 * n); }
#pragma unroll
        for (int ai = 0; ai < 2; ++ai)
#pragma unroll
            for (int m = 0; m < 4; ++m) { const size_t slot = (size_t)mt * 256 + ai * 128 + wr * 64 + m * 16 + fr; float o[8];
#pragma unroll
                for (int n = 0; n < 2; ++n)
#pragma unroll
                    for (int j = 0; j < 4; ++j) { float g = acc[ai][0][m][n][j] + bg[n][j], up = acc[ai][1][m][n][j] + bu[n][j];
                        g = fminf(g, 7.0f); up = fminf(fmaxf(up, -7.0f), 7.0f); o[4 * n + j] = (up + 1.0f) * (g / (1.0f + __expf(-1.702f * g))); }
                u32x2 w; w.x = pk4_fp8(o[0], o[1], o[2], o[3]); w.y = pk4_fp8(o[4], o[5], o[6], o[7]);
                *(GAS u32x2*)(act + slot * D + col0) = w; }
    }
};
struct SchedMoe2 {
    static constexpr bool GATHER = false;
    const LAS int* M; unsigned act; unsigned w; int G, vcu; int nt; unsigned ldb;
    __device__ __forceinline__ bool next(int i, GU& u) const { const int L = i * G + vcu; const int tt = M[16 + NE]; if (L >= tt * 4) return false; const int mt = L >> 2, pn = L & 3;
        int e = 0; while (M[16 + e + 1] <= mt) ++e;
        u.a = act + (unsigned)((size_t)mt * 256 * D); u.b = w + (unsigned)(((size_t)e * 1024 + pn * 256) * 1024); u.i0 = e; u.i1 = mt; u.i2 = pn; u.i3 = 0; return true; }
    __device__ __forceinline__ void aoff(const GU&, const int (&R)[2], const int (&C)[2], unsigned (&v)[2][2]) const {
#pragma unroll
        for (int h = 0; h < 2; ++h)
#pragma unroll
            for (int i = 0; i < 2; ++i) v[h][i] = (unsigned)((h * 128 + R[i]) * D + 2 * C[i]); }
};
struct EpiMoe2 {
    static constexpr bool FP8 = true; static constexpr bool PERM = true;
    const float* bdn; bf16_t* y2;
    __device__ __forceinline__ void operator()(const f32x4 (&acc)[2][2][4][2], const GU& u, int wr, int wc, int fr, int fq) const {
        const int e = u.i0, mt = u.i1, pn = u.i2; const int col0 = pn * 256 + wc * 32 + 8 * fq;
        f32x4 bv[2][2];
#pragma unroll
        for (int bj = 0; bj < 2; ++bj)
#pragma unroll
            for (int n = 0; n < 2; ++n) bv[bj][n] = *(const GAS f32x4*)(bdn + (size_t)e * D + col0 + bj * 128 + 4 * n);
#pragma unroll
        for (int ai = 0; ai < 2; ++ai)
#pragma unroll
            for (int m = 0; m < 4; ++m) { const size_t slot = (size_t)mt * 256 + ai * 128 + wr * 64 + m * 16 + fr;
#pragma unroll
                for (int bj = 0; bj < 2; ++bj) { const f32x4 v0 = acc[ai][bj][m][0] + bv[bj][0], v1 = acc[ai][bj][m][1] + bv[bj][1];
                    u32x4 w; w.x = cvt_pk_bf16(v0[0], v0[1]); w.y = cvt_pk_bf16(v0[2], v0[3]); w.z = cvt_pk_bf16(v1[0], v1[1]); w.w = cvt_pk_bf16(v1[2], v1[3]);
                    *(GAS u32x4*)(y2 + slot * D + col0 + bj * 128) = w; } }
    }
};
__device__ __forceinline__ void phase_moe1(const Frame& F, const Args& A, int l) {
    moe_prefix(F, l);
    SchedMoe1 S{(const LAS int*)(F.lds + MISC_OFF), (const int*)(F.ws + WS_LIST) + (size_t)l * NE * NTOK, (unsigned)WS_H2, (unsigned)(WS_WGU + (size_t)l * NE * 2048 * 1024), F.G, F.vcu, 8, 1024u};
    EpiMoe1 E{A.in[I_BGU] + (size_t)l * NE * 2048, F.ws + WS_ACT};
    pg8::gemm_phase<EpiMoe1, SchedMoe1>(F.scr, F.ws, S, E);
}
__device__ __forceinline__ void phase_moe2(const Frame& F, const Args& A, int l) {
    moe_prefix(F, l);
    SchedMoe2 S{(const LAS int*)(F.lds + MISC_OFF), (unsigned)WS_ACT, (unsigned)(WS_WDN + (size_t)l * NE * 1024 * 1024), F.G, F.vcu, 8, 1024u};
    EpiMoe2 E{A.in[I_BDN] + (size_t)l * NE * D, (bf16_t*)(F.ws + WS_Y2)};
    pg8::gemm_phase<EpiMoe2, SchedMoe2>(F.scr, F.ws, S, E);
}
__device__ __forceinline__ void moe_combine_row(const Frame& F, int l, int n, f32x4 (&o)[4]) {
    const volatile LAS int* M = (const volatile LAS int*)(F.lds + MISC_OFF);
    const int* ti = (const int*)(F.ws + WS_TINFO) + ((size_t)l * NTOK + n) * 4; const float* tg = (const float*)(F.ws + WS_TGATE) + ((size_t)l * NTOK + n) * 4;
    const bf16_t* y2 = (const bf16_t*)(F.ws + WS_Y2);
#pragma unroll
    for (int q = 0; q < 4; ++q) o[q] = (f32x4){0.f, 0.f, 0.f, 0.f};
#pragma unroll
    for (int j = 0; j < 4; ++j) { const int inf = ti[j]; const float g = tg[j]; const int e = inf >> 16, pos = inf & 0xffff; const size_t slot = (size_t)M[16 + e] * 256 + pos;
#pragma unroll
        for (int q = 0; q < 4; ++q) { const u32x2 w = *(const GAS u32x2*)(y2 + slot * D + 4 * F.lane + 256 * q);
            o[q] += (f32x4){bf_lo(w.x), bf_hi(w.x), bf_lo(w.y), bf_hi(w.y)} * g; } }
}
__device__ __forceinline__ void phase_final(const Frame& F, const Args& A, int l, const float* xs) {
    moe_prefix(F, l);
    const int gw = blockIdx.x * NWAVES + F.wave, NGW = F.G * NWAVES;
    for (int n = gw; n < NL; n += NGW) { const float* xr = xs + (size_t)n * D; const float* gate = modp(F, l, n >> 14, 5); f32x4 v[4], mo[4]; float s = 0.f;
        moe_combine_row(F, l, n, mo);
#pragma unroll
        for (int q = 0; q < 4; ++q) { const int c = 4 * F.lane + 256 * q; v[q] = *(const GAS f32x4*)(xr + c) + *(const GAS f32x4*)(gate + c) * mo[q]; s += v[q][0] * v[q][0] + v[q][1] * v[q][1] + v[q][2] * v[q][2] + v[q][3] * v[q][3]; }
        s = wave_sum(s); const float r = 1.0f / sqrtf(s * (1.0f / D) + NORM_EPS);
#pragma unroll
        for (int q = 0; q < 4; ++q) { const f32x4 g = *(const GAS f32x4*)(A.in[I_FINALG] + 4 * F.lane + 256 * q); *(GAS f32x4*)(A.out + (size_t)n * D + 4 * F.lane + 256 * q) = v[q] * r * g; }
    }
}


__device__ __forceinline__ void phase_pre1(const Frame& F, const Args& A) {
    moe_prefix(F, 0);
    LAS float* hs = (LAS float*)F.scr;
    const float* xs0 = (const float*)(F.ws + WS_XS0); float* xs1 = (float*)(F.ws + WS_XS1);
    const float* ng = A.in[I_NORMG] + (size_t)(1 * 2 + 0) * D;
    for (int tile = blockIdx.x; tile < NTOK / 32; tile += F.G) {
        const int n0 = tile * 32, mrow = mrow_of(n0);
        const int sbeg = n0 < NL ? (n0 & ~(TSEQ - 1)) : (NL + ((n0 - NL) & ~(CT - 1))), send = sbeg + (n0 < NL ? TSEQ : CT);
        const float* gate5 = modp(F, 0, mrow, 5); const float* sc = modp(F, 1, mrow, 1); const float* sh = modp(F, 1, mrow, 0);
        for (int j = F.wave; j < 34; j += NWAVES) { const int n = n0 - 1 + j;
            if (n < sbeg || n >= send) {
#pragma unroll
                for (int q = 0; q < 4; ++q) *(LAS f32x4*)(hs + j * 1028 + 4 * F.lane + 256 * q) = (f32x4){0.f, 0.f, 0.f, 0.f};
                continue; }
            f32x4 mo[4], v[4]; float s = 0.f; moe_combine_row(F, 0, n, mo);
#pragma unroll
            for (int q = 0; q < 4; ++q) { const int c = 4 * F.lane + 256 * q; v[q] = *(const GAS f32x4*)(xs0 + (size_t)n * D + c) + *(const GAS f32x4*)(gate5 + c) * mo[q];
                s += v[q][0] * v[q][0] + v[q][1] * v[q][1] + v[q][2] * v[q][2] + v[q][3] * v[q][3]; }
            if (j >= 1 && j <= 32) {
#pragma unroll
                for (int q = 0; q < 4; ++q) *(GAS f32x4*)(xs1 + (size_t)n * D + 4 * F.lane + 256 * q) = v[q]; }
            s = wave_sum(s); const float r = 1.0f / sqrtf(s * (1.0f / D) + NORM_EPS);
#pragma unroll
            for (int q = 0; q < 4; ++q) { const int c = 4 * F.lane + 256 * q; const f32x4 g = *(const GAS f32x4*)(ng + c), a = *(const GAS f32x4*)(sc + c), b = *(const GAS f32x4*)(sh + c);
                *(LAS f32x4*)(hs + j * 1028 + c) = v[q] * r * g * (a + 1.0f) + b; } }
        __syncthreads();
#pragma unroll 1
        for (int q4 = 0; q4 < 4; ++q4) { const int t = F.wave * 4 + q4, j = t + 1, n = n0 + t;
#pragma unroll
            for (int q = 0; q < 4; ++q) { const int c = 4 * F.lane + 256 * q;
                const f32x4 hm = *(const LAS f32x4*)(hs + (j - 1) * 1028 + c), h0 = *(const LAS f32x4*)(hs + j * 1028 + c), hp = *(const LAS f32x4*)(hs + (j + 1) * 1028 + c);
                const f32x4 xx = (hm + hp) * 0.5f - h0;
#pragma unroll
                for (int i = 0; i < 6; ++i) { const f32x4 mu = *(const GAS f32x4*)(A.in[I_MU] + (size_t)i * D + c); const f32x4 o = h0 + xx * mu;
                    u32x2 w; w.x = cvt_pk_bf16(o[0], o[1]); w.y = cvt_pk_bf16(o[2], o[3]);
                    *(GAS u32x2*)((bf16_t*)(F.ws + WS_MIX + (size_t)i * ACTB) + (size_t)n * D + c) = w; } } }
        __syncthreads();
    }
}

struct SchedProj {
    static constexpr bool GATHER = false;
    int G, vcu; int nt; unsigned ldb;
    __device__ __forceinline__ bool next(int i, GU& u) const { int L = i * G + vcu; if (L >= 1940) return false;
        int kind, mi, wi, pm, pn;
        if (L < 512) { kind = 0; mi = 0; wi = 0; pm = L >> 2; pn = L & 3; }
        else if (L < 1032) { L -= 512; kind = 0; mi = 2; wi = 1; pm = L >> 2; pn = L & 3; }
        else if (L < 1552) { L -= 1032; kind = 0; mi = 3; wi = 2; pm = L >> 2; pn = L & 3; }
        else if (L < 1682) { L -= 1552; kind = 1; mi = 1; wi = 0; pm = L; pn = 0; }
        else if (L < 1812) { L -= 1682; kind = 2; mi = 4; wi = 1; pm = L; pn = 0; }
        else { L -= 1812; kind = 3; mi = 5; wi = 2; pm = L; pn = 0; }
        u.a = (unsigned)(WS_MIX + (size_t)mi * ACTB + (size_t)pm * 256 * D * 2);
        u.b = kind == 0 ? (unsigned)(WS_WRKV + ((size_t)wi * 1024 + pn * 256) * 1024 * 2) : (unsigned)(WS_WL1 + (size_t)wi * 256 * 1024 * 2);
        u.i0 = pm; u.i1 = pn; u.i2 = kind; u.i3 = wi; return true; }
    __device__ __forceinline__ void aoff(const GU&, const int (&R)[2], const int (&C)[2], unsigned (&v)[2][2]) const {
#pragma unroll
        for (int h = 0; h < 2; ++h)
#pragma unroll
            for (int i = 0; i < 2; ++i) v[h][i] = (unsigned)((h * 128 + R[i]) * D + C[i]) * 2u; }
};
struct EpiProj {
    static constexpr bool FP8 = false; static constexpr bool PERM = true;
    unsigned char* ws;
    __device__ __forceinline__ void operator()(const f32x4 (&acc)[2][2][4][2], const GU& u, int wr, int wc, int fr, int fq) const {
        const int pm = u.i0, pn = u.i1, kind = u.i2, wi = u.i3;
        if (kind == 0) { bf16_t* o = (bf16_t*)(ws + WS_RKV + (size_t)wi * ACTB); const int col0 = pn * 256 + wc * 32 + 8 * fq;
#pragma unroll
            for (int ai = 0; ai < 2; ++ai)
#pragma unroll
                for (int m = 0; m < 4; ++m) { const size_t n = (size_t)pm * 256 + ai * 128 + wr * 64 + m * 16 + fr;
#pragma unroll
                    for (int bj = 0; bj < 2; ++bj) { const f32x4 v0 = acc[ai][bj][m][0], v1 = acc[ai][bj][m][1];
                        u32x4 w; w.x = cvt_pk_bf16(v0[0], v0[1]); w.y = cvt_pk_bf16(v0[2], v0[3]); w.z = cvt_pk_bf16(v1[0], v1[1]); w.w = cvt_pk_bf16(v1[2], v1[3]);
                        *(GAS u32x4*)(o + n * D + col0 + bj * 128) = w; } }
        } else { bf16_t* o = (bf16_t*)(ws + WS_LACT + (size_t)(kind - 1) * NTOK * 128 * 2); const int col0 = wc * 32 + 8 * fq;
#pragma unroll
            for (int ai = 0; ai < 2; ++ai)
#pragma unroll
                for (int m = 0; m < 4; ++m) { const size_t n = (size_t)pm * 256 + ai * 128 + wr * 64 + m * 16 + fr; float t[8];
#pragma unroll
                    for (int nn = 0; nn < 2; ++nn)
#pragma unroll
                        for (int j = 0; j < 4; ++j) { const float x = acc[ai][0][m][nn][j]; t[4 * nn + j] = kind == 1 ? tanhf(x) : (kind == 2 ? x : sigmoidf_(x)); }
                    u32x4 w; w.x = cvt_pk_bf16(t[0], t[1]); w.y = cvt_pk_bf16(t[2], t[3]); w.z = cvt_pk_bf16(t[4], t[5]); w.w = cvt_pk_bf16(t[6], t[7]);
                    *(GAS u32x4*)(o + n * 128 + col0) = w; } }
    }
};
struct SchedLora2 {
    static constexpr bool GATHER = false;
    int G, vcu; int nt; unsigned ldb;
    __device__ __forceinline__ bool next(int i, GU& u) const { int L = i * G + vcu; if (L >= 4 * 520 + 512) return false;
        const int o = L < 2080 ? L / 520 : 4; L -= o * 520; const int pm = L >> 2, pn = L & 3; const int oa = o < 4 ? (o >> 1) : 2;
        u.a = (unsigned)(WS_LACT + (size_t)oa * NTOK * 128 * 2 + (size_t)pm * 256 * 128 * 2); u.b = (unsigned)(WS_WL2 + ((size_t)o * 1024 + pn * 256) * 128 * 2);
        u.i0 = pm; u.i1 = pn; u.i2 = o; u.i3 = 0; return true; }
    __device__ __forceinline__ void aoff(const GU&, const int (&R)[2], const int (&C)[2], unsigned (&v)[2][2]) const {
#pragma unroll
        for (int h = 0; h < 2; ++h)
#pragma unroll
            for (int i = 0; i < 2; ++i) v[h][i] = (unsigned)((h * 128 + R[i]) * 128 + C[i]) * 2u; }
};
struct EpiLora2 {
    static constexpr bool FP8 = false; static constexpr bool PERM = false;
    unsigned char* ws; const float* w0; const float* a0;
    __device__ __forceinline__ void operator()(const f32x4 (&acc)[2][2][4][2], const GU& u, int wr, int wc, int fr, int fq) const {
        const int pm = u.i0, pn = u.i1, o = u.i2; const int col0 = pn * 256 + wc * 32 + 4 * fq;
        const float* bp = (o < 2 ? w0 + (size_t)o * D : a0 + (size_t)(o & 1) * D) + col0; const float bsc = o < 4 ? 1.0f : 0.0f;
        f32x4 bv[2][2];
#pragma unroll
        for (int bj = 0; bj < 2; ++bj)
#pragma unroll
            for (int n = 0; n < 2; ++n) bv[bj][n] = *(const GAS f32x4*)(bp + bj * 128 + n * 16) * bsc;
        const size_t row0 = (size_t)pm * 256 + wr * 64 + fr;
        if (o < 2) { float* dst = (float*)(ws + WS_DEC) + ((size_t)o * NTOK + row0) * D + col0;
#pragma unroll
            for (int ai = 0; ai < 2; ++ai)
#pragma unroll
                for (int m = 0; m < 4; ++m)
#pragma unroll
                    for (int bj = 0; bj < 2; ++bj)
#pragma unroll
                        for (int nn = 0; nn < 2; ++nn) { const f32x4 z = acc[ai][bj][m][nn] + bv[bj][nn]; f32x4 d;
#pragma unroll
                            for (int j = 0; j < 4; ++j) d[j] = __expf(-0.60653066f * sigmoidf_(z[j]));
                            *(GAS f32x4*)(dst + (size_t)(ai * 128 + m * 16) * D + bj * 128 + nn * 16) = d; }
        } else { bf16_t* dst = (o < 4 ? (bf16_t*)(ws + WS_ICL + (size_t)(o - 2) * ACTB) : (bf16_t*)(ws + WS_G)) + row0 * D + col0; const bool sg = o < 4;
#pragma unroll
            for (int ai = 0; ai < 2; ++ai)
#pragma unroll
                for (int m = 0; m < 4; ++m)
#pragma unroll
                    for (int bj = 0; bj < 2; ++bj)
#pragma unroll
                        for (int nn = 0; nn < 2; ++nn) { f32x4 z = acc[ai][bj][m][nn] + bv[bj][nn];
#pragma unroll
                            for (int j = 0; j < 4; ++j) z[j] = sg ? sigmoidf_(z[j]) : z[j];
                            u32x2 w; w.x = cvt_pk_bf16(z[0], z[1]); w.y = cvt_pk_bf16(z[2], z[3]);
                            *(GAS u32x2*)(dst + (size_t)(ai * 128 + m * 16) * D + bj * 128 + nn * 16) = w; }
        }
    }
};
__device__ __forceinline__ void ld16bf(const bf16_t* p, float (&o)[16]) { const u32x4 a = *(const GAS u32x4*)p, b = *(const GAS u32x4*)(p + 8);
    o[0] = bf_lo(a.x); o[1] = bf_hi(a.x); o[2] = bf_lo(a.y); o[3] = bf_hi(a.y); o[4] = bf_lo(a.z); o[5] = bf_hi(a.z); o[6] = bf_lo(a.w); o[7] = bf_hi(a.w);
    o[8] = bf_lo(b.x); o[9] = bf_hi(b.x); o[10] = bf_lo(b.y); o[11] = bf_hi(b.y); o[12] = bf_lo(b.z); o[13] = bf_hi(b.z); o[14] = bf_lo(b.w); o[15] = bf_hi(b.w); }
__device__ __forceinline__ void st16bf(bf16_t* p, const float (&o)[16]) { u32x4 a, b;
    a.x = cvt_pk_bf16(o[0], o[1]); a.y = cvt_pk_bf16(o[2], o[3]); a.z = cvt_pk_bf16(o[4], o[5]); a.w = cvt_pk_bf16(o[6], o[7]);
    b.x = cvt_pk_bf16(o[8], o[9]); b.y = cvt_pk_bf16(o[10], o[11]); b.z = cvt_pk_bf16(o[12], o[13]); b.w = cvt_pk_bf16(o[14], o[15]);
    *(GAS u32x4*)p = a; *(GAS u32x4*)(p + 8) = b; }
__device__ __forceinline__ void ld16f(const float* p, float (&o)[16]) {
#pragma unroll
    for (int q = 0; q < 4; ++q) { const f32x4 v = *(const GAS f32x4*)(p + 4 * q); o[4 * q] = v[0]; o[4 * q + 1] = v[1]; o[4 * q + 2] = v[2]; o[4 * q + 3] = v[3]; } }
__device__ __forceinline__ void phase_fin(const Frame& F, const Args& A) {
    const int gw = blockIdx.x * NWAVES + F.wave, NGW = F.G * NWAVES; const int c0 = 16 * F.lane;
    float kkw[16], kaw[16]; ld16f(A.in[I_KK] + c0, kkw); ld16f(A.in[I_KA] + c0, kaw);
    const bf16_t* Kp = (const bf16_t*)(F.ws + WS_RKV + 1 * ACTB);
    for (int n = gw; n < NTOK; n += NGW) { const size_t off = (size_t)n * D + c0; float k[16], i0[16], i1[16], kk[16], o[16];
        ld16bf(Kp + off, k); ld16bf((const bf16_t*)(F.ws + WS_ICL) + off, i0); ld16bf((const bf16_t*)(F.ws + WS_ICL + ACTB) + off, i1);
        float ss = 0.f;
#pragma unroll
        for (int j = 0; j < 16; ++j) { kk[j] = k[j] * kkw[j]; ss += kk[j] * kk[j]; }
        ss += __shfl_xor(ss, 1); ss += __shfl_xor(ss, 2);
        const float inv = 1.0f / fmaxf(sqrtf(ss), 1e-12f);
#pragma unroll
        for (int j = 0; j < 16; ++j) kk[j] *= inv;
        st16bf((bf16_t*)(F.ws + WS_KK) + off, kk);
#pragma unroll
        for (int j = 0; j < 16; ++j) o[j] = k[j] * (1.0f + (i0[j] - 1.0f) * kaw[j]);
        st16bf((bf16_t*)(F.ws + WS_KDIR) + off, o);
#pragma unroll
        for (int j = 0; j < 16; ++j) o[j] = k[j] * (1.0f + (i1[j] - 1.0f) * kaw[j]);
        st16bf((bf16_t*)(F.ws + WS_KDIR + ACTB) + off, o);
#pragma unroll
        for (int j = 0; j < 16; ++j) o[j] = kk[j] * i0[j];
        st16bf((bf16_t*)(F.ws + WS_BV) + off, o);
#pragma unroll
        for (int j = 0; j < 16; ++j) o[j] = kk[j] * i1[j];
        st16bf((bf16_t*)(F.ws + WS_BV + ACTB) + off, o);
    }
}
__device__ __forceinline__ float dpp_add(float v, const int ctrl_sel) {
    const int x = __builtin_bit_cast(int, v); int y;
    if (ctrl_sel == 0) y = __builtin_amdgcn_update_dpp(0, x, 0xB1, 0xF, 0xF, true);
    else if (ctrl_sel == 1) y = __builtin_amdgcn_update_dpp(0, x, 0x4E, 0xF, 0xF, true);
    else if (ctrl_sel == 2) y = __builtin_amdgcn_update_dpp(0, x, 0x141, 0xF, 0xF, true);
    else y = __builtin_amdgcn_update_dpp(0, x, 0x140, 0xF, 0xF, true);
    return v + __builtin_bit_cast(float, y);
}
__device__ __forceinline__ float red16(float v) { v = dpp_add(v, 0); v = dpp_add(v, 1); v = dpp_add(v, 2); v = dpp_add(v, 3); return v; }
constexpr int SCS = 16, SNS = CT + TSEQ, SNCH = SNS / SCS;
constexpr int SB_V = 5 * SCS * 64, SB_Y = SB_V + SCS * 16, SBUF_FLOATS = SB_Y + SCS * 256;
__device__ __forceinline__ int scan_token(int sg, int d, int b) { if (sg < CT) { const int t = d ? (CT - 1 - sg) : sg; return NL + b * CT + t; } const int u = sg - CT; const int t = d ? (TSEQ - 1 - u) : u; return b * TSEQ + t; }
struct ScanRegs { f32x4 dec; u32x2 a[4]; u32x2 v; };
__device__ __forceinline__ void scan_issue(const Frame& F, ScanRegs& R, int ch, int d, int b, int hd, int rq) {
    const int lt = F.tid - 256, s = lt >> 4, p = lt & 15; const int sg = ch * SCS + s; const int n = scan_token(sg, d, b); const size_t off = (size_t)n * D + hd * 64 + 4 * p;
    R.dec = *(const GAS f32x4*)((const float*)(F.ws + WS_DEC) + (size_t)d * NTOK * D + off);
    R.a[0] = *(const GAS u32x2*)((const bf16_t*)(F.ws + WS_KDIR + (size_t)d * ACTB) + off);
    R.a[1] = *(const GAS u32x2*)((const bf16_t*)(F.ws + WS_KK) + off);
    R.a[2] = *(const GAS u32x2*)((const bf16_t*)(F.ws + WS_BV + (size_t)d * ACTB) + off);
    R.a[3] = (sg >= CT) ? *(const GAS u32x2*)((const bf16_t*)(F.ws + WS_RKV) + off) : (u32x2){0u, 0u};
    R.v = *(const GAS u32x2*)((const bf16_t*)(F.ws + WS_RKV + 2 * ACTB) + (size_t)n * D + hd * 64 + rq * 16 + 4 * (p & 3));
}
__device__ __forceinline__ void scan_write(const Frame& F, const ScanRegs& R, LAS float* buf) {
    const int lt = F.tid - 256, s = lt >> 4, p = lt & 15;
    *(LAS f32x4*)(buf + (0 * SCS + s) * 64 + 4 * p) = R.dec;
#pragma unroll
    for (int v = 0; v < 4; ++v) *(LAS f32x4*)(buf + ((v + 1) * SCS + s) * 64 + 4 * p) = (f32x4){bf_lo(R.a[v].x), bf_hi(R.a[v].x), bf_lo(R.a[v].y), bf_hi(R.a[v].y)};
    if (p < 4) *(LAS f32x4*)(buf + SB_V + s * 16 + 4 * p) = (f32x4){bf_lo(R.v.x), bf_hi(R.v.x), bf_lo(R.v.y), bf_hi(R.v.y)};
}
__device__ __forceinline__ void scan_store_chunk(const Frame& F, const LAS float* buf, int ch, int d, int b, int hd, int rq) {
    const int lt = F.tid - 256, s = lt >> 4, row = lt & 15; const int sg = ch * SCS + s;
    const LAS float* yp = buf + SB_Y + s * 256 + (row >> 2) * 64 + (row & 3) * 16;
    const f32x4 a = *(const LAS f32x4*)yp, b4 = *(const LAS f32x4*)(yp + 4), c = *(const LAS f32x4*)(yp + 8), e = *(const LAS f32x4*)(yp + 12);
    const f32x4 t = (a + b4) + (c + e); const float y = (t[0] + t[1]) + (t[2] + t[3]);
    const float y2 = __shfl_down(y, 1);
    if (sg >= CT && (row & 1) == 0) { const int n = scan_token(sg, d, b);
        *(GAS unsigned*)((bf16_t*)(F.ws + WS_YD + (size_t)d * NL * D * 2) + (size_t)n * D + hd * 64 + rq * 16 + row) = cvt_pk_bf16(y, y2); }
}
struct ScanOps { f32x4 w, kd, kk, bv, r; float v; };
__device__ __forceinline__ void scan_ld(ScanOps& o, const LAS float* buf, int s, int kg, int vrow) {
    o.w = *(const LAS f32x4*)(buf + (0 * SCS + s) * 64 + 4 * kg); o.kd = *(const LAS f32x4*)(buf + (1 * SCS + s) * 64 + 4 * kg); o.kk = *(const LAS f32x4*)(buf + (2 * SCS + s) * 64 + 4 * kg);
    o.bv = *(const LAS f32x4*)(buf + (3 * SCS + s) * 64 + 4 * kg); o.r = *(const LAS f32x4*)(buf + (4 * SCS + s) * 64 + 4 * kg); o.v = buf[SB_V + s * 16 + vrow];
}
__device__ __forceinline__ void scan_step(const ScanOps& o, f32x2& s01, f32x2& s23, LAS float* yp) {
    const f32x2 p = s01 * (f32x2){o.kk[0], o.kk[1]} + s23 * (f32x2){o.kk[2], o.kk[3]};
    const float sa = red16(p[0] + p[1]);
    const f32x2 t01 = (f32x2){o.kd[0], o.kd[1]} * o.v - (f32x2){o.bv[0], o.bv[1]} * sa, t23 = (f32x2){o.kd[2], o.kd[3]} * o.v - (f32x2){o.bv[2], o.bv[3]} * sa;
    s01 = s01 * (f32x2){o.w[0], o.w[1]} + t01; s23 = s23 * (f32x2){o.w[2], o.w[3]} + t23;
    const f32x2 q = s01 * (f32x2){o.r[0], o.r[1]} + s23 * (f32x2){o.r[2], o.r[3]};
    *yp = q[0] + q[1];
}
__device__ __forceinline__ void phase_scan(const Frame& F, const Args& A) {
    LAS float* bufs = (LAS float*)F.scr;
    for (int job = F.vcu; job < 256; job += F.G) {
        const int sd = job >> 2, rq = job & 3, d = sd & 1, bh = sd >> 1, b = bh >> 4, hd = bh & 15;
        const int kg = F.lane & 15, rho = F.lane >> 4;
        f32x2 s01 = {0.f, 0.f}, s23 = {0.f, 0.f};
        ScanRegs RA, RB;
        __syncthreads();
        if (F.tid >= 256) { scan_issue(F, RA, 0, d, b, hd, rq); scan_write(F, RA, bufs); scan_issue(F, RA, 1, d, b, hd, rq); scan_issue(F, RB, 2, d, b, hd, rq); }
        __syncthreads();
#define SCAN_ITER(ch, RR) do { \
            LAS float* buf = bufs + ((ch) & 1) * SBUF_FLOATS; \
            if (F.tid >= 256) { \
                if ((ch) > 0) scan_store_chunk(F, bufs + (((ch) - 1) & 1) * SBUF_FLOATS, (ch) - 1, d, b, hd, rq); \
                if ((ch) + 1 < SNCH) scan_write(F, RR, bufs + (((ch) + 1) & 1) * SBUF_FLOATS); \
                if ((ch) + 3 < SNCH) scan_issue(F, RR, (ch) + 3, d, b, hd, rq); \
            } else { \
                const int vrow = 4 * F.wave + rho; LAS float* yp = buf + SB_Y + F.wave * 64 + F.lane; \
                ScanOps o0, o1; scan_ld(o0, buf, 0, kg, vrow); \
                _Pragma("unroll") for (int s = 0; s < SCS; s += 2) { \
                    scan_ld(o1, buf, s + 1, kg, vrow); \
                    scan_step(o0, s01, s23, yp + s * 256); \
                    if (s + 2 < SCS) scan_ld(o0, buf, s + 2, kg, vrow); \
                    scan_step(o1, s01, s23, yp + (s + 1) * 256); \
                } \
            } \
            __syncthreads(); } while (0)
        for (int ch = 0; ch < SNCH; ch += 2) { SCAN_ITER(ch, RA); SCAN_ITER(ch + 1, RB); }
#undef SCAN_ITER
        if (F.tid >= 256) scan_store_chunk(F, bufs + ((SNCH - 1) & 1) * SBUF_FLOATS, SNCH - 1, d, b, hd, rq);
    }
}
__device__ __forceinline__ void phase_readout(const Frame& F, const Args& A) {
    const int gw = blockIdx.x * NWAVES + F.wave, NGW = F.G * NWAVES; const int c0 = 16 * F.lane;
    float lng[16], lnb[16], rk[16]; ld16f(A.in[I_LNG] + c0, lng); ld16f(A.in[I_LNB] + c0, lnb); ld16f(A.in[I_RK] + c0, rk);
    for (int n = gw; n < NL; n += NGW) { const size_t off = (size_t)n * D + c0; float y[16], t[16], r[16], kd[16], v[16], g[16], o[16];
        ld16bf((const bf16_t*)(F.ws + WS_YD) + off, y); ld16bf((const bf16_t*)(F.ws + WS_YD + (size_t)NL * D * 2) + off, t);
        float s = 0.f;
#pragma unroll
        for (int j = 0; j < 16; ++j) { y[j] += t[j]; s += y[j]; }
        s += __shfl_xor(s, 1); s += __shfl_xor(s, 2); const float m = s * (1.0f / 64.0f); float q = 0.f;
#pragma unroll
        for (int j = 0; j < 16; ++j) { y[j] -= m; q += y[j] * y[j]; }
        q += __shfl_xor(q, 1); q += __shfl_xor(q, 2); const float rs = 1.0f / sqrtf(q * (1.0f / 64.0f) + GN_EPS);
        ld16bf((const bf16_t*)(F.ws + WS_RKV) + off, r); ld16bf((const bf16_t*)(F.ws + WS_KDIR) + off, kd); ld16bf((const bf16_t*)(F.ws + WS_KDIR + ACTB) + off, t);
        float bs = 0.f;
#pragma unroll
        for (int j = 0; j < 16; ++j) bs += r[j] * (kd[j] + t[j]) * rk[j];
        bs += __shfl_xor(bs, 1); bs += __shfl_xor(bs, 2);
        ld16bf((const bf16_t*)(F.ws + WS_RKV + 2 * ACTB) + off, v); ld16bf((const bf16_t*)(F.ws + WS_G) + off, g);
#pragma unroll
        for (int j = 0; j < 16; ++j) o[j] = (y[j] * rs * lng[j] + lnb[j] + bs * v[j]) * g[j];
        st16bf((bf16_t*)(F.ws + WS_RO) + off, o);
    }
}
struct SchedWo {
    static constexpr bool GATHER = false;
    int G, vcu; int nt; unsigned ldb;
    __device__ __forceinline__ bool next(int i, GU& u) const { const int L = i * G + vcu; if (L >= 512) return false; const int pm = L >> 2, pn = L & 3;
        u.a = (unsigned)(WS_RO + (size_t)pm * 256 * D * 2); u.b = (unsigned)(WS_WO + (size_t)pn * 256 * 1024 * 2); u.i0 = pm; u.i1 = pn; u.i2 = 0; u.i3 = 0; return true; }
    __device__ __forceinline__ void aoff(const GU&, const int (&R)[2], const int (&C)[2], unsigned (&v)[2][2]) const {
#pragma unroll
        for (int h = 0; h < 2; ++h)
#pragma unroll
            for (int i = 0; i < 2; ++i) v[h][i] = (unsigned)((h * 128 + R[i]) * D + C[i]) * 2u; }
};
struct EpiWo {
    static constexpr bool FP8 = false; static constexpr bool PERM = false;
    const float* xin; float* xout; const float* gate_base;
    __device__ __forceinline__ void operator()(const f32x4 (&acc)[2][2][4][2], const GU& u, int wr, int wc, int fr, int fq) const {
        const int pm = u.i0, pn = u.i1; const float* gate = gate_base + (size_t)(pm >> 6) * NMOD * D; const int col0 = pn * 256 + wc * 32 + 4 * fq;
        f32x4 gl[2][2];
#pragma unroll
        for (int bj = 0; bj < 2; ++bj)
#pragma unroll
            for (int n = 0; n < 2; ++n) gl[bj][n] = *(const GAS f32x4*)(gate + col0 + bj * 128 + n * 16);
#pragma unroll
        for (int ai = 0; ai < 2; ++ai)
#pragma unroll
            for (int m = 0; m < 4; ++m) { const size_t off = ((size_t)pm * 256 + ai * 128 + wr * 64 + m * 16 + fr) * D + col0;
#pragma unroll
                for (int bj = 0; bj < 2; ++bj)
#pragma unroll
                    for (int n = 0; n < 2; ++n) *(GAS f32x4*)(xout + off + bj * 128 + n * 16) = *(const GAS f32x4*)(xin + off + bj * 128 + n * 16) + gl[bj][n] * acc[ai][bj][m][n]; }
    }
};

constexpr int NPHASES = 3;
__global__ void __launch_bounds__(NTHREADS, 2) fwd_kernel(Args args) {
    extern __shared__ __attribute__((aligned(16))) unsigned char lds_raw[];
    Frame F;
    F.lds = (LAS unsigned char*)lds_raw; F.scr = F.lds + SCR_OFF; F.ws = args.ws;
    F.tid = threadIdx.x; F.lane = F.tid & 63; F.wave = __builtin_amdgcn_readfirstlane(F.tid >> 6);
    F.G = gridDim.x; { const int bx = blockIdx.x; F.vcu = (F.G % 8 == 0) ? (bx % 8) * (F.G / 8) + bx / 8 : bx; }
    volatile LAS unsigned* MISC = (volatile LAS unsigned*)(F.lds + MISC_OFF);
    if (F.tid < 64) MISC[F.tid] = 0u;
    __syncthreads();
    const int lo = args.ph_lo, hi = args.ph_hi;
    XcdBarrier bar; bar.bar = (unsigned*)(F.ws + WS_CTL); bar.x = 0; bar.st = MISC + 8;
    if (hi - lo > 1) bar = xcd_barrier_post((unsigned*)(F.ws + WS_CTL), MISC + 8);
#define IN(k) (lo <= (k) && (k) < hi)
#define SEAM(k) do { if (IN(k) && IN((k) + 1)) xcd_barrier(bar); } while (0)
#define PH(k, ...) do { if (IN(k)) { __VA_ARGS__; if constexpr (((REPEAT_MASK >> (k)) & 1) != 0) { xcd_barrier(bar); __VA_ARGS__; } } SEAM(k); } while (0)
    PH(0, phase_prep(F, args));
    PH(1, phase_pre0(F, args));
    PH(2, { SchedPool S{F.G, F.vcu, 4, 512u};
            EpiPool E{args.in[I_X], args.in[I_CTX], args.in[I_POOLLS], modp(F, 0, 0, 2), (float*)(F.ws + WS_XS0)};
            pg8::gemm_phase<EpiPool, SchedPool>(F.scr, F.ws, S, E); });
    PH(3, phase_post(F, args, 0, (const float*)(F.ws + WS_XS0), NTOK));
    PH(4, phase_moe1(F, args, 0));
    PH(5, phase_moe2(F, args, 0));
    PH(6, phase_pre1(F, args));
    PH(7, { SchedProj S{F.G, F.vcu, 16, 2048u}; EpiProj E{F.ws}; pg8::gemm_phase<EpiProj, SchedProj>(F.scr, F.ws, S, E); });
    PH(8, { SchedLora2 S{F.G, F.vcu, 2, 256u}; EpiLora2 E{F.ws, args.in[I_W0], args.in[I_A0]}; pg8::gemm_phase<EpiLora2, SchedLora2>(F.scr, F.ws, S, E); });
    PH(9, phase_fin(F, args));
    PH(10, phase_scan(F, args));
    PH(11, phase_readout(F, args));
    PH(12, { SchedWo S{F.G, F.vcu, 16, 2048u}; EpiWo E{(const float*)(F.ws + WS_XS1), (float*)(F.ws + WS_XS0), modp(F, 1, 0, 2)}; pg8::gemm_phase<EpiWo, SchedWo>(F.scr, F.ws, S, E); });
    PH(13, phase_post(F, args, 1, (const float*)(F.ws + WS_XS0), NL));
    PH(14, phase_moe1(F, args, 1));
    PH(15, phase_moe2(F, args, 1));
    PH(16, phase_final(F, args, 1, (const float*)(F.ws + WS_XS0)));
#undef PH
#undef SEAM
#undef IN
}

extern "C" void kernel_launch(void* const* d_in, const int* in_sizes, int n_in, void* d_out, int out_size, void* d_ws, size_t ws_size, hipStream_t stream) {
    static int grid = 0;
    if (grid == 0) {
        if (n_in != 32 || ws_size < WS_END) { fprintf(stderr, "kernel_launch: unexpected n_in %d / ws %zu (need %zu)\n", n_in, ws_size, (size_t)WS_END); grid = -1; return; }
        int dev = 0, cus = 0;
        if (hipGetDevice(&dev) != hipSuccess || hipDeviceGetAttribute(&cus, hipDeviceAttributeMultiprocessorCount, dev) != hipSuccess) { grid = -1; return; }
        if (hipFuncSetAttribute((const void*)fwd_kernel, hipFuncAttributeMaxDynamicSharedMemorySize, LDS_BYTES) != hipSuccess) { fprintf(stderr, "kernel_launch: hipFuncSetAttribute failed\n"); grid = -1; return; }
        (void)hipGetLastError();
        grid = cus;
    }
    if (grid < 0) return;
    (void)hipMemsetAsync((char*)d_ws + WS_CTL, 0, CTL_BYTES, stream);
    Args a{};
    for (int i = 0; i < 32; ++i) a.in[i] = (const float*)d_in[i];
    a.out = (float*)d_out; a.ws = (unsigned char*)d_ws;
    const int last = 16;
#if N_LAUNCH_MODE == 1
    a.ph_lo = 0; a.ph_hi = last + 1;
    hipLaunchKernelGGL(fwd_kernel, dim3(grid), dim3(NTHREADS), LDS_BYTES, stream, a);
#else
    for (int p = 0; p <= last; ++p) { a.ph_lo = p; a.ph_hi = p + 1; hipLaunchKernelGGL(fwd_kernel, dim3(grid), dim3(NTHREADS), LDS_BYTES, stream, a); }
#endif
}
```

```cpp
#include <hip/hip_runtime.h>
#include <cstdio>
#include <cstdint>

#define LAS __attribute__((address_space(3)))
#define GAS __attribute__((address_space(1)))
typedef unsigned short bf16_t;
typedef short bf16x8 __attribute__((ext_vector_type(8)));
typedef float f32x4 __attribute__((ext_vector_type(4)));
typedef float f32x2 __attribute__((ext_vector_type(2)));
typedef float f32x16 __attribute__((ext_vector_type(16)));
typedef unsigned u32x4 __attribute__((ext_vector_type(4)));
typedef unsigned u32x2 __attribute__((ext_vector_type(2)));

#ifndef N_LAUNCH_MODE
#define N_LAUNCH_MODE 1
#endif
#ifndef REPEAT_MASK
#define REPEAT_MASK 0
#endif

constexpr int D = 1024, NB = 2, TSEQ = 16384, CT = 256, NL = NB * TSEQ, NC = NB * CT, NTOK = NL + NC;
constexpr int NE = 32, TOPK = 4, NMOD = 6;
constexpr int NWAVES = 8, NTHREADS = 512;
constexpr int MAXSLOT = ((NTOK * TOPK + 255) / 256 + NE) * 256;
constexpr float NORM_EPS = 1e-6f, GN_EPS = 64e-5f;

constexpr size_t AL(size_t x) { return (x + 255) & ~(size_t)255; }
constexpr size_t WS_CTL = 0, CTL_BYTES = 65536;
constexpr size_t CTL_XSYNC = 32768;
constexpr size_t CTL_CNT = 16384;
constexpr size_t WS_MOD = WS_CTL + CTL_BYTES;
constexpr size_t WS_LIST = AL(WS_MOD + 2 * 3 * 6144 * 4);
constexpr size_t WS_TINFO = AL(WS_LIST + (size_t)2 * NE * NTOK * 4);
constexpr size_t WS_TGATE = AL(WS_TINFO + (size_t)2 * NTOK * 4 * 4);
constexpr size_t WS_WGU = AL(WS_TGATE + (size_t)2 * NTOK * 4 * 4);
constexpr size_t WS_WDN = AL(WS_WGU + (size_t)2 * NE * 2048 * 1024 * 2);
constexpr size_t WS_WRKV = AL(WS_WDN + (size_t)2 * NE * 1024 * 1024 * 2);
constexpr size_t WS_WO = AL(WS_WRKV + (size_t)3 * 1024 * 1024 * 2);
constexpr size_t WS_WL1 = AL(WS_WO + (size_t)1024 * 1024 * 2);
constexpr size_t WS_WL2 = AL(WS_WL1 + (size_t)3 * 256 * 1024 * 2);
constexpr size_t WS_WPOOL = AL(WS_WL2 + (size_t)5 * 1024 * 128 * 2);
constexpr size_t WS_XS0 = AL(WS_WPOOL + (size_t)4 * 256 * 256 * 2);
constexpr size_t WS_XS1 = AL(WS_XS0 + (size_t)NTOK * D * 4);
constexpr size_t WS_T = AL(WS_XS1 + (size_t)NTOK * D * 4);
constexpr size_t ACTB = (size_t)NTOK * D * 2;
constexpr size_t TA = WS_T;
constexpr size_t TA_BYTES = (size_t)432 << 20;
constexpr size_t WS_DBUF = TA, WS_H2 = TA + ACTB, WS_ACT = TA + 2 * ACTB;
constexpr size_t WS_MIX = TA;
constexpr size_t WS_KDIR = TA, WS_BV = TA + 2 * ACTB, WS_KK = TA + 4 * ACTB;
constexpr size_t TB = TA + TA_BYTES;
constexpr size_t TB_BYTES = (size_t)290 << 20;
constexpr size_t WS_Y2 = TB, WS_RKV = TB;
constexpr size_t TC = TB + TB_BYTES;
constexpr size_t WS_DEC = TC, WS_RO = TC;
constexpr size_t TD = AL(TC + (size_t)2 * NTOK * D * 4);
constexpr size_t WS_ICL = TD, WS_YD = TD;
constexpr size_t TE = AL(TD + 2 * ACTB);
constexpr size_t WS_G = TE;
constexpr size_t TF = AL(TE + ACTB);
constexpr size_t WS_LACT = TF;
constexpr size_t WS_END = AL(TF + (size_t)3 * NTOK * 128 * 2);
static_assert(WS_ACT + (size_t)MAXSLOT * D * 2 <= TA + TA_BYTES, "ACT overflows TA");
static_assert((size_t)MAXSLOT * D * 2 <= TB_BYTES, "Y2 overflows TB");
static_assert(WS_END <= ((size_t)2048 << 20), "workspace too large");

constexpr int MISC_OFF = 0, SCR_OFF = 1024, SCR_BYTES = 162816, LDS_BYTES = SCR_OFF + SCR_BYTES;

typedef __bf16 bf16x2_t __attribute__((ext_vector_type(2)));
__device__ __forceinline__ unsigned cvt_pk_bf16(float lo, float hi) { const f32x2 v = {lo, hi}; return __builtin_bit_cast(unsigned, __builtin_convertvector(v, bf16x2_t)); }
__device__ __forceinline__ float bf_lo(unsigned w) { return __uint_as_float(w << 16); }
__device__ __forceinline__ float bf_hi(unsigned w) { return __uint_as_float(w & 0xffff0000u); }
__device__ __forceinline__ float bf2f(bf16_t b) { return __uint_as_float(((unsigned)b) << 16); }
__device__ __forceinline__ float wave_sum(float v) {
#pragma unroll
    for (int o = 1; o < 64; o <<= 1) v += __shfl_xor(v, o);
    return v;
}
__device__ __forceinline__ float sigmoidf_(float x) { return 1.0f / (1.0f + __expf(-x)); }
#define LDS_WAIT() asm volatile("s_waitcnt lgkmcnt(0)" ::: "memory")
#define VM_WAIT() asm volatile("s_waitcnt vmcnt(0)" ::: "memory")

#define XB_TMO      128
#define XB_XCNT(j)  (256  + 64 * (j))
#define XB_XSUB(j)  (1280 + 64 * (j))
#define XB_XGEN(j)  (2304 + 64 * (j))
#define XB_TOP      3328
#define XB_TOPGEN   3392
#define XCD_BAR_WORDS 3456
#define XB_SPIN_CAP (1u << 22)
__device__ __forceinline__ unsigned xb_ld(unsigned* p)              { return __hip_atomic_load(p, __ATOMIC_RELAXED, __HIP_MEMORY_SCOPE_AGENT); }
__device__ __forceinline__ unsigned xb_add(unsigned* p, unsigned v) { return __hip_atomic_fetch_add(p, v, __ATOMIC_RELAXED, __HIP_MEMORY_SCOPE_AGENT); }
__device__ __forceinline__ unsigned xb_xcc_id() { return (unsigned)__builtin_amdgcn_s_getreg((3 << 11) | 20) & 0xFu; }
#define XB_SPIN(cond, bar) do { unsigned _sp = 0; while (cond) { __builtin_amdgcn_s_sleep(1); \
    if ((++_sp & 255u) == 0u) { if (xb_ld(&(bar)[XB_TMO])) break; if (_sp > XB_SPIN_CAP) { atomicAdd(&(bar)[XB_TMO], 1u); break; } } } } while (0)
struct XcdBarrier { unsigned* bar; unsigned x; volatile LAS unsigned* st; };
__device__ __forceinline__ XcdBarrier xcd_barrier_post(unsigned* bar, volatile LAS unsigned* st) {
    XcdBarrier b; b.bar = bar; b.x = xb_xcc_id(); b.st = st;
    if (threadIdx.x == 0) (void)xb_add(&bar[XB_XCNT(b.x)], 1u);
    return b;
}
__device__ __forceinline__ void xcd_barrier_complete(unsigned* bar, unsigned x, unsigned& nloc, unsigned& nx) {
    const unsigned G = gridDim.x * gridDim.y * gridDim.z;
    unsigned sum, cnt, mine, sp = 0u;
    for (;;) {
        sum = 0u; cnt = 0u; mine = 0u;
#pragma unroll
        for (unsigned j = 0; j < 16; ++j) { const unsigned c = xb_ld(&bar[XB_XCNT(j)]); sum += c; cnt += (c > 0u) ? 1u : 0u; mine = (j == x) ? c : mine; }
        if (sum == G) break;
        __builtin_amdgcn_s_sleep(1);
        if ((++sp & 255u) == 0u) { if (xb_ld(&bar[XB_TMO])) break; if (sp > XB_SPIN_CAP) { atomicAdd(&bar[XB_TMO], 1u); break; } }
    }
    nloc = mine > 0u ? mine : 1u; nx = cnt > 0u ? cnt : 1u;
}
__device__ __forceinline__ void xcd_barrier(const XcdBarrier& b) {
    asm volatile("s_waitcnt vmcnt(0)" ::: "memory");
    __syncthreads();
    if (threadIdx.x == 0) {
        unsigned* bar = b.bar;
        __builtin_amdgcn_s_waitcnt(0);
        unsigned nloc = b.st[0], nx = b.st[1];
        if (nloc == 0u) { xcd_barrier_complete(bar, b.x, nloc, nx); b.st[0] = nloc; b.st[1] = nx; }
        const unsigned old = xb_add(&bar[XB_XSUB(b.x)], 1u);
        const unsigned gen = old / nloc;
        if (old + 1u == (gen + 1u) * nloc) {
            __builtin_amdgcn_fence(__ATOMIC_RELEASE, "agent");
            asm volatile("s_waitcnt vmcnt(0)" ::: "memory");
            const unsigned og = xb_add(&bar[XB_TOP], 1u);
            const unsigned tg = og / nx;
            if (og + 1u == (tg + 1u) * nx) xb_add(&bar[XB_TOPGEN], 1u);
            else XB_SPIN(xb_ld(&bar[XB_TOPGEN]) == tg, bar);
            __builtin_amdgcn_fence(__ATOMIC_ACQUIRE, "agent");
            xb_add(&bar[XB_XGEN(b.x)], 1u);
            asm volatile("s_waitcnt vmcnt(0)" ::: "memory");
        } else {
            XB_SPIN(xb_ld(&bar[XB_XGEN(b.x)]) == gen, bar);
            __builtin_amdgcn_fence(__ATOMIC_ACQUIRE, "agent");
            asm volatile("s_waitcnt vmcnt(0)" ::: "memory");
        }
    }
    __syncthreads();
}

namespace pg8 {
constexpr int BM = 256, BK = 64, HALF = 128, HTB = HALF * BK * 2, STAGE_BYTES = 8 * HTB;
__host__ __device__ __forceinline__ int lds_byte(int r, int c) { const int st = (r >> 4) * 2 + (c >> 5), rr = r & 15, cc = c & 31, ob = rr * 64 + cc * 2; return st * 1024 + (ob ^ (((ob >> 9) & 1) << 5)); }
__host__ __device__ __forceinline__ void stage_rc(int b, int& R, int& C) { const int st = b / 1024, sb = b % 1024, swz = sb ^ (((sb >> 9) & 1) << 5); R = (st >> 1) * 16 + swz / 64; C = (st & 1) * 32 + (swz % 64) / 2; }
__host__ __device__ __forceinline__ int perm32(int rho) { const int n = rho >> 4, i = rho & 15; return 8 * (i >> 2) + 4 * n + (i & 3); }

struct GU { unsigned a, b; int i0, i1, i2, i3; };
typedef int v8i __attribute__((ext_vector_type(8)));
typedef int v4i __attribute__((ext_vector_type(4)));
__device__ __forceinline__ bf16x8 half8(v8i v, int h) { const v4i a = h ? __builtin_shufflevector(v, v, 4, 5, 6, 7) : __builtin_shufflevector(v, v, 0, 1, 2, 3); return __builtin_bit_cast(bf16x8, a); }
__device__ __forceinline__ v8i cat8(bf16x8 lo, bf16x8 hi) { const v4i a = __builtin_bit_cast(v4i, lo), b = __builtin_bit_cast(v4i, hi); return __builtin_shufflevector(a, b, 0, 1, 2, 3, 4, 5, 6, 7); }

template <class Epi, class Sched>
__device__ __forceinline__ void gemm_phase(LAS unsigned char* lds, unsigned char* wsbase, const Sched& S, const Epi& E) {
    const int tid = threadIdx.x, wid = __builtin_amdgcn_readfirstlane(tid >> 6), lane = tid & 63, wr = wid >> 2, wc = wid & 3, fr = lane & 15, fq = lane >> 4;
    const int nt = S.nt;
    const __amdgpu_buffer_rsrc_t rsrc = __builtin_amdgcn_make_buffer_rsrc((void*)wsbase, 0, 0xffffffff, 0x00020000);
    constexpr int SIDE_OFF = STAGE_BYTES;
#define PG8_SIDE(u, buf) do { if constexpr (Sched::SIDE) { unsigned so_; const bool isb_ = S.side_src((u), tid, so_); (void)isb_; \
        if (wid < 4) __builtin_amdgcn_raw_ptr_buffer_load_lds(rsrc, (LAS void*)(lds + SIDE_OFF + (buf) * 2048 + wid * 256), 4, (int)so_, 0, 0, 0); \
        else __builtin_amdgcn_raw_ptr_buffer_load_lds(S.rsrcb, (LAS void*)(lds + SIDE_OFF + (buf) * 2048 + wid * 256), 4, (int)so_, 0, 0, 0); } } while (0)
    int Rr[2], Cc[2]; unsigned voffB[2];
#pragma unroll
    for (int i = 0; i < 2; ++i) { int R, C; stage_rc(tid * 16 + i * 8192, R, C); Rr[i] = R; Cc[i] = C; const int Rb = Epi::PERM ? ((R & ~31) + perm32(R & 31)) : R;
        voffB[i] = (unsigned)Rb * S.ldb + 2u * (unsigned)C; }
    const unsigned kstep = 128u;
    const unsigned hstepB = (unsigned)HALF * S.ldb;
    const unsigned ldsw = (unsigned)wid * 1024u;
    const int aoff = lds_byte(wr * 64 + fr, fq * 8), boff = lds_byte(wc * 32 + fr, fq * 8);
#define PG8_SA(b, h) (((b) * 2 + (h)) * HTB)
#define PG8_SB(b, h) ((4 + (b) * 2 + (h)) * HTB)
#define PG8_STAGE(bufoff, soff, voff) do { _Pragma("unroll") for (int _i = 0; _i < 2; ++_i) \
        __builtin_amdgcn_raw_ptr_buffer_load_lds(rsrc, (LAS void*)(lds + (bufoff) + ldsw + _i * 8192), 16, (int)(voff)[_i], (int)(soff), 0, 0); } while (0)
#define PG8_LDA(dst, b, h) do { _Pragma("unroll") for (int m = 0; m < 4; ++m) dst[m] = cat8(*(const LAS bf16x8*)(lds + PG8_SA(b, h) + aoff + m * 2048), *(const LAS bf16x8*)(lds + PG8_SA(b, h) + aoff + m * 2048 + 1024)); } while (0)
#define PG8_LDB(dst, b, h) do { _Pragma("unroll") for (int n = 0; n < 2; ++n) dst[n] = cat8(*(const LAS bf16x8*)(lds + PG8_SB(b, h) + boff + n * 2048), *(const LAS bf16x8*)(lds + PG8_SB(b, h) + boff + n * 2048 + 1024)); } while (0)
#define PG8_MMA(ai, bj, At, Bt) do { __builtin_amdgcn_s_setprio(1); _Pragma("unroll") for (int m = 0; m < 4; ++m) _Pragma("unroll") for (int n = 0; n < 2; ++n) { \
        if constexpr (Epi::FP8) { asm volatile("v_mfma_scale_f32_16x16x128_f8f6f4 %0, %1, %2, %0, %3, %4 op_sel_hi:[0,0,0]" : "+v"(acc[ai][bj][m][n]) : "v"(Bt[n]), "v"(At[m]), "v"(sc_w), "v"(sc_a)); } \
        else { acc[ai][bj][m][n] = __builtin_amdgcn_mfma_f32_16x16x32_bf16(half8(Bt[n], 0), half8(At[m], 0), acc[ai][bj][m][n], 0, 0, 0); \
               acc[ai][bj][m][n] = __builtin_amdgcn_mfma_f32_16x16x32_bf16(half8(Bt[n], 1), half8(At[m], 1), acc[ai][bj][m][n], 0, 0, 0); } } \
        __builtin_amdgcn_s_setprio(0); } while (0)
#define PG8_WAIT_V(n) asm volatile("s_waitcnt vmcnt(" #n ")" ::: "memory")
#define PG8_WAIT_L(n) asm volatile("s_waitcnt lgkmcnt(" #n ")" ::: "memory")
#define PG8_BAR __builtin_amdgcn_s_barrier()
#define PG8_SCHED __builtin_amdgcn_sched_barrier(0)
#define PG8_RC() do { _Pragma("unroll") for (int i = 0; i < 2; ++i) { int R, C; stage_rc((int)threadIdx.x * 16 + i * 8192, R, C); Rr[i] = R; Cc[i] = C; } } while (0)
    GU cur, nxt; int ui = 0;
    if (!S.next(0, cur)) { if constexpr (Sched::XSYNC) { if (tid == 0) (void)xb_add(S.xw, (unsigned)S.rounds); } return; }
    f32x4 acc[2][2][4][2];
#pragma unroll
    for (int a = 0; a < 2; ++a)
#pragma unroll
        for (int b = 0; b < 2; ++b)
#pragma unroll
            for (int m = 0; m < 4; ++m)
#pragma unroll
                for (int n = 0; n < 2; ++n) acc[a][b][m][n] = (f32x4){0.f, 0.f, 0.f, 0.f};
    v8i At[4], B0[2], B1[2];
    int sc_w = 0x7a7a7a7a, sc_a = 0x7f7f7f7f; asm volatile("" : "+v"(sc_w), "+v"(sc_a));
    unsigned vA[2][2], nvA[2][2];
    S.aoff(cur, Rr, Cc, vA);
    unsigned cA = __builtin_amdgcn_readfirstlane(cur.a), cB = __builtin_amdgcn_readfirstlane(cur.b);
    PG8_SIDE(cur, 0);
    PG8_STAGE(PG8_SB(0, 0), cB, voffB); PG8_STAGE(PG8_SB(0, 1), cB + hstepB, voffB); PG8_STAGE(PG8_SA(0, 0), cA, vA[0]); PG8_STAGE(PG8_SA(0, 1), cA, vA[1]);
    if (wr == 1) PG8_BAR;
    PG8_WAIT_V(2); PG8_BAR;
    PG8_STAGE(PG8_SB(1, 0), cB + kstep, voffB); PG8_STAGE(PG8_SA(1, 0), cA + kstep, vA[0]); PG8_STAGE(PG8_SB(1, 1), cB + hstepB + kstep, voffB);
    PG8_WAIT_V(6); PG8_BAR;
    for (;;) {
        const bool has_next = S.next(ui + 1, nxt);
        const unsigned nA = has_next ? __builtin_amdgcn_readfirstlane(nxt.a) : cA, nB = has_next ? __builtin_amdgcn_readfirstlane(nxt.b) : cB;
        if (has_next) PG8_SIDE(nxt, (ui + 1) & 1);
        if constexpr (Sched::GATHER && !Sched::SIDE) {
            if (has_next) { PG8_RC(); S.aoff(nxt, Rr, Cc, nvA); }
            else { nvA[0][0] = vA[0][0]; nvA[0][1] = vA[0][1]; nvA[1][0] = vA[1][0]; nvA[1][1] = vA[1][1]; }
        }
#pragma unroll 1
        for (int t = 0; t < nt; t += 2) {
            const bool last = (t == nt - 2);
            const unsigned a1 = cA + (unsigned)(t + 1) * kstep;
            const unsigned a2 = last ? nA : cA + (unsigned)(t + 2) * kstep, b2 = last ? nB : cB + (unsigned)(t + 2) * kstep;
            const unsigned a3 = a2 + kstep, b3 = b2 + kstep;
            if constexpr (Sched::GATHER && Sched::SIDE) {
                if (last) { if (has_next) { PG8_RC(); const LAS int* tk = (const LAS int*)(lds + SIDE_OFF + ((ui + 1) & 1) * 2048);
#pragma unroll
                        for (int h = 0; h < 2; ++h)
#pragma unroll
                            for (int i = 0; i < 2; ++i) nvA[h][i] = S.tok_off(tk[h * 128 + Rr[i]], Cc[i]); }
                    else { nvA[0][0] = vA[0][0]; nvA[0][1] = vA[0][1]; nvA[1][0] = vA[1][0]; nvA[1][1] = vA[1][1]; } }
            }
            unsigned w0[2], w1[2];
            if constexpr (Sched::GATHER) { w0[0] = last ? nvA[0][0] : vA[0][0]; w0[1] = last ? nvA[0][1] : vA[0][1]; w1[0] = last ? nvA[1][0] : vA[1][0]; w1[1] = last ? nvA[1][1] : vA[1][1]; }
            else { w0[0] = vA[0][0]; w0[1] = vA[0][1]; w1[0] = vA[1][0]; w1[1] = vA[1][1]; }
            PG8_LDB(B0, 0, 0); PG8_LDB(B1, 0, 1); PG8_SCHED; PG8_LDA(At, 0, 0); PG8_STAGE(PG8_SA(1, 1), a1, vA[1]);
            PG8_WAIT_V(8); PG8_WAIT_L(0); PG8_BAR; PG8_MMA(0, 0, At, B0); PG8_MMA(0, 1, At, B1); PG8_BAR; PG8_SCHED;
            PG8_LDA(At, 0, 1); PG8_STAGE(PG8_SB(0, 0), b2, voffB); PG8_STAGE(PG8_SB(0, 1), b2 + hstepB, voffB); PG8_STAGE(PG8_SA(0, 0), a2, w0);
            PG8_WAIT_V(8); PG8_WAIT_L(0); PG8_BAR; PG8_MMA(1, 0, At, B0); PG8_MMA(1, 1, At, B1); PG8_BAR; PG8_SCHED;
            PG8_LDB(B0, 1, 0); PG8_LDB(B1, 1, 1); PG8_SCHED; PG8_LDA(At, 1, 0); PG8_STAGE(PG8_SA(0, 1), a2, w1);
            PG8_WAIT_V(8); PG8_WAIT_L(0); PG8_BAR; PG8_MMA(0, 0, At, B0); PG8_MMA(0, 1, At, B1); PG8_BAR; PG8_SCHED;
            PG8_LDA(At, 1, 1); PG8_STAGE(PG8_SB(1, 0), b3, voffB); PG8_STAGE(PG8_SB(1, 1), b3 + hstepB, voffB); PG8_STAGE(PG8_SA(1, 0), a3, w0);
            PG8_WAIT_V(8); PG8_WAIT_L(0); PG8_BAR; PG8_MMA(1, 0, At, B0); PG8_MMA(1, 1, At, B1); PG8_BAR; PG8_SCHED;
        }
        if (wr == 0) PG8_BAR;
        if constexpr (Epi::FP8) asm volatile("s_nop 15\n\ts_nop 7" ::: "memory");
        { int fr_ = fr, fq_ = fq; asm volatile("" : "+v"(fr_), "+v"(fq_)); E(acc, cur, wr, wc, fr_, fq_, (const LAS float*)(lds + SIDE_OFF + (ui & 1) * 2048 + 1024)); }
        if constexpr (Sched::XSYNC) {
            if (tid == 0) { (void)xb_add(S.xw, 1u); const unsigned tgt = (unsigned)(ui + 1) * S.nloc; unsigned sp = 0;
                while (xb_ld(S.xw) < tgt && ++sp < (1u << 16)) __builtin_amdgcn_s_sleep(1);
                if (!has_next && S.rounds > ui + 1) (void)xb_add(S.xw, (unsigned)(S.rounds - (ui + 1))); }
        }
        if constexpr (Sched::XSYNC || Sched::SIDE) PG8_BAR;
        if (!has_next) break;
#pragma unroll
        for (int a = 0; a < 2; ++a)
#pragma unroll
            for (int b = 0; b < 2; ++b)
#pragma unroll
                for (int m = 0; m < 4; ++m)
#pragma unroll
                    for (int n = 0; n < 2; ++n) acc[a][b][m][n] = (f32x4){0.f, 0.f, 0.f, 0.f};
        cur = nxt; cA = nA; cB = nB; ++ui;
        if constexpr (Sched::GATHER) { vA[0][0] = nvA[0][0]; vA[0][1] = nvA[0][1]; vA[1][0] = nvA[1][0]; vA[1][1] = nvA[1][1]; }
        if (wr == 1) PG8_BAR;
    }
    PG8_WAIT_V(0);
    PG8_BAR;
#undef PG8_RC
#undef PG8_SIDE
#undef PG8_SA
#undef PG8_SB
#undef PG8_STAGE
#undef PG8_LDA
#undef PG8_LDB
#undef PG8_MMA
#undef PG8_WAIT_V
#undef PG8_WAIT_L
#undef PG8_BAR
#undef PG8_SCHED
}
}
using pg8::GU;

struct Args { const float* in[32]; float* out; unsigned char* ws; int ph_lo, ph_hi; };
struct Frame {
    LAS unsigned char* lds;
    LAS unsigned char* scr;
    unsigned char* ws;
    int tid, lane, wave, G, vcu;
};
enum { I_X = 0, I_C, I_CTX, I_CCTX, I_NORMG, I_ADAW, I_ADAB, I_POOLW, I_POOLLS, I_MU, I_WRKV, I_W0, I_W1, I_W2, I_A0, I_A1, I_A2, I_G1, I_G2, I_KK, I_KA, I_RK, I_LNG, I_LNB, I_WO,
       I_RW, I_RB, I_WGU, I_BGU, I_WDN, I_BDN, I_FINALG };

__device__ __forceinline__ const float* modp(const Frame& F, int layer, int row, int k) { return (const float*)(F.ws + WS_MOD) + ((size_t)(layer * 3 + row) * NMOD + k) * D; }
__device__ __forceinline__ int mrow_of(int n) { return n < NL ? (n >> 14) : 2; }

__device__ __forceinline__ void transpose_tile(const float* W, int ldw, int k0, int n0, bf16_t* WT, size_t dst_row0, int ldk, int kdst0, LAS float* scr, int lane) {
    const int c4 = lane & 15, kr = lane >> 4;
#pragma unroll 4
    for (int it = 0; it < 16; ++it) { const int kk = 4 * it + kr; const f32x4 v = *(const GAS f32x4*)(W + (size_t)(k0 + kk) * ldw + n0 + 4 * c4);
        LAS float* s = scr + kk * 65 + 4 * c4; s[0] = v[0]; s[1] = v[1]; s[2] = v[2]; s[3] = v[3]; }
    LDS_WAIT(); asm volatile("" ::: "memory");
    const int c = lane & 7;
#pragma unroll
    for (int j = 0; j < 8; ++j) { const int n = (lane >> 3) + 8 * j; const LAS float* s = scr + (8 * c) * 65 + n;
        u32x4 o; o.x = cvt_pk_bf16(s[0 * 65], s[1 * 65]); o.y = cvt_pk_bf16(s[2 * 65], s[3 * 65]); o.z = cvt_pk_bf16(s[4 * 65], s[5 * 65]); o.w = cvt_pk_bf16(s[6 * 65], s[7 * 65]);
        *(GAS u32x4*)(WT + (dst_row0 + n) * (size_t)ldk + kdst0 + k0 + 8 * c) = o; }
    LDS_WAIT(); asm volatile("" ::: "memory");
}

__device__ __forceinline__ unsigned pk4_fp8(float a, float b, float c, float d) { int w = 0; w = __builtin_amdgcn_cvt_pk_fp8_f32(a, b, w, false); w = __builtin_amdgcn_cvt_pk_fp8_f32(c, d, w, true); return (unsigned)w; }
__device__ __forceinline__ void transpose_tile_fp8(const float* W, int ldw, int k0, int n0, unsigned char* WT, size_t dst_row0, int ldk, float scale, LAS float* scr, int lane) {
    const int c4 = lane & 15, kr = lane >> 4;
#pragma unroll 4
    for (int it = 0; it < 16; ++it) { const int kk = 4 * it + kr; const f32x4 v = *(const GAS f32x4*)(W + (size_t)(k0 + kk) * ldw + n0 + 4 * c4);
        LAS float* s = scr + kk * 65 + 4 * c4; s[0] = v[0] * scale; s[1] = v[1] * scale; s[2] = v[2] * scale; s[3] = v[3] * scale; }
    LDS_WAIT(); asm volatile("" ::: "memory");
    const int c = lane & 3;
#pragma unroll
    for (int j = 0; j < 4; ++j) { const int n = (lane >> 2) + 16 * j; const LAS float* s = scr + (16 * c) * 65 + n;
        u32x4 o; o.x = pk4_fp8(s[0 * 65], s[1 * 65], s[2 * 65], s[3 * 65]); o.y = pk4_fp8(s[4 * 65], s[5 * 65], s[6 * 65], s[7 * 65]);
        o.z = pk4_fp8(s[8 * 65], s[9 * 65], s[10 * 65], s[11 * 65]); o.w = pk4_fp8(s[12 * 65], s[13 * 65], s[14 * 65], s[15 * 65]);
        *(GAS u32x4*)(WT + (dst_row0 + n) * (size_t)ldk + k0 + 16 * c) = o; }
    LDS_WAIT(); asm volatile("" ::: "memory");
}
__device__ __forceinline__ void phase_prep(const Frame& F, const Args& A) {
    unsigned char* ws = F.ws;
    if (blockIdx.x < 192) {
        const int l = blockIdx.x / 96, cc = blockIdx.x % 96, c4 = F.tid & 15, kq = F.tid >> 4;
        const float* w = A.in[I_ADAW] + (size_t)l * D * (NMOD * D) + cc * 64 + 4 * c4;
        f32x4 a0 = {0, 0, 0, 0}, a1 = {0, 0, 0, 0}, a2 = {0, 0, 0, 0};
        for (int i = 0; i < 32; ++i) { const int k = kq + 32 * i;
            const f32x4 wv = *(const GAS f32x4*)(w + (size_t)k * (NMOD * D));
            float c0 = A.in[I_C][k], c1 = A.in[I_C][D + k], c2 = A.in[I_CCTX][k];
            c0 = c0 * sigmoidf_(c0); c1 = c1 * sigmoidf_(c1); c2 = c2 * sigmoidf_(c2);
            a0 += wv * c0; a1 += wv * c1; a2 += wv * c2; }
        LAS f32x4* red = (LAS f32x4*)F.scr;
        red[(kq * 3 + 0) * 16 + c4] = a0; red[(kq * 3 + 1) * 16 + c4] = a1; red[(kq * 3 + 2) * 16 + c4] = a2;
        __syncthreads();
        if (F.tid < 192) { const int r = F.tid / 64, c = F.tid % 64; float s = 0.f;
            for (int q = 0; q < 32; ++q) s += ((LAS float*)F.scr)[((q * 3 + r) * 16) * 4 + c];
            const int col = cc * 64 + c;
            ((float*)(ws + WS_MOD))[(size_t)(l * 3 + r) * (NMOD * D) + col] = s + A.in[I_ADAB][(size_t)l * NMOD * D + col]; }
        __syncthreads();
    }
    { bf16_t* w2p = (bf16_t*)(ws + WS_WL2);
      for (int i = blockIdx.x * NTHREADS + F.tid; i < 4 * 1024 * 8; i += F.G * NTHREADS) { const int o = i / 8192, c = (i / 8) % 1024, q = i % 8, d = o & 1;
          *(GAS u32x4*)(w2p + ((size_t)o * 1024 + c) * 128 + (1 - d) * 64 + q * 8) = (u32x4){0u, 0u, 0u, 0u}; } }
    LAS float* scr = (LAS float*)(F.scr) + F.wave * (64 * 65 + 63);
    const int gw = F.vcu * NWAVES + F.wave, NGW = F.G * NWAVES;
    constexpr int T_GU = 2 * NE * 16 * 32, T_DN = 2 * NE * 16 * 16, T_RKV = 3 * 256, T_WO = 256, T_L1 = 2 * 16 + 2 * 16 + 32, T_L2 = 2 * 16 + 2 * 16 + 2 * 16, T_PW = 4 * 16;
    constexpr int T_ALL = T_GU + T_DN + T_RKV + T_WO + T_L1 + T_L2 + T_PW;
    for (int it = gw; it < T_ALL; it += NGW) {
        int r = it;
        if (r < T_GU) { const int le = r / 512, q = r % 512, kb = q / 32, nb = q % 32; const int n0 = nb * 64;
            const int drow = (n0 < 1024) ? ((n0 >> 7) * 256 + (n0 & 127)) : (((n0 - 1024) >> 7) * 256 + 128 + ((n0 - 1024) & 127));
            transpose_tile_fp8(A.in[I_WGU] + (size_t)le * 1024 * 2048, 2048, kb * 64, n0, ws + WS_WGU, (size_t)le * 2048 + drow, 1024, 32.0f, scr, F.lane); continue; } r -= T_GU;
        if (r < T_DN) { const int le = r / 256, q = r % 256, kb = q / 16, nb = q % 16;
            transpose_tile_fp8(A.in[I_WDN] + (size_t)le * 1024 * 1024, 1024, kb * 64, nb * 64, ws + WS_WDN, (size_t)le * 1024 + nb * 64, 1024, 32.0f, scr, F.lane); continue; } r -= T_DN;
        if (r < T_RKV) { const int p = r / 256, q = r % 256, kb = q / 16, nb = q % 16;
            transpose_tile(A.in[I_WRKV] + (size_t)p * 1024 * 1024, 1024, kb * 64, nb * 64, (bf16_t*)(ws + WS_WRKV), (size_t)p * 1024 + nb * 64, 1024, 0, scr, F.lane); continue; } r -= T_RKV;
        if (r < T_WO) { const int kb = r / 16, nb = r % 16;
            transpose_tile(A.in[I_WO], 1024, kb * 64, nb * 64, (bf16_t*)(ws + WS_WO), (size_t)nb * 64, 1024, 0, scr, F.lane); continue; } r -= T_WO;
        if (r < T_L1) {
            if (r < 32) { const int d = r / 16, kb = r % 16; transpose_tile(A.in[I_W1] + (size_t)d * 1024 * 64, 64, kb * 64, 0, (bf16_t*)(ws + WS_WL1), (size_t)0 * 256 + d * 64, 1024, 0, scr, F.lane); continue; }
            r -= 32;
            if (r < 32) { const int d = r / 16, kb = r % 16; transpose_tile(A.in[I_A1] + (size_t)d * 1024 * 64, 64, kb * 64, 0, (bf16_t*)(ws + WS_WL1), (size_t)1 * 256 + d * 64, 1024, 0, scr, F.lane); continue; }
            r -= 32;
            { const int kb = r / 2, nb = r % 2; transpose_tile(A.in[I_G1], 128, kb * 64, nb * 64, (bf16_t*)(ws + WS_WL1), (size_t)2 * 256 + nb * 64, 1024, 0, scr, F.lane); continue; }
        } r -= T_L1;
        if (r < T_L2) {
            if (r < 32) { const int d = r / 16, nb = r % 16; transpose_tile(A.in[I_W2] + (size_t)d * 64 * 1024, 1024, 0, nb * 64, (bf16_t*)(ws + WS_WL2), (size_t)d * 1024 + nb * 64, 128, d * 64, scr, F.lane); continue; }
            r -= 32;
            if (r < 32) { const int d = r / 16, nb = r % 16; transpose_tile(A.in[I_A2] + (size_t)d * 64 * 1024, 1024, 0, nb * 64, (bf16_t*)(ws + WS_WL2), (size_t)(2 + d) * 1024 + nb * 64, 128, d * 64, scr, F.lane); continue; }
            r -= 32;
            { const int kb = r / 16, nb = r % 16; transpose_tile(A.in[I_G2], 1024, kb * 64, nb * 64, (bf16_t*)(ws + WS_WL2), (size_t)4 * 1024 + nb * 64, 128, 0, scr, F.lane); continue; }
        } r -= T_L2;
        { const int g = r / 16, q = r % 16, kb = q / 4, nb = q % 4;
          transpose_tile(A.in[I_POOLW] + (size_t)g * 256 * 256, 256, kb * 64, nb * 64, (bf16_t*)(ws + WS_WPOOL), (size_t)g * 256 + nb * 64, 256, 0, scr, F.lane); }
    }
}

__device__ __forceinline__ void phase_pre0(const Frame& F, const Args& A) {
    LAS float* hb = (LAS float*)F.scr;
    LAS float* rs = hb + 80 * 258;
    LAS float* gsc = rs + 80;
    LAS float* gsh = gsc + 256;
    bf16_t* dbuf = (bf16_t*)(F.ws + WS_DBUF);
    const float* ng = A.in[I_NORMG];
    for (int u = blockIdx.x; u < 520; u += F.G) {
        int tok0, nown = 64, hl = 0, hr = 0, L, pos0, row; const float* xsrc;
        if (u < 512) { tok0 = u * 64; L = 64; pos0 = 0; row = tok0 >> 14; xsrc = A.in[I_X] + (size_t)tok0 * D; }
        else { const int b = (u - 512) >> 2, q = (u - 512) & 3; tok0 = NL + b * CT + q * 64; L = CT; pos0 = q * 64; hl = q > 0 ? 8 : 0; hr = q < 3 ? 8 : 0; row = 2;
               xsrc = A.in[I_CTX] + (size_t)(b * CT + q * 64) * D; }
        const int nt = nown + hl + hr;
        for (int j = F.wave; j < nt; j += NWAVES) { const float* xr = xsrc + (ptrdiff_t)(j - hl) * D; float s = 0.f;
#pragma unroll
            for (int q = 0; q < 4; ++q) { const f32x4 v = *(const GAS f32x4*)(xr + 4 * F.lane + 256 * q); s += v[0] * v[0] + v[1] * v[1] + v[2] * v[2] + v[3] * v[3]; }
            s = wave_sum(s); if (F.lane == 0) rs[j] = 1.0f / sqrtf(s * (1.0f / D) + NORM_EPS); }
        for (int g = 0; g < 4; ++g) {
            __syncthreads();
            if (F.tid < 256) { const int c = g * 256 + F.tid; gsc[F.tid] = ng[c] * (1.0f + modp(F, 0, row, 1)[c]); gsh[F.tid] = modp(F, 0, row, 0)[c]; }
            __syncthreads();
            for (int i = F.tid; i < nt * 64; i += NTHREADS) { const int j = i >> 6, c4 = i & 63; const f32x4 v = *(const GAS f32x4*)(xsrc + (ptrdiff_t)(j - hl) * D + g * 256 + 4 * c4);
                const float r = rs[j]; LAS float* h = hb + j * 258 + 4 * c4;
                h[0] = v[0] * r * gsc[4 * c4 + 0] + gsh[4 * c4 + 0]; h[1] = v[1] * r * gsc[4 * c4 + 1] + gsh[4 * c4 + 1];
                h[2] = v[2] * r * gsc[4 * c4 + 2] + gsh[4 * c4 + 2]; h[3] = v[3] * r * gsc[4 * c4 + 3] + gsh[4 * c4 + 3]; }
            __syncthreads();
            const int win = 2 << g, hw = win >> 1;
            for (int i = F.tid; i < 64 * 128; i += NTHREADS) { const int cp = i & 127, t = i >> 7; const int p = pos0 + t;
                int lo = p - hw, hi = p + hw - 1; lo = lo < 0 ? 0 : lo; hi = hi > L - 1 ? L - 1 : hi;
                const int jlo = lo - (pos0 - hl), jhi = hi - (pos0 - hl);
                float s0 = 0.f, s1 = 0.f;
                for (int j = jlo; j <= jhi; ++j) { const f32x2 v = *(const LAS f32x2*)(hb + j * 258 + 2 * cp); s0 += v[0]; s1 += v[1]; }
                const float ic = 1.0f / (float)(hi - lo + 1); const f32x2 hv = *(const LAS f32x2*)(hb + (t + hl) * 258 + 2 * cp);
                *(GAS unsigned*)(dbuf + (size_t)(tok0 + t) * D + g * 256 + 2 * cp) = cvt_pk_bf16(s0 * ic - hv[0], s1 * ic - hv[1]); }
        }
        __syncthreads();
    }
}

struct SchedPool {
    static constexpr bool SIDE = false; static constexpr bool XSYNC = false; static constexpr bool GATHER = false;
    int G, vcu; int nt; unsigned ldb;
    __device__ __forceinline__ bool next(int i, GU& u) const { const int L = i * G + vcu; if (L >= 130 * 4) return false; const int pm = L >> 2, g = L & 3;
        u.a = (unsigned)(WS_DBUF + ((size_t)pm * 256 * D + g * 256) * 2); u.b = (unsigned)(WS_WPOOL + (size_t)g * 256 * 256 * 2); u.i0 = pm; u.i1 = g; u.i2 = 0; u.i3 = 0; return true; }
    __device__ __forceinline__ void aoff(const GU&, const int (&R)[2], const int (&C)[2], unsigned (&v)[2][2]) const {
#pragma unroll
        for (int h = 0; h < 2; ++h)
#pragma unroll
            for (int i = 0; i < 2; ++i) v[h][i] = (unsigned)((h * 128 + R[i]) * D + C[i]) * 2u; }
};
struct EpiPool {
    static constexpr bool FP8 = false; static constexpr bool PERM = false;
    const float* x; const float* ctx; const float* ls; const float* gate_base; float* xs;
    __device__ __forceinline__ void operator()(const f32x4 (&acc)[2][2][4][2], const GU& u, int wr, int wc, int fr, int fq, const LAS float* sb) const {
        const int pm = u.i0, g = u.i1; const int mrow = pm < 128 ? (pm >> 6) : 2;
        const float* gate = gate_base + (size_t)mrow * NMOD * D;
        const float* src = pm < 128 ? x + (size_t)pm * 256 * D : ctx + (size_t)(pm - 128) * 256 * D;
        const int col0 = g * 256 + wc * 32 + 4 * fq;
        f32x4 gl[2][2];
#pragma unroll
        for (int bj = 0; bj < 2; ++bj)
#pragma unroll
            for (int n = 0; n < 2; ++n) { const int c = col0 + bj * 128 + n * 16; gl[bj][n] = *(const GAS f32x4*)(gate + c) * *(const GAS f32x4*)(ls + c); }
#pragma unroll
        for (int ai = 0; ai < 2; ++ai)
#pragma unroll
            for (int m = 0; m < 4; ++m) { const int r = ai * 128 + wr * 64 + m * 16 + fr; const float* sp = src + (size_t)r * D + col0; float* op = xs + ((size_t)pm * 256 + r) * D + col0;
#pragma unroll
                for (int bj = 0; bj < 2; ++bj)
#pragma unroll
                    for (int n = 0; n < 2; ++n) *(GAS f32x4*)(op + bj * 128 + n * 16) = *(const GAS f32x4*)(sp + bj * 128 + n * 16) + gl[bj][n] * acc[ai][bj][m][n]; }
    }
};

__device__ __forceinline__ void phase_final_plain(const Frame& F, const Args& A, const float* xs) {
    const int gw = blockIdx.x * NWAVES + F.wave, NGW = F.G * NWAVES;
    for (int n = gw; n < NL; n += NGW) { const float* xr = xs + (size_t)n * D; f32x4 v[4]; float s = 0.f;
#pragma unroll
        for (int q = 0; q < 4; ++q) { v[q] = *(const GAS f32x4*)(xr + 4 * F.lane + 256 * q); s += v[q][0] * v[q][0] + v[q][1] * v[q][1] + v[q][2] * v[q][2] + v[q][3] * v[q][3]; }
        s = wave_sum(s); const float r = 1.0f / sqrtf(s * (1.0f / D) + NORM_EPS);
#pragma unroll
        for (int q = 0; q < 4; ++q) { const f32x4 g = *(const GAS f32x4*)(A.in[I_FINALG] + 4 * F.lane + 256 * q); *(GAS f32x4*)(A.out + (size_t)n * D + 4 * F.lane + 256 * q) = v[q] * r * g; }
    }
}


__device__ __forceinline__ int* cnt_word(const Frame& F, int l, int e) { return (int*)(F.ws + WS_CTL + CTL_CNT) + (l * NE + e) * 64; }
__device__ __forceinline__ void phase_post(const Frame& F, const Args& A, int l, const float* xs, int ntok) {
    LAS float* h2s = (LAS float*)F.scr;
    LAS float* part = (LAS float*)F.scr;
    LAS float* lgs = (LAS float*)(F.scr + 32 * 1028 * 4);
    LAS int* hist = (LAS int*)(lgs + 32 * 33);
    LAS int* base = hist + 32;
    LAS int* sel = base + 32;
    LAS int* lrank = sel + 128;
    unsigned char* H2 = F.ws + WS_H2;
    int* list = (int*)(F.ws + WS_LIST) + (size_t)l * NE * NTOK;
    int* tinfo = (int*)(F.ws + WS_TINFO) + (size_t)l * NTOK * 4;
    float* tgate = (float*)(F.ws + WS_TGATE) + (size_t)l * NTOK * 4;
    const float* ng = A.in[I_NORMG] + (size_t)(l * 2 + 1) * D;
    const float* rw = A.in[I_RW] + (size_t)l * D * NE;
    const float* rb = A.in[I_RB] + (size_t)l * NE;
    const int ntiles = ntok / 32;
    for (int tile = blockIdx.x; tile < ntiles; tile += F.G) {
        const int n0 = tile * 32, mrow = mrow_of(n0);
        const float* sc = modp(F, l, mrow, 4); const float* sh = modp(F, l, mrow, 3);
        if (F.tid < 32) hist[F.tid] = 0;
#pragma unroll 1
        for (int q = 0; q < 4; ++q) { const int tt = F.wave * 4 + q, n = n0 + tt; const float* xr = xs + (size_t)n * D; f32x4 v[4]; float s = 0.f;
#pragma unroll
            for (int jj = 0; jj < 4; ++jj) { v[jj] = *(const GAS f32x4*)(xr + 4 * F.lane + 256 * jj); s += v[jj][0] * v[jj][0] + v[jj][1] * v[jj][1] + v[jj][2] * v[jj][2] + v[jj][3] * v[jj][3]; }
            s = wave_sum(s); const float r = 1.0f / sqrtf(s * (1.0f / D) + NORM_EPS);
#pragma unroll
            for (int jj = 0; jj < 4; ++jj) { const int c = 4 * F.lane + 256 * jj; const f32x4 g = *(const GAS f32x4*)(ng + c), a = *(const GAS f32x4*)(sc + c), b = *(const GAS f32x4*)(sh + c);
                const f32x4 h = v[jj] * r * g * (a + 1.0f) + b;
                *(LAS f32x4*)(h2s + tt * 1028 + c) = h;
                *(GAS unsigned*)(H2 + (size_t)n * D + c) = pk4_fp8(h[0], h[1], h[2], h[3]); } }
        __syncthreads();
        f32x16 acc;
#pragma unroll
        for (int i = 0; i < 16; ++i) acc[i] = 0.f;
        { const int r = F.lane & 31, h = F.lane >> 5;
#pragma unroll 4
          for (int q = 0; q < 16; ++q) { const int kb = 128 * F.wave + 8 * q + 4 * h; const f32x4 a = *(const LAS f32x4*)(h2s + r * 1028 + kb);
              const float b0 = rw[(size_t)(kb + 0) * NE + r], b1 = rw[(size_t)(kb + 1) * NE + r], b2 = rw[(size_t)(kb + 2) * NE + r], b3 = rw[(size_t)(kb + 3) * NE + r];
              acc = __builtin_amdgcn_mfma_f32_32x32x2f32(a[0], b0, acc, 0, 0, 0); acc = __builtin_amdgcn_mfma_f32_32x32x2f32(a[1], b1, acc, 0, 0, 0);
              acc = __builtin_amdgcn_mfma_f32_32x32x2f32(a[2], b2, acc, 0, 0, 0); acc = __builtin_amdgcn_mfma_f32_32x32x2f32(a[3], b3, acc, 0, 0, 0); } }
        __syncthreads();
#pragma unroll
        for (int i = 0; i < 16; ++i) { const int row = (i & 3) + 8 * (i >> 2) + 4 * (F.lane >> 5), col = F.lane & 31; part[(F.wave * 32 + row) * 32 + col] = acc[i]; }
        __syncthreads();
        for (int i = F.tid; i < 1024; i += NTHREADS) { const int row = i >> 5, col = i & 31; float s = rb[col];
#pragma unroll
            for (int w = 0; w < 8; ++w) s += part[(w * 32 + row) * 32 + col];
            lgs[row * 33 + col] = s; }
        __syncthreads();
        if (F.tid < 32) { const int t = F.tid; float lv[32];
#pragma unroll
            for (int e = 0; e < 32; ++e) lv[e] = lgs[t * 33 + e];
            float tv[4]; int te[4];
#pragma unroll
            for (int j = 0; j < 4; ++j) { float best = -3.0e38f; int be = 0;
#pragma unroll
                for (int e = 0; e < 32; ++e) { const bool gt = lv[e] > best; best = gt ? lv[e] : best; be = gt ? e : be; }
                tv[j] = best; te[j] = be;
#pragma unroll
                for (int e = 0; e < 32; ++e) lv[e] = (e == be) ? -3.0e38f : lv[e]; }
            const float e1 = __expf(tv[1] - tv[0]), e2 = __expf(tv[2] - tv[0]), e3 = __expf(tv[3] - tv[0]); const float inv = 1.0f / (1.0f + e1 + e2 + e3);
            const float gt[4] = {inv, e1 * inv, e2 * inv, e3 * inv};
#pragma unroll
            for (int j = 0; j < 4; ++j) { sel[t * 4 + j] = te[j]; lrank[t * 4 + j] = __hip_atomic_fetch_add(&hist[te[j]], 1, __ATOMIC_RELAXED, __HIP_MEMORY_SCOPE_WORKGROUP);
                tgate[(size_t)(n0 + t) * 4 + j] = gt[j]; } }
        __syncthreads();
        if (F.tid < 32) { const int c = hist[F.tid]; base[F.tid] = c > 0 ? __hip_atomic_fetch_add(cnt_word(F, l, F.tid), c, __ATOMIC_RELAXED, __HIP_MEMORY_SCOPE_AGENT) : 0; }
        __syncthreads();
        if (F.tid < 128) { const int t = F.tid >> 2, e = sel[F.tid], pos = base[e] + lrank[F.tid]; list[(size_t)e * NTOK + pos] = n0 + t; tinfo[(size_t)(n0 + t) * 4 + (F.tid & 3)] = (e << 16) | pos; }
        __syncthreads();
    }
}

__device__ __forceinline__ void moe_prefix(const Frame& F, int l) {
    volatile LAS int* M = (volatile LAS int*)(F.lds + MISC_OFF);
    __syncthreads();
    if (F.tid == 0) { int acc = 0; for (int e = 0; e < NE; ++e) { const int c = __hip_atomic_load(cnt_word(F, l, e), __ATOMIC_RELAXED, __HIP_MEMORY_SCOPE_AGENT); M[64 + e] = c; M[16 + e] = acc; acc += (c + 255) >> 8; } M[16 + NE] = acc; }
    __syncthreads();
    { volatile LAS unsigned char* T2E = (volatile LAS unsigned char*)(F.lds + MISC_OFF + 448);
      for (int t = F.tid; t < 560; t += NTHREADS) { int e = 0; while (e < NE - 1 && M[16 + e + 1] <= t) ++e; T2E[t] = (unsigned char)e; } }
    __syncthreads();
}

struct SchedMoe1 {
    static constexpr bool SIDE = true; static constexpr bool XSYNC = false; static constexpr bool GATHER = true;
    const LAS int* M; const int* list; unsigned h2; unsigned w; int G, vcu; int nt; unsigned ldb; unsigned* xw; unsigned nloc; int rounds; __amdgpu_buffer_rsrc_t rsrcb; unsigned listoff;
    __device__ __forceinline__ bool side_src(const GU& u, int tid, unsigned& off) const { const int e = u.i0, pn = u.i2;
        if (tid < 256) { const int row0 = (u.i1 - M[16 + e]) * 256, nv = M[64 + e] - row0; off = listoff + (unsigned)(e * NTOK + row0 + (tid < nv ? tid : 0)) * 4u; return false; }
        const int j = tid - 256; off = (unsigned)(e * 2048 + (j < 128 ? 0 : 1024) + pn * 128 + (j & 127)) * 4u; return true; }
    __device__ __forceinline__ unsigned tok_off(int tok, int c) const { return (unsigned)(tok * D + 2 * c); }
    __device__ __forceinline__ bool next(int i, GU& u) const { const int L = i * G + vcu; const int tt = M[16 + NE]; if (L >= tt * 8) return false; const int mt = L >> 3, pn = L & 7;
        const int e = ((const LAS unsigned char*)M)[448 + mt];
        u.a = h2; u.b = w + (unsigned)(((size_t)e * 2048 + pn * 256) * 1024); u.i0 = e; u.i1 = mt; u.i2 = pn; u.i3 = 0; return true; }
    __device__ __forceinline__ void aoff(const GU& u, const int (&R)[2], const int (&C)[2], unsigned (&v)[2][2]) const {
        const int e = u.i0, row0 = (u.i1 - M[16 + e]) * 256, nv = M[64 + e] - row0; const int* lp = list + (size_t)e * NTOK + row0;
#pragma unroll
        for (int h = 0; h < 2; ++h)
#pragma unroll
            for (int i = 0; i < 2; ++i) { const int r = h * 128 + R[i]; const int tok = lp[r < nv ? r : 0]; v[h][i] = (unsigned)(tok * D + 2 * C[i]); } }
};
struct EpiMoe1 {
    static constexpr bool FP8 = true; static constexpr bool PERM = true;
    const float* bgu; unsigned char* act;
    __device__ __forceinline__ void operator()(const f32x4 (&acc)[2][2][4][2], const GU& u, int wr, int wc, int fr, int fq, const LAS float* sb) const {
        const int e = u.i0, mt = u.i1, pn = u.i2; const int col0 = pn * 128 + wc * 32 + 8 * fq;
        f32x4 bg[2], bu[2];
#pragma unroll
        for (int n = 0; n < 2; ++n) { bg[n] = *(const LAS f32x4*)(sb + wc * 32 + 8 * fq + 4 * n); bu[n] = *(const LAS f32x4*)(sb + 128 + wc * 32 + 8 * fq + 4 * n); }
#pragma unroll
        for (int ai = 0; ai < 2; ++ai)
#pragma unroll
            for (int m = 0; m < 4; ++m) { const size_t slot = (size_t)mt * 256 + ai * 128 + wr * 64 + m * 16 + fr; float o[8];
#pragma unroll
                for (int n = 0; n < 2; ++n)
#pragma unroll
                    for (int j = 0; j < 4; ++j) { float g = acc[ai][0][m][n][j] + bg[n][j], up = acc[ai][1][m][n][j] + bu[n][j];
                        g = fminf(g, 7.0f); up = fminf(fmaxf(up, -7.0f), 7.0f); o[4 * n + j] = (up + 1.0f) * (g * __builtin_amdgcn_rcpf(1.0f + __expf(-1.702f * g))); }
                u32x2 w; w.x = pk4_fp8(o[0], o[1], o[2], o[3]); w.y = pk4_fp8(o[4], o[5], o[6], o[7]);
                *(GAS u32x2*)(act + slot * D + col0) = w; }
    }
};
struct SchedMoe2 {
    static constexpr bool SIDE = true; static constexpr bool XSYNC = false; static constexpr bool GATHER = false;
    const LAS int* M; unsigned act; unsigned w; int G, vcu; int nt; unsigned ldb; unsigned* xw; unsigned nloc; int rounds; __amdgpu_buffer_rsrc_t rsrcb;
    __device__ __forceinline__ bool side_src(const GU& u, int tid, unsigned& off) const { const int e = u.i0, pn = u.i2;
        if (tid < 256) { off = 0u; return false; }
        off = (unsigned)(e * D + pn * 256 + (tid - 256)) * 4u; return true; }
    __device__ __forceinline__ bool next(int i, GU& u) const { const int L = i * G + vcu; const int tt = M[16 + NE]; if (L >= tt * 4) return false; const int mt = L >> 2, pn = L & 3;
        const int e = ((const LAS unsigned char*)M)[448 + mt];
        u.a = act + (unsigned)((size_t)mt * 256 * D); u.b = w + (unsigned)(((size_t)e * 1024 + pn * 256) * 1024); u.i0 = e; u.i1 = mt; u.i2 = pn; u.i3 = 0; return true; }
    __device__ __forceinline__ void aoff(const GU&, const int (&R)[2], const int (&C)[2], unsigned (&v)[2][2]) const {
#pragma unroll
        for (int h = 0; h < 2; ++h)
#pragma unroll
            for (int i = 0; i < 2; ++i) v[h][i] = (unsigned)((h * 128 + R[i]) * D + 2 * C[i]); }
};
struct EpiMoe2 {
    static constexpr bool FP8 = true; static constexpr bool PERM = true;
    const float* bdn; bf16_t* y2;
    __device__ __forceinline__ void operator()(const f32x4 (&acc)[2][2][4][2], const GU& u, int wr, int wc, int fr, int fq, const LAS float* sb) const {
        const int e = u.i0, mt = u.i1, pn = u.i2; const int col0 = pn * 256 + wc * 32 + 8 * fq;
        f32x4 bv[2][2];
#pragma unroll
        for (int bj = 0; bj < 2; ++bj)
#pragma unroll
            for (int n = 0; n < 2; ++n) bv[bj][n] = *(const LAS f32x4*)(sb + bj * 128 + wc * 32 + 8 * fq + 4 * n);
#pragma unroll
        for (int ai = 0; ai < 2; ++ai)
#pragma unroll
            for (int m = 0; m < 4; ++m) { const size_t slot = (size_t)mt * 256 + ai * 128 + wr * 64 + m * 16 + fr;
#pragma unroll
                for (int bj = 0; bj < 2; ++bj) { const f32x4 v0 = acc[ai][bj][m][0] + bv[bj][0], v1 = acc[ai][bj][m][1] + bv[bj][1];
                    u32x4 w; w.x = cvt_pk_bf16(v0[0], v0[1]); w.y = cvt_pk_bf16(v0[2], v0[3]); w.z = cvt_pk_bf16(v1[0], v1[1]); w.w = cvt_pk_bf16(v1[2], v1[3]);
                    *(GAS u32x4*)(y2 + slot * D + col0 + bj * 128) = w; } }
    }
};
__device__ __forceinline__ void phase_moe1(const Frame& F, const Args& A, int l) {
    moe_prefix(F, l);
    SchedMoe1 S{(const LAS int*)(F.lds + MISC_OFF), (const int*)(F.ws + WS_LIST) + (size_t)l * NE * NTOK, (unsigned)WS_H2, (unsigned)(WS_WGU + (size_t)l * NE * 2048 * 1024), F.G, F.vcu, 8, 1024u,
                (unsigned*)(F.ws + WS_CTL + CTL_XSYNC) + ((l * 2 + 0) * 16 + xb_xcc_id()) * 32, ((volatile LAS unsigned*)(F.lds + MISC_OFF))[8], (((const LAS int*)(F.lds + MISC_OFF))[16 + NE] * 8 + F.G - 1) / F.G,
                __builtin_amdgcn_make_buffer_rsrc((void*)(A.in[I_BGU] + (size_t)l * NE * 2048), 0, NE * 2048 * 4, 0x00020000), (unsigned)(WS_LIST + (size_t)l * NE * NTOK * 4)};
    EpiMoe1 E{A.in[I_BGU] + (size_t)l * NE * 2048, F.ws + WS_ACT};
    pg8::gemm_phase<EpiMoe1, SchedMoe1>(F.scr, F.ws, S, E);
}
__device__ __forceinline__ void phase_moe2(const Frame& F, const Args& A, int l) {
    moe_prefix(F, l);
    SchedMoe2 S{(const LAS int*)(F.lds + MISC_OFF), (unsigned)WS_ACT, (unsigned)(WS_WDN + (size_t)l * NE * 1024 * 1024), F.G, F.vcu, 8, 1024u,
                (unsigned*)(F.ws + WS_CTL + CTL_XSYNC) + ((l * 2 + 1) * 16 + xb_xcc_id()) * 32, ((volatile LAS unsigned*)(F.lds + MISC_OFF))[8], (((const LAS int*)(F.lds + MISC_OFF))[16 + NE] * 4 + F.G - 1) / F.G,
                __builtin_amdgcn_make_buffer_rsrc((void*)(A.in[I_BDN] + (size_t)l * NE * D), 0, NE * D * 4, 0x00020000)};
    EpiMoe2 E{A.in[I_BDN] + (size_t)l * NE * D, (bf16_t*)(F.ws + WS_Y2)};
    pg8::gemm_phase<EpiMoe2, SchedMoe2>(F.scr, F.ws, S, E);
}
__device__ __forceinline__ void moe_combine_row(const Frame& F, int l, int n, f32x4 (&o)[4]) {
    const volatile LAS int* M = (const volatile LAS int*)(F.lds + MISC_OFF);
    const int* ti = (const int*)(F.ws + WS_TINFO) + ((size_t)l * NTOK + n) * 4; const float* tg = (const float*)(F.ws + WS_TGATE) + ((size_t)l * NTOK + n) * 4;
    const bf16_t* y2 = (const bf16_t*)(F.ws + WS_Y2);
#pragma unroll
    for (int q = 0; q < 4; ++q) o[q] = (f32x4){0.f, 0.f, 0.f, 0.f};
#pragma unroll
    for (int j = 0; j < 4; ++j) { const int inf = ti[j]; const float g = tg[j]; const int e = inf >> 16, pos = inf & 0xffff; const size_t slot = (size_t)M[16 + e] * 256 + pos;
#pragma unroll
        for (int q = 0; q < 4; ++q) { const u32x2 w = *(const GAS u32x2*)(y2 + slot * D + 4 * F.lane + 256 * q);
            o[q] += (f32x4){bf_lo(w.x), bf_hi(w.x), bf_lo(w.y), bf_hi(w.y)} * g; } }
}
__device__ __forceinline__ void phase_final(const Frame& F, const Args& A, int l, const float* xs) {
    moe_prefix(F, l);
    const int gw = blockIdx.x * NWAVES + F.wave, NGW = F.G * NWAVES;
    for (int n = gw; n < NL; n += NGW) { const float* xr = xs + (size_t)n * D; const float* gate = modp(F, l, n >> 14, 5); f32x4 v[4], mo[4]; float s = 0.f;
        moe_combine_row(F, l, n, mo);
#pragma unroll
        for (int q = 0; q < 4; ++q) { const int c = 4 * F.lane + 256 * q; v[q] = *(const GAS f32x4*)(xr + c) + *(const GAS f32x4*)(gate + c) * mo[q]; s += v[q][0] * v[q][0] + v[q][1] * v[q][1] + v[q][2] * v[q][2] + v[q][3] * v[q][3]; }
        s = wave_sum(s); const float r = 1.0f / sqrtf(s * (1.0f / D) + NORM_EPS);
#pragma unroll
        for (int q = 0; q < 4; ++q) { const f32x4 g = *(const GAS f32x4*)(A.in[I_FINALG] + 4 * F.lane + 256 * q); *(GAS f32x4*)(A.out + (size_t)n * D + 4 * F.lane + 256 * q) = v[q] * r * g; }
    }
}


__device__ __forceinline__ void phase_pre1(const Frame& F, const Args& A) {
    moe_prefix(F, 0);
    LAS float* hs = (LAS float*)F.scr;
    const float* xs0 = (const float*)(F.ws + WS_XS0); float* xs1 = (float*)(F.ws + WS_XS1);
    const float* ng = A.in[I_NORMG] + (size_t)(1 * 2 + 0) * D;
    for (int tile = blockIdx.x; tile < NTOK / 32; tile += F.G) {
        const int n0 = tile * 32, mrow = mrow_of(n0);
        const int sbeg = n0 < NL ? (n0 & ~(TSEQ - 1)) : (NL + ((n0 - NL) & ~(CT - 1))), send = sbeg + (n0 < NL ? TSEQ : CT);
        const float* gate5 = modp(F, 0, mrow, 5); const float* sc = modp(F, 1, mrow, 1); const float* sh = modp(F, 1, mrow, 0);
        for (int j = F.wave; j < 34; j += NWAVES) { const int n = n0 - 1 + j;
            if (n < sbeg || n >= send) {
#pragma unroll
                for (int q = 0; q < 4; ++q) *(LAS f32x4*)(hs + j * 1028 + 4 * F.lane + 256 * q) = (f32x4){0.f, 0.f, 0.f, 0.f};
                continue; }
            f32x4 mo[4], v[4]; float s = 0.f; moe_combine_row(F, 0, n, mo);
#pragma unroll
            for (int q = 0; q < 4; ++q) { const int c = 4 * F.lane + 256 * q; v[q] = *(const GAS f32x4*)(xs0 + (size_t)n * D + c) + *(const GAS f32x4*)(gate5 + c) * mo[q];
                s += v[q][0] * v[q][0] + v[q][1] * v[q][1] + v[q][2] * v[q][2] + v[q][3] * v[q][3]; }
            if (j >= 1 && j <= 32) {
#pragma unroll
                for (int q = 0; q < 4; ++q) *(GAS f32x4*)(xs1 + (size_t)n * D + 4 * F.lane + 256 * q) = v[q]; }
            s = wave_sum(s); const float r = 1.0f / sqrtf(s * (1.0f / D) + NORM_EPS);
#pragma unroll
            for (int q = 0; q < 4; ++q) { const int c = 4 * F.lane + 256 * q; const f32x4 g = *(const GAS f32x4*)(ng + c), a = *(const GAS f32x4*)(sc + c), b = *(const GAS f32x4*)(sh + c);
                *(LAS f32x4*)(hs + j * 1028 + c) = v[q] * r * g * (a + 1.0f) + b; } }
        __syncthreads();
#pragma unroll 1
        for (int q4 = 0; q4 < 4; ++q4) { const int t = F.wave * 4 + q4, j = t + 1, n = n0 + t;
#pragma unroll
            for (int q = 0; q < 4; ++q) { const int c = 4 * F.lane + 256 * q;
                const f32x4 hm = *(const LAS f32x4*)(hs + (j - 1) * 1028 + c), h0 = *(const LAS f32x4*)(hs + j * 1028 + c), hp = *(const LAS f32x4*)(hs + (j + 1) * 1028 + c);
                const f32x4 xx = (hm + hp) * 0.5f - h0;
#pragma unroll
                for (int i = 0; i < 6; ++i) { const f32x4 mu = *(const GAS f32x4*)(A.in[I_MU] + (size_t)i * D + c); const f32x4 o = h0 + xx * mu;
                    u32x2 w; w.x = cvt_pk_bf16(o[0], o[1]); w.y = cvt_pk_bf16(o[2], o[3]);
                    *(GAS u32x2*)((bf16_t*)(F.ws + WS_MIX + (size_t)i * ACTB) + (size_t)n * D + c) = w; } } }
        __syncthreads();
    }
}

struct SchedProj {
    static constexpr bool SIDE = false; static constexpr bool XSYNC = false; static constexpr bool GATHER = false;
    int G, vcu; int nt; unsigned ldb;
    __device__ __forceinline__ bool next(int i, GU& u) const { int L = i * G + vcu; if (L >= 1940) return false;
        int kind, mi, wi, pm, pn;
        if (L < 512) { kind = 0; mi = 0; wi = 0; pm = L >> 2; pn = L & 3; }
        else if (L < 1032) { L -= 512; kind = 0; mi = 2; wi = 1; pm = L >> 2; pn = L & 3; }
        else if (L < 1552) { L -= 1032; kind = 0; mi = 3; wi = 2; pm = L >> 2; pn = L & 3; }
        else if (L < 1682) { L -= 1552; kind = 1; mi = 1; wi = 0; pm = L; pn = 0; }
        else if (L < 1812) { L -= 1682; kind = 2; mi = 4; wi = 1; pm = L; pn = 0; }
        else { L -= 1812; kind = 3; mi = 5; wi = 2; pm = L; pn = 0; }
        u.a = (unsigned)(WS_MIX + (size_t)mi * ACTB + (size_t)pm * 256 * D * 2);
        u.b = kind == 0 ? (unsigned)(WS_WRKV + ((size_t)wi * 1024 + pn * 256) * 1024 * 2) : (unsigned)(WS_WL1 + (size_t)wi * 256 * 1024 * 2);
        u.i0 = pm; u.i1 = pn; u.i2 = kind; u.i3 = wi; return true; }
    __device__ __forceinline__ void aoff(const GU&, const int (&R)[2], const int (&C)[2], unsigned (&v)[2][2]) const {
#pragma unroll
        for (int h = 0; h < 2; ++h)
#pragma unroll
            for (int i = 0; i < 2; ++i) v[h][i] = (unsigned)((h * 128 + R[i]) * D + C[i]) * 2u; }
};
struct EpiProj {
    static constexpr bool FP8 = false; static constexpr bool PERM = true;
    unsigned char* ws;
    __device__ __forceinline__ void operator()(const f32x4 (&acc)[2][2][4][2], const GU& u, int wr, int wc, int fr, int fq, const LAS float* sb) const {
        const int pm = u.i0, pn = u.i1, kind = u.i2, wi = u.i3;
        if (kind == 0) { bf16_t* o = (bf16_t*)(ws + WS_RKV + (size_t)wi * ACTB); const int col0 = pn * 256 + wc * 32 + 8 * fq;
#pragma unroll
            for (int ai = 0; ai < 2; ++ai)
#pragma unroll
                for (int m = 0; m < 4; ++m) { const size_t n = (size_t)pm * 256 + ai * 128 + wr * 64 + m * 16 + fr;
#pragma unroll
                    for (int bj = 0; bj < 2; ++bj) { const f32x4 v0 = acc[ai][bj][m][0], v1 = acc[ai][bj][m][1];
                        u32x4 w; w.x = cvt_pk_bf16(v0[0], v0[1]); w.y = cvt_pk_bf16(v0[2], v0[3]); w.z = cvt_pk_bf16(v1[0], v1[1]); w.w = cvt_pk_bf16(v1[2], v1[3]);
                        *(GAS u32x4*)(o + n * D + col0 + bj * 128) = w; } }
        } else { bf16_t* o = (bf16_t*)(ws + WS_LACT + (size_t)(kind - 1) * NTOK * 128 * 2); const int col0 = wc * 32 + 8 * fq;
#pragma unroll
            for (int ai = 0; ai < 2; ++ai)
#pragma unroll
                for (int m = 0; m < 4; ++m) { const size_t n = (size_t)pm * 256 + ai * 128 + wr * 64 + m * 16 + fr; float t[8];
#pragma unroll
                    for (int nn = 0; nn < 2; ++nn)
#pragma unroll
                        for (int j = 0; j < 4; ++j) { const float x = acc[ai][0][m][nn][j]; t[4 * nn + j] = kind == 1 ? tanhf(x) : (kind == 2 ? x : sigmoidf_(x)); }
                    u32x4 w; w.x = cvt_pk_bf16(t[0], t[1]); w.y = cvt_pk_bf16(t[2], t[3]); w.z = cvt_pk_bf16(t[4], t[5]); w.w = cvt_pk_bf16(t[6], t[7]);
                    *(GAS u32x4*)(o + n * 128 + col0) = w; } }
    }
};
struct SchedLora2 {
    static constexpr bool SIDE = false; static constexpr bool XSYNC = false; static constexpr bool GATHER = false;
    int G, vcu; int nt; unsigned ldb;
    __device__ __forceinline__ bool next(int i, GU& u) const { int L = i * G + vcu; if (L >= 4 * 520 + 512) return false;
        const int o = L < 2080 ? L / 520 : 4; L -= o * 520; const int pm = L >> 2, pn = L & 3; const int oa = o < 4 ? (o >> 1) : 2;
        u.a = (unsigned)(WS_LACT + (size_t)oa * NTOK * 128 * 2 + (size_t)pm * 256 * 128 * 2); u.b = (unsigned)(WS_WL2 + ((size_t)o * 1024 + pn * 256) * 128 * 2);
        u.i0 = pm; u.i1 = pn; u.i2 = o; u.i3 = 0; return true; }
    __device__ __forceinline__ void aoff(const GU&, const int (&R)[2], const int (&C)[2], unsigned (&v)[2][2]) const {
#pragma unroll
        for (int h = 0; h < 2; ++h)
#pragma unroll
            for (int i = 0; i < 2; ++i) v[h][i] = (unsigned)((h * 128 + R[i]) * 128 + C[i]) * 2u; }
};
struct EpiLora2 {
    static constexpr bool FP8 = false; static constexpr bool PERM = false;
    unsigned char* ws; const float* w0; const float* a0;
    __device__ __forceinline__ void operator()(const f32x4 (&acc)[2][2][4][2], const GU& u, int wr, int wc, int fr, int fq, const LAS float* sb) const {
        const int pm = u.i0, pn = u.i1, o = u.i2; const int col0 = pn * 256 + wc * 32 + 4 * fq;
        const float* bp = (o < 2 ? w0 + (size_t)o * D : a0 + (size_t)(o & 1) * D) + col0; const float bsc = o < 4 ? 1.0f : 0.0f;
        f32x4 bv[2][2];
#pragma unroll
        for (int bj = 0; bj < 2; ++bj)
#pragma unroll
            for (int n = 0; n < 2; ++n) bv[bj][n] = *(const GAS f32x4*)(bp + bj * 128 + n * 16) * bsc;
        const size_t row0 = (size_t)pm * 256 + wr * 64 + fr;
        if (o < 2) { bf16_t* dst = (bf16_t*)(ws + WS_DEC + (size_t)o * ACTB) + row0 * D + col0;
#pragma unroll
            for (int ai = 0; ai < 2; ++ai)
#pragma unroll
                for (int m = 0; m < 4; ++m)
#pragma unroll
                    for (int bj = 0; bj < 2; ++bj)
#pragma unroll
                        for (int nn = 0; nn < 2; ++nn) { const f32x4 z = acc[ai][bj][m][nn] + bv[bj][nn]; f32x4 d;
#pragma unroll
                            for (int j = 0; j < 4; ++j) d[j] = -0.60653066f * sigmoidf_(z[j]);
                            u32x2 w; w.x = cvt_pk_bf16(d[0], d[1]); w.y = cvt_pk_bf16(d[2], d[3]);
                            *(GAS u32x2*)(dst + (size_t)(ai * 128 + m * 16) * D + bj * 128 + nn * 16) = w; }
        } else { bf16_t* dst = (o < 4 ? (bf16_t*)(ws + WS_ICL + (size_t)(o - 2) * ACTB) : (bf16_t*)(ws + WS_G)) + row0 * D + col0; const bool sg = o < 4;
#pragma unroll
            for (int ai = 0; ai < 2; ++ai)
#pragma unroll
                for (int m = 0; m < 4; ++m)
#pragma unroll
                    for (int bj = 0; bj < 2; ++bj)
#pragma unroll
                        for (int nn = 0; nn < 2; ++nn) { f32x4 z = acc[ai][bj][m][nn] + bv[bj][nn];
#pragma unroll
                            for (int j = 0; j < 4; ++j) z[j] = sg ? sigmoidf_(z[j]) : z[j];
                            u32x2 w; w.x = cvt_pk_bf16(z[0], z[1]); w.y = cvt_pk_bf16(z[2], z[3]);
                            *(GAS u32x2*)(dst + (size_t)(ai * 128 + m * 16) * D + bj * 128 + nn * 16) = w; }
        }
    }
};
__device__ __forceinline__ void ld16bf(const bf16_t* p, float (&o)[16]) { const u32x4 a = *(const GAS u32x4*)p, b = *(const GAS u32x4*)(p + 8);
    o[0] = bf_lo(a.x); o[1] = bf_hi(a.x); o[2] = bf_lo(a.y); o[3] = bf_hi(a.y); o[4] = bf_lo(a.z); o[5] = bf_hi(a.z); o[6] = bf_lo(a.w); o[7] = bf_hi(a.w);
    o[8] = bf_lo(b.x); o[9] = bf_hi(b.x); o[10] = bf_lo(b.y); o[11] = bf_hi(b.y); o[12] = bf_lo(b.z); o[13] = bf_hi(b.z); o[14] = bf_lo(b.w); o[15] = bf_hi(b.w); }
__device__ __forceinline__ void st16bf(bf16_t* p, const float (&o)[16]) { u32x4 a, b;
    a.x = cvt_pk_bf16(o[0], o[1]); a.y = cvt_pk_bf16(o[2], o[3]); a.z = cvt_pk_bf16(o[4], o[5]); a.w = cvt_pk_bf16(o[6], o[7]);
    b.x = cvt_pk_bf16(o[8], o[9]); b.y = cvt_pk_bf16(o[10], o[11]); b.z = cvt_pk_bf16(o[12], o[13]); b.w = cvt_pk_bf16(o[14], o[15]);
    *(GAS u32x4*)p = a; *(GAS u32x4*)(p + 8) = b; }
__device__ __forceinline__ void ld16f(const float* p, float (&o)[16]) {
#pragma unroll
    for (int q = 0; q < 4; ++q) { const f32x4 v = *(const GAS f32x4*)(p + 4 * q); o[4 * q] = v[0]; o[4 * q + 1] = v[1]; o[4 * q + 2] = v[2]; o[4 * q + 3] = v[3]; } }
__device__ __forceinline__ void phase_fin(const Frame& F, const Args& A) {
    const int gw = blockIdx.x * NWAVES + F.wave, NGW = F.G * NWAVES; const int c0 = 16 * F.lane;
    float kkw[16], kaw[16]; ld16f(A.in[I_KK] + c0, kkw); ld16f(A.in[I_KA] + c0, kaw);
    const bf16_t* Kp = (const bf16_t*)(F.ws + WS_RKV + 1 * ACTB);
    for (int n = gw; n < NTOK; n += NGW) { const size_t off = (size_t)n * D + c0; float k[16], i0[16], i1[16], kk[16], o[16];
        ld16bf(Kp + off, k); ld16bf((const bf16_t*)(F.ws + WS_ICL) + off, i0); ld16bf((const bf16_t*)(F.ws + WS_ICL + ACTB) + off, i1);
        float ss = 0.f;
#pragma unroll
        for (int j = 0; j < 16; ++j) { kk[j] = k[j] * kkw[j]; ss += kk[j] * kk[j]; }
        ss += __shfl_xor(ss, 1); ss += __shfl_xor(ss, 2);
        const float inv = 1.0f / fmaxf(sqrtf(ss), 1e-12f);
#pragma unroll
        for (int j = 0; j < 16; ++j) kk[j] *= inv;
        st16bf((bf16_t*)(F.ws + WS_KK) + off, kk);
#pragma unroll
        for (int j = 0; j < 16; ++j) o[j] = k[j] * (1.0f + (i0[j] - 1.0f) * kaw[j]);
        st16bf((bf16_t*)(F.ws + WS_KDIR) + off, o);
#pragma unroll
        for (int j = 0; j < 16; ++j) o[j] = k[j] * (1.0f + (i1[j] - 1.0f) * kaw[j]);
        st16bf((bf16_t*)(F.ws + WS_KDIR + ACTB) + off, o);
#pragma unroll
        for (int j = 0; j < 16; ++j) o[j] = kk[j] * i0[j];
        st16bf((bf16_t*)(F.ws + WS_BV) + off, o);
#pragma unroll
        for (int j = 0; j < 16; ++j) o[j] = kk[j] * i1[j];
        st16bf((bf16_t*)(F.ws + WS_BV + ACTB) + off, o);
    }
}
constexpr int CK = 32, SNS = CT + TSEQ, CNCH = SNS / CK;
constexpr int RS = 144, TS = 80;
constexpr int OS_A = 0, OS_R = 4608, OS_KT = 9216, OS_BT = 14336, OS_VT = 19456, OS_GAM = 20736, OS_BYTES = 20992;
constexpr int OG_B = 0, OG_K = 4608, OG_BYTES = 9216;
constexpr int GM_KA = 0, GM_KR = 2560, GM_BR = 5120, GM_TT = 7680, GM_BYTES = 10240;
constexpr int RAW_BYTES = 5 * 4096 + 1024;
constexpr int L_OS = 0, L_OG = 3 * OS_BYTES, L_GM = L_OG + 2 * OG_BYTES, L_TSCR = L_GM + 2 * GM_BYTES, L_SSCR = L_TSCR + 5120, L_RAW = L_SSCR + 4864, L_SCAN_END = L_RAW + 2 * RAW_BYTES;
static_assert(L_SCAN_END <= SCR_BYTES, "scan LDS");
__device__ __forceinline__ int scan_token(int sg, int d, int b) { if (sg < CT) { const int t = d ? (CT - 1 - sg) : sg; return NL + b * CT + t; } const int u = sg - CT; const int t = d ? (TSEQ - 1 - u) : u; return b * TSEQ + t; }
__device__ __forceinline__ unsigned short f2bf(float f) { return (unsigned short)(cvt_pk_bf16(f, 0.f) & 0xffffu); }
__device__ __forceinline__ int acc_row(int p, int lane) { return (p & 3) + 8 * (p >> 2) + 4 * (lane >> 5); }
__device__ __forceinline__ void st_acc32(LAS unsigned char* dst, const f32x16& a, int lane) {
#pragma unroll
    for (int p = 0; p < 16; ++p) *(LAS unsigned short*)(dst + acc_row(p, lane) * TS + 2 * (lane & 31)) = f2bf(a[p]);
}
__device__ __forceinline__ bf16x8 acc_bfrag(const f32x16& a, int s) { u32x4 w; w.x = cvt_pk_bf16(a[8 * s + 0], a[8 * s + 1]); w.y = cvt_pk_bf16(a[8 * s + 2], a[8 * s + 3]); w.z = cvt_pk_bf16(a[8 * s + 4], a[8 * s + 5]); w.w = cvt_pk_bf16(a[8 * s + 6], a[8 * s + 7]); return __builtin_bit_cast(bf16x8, w); }
__device__ __forceinline__ bf16x8 lds_afrag_perm(const LAS unsigned char* m, int s, int lane) { const LAS unsigned char* p = m + (lane & 31) * TS + 2 * (16 * s + 4 * (lane >> 5));
    const u32x2 lo = *(const LAS u32x2*)p, hi = *(const LAS u32x2*)(p + 16); u32x4 w; w.x = lo.x; w.y = lo.y; w.z = hi.x; w.w = hi.y; return __builtin_bit_cast(bf16x8, w); }
__device__ __forceinline__ f32x16 gram32(const LAS unsigned char* P, const LAS unsigned char* Q, int lane) {
    f32x16 c;
#pragma unroll
    for (int p = 0; p < 16; ++p) c[p] = 0.f;
#pragma unroll
    for (int s = 0; s < 4; ++s) { const bf16x8 a = *(const LAS bf16x8*)(P + (lane & 31) * RS + 32 * s + 16 * (lane >> 5)), b = *(const LAS bf16x8*)(Q + (lane & 31) * RS + 32 * s + 16 * (lane >> 5));
        c = __builtin_amdgcn_mfma_f32_32x32x16_bf16(a, b, c, 0, 0, 0); }
    return c;
}
__device__ __forceinline__ void phase_scan(const Frame& F, const Args& A) {
    LAS unsigned char* lds = F.scr;
    const int lane = F.lane, wave = F.wave;
    const __amdgpu_buffer_rsrc_t rsrc = __builtin_amdgcn_make_buffer_rsrc((void*)F.ws, 0, 0xffffffff, 0x00020000);
    for (int job = F.vcu; job < 256; job += F.G) {
        const int sd = job >> 2, rq = job & 3, d = sd & 1, bh = sd >> 1, b = bh >> 4, hd = bh & 15;
        f32x4 Xa[4];
#pragma unroll
        for (int t = 0; t < 4; ++t) Xa[t] = (f32x4){0.f, 0.f, 0.f, 0.f};
        const int pj = wave - 3;
#define SCAN_DMA(c) do { const int c_ = (c); LAS unsigned char* raw_ = lds + L_RAW + (c_ & 1) * RAW_BYTES; \
            _Pragma("unroll") for (int g = 0; g < 4; ++g) { const int row = 8 * g + (lane >> 3); const int sg = c_ * CK + row; const unsigned n = (unsigned)scan_token(sg, d, b); \
                const unsigned off = n * (unsigned)(D * 2) + (unsigned)(hd * 128 + (lane & 7) * 16); \
                __builtin_amdgcn_raw_ptr_buffer_load_lds(rsrc, (LAS void*)(raw_ + 0 * 4096 + g * 1024), 16, (int)(off + (unsigned)(WS_DEC + (size_t)d * ACTB)), 0, 0, 0); \
                __builtin_amdgcn_raw_ptr_buffer_load_lds(rsrc, (LAS void*)(raw_ + 1 * 4096 + g * 1024), 16, (int)(off + (unsigned)WS_KK), 0, 0, 0); \
                __builtin_amdgcn_raw_ptr_buffer_load_lds(rsrc, (LAS void*)(raw_ + 2 * 4096 + g * 1024), 16, (int)(off + (unsigned)(WS_BV + (size_t)d * ACTB)), 0, 0, 0); \
                __builtin_amdgcn_raw_ptr_buffer_load_lds(rsrc, (LAS void*)(raw_ + 3 * 4096 + g * 1024), 16, (int)(off + (unsigned)(WS_KDIR + (size_t)d * ACTB)), 0, 0, 0); \
                if (c_ >= CT / CK) __builtin_amdgcn_raw_ptr_buffer_load_lds(rsrc, (LAS void*)(raw_ + 4 * 4096 + g * 1024), 16, (int)(off + (unsigned)WS_RKV), 0, 0, 0); } \
            { const int row = lane >> 1; const unsigned n = (unsigned)scan_token(c_ * CK + row, d, b); \
              __builtin_amdgcn_raw_ptr_buffer_load_lds(rsrc, (LAS void*)(raw_ + 5 * 4096), 16, (int)(n * (unsigned)(D * 2) + (unsigned)(hd * 128 + rq * 32 + (lane & 1) * 16) + (unsigned)(WS_RKV + 2 * ACTB)), 0, 0, 0); } } while (0)
        __syncthreads();
        if (wave == 0) { for (int i = lane; i < 16 * RS / 4; i += 64) ((LAS unsigned*)(lds + L_SSCR))[i] = 0u; }
        if (wave == 7) { SCAN_DMA(0); SCAN_DMA(1); asm volatile("s_waitcnt vmcnt(0)" ::: "memory"); }
        __syncthreads();
        for (int it = -2; it < CNCH; ++it) {
            const int cs = it, cg = it + 1, cp = it + 2;
            if (wave >= 3 && wave <= 6) {
                if (cp < CNCH) {
                    const LAS unsigned char* raw = lds + L_RAW + (cp & 1) * RAW_BYTES;
                    LAS unsigned char* os = lds + L_OS + (cp % 3) * OS_BYTES; LAS unsigned char* og = lds + L_OG + (cp & 1) * OG_BYTES;
                    float Lpre = 0.f, Ltot = 0.f, lwv[8];
#pragma unroll
                    for (int m = 0; m < 32; ++m) { const float x = bf2f(*(const LAS unsigned short*)(raw + m * 128 + 2 * lane)); Ltot += x; if (m < 8 * pj) Lpre += x; if (m >= 8 * pj && m < 8 * pj + 8) lwv[m & 7] = x; }
                    const float gam = __expf(Ltot);
                    if (pj == 0) *(LAS float*)(os + OS_GAM + 4 * lane) = gam;
                    float Lr = Lpre; float kt[8], bt[8]; const bool has_r = cp >= CT / CK;
#pragma unroll
                    for (int j = 0; j < 8; ++j) { const int m = 8 * pj + j; const float lw = lwv[j]; const float Lp = Lr; Lr += lw;
                        const float eprev = __expf(Lp), em = __expf(-Lr), ep = __expf(Lr), et = gam * em;
                        const float kk = bf2f(*(const LAS unsigned short*)(raw + 4096 + m * 128 + 2 * lane)), bb = bf2f(*(const LAS unsigned short*)(raw + 8192 + m * 128 + 2 * lane)),
                                    kd = bf2f(*(const LAS unsigned short*)(raw + 12288 + m * 128 + 2 * lane)), r = has_r ? bf2f(*(const LAS unsigned short*)(raw + 16384 + m * 128 + 2 * lane)) : 0.f;
                        *(LAS unsigned short*)(os + OS_A + m * RS + 2 * lane) = f2bf(kk * eprev);
                        *(LAS unsigned short*)(os + OS_R + m * RS + 2 * lane) = f2bf(r * ep);
                        *(LAS unsigned short*)(og + OG_B + m * RS + 2 * lane) = f2bf(bb * em);
                        *(LAS unsigned short*)(og + OG_K + m * RS + 2 * lane) = f2bf(kd * em);
                        kt[j] = kd * et; bt[j] = -bb * et; }
#pragma unroll
                    for (int g = 0; g < 2; ++g) { u32x2 w; w.x = cvt_pk_bf16(kt[4 * g], kt[4 * g + 1]); w.y = cvt_pk_bf16(kt[4 * g + 2], kt[4 * g + 3]);
                        *(LAS u32x2*)(os + OS_KT + lane * TS + 2 * (8 * pj + 4 * g)) = w;
                        w.x = cvt_pk_bf16(bt[4 * g], bt[4 * g + 1]); w.y = cvt_pk_bf16(bt[4 * g + 2], bt[4 * g + 3]);
                        *(LAS u32x2*)(os + OS_BT + lane * TS + 2 * (8 * pj + 4 * g)) = w; }
                }
            } else if (wave == 7) {
                if (cp + 1 < CNCH && it >= -1) SCAN_DMA(cp + 1);
                if (cp < CNCH) { const LAS unsigned char* raw = lds + L_RAW + (cp & 1) * RAW_BYTES; LAS unsigned char* os = lds + L_OS + (cp % 3) * OS_BYTES;
                    unsigned short rv[8];
#pragma unroll
                    for (int j = 0; j < 8; ++j) rv[j] = *(const LAS unsigned short*)(raw + 5 * 4096 + (8 * (lane >> 4) + j) * 32 + 2 * (lane & 15));
                    u32x4 w; w.x = (unsigned)rv[0] | ((unsigned)rv[1] << 16); w.y = (unsigned)rv[2] | ((unsigned)rv[3] << 16); w.z = (unsigned)rv[4] | ((unsigned)rv[5] << 16); w.w = (unsigned)rv[6] | ((unsigned)rv[7] << 16);
                    *(LAS u32x4*)(os + OS_VT + (lane & 15) * TS + 16 * (lane >> 4)) = w; }
                asm volatile("s_waitcnt vmcnt(0)" ::: "memory");
            } else if (wave == 2) {
                if (cg >= 0 && cg < CNCH) {
                    const LAS unsigned char* os = lds + L_OS + (cg % 3) * OS_BYTES; const LAS unsigned char* og = lds + L_OG + (cg & 1) * OG_BYTES; LAS unsigned char* gm = lds + L_GM + (cg & 1) * GM_BYTES;
                    f32x16 c = gram32(os + OS_A, og + OG_K, lane);
#pragma unroll
                    for (int p = 0; p < 16; ++p) c[p] = (lane & 31) < acc_row(p, lane) ? c[p] : 0.f;
                    st_acc32(gm + GM_KA, c, lane);
                    c = gram32(os + OS_R, og + OG_K, lane);
#pragma unroll
                    for (int p = 0; p < 16; ++p) c[p] = (lane & 31) <= acc_row(p, lane) ? c[p] : 0.f;
                    st_acc32(gm + GM_KR, c, lane);
                    c = gram32(os + OS_R, og + OG_B, lane);
#pragma unroll
                    for (int p = 0; p < 16; ++p) c[p] = (lane & 31) <= acc_row(p, lane) ? -c[p] : 0.f;
                    st_acc32(gm + GM_BR, c, lane);
                }
            } else if (wave == 1) {
                if (cg >= 0 && cg < CNCH) {
                    const LAS unsigned char* os = lds + L_OS + (cg % 3) * OS_BYTES; const LAS unsigned char* og = lds + L_OG + (cg & 1) * OG_BYTES; LAS unsigned char* gm = lds + L_GM + (cg & 1) * GM_BYTES;
                    LAS unsigned char* Ml = lds + L_TSCR;
                    f32x16 Mp = gram32(os + OS_A, og + OG_B, lane), Rm;
#pragma unroll
                    for (int p = 0; p < 16; ++p) { const int row = acc_row(p, lane), col = lane & 31; Mp[p] = col < row ? -Mp[p] : 0.f; Rm[p] = Mp[p] + (col == row ? 1.f : 0.f); }
#pragma unroll
                    for (int lev = 0; lev < 5; ++lev) {
                        st_acc32(Ml + (lev & 1) * 2560, Mp, lane);
                        LDS_WAIT();
                        const bf16x8 am0 = lds_afrag_perm(Ml + (lev & 1) * 2560, 0, lane), am1 = lds_afrag_perm(Ml + (lev & 1) * 2560, 1, lane);
                        if (lev >= 1) { const bf16x8 r0 = acc_bfrag(Rm, 0), r1 = acc_bfrag(Rm, 1);
                            Rm = __builtin_amdgcn_mfma_f32_32x32x16_bf16(am0, r0, Rm, 0, 0, 0); Rm = __builtin_amdgcn_mfma_f32_32x32x16_bf16(am1, r1, Rm, 0, 0, 0); }
                        if (lev < 4) { const bf16x8 b0 = acc_bfrag(Mp, 0), b1 = acc_bfrag(Mp, 1); f32x16 z;
#pragma unroll
                            for (int p = 0; p < 16; ++p) z[p] = 0.f;
                            z = __builtin_amdgcn_mfma_f32_32x32x16_bf16(am0, b0, z, 0, 0, 0); z = __builtin_amdgcn_mfma_f32_32x32x16_bf16(am1, b1, z, 0, 0, 0);
                            Mp = z; }
                    }
                    st_acc32(gm + GM_TT, Rm, lane);
                }
            } else {
                if (cs >= 0) {
                    const LAS unsigned char* os = lds + L_OS + (cs % 3) * OS_BYTES; const LAS unsigned char* gm = lds + L_GM + (cs & 1) * GM_BYTES;
                    LAS unsigned char* Xb = lds + L_SSCR; LAS unsigned char* Hb = lds + L_SSCR + 2304; LAS unsigned char* Ub = lds + L_SSCR + 2304 + 1280;
                    const int r16 = lane & 15, q = lane >> 4;
                    const bf16x8 xa0 = *(const LAS bf16x8*)(Xb + r16 * RS + 16 * q), xa1 = *(const LAS bf16x8*)(Xb + r16 * RS + 64 + 16 * q), va = *(const LAS bf16x8*)(os + OS_VT + r16 * TS + 16 * q);
                    f32x4 h[2];
#pragma unroll
                    for (int ti = 0; ti < 2; ++ti) { const int i = 16 * ti + r16; f32x4 c = {0.f, 0.f, 0.f, 0.f};
                        c = __builtin_amdgcn_mfma_f32_16x16x32_bf16(xa0, *(const LAS bf16x8*)(os + OS_A + i * RS + 16 * q), c, 0, 0, 0);
                        c = __builtin_amdgcn_mfma_f32_16x16x32_bf16(xa1, *(const LAS bf16x8*)(os + OS_A + i * RS + 64 + 16 * q), c, 0, 0, 0);
                        c = __builtin_amdgcn_mfma_f32_16x16x32_bf16(va, *(const LAS bf16x8*)(gm + GM_KA + i * TS + 16 * q), c, 0, 0, 0);
                        h[ti] = c; }
#pragma unroll
                    for (int ti = 0; ti < 2; ++ti)
#pragma unroll
                        for (int j = 0; j < 4; ++j) *(LAS unsigned short*)(Hb + (4 * q + j) * TS + 2 * (16 * ti + r16)) = f2bf(h[ti][j]);
                    LDS_WAIT();
                    const bf16x8 ha = *(const LAS bf16x8*)(Hb + r16 * TS + 16 * q);
                    f32x4 u[2];
#pragma unroll
                    for (int ti = 0; ti < 2; ++ti) { const int i = 16 * ti + r16; f32x4 c = {0.f, 0.f, 0.f, 0.f};
                        u[ti] = __builtin_amdgcn_mfma_f32_16x16x32_bf16(ha, *(const LAS bf16x8*)(gm + GM_TT + i * TS + 16 * q), c, 0, 0, 0); }
#pragma unroll
                    for (int ti = 0; ti < 2; ++ti)
#pragma unroll
                        for (int j = 0; j < 4; ++j) *(LAS unsigned short*)(Ub + (4 * q + j) * TS + 2 * (16 * ti + r16)) = f2bf(u[ti][j]);
                    LDS_WAIT();
                    const bf16x8 ua = *(const LAS bf16x8*)(Ub + r16 * TS + 16 * q);
#pragma unroll
                    for (int t = 0; t < 4; ++t) { const int k = 16 * t + r16; const float g = *(const LAS float*)(os + OS_GAM + 4 * k); f32x4 c = Xa[t] * g;
                        c = __builtin_amdgcn_mfma_f32_16x16x32_bf16(va, *(const LAS bf16x8*)(os + OS_KT + k * TS + 16 * q), c, 0, 0, 0);
                        c = __builtin_amdgcn_mfma_f32_16x16x32_bf16(ua, *(const LAS bf16x8*)(os + OS_BT + k * TS + 16 * q), c, 0, 0, 0);
                        Xa[t] = c; }
                    if (cs >= CT / CK) {
#pragma unroll
                        for (int ti = 0; ti < 2; ++ti) { const int i = 16 * ti + r16; f32x4 c = {0.f, 0.f, 0.f, 0.f};
                            c = __builtin_amdgcn_mfma_f32_16x16x32_bf16(xa0, *(const LAS bf16x8*)(os + OS_R + i * RS + 16 * q), c, 0, 0, 0);
                            c = __builtin_amdgcn_mfma_f32_16x16x32_bf16(xa1, *(const LAS bf16x8*)(os + OS_R + i * RS + 64 + 16 * q), c, 0, 0, 0);
                            c = __builtin_amdgcn_mfma_f32_16x16x32_bf16(va, *(const LAS bf16x8*)(gm + GM_KR + i * TS + 16 * q), c, 0, 0, 0);
                            c = __builtin_amdgcn_mfma_f32_16x16x32_bf16(ua, *(const LAS bf16x8*)(gm + GM_BR + i * TS + 16 * q), c, 0, 0, 0);
                            const int n = scan_token(cs * CK + i, d, b);
                            u32x2 w; w.x = cvt_pk_bf16(c[0], c[1]); w.y = cvt_pk_bf16(c[2], c[3]);
                            *(GAS u32x2*)((bf16_t*)(F.ws + WS_YD + (size_t)d * NL * D * 2) + (size_t)n * D + hd * 64 + rq * 16 + 4 * q) = w; }
                    }
#pragma unroll
                    for (int t = 0; t < 4; ++t)
#pragma unroll
                        for (int j = 0; j < 4; ++j) *(LAS unsigned short*)(Xb + (4 * q + j) * RS + 2 * (16 * t + r16)) = f2bf(Xa[t][j]);
                }
            }
            __syncthreads();
        }
#undef SCAN_DMA
    }
}
__device__ __forceinline__ void phase_readout(const Frame& F, const Args& A) {
    const int gw = blockIdx.x * NWAVES + F.wave, NGW = F.G * NWAVES; const int c0 = 16 * F.lane;
    float lng[16], lnb[16], rk[16]; ld16f(A.in[I_LNG] + c0, lng); ld16f(A.in[I_LNB] + c0, lnb); ld16f(A.in[I_RK] + c0, rk);
    for (int n = gw; n < NL; n += NGW) { const size_t off = (size_t)n * D + c0; float y[16], t[16], r[16], kd[16], v[16], g[16], o[16];
        ld16bf((const bf16_t*)(F.ws + WS_YD) + off, y); ld16bf((const bf16_t*)(F.ws + WS_YD + (size_t)NL * D * 2) + off, t);
        float s = 0.f;
#pragma unroll
        for (int j = 0; j < 16; ++j) { y[j] += t[j]; s += y[j]; }
        s += __shfl_xor(s, 1); s += __shfl_xor(s, 2); const float m = s * (1.0f / 64.0f); float q = 0.f;
#pragma unroll
        for (int j = 0; j < 16; ++j) { y[j] -= m; q += y[j] * y[j]; }
        q += __shfl_xor(q, 1); q += __shfl_xor(q, 2); const float rs = 1.0f / sqrtf(q * (1.0f / 64.0f) + GN_EPS);
        ld16bf((const bf16_t*)(F.ws + WS_RKV) + off, r); ld16bf((const bf16_t*)(F.ws + WS_KDIR) + off, kd); ld16bf((const bf16_t*)(F.ws + WS_KDIR + ACTB) + off, t);
        float bs = 0.f;
#pragma unroll
        for (int j = 0; j < 16; ++j) bs += r[j] * (kd[j] + t[j]) * rk[j];
        bs += __shfl_xor(bs, 1); bs += __shfl_xor(bs, 2);
        ld16bf((const bf16_t*)(F.ws + WS_RKV + 2 * ACTB) + off, v); ld16bf((const bf16_t*)(F.ws + WS_G) + off, g);
#pragma unroll
        for (int j = 0; j < 16; ++j) o[j] = (y[j] * rs * lng[j] + lnb[j] + bs * v[j]) * g[j];
        st16bf((bf16_t*)(F.ws + WS_RO) + off, o);
    }
}
struct SchedWo {
    static constexpr bool SIDE = false; static constexpr bool XSYNC = false; static constexpr bool GATHER = false;
    int G, vcu; int nt; unsigned ldb;
    __device__ __forceinline__ bool next(int i, GU& u) const { const int L = i * G + vcu; if (L >= 512) return false; const int pm = L >> 2, pn = L & 3;
        u.a = (unsigned)(WS_RO + (size_t)pm * 256 * D * 2); u.b = (unsigned)(WS_WO + (size_t)pn * 256 * 1024 * 2); u.i0 = pm; u.i1 = pn; u.i2 = 0; u.i3 = 0; return true; }
    __device__ __forceinline__ void aoff(const GU&, const int (&R)[2], const int (&C)[2], unsigned (&v)[2][2]) const {
#pragma unroll
        for (int h = 0; h < 2; ++h)
#pragma unroll
            for (int i = 0; i < 2; ++i) v[h][i] = (unsigned)((h * 128 + R[i]) * D + C[i]) * 2u; }
};
struct EpiWo {
    static constexpr bool FP8 = false; static constexpr bool PERM = false;
    const float* xin; float* xout; const float* gate_base;
    __device__ __forceinline__ void operator()(const f32x4 (&acc)[2][2][4][2], const GU& u, int wr, int wc, int fr, int fq, const LAS float* sb) const {
        const int pm = u.i0, pn = u.i1; const float* gate = gate_base + (size_t)(pm >> 6) * NMOD * D; const int col0 = pn * 256 + wc * 32 + 4 * fq;
        f32x4 gl[2][2];
#pragma unroll
        for (int bj = 0; bj < 2; ++bj)
#pragma unroll
            for (int n = 0; n < 2; ++n) gl[bj][n] = *(const GAS f32x4*)(gate + col0 + bj * 128 + n * 16);
#pragma unroll
        for (int ai = 0; ai < 2; ++ai)
#pragma unroll
            for (int m = 0; m < 4; ++m) { const size_t off = ((size_t)pm * 256 + ai * 128 + wr * 64 + m * 16 + fr) * D + col0;
#pragma unroll
                for (int bj = 0; bj < 2; ++bj)
#pragma unroll
                    for (int n = 0; n < 2; ++n) *(GAS f32x4*)(xout + off + bj * 128 + n * 16) = *(const GAS f32x4*)(xin + off + bj * 128 + n * 16) + gl[bj][n] * acc[ai][bj][m][n]; }
    }
};

constexpr int NPHASES = 3;
__global__ void __launch_bounds__(NTHREADS, 2) fwd_kernel(Args args) {
    extern __shared__ __attribute__((aligned(16))) unsigned char lds_raw[];
    Frame F;
    F.lds = (LAS unsigned char*)lds_raw; F.scr = F.lds + SCR_OFF; F.ws = args.ws;
    F.tid = threadIdx.x; F.lane = F.tid & 63; F.wave = __builtin_amdgcn_readfirstlane(F.tid >> 6);
    F.G = gridDim.x; { const int bx = blockIdx.x; F.vcu = (F.G % 8 == 0) ? (bx % 8) * (F.G / 8) + bx / 8 : bx; }
    volatile LAS unsigned* MISC = (volatile LAS unsigned*)(F.lds + MISC_OFF);
    if (F.tid < 64) MISC[F.tid] = 0u;
    __syncthreads();
    const int lo = args.ph_lo, hi = args.ph_hi;
    XcdBarrier bar; bar.bar = (unsigned*)(F.ws + WS_CTL); bar.x = 0; bar.st = MISC + 8;
    if (hi - lo > 1) {
        unsigned* barw = (unsigned*)(F.ws + WS_CTL);
        bar.bar = barw; bar.x = xb_xcc_id(); bar.st = MISC + 8;
        if (F.tid == 0) {
            const unsigned rank = xb_add(&barw[XB_XCNT(bar.x)], 1u);
            unsigned nloc, nx; xcd_barrier_complete(barw, bar.x, nloc, nx); MISC[8] = nloc; MISC[9] = nx;
            unsigned pre = 0;
            for (unsigned j = 0; j < 16; ++j) { const unsigned c = xb_ld(&barw[XB_XCNT(j)]); if (j < bar.x) pre += c; }
            MISC[10] = pre + rank;
        }
        __syncthreads();
        F.vcu = (int)MISC[10];
    }
#define IN(k) (lo <= (k) && (k) < hi)
#define SEAM(k) do { if (IN(k) && IN((k) + 1)) xcd_barrier(bar); } while (0)
#define PH(k, ...) do { if (IN(k)) { __VA_ARGS__; if constexpr (((REPEAT_MASK >> (k)) & 1) != 0) { xcd_barrier(bar); __VA_ARGS__; } } SEAM(k); } while (0)
    PH(0, phase_prep(F, args));
    PH(1, phase_pre0(F, args));
    PH(2, { SchedPool S{F.G, F.vcu, 4, 512u};
            EpiPool E{args.in[I_X], args.in[I_CTX], args.in[I_POOLLS], modp(F, 0, 0, 2), (float*)(F.ws + WS_XS0)};
            pg8::gemm_phase<EpiPool, SchedPool>(F.scr, F.ws, S, E); });
    PH(3, phase_post(F, args, 0, (const float*)(F.ws + WS_XS0), NTOK));
    PH(4, phase_moe1(F, args, 0));
    PH(5, phase_moe2(F, args, 0));
    PH(6, phase_pre1(F, args));
    PH(7, { SchedProj S{F.G, F.vcu, 16, 2048u}; EpiProj E{F.ws}; pg8::gemm_phase<EpiProj, SchedProj>(F.scr, F.ws, S, E); });
    PH(8, { SchedLora2 S{F.G, F.vcu, 2, 256u}; EpiLora2 E{F.ws, args.in[I_W0], args.in[I_A0]}; pg8::gemm_phase<EpiLora2, SchedLora2>(F.scr, F.ws, S, E); });
    PH(9, phase_fin(F, args));
    PH(10, phase_scan(F, args));
    PH(11, phase_readout(F, args));
    PH(12, { SchedWo S{F.G, F.vcu, 16, 2048u}; EpiWo E{(const float*)(F.ws + WS_XS1), (float*)(F.ws + WS_XS0), modp(F, 1, 0, 2)}; pg8::gemm_phase<EpiWo, SchedWo>(F.scr, F.ws, S, E); });
    PH(13, phase_post(F, args, 1, (const float*)(F.ws + WS_XS0), NL));
    PH(14, phase_moe1(F, args, 1));
    PH(15, phase_moe2(F, args, 1));
    PH(16, phase_final(F, args, 1, (const float*)(F.ws + WS_XS0)));
#undef PH
#undef SEAM
#undef IN
}

extern "C" void kernel_launch(void* const* d_in, const int* in_sizes, int n_in, void* d_out, int out_size, void* d_ws, size_t ws_size, hipStream_t stream) {
    static int grid = 0;
    if (grid == 0) {
        if (n_in != 32 || ws_size < WS_END) { fprintf(stderr, "kernel_launch: unexpected n_in %d / ws %zu (need %zu)\n", n_in, ws_size, (size_t)WS_END); grid = -1; return; }
        int dev = 0, cus = 0;
        if (hipGetDevice(&dev) != hipSuccess || hipDeviceGetAttribute(&cus, hipDeviceAttributeMultiprocessorCount, dev) != hipSuccess) { grid = -1; return; }
        if (hipFuncSetAttribute((const void*)fwd_kernel, hipFuncAttributeMaxDynamicSharedMemorySize, LDS_BYTES) != hipSuccess) { fprintf(stderr, "kernel_launch: hipFuncSetAttribute failed\n"); grid = -1; return; }
        (void)hipGetLastError();
        grid = cus;
    }
    if (grid < 0) return;
    (void)hipMemsetAsync((char*)d_ws + WS_CTL, 0, CTL_BYTES, stream);
    Args a{};
    for (int i = 0; i < 32; ++i) a.in[i] = (const float*)d_in[i];
    a.out = (float*)d_out; a.ws = (unsigned char*)d_ws;
    const int last = 16;
#if N_LAUNCH_MODE == 1
    a.ph_lo = 0; a.ph_hi = last + 1;
    hipLaunchKernelGGL(fwd_kernel, dim3(grid), dim3(NTHREADS), LDS_BYTES, stream, a);
#else
    for (int p = 0; p <= last; ++p) { a.ph_lo = p; a.ph_hi = p + 1; hipLaunchKernelGGL(fwd_kernel, dim3(grid), dim3(NTHREADS), LDS_BYTES, stream, a); }
#endif
}
```

```cpp
#include <hip/hip_runtime.h>
#include <cstdio>
#include <cstdint>

#define LAS __attribute__((address_space(3)))
#define GAS __attribute__((address_space(1)))
typedef unsigned short bf16_t;
typedef short bf16x8 __attribute__((ext_vector_type(8)));
typedef float f32x4 __attribute__((ext_vector_type(4)));
typedef float f32x2 __attribute__((ext_vector_type(2)));
typedef float f32x16 __attribute__((ext_vector_type(16)));
typedef unsigned u32x4 __attribute__((ext_vector_type(4)));
typedef unsigned u32x2 __attribute__((ext_vector_type(2)));

#ifndef N_LAUNCH_MODE
#define N_LAUNCH_MODE 1
#endif
#ifndef REPEAT_MASK
#define REPEAT_MASK 0
#endif

constexpr int D = 1024, NB = 2, TSEQ = 16384, CT = 256, NL = NB * TSEQ, NC = NB * CT, NTOK = NL + NC;
constexpr int NE = 32, TOPK = 4, NMOD = 6;
constexpr int NWAVES = 8, NTHREADS = 512;
constexpr int MAXSLOT = ((NTOK * TOPK + 255) / 256 + NE) * 256;
constexpr float NORM_EPS = 1e-6f, GN_EPS = 64e-5f;

constexpr size_t AL(size_t x) { return (x + 255) & ~(size_t)255; }
constexpr size_t WS_CTL = 0, CTL_BYTES = 65536;
constexpr size_t CTL_XSYNC = 32768;
constexpr size_t CTL_CNT = 16384;
constexpr size_t WS_MOD = WS_CTL + CTL_BYTES;
constexpr size_t WS_LIST = AL(WS_MOD + 2 * 3 * 6144 * 4);
constexpr size_t WS_TINFO = AL(WS_LIST + (size_t)2 * NE * NTOK * 4);
constexpr size_t WS_TGATE = AL(WS_TINFO + (size_t)2 * NTOK * 4 * 4);
constexpr size_t WS_WGU = AL(WS_TGATE + (size_t)2 * NTOK * 4 * 4);
constexpr size_t WS_WDN = AL(WS_WGU + (size_t)2 * NE * 2048 * 1024 * 2);
constexpr size_t WS_WRKV = AL(WS_WDN + (size_t)2 * NE * 1024 * 1024 * 2);
constexpr size_t WS_WO = AL(WS_WRKV + (size_t)3 * 1024 * 1024 * 2);
constexpr size_t WS_WL1 = AL(WS_WO + (size_t)1024 * 1024 * 2);
constexpr size_t WS_WL2 = AL(WS_WL1 + (size_t)3 * 256 * 1024 * 2);
constexpr size_t WS_WPOOL = AL(WS_WL2 + (size_t)5 * 1024 * 128 * 2);
constexpr size_t WS_XS0 = AL(WS_WPOOL + (size_t)4 * 256 * 256 * 2);
constexpr size_t WS_XS1 = AL(WS_XS0 + (size_t)NTOK * D * 4);
constexpr size_t WS_T = AL(WS_XS1 + (size_t)NTOK * D * 4);
constexpr size_t ACTB = (size_t)NTOK * D * 2;
constexpr size_t TA = WS_T;
constexpr size_t TA_BYTES = (size_t)432 << 20;
constexpr size_t WS_DBUF = TA, WS_H2 = TA + ACTB, WS_ACT = TA + 2 * ACTB;
constexpr size_t WS_MIX = TA;
constexpr size_t WS_KDIR = TA, WS_BV = TA + 2 * ACTB, WS_KK = TA + 4 * ACTB;
constexpr size_t TB = TA + TA_BYTES;
constexpr size_t TB_BYTES = (size_t)290 << 20;
constexpr size_t WS_Y2 = TB, WS_RKV = TB;
constexpr size_t TC = TB + TB_BYTES;
constexpr size_t WS_DEC = TC, WS_RO = TC;
constexpr size_t TD = AL(TC + (size_t)2 * NTOK * D * 4);
constexpr size_t WS_ICL = TD, WS_YD = TD;
constexpr size_t TE = AL(TD + 2 * ACTB);
constexpr size_t WS_G = TE;
constexpr size_t TF = AL(TE + ACTB);
constexpr size_t WS_LACT = TF;
constexpr size_t WS_END = AL(TF + (size_t)3 * NTOK * 128 * 2);
static_assert(WS_ACT + (size_t)MAXSLOT * D * 2 <= TA + TA_BYTES, "ACT overflows TA");
static_assert((size_t)MAXSLOT * D * 2 <= TB_BYTES, "Y2 overflows TB");
static_assert(WS_END <= ((size_t)2048 << 20), "workspace too large");

constexpr int MISC_OFF = 0, SCR_OFF = 1024, SCR_BYTES = 162816, LDS_BYTES = SCR_OFF + SCR_BYTES;

typedef __bf16 bf16x2_t __attribute__((ext_vector_type(2)));
__device__ __forceinline__ unsigned cvt_pk_bf16(float lo, float hi) { const f32x2 v = {lo, hi}; return __builtin_bit_cast(unsigned, __builtin_convertvector(v, bf16x2_t)); }
__device__ __forceinline__ float bf_lo(unsigned w) { return __uint_as_float(w << 16); }
__device__ __forceinline__ float bf_hi(unsigned w) { return __uint_as_float(w & 0xffff0000u); }
__device__ __forceinline__ float bf2f(bf16_t b) { return __uint_as_float(((unsigned)b) << 16); }
__device__ __forceinline__ float wave_sum(float v) {
#pragma unroll
    for (int o = 1; o < 64; o <<= 1) v += __shfl_xor(v, o);
    return v;
}
__device__ __forceinline__ float sigmoidf_(float x) { return 1.0f / (1.0f + __expf(-x)); }
#define LDS_WAIT() asm volatile("s_waitcnt lgkmcnt(0)" ::: "memory")
#define VM_WAIT() asm volatile("s_waitcnt vmcnt(0)" ::: "memory")

#define XB_TMO      128
#define XB_XCNT(j)  (256  + 64 * (j))
#define XB_XSUB(j)  (1280 + 64 * (j))
#define XB_XGEN(j)  (2304 + 64 * (j))
#define XB_TOP      3328
#define XB_TOPGEN   3392
#define XCD_BAR_WORDS 3456
#define XB_SPIN_CAP (1u << 22)
__device__ __forceinline__ unsigned xb_ld(unsigned* p)              { return __hip_atomic_load(p, __ATOMIC_RELAXED, __HIP_MEMORY_SCOPE_AGENT); }
__device__ __forceinline__ unsigned xb_add(unsigned* p, unsigned v) { return __hip_atomic_fetch_add(p, v, __ATOMIC_RELAXED, __HIP_MEMORY_SCOPE_AGENT); }
__device__ __forceinline__ unsigned xb_xcc_id() { return (unsigned)__builtin_amdgcn_s_getreg((3 << 11) | 20) & 0xFu; }
#define XB_SPIN(cond, bar) do { unsigned _sp = 0; while (cond) { __builtin_amdgcn_s_sleep(1); \
    if ((++_sp & 255u) == 0u) { if (xb_ld(&(bar)[XB_TMO])) break; if (_sp > XB_SPIN_CAP) { atomicAdd(&(bar)[XB_TMO], 1u); break; } } } } while (0)
struct XcdBarrier { unsigned* bar; unsigned x; volatile LAS unsigned* st; };
__device__ __forceinline__ XcdBarrier xcd_barrier_post(unsigned* bar, volatile LAS unsigned* st) {
    XcdBarrier b; b.bar = bar; b.x = xb_xcc_id(); b.st = st;
    if (threadIdx.x == 0) (void)xb_add(&bar[XB_XCNT(b.x)], 1u);
    return b;
}
__device__ __forceinline__ void xcd_barrier_complete(unsigned* bar, unsigned x, unsigned& nloc, unsigned& nx) {
    const unsigned G = gridDim.x * gridDim.y * gridDim.z;
    unsigned sum, cnt, mine, sp = 0u;
    for (;;) {
        sum = 0u; cnt = 0u; mine = 0u;
#pragma unroll
        for (unsigned j = 0; j < 16; ++j) { const unsigned c = xb_ld(&bar[XB_XCNT(j)]); sum += c; cnt += (c > 0u) ? 1u : 0u; mine = (j == x) ? c : mine; }
        if (sum == G) break;
        __builtin_amdgcn_s_sleep(1);
        if ((++sp & 255u) == 0u) { if (xb_ld(&bar[XB_TMO])) break; if (sp > XB_SPIN_CAP) { atomicAdd(&bar[XB_TMO], 1u); break; } }
    }
    nloc = mine > 0u ? mine : 1u; nx = cnt > 0u ? cnt : 1u;
}
__device__ __forceinline__ void xcd_barrier(const XcdBarrier& b) {
    asm volatile("s_waitcnt vmcnt(0)" ::: "memory");
    __syncthreads();
    if (threadIdx.x == 0) {
        unsigned* bar = b.bar;
        __builtin_amdgcn_s_waitcnt(0);
        unsigned nloc = b.st[0], nx = b.st[1];
        if (nloc == 0u) { xcd_barrier_complete(bar, b.x, nloc, nx); b.st[0] = nloc; b.st[1] = nx; }
        const unsigned old = xb_add(&bar[XB_XSUB(b.x)], 1u);
        const unsigned gen = old / nloc;
        if (old + 1u == (gen + 1u) * nloc) {
            __builtin_amdgcn_fence(__ATOMIC_RELEASE, "agent");
            asm volatile("s_waitcnt vmcnt(0)" ::: "memory");
            const unsigned og = xb_add(&bar[XB_TOP], 1u);
            const unsigned tg = og / nx;
            if (og + 1u == (tg + 1u) * nx) xb_add(&bar[XB_TOPGEN], 1u);
            else XB_SPIN(xb_ld(&bar[XB_TOPGEN]) == tg, bar);
            __builtin_amdgcn_fence(__ATOMIC_ACQUIRE, "agent");
            xb_add(&bar[XB_XGEN(b.x)], 1u);
            asm volatile("s_waitcnt vmcnt(0)" ::: "memory");
        } else {
            XB_SPIN(xb_ld(&bar[XB_XGEN(b.x)]) == gen, bar);
            __builtin_amdgcn_fence(__ATOMIC_ACQUIRE, "agent");
            asm volatile("s_waitcnt vmcnt(0)" ::: "memory");
        }
    }
    __syncthreads();
}

namespace pg8 {
constexpr int BM = 256, BK = 64, HALF = 128, HTB = HALF * BK * 2, STAGE_BYTES = 8 * HTB;
__host__ __device__ __forceinline__ int lds_byte(int r, int c) { const int st = (r >> 4) * 2 + (c >> 5), rr = r & 15, cc = c & 31, ob = rr * 64 + cc * 2; return st * 1024 + (ob ^ (((ob >> 9) & 1) << 5)); }
__host__ __device__ __forceinline__ void stage_rc(int b, int& R, int& C) { const int st = b / 1024, sb = b % 1024, swz = sb ^ (((sb >> 9) & 1) << 5); R = (st >> 1) * 16 + swz / 64; C = (st & 1) * 32 + (swz % 64) / 2; }
__host__ __device__ __forceinline__ int perm32(int rho) { const int n = rho >> 4, i = rho & 15; return 8 * (i >> 2) + 4 * n + (i & 3); }

struct GU { unsigned a, b; int i0, i1, i2, i3; };
typedef int v8i __attribute__((ext_vector_type(8)));
typedef int v4i __attribute__((ext_vector_type(4)));
__device__ __forceinline__ bf16x8 half8(v8i v, int h) { const v4i a = h ? __builtin_shufflevector(v, v, 4, 5, 6, 7) : __builtin_shufflevector(v, v, 0, 1, 2, 3); return __builtin_bit_cast(bf16x8, a); }
__device__ __forceinline__ v8i cat8(bf16x8 lo, bf16x8 hi) { const v4i a = __builtin_bit_cast(v4i, lo), b = __builtin_bit_cast(v4i, hi); return __builtin_shufflevector(a, b, 0, 1, 2, 3, 4, 5, 6, 7); }

template <class Epi, class Sched>
__device__ __forceinline__ void gemm_phase(LAS unsigned char* lds, unsigned char* wsbase, const Sched& S, const Epi& E) {
    const int tid = threadIdx.x, wid = __builtin_amdgcn_readfirstlane(tid >> 6), lane = tid & 63, wr = wid >> 2, wc = wid & 3, fr = lane & 15, fq = lane >> 4;
    const int nt = S.nt;
    const __amdgpu_buffer_rsrc_t rsrc = __builtin_amdgcn_make_buffer_rsrc((void*)wsbase, 0, 0xffffffff, 0x00020000);
    constexpr int SIDE_OFF = STAGE_BYTES;
#define PG8_SIDE(u, buf) do { if constexpr (Sched::SIDE) { unsigned so_; const bool isb_ = S.side_src((u), tid, so_); (void)isb_; \
        if (wid < 4) __builtin_amdgcn_raw_ptr_buffer_load_lds(rsrc, (LAS void*)(lds + SIDE_OFF + (buf) * 2048 + wid * 256), 4, (int)so_, 0, 0, 0); \
        else __builtin_amdgcn_raw_ptr_buffer_load_lds(S.rsrcb, (LAS void*)(lds + SIDE_OFF + (buf) * 2048 + wid * 256), 4, (int)so_, 0, 0, 0); } } while (0)
    int Rr[2], Cc[2]; unsigned voffB[2];
#pragma unroll
    for (int i = 0; i < 2; ++i) { int R, C; stage_rc(tid * 16 + i * 8192, R, C); Rr[i] = R; Cc[i] = C; const int Rb = Epi::PERM ? ((R & ~31) + perm32(R & 31)) : R;
        voffB[i] = (unsigned)Rb * S.ldb + 2u * (unsigned)C; }
    const unsigned kstep = 128u;
    const unsigned hstepB = (unsigned)HALF * S.ldb;
    const unsigned ldsw = (unsigned)wid * 1024u;
    const int aoff = lds_byte(wr * 64 + fr, fq * 8), boff = lds_byte(wc * 32 + fr, fq * 8);
#define PG8_SA(b, h) (((b) * 2 + (h)) * HTB)
#define PG8_SB(b, h) ((4 + (b) * 2 + (h)) * HTB)
#define PG8_STAGE(bufoff, soff, voff) do { _Pragma("unroll") for (int _i = 0; _i < 2; ++_i) \
        __builtin_amdgcn_raw_ptr_buffer_load_lds(rsrc, (LAS void*)(lds + (bufoff) + ldsw + _i * 8192), 16, (int)(voff)[_i], (int)(soff), 0, 0); } while (0)
#define PG8_LDA(dst, b, h) do { _Pragma("unroll") for (int m = 0; m < 4; ++m) dst[m] = cat8(*(const LAS bf16x8*)(lds + PG8_SA(b, h) + aoff + m * 2048), *(const LAS bf16x8*)(lds + PG8_SA(b, h) + aoff + m * 2048 + 1024)); } while (0)
#define PG8_LDB(dst, b, h) do { _Pragma("unroll") for (int n = 0; n < 2; ++n) dst[n] = cat8(*(const LAS bf16x8*)(lds + PG8_SB(b, h) + boff + n * 2048), *(const LAS bf16x8*)(lds + PG8_SB(b, h) + boff + n * 2048 + 1024)); } while (0)
#define PG8_MMA(ai, bj, At, Bt) do { __builtin_amdgcn_s_setprio(1); _Pragma("unroll") for (int m = 0; m < 4; ++m) _Pragma("unroll") for (int n = 0; n < 2; ++n) { \
        if constexpr (Epi::FP8) { asm volatile("v_mfma_scale_f32_16x16x128_f8f6f4 %0, %1, %2, %0, %3, %4 op_sel_hi:[0,0,0]" : "+v"(acc[ai][bj][m][n]) : "v"(Bt[n]), "v"(At[m]), "v"(sc_w), "v"(sc_a)); } \
        else { acc[ai][bj][m][n] = __builtin_amdgcn_mfma_f32_16x16x32_bf16(half8(Bt[n], 0), half8(At[m], 0), acc[ai][bj][m][n], 0, 0, 0); \
               acc[ai][bj][m][n] = __builtin_amdgcn_mfma_f32_16x16x32_bf16(half8(Bt[n], 1), half8(At[m], 1), acc[ai][bj][m][n], 0, 0, 0); } } \
        __builtin_amdgcn_s_setprio(0); } while (0)
#define PG8_WAIT_V(n) asm volatile("s_waitcnt vmcnt(" #n ")" ::: "memory")
#define PG8_WAIT_L(n) asm volatile("s_waitcnt lgkmcnt(" #n ")" ::: "memory")
#define PG8_BAR __builtin_amdgcn_s_barrier()
#define PG8_SCHED __builtin_amdgcn_sched_barrier(0)
#define PG8_RC() do { _Pragma("unroll") for (int i = 0; i < 2; ++i) { int R, C; stage_rc((int)threadIdx.x * 16 + i * 8192, R, C); Rr[i] = R; Cc[i] = C; } } while (0)
    GU cur, nxt; int ui = 0;
    if (!S.next(0, cur)) { if constexpr (Sched::XSYNC) { if (tid == 0) (void)xb_add(S.xw, (unsigned)S.rounds); } return; }
    f32x4 acc[2][2][4][2];
#pragma unroll
    for (int a = 0; a < 2; ++a)
#pragma unroll
        for (int b = 0; b < 2; ++b)
#pragma unroll
            for (int m = 0; m < 4; ++m)
#pragma unroll
                for (int n = 0; n < 2; ++n) acc[a][b][m][n] = (f32x4){0.f, 0.f, 0.f, 0.f};
    v8i At[4], B0[2], B1[2];
    int sc_w = 0x7a7a7a7a, sc_a = 0x7f7f7f7f; asm volatile("" : "+v"(sc_w), "+v"(sc_a));
    unsigned vA[2][2], nvA[2][2];
    S.aoff(cur, Rr, Cc, vA);
    unsigned cA = __builtin_amdgcn_readfirstlane(cur.a), cB = __builtin_amdgcn_readfirstlane(cur.b);
    PG8_SIDE(cur, 0);
    PG8_STAGE(PG8_SB(0, 0), cB, voffB); PG8_STAGE(PG8_SB(0, 1), cB + hstepB, voffB); PG8_STAGE(PG8_SA(0, 0), cA, vA[0]); PG8_STAGE(PG8_SA(0, 1), cA, vA[1]);
    if (wr == 1) PG8_BAR;
    PG8_WAIT_V(2); PG8_BAR;
    PG8_STAGE(PG8_SB(1, 0), cB + kstep, voffB); PG8_STAGE(PG8_SA(1, 0), cA + kstep, vA[0]); PG8_STAGE(PG8_SB(1, 1), cB + hstepB + kstep, voffB);
    PG8_WAIT_V(6); PG8_BAR;
    for (;;) {
        const bool has_next = S.next(ui + 1, nxt);
        const unsigned nA = has_next ? __builtin_amdgcn_readfirstlane(nxt.a) : cA, nB = has_next ? __builtin_amdgcn_readfirstlane(nxt.b) : cB;
        if (has_next) PG8_SIDE(nxt, (ui + 1) & 1);
        if constexpr (Sched::GATHER && !Sched::SIDE) {
            if (has_next) { PG8_RC(); S.aoff(nxt, Rr, Cc, nvA); }
            else { nvA[0][0] = vA[0][0]; nvA[0][1] = vA[0][1]; nvA[1][0] = vA[1][0]; nvA[1][1] = vA[1][1]; }
        }
#pragma unroll 1
        for (int t = 0; t < nt; t += 2) {
            const bool last = (t == nt - 2);
            const unsigned a1 = cA + (unsigned)(t + 1) * kstep;
            const unsigned a2 = last ? nA : cA + (unsigned)(t + 2) * kstep, b2 = last ? nB : cB + (unsigned)(t + 2) * kstep;
            const unsigned a3 = a2 + kstep, b3 = b2 + kstep;
            if constexpr (Sched::GATHER && Sched::SIDE) {
                if (last) { if (has_next) { PG8_RC(); const LAS int* tk = (const LAS int*)(lds + SIDE_OFF + ((ui + 1) & 1) * 2048);
#pragma unroll
                        for (int h = 0; h < 2; ++h)
#pragma unroll
                            for (int i = 0; i < 2; ++i) nvA[h][i] = S.tok_off(tk[h * 128 + Rr[i]], Cc[i]); }
                    else { nvA[0][0] = vA[0][0]; nvA[0][1] = vA[0][1]; nvA[1][0] = vA[1][0]; nvA[1][1] = vA[1][1]; } }
            }
            unsigned w0[2], w1[2];
            if constexpr (Sched::GATHER) { w0[0] = last ? nvA[0][0] : vA[0][0]; w0[1] = last ? nvA[0][1] : vA[0][1]; w1[0] = last ? nvA[1][0] : vA[1][0]; w1[1] = last ? nvA[1][1] : vA[1][1]; }
            else { w0[0] = vA[0][0]; w0[1] = vA[0][1]; w1[0] = vA[1][0]; w1[1] = vA[1][1]; }
            PG8_LDB(B0, 0, 0); PG8_LDB(B1, 0, 1); PG8_SCHED; PG8_LDA(At, 0, 0); PG8_STAGE(PG8_SA(1, 1), a1, vA[1]);
            PG8_WAIT_V(8); PG8_WAIT_L(0); PG8_BAR; PG8_MMA(0, 0, At, B0); PG8_MMA(0, 1, At, B1); PG8_BAR; PG8_SCHED;
            PG8_LDA(At, 0, 1); PG8_STAGE(PG8_SB(0, 0), b2, voffB); PG8_STAGE(PG8_SB(0, 1), b2 + hstepB, voffB); PG8_STAGE(PG8_SA(0, 0), a2, w0);
            PG8_WAIT_V(8); PG8_WAIT_L(0); PG8_BAR; PG8_MMA(1, 0, At, B0); PG8_MMA(1, 1, At, B1); PG8_BAR; PG8_SCHED;
            PG8_LDB(B0, 1, 0); PG8_LDB(B1, 1, 1); PG8_SCHED; PG8_LDA(At, 1, 0); PG8_STAGE(PG8_SA(0, 1), a2, w1);
            PG8_WAIT_V(8); PG8_WAIT_L(0); PG8_BAR; PG8_MMA(0, 0, At, B0); PG8_MMA(0, 1, At, B1); PG8_BAR; PG8_SCHED;
            PG8_LDA(At, 1, 1); PG8_STAGE(PG8_SB(1, 0), b3, voffB); PG8_STAGE(PG8_SB(1, 1), b3 + hstepB, voffB); PG8_STAGE(PG8_SA(1, 0), a3, w0);
            PG8_WAIT_V(8); PG8_WAIT_L(0); PG8_BAR; PG8_MMA(1, 0, At, B0); PG8_MMA(1, 1, At, B1); PG8_BAR; PG8_SCHED;
        }
        if (wr == 0) PG8_BAR;
        if constexpr (Epi::FP8) asm volatile("s_nop 15\n\ts_nop 7" ::: "memory");
        { int fr_ = fr, fq_ = fq; asm volatile("" : "+v"(fr_), "+v"(fq_)); E(acc, cur, wr, wc, fr_, fq_, (const LAS float*)(lds + SIDE_OFF + (ui & 1) * 2048 + 1024)); }
        if constexpr (Sched::XSYNC) {
            if (tid == 0) { (void)xb_add(S.xw, 1u); const unsigned tgt = (unsigned)(ui + 1) * S.nloc; unsigned sp = 0;
                while (xb_ld(S.xw) < tgt && ++sp < (1u << 16)) __builtin_amdgcn_s_sleep(1);
                if (!has_next && S.rounds > ui + 1) (void)xb_add(S.xw, (unsigned)(S.rounds - (ui + 1))); }
        }
        if constexpr (Sched::XSYNC || Sched::SIDE) PG8_BAR;
        if (!has_next) break;
#pragma unroll
        for (int a = 0; a < 2; ++a)
#pragma unroll
            for (int b = 0; b < 2; ++b)
#pragma unroll
                for (int m = 0; m < 4; ++m)
#pragma unroll
                    for (int n = 0; n < 2; ++n) acc[a][b][m][n] = (f32x4){0.f, 0.f, 0.f, 0.f};
        cur = nxt; cA = nA; cB = nB; ++ui;
        if constexpr (Sched::GATHER) { vA[0][0] = nvA[0][0]; vA[0][1] = nvA[0][1]; vA[1][0] = nvA[1][0]; vA[1][1] = nvA[1][1]; }
        if (wr == 1) PG8_BAR;
    }
    PG8_WAIT_V(0);
    PG8_BAR;
#undef PG8_RC
#undef PG8_SIDE
#undef PG8_SA
#undef PG8_SB
#undef PG8_STAGE
#undef PG8_LDA
#undef PG8_LDB
#undef PG8_MMA
#undef PG8_WAIT_V
#undef PG8_WAIT_L
#undef PG8_BAR
#undef PG8_SCHED
}
}
using pg8::GU;

struct Args { const float* in[32]; float* out; unsigned char* ws; int ph_lo, ph_hi; };
struct Frame {
    LAS unsigned char* lds;
    LAS unsigned char* scr;
    unsigned char* ws;
    int tid, lane, wave, G, vcu;
};
enum { I_X = 0, I_C, I_CTX, I_CCTX, I_NORMG, I_ADAW, I_ADAB, I_POOLW, I_POOLLS, I_MU, I_WRKV, I_W0, I_W1, I_W2, I_A0, I_A1, I_A2, I_G1, I_G2, I_KK, I_KA, I_RK, I_LNG, I_LNB, I_WO,
       I_RW, I_RB, I_WGU, I_BGU, I_WDN, I_BDN, I_FINALG };

__device__ __forceinline__ const float* modp(const Frame& F, int layer, int row, int k) { return (const float*)(F.ws + WS_MOD) + ((size_t)(layer * 3 + row) * NMOD + k) * D; }
__device__ __forceinline__ int mrow_of(int n) { return n < NL ? (n >> 14) : 2; }

__device__ __forceinline__ void transpose_tile(const float* W, int ldw, int k0, int n0, bf16_t* WT, size_t dst_row0, int ldk, int kdst0, LAS float* scr, int lane) {
    const int c4 = lane & 15, kr = lane >> 4;
#pragma unroll 4
    for (int it = 0; it < 16; ++it) { const int kk = 4 * it + kr; const f32x4 v = *(const GAS f32x4*)(W + (size_t)(k0 + kk) * ldw + n0 + 4 * c4);
        LAS float* s = scr + kk * 65 + 4 * c4; s[0] = v[0]; s[1] = v[1]; s[2] = v[2]; s[3] = v[3]; }
    LDS_WAIT(); asm volatile("" ::: "memory");
    const int c = lane & 7;
#pragma unroll
    for (int j = 0; j < 8; ++j) { const int n = (lane >> 3) + 8 * j; const LAS float* s = scr + (8 * c) * 65 + n;
        u32x4 o; o.x = cvt_pk_bf16(s[0 * 65], s[1 * 65]); o.y = cvt_pk_bf16(s[2 * 65], s[3 * 65]); o.z = cvt_pk_bf16(s[4 * 65], s[5 * 65]); o.w = cvt_pk_bf16(s[6 * 65], s[7 * 65]);
        *(GAS u32x4*)(WT + (dst_row0 + n) * (size_t)ldk + kdst0 + k0 + 8 * c) = o; }
    LDS_WAIT(); asm volatile("" ::: "memory");
}

__device__ __forceinline__ unsigned pk4_fp8(float a, float b, float c, float d) { int w = 0; w = __builtin_amdgcn_cvt_pk_fp8_f32(a, b, w, false); w = __builtin_amdgcn_cvt_pk_fp8_f32(c, d, w, true); return (unsigned)w; }
__device__ __forceinline__ void transpose_tile_fp8(const float* W, int ldw, int k0, int n0, unsigned char* WT, size_t dst_row0, int ldk, float scale, LAS float* scr, int lane) {
    const int c4 = lane & 15, kr = lane >> 4;
#pragma unroll 4
    for (int it = 0; it < 16; ++it) { const int kk = 4 * it + kr; const f32x4 v = *(const GAS f32x4*)(W + (size_t)(k0 + kk) * ldw + n0 + 4 * c4);
        LAS float* s = scr + kk * 65 + 4 * c4; s[0] = v[0] * scale; s[1] = v[1] * scale; s[2] = v[2] * scale; s[3] = v[3] * scale; }
    LDS_WAIT(); asm volatile("" ::: "memory");
    const int c = lane & 3;
#pragma unroll
    for (int j = 0; j < 4; ++j) { const int n = (lane >> 2) + 16 * j; const LAS float* s = scr + (16 * c) * 65 + n;
        u32x4 o; o.x = pk4_fp8(s[0 * 65], s[1 * 65], s[2 * 65], s[3 * 65]); o.y = pk4_fp8(s[4 * 65], s[5 * 65], s[6 * 65], s[7 * 65]);
        o.z = pk4_fp8(s[8 * 65], s[9 * 65], s[10 * 65], s[11 * 65]); o.w = pk4_fp8(s[12 * 65], s[13 * 65], s[14 * 65], s[15 * 65]);
        *(GAS u32x4*)(WT + (dst_row0 + n) * (size_t)ldk + k0 + 16 * c) = o; }
    LDS_WAIT(); asm volatile("" ::: "memory");
}
__device__ __forceinline__ void phase_prep(const Frame& F, const Args& A) {
    unsigned char* ws = F.ws;
    if (blockIdx.x < 192) {
        const int l = blockIdx.x / 96, cc = blockIdx.x % 96, c4 = F.tid & 15, kq = F.tid >> 4;
        const float* w = A.in[I_ADAW] + (size_t)l * D * (NMOD * D) + cc * 64 + 4 * c4;
        f32x4 a0 = {0, 0, 0, 0}, a1 = {0, 0, 0, 0}, a2 = {0, 0, 0, 0};
        for (int i = 0; i < 32; ++i) { const int k = kq + 32 * i;
            const f32x4 wv = *(const GAS f32x4*)(w + (size_t)k * (NMOD * D));
            float c0 = A.in[I_C][k], c1 = A.in[I_C][D + k], c2 = A.in[I_CCTX][k];
            c0 = c0 * sigmoidf_(c0); c1 = c1 * sigmoidf_(c1); c2 = c2 * sigmoidf_(c2);
            a0 += wv * c0; a1 += wv * c1; a2 += wv * c2; }
        LAS f32x4* red = (LAS f32x4*)F.scr;
        red[(kq * 3 + 0) * 16 + c4] = a0; red[(kq * 3 + 1) * 16 + c4] = a1; red[(kq * 3 + 2) * 16 + c4] = a2;
        __syncthreads();
        if (F.tid < 192) { const int r = F.tid / 64, c = F.tid % 64; float s = 0.f;
            for (int q = 0; q < 32; ++q) s += ((LAS float*)F.scr)[((q * 3 + r) * 16) * 4 + c];
            const int col = cc * 64 + c;
            ((float*)(ws + WS_MOD))[(size_t)(l * 3 + r) * (NMOD * D) + col] = s + A.in[I_ADAB][(size_t)l * NMOD * D + col]; }
        __syncthreads();
    }
    { bf16_t* w2p = (bf16_t*)(ws + WS_WL2);
      for (int i = blockIdx.x * NTHREADS + F.tid; i < 4 * 1024 * 8; i += F.G * NTHREADS) { const int o = i / 8192, c = (i / 8) % 1024, q = i % 8, d = o & 1;
          *(GAS u32x4*)(w2p + ((size_t)o * 1024 + c) * 128 + (1 - d) * 64 + q * 8) = (u32x4){0u, 0u, 0u, 0u}; } }
    LAS float* scr = (LAS float*)(F.scr) + F.wave * (64 * 65 + 63);
    const int gw = F.vcu * NWAVES + F.wave, NGW = F.G * NWAVES;
    constexpr int T_GU = 2 * NE * 16 * 32, T_DN = 2 * NE * 16 * 16, T_RKV = 3 * 256, T_WO = 256, T_L1 = 2 * 16 + 2 * 16 + 32, T_L2 = 2 * 16 + 2 * 16 + 2 * 16, T_PW = 4 * 16;
    constexpr int T_ALL = T_GU + T_DN + T_RKV + T_WO + T_L1 + T_L2 + T_PW;
    for (int it = gw; it < T_ALL; it += NGW) {
        int r = it;
        if (r < T_GU) { const int le = r / 512, q = r % 512, kb = q / 32, nb = q % 32; const int n0 = nb * 64;
            const int drow = (n0 < 1024) ? ((n0 >> 7) * 256 + (n0 & 127)) : (((n0 - 1024) >> 7) * 256 + 128 + ((n0 - 1024) & 127));
            transpose_tile_fp8(A.in[I_WGU] + (size_t)le * 1024 * 2048, 2048, kb * 64, n0, ws + WS_WGU, (size_t)le * 2048 + drow, 1024, 32.0f, scr, F.lane); continue; } r -= T_GU;
        if (r < T_DN) { const int le = r / 256, q = r % 256, kb = q / 16, nb = q % 16;
            transpose_tile_fp8(A.in[I_WDN] + (size_t)le * 1024 * 1024, 1024, kb * 64, nb * 64, ws + WS_WDN, (size_t)le * 1024 + nb * 64, 1024, 32.0f, scr, F.lane); continue; } r -= T_DN;
        if (r < T_RKV) { const int p = r / 256, q = r % 256, kb = q / 16, nb = q % 16;
            transpose_tile(A.in[I_WRKV] + (size_t)p * 1024 * 1024, 1024, kb * 64, nb * 64, (bf16_t*)(ws + WS_WRKV), (size_t)p * 1024 + nb * 64, 1024, 0, scr, F.lane); continue; } r -= T_RKV;
        if (r < T_WO) { const int kb = r / 16, nb = r % 16;
            transpose_tile(A.in[I_WO], 1024, kb * 64, nb * 64, (bf16_t*)(ws + WS_WO), (size_t)nb * 64, 1024, 0, scr, F.lane); continue; } r -= T_WO;
        if (r < T_L1) {
            if (r < 32) { const int d = r / 16, kb = r % 16; transpose_tile(A.in[I_W1] + (size_t)d * 1024 * 64, 64, kb * 64, 0, (bf16_t*)(ws + WS_WL1), (size_t)0 * 256 + d * 64, 1024, 0, scr, F.lane); continue; }
            r -= 32;
            if (r < 32) { const int d = r / 16, kb = r % 16; transpose_tile(A.in[I_A1] + (size_t)d * 1024 * 64, 64, kb * 64, 0, (bf16_t*)(ws + WS_WL1), (size_t)1 * 256 + d * 64, 1024, 0, scr, F.lane); continue; }
            r -= 32;
            { const int kb = r / 2, nb = r % 2; transpose_tile(A.in[I_G1], 128, kb * 64, nb * 64, (bf16_t*)(ws + WS_WL1), (size_t)2 * 256 + nb * 64, 1024, 0, scr, F.lane); continue; }
        } r -= T_L1;
        if (r < T_L2) {
            if (r < 32) { const int d = r / 16, nb = r % 16; transpose_tile(A.in[I_W2] + (size_t)d * 64 * 1024, 1024, 0, nb * 64, (bf16_t*)(ws + WS_WL2), (size_t)d * 1024 + nb * 64, 128, d * 64, scr, F.lane); continue; }
            r -= 32;
            if (r < 32) { const int d = r / 16, nb = r % 16; transpose_tile(A.in[I_A2] + (size_t)d * 64 * 1024, 1024, 0, nb * 64, (bf16_t*)(ws + WS_WL2), (size_t)(2 + d) * 1024 + nb * 64, 128, d * 64, scr, F.lane); continue; }
            r -= 32;
            { const int kb = r / 16, nb = r % 16; transpose_tile(A.in[I_G2], 1024, kb * 64, nb * 64, (bf16_t*)(ws + WS_WL2), (size_t)4 * 1024 + nb * 64, 128, 0, scr, F.lane); continue; }
        } r -= T_L2;
        { const int g = r / 16, q = r % 16, kb = q / 4, nb = q % 4;
          transpose_tile(A.in[I_POOLW] + (size_t)g * 256 * 256, 256, kb * 64, nb * 64, (bf16_t*)(ws + WS_WPOOL), (size_t)g * 256 + nb * 64, 256, 0, scr, F.lane); }
    }
}

__device__ __forceinline__ void phase_pre0(const Frame& F, const Args& A) {
    LAS float* hb = (LAS float*)F.scr;
    LAS float* rs = hb + 80 * 258;
    LAS float* gsc = rs + 80;
    LAS float* gsh = gsc + 256;
    bf16_t* dbuf = (bf16_t*)(F.ws + WS_DBUF);
    const float* ng = A.in[I_NORMG];
    for (int u = blockIdx.x; u < 520; u += F.G) {
        int tok0, nown = 64, hl = 0, hr = 0, L, pos0, row; const float* xsrc;
        if (u < 512) { tok0 = u * 64; L = 64; pos0 = 0; row = tok0 >> 14; xsrc = A.in[I_X] + (size_t)tok0 * D; }
        else { const int b = (u - 512) >> 2, q = (u - 512) & 3; tok0 = NL + b * CT + q * 64; L = CT; pos0 = q * 64; hl = q > 0 ? 8 : 0; hr = q < 3 ? 8 : 0; row = 2;
               xsrc = A.in[I_CTX] + (size_t)(b * CT + q * 64) * D; }
        const int nt = nown + hl + hr;
        for (int j = F.wave; j < nt; j += NWAVES) { const float* xr = xsrc + (ptrdiff_t)(j - hl) * D; float s = 0.f;
#pragma unroll
            for (int q = 0; q < 4; ++q) { const f32x4 v = *(const GAS f32x4*)(xr + 4 * F.lane + 256 * q); s += v[0] * v[0] + v[1] * v[1] + v[2] * v[2] + v[3] * v[3]; }
            s = wave_sum(s); if (F.lane == 0) rs[j] = 1.0f / sqrtf(s * (1.0f / D) + NORM_EPS); }
        for (int g = 0; g < 4; ++g) {
            __syncthreads();
            if (F.tid < 256) { const int c = g * 256 + F.tid; gsc[F.tid] = ng[c] * (1.0f + modp(F, 0, row, 1)[c]); gsh[F.tid] = modp(F, 0, row, 0)[c]; }
            __syncthreads();
            for (int i = F.tid; i < nt * 64; i += NTHREADS) { const int j = i >> 6, c4 = i & 63; const f32x4 v = *(const GAS f32x4*)(xsrc + (ptrdiff_t)(j - hl) * D + g * 256 + 4 * c4);
                const float r = rs[j]; LAS float* h = hb + j * 258 + 4 * c4;
                h[0] = v[0] * r * gsc[4 * c4 + 0] + gsh[4 * c4 + 0]; h[1] = v[1] * r * gsc[4 * c4 + 1] + gsh[4 * c4 + 1];
                h[2] = v[2] * r * gsc[4 * c4 + 2] + gsh[4 * c4 + 2]; h[3] = v[3] * r * gsc[4 * c4 + 3] + gsh[4 * c4 + 3]; }
            __syncthreads();
            const int win = 2 << g, hw = win >> 1;
            for (int i = F.tid; i < 64 * 128; i += NTHREADS) { const int cp = i & 127, t = i >> 7; const int p = pos0 + t;
                int lo = p - hw, hi = p + hw - 1; lo = lo < 0 ? 0 : lo; hi = hi > L - 1 ? L - 1 : hi;
                const int jlo = lo - (pos0 - hl), jhi = hi - (pos0 - hl);
                float s0 = 0.f, s1 = 0.f;
                for (int j = jlo; j <= jhi; ++j) { const f32x2 v = *(const LAS f32x2*)(hb + j * 258 + 2 * cp); s0 += v[0]; s1 += v[1]; }
                const float ic = 1.0f / (float)(hi - lo + 1); const f32x2 hv = *(const LAS f32x2*)(hb + (t + hl) * 258 + 2 * cp);
                *(GAS unsigned*)(dbuf + (size_t)(tok0 + t) * D + g * 256 + 2 * cp) = cvt_pk_bf16(s0 * ic - hv[0], s1 * ic - hv[1]); }
        }
        __syncthreads();
    }
}

struct SchedPool {
    static constexpr bool SIDE = false; static constexpr bool XSYNC = false; static constexpr bool GATHER = false;
    int G, vcu; int nt; unsigned ldb;
    __device__ __forceinline__ bool next(int i, GU& u) const { const int L = i * G + vcu; if (L >= 130 * 4) return false; const int pm = L >> 2, g = L & 3;
        u.a = (unsigned)(WS_DBUF + ((size_t)pm * 256 * D + g * 256) * 2); u.b = (unsigned)(WS_WPOOL + (size_t)g * 256 * 256 * 2); u.i0 = pm; u.i1 = g; u.i2 = 0; u.i3 = 0; return true; }
    __device__ __forceinline__ void aoff(const GU&, const int (&R)[2], const int (&C)[2], unsigned (&v)[2][2]) const {
#pragma unroll
        for (int h = 0; h < 2; ++h)
#pragma unroll
            for (int i = 0; i < 2; ++i) v[h][i] = (unsigned)((h * 128 + R[i]) * D + C[i]) * 2u; }
};
struct EpiPool {
    static constexpr bool FP8 = false; static constexpr bool PERM = false;
    const float* x; const float* ctx; const float* ls; const float* gate_base; float* xs;
    __device__ __forceinline__ void operator()(const f32x4 (&acc)[2][2][4][2], const GU& u, int wr, int wc, int fr, int fq, const LAS float* sb) const {
        const int pm = u.i0, g = u.i1; const int mrow = pm < 128 ? (pm >> 6) : 2;
        const float* gate = gate_base + (size_t)mrow * NMOD * D;
        const float* src = pm < 128 ? x + (size_t)pm * 256 * D : ctx + (size_t)(pm - 128) * 256 * D;
        const int col0 = g * 256 + wc * 32 + 4 * fq;
        f32x4 gl[2][2];
#pragma unroll
        for (int bj = 0; bj < 2; ++bj)
#pragma unroll
            for (int n = 0; n < 2; ++n) { const int c = col0 + bj * 128 + n * 16; gl[bj][n] = *(const GAS f32x4*)(gate + c) * *(const GAS f32x4*)(ls + c); }
#pragma unroll
        for (int ai = 0; ai < 2; ++ai)
#pragma unroll
            for (int m = 0; m < 4; ++m) { const int r = ai * 128 + wr * 64 + m * 16 + fr; const float* sp = src + (size_t)r * D + col0; float* op = xs + ((size_t)pm * 256 + r) * D + col0;
#pragma unroll
                for (int bj = 0; bj < 2; ++bj)
#pragma unroll
                    for (int n = 0; n < 2; ++n) *(GAS f32x4*)(op + bj * 128 + n * 16) = *(const GAS f32x4*)(sp + bj * 128 + n * 16) + gl[bj][n] * acc[ai][bj][m][n]; }
    }
};

__device__ __forceinline__ void phase_final_plain(const Frame& F, const Args& A, const float* xs) {
    const int gw = blockIdx.x * NWAVES + F.wave, NGW = F.G * NWAVES;
    for (int n = gw; n < NL; n += NGW) { const float* xr = xs + (size_t)n * D; f32x4 v[4]; float s = 0.f;
#pragma unroll
        for (int q = 0; q < 4; ++q) { v[q] = *(const GAS f32x4*)(xr + 4 * F.lane + 256 * q); s += v[q][0] * v[q][0] + v[q][1] * v[q][1] + v[q][2] * v[q][2] + v[q][3] * v[q][3]; }
        s = wave_sum(s); const float r = 1.0f / sqrtf(s * (1.0f / D) + NORM_EPS);
#pragma unroll
        for (int q = 0; q < 4; ++q) { const f32x4 g = *(const GAS f32x4*)(A.in[I_FINALG] + 4 * F.lane + 256 * q); *(GAS f32x4*)(A.out + (size_t)n * D + 4 * F.lane + 256 * q) = v[q] * r * g; }
    }
}


__device__ __forceinline__ int* cnt_word(const Frame& F, int l, int e) { return (int*)(F.ws + WS_CTL + CTL_CNT) + (l * NE + e) * 64; }
__device__ __forceinline__ void phase_post(const Frame& F, const Args& A, int l, const float* xs, int ntok) {
    LAS float* h2s = (LAS float*)F.scr;
    LAS float* part = (LAS float*)F.scr;
    LAS float* lgs = (LAS float*)(F.scr + 32 * 1028 * 4);
    LAS int* hist = (LAS int*)(lgs + 32 * 33);
    LAS int* base = hist + 32;
    LAS int* sel = base + 32;
    LAS int* lrank = sel + 128;
    unsigned char* H2 = F.ws + WS_H2;
    int* list = (int*)(F.ws + WS_LIST) + (size_t)l * NE * NTOK;
    int* tinfo = (int*)(F.ws + WS_TINFO) + (size_t)l * NTOK * 4;
    float* tgate = (float*)(F.ws + WS_TGATE) + (size_t)l * NTOK * 4;
    const float* ng = A.in[I_NORMG] + (size_t)(l * 2 + 1) * D;
    const float* rw = A.in[I_RW] + (size_t)l * D * NE;
    const float* rb = A.in[I_RB] + (size_t)l * NE;
    const int ntiles = ntok / 32;
    for (int tile = blockIdx.x; tile < ntiles; tile += F.G) {
        const int n0 = tile * 32, mrow = mrow_of(n0);
        const float* sc = modp(F, l, mrow, 4); const float* sh = modp(F, l, mrow, 3);
        if (F.tid < 32) hist[F.tid] = 0;
#pragma unroll 1
        for (int q = 0; q < 4; ++q) { const int tt = F.wave * 4 + q, n = n0 + tt; const float* xr = xs + (size_t)n * D; f32x4 v[4]; float s = 0.f;
#pragma unroll
            for (int jj = 0; jj < 4; ++jj) { v[jj] = *(const GAS f32x4*)(xr + 4 * F.lane + 256 * jj); s += v[jj][0] * v[jj][0] + v[jj][1] * v[jj][1] + v[jj][2] * v[jj][2] + v[jj][3] * v[jj][3]; }
            s = wave_sum(s); const float r = 1.0f / sqrtf(s * (1.0f / D) + NORM_EPS);
#pragma unroll
            for (int jj = 0; jj < 4; ++jj) { const int c = 4 * F.lane + 256 * jj; const f32x4 g = *(const GAS f32x4*)(ng + c), a = *(const GAS f32x4*)(sc + c), b = *(const GAS f32x4*)(sh + c);
                const f32x4 h = v[jj] * r * g * (a + 1.0f) + b;
                *(LAS f32x4*)(h2s + tt * 1028 + c) = h;
                *(GAS unsigned*)(H2 + (size_t)n * D + c) = pk4_fp8(h[0], h[1], h[2], h[3]); } }
        __syncthreads();
        f32x16 acc;
#pragma unroll
        for (int i = 0; i < 16; ++i) acc[i] = 0.f;
        { const int r = F.lane & 31, h = F.lane >> 5;
#pragma unroll 4
          for (int q = 0; q < 16; ++q) { const int kb = 128 * F.wave + 8 * q + 4 * h; const f32x4 a = *(const LAS f32x4*)(h2s + r * 1028 + kb);
              const float b0 = rw[(size_t)(kb + 0) * NE + r], b1 = rw[(size_t)(kb + 1) * NE + r], b2 = rw[(size_t)(kb + 2) * NE + r], b3 = rw[(size_t)(kb + 3) * NE + r];
              acc = __builtin_amdgcn_mfma_f32_32x32x2f32(a[0], b0, acc, 0, 0, 0); acc = __builtin_amdgcn_mfma_f32_32x32x2f32(a[1], b1, acc, 0, 0, 0);
              acc = __builtin_amdgcn_mfma_f32_32x32x2f32(a[2], b2, acc, 0, 0, 0); acc = __builtin_amdgcn_mfma_f32_32x32x2f32(a[3], b3, acc, 0, 0, 0); } }
        __syncthreads();
#pragma unroll
        for (int i = 0; i < 16; ++i) { const int row = (i & 3) + 8 * (i >> 2) + 4 * (F.lane >> 5), col = F.lane & 31; part[(F.wave * 32 + row) * 32 + col] = acc[i]; }
        __syncthreads();
        for (int i = F.tid; i < 1024; i += NTHREADS) { const int row = i >> 5, col = i & 31; float s = rb[col];
#pragma unroll
            for (int w = 0; w < 8; ++w) s += part[(w * 32 + row) * 32 + col];
            lgs[row * 33 + col] = s; }
        __syncthreads();
        if (F.tid < 32) { const int t = F.tid; float lv[32];
#pragma unroll
            for (int e = 0; e < 32; ++e) lv[e] = lgs[t * 33 + e];
            float tv[4]; int te[4];
#pragma unroll
            for (int j = 0; j < 4; ++j) { float best = -3.0e38f; int be = 0;
#pragma unroll
                for (int e = 0; e < 32; ++e) { const bool gt = lv[e] > best; best = gt ? lv[e] : best; be = gt ? e : be; }
                tv[j] = best; te[j] = be;
#pragma unroll
                for (int e = 0; e < 32; ++e) lv[e] = (e == be) ? -3.0e38f : lv[e]; }
            const float e1 = __expf(tv[1] - tv[0]), e2 = __expf(tv[2] - tv[0]), e3 = __expf(tv[3] - tv[0]); const float inv = 1.0f / (1.0f + e1 + e2 + e3);
            const float gt[4] = {inv, e1 * inv, e2 * inv, e3 * inv};
#pragma unroll
            for (int j = 0; j < 4; ++j) { sel[t * 4 + j] = te[j]; lrank[t * 4 + j] = __hip_atomic_fetch_add(&hist[te[j]], 1, __ATOMIC_RELAXED, __HIP_MEMORY_SCOPE_WORKGROUP);
                tgate[(size_t)(n0 + t) * 4 + j] = gt[j]; } }
        __syncthreads();
        if (F.tid < 32) { const int c = hist[F.tid]; base[F.tid] = c > 0 ? __hip_atomic_fetch_add(cnt_word(F, l, F.tid), c, __ATOMIC_RELAXED, __HIP_MEMORY_SCOPE_AGENT) : 0; }
        __syncthreads();
        if (F.tid < 128) { const int t = F.tid >> 2, e = sel[F.tid], pos = base[e] + lrank[F.tid]; list[(size_t)e * NTOK + pos] = n0 + t; tinfo[(size_t)(n0 + t) * 4 + (F.tid & 3)] = (e << 16) | pos; }
        __syncthreads();
    }
}

__device__ __forceinline__ void moe_prefix(const Frame& F, int l) {
    volatile LAS int* M = (volatile LAS int*)(F.lds + MISC_OFF);
    __syncthreads();
    if (F.tid == 0) { int acc = 0; for (int e = 0; e < NE; ++e) { const int c = __hip_atomic_load(cnt_word(F, l, e), __ATOMIC_RELAXED, __HIP_MEMORY_SCOPE_AGENT); M[64 + e] = c; M[16 + e] = acc; acc += (c + 255) >> 8; } M[16 + NE] = acc; }
    __syncthreads();
    { volatile LAS unsigned char* T2E = (volatile LAS unsigned char*)(F.lds + MISC_OFF + 448);
      for (int t = F.tid; t < 560; t += NTHREADS) { int e = 0; while (e < NE - 1 && M[16 + e + 1] <= t) ++e; T2E[t] = (unsigned char)e; } }
    __syncthreads();
}

struct SchedMoe1 {
    static constexpr bool SIDE = true; static constexpr bool XSYNC = false; static constexpr bool GATHER = true;
    const LAS int* M; const int* list; unsigned h2; unsigned w; int G, vcu; int nt; unsigned ldb; unsigned* xw; unsigned nloc; int rounds; __amdgpu_buffer_rsrc_t rsrcb; unsigned listoff;
    __device__ __forceinline__ bool side_src(const GU& u, int tid, unsigned& off) const { const int e = u.i0, pn = u.i2;
        if (tid < 256) { const int row0 = (u.i1 - M[16 + e]) * 256, nv = M[64 + e] - row0; off = listoff + (unsigned)(e * NTOK + row0 + (tid < nv ? tid : 0)) * 4u; return false; }
        const int j = tid - 256; off = (unsigned)(e * 2048 + (j < 128 ? 0 : 1024) + pn * 128 + (j & 127)) * 4u; return true; }
    __device__ __forceinline__ unsigned tok_off(int tok, int c) const { return (unsigned)(tok * D + 2 * c); }
    __device__ __forceinline__ bool next(int i, GU& u) const { const int L = i * G + vcu; const int tt = M[16 + NE]; if (L >= tt * 8) return false; const int mt = L >> 3, pn = L & 7;
        const int e = ((const LAS unsigned char*)M)[448 + mt];
        u.a = h2; u.b = w + (unsigned)(((size_t)e * 2048 + pn * 256) * 1024); u.i0 = e; u.i1 = mt; u.i2 = pn; u.i3 = 0; return true; }
    __device__ __forceinline__ void aoff(const GU& u, const int (&R)[2], const int (&C)[2], unsigned (&v)[2][2]) const {
        const int e = u.i0, row0 = (u.i1 - M[16 + e]) * 256, nv = M[64 + e] - row0; const int* lp = list + (size_t)e * NTOK + row0;
#pragma unroll
        for (int h = 0; h < 2; ++h)
#pragma unroll
            for (int i = 0; i < 2; ++i) { const int r = h * 128 + R[i]; const int tok = lp[r < nv ? r : 0]; v[h][i] = (unsigned)(tok * D + 2 * C[i]); } }
};
struct EpiMoe1 {
    static constexpr bool FP8 = true; static constexpr bool PERM = true;
    const float* bgu; unsigned char* act;
    __device__ __forceinline__ void operator()(const f32x4 (&acc)[2][2][4][2], const GU& u, int wr, int wc, int fr, int fq, const LAS float* sb) const {
        const int e = u.i0, mt = u.i1, pn = u.i2; const int col0 = pn * 128 + wc * 32 + 8 * fq;
        f32x4 bg[2], bu[2];
#pragma unroll
        for (int n = 0; n < 2; ++n) { bg[n] = *(const LAS f32x4*)(sb + wc * 32 + 8 * fq + 4 * n); bu[n] = *(const LAS f32x4*)(sb + 128 + wc * 32 + 8 * fq + 4 * n); }
#pragma unroll
        for (int ai = 0; ai < 2; ++ai)
#pragma unroll
            for (int m = 0; m < 4; ++m) { const size_t slot = (size_t)mt * 256 + ai * 128 + wr * 64 + m * 16 + fr; float o[8];
#pragma unroll
                for (int n = 0; n < 2; ++n)
#pragma unroll
                    for (int j = 0; j < 4; ++j) { float g = acc[ai][0][m][n][j] + bg[n][j], up = acc[ai][1][m][n][j] + bu[n][j];
                        g = fminf(g, 7.0f); up = fminf(fmaxf(up, -7.0f), 7.0f); o[4 * n + j] = (up + 1.0f) * (g * __builtin_amdgcn_rcpf(1.0f + __expf(-1.702f * g))); }
                u32x2 w; w.x = pk4_fp8(o[0], o[1], o[2], o[3]); w.y = pk4_fp8(o[4], o[5], o[6], o[7]);
                *(GAS u32x2*)(act + slot * D + col0) = w; }
    }
};
struct SchedMoe2 {
    static constexpr bool SIDE = true; static constexpr bool XSYNC = false; static constexpr bool GATHER = false;
    const LAS int* M; unsigned act; unsigned w; int G, vcu; int nt; unsigned ldb; unsigned* xw; unsigned nloc; int rounds; __amdgpu_buffer_rsrc_t rsrcb;
    __device__ __forceinline__ bool side_src(const GU& u, int tid, unsigned& off) const { const int e = u.i0, pn = u.i2;
        if (tid < 256) { off = 0u; return false; }
        off = (unsigned)(e * D + pn * 256 + (tid - 256)) * 4u; return true; }
    __device__ __forceinline__ bool next(int i, GU& u) const { const int L = i * G + vcu; const int tt = M[16 + NE]; if (L >= tt * 4) return false; const int mt = L >> 2, pn = L & 3;
        const int e = ((const LAS unsigned char*)M)[448 + mt];
        u.a = act + (unsigned)((size_t)mt * 256 * D); u.b = w + (unsigned)(((size_t)e * 1024 + pn * 256) * 1024); u.i0 = e; u.i1 = mt; u.i2 = pn; u.i3 = 0; return true; }
    __device__ __forceinline__ void aoff(const GU&, const int (&R)[2], const int (&C)[2], unsigned (&v)[2][2]) const {
#pragma unroll
        for (int h = 0; h < 2; ++h)
#pragma unroll
            for (int i = 0; i < 2; ++i) v[h][i] = (unsigned)((h * 128 + R[i]) * D + 2 * C[i]); }
};
struct EpiMoe2 {
    static constexpr bool FP8 = true; static constexpr bool PERM = true;
    const float* bdn; bf16_t* y2;
    __device__ __forceinline__ void operator()(const f32x4 (&acc)[2][2][4][2], const GU& u, int wr, int wc, int fr, int fq, const LAS float* sb) const {
        const int e = u.i0, mt = u.i1, pn = u.i2; const int col0 = pn * 256 + wc * 32 + 8 * fq;
        f32x4 bv[2][2];
#pragma unroll
        for (int bj = 0; bj < 2; ++bj)
#pragma unroll
            for (int n = 0; n < 2; ++n) bv[bj][n] = *(const LAS f32x4*)(sb + bj * 128 + wc * 32 + 8 * fq + 4 * n);
#pragma unroll
        for (int ai = 0; ai < 2; ++ai)
#pragma unroll
            for (int m = 0; m < 4; ++m) { const size_t slot = (size_t)mt * 256 + ai * 128 + wr * 64 + m * 16 + fr;
#pragma unroll
                for (int bj = 0; bj < 2; ++bj) { const f32x4 v0 = acc[ai][bj][m][0] + bv[bj][0], v1 = acc[ai][bj][m][1] + bv[bj][1];
                    u32x4 w; w.x = cvt_pk_bf16(v0[0], v0[1]); w.y = cvt_pk_bf16(v0[2], v0[3]); w.z = cvt_pk_bf16(v1[0], v1[1]); w.w = cvt_pk_bf16(v1[2], v1[3]);
                    *(GAS u32x4*)(y2 + slot * D + col0 + bj * 128) = w; } }
    }
};
__device__ __forceinline__ void phase_moe1(const Frame& F, const Args& A, int l) {
    moe_prefix(F, l);
    SchedMoe1 S{(const LAS int*)(F.lds + MISC_OFF), (const int*)(F.ws + WS_LIST) + (size_t)l * NE * NTOK, (unsigned)WS_H2, (unsigned)(WS_WGU + (size_t)l * NE * 2048 * 1024), F.G, F.vcu, 8, 1024u,
                (unsigned*)(F.ws + WS_CTL + CTL_XSYNC) + ((l * 2 + 0) * 16 + xb_xcc_id()) * 32, ((volatile LAS unsigned*)(F.lds + MISC_OFF))[8], (((const LAS int*)(F.lds + MISC_OFF))[16 + NE] * 8 + F.G - 1) / F.G,
                __builtin_amdgcn_make_buffer_rsrc((void*)(A.in[I_BGU] + (size_t)l * NE * 2048), 0, NE * 2048 * 4, 0x00020000), (unsigned)(WS_LIST + (size_t)l * NE * NTOK * 4)};
    EpiMoe1 E{A.in[I_BGU] + (size_t)l * NE * 2048, F.ws + WS_ACT};
    pg8::gemm_phase<EpiMoe1, SchedMoe1>(F.scr, F.ws, S, E);
}
__device__ __forceinline__ void phase_moe2(const Frame& F, const Args& A, int l) {
    moe_prefix(F, l);
    SchedMoe2 S{(const LAS int*)(F.lds + MISC_OFF), (unsigned)WS_ACT, (unsigned)(WS_WDN + (size_t)l * NE * 1024 * 1024), F.G, F.vcu, 8, 1024u,
                (unsigned*)(F.ws + WS_CTL + CTL_XSYNC) + ((l * 2 + 1) * 16 + xb_xcc_id()) * 32, ((volatile LAS unsigned*)(F.lds + MISC_OFF))[8], (((const LAS int*)(F.lds + MISC_OFF))[16 + NE] * 4 + F.G - 1) / F.G,
                __builtin_amdgcn_make_buffer_rsrc((void*)(A.in[I_BDN] + (size_t)l * NE * D), 0, NE * D * 4, 0x00020000)};
    EpiMoe2 E{A.in[I_BDN] + (size_t)l * NE * D, (bf16_t*)(F.ws + WS_Y2)};
    pg8::gemm_phase<EpiMoe2, SchedMoe2>(F.scr, F.ws, S, E);
}
__device__ __forceinline__ void moe_combine_row(const Frame& F, int l, int n, f32x4 (&o)[4]) {
    const volatile LAS int* M = (const volatile LAS int*)(F.lds + MISC_OFF);
    const int* ti = (const int*)(F.ws + WS_TINFO) + ((size_t)l * NTOK + n) * 4; const float* tg = (const float*)(F.ws + WS_TGATE) + ((size_t)l * NTOK + n) * 4;
    const bf16_t* y2 = (const bf16_t*)(F.ws + WS_Y2);
#pragma unroll
    for (int q = 0; q < 4; ++q) o[q] = (f32x4){0.f, 0.f, 0.f, 0.f};
#pragma unroll
    for (int j = 0; j < 4; ++j) { const int inf = ti[j]; const float g = tg[j]; const int e = inf >> 16, pos = inf & 0xffff; const size_t slot = (size_t)M[16 + e] * 256 + pos;
#pragma unroll
        for (int q = 0; q < 4; ++q) { const u32x2 w = *(const GAS u32x2*)(y2 + slot * D + 4 * F.lane + 256 * q);
            o[q] += (f32x4){bf_lo(w.x), bf_hi(w.x), bf_lo(w.y), bf_hi(w.y)} * g; } }
}
__device__ __forceinline__ void phase_final(const Frame& F, const Args& A, int l, const float* xs) {
    moe_prefix(F, l);
    const int gw = blockIdx.x * NWAVES + F.wave, NGW = F.G * NWAVES;
    for (int n = gw; n < NL; n += NGW) { const float* xr = xs + (size_t)n * D; const float* gate = modp(F, l, n >> 14, 5); f32x4 v[4], mo[4]; float s = 0.f;
        moe_combine_row(F, l, n, mo);
#pragma unroll
        for (int q = 0; q < 4; ++q) { const int c = 4 * F.lane + 256 * q; v[q] = *(const GAS f32x4*)(xr + c) + *(const GAS f32x4*)(gate + c) * mo[q]; s += v[q][0] * v[q][0] + v[q][1] * v[q][1] + v[q][2] * v[q][2] + v[q][3] * v[q][3]; }
        s = wave_sum(s); const float r = 1.0f / sqrtf(s * (1.0f / D) + NORM_EPS);
#pragma unroll
        for (int q = 0; q < 4; ++q) { const f32x4 g = *(const GAS f32x4*)(A.in[I_FINALG] + 4 * F.lane + 256 * q); *(GAS f32x4*)(A.out + (size_t)n * D + 4 * F.lane + 256 * q) = v[q] * r * g; }
    }
}


__device__ __forceinline__ void phase_pre1(const Frame& F, const Args& A) {
    moe_prefix(F, 0);
    LAS float* hs = (LAS float*)F.scr;
    const float* xs0 = (const float*)(F.ws + WS_XS0); float* xs1 = (float*)(F.ws + WS_XS1);
    const float* ng = A.in[I_NORMG] + (size_t)(1 * 2 + 0) * D;
    for (int tile = blockIdx.x; tile < NTOK / 32; tile += F.G) {
        const int n0 = tile * 32, mrow = mrow_of(n0);
        const int sbeg = n0 < NL ? (n0 & ~(TSEQ - 1)) : (NL + ((n0 - NL) & ~(CT - 1))), send = sbeg + (n0 < NL ? TSEQ : CT);
        const float* gate5 = modp(F, 0, mrow, 5); const float* sc = modp(F, 1, mrow, 1); const float* sh = modp(F, 1, mrow, 0);
        for (int j = F.wave; j < 34; j += NWAVES) { const int n = n0 - 1 + j;
            if (n < sbeg || n >= send) {
#pragma unroll
                for (int q = 0; q < 4; ++q) *(LAS f32x4*)(hs + j * 1028 + 4 * F.lane + 256 * q) = (f32x4){0.f, 0.f, 0.f, 0.f};
                continue; }
            f32x4 mo[4], v[4]; float s = 0.f; moe_combine_row(F, 0, n, mo);
#pragma unroll
            for (int q = 0; q < 4; ++q) { const int c = 4 * F.lane + 256 * q; v[q] = *(const GAS f32x4*)(xs0 + (size_t)n * D + c) + *(const GAS f32x4*)(gate5 + c) * mo[q];
                s += v[q][0] * v[q][0] + v[q][1] * v[q][1] + v[q][2] * v[q][2] + v[q][3] * v[q][3]; }
            if (j >= 1 && j <= 32) {
#pragma unroll
                for (int q = 0; q < 4; ++q) *(GAS f32x4*)(xs1 + (size_t)n * D + 4 * F.lane + 256 * q) = v[q]; }
            s = wave_sum(s); const float r = 1.0f / sqrtf(s * (1.0f / D) + NORM_EPS);
#pragma unroll
            for (int q = 0; q < 4; ++q) { const int c = 4 * F.lane + 256 * q; const f32x4 g = *(const GAS f32x4*)(ng + c), a = *(const GAS f32x4*)(sc + c), b = *(const GAS f32x4*)(sh + c);
                *(LAS f32x4*)(hs + j * 1028 + c) = v[q] * r * g * (a + 1.0f) + b; } }
        __syncthreads();
#pragma unroll 1
        for (int q4 = 0; q4 < 4; ++q4) { const int t = F.wave * 4 + q4, j = t + 1, n = n0 + t;
#pragma unroll
            for (int q = 0; q < 4; ++q) { const int c = 4 * F.lane + 256 * q;
                const f32x4 hm = *(const LAS f32x4*)(hs + (j - 1) * 1028 + c), h0 = *(const LAS f32x4*)(hs + j * 1028 + c), hp = *(const LAS f32x4*)(hs + (j + 1) * 1028 + c);
                const f32x4 xx = (hm + hp) * 0.5f - h0;
#pragma unroll
                for (int i = 0; i < 6; ++i) { const f32x4 mu = *(const GAS f32x4*)(A.in[I_MU] + (size_t)i * D + c); const f32x4 o = h0 + xx * mu;
                    u32x2 w; w.x = cvt_pk_bf16(o[0], o[1]); w.y = cvt_pk_bf16(o[2], o[3]);
                    *(GAS u32x2*)((bf16_t*)(F.ws + WS_MIX + (size_t)i * ACTB) + (size_t)n * D + c) = w; } } }
        __syncthreads();
    }
}

struct SchedProj {
    static constexpr bool SIDE = false; static constexpr bool XSYNC = false; static constexpr bool GATHER = false;
    int G, vcu; int nt; unsigned ldb;
    __device__ __forceinline__ bool next(int i, GU& u) const { int L = i * G + vcu; if (L >= 1940) return false;
        int kind, mi, wi, pm, pn;
        if (L < 512) { kind = 0; mi = 0; wi = 0; pm = L >> 2; pn = L & 3; }
        else if (L < 1032) { L -= 512; kind = 0; mi = 2; wi = 1; pm = L >> 2; pn = L & 3; }
        else if (L < 1552) { L -= 1032; kind = 0; mi = 3; wi = 2; pm = L >> 2; pn = L & 3; }
        else if (L < 1682) { L -= 1552; kind = 1; mi = 1; wi = 0; pm = L; pn = 0; }
        else if (L < 1812) { L -= 1682; kind = 2; mi = 4; wi = 1; pm = L; pn = 0; }
        else { L -= 1812; kind = 3; mi = 5; wi = 2; pm = L; pn = 0; }
        u.a = (unsigned)(WS_MIX + (size_t)mi * ACTB + (size_t)pm * 256 * D * 2);
        u.b = kind == 0 ? (unsigned)(WS_WRKV + ((size_t)wi * 1024 + pn * 256) * 1024 * 2) : (unsigned)(WS_WL1 + (size_t)wi * 256 * 1024 * 2);
        u.i0 = pm; u.i1 = pn; u.i2 = kind; u.i3 = wi; return true; }
    __device__ __forceinline__ void aoff(const GU&, const int (&R)[2], const int (&C)[2], unsigned (&v)[2][2]) const {
#pragma unroll
        for (int h = 0; h < 2; ++h)
#pragma unroll
            for (int i = 0; i < 2; ++i) v[h][i] = (unsigned)((h * 128 + R[i]) * D + C[i]) * 2u; }
};
struct EpiProj {
    static constexpr bool FP8 = false; static constexpr bool PERM = true;
    unsigned char* ws;
    __device__ __forceinline__ void operator()(const f32x4 (&acc)[2][2][4][2], const GU& u, int wr, int wc, int fr, int fq, const LAS float* sb) const {
        const int pm = u.i0, pn = u.i1, kind = u.i2, wi = u.i3;
        if (kind == 0) { bf16_t* o = (bf16_t*)(ws + WS_RKV + (size_t)wi * ACTB); const int col0 = pn * 256 + wc * 32 + 8 * fq;
#pragma unroll
            for (int ai = 0; ai < 2; ++ai)
#pragma unroll
                for (int m = 0; m < 4; ++m) { const size_t n = (size_t)pm * 256 + ai * 128 + wr * 64 + m * 16 + fr;
#pragma unroll
                    for (int bj = 0; bj < 2; ++bj) { const f32x4 v0 = acc[ai][bj][m][0], v1 = acc[ai][bj][m][1];
                        u32x4 w; w.x = cvt_pk_bf16(v0[0], v0[1]); w.y = cvt_pk_bf16(v0[2], v0[3]); w.z = cvt_pk_bf16(v1[0], v1[1]); w.w = cvt_pk_bf16(v1[2], v1[3]);
                        *(GAS u32x4*)(o + n * D + col0 + bj * 128) = w; } }
        } else { bf16_t* o = (bf16_t*)(ws + WS_LACT + (size_t)(kind - 1) * NTOK * 128 * 2); const int col0 = wc * 32 + 8 * fq;
#pragma unroll
            for (int ai = 0; ai < 2; ++ai)
#pragma unroll
                for (int m = 0; m < 4; ++m) { const size_t n = (size_t)pm * 256 + ai * 128 + wr * 64 + m * 16 + fr; float t[8];
#pragma unroll
                    for (int nn = 0; nn < 2; ++nn)
#pragma unroll
                        for (int j = 0; j < 4; ++j) { const float x = acc[ai][0][m][nn][j]; t[4 * nn + j] = kind == 1 ? tanhf(x) : (kind == 2 ? x : sigmoidf_(x)); }
                    u32x4 w; w.x = cvt_pk_bf16(t[0], t[1]); w.y = cvt_pk_bf16(t[2], t[3]); w.z = cvt_pk_bf16(t[4], t[5]); w.w = cvt_pk_bf16(t[6], t[7]);
                    *(GAS u32x4*)(o + n * 128 + col0) = w; } }
    }
};
struct SchedLora2 {
    static constexpr bool SIDE = false; static constexpr bool XSYNC = false; static constexpr bool GATHER = false;
    int G, vcu; int nt; unsigned ldb;
    __device__ __forceinline__ bool next(int i, GU& u) const { int L = i * G + vcu; if (L >= 4 * 520 + 512) return false;
        const int o = L < 2080 ? L / 520 : 4; L -= o * 520; const int pm = L >> 2, pn = L & 3; const int oa = o < 4 ? (o >> 1) : 2;
        u.a = (unsigned)(WS_LACT + (size_t)oa * NTOK * 128 * 2 + (size_t)pm * 256 * 128 * 2); u.b = (unsigned)(WS_WL2 + ((size_t)o * 1024 + pn * 256) * 128 * 2);
        u.i0 = pm; u.i1 = pn; u.i2 = o; u.i3 = 0; return true; }
    __device__ __forceinline__ void aoff(const GU&, const int (&R)[2], const int (&C)[2], unsigned (&v)[2][2]) const {
#pragma unroll
        for (int h = 0; h < 2; ++h)
#pragma unroll
            for (int i = 0; i < 2; ++i) v[h][i] = (unsigned)((h * 128 + R[i]) * 128 + C[i]) * 2u; }
};
struct EpiLora2 {
    static constexpr bool FP8 = false; static constexpr bool PERM = false;
    unsigned char* ws; const float* w0; const float* a0;
    __device__ __forceinline__ void operator()(const f32x4 (&acc)[2][2][4][2], const GU& u, int wr, int wc, int fr, int fq, const LAS float* sb) const {
        const int pm = u.i0, pn = u.i1, o = u.i2; const int col0 = pn * 256 + wc * 32 + 4 * fq;
        const float* bp = (o < 2 ? w0 + (size_t)o * D : a0 + (size_t)(o & 1) * D) + col0; const float bsc = o < 4 ? 1.0f : 0.0f;
        f32x4 bv[2][2];
#pragma unroll
        for (int bj = 0; bj < 2; ++bj)
#pragma unroll
            for (int n = 0; n < 2; ++n) bv[bj][n] = *(const GAS f32x4*)(bp + bj * 128 + n * 16) * bsc;
        const size_t row0 = (size_t)pm * 256 + wr * 64 + fr;
        if (o < 2) { bf16_t* dst = (bf16_t*)(ws + WS_DEC + (size_t)o * ACTB) + row0 * D + col0;
#pragma unroll
            for (int ai = 0; ai < 2; ++ai)
#pragma unroll
                for (int m = 0; m < 4; ++m)
#pragma unroll
                    for (int bj = 0; bj < 2; ++bj)
#pragma unroll
                        for (int nn = 0; nn < 2; ++nn) { const f32x4 z = acc[ai][bj][m][nn] + bv[bj][nn]; f32x4 d;
#pragma unroll
                            for (int j = 0; j < 4; ++j) d[j] = -0.60653066f * sigmoidf_(z[j]);
                            u32x2 w; w.x = cvt_pk_bf16(d[0], d[1]); w.y = cvt_pk_bf16(d[2], d[3]);
                            *(GAS u32x2*)(dst + (size_t)(ai * 128 + m * 16) * D + bj * 128 + nn * 16) = w; }
        } else { bf16_t* dst = (o < 4 ? (bf16_t*)(ws + WS_ICL + (size_t)(o - 2) * ACTB) : (bf16_t*)(ws + WS_G)) + row0 * D + col0; const bool sg = o < 4;
#pragma unroll
            for (int ai = 0; ai < 2; ++ai)
#pragma unroll
                for (int m = 0; m < 4; ++m)
#pragma unroll
                    for (int bj = 0; bj < 2; ++bj)
#pragma unroll
                        for (int nn = 0; nn < 2; ++nn) { f32x4 z = acc[ai][bj][m][nn] + bv[bj][nn];
#pragma unroll
                            for (int j = 0; j < 4; ++j) z[j] = sg ? sigmoidf_(z[j]) : z[j];
                            u32x2 w; w.x = cvt_pk_bf16(z[0], z[1]); w.y = cvt_pk_bf16(z[2], z[3]);
                            *(GAS u32x2*)(dst + (size_t)(ai * 128 + m * 16) * D + bj * 128 + nn * 16) = w; }
        }
    }
};
__device__ __forceinline__ void ld16bf(const bf16_t* p, float (&o)[16]) { const u32x4 a = *(const GAS u32x4*)p, b = *(const GAS u32x4*)(p + 8);
    o[0] = bf_lo(a.x); o[1] = bf_hi(a.x); o[2] = bf_lo(a.y); o[3] = bf_hi(a.y); o[4] = bf_lo(a.z); o[5] = bf_hi(a.z); o[6] = bf_lo(a.w); o[7] = bf_hi(a.w);
    o[8] = bf_lo(b.x); o[9] = bf_hi(b.x); o[10] = bf_lo(b.y); o[11] = bf_hi(b.y); o[12] = bf_lo(b.z); o[13] = bf_hi(b.z); o[14] = bf_lo(b.w); o[15] = bf_hi(b.w); }
__device__ __forceinline__ void st16bf(bf16_t* p, const float (&o)[16]) { u32x4 a, b;
    a.x = cvt_pk_bf16(o[0], o[1]); a.y = cvt_pk_bf16(o[2], o[3]); a.z = cvt_pk_bf16(o[4], o[5]); a.w = cvt_pk_bf16(o[6], o[7]);
    b.x = cvt_pk_bf16(o[8], o[9]); b.y = cvt_pk_bf16(o[10], o[11]); b.z = cvt_pk_bf16(o[12], o[13]); b.w = cvt_pk_bf16(o[14], o[15]);
    *(GAS u32x4*)p = a; *(GAS u32x4*)(p + 8) = b; }
__device__ __forceinline__ void ld16f(const float* p, float (&o)[16]) {
#pragma unroll
    for (int q = 0; q < 4; ++q) { const f32x4 v = *(const GAS f32x4*)(p + 4 * q); o[4 * q] = v[0]; o[4 * q + 1] = v[1]; o[4 * q + 2] = v[2]; o[4 * q + 3] = v[3]; } }
__device__ __forceinline__ void phase_fin(const Frame& F, const Args& A) {
    const int gw = blockIdx.x * NWAVES + F.wave, NGW = F.G * NWAVES; const int c0 = 16 * F.lane;
    float kkw[16], kaw[16]; ld16f(A.in[I_KK] + c0, kkw); ld16f(A.in[I_KA] + c0, kaw);
    const bf16_t* Kp = (const bf16_t*)(F.ws + WS_RKV + 1 * ACTB);
    for (int n = gw; n < NTOK; n += NGW) { const size_t off = (size_t)n * D + c0; float k[16], i0[16], i1[16], kk[16], o[16];
        ld16bf(Kp + off, k); ld16bf((const bf16_t*)(F.ws + WS_ICL) + off, i0); ld16bf((const bf16_t*)(F.ws + WS_ICL + ACTB) + off, i1);
        float ss = 0.f;
#pragma unroll
        for (int j = 0; j < 16; ++j) { kk[j] = k[j] * kkw[j]; ss += kk[j] * kk[j]; }
        ss += __shfl_xor(ss, 1); ss += __shfl_xor(ss, 2);
        const float inv = 1.0f / fmaxf(sqrtf(ss), 1e-12f);
#pragma unroll
        for (int j = 0; j < 16; ++j) kk[j] *= inv;
        st16bf((bf16_t*)(F.ws + WS_KK) + off, kk);
#pragma unroll
        for (int j = 0; j < 16; ++j) o[j] = k[j] * (1.0f + (i0[j] - 1.0f) * kaw[j]);
        st16bf((bf16_t*)(F.ws + WS_KDIR) + off, o);
#pragma unroll
        for (int j = 0; j < 16; ++j) o[j] = k[j] * (1.0f + (i1[j] - 1.0f) * kaw[j]);
        st16bf((bf16_t*)(F.ws + WS_KDIR + ACTB) + off, o);
#pragma unroll
        for (int j = 0; j < 16; ++j) o[j] = kk[j] * i0[j];
        st16bf((bf16_t*)(F.ws + WS_BV) + off, o);
#pragma unroll
        for (int j = 0; j < 16; ++j) o[j] = kk[j] * i1[j];
        st16bf((bf16_t*)(F.ws + WS_BV + ACTB) + off, o);
    }
}
constexpr int CK = 32, SNS = CT + TSEQ, CNCH = SNS / CK;
constexpr int RS = 144, TS = 80;
constexpr int OS_A = 0, OS_R = 4608, OS_KT = 9216, OS_BT = 14336, OS_VT = 19456, OS_GAM = 20736, OS_BYTES = 20992;
constexpr int OG_B = 0, OG_K = 4608, OG_BYTES = 9216;
constexpr int GM_KA = 0, GM_KR = 2560, GM_BR = 5120, GM_TT = 7680, GM_BYTES = 10240;
constexpr int RAW_BYTES = 5 * 4096 + 1024;
constexpr int L_OS = 0, L_OG = 3 * OS_BYTES, L_GM = L_OG + 2 * OG_BYTES, L_TSCR = L_GM + 2 * GM_BYTES, L_SSCR = L_TSCR + 5120, L_RAW = L_SSCR + 4864, L_SCAN_END = L_RAW + 2 * RAW_BYTES;
static_assert(L_SCAN_END <= SCR_BYTES, "scan LDS");
__device__ __forceinline__ int scan_token(int sg, int d, int b) { if (sg < CT) { const int t = d ? (CT - 1 - sg) : sg; return NL + b * CT + t; } const int u = sg - CT; const int t = d ? (TSEQ - 1 - u) : u; return b * TSEQ + t; }
__device__ __forceinline__ unsigned short f2bf(float f) { return (unsigned short)(cvt_pk_bf16(f, 0.f) & 0xffffu); }
__device__ __forceinline__ int acc_row(int p, int lane) { return (p & 3) + 8 * (p >> 2) + 4 * (lane >> 5); }
__device__ __forceinline__ void st_acc32(LAS unsigned char* dst, const f32x16& a, int lane) {
#pragma unroll
    for (int p = 0; p < 16; ++p) *(LAS unsigned short*)(dst + acc_row(p, lane) * TS + 2 * (lane & 31)) = f2bf(a[p]);
}
__device__ __forceinline__ bf16x8 acc_bfrag(const f32x16& a, int s) { u32x4 w; w.x = cvt_pk_bf16(a[8 * s + 0], a[8 * s + 1]); w.y = cvt_pk_bf16(a[8 * s + 2], a[8 * s + 3]); w.z = cvt_pk_bf16(a[8 * s + 4], a[8 * s + 5]); w.w = cvt_pk_bf16(a[8 * s + 6], a[8 * s + 7]); return __builtin_bit_cast(bf16x8, w); }
__device__ __forceinline__ bf16x8 lds_afrag_perm(const LAS unsigned char* m, int s, int lane) { const LAS unsigned char* p = m + (lane & 31) * TS + 2 * (16 * s + 4 * (lane >> 5));
    const u32x2 lo = *(const LAS u32x2*)p, hi = *(const LAS u32x2*)(p + 16); u32x4 w; w.x = lo.x; w.y = lo.y; w.z = hi.x; w.w = hi.y; return __builtin_bit_cast(bf16x8, w); }
__device__ __forceinline__ f32x16 gram32(const LAS unsigned char* P, const LAS unsigned char* Q, int lane) {
    f32x16 c;
#pragma unroll
    for (int p = 0; p < 16; ++p) c[p] = 0.f;
#pragma unroll
    for (int s = 0; s < 4; ++s) { const bf16x8 a = *(const LAS bf16x8*)(P + (lane & 31) * RS + 32 * s + 16 * (lane >> 5)), b = *(const LAS bf16x8*)(Q + (lane & 31) * RS + 32 * s + 16 * (lane >> 5));
        c = __builtin_amdgcn_mfma_f32_32x32x16_bf16(a, b, c, 0, 0, 0); }
    return c;
}
__device__ __forceinline__ void phase_scan(const Frame& F, const Args& A) {
    LAS unsigned char* lds = F.scr;
    const int lane = F.lane, wave = F.wave;
    const __amdgpu_buffer_rsrc_t rsrc = __builtin_amdgcn_make_buffer_rsrc((void*)F.ws, 0, 0xffffffff, 0x00020000);
    for (int job = F.vcu; job < 256; job += F.G) {
        const int sd = job >> 2, rq = job & 3, d = sd & 1, bh = sd >> 1, b = bh >> 4, hd = bh & 15;
        f32x4 Xa[4];
#pragma unroll
        for (int t = 0; t < 4; ++t) Xa[t] = (f32x4){0.f, 0.f, 0.f, 0.f};
        const int pj = wave == 3 ? 0 : (wave == 4 ? 1 : (wave == 6 ? 2 : 3));
        const bool is_prep = wave == 3 || wave == 4 || wave == 6 || wave == 7;
#define SCAN_DMA(c) do { const int c_ = (c); LAS unsigned char* raw_ = lds + L_RAW + (c_ & 1) * RAW_BYTES; \
            _Pragma("unroll") for (int g = 0; g < 4; ++g) { const int row = 8 * g + (lane >> 3); const int sg = c_ * CK + row; const unsigned n = (unsigned)scan_token(sg, d, b); \
                const unsigned off = n * (unsigned)(D * 2) + (unsigned)(hd * 128 + (lane & 7) * 16); \
                __builtin_amdgcn_raw_ptr_buffer_load_lds(rsrc, (LAS void*)(raw_ + 0 * 4096 + g * 1024), 16, (int)(off + (unsigned)(WS_DEC + (size_t)d * ACTB)), 0, 0, 0); \
                __builtin_amdgcn_raw_ptr_buffer_load_lds(rsrc, (LAS void*)(raw_ + 1 * 4096 + g * 1024), 16, (int)(off + (unsigned)WS_KK), 0, 0, 0); \
                __builtin_amdgcn_raw_ptr_buffer_load_lds(rsrc, (LAS void*)(raw_ + 2 * 4096 + g * 1024), 16, (int)(off + (unsigned)(WS_BV + (size_t)d * ACTB)), 0, 0, 0); \
                __builtin_amdgcn_raw_ptr_buffer_load_lds(rsrc, (LAS void*)(raw_ + 3 * 4096 + g * 1024), 16, (int)(off + (unsigned)(WS_KDIR + (size_t)d * ACTB)), 0, 0, 0); \
                if (c_ >= CT / CK) __builtin_amdgcn_raw_ptr_buffer_load_lds(rsrc, (LAS void*)(raw_ + 4 * 4096 + g * 1024), 16, (int)(off + (unsigned)WS_RKV), 0, 0, 0); } \
            { const int row = lane >> 1; const unsigned n = (unsigned)scan_token(c_ * CK + row, d, b); \
              __builtin_amdgcn_raw_ptr_buffer_load_lds(rsrc, (LAS void*)(raw_ + 5 * 4096), 16, (int)(n * (unsigned)(D * 2) + (unsigned)(hd * 128 + rq * 32 + (lane & 1) * 16) + (unsigned)(WS_RKV + 2 * ACTB)), 0, 0, 0); } } while (0)
        __syncthreads();
        if (wave == 0) { for (int i = lane; i < 16 * RS / 4; i += 64) ((LAS unsigned*)(lds + L_SSCR))[i] = 0u; }
        if (wave == 5) { SCAN_DMA(0); SCAN_DMA(1); asm volatile("s_waitcnt vmcnt(0)" ::: "memory"); }
        __syncthreads();
        for (int it = -2; it < CNCH; ++it) {
            const int cs = it, cg = it + 1, cp = it + 2;
            if (is_prep) {
                if (cp < CNCH) {
                    const LAS unsigned char* raw = lds + L_RAW + (cp & 1) * RAW_BYTES;
                    LAS unsigned char* os = lds + L_OS + (cp % 3) * OS_BYTES; LAS unsigned char* og = lds + L_OG + (cp & 1) * OG_BYTES;
                    float Lpre = 0.f, Ltot = 0.f, lwv[8];
#pragma unroll
                    for (int m = 0; m < 32; ++m) { const float x = bf2f(*(const LAS unsigned short*)(raw + m * 128 + 2 * lane)); Ltot += x; if (m < 8 * pj) Lpre += x; if (m >= 8 * pj && m < 8 * pj + 8) lwv[m & 7] = x; }
                    const float gam = __expf(Ltot);
                    if (pj == 0) *(LAS float*)(os + OS_GAM + 4 * lane) = gam;
                    float Lr = Lpre, ep_prev = __expf(Lpre); float kt[8], bt[8]; const bool has_r = cp >= CT / CK;
#pragma unroll
                    for (int j = 0; j < 8; ++j) { const int m = 8 * pj + j; Lr += lwv[j];
                        const float ep = __expf(Lr), em = __builtin_amdgcn_rcpf(ep);
                        const float kk = bf2f(*(const LAS unsigned short*)(raw + 4096 + m * 128 + 2 * lane)), bb = bf2f(*(const LAS unsigned short*)(raw + 8192 + m * 128 + 2 * lane)),
                                    kd = bf2f(*(const LAS unsigned short*)(raw + 12288 + m * 128 + 2 * lane)), r = has_r ? bf2f(*(const LAS unsigned short*)(raw + 16384 + m * 128 + 2 * lane)) : 0.f;
                        const f32x2 ar = (f32x2){kk, r} * (f32x2){ep_prev, ep}, bk = (f32x2){bb, kd} * em, tb = (f32x2){bk[1], bk[0]} * (f32x2){gam, -gam};
                        const unsigned w1 = cvt_pk_bf16(ar[0], ar[1]), w2 = cvt_pk_bf16(bk[0], bk[1]);
                        *(LAS unsigned short*)(os + OS_A + m * RS + 2 * lane) = (unsigned short)(w1 & 0xffffu);
                        *(LAS unsigned short*)(os + OS_R + m * RS + 2 * lane) = (unsigned short)(w1 >> 16);
                        *(LAS unsigned short*)(og + OG_B + m * RS + 2 * lane) = (unsigned short)(w2 & 0xffffu);
                        *(LAS unsigned short*)(og + OG_K + m * RS + 2 * lane) = (unsigned short)(w2 >> 16);
                        kt[j] = tb[0]; bt[j] = tb[1]; ep_prev = ep; }
#pragma unroll
                    for (int g = 0; g < 2; ++g) { u32x2 w; w.x = cvt_pk_bf16(kt[4 * g], kt[4 * g + 1]); w.y = cvt_pk_bf16(kt[4 * g + 2], kt[4 * g + 3]);
                        *(LAS u32x2*)(os + OS_KT + lane * TS + 2 * (8 * pj + 4 * g)) = w;
                        w.x = cvt_pk_bf16(bt[4 * g], bt[4 * g + 1]); w.y = cvt_pk_bf16(bt[4 * g + 2], bt[4 * g + 3]);
                        *(LAS u32x2*)(os + OS_BT + lane * TS + 2 * (8 * pj + 4 * g)) = w; }
                }
            } else if (wave == 5) {
                if (cp + 1 < CNCH && it >= -1) SCAN_DMA(cp + 1);
                if (cp < CNCH) { const LAS unsigned char* raw = lds + L_RAW + (cp & 1) * RAW_BYTES; LAS unsigned char* os = lds + L_OS + (cp % 3) * OS_BYTES;
                    unsigned short rv[8];
#pragma unroll
                    for (int j = 0; j < 8; ++j) rv[j] = *(const LAS unsigned short*)(raw + 5 * 4096 + (8 * (lane >> 4) + j) * 32 + 2 * (lane & 15));
                    u32x4 w; w.x = (unsigned)rv[0] | ((unsigned)rv[1] << 16); w.y = (unsigned)rv[2] | ((unsigned)rv[3] << 16); w.z = (unsigned)rv[4] | ((unsigned)rv[5] << 16); w.w = (unsigned)rv[6] | ((unsigned)rv[7] << 16);
                    *(LAS u32x4*)(os + OS_VT + (lane & 15) * TS + 16 * (lane >> 4)) = w; }
                asm volatile("s_waitcnt vmcnt(0)" ::: "memory");
            } else if (wave == 2) {
                if (cg >= 0 && cg < CNCH) {
                    const LAS unsigned char* os = lds + L_OS + (cg % 3) * OS_BYTES; const LAS unsigned char* og = lds + L_OG + (cg & 1) * OG_BYTES; LAS unsigned char* gm = lds + L_GM + (cg & 1) * GM_BYTES;
                    f32x16 c = gram32(os + OS_A, og + OG_K, lane);
#pragma unroll
                    for (int p = 0; p < 16; ++p) c[p] = (lane & 31) < acc_row(p, lane) ? c[p] : 0.f;
                    st_acc32(gm + GM_KA, c, lane);
                    c = gram32(os + OS_R, og + OG_K, lane);
#pragma unroll
                    for (int p = 0; p < 16; ++p) c[p] = (lane & 31) <= acc_row(p, lane) ? c[p] : 0.f;
                    st_acc32(gm + GM_KR, c, lane);
                    c = gram32(os + OS_R, og + OG_B, lane);
#pragma unroll
                    for (int p = 0; p < 16; ++p) c[p] = (lane & 31) <= acc_row(p, lane) ? -c[p] : 0.f;
                    st_acc32(gm + GM_BR, c, lane);
                }
            } else if (wave == 1) {
                if (cg >= 0 && cg < CNCH) {
                    const LAS unsigned char* os = lds + L_OS + (cg % 3) * OS_BYTES; const LAS unsigned char* og = lds + L_OG + (cg & 1) * OG_BYTES; LAS unsigned char* gm = lds + L_GM + (cg & 1) * GM_BYTES;
                    f32x16 X = gram32(os + OS_A, og + OG_B, lane), Xt = gram32(og + OG_B, os + OS_A, lane), Rm;
#pragma unroll
                    for (int p = 0; p < 16; ++p) { const int row = acc_row(p, lane), col = lane & 31; X[p] = col < row ? -X[p] : 0.f; Xt[p] = row < col ? -Xt[p] : 0.f; Rm[p] = X[p] + (col == row ? 1.f : 0.f); }
#pragma unroll
                    for (int lev = 0; lev < 5; ++lev) {
                        const bf16x8 xt0 = acc_bfrag(Xt, 0), xt1 = acc_bfrag(Xt, 1);
                        if (lev >= 1) { const bf16x8 r0 = acc_bfrag(Rm, 0), r1 = acc_bfrag(Rm, 1);
                            Rm = __builtin_amdgcn_mfma_f32_32x32x16_bf16(xt0, r0, Rm, 0, 0, 0); Rm = __builtin_amdgcn_mfma_f32_32x32x16_bf16(xt1, r1, Rm, 0, 0, 0); }
                        if (lev < 4) { const bf16x8 x0 = acc_bfrag(X, 0), x1 = acc_bfrag(X, 1); f32x16 z, zt;
#pragma unroll
                            for (int p = 0; p < 16; ++p) { z[p] = 0.f; zt[p] = 0.f; }
                            z = __builtin_amdgcn_mfma_f32_32x32x16_bf16(xt0, x0, z, 0, 0, 0); zt = __builtin_amdgcn_mfma_f32_32x32x16_bf16(x0, xt0, zt, 0, 0, 0);
                            z = __builtin_amdgcn_mfma_f32_32x32x16_bf16(xt1, x1, z, 0, 0, 0); zt = __builtin_amdgcn_mfma_f32_32x32x16_bf16(x1, xt1, zt, 0, 0, 0);
                            X = z; Xt = zt; }
                    }
                    st_acc32(gm + GM_TT, Rm, lane);
                }
            } else {
                if (cs >= 0) {
                    const LAS unsigned char* os = lds + L_OS + (cs % 3) * OS_BYTES; const LAS unsigned char* gm = lds + L_GM + (cs & 1) * GM_BYTES;
                    LAS unsigned char* Xb = lds + L_SSCR; LAS unsigned char* Hb = lds + L_SSCR + 2304; LAS unsigned char* Ub = lds + L_SSCR + 2304 + 1280;
                    const int r16 = lane & 15, q = lane >> 4;
                    const bf16x8 xa0 = *(const LAS bf16x8*)(Xb + r16 * RS + 16 * q), xa1 = *(const LAS bf16x8*)(Xb + r16 * RS + 64 + 16 * q), va = *(const LAS bf16x8*)(os + OS_VT + r16 * TS + 16 * q);
                    f32x4 h[2];
#pragma unroll
                    for (int ti = 0; ti < 2; ++ti) { const int i = 16 * ti + r16; f32x4 c = {0.f, 0.f, 0.f, 0.f};
                        c = __builtin_amdgcn_mfma_f32_16x16x32_bf16(xa0, *(const LAS bf16x8*)(os + OS_A + i * RS + 16 * q), c, 0, 0, 0);
                        c = __builtin_amdgcn_mfma_f32_16x16x32_bf16(xa1, *(const LAS bf16x8*)(os + OS_A + i * RS + 64 + 16 * q), c, 0, 0, 0);
                        c = __builtin_amdgcn_mfma_f32_16x16x32_bf16(va, *(const LAS bf16x8*)(gm + GM_KA + i * TS + 16 * q), c, 0, 0, 0);
                        h[ti] = c; }
#pragma unroll
                    for (int ti = 0; ti < 2; ++ti)
#pragma unroll
                        for (int j = 0; j < 4; ++j) *(LAS unsigned short*)(Hb + (4 * q + j) * TS + 2 * (16 * ti + r16)) = f2bf(h[ti][j]);
                    LDS_WAIT();
                    const bf16x8 ha = *(const LAS bf16x8*)(Hb + r16 * TS + 16 * q);
                    f32x4 u[2];
#pragma unroll
                    for (int ti = 0; ti < 2; ++ti) { const int i = 16 * ti + r16; f32x4 c = {0.f, 0.f, 0.f, 0.f};
                        u[ti] = __builtin_amdgcn_mfma_f32_16x16x32_bf16(ha, *(const LAS bf16x8*)(gm + GM_TT + i * TS + 16 * q), c, 0, 0, 0); }
#pragma unroll
                    for (int ti = 0; ti < 2; ++ti)
#pragma unroll
                        for (int j = 0; j < 4; ++j) *(LAS unsigned short*)(Ub + (4 * q + j) * TS + 2 * (16 * ti + r16)) = f2bf(u[ti][j]);
                    LDS_WAIT();
                    const bf16x8 ua = *(const LAS bf16x8*)(Ub + r16 * TS + 16 * q);
#pragma unroll
                    for (int t = 0; t < 4; ++t) { const int k = 16 * t + r16; const float g = *(const LAS float*)(os + OS_GAM + 4 * k); f32x4 c = Xa[t] * g;
                        c = __builtin_amdgcn_mfma_f32_16x16x32_bf16(va, *(const LAS bf16x8*)(os + OS_KT + k * TS + 16 * q), c, 0, 0, 0);
                        c = __builtin_amdgcn_mfma_f32_16x16x32_bf16(ua, *(const LAS bf16x8*)(os + OS_BT + k * TS + 16 * q), c, 0, 0, 0);
                        Xa[t] = c; }
                    if (cs >= CT / CK) {
#pragma unroll
                        for (int ti = 0; ti < 2; ++ti) { const int i = 16 * ti + r16; f32x4 c = {0.f, 0.f, 0.f, 0.f};
                            c = __builtin_amdgcn_mfma_f32_16x16x32_bf16(xa0, *(const LAS bf16x8*)(os + OS_R + i * RS + 16 * q), c, 0, 0, 0);
                            c = __builtin_amdgcn_mfma_f32_16x16x32_bf16(xa1, *(const LAS bf16x8*)(os + OS_R + i * RS + 64 + 16 * q), c, 0, 0, 0);
                            c = __builtin_amdgcn_mfma_f32_16x16x32_bf16(va, *(const LAS bf16x8*)(gm + GM_KR + i * TS + 16 * q), c, 0, 0, 0);
                            c = __builtin_amdgcn_mfma_f32_16x16x32_bf16(ua, *(const LAS bf16x8*)(gm + GM_BR + i * TS + 16 * q), c, 0, 0, 0);
                            const int n = scan_token(cs * CK + i, d, b);
                            u32x2 w; w.x = cvt_pk_bf16(c[0], c[1]); w.y = cvt_pk_bf16(c[2], c[3]);
                            *(GAS u32x2*)((bf16_t*)(F.ws + WS_YD + (size_t)d * NL * D * 2) + (size_t)n * D + hd * 64 + rq * 16 + 4 * q) = w; }
                    }
#pragma unroll
                    for (int t = 0; t < 4; ++t)
#pragma unroll
                        for (int j = 0; j < 4; ++j) *(LAS unsigned short*)(Xb + (4 * q + j) * RS + 2 * (16 * t + r16)) = f2bf(Xa[t][j]);
                }
            }
            __syncthreads();
        }
#undef SCAN_DMA
    }
}
__device__ __forceinline__ void phase_readout(const Frame& F, const Args& A) {
    const int gw = blockIdx.x * NWAVES + F.wave, NGW = F.G * NWAVES; const int c0 = 16 * F.lane;
    float lng[16], lnb[16], rk[16]; ld16f(A.in[I_LNG] + c0, lng); ld16f(A.in[I_LNB] + c0, lnb); ld16f(A.in[I_RK] + c0, rk);
    for (int n = gw; n < NL; n += NGW) { const size_t off = (size_t)n * D + c0; float y[16], t[16], r[16], kd[16], v[16], g[16], o[16];
        ld16bf((const bf16_t*)(F.ws + WS_YD) + off, y); ld16bf((const bf16_t*)(F.ws + WS_YD + (size_t)NL * D * 2) + off, t);
        float s = 0.f;
#pragma unroll
        for (int j = 0; j < 16; ++j) { y[j] += t[j]; s += y[j]; }
        s += __shfl_xor(s, 1); s += __shfl_xor(s, 2); const float m = s * (1.0f / 64.0f); float q = 0.f;
#pragma unroll
        for (int j = 0; j < 16; ++j) { y[j] -= m; q += y[j] * y[j]; }
        q += __shfl_xor(q, 1); q += __shfl_xor(q, 2); const float rs = 1.0f / sqrtf(q * (1.0f / 64.0f) + GN_EPS);
        ld16bf((const bf16_t*)(F.ws + WS_RKV) + off, r); ld16bf((const bf16_t*)(F.ws + WS_KDIR) + off, kd); ld16bf((const bf16_t*)(F.ws + WS_KDIR + ACTB) + off, t);
        float bs = 0.f;
#pragma unroll
        for (int j = 0; j < 16; ++j) bs += r[j] * (kd[j] + t[j]) * rk[j];
        bs += __shfl_xor(bs, 1); bs += __shfl_xor(bs, 2);
        ld16bf((const bf16_t*)(F.ws + WS_RKV + 2 * ACTB) + off, v); ld16bf((const bf16_t*)(F.ws + WS_G) + off, g);
#pragma unroll
        for (int j = 0; j < 16; ++j) o[j] = (y[j] * rs * lng[j] + lnb[j] + bs * v[j]) * g[j];
        st16bf((bf16_t*)(F.ws + WS_RO) + off, o);
    }
}
struct SchedWo {
    static constexpr bool SIDE = false; static constexpr bool XSYNC = false; static constexpr bool GATHER = false;
    int G, vcu; int nt; unsigned ldb;
    __device__ __forceinline__ bool next(int i, GU& u) const { const int L = i * G + vcu; if (L >= 512) return false; const int pm = L >> 2, pn = L & 3;
        u.a = (unsigned)(WS_RO + (size_t)pm * 256 * D * 2); u.b = (unsigned)(WS_WO + (size_t)pn * 256 * 1024 * 2); u.i0 = pm; u.i1 = pn; u.i2 = 0; u.i3 = 0; return true; }
    __device__ __forceinline__ void aoff(const GU&, const int (&R)[2], const int (&C)[2], unsigned (&v)[2][2]) const {
#pragma unroll
        for (int h = 0; h < 2; ++h)
#pragma unroll
            for (int i = 0; i < 2; ++i) v[h][i] = (unsigned)((h * 128 + R[i]) * D + C[i]) * 2u; }
};
struct EpiWo {
    static constexpr bool FP8 = false; static constexpr bool PERM = false;
    const float* xin; float* xout; const float* gate_base;
    __device__ __forceinline__ void operator()(const f32x4 (&acc)[2][2][4][2], const GU& u, int wr, int wc, int fr, int fq, const LAS float* sb) const {
        const int pm = u.i0, pn = u.i1; const float* gate = gate_base + (size_t)(pm >> 6) * NMOD * D; const int col0 = pn * 256 + wc * 32 + 4 * fq;
        f32x4 gl[2][2];
#pragma unroll
        for (int bj = 0; bj < 2; ++bj)
#pragma unroll
            for (int n = 0; n < 2; ++n) gl[bj][n] = *(const GAS f32x4*)(gate + col0 + bj * 128 + n * 16);
#pragma unroll
        for (int ai = 0; ai < 2; ++ai)
#pragma unroll
            for (int m = 0; m < 4; ++m) { const size_t off = ((size_t)pm * 256 + ai * 128 + wr * 64 + m * 16 + fr) * D + col0;
#pragma unroll
                for (int bj = 0; bj < 2; ++bj)
#pragma unroll
                    for (int n = 0; n < 2; ++n) *(GAS f32x4*)(xout + off + bj * 128 + n * 16) = *(const GAS f32x4*)(xin + off + bj * 128 + n * 16) + gl[bj][n] * acc[ai][bj][m][n]; }
    }
};

constexpr int NPHASES = 3;
__global__ void __launch_bounds__(NTHREADS, 2) fwd_kernel(Args args) {
    extern __shared__ __attribute__((aligned(16))) unsigned char lds_raw[];
    Frame F;
    F.lds = (LAS unsigned char*)lds_raw; F.scr = F.lds + SCR_OFF; F.ws = args.ws;
    F.tid = threadIdx.x; F.lane = F.tid & 63; F.wave = __builtin_amdgcn_readfirstlane(F.tid >> 6);
    F.G = gridDim.x; { const int bx = blockIdx.x; F.vcu = (F.G % 8 == 0) ? (bx % 8) * (F.G / 8) + bx / 8 : bx; }
    volatile LAS unsigned* MISC = (volatile LAS unsigned*)(F.lds + MISC_OFF);
    if (F.tid < 64) MISC[F.tid] = 0u;
    __syncthreads();
    const int lo = args.ph_lo, hi = args.ph_hi;
    XcdBarrier bar; bar.bar = (unsigned*)(F.ws + WS_CTL); bar.x = 0; bar.st = MISC + 8;
    if (hi - lo > 1) {
        unsigned* barw = (unsigned*)(F.ws + WS_CTL);
        bar.bar = barw; bar.x = xb_xcc_id(); bar.st = MISC + 8;
        if (F.tid == 0) {
            const unsigned rank = xb_add(&barw[XB_XCNT(bar.x)], 1u);
            unsigned nloc, nx; xcd_barrier_complete(barw, bar.x, nloc, nx); MISC[8] = nloc; MISC[9] = nx;
            unsigned pre = 0;
            for (unsigned j = 0; j < 16; ++j) { const unsigned c = xb_ld(&barw[XB_XCNT(j)]); if (j < bar.x) pre += c; }
            MISC[10] = pre + rank;
        }
        __syncthreads();
        F.vcu = (int)MISC[10];
    }
#define IN(k) (lo <= (k) && (k) < hi)
#define SEAM(k) do { if (IN(k) && IN((k) + 1)) xcd_barrier(bar); } while (0)
#define PH(k, ...) do { if (IN(k)) { __VA_ARGS__; if constexpr (((REPEAT_MASK >> (k)) & 1) != 0) { xcd_barrier(bar); __VA_ARGS__; } } SEAM(k); } while (0)
    PH(0, phase_prep(F, args));
    PH(1, phase_pre0(F, args));
    PH(2, { SchedPool S{F.G, F.vcu, 4, 512u};
            EpiPool E{args.in[I_X], args.in[I_CTX], args.in[I_POOLLS], modp(F, 0, 0, 2), (float*)(F.ws + WS_XS0)};
            pg8::gemm_phase<EpiPool, SchedPool>(F.scr, F.ws, S, E); });
    PH(3, phase_post(F, args, 0, (const float*)(F.ws + WS_XS0), NTOK));
    PH(4, phase_moe1(F, args, 0));
    PH(5, phase_moe2(F, args, 0));
    PH(6, phase_pre1(F, args));
    PH(7, { SchedProj S{F.G, F.vcu, 16, 2048u}; EpiProj E{F.ws}; pg8::gemm_phase<EpiProj, SchedProj>(F.scr, F.ws, S, E); });
    PH(8, { SchedLora2 S{F.G, F.vcu, 2, 256u}; EpiLora2 E{F.ws, args.in[I_W0], args.in[I_A0]}; pg8::gemm_phase<EpiLora2, SchedLora2>(F.scr, F.ws, S, E); });
    PH(9, phase_fin(F, args));
    PH(10, phase_scan(F, args));
    PH(11, phase_readout(F, args));
    PH(12, { SchedWo S{F.G, F.vcu, 16, 2048u}; EpiWo E{(const float*)(F.ws + WS_XS1), (float*)(F.ws + WS_XS0), modp(F, 1, 0, 2)}; pg8::gemm_phase<EpiWo, SchedWo>(F.scr, F.ws, S, E); });
    PH(13, phase_post(F, args, 1, (const float*)(F.ws + WS_XS0), NL));
    PH(14, phase_moe1(F, args, 1));
    PH(15, phase_moe2(F, args, 1));
    PH(16, phase_final(F, args, 1, (const float*)(F.ws + WS_XS0)));
#undef PH
#undef SEAM
#undef IN
}

extern "C" void kernel_launch(void* const* d_in, const int* in_sizes, int n_in, void* d_out, int out_size, void* d_ws, size_t ws_size, hipStream_t stream) {
    static int grid = 0;
    if (grid == 0) {
        if (n_in != 32 || ws_size < WS_END) { fprintf(stderr, "kernel_launch: unexpected n_in %d / ws %zu (need %zu)\n", n_in, ws_size, (size_t)WS_END); grid = -1; return; }
        int dev = 0, cus = 0;
        if (hipGetDevice(&dev) != hipSuccess || hipDeviceGetAttribute(&cus, hipDeviceAttributeMultiprocessorCount, dev) != hipSuccess) { grid = -1; return; }
        if (hipFuncSetAttribute((const void*)fwd_kernel, hipFuncAttributeMaxDynamicSharedMemorySize, LDS_BYTES) != hipSuccess) { fprintf(stderr, "kernel_launch: hipFuncSetAttribute failed\n"); grid = -1; return; }
        (void)hipGetLastError();
        grid = cus;
    }
    if (grid < 0) return;
    (void)hipMemsetAsync((char*)d_ws + WS_CTL, 0, CTL_BYTES, stream);
    Args a{};
    for (int i = 0; i < 32; ++i) a.in[i] = (const float*)d_in[i];
    a.out = (float*)d_out; a.ws = (unsigned char*)d_ws;
    const int last = 16;
#if N_LAUNCH_MODE == 1
    a.ph_lo = 0; a.ph_hi = last + 1;
    hipLaunchKernelGGL(fwd_kernel, dim3(grid), dim3(NTHREADS), LDS_BYTES, stream, a);
#else
    for (int p = 0; p <= last; ++p) { a.ph_lo = p; a.ph_hi = p + 1; hipLaunchKernelGGL(fwd_kernel, dim3(grid), dim3(NTHREADS), LDS_BYTES, stream, a); }
#endif
}
```

```cpp
#include <hip/hip_runtime.h>
#include <cstdio>
#include <cstdint>

#define LAS __attribute__((address_space(3)))
#define GAS __attribute__((address_space(1)))
typedef unsigned short bf16_t;
typedef short bf16x8 __attribute__((ext_vector_type(8)));
typedef float f32x4 __attribute__((ext_vector_type(4)));
typedef float f32x2 __attribute__((ext_vector_type(2)));
typedef float f32x16 __attribute__((ext_vector_type(16)));
typedef unsigned u32x4 __attribute__((ext_vector_type(4)));
typedef unsigned u32x2 __attribute__((ext_vector_type(2)));

#ifndef N_LAUNCH_MODE
#define N_LAUNCH_MODE 1
#endif
#ifndef REPEAT_MASK
#define REPEAT_MASK 0
#endif

constexpr int D = 1024, NB = 2, TSEQ = 16384, CT = 256, NL = NB * TSEQ, NC = NB * CT, NTOK = NL + NC;
constexpr int NE = 32, TOPK = 4, NMOD = 6;
constexpr int NWAVES = 8, NTHREADS = 512;
constexpr int MAXSLOT = ((NTOK * TOPK + 255) / 256 + NE) * 256;
constexpr float NORM_EPS = 1e-6f, GN_EPS = 64e-5f;

constexpr size_t AL(size_t x) { return (x + 255) & ~(size_t)255; }
constexpr size_t WS_CTL = 0, CTL_BYTES = 65536;
constexpr size_t CTL_XSYNC = 32768;
constexpr size_t CTL_CNT = 16384;
constexpr size_t WS_MOD = WS_CTL + CTL_BYTES;
constexpr size_t WS_LIST = AL(WS_MOD + 2 * 3 * 6144 * 4);
constexpr size_t WS_TINFO = AL(WS_LIST + (size_t)2 * NE * NTOK * 4);
constexpr size_t WS_TGATE = AL(WS_TINFO + (size_t)2 * NTOK * 4 * 4);
constexpr size_t WS_WGU = AL(WS_TGATE + (size_t)2 * NTOK * 4 * 4);
constexpr size_t WS_WDN = AL(WS_WGU + (size_t)2 * NE * 2048 * 1024 * 2);
constexpr size_t WS_WRKV = AL(WS_WDN + (size_t)2 * NE * 1024 * 1024 * 2);
constexpr size_t WS_WO = AL(WS_WRKV + (size_t)3 * 1024 * 1024 * 2);
constexpr size_t WS_WL1 = AL(WS_WO + (size_t)1024 * 1024 * 2);
constexpr size_t WS_WL2 = AL(WS_WL1 + (size_t)3 * 256 * 1024 * 2);
constexpr size_t WS_WPOOL = AL(WS_WL2 + (size_t)5 * 1024 * 128 * 2);
constexpr size_t WS_XS0 = AL(WS_WPOOL + (size_t)4 * 256 * 256 * 2);
constexpr size_t WS_XS1 = AL(WS_XS0 + (size_t)NTOK * D * 4);
constexpr size_t WS_T = AL(WS_XS1 + (size_t)NTOK * D * 4);
constexpr size_t ACTB = (size_t)NTOK * D * 2;
constexpr size_t TA = WS_T;
constexpr size_t TA_BYTES = (size_t)432 << 20;
constexpr size_t WS_DBUF = TA, WS_H2 = TA + ACTB, WS_ACT = TA + 2 * ACTB;
constexpr size_t WS_MIX = TA;
constexpr size_t WS_KDIR = TA, WS_BV = TA + 2 * ACTB, WS_KK = TA + 4 * ACTB;
constexpr size_t TB = TA + TA_BYTES;
constexpr size_t TB_BYTES = (size_t)290 << 20;
constexpr size_t WS_Y2 = TB, WS_RKV = TB;
constexpr size_t TC = TB + TB_BYTES;
constexpr size_t WS_DEC = TC, WS_RO = TC;
constexpr size_t TD = AL(TC + (size_t)2 * NTOK * D * 4);
constexpr size_t WS_ICL = TD, WS_YD = TD;
constexpr size_t TE = AL(TD + 2 * ACTB);
constexpr size_t WS_G = TE;
constexpr size_t TF = AL(TE + ACTB);
constexpr size_t WS_LACT = TF;
constexpr size_t WS_END = AL(TF + (size_t)3 * NTOK * 128 * 2);
static_assert(WS_ACT + (size_t)MAXSLOT * D * 2 <= TA + TA_BYTES, "ACT overflows TA");
static_assert((size_t)MAXSLOT * D * 2 <= TB_BYTES, "Y2 overflows TB");
static_assert(WS_END <= ((size_t)2048 << 20), "workspace too large");

constexpr int MISC_OFF = 0, SCR_OFF = 1024, SCR_BYTES = 162816, LDS_BYTES = SCR_OFF + SCR_BYTES;

typedef __bf16 bf16x2_t __attribute__((ext_vector_type(2)));
__device__ __forceinline__ unsigned cvt_pk_bf16(float lo, float hi) { const f32x2 v = {lo, hi}; return __builtin_bit_cast(unsigned, __builtin_convertvector(v, bf16x2_t)); }
__device__ __forceinline__ float bf_lo(unsigned w) { return __uint_as_float(w << 16); }
__device__ __forceinline__ float bf_hi(unsigned w) { return __uint_as_float(w & 0xffff0000u); }
__device__ __forceinline__ float bf2f(bf16_t b) { return __uint_as_float(((unsigned)b) << 16); }
__device__ __forceinline__ float wave_sum(float v) {
#pragma unroll
    for (int o = 1; o < 64; o <<= 1) v += __shfl_xor(v, o);
    return v;
}
__device__ __forceinline__ float sigmoidf_(float x) { return 1.0f / (1.0f + __expf(-x)); }
#define LDS_WAIT() asm volatile("s_waitcnt lgkmcnt(0)" ::: "memory")
#define VM_WAIT() asm volatile("s_waitcnt vmcnt(0)" ::: "memory")

#define XB_TMO      128
#define XB_XCNT(j)  (256  + 64 * (j))
#define XB_XSUB(j)  (1280 + 64 * (j))
#define XB_XGEN(j)  (2304 + 64 * (j))
#define XB_TOP      3328
#define XB_TOPGEN   3392
#define XCD_BAR_WORDS 3456
#define XB_SPIN_CAP (1u << 22)
__device__ __forceinline__ unsigned xb_ld(unsigned* p)              { return __hip_atomic_load(p, __ATOMIC_RELAXED, __HIP_MEMORY_SCOPE_AGENT); }
__device__ __forceinline__ unsigned xb_add(unsigned* p, unsigned v) { return __hip_atomic_fetch_add(p, v, __ATOMIC_RELAXED, __HIP_MEMORY_SCOPE_AGENT); }
__device__ __forceinline__ unsigned xb_xcc_id() { return (unsigned)__builtin_amdgcn_s_getreg((3 << 11) | 20) & 0xFu; }
#define XB_SPIN(cond, bar) do { unsigned _sp = 0; while (cond) { __builtin_amdgcn_s_sleep(1); \
    if ((++_sp & 255u) == 0u) { if (xb_ld(&(bar)[XB_TMO])) break; if (_sp > XB_SPIN_CAP) { atomicAdd(&(bar)[XB_TMO], 1u); break; } } } } while (0)
struct XcdBarrier { unsigned* bar; unsigned x; volatile LAS unsigned* st; };
__device__ __forceinline__ XcdBarrier xcd_barrier_post(unsigned* bar, volatile LAS unsigned* st) {
    XcdBarrier b; b.bar = bar; b.x = xb_xcc_id(); b.st = st;
    if (threadIdx.x == 0) (void)xb_add(&bar[XB_XCNT(b.x)], 1u);
    return b;
}
__device__ __forceinline__ void xcd_barrier_complete(unsigned* bar, unsigned x, unsigned& nloc, unsigned& nx) {
    const unsigned G = gridDim.x * gridDim.y * gridDim.z;
    unsigned sum, cnt, mine, sp = 0u;
    for (;;) {
        sum = 0u; cnt = 0u; mine = 0u;
#pragma unroll
        for (unsigned j = 0; j < 16; ++j) { const unsigned c = xb_ld(&bar[XB_XCNT(j)]); sum += c; cnt += (c > 0u) ? 1u : 0u; mine = (j == x) ? c : mine; }
        if (sum == G) break;
        __builtin_amdgcn_s_sleep(1);
        if ((++sp & 255u) == 0u) { if (xb_ld(&bar[XB_TMO])) break; if (sp > XB_SPIN_CAP) { atomicAdd(&bar[XB_TMO], 1u); break; } }
    }
    nloc = mine > 0u ? mine : 1u; nx = cnt > 0u ? cnt : 1u;
}
__device__ __forceinline__ void xcd_barrier(const XcdBarrier& b) {
    asm volatile("s_waitcnt vmcnt(0)" ::: "memory");
    __syncthreads();
    if (threadIdx.x == 0) {
        unsigned* bar = b.bar;
        __builtin_amdgcn_s_waitcnt(0);
        unsigned nloc = b.st[0], nx = b.st[1];
        if (nloc == 0u) { xcd_barrier_complete(bar, b.x, nloc, nx); b.st[0] = nloc; b.st[1] = nx; }
        const unsigned old = xb_add(&bar[XB_XSUB(b.x)], 1u);
        const unsigned gen = old / nloc;
        if (old + 1u == (gen + 1u) * nloc) {
            __builtin_amdgcn_fence(__ATOMIC_RELEASE, "agent");
            asm volatile("s_waitcnt vmcnt(0)" ::: "memory");
            const unsigned og = xb_add(&bar[XB_TOP], 1u);
            const unsigned tg = og / nx;
            if (og + 1u == (tg + 1u) * nx) xb_add(&bar[XB_TOPGEN], 1u);
            else XB_SPIN(xb_ld(&bar[XB_TOPGEN]) == tg, bar);
            __builtin_amdgcn_fence(__ATOMIC_ACQUIRE, "agent");
            xb_add(&bar[XB_XGEN(b.x)], 1u);
            asm volatile("s_waitcnt vmcnt(0)" ::: "memory");
        } else {
            XB_SPIN(xb_ld(&bar[XB_XGEN(b.x)]) == gen, bar);
            __builtin_amdgcn_fence(__ATOMIC_ACQUIRE, "agent");
            asm volatile("s_waitcnt vmcnt(0)" ::: "memory");
        }
    }
    __syncthreads();
}

namespace pg8 {
constexpr int BM = 256, BK = 64, HALF = 128, HTB = HALF * BK * 2, STAGE_BYTES = 8 * HTB;
__host__ __device__ __forceinline__ int lds_byte(int r, int c) { const int st = (r >> 4) * 2 + (c >> 5), rr = r & 15, cc = c & 31, ob = rr * 64 + cc * 2; return st * 1024 + (ob ^ (((ob >> 9) & 1) << 5)); }
__host__ __device__ __forceinline__ void stage_rc(int b, int& R, int& C) { const int st = b / 1024, sb = b % 1024, swz = sb ^ (((sb >> 9) & 1) << 5); R = (st >> 1) * 16 + swz / 64; C = (st & 1) * 32 + (swz % 64) / 2; }
__host__ __device__ __forceinline__ int perm32(int rho) { const int n = rho >> 4, i = rho & 15; return 8 * (i >> 2) + 4 * n + (i & 3); }

struct GU { unsigned a, b; int i0, i1, i2, i3; };
typedef int v8i __attribute__((ext_vector_type(8)));
typedef int v4i __attribute__((ext_vector_type(4)));
__device__ __forceinline__ bf16x8 half8(v8i v, int h) { const v4i a = h ? __builtin_shufflevector(v, v, 4, 5, 6, 7) : __builtin_shufflevector(v, v, 0, 1, 2, 3); return __builtin_bit_cast(bf16x8, a); }
__device__ __forceinline__ v8i cat8(bf16x8 lo, bf16x8 hi) { const v4i a = __builtin_bit_cast(v4i, lo), b = __builtin_bit_cast(v4i, hi); return __builtin_shufflevector(a, b, 0, 1, 2, 3, 4, 5, 6, 7); }

template <class Epi, class Sched>
__device__ __forceinline__ void gemm_phase(LAS unsigned char* lds, unsigned char* wsbase, const Sched& S, const Epi& E) {
    const int tid = threadIdx.x, wid = __builtin_amdgcn_readfirstlane(tid >> 6), lane = tid & 63, wr = wid >> 2, wc = wid & 3, fr = lane & 15, fq = lane >> 4;
    const int nt = S.nt;
    const __amdgpu_buffer_rsrc_t rsrc = __builtin_amdgcn_make_buffer_rsrc((void*)wsbase, 0, 0xffffffff, 0x00020000);
    constexpr int SIDE_OFF = STAGE_BYTES;
#define PG8_SIDE(u, buf) do { if constexpr (Sched::SIDE) { unsigned so_; const bool isb_ = S.side_src((u), tid, so_); (void)isb_; \
        if (wid < 4) __builtin_amdgcn_raw_ptr_buffer_load_lds(rsrc, (LAS void*)(lds + SIDE_OFF + (buf) * 2048 + wid * 256), 4, (int)so_, 0, 0, 0); \
        else __builtin_amdgcn_raw_ptr_buffer_load_lds(S.rsrcb, (LAS void*)(lds + SIDE_OFF + (buf) * 2048 + wid * 256), 4, (int)so_, 0, 0, 0); } } while (0)
    int Rr[2], Cc[2]; unsigned voffB[2];
#pragma unroll
    for (int i = 0; i < 2; ++i) { int R, C; stage_rc(tid * 16 + i * 8192, R, C); Rr[i] = R; Cc[i] = C; const int Rb = Epi::PERM ? ((R & ~31) + perm32(R & 31)) : R;
        voffB[i] = (unsigned)Rb * S.ldb + 2u * (unsigned)C; }
    const unsigned kstep = 128u;
    const unsigned hstepB = (unsigned)HALF * S.ldb;
    const unsigned ldsw = (unsigned)wid * 1024u;
    const int aoff = lds_byte(wr * 64 + fr, fq * 8), boff = lds_byte(wc * 32 + fr, fq * 8);
#define PG8_SA(b, h) (((b) * 2 + (h)) * HTB)
#define PG8_SB(b, h) ((4 + (b) * 2 + (h)) * HTB)
#define PG8_STAGE(bufoff, soff, voff) do { _Pragma("unroll") for (int _i = 0; _i < 2; ++_i) \
        __builtin_amdgcn_raw_ptr_buffer_load_lds(rsrc, (LAS void*)(lds + (bufoff) + ldsw + _i * 8192), 16, (int)(voff)[_i], (int)(soff), 0, 0); } while (0)
#define PG8_LDA(dst, b, h) do { _Pragma("unroll") for (int m = 0; m < 4; ++m) dst[m] = cat8(*(const LAS bf16x8*)(lds + PG8_SA(b, h) + aoff + m * 2048), *(const LAS bf16x8*)(lds + PG8_SA(b, h) + aoff + m * 2048 + 1024)); } while (0)
#define PG8_LDB(dst, b, h) do { _Pragma("unroll") for (int n = 0; n < 2; ++n) dst[n] = cat8(*(const LAS bf16x8*)(lds + PG8_SB(b, h) + boff + n * 2048), *(const LAS bf16x8*)(lds + PG8_SB(b, h) + boff + n * 2048 + 1024)); } while (0)
#define PG8_MMA(ai, bj, At, Bt) do { __builtin_amdgcn_s_setprio(1); _Pragma("unroll") for (int m = 0; m < 4; ++m) _Pragma("unroll") for (int n = 0; n < 2; ++n) { \
        if constexpr (Epi::FP8) { asm volatile("v_mfma_scale_f32_16x16x128_f8f6f4 %0, %1, %2, %0, %3, %4 op_sel_hi:[0,0,0]" : "+v"(acc[ai][bj][m][n]) : "v"(Bt[n]), "v"(At[m]), "v"(sc_w), "v"(sc_a)); } \
        else { acc[ai][bj][m][n] = __builtin_amdgcn_mfma_f32_16x16x32_bf16(half8(Bt[n], 0), half8(At[m], 0), acc[ai][bj][m][n], 0, 0, 0); \
               acc[ai][bj][m][n] = __builtin_amdgcn_mfma_f32_16x16x32_bf16(half8(Bt[n], 1), half8(At[m], 1), acc[ai][bj][m][n], 0, 0, 0); } } \
        __builtin_amdgcn_s_setprio(0); } while (0)
#define PG8_WAIT_V(n) asm volatile("s_waitcnt vmcnt(" #n ")" ::: "memory")
#define PG8_WAIT_L(n) asm volatile("s_waitcnt lgkmcnt(" #n ")" ::: "memory")
#define PG8_BAR __builtin_amdgcn_s_barrier()
#define PG8_SCHED __builtin_amdgcn_sched_barrier(0)
#define PG8_RC() do { _Pragma("unroll") for (int i = 0; i < 2; ++i) { int R, C; stage_rc((int)threadIdx.x * 16 + i * 8192, R, C); Rr[i] = R; Cc[i] = C; } } while (0)
    GU cur, nxt; int ui = 0;
    if (!S.next(0, cur)) { if constexpr (Sched::XSYNC) { if (tid == 0) (void)xb_add(S.xw, (unsigned)S.rounds); } return; }
    f32x4 acc[2][2][4][2];
#pragma unroll
    for (int a = 0; a < 2; ++a)
#pragma unroll
        for (int b = 0; b < 2; ++b)
#pragma unroll
            for (int m = 0; m < 4; ++m)
#pragma unroll
                for (int n = 0; n < 2; ++n) acc[a][b][m][n] = (f32x4){0.f, 0.f, 0.f, 0.f};
    v8i At[4], B0[2], B1[2];
    int sc_w = 0x7a7a7a7a, sc_a = 0x7f7f7f7f; asm volatile("" : "+v"(sc_w), "+v"(sc_a));
    unsigned vA[2][2], nvA[2][2];
    S.aoff(cur, Rr, Cc, vA);
    unsigned cA = __builtin_amdgcn_readfirstlane(cur.a), cB = __builtin_amdgcn_readfirstlane(cur.b);
    PG8_SIDE(cur, 0);
    PG8_STAGE(PG8_SB(0, 0), cB, voffB); PG8_STAGE(PG8_SB(0, 1), cB + hstepB, voffB); PG8_STAGE(PG8_SA(0, 0), cA, vA[0]); PG8_STAGE(PG8_SA(0, 1), cA, vA[1]);
    if (wr == 1) PG8_BAR;
    PG8_WAIT_V(2); PG8_BAR;
    PG8_STAGE(PG8_SB(1, 0), cB + kstep, voffB); PG8_STAGE(PG8_SA(1, 0), cA + kstep, vA[0]); PG8_STAGE(PG8_SB(1, 1), cB + hstepB + kstep, voffB);
    PG8_WAIT_V(6); PG8_BAR;
    for (;;) {
        const bool has_next = S.next(ui + 1, nxt);
        const unsigned nA = has_next ? __builtin_amdgcn_readfirstlane(nxt.a) : cA, nB = has_next ? __builtin_amdgcn_readfirstlane(nxt.b) : cB;
        if (has_next) PG8_SIDE(nxt, (ui + 1) & 1);
        if constexpr (Sched::GATHER && !Sched::SIDE) {
            if (has_next) { PG8_RC(); S.aoff(nxt, Rr, Cc, nvA); }
            else { nvA[0][0] = vA[0][0]; nvA[0][1] = vA[0][1]; nvA[1][0] = vA[1][0]; nvA[1][1] = vA[1][1]; }
        }
#pragma unroll 1
        for (int t = 0; t < nt; t += 2) {
            const bool last = (t == nt - 2);
            const unsigned a1 = cA + (unsigned)(t + 1) * kstep;
            const unsigned a2 = last ? nA : cA + (unsigned)(t + 2) * kstep, b2 = last ? nB : cB + (unsigned)(t + 2) * kstep;
            const unsigned a3 = a2 + kstep, b3 = b2 + kstep;
            if constexpr (Sched::GATHER && Sched::SIDE) {
                if (last) { if (has_next) { PG8_RC(); const LAS int* tk = (const LAS int*)(lds + SIDE_OFF + ((ui + 1) & 1) * 2048);
#pragma unroll
                        for (int h = 0; h < 2; ++h)
#pragma unroll
                            for (int i = 0; i < 2; ++i) nvA[h][i] = S.tok_off(tk[h * 128 + Rr[i]], Cc[i]); }
                    else { nvA[0][0] = vA[0][0]; nvA[0][1] = vA[0][1]; nvA[1][0] = vA[1][0]; nvA[1][1] = vA[1][1]; } }
            }
            unsigned w0[2], w1[2];
            if constexpr (Sched::GATHER) { w0[0] = last ? nvA[0][0] : vA[0][0]; w0[1] = last ? nvA[0][1] : vA[0][1]; w1[0] = last ? nvA[1][0] : vA[1][0]; w1[1] = last ? nvA[1][1] : vA[1][1]; }
            else { w0[0] = vA[0][0]; w0[1] = vA[0][1]; w1[0] = vA[1][0]; w1[1] = vA[1][1]; }
            PG8_LDB(B0, 0, 0); PG8_LDB(B1, 0, 1); PG8_SCHED; PG8_LDA(At, 0, 0); PG8_STAGE(PG8_SA(1, 1), a1, vA[1]);
            PG8_WAIT_V(8); PG8_WAIT_L(0); PG8_BAR; PG8_MMA(0, 0, At, B0); PG8_MMA(0, 1, At, B1); PG8_BAR; PG8_SCHED;
            PG8_LDA(At, 0, 1); PG8_STAGE(PG8_SB(0, 0), b2, voffB); PG8_STAGE(PG8_SB(0, 1), b2 + hstepB, voffB); PG8_STAGE(PG8_SA(0, 0), a2, w0);
            PG8_WAIT_V(8); PG8_WAIT_L(0); PG8_BAR; PG8_MMA(1, 0, At, B0); PG8_MMA(1, 1, At, B1); PG8_BAR; PG8_SCHED;
            PG8_LDB(B0, 1, 0); PG8_LDB(B1, 1, 1); PG8_SCHED; PG8_LDA(At, 1, 0); PG8_STAGE(PG8_SA(0, 1), a2, w1);
            PG8_WAIT_V(8); PG8_WAIT_L(0); PG8_BAR; PG8_MMA(0, 0, At, B0); PG8_MMA(0, 1, At, B1); PG8_BAR; PG8_SCHED;
            PG8_LDA(At, 1, 1); PG8_STAGE(PG8_SB(1, 0), b3, voffB); PG8_STAGE(PG8_SB(1, 1), b3 + hstepB, voffB); PG8_STAGE(PG8_SA(1, 0), a3, w0);
            PG8_WAIT_V(8); PG8_WAIT_L(0); PG8_BAR; PG8_MMA(1, 0, At, B0); PG8_MMA(1, 1, At, B1); PG8_BAR; PG8_SCHED;
        }
        if (wr == 0) PG8_BAR;
        if constexpr (Epi::FP8) asm volatile("s_nop 15\n\ts_nop 7" ::: "memory");
        { int fr_ = fr, fq_ = fq; asm volatile("" : "+v"(fr_), "+v"(fq_)); E(acc, cur, wr, wc, fr_, fq_, (const LAS float*)(lds + SIDE_OFF + (ui & 1) * 2048 + 1024)); }
        if constexpr (Sched::XSYNC) {
            if (tid == 0) { (void)xb_add(S.xw, 1u); const unsigned tgt = (unsigned)(ui + 1) * S.nloc; unsigned sp = 0;
                while (xb_ld(S.xw) < tgt && ++sp < (1u << 16)) __builtin_amdgcn_s_sleep(1);
                if (!has_next && S.rounds > ui + 1) (void)xb_add(S.xw, (unsigned)(S.rounds - (ui + 1))); }
        }
        if constexpr (Sched::XSYNC || Sched::SIDE) PG8_BAR;
        if (!has_next) break;
#pragma unroll
        for (int a = 0; a < 2; ++a)
#pragma unroll
            for (int b = 0; b < 2; ++b)
#pragma unroll
                for (int m = 0; m < 4; ++m)
#pragma unroll
                    for (int n = 0; n < 2; ++n) acc[a][b][m][n] = (f32x4){0.f, 0.f, 0.f, 0.f};
        cur = nxt; cA = nA; cB = nB; ++ui;
        if constexpr (Sched::GATHER) { vA[0][0] = nvA[0][0]; vA[0][1] = nvA[0][1]; vA[1][0] = nvA[1][0]; vA[1][1] = nvA[1][1]; }
        if (wr == 1) PG8_BAR;
    }
    PG8_WAIT_V(0);
    PG8_BAR;
#undef PG8_RC
#undef PG8_SIDE
#undef PG8_SA
#undef PG8_SB
#undef PG8_STAGE
#undef PG8_LDA
#undef PG8_LDB
#undef PG8_MMA
#undef PG8_WAIT_V
#undef PG8_WAIT_L
#undef PG8_BAR
#undef PG8_SCHED
}
}
using pg8::GU;

struct Args { const float* in[32]; float* out; unsigned char* ws; int ph_lo, ph_hi; };
struct Frame {
    LAS unsigned char* lds;
    LAS unsigned char* scr;
    unsigned char* ws;
    int tid, lane, wave, G, vcu;
};
enum { I_X = 0, I_C, I_CTX, I_CCTX, I_NORMG, I_ADAW, I_ADAB, I_POOLW, I_POOLLS, I_MU, I_WRKV, I_W0, I_W1, I_W2, I_A0, I_A1, I_A2, I_G1, I_G2, I_KK, I_KA, I_RK, I_LNG, I_LNB, I_WO,
       I_RW, I_RB, I_WGU, I_BGU, I_WDN, I_BDN, I_FINALG };

__device__ __forceinline__ const float* modp(const Frame& F, int layer, int row, int k) { return (const float*)(F.ws + WS_MOD) + ((size_t)(layer * 3 + row) * NMOD + k) * D; }
__device__ __forceinline__ int mrow_of(int n) { return n < NL ? (n >> 14) : 2; }

__device__ __forceinline__ void transpose_tile(const float* W, int ldw, int k0, int n0, bf16_t* WT, size_t dst_row0, int ldk, int kdst0, LAS float* scr, int lane) {
    const int c4 = lane & 15, kr = lane >> 4;
#pragma unroll 4
    for (int it = 0; it < 16; ++it) { const int kk = 4 * it + kr; const f32x4 v = *(const GAS f32x4*)(W + (size_t)(k0 + kk) * ldw + n0 + 4 * c4);
        LAS float* s = scr + kk * 65 + 4 * c4; s[0] = v[0]; s[1] = v[1]; s[2] = v[2]; s[3] = v[3]; }
    LDS_WAIT(); asm volatile("" ::: "memory");
    const int c = lane & 7;
#pragma unroll
    for (int j = 0; j < 8; ++j) { const int n = (lane >> 3) + 8 * j; const LAS float* s = scr + (8 * c) * 65 + n;
        u32x4 o; o.x = cvt_pk_bf16(s[0 * 65], s[1 * 65]); o.y = cvt_pk_bf16(s[2 * 65], s[3 * 65]); o.z = cvt_pk_bf16(s[4 * 65], s[5 * 65]); o.w = cvt_pk_bf16(s[6 * 65], s[7 * 65]);
        *(GAS u32x4*)(WT + (dst_row0 + n) * (size_t)ldk + kdst0 + k0 + 8 * c) = o; }
    LDS_WAIT(); asm volatile("" ::: "memory");
}

__device__ __forceinline__ unsigned pk4_fp8(float a, float b, float c, float d) { int w = 0; w = __builtin_amdgcn_cvt_pk_fp8_f32(a, b, w, false); w = __builtin_amdgcn_cvt_pk_fp8_f32(c, d, w, true); return (unsigned)w; }
__device__ __forceinline__ void transpose_tile_fp8(const float* W, int ldw, int k0, int n0, unsigned char* WT, size_t dst_row0, int ldk, float scale, LAS float* scr, int lane) {
    const int c4 = lane & 15, kr = lane >> 4;
#pragma unroll 4
    for (int it = 0; it < 16; ++it) { const int kk = 4 * it + kr; const f32x4 v = *(const GAS f32x4*)(W + (size_t)(k0 + kk) * ldw + n0 + 4 * c4);
        LAS float* s = scr + kk * 65 + 4 * c4; s[0] = v[0] * scale; s[1] = v[1] * scale; s[2] = v[2] * scale; s[3] = v[3] * scale; }
    LDS_WAIT(); asm volatile("" ::: "memory");
    const int c = lane & 3;
#pragma unroll
    for (int j = 0; j < 4; ++j) { const int n = (lane >> 2) + 16 * j; const LAS float* s = scr + (16 * c) * 65 + n;
        u32x4 o; o.x = pk4_fp8(s[0 * 65], s[1 * 65], s[2 * 65], s[3 * 65]); o.y = pk4_fp8(s[4 * 65], s[5 * 65], s[6 * 65], s[7 * 65]);
        o.z = pk4_fp8(s[8 * 65], s[9 * 65], s[10 * 65], s[11 * 65]); o.w = pk4_fp8(s[12 * 65], s[13 * 65], s[14 * 65], s[15 * 65]);
        *(GAS u32x4*)(WT + (dst_row0 + n) * (size_t)ldk + k0 + 16 * c) = o; }
    LDS_WAIT(); asm volatile("" ::: "memory");
}
__device__ __forceinline__ void phase_prep(const Frame& F, const Args& A) {
    unsigned char* ws = F.ws;
    if (blockIdx.x < 192) {
        const int l = blockIdx.x / 96, cc = blockIdx.x % 96, c4 = F.tid & 15, kq = F.tid >> 4;
        const float* w = A.in[I_ADAW] + (size_t)l * D * (NMOD * D) + cc * 64 + 4 * c4;
        f32x4 a0 = {0, 0, 0, 0}, a1 = {0, 0, 0, 0}, a2 = {0, 0, 0, 0};
        for (int i = 0; i < 32; ++i) { const int k = kq + 32 * i;
            const f32x4 wv = *(const GAS f32x4*)(w + (size_t)k * (NMOD * D));
            float c0 = A.in[I_C][k], c1 = A.in[I_C][D + k], c2 = A.in[I_CCTX][k];
            c0 = c0 * sigmoidf_(c0); c1 = c1 * sigmoidf_(c1); c2 = c2 * sigmoidf_(c2);
            a0 += wv * c0; a1 += wv * c1; a2 += wv * c2; }
        LAS f32x4* red = (LAS f32x4*)F.scr;
        red[(kq * 3 + 0) * 16 + c4] = a0; red[(kq * 3 + 1) * 16 + c4] = a1; red[(kq * 3 + 2) * 16 + c4] = a2;
        __syncthreads();
        if (F.tid < 192) { const int r = F.tid / 64, c = F.tid % 64; float s = 0.f;
            for (int q = 0; q < 32; ++q) s += ((LAS float*)F.scr)[((q * 3 + r) * 16) * 4 + c];
            const int col = cc * 64 + c;
            ((float*)(ws + WS_MOD))[(size_t)(l * 3 + r) * (NMOD * D) + col] = s + A.in[I_ADAB][(size_t)l * NMOD * D + col]; }
        __syncthreads();
    }
    { bf16_t* w2p = (bf16_t*)(ws + WS_WL2);
      for (int i = blockIdx.x * NTHREADS + F.tid; i < 4 * 1024 * 8; i += F.G * NTHREADS) { const int o = i / 8192, c = (i / 8) % 1024, q = i % 8, d = o & 1;
          *(GAS u32x4*)(w2p + ((size_t)o * 1024 + c) * 128 + (1 - d) * 64 + q * 8) = (u32x4){0u, 0u, 0u, 0u}; } }
    LAS float* scr = (LAS float*)(F.scr) + F.wave * (64 * 65 + 63);
    const int gw = F.vcu * NWAVES + F.wave, NGW = F.G * NWAVES;
    constexpr int T_GU = 2 * NE * 16 * 32, T_DN = 2 * NE * 16 * 16, T_RKV = 3 * 256, T_WO = 256, T_L1 = 2 * 16 + 2 * 16 + 32, T_L2 = 2 * 16 + 2 * 16 + 2 * 16, T_PW = 4 * 16;
    constexpr int T_ALL = T_GU + T_DN + T_RKV + T_WO + T_L1 + T_L2 + T_PW;
    for (int it = gw; it < T_ALL; it += NGW) {
        int r = it;
        if (r < T_GU) { const int le = r / 512, q = r % 512, kb = q / 32, nb = q % 32; const int n0 = nb * 64;
            const int drow = (n0 < 1024) ? ((n0 >> 7) * 256 + (n0 & 127)) : (((n0 - 1024) >> 7) * 256 + 128 + ((n0 - 1024) & 127));
            transpose_tile_fp8(A.in[I_WGU] + (size_t)le * 1024 * 2048, 2048, kb * 64, n0, ws + WS_WGU, (size_t)le * 2048 + drow, 1024, 32.0f, scr, F.lane); continue; } r -= T_GU;
        if (r < T_DN) { const int le = r / 256, q = r % 256, kb = q / 16, nb = q % 16;
            transpose_tile_fp8(A.in[I_WDN] + (size_t)le * 1024 * 1024, 1024, kb * 64, nb * 64, ws + WS_WDN, (size_t)le * 1024 + nb * 64, 1024, 32.0f, scr, F.lane); continue; } r -= T_DN;
        if (r < T_RKV) { const int p = r / 256, q = r % 256, kb = q / 16, nb = q % 16;
            transpose_tile_fp8(A.in[I_WRKV] + (size_t)p * 1024 * 1024, 1024, kb * 64, nb * 64, ws + WS_WRKV, (size_t)p * 1024 + nb * 64, 1024, 32.0f, scr, F.lane); continue; } r -= T_RKV;
        if (r < T_WO) { const int kb = r / 16, nb = r % 16;
            transpose_tile(A.in[I_WO], 1024, kb * 64, nb * 64, (bf16_t*)(ws + WS_WO), (size_t)nb * 64, 1024, 0, scr, F.lane); continue; } r -= T_WO;
        if (r < T_L1) {
            if (r < 32) { const int d = r / 16, kb = r % 16; transpose_tile_fp8(A.in[I_W1] + (size_t)d * 1024 * 64, 64, kb * 64, 0, ws + WS_WL1, (size_t)0 * 256 + d * 64, 1024, 32.0f, scr, F.lane); continue; }
            r -= 32;
            if (r < 32) { const int d = r / 16, kb = r % 16; transpose_tile_fp8(A.in[I_A1] + (size_t)d * 1024 * 64, 64, kb * 64, 0, ws + WS_WL1, (size_t)1 * 256 + d * 64, 1024, 32.0f, scr, F.lane); continue; }
            r -= 32;
            { const int kb = r / 2, nb = r % 2; transpose_tile_fp8(A.in[I_G1], 128, kb * 64, nb * 64, ws + WS_WL1, (size_t)2 * 256 + nb * 64, 1024, 32.0f, scr, F.lane); continue; }
        } r -= T_L1;
        if (r < T_L2) {
            if (r < 32) { const int d = r / 16, nb = r % 16; transpose_tile(A.in[I_W2] + (size_t)d * 64 * 1024, 1024, 0, nb * 64, (bf16_t*)(ws + WS_WL2), (size_t)d * 1024 + nb * 64, 128, d * 64, scr, F.lane); continue; }
            r -= 32;
            if (r < 32) { const int d = r / 16, nb = r % 16; transpose_tile(A.in[I_A2] + (size_t)d * 64 * 1024, 1024, 0, nb * 64, (bf16_t*)(ws + WS_WL2), (size_t)(2 + d) * 1024 + nb * 64, 128, d * 64, scr, F.lane); continue; }
            r -= 32;
            { const int kb = r / 16, nb = r % 16; transpose_tile(A.in[I_G2], 1024, kb * 64, nb * 64, (bf16_t*)(ws + WS_WL2), (size_t)4 * 1024 + nb * 64, 128, 0, scr, F.lane); continue; }
        } r -= T_L2;
        { const int g = r / 16, q = r % 16, kb = q / 4, nb = q % 4;
          transpose_tile(A.in[I_POOLW] + (size_t)g * 256 * 256, 256, kb * 64, nb * 64, (bf16_t*)(ws + WS_WPOOL), (size_t)g * 256 + nb * 64, 256, 0, scr, F.lane); }
    }
}

__device__ __forceinline__ void phase_pre0(const Frame& F, const Args& A) {
    LAS float* hb = (LAS float*)F.scr;
    LAS float* rs = hb + 80 * 258;
    LAS float* gsc = rs + 80;
    LAS float* gsh = gsc + 256;
    bf16_t* dbuf = (bf16_t*)(F.ws + WS_DBUF);
    const float* ng = A.in[I_NORMG];
    for (int u = blockIdx.x; u < 520; u += F.G) {
        int tok0, nown = 64, hl = 0, hr = 0, L, pos0, row; const float* xsrc;
        if (u < 512) { tok0 = u * 64; L = 64; pos0 = 0; row = tok0 >> 14; xsrc = A.in[I_X] + (size_t)tok0 * D; }
        else { const int b = (u - 512) >> 2, q = (u - 512) & 3; tok0 = NL + b * CT + q * 64; L = CT; pos0 = q * 64; hl = q > 0 ? 8 : 0; hr = q < 3 ? 8 : 0; row = 2;
               xsrc = A.in[I_CTX] + (size_t)(b * CT + q * 64) * D; }
        const int nt = nown + hl + hr;
        for (int j = F.wave; j < nt; j += NWAVES) { const float* xr = xsrc + (ptrdiff_t)(j - hl) * D; float s = 0.f;
#pragma unroll
            for (int q = 0; q < 4; ++q) { const f32x4 v = *(const GAS f32x4*)(xr + 4 * F.lane + 256 * q); s += v[0] * v[0] + v[1] * v[1] + v[2] * v[2] + v[3] * v[3]; }
            s = wave_sum(s); if (F.lane == 0) rs[j] = 1.0f / sqrtf(s * (1.0f / D) + NORM_EPS); }
        for (int g = 0; g < 4; ++g) {
            __syncthreads();
            if (F.tid < 256) { const int c = g * 256 + F.tid; gsc[F.tid] = ng[c] * (1.0f + modp(F, 0, row, 1)[c]); gsh[F.tid] = modp(F, 0, row, 0)[c]; }
            __syncthreads();
            for (int i = F.tid; i < nt * 64; i += NTHREADS) { const int j = i >> 6, c4 = i & 63; const f32x4 v = *(const GAS f32x4*)(xsrc + (ptrdiff_t)(j - hl) * D + g * 256 + 4 * c4);
                const float r = rs[j]; LAS float* h = hb + j * 258 + 4 * c4;
                h[0] = v[0] * r * gsc[4 * c4 + 0] + gsh[4 * c4 + 0]; h[1] = v[1] * r * gsc[4 * c4 + 1] + gsh[4 * c4 + 1];
                h[2] = v[2] * r * gsc[4 * c4 + 2] + gsh[4 * c4 + 2]; h[3] = v[3] * r * gsc[4 * c4 + 3] + gsh[4 * c4 + 3]; }
            __syncthreads();
            const int win = 2 << g, hw = win >> 1;
            for (int i = F.tid; i < 64 * 128; i += NTHREADS) { const int cp = i & 127, t = i >> 7; const int p = pos0 + t;
                int lo = p - hw, hi = p + hw - 1; lo = lo < 0 ? 0 : lo; hi = hi > L - 1 ? L - 1 : hi;
                const int jlo = lo - (pos0 - hl), jhi = hi - (pos0 - hl);
                float s0 = 0.f, s1 = 0.f;
                for (int j = jlo; j <= jhi; ++j) { const f32x2 v = *(const LAS f32x2*)(hb + j * 258 + 2 * cp); s0 += v[0]; s1 += v[1]; }
                const float ic = 1.0f / (float)(hi - lo + 1); const f32x2 hv = *(const LAS f32x2*)(hb + (t + hl) * 258 + 2 * cp);
                *(GAS unsigned*)(dbuf + (size_t)(tok0 + t) * D + g * 256 + 2 * cp) = cvt_pk_bf16(s0 * ic - hv[0], s1 * ic - hv[1]); }
        }
        __syncthreads();
    }
}

struct SchedPool {
    static constexpr bool SIDE = false; static constexpr bool XSYNC = false; static constexpr bool GATHER = false;
    int G, vcu; int nt; unsigned ldb;
    __device__ __forceinline__ bool next(int i, GU& u) const { const int L = i * G + vcu; if (L >= 130 * 4) return false; const int pm = L >> 2, g = L & 3;
        u.a = (unsigned)(WS_DBUF + ((size_t)pm * 256 * D + g * 256) * 2); u.b = (unsigned)(WS_WPOOL + (size_t)g * 256 * 256 * 2); u.i0 = pm; u.i1 = g; u.i2 = 0; u.i3 = 0; return true; }
    __device__ __forceinline__ void aoff(const GU&, const int (&R)[2], const int (&C)[2], unsigned (&v)[2][2]) const {
#pragma unroll
        for (int h = 0; h < 2; ++h)
#pragma unroll
            for (int i = 0; i < 2; ++i) v[h][i] = (unsigned)((h * 128 + R[i]) * D + C[i]) * 2u; }
};
struct EpiPool {
    static constexpr bool FP8 = false; static constexpr bool PERM = false;
    const float* x; const float* ctx; const float* ls; const float* gate_base; float* xs;
    __device__ __forceinline__ void operator()(const f32x4 (&acc)[2][2][4][2], const GU& u, int wr, int wc, int fr, int fq, const LAS float* sb) const {
        const int pm = u.i0, g = u.i1; const int mrow = pm < 128 ? (pm >> 6) : 2;
        const float* gate = gate_base + (size_t)mrow * NMOD * D;
        const float* src = pm < 128 ? x + (size_t)pm * 256 * D : ctx + (size_t)(pm - 128) * 256 * D;
        const int col0 = g * 256 + wc * 32 + 4 * fq;
        f32x4 gl[2][2];
#pragma unroll
        for (int bj = 0; bj < 2; ++bj)
#pragma unroll
            for (int n = 0; n < 2; ++n) { const int c = col0 + bj * 128 + n * 16; gl[bj][n] = *(const GAS f32x4*)(gate + c) * *(const GAS f32x4*)(ls + c); }
#pragma unroll
        for (int ai = 0; ai < 2; ++ai)
#pragma unroll
            for (int m = 0; m < 4; ++m) { const int r = ai * 128 + wr * 64 + m * 16 + fr; const float* sp = src + (size_t)r * D + col0; float* op = xs + ((size_t)pm * 256 + r) * D + col0;
#pragma unroll
                for (int bj = 0; bj < 2; ++bj)
#pragma unroll
                    for (int n = 0; n < 2; ++n) *(GAS f32x4*)(op + bj * 128 + n * 16) = *(const GAS f32x4*)(sp + bj * 128 + n * 16) + gl[bj][n] * acc[ai][bj][m][n]; }
    }
};

__device__ __forceinline__ void phase_final_plain(const Frame& F, const Args& A, const float* xs) {
    const int gw = blockIdx.x * NWAVES + F.wave, NGW = F.G * NWAVES;
    for (int n = gw; n < NL; n += NGW) { const float* xr = xs + (size_t)n * D; f32x4 v[4]; float s = 0.f;
#pragma unroll
        for (int q = 0; q < 4; ++q) { v[q] = *(const GAS f32x4*)(xr + 4 * F.lane + 256 * q); s += v[q][0] * v[q][0] + v[q][1] * v[q][1] + v[q][2] * v[q][2] + v[q][3] * v[q][3]; }
        s = wave_sum(s); const float r = 1.0f / sqrtf(s * (1.0f / D) + NORM_EPS);
#pragma unroll
        for (int q = 0; q < 4; ++q) { const f32x4 g = *(const GAS f32x4*)(A.in[I_FINALG] + 4 * F.lane + 256 * q); *(GAS f32x4*)(A.out + (size_t)n * D + 4 * F.lane + 256 * q) = v[q] * r * g; }
    }
}


__device__ __forceinline__ int* cnt_word(const Frame& F, int l, int e) { return (int*)(F.ws + WS_CTL + CTL_CNT) + (l * NE + e) * 64; }
__device__ __forceinline__ void phase_post(const Frame& F, const Args& A, int l, const float* xs, int ntok) {
    LAS float* h2s = (LAS float*)F.scr;
    LAS float* part = (LAS float*)F.scr;
    LAS float* lgs = (LAS float*)(F.scr + 32 * 1028 * 4);
    LAS int* hist = (LAS int*)(lgs + 32 * 33);
    LAS int* base = hist + 32;
    LAS int* sel = base + 32;
    LAS int* lrank = sel + 128;
    unsigned char* H2 = F.ws + WS_H2;
    int* list = (int*)(F.ws + WS_LIST) + (size_t)l * NE * NTOK;
    int* tinfo = (int*)(F.ws + WS_TINFO) + (size_t)l * NTOK * 4;
    float* tgate = (float*)(F.ws + WS_TGATE) + (size_t)l * NTOK * 4;
    const float* ng = A.in[I_NORMG] + (size_t)(l * 2 + 1) * D;
    const float* rw = A.in[I_RW] + (size_t)l * D * NE;
    const float* rb = A.in[I_RB] + (size_t)l * NE;
    const int ntiles = ntok / 32;
    for (int tile = blockIdx.x; tile < ntiles; tile += F.G) {
        const int n0 = tile * 32, mrow = mrow_of(n0);
        const float* sc = modp(F, l, mrow, 4); const float* sh = modp(F, l, mrow, 3);
        if (F.tid < 32) hist[F.tid] = 0;
#pragma unroll 1
        for (int q = 0; q < 4; ++q) { const int tt = F.wave * 4 + q, n = n0 + tt; const float* xr = xs + (size_t)n * D; f32x4 v[4]; float s = 0.f;
#pragma unroll
            for (int jj = 0; jj < 4; ++jj) { v[jj] = *(const GAS f32x4*)(xr + 4 * F.lane + 256 * jj); s += v[jj][0] * v[jj][0] + v[jj][1] * v[jj][1] + v[jj][2] * v[jj][2] + v[jj][3] * v[jj][3]; }
            s = wave_sum(s); const float r = 1.0f / sqrtf(s * (1.0f / D) + NORM_EPS);
#pragma unroll
            for (int jj = 0; jj < 4; ++jj) { const int c = 4 * F.lane + 256 * jj; const f32x4 g = *(const GAS f32x4*)(ng + c), a = *(const GAS f32x4*)(sc + c), b = *(const GAS f32x4*)(sh + c);
                const f32x4 h = v[jj] * r * g * (a + 1.0f) + b;
                *(LAS f32x4*)(h2s + tt * 1028 + c) = h;
                *(GAS unsigned*)(H2 + (size_t)n * D + c) = pk4_fp8(h[0], h[1], h[2], h[3]); } }
        __syncthreads();
        f32x16 acc;
#pragma unroll
        for (int i = 0; i < 16; ++i) acc[i] = 0.f;
        { const int r = F.lane & 31, h = F.lane >> 5;
#pragma unroll 4
          for (int q = 0; q < 16; ++q) { const int kb = 128 * F.wave + 8 * q + 4 * h; const f32x4 a = *(const LAS f32x4*)(h2s + r * 1028 + kb);
              const float b0 = rw[(size_t)(kb + 0) * NE + r], b1 = rw[(size_t)(kb + 1) * NE + r], b2 = rw[(size_t)(kb + 2) * NE + r], b3 = rw[(size_t)(kb + 3) * NE + r];
              acc = __builtin_amdgcn_mfma_f32_32x32x2f32(a[0], b0, acc, 0, 0, 0); acc = __builtin_amdgcn_mfma_f32_32x32x2f32(a[1], b1, acc, 0, 0, 0);
              acc = __builtin_amdgcn_mfma_f32_32x32x2f32(a[2], b2, acc, 0, 0, 0); acc = __builtin_amdgcn_mfma_f32_32x32x2f32(a[3], b3, acc, 0, 0, 0); } }
        __syncthreads();
#pragma unroll
        for (int i = 0; i < 16; ++i) { const int row = (i & 3) + 8 * (i >> 2) + 4 * (F.lane >> 5), col = F.lane & 31; part[(F.wave * 32 + row) * 32 + col] = acc[i]; }
        __syncthreads();
        for (int i = F.tid; i < 1024; i += NTHREADS) { const int row = i >> 5, col = i & 31; float s = rb[col];
#pragma unroll
            for (int w = 0; w < 8; ++w) s += part[(w * 32 + row) * 32 + col];
            lgs[row * 33 + col] = s; }
        __syncthreads();
        if (F.tid < 32) { const int t = F.tid; float lv[32];
#pragma unroll
            for (int e = 0; e < 32; ++e) lv[e] = lgs[t * 33 + e];
            float tv[4]; int te[4];
#pragma unroll
            for (int j = 0; j < 4; ++j) { float best = -3.0e38f; int be = 0;
#pragma unroll
                for (int e = 0; e < 32; ++e) { const bool gt = lv[e] > best; best = gt ? lv[e] : best; be = gt ? e : be; }
                tv[j] = best; te[j] = be;
#pragma unroll
                for (int e = 0; e < 32; ++e) lv[e] = (e == be) ? -3.0e38f : lv[e]; }
            const float e1 = __expf(tv[1] - tv[0]), e2 = __expf(tv[2] - tv[0]), e3 = __expf(tv[3] - tv[0]); const float inv = 1.0f / (1.0f + e1 + e2 + e3);
            const float gt[4] = {inv, e1 * inv, e2 * inv, e3 * inv};
#pragma unroll
            for (int j = 0; j < 4; ++j) { sel[t * 4 + j] = te[j]; lrank[t * 4 + j] = __hip_atomic_fetch_add(&hist[te[j]], 1, __ATOMIC_RELAXED, __HIP_MEMORY_SCOPE_WORKGROUP);
                tgate[(size_t)(n0 + t) * 4 + j] = gt[j]; } }
        __syncthreads();
        if (F.tid < 32) { const int c = hist[F.tid]; base[F.tid] = c > 0 ? __hip_atomic_fetch_add(cnt_word(F, l, F.tid), c, __ATOMIC_RELAXED, __HIP_MEMORY_SCOPE_AGENT) : 0; }
        __syncthreads();
        if (F.tid < 128) { const int t = F.tid >> 2, e = sel[F.tid], pos = base[e] + lrank[F.tid]; list[(size_t)e * NTOK + pos] = n0 + t; tinfo[(size_t)(n0 + t) * 4 + (F.tid & 3)] = (e << 16) | pos; }
        __syncthreads();
    }
}

__device__ __forceinline__ void moe_prefix(const Frame& F, int l) {
    volatile LAS int* M = (volatile LAS int*)(F.lds + MISC_OFF);
    __syncthreads();
    if (F.tid == 0) { int acc = 0; for (int e = 0; e < NE; ++e) { const int c = __hip_atomic_load(cnt_word(F, l, e), __ATOMIC_RELAXED, __HIP_MEMORY_SCOPE_AGENT); M[64 + e] = c; M[16 + e] = acc; acc += (c + 255) >> 8; } M[16 + NE] = acc; }
    __syncthreads();
    { volatile LAS unsigned char* T2E = (volatile LAS unsigned char*)(F.lds + MISC_OFF + 448);
      for (int t = F.tid; t < 560; t += NTHREADS) { int e = 0; while (e < NE - 1 && M[16 + e + 1] <= t) ++e; T2E[t] = (unsigned char)e; } }
    __syncthreads();
}

struct SchedMoe1 {
    static constexpr bool SIDE = true; static constexpr bool XSYNC = false; static constexpr bool GATHER = true;
    const LAS int* M; const int* list; unsigned h2; unsigned w; int G, vcu; int nt; unsigned ldb; unsigned* xw; unsigned nloc; int rounds; __amdgpu_buffer_rsrc_t rsrcb; unsigned listoff;
    __device__ __forceinline__ bool side_src(const GU& u, int tid, unsigned& off) const { const int e = u.i0, pn = u.i2;
        if (tid < 256) { const int row0 = (u.i1 - M[16 + e]) * 256, nv = M[64 + e] - row0; off = listoff + (unsigned)(e * NTOK + row0 + (tid < nv ? tid : 0)) * 4u; return false; }
        const int j = tid - 256; off = (unsigned)(e * 2048 + (j < 128 ? 0 : 1024) + pn * 128 + (j & 127)) * 4u; return true; }
    __device__ __forceinline__ unsigned tok_off(int tok, int c) const { return (unsigned)(tok * D + 2 * c); }
    __device__ __forceinline__ bool next(int i, GU& u) const { const int L = i * G + vcu; const int tt = M[16 + NE]; if (L >= tt * 8) return false; const int mt = L >> 3, pn = L & 7;
        const int e = ((const LAS unsigned char*)M)[448 + mt];
        u.a = h2; u.b = w + (unsigned)(((size_t)e * 2048 + pn * 256) * 1024); u.i0 = e; u.i1 = mt; u.i2 = pn; u.i3 = 0; return true; }
    __device__ __forceinline__ void aoff(const GU& u, const int (&R)[2], const int (&C)[2], unsigned (&v)[2][2]) const {
        const int e = u.i0, row0 = (u.i1 - M[16 + e]) * 256, nv = M[64 + e] - row0; const int* lp = list + (size_t)e * NTOK + row0;
#pragma unroll
        for (int h = 0; h < 2; ++h)
#pragma unroll
            for (int i = 0; i < 2; ++i) { const int r = h * 128 + R[i]; const int tok = lp[r < nv ? r : 0]; v[h][i] = (unsigned)(tok * D + 2 * C[i]); } }
};
struct EpiMoe1 {
    static constexpr bool FP8 = true; static constexpr bool PERM = true;
    const float* bgu; unsigned char* act;
    __device__ __forceinline__ void operator()(const f32x4 (&acc)[2][2][4][2], const GU& u, int wr, int wc, int fr, int fq, const LAS float* sb) const {
        const int e = u.i0, mt = u.i1, pn = u.i2; const int col0 = pn * 128 + wc * 32 + 8 * fq;
        f32x4 bg[2], bu[2];
#pragma unroll
        for (int n = 0; n < 2; ++n) { bg[n] = *(const LAS f32x4*)(sb + wc * 32 + 8 * fq + 4 * n); bu[n] = *(const LAS f32x4*)(sb + 128 + wc * 32 + 8 * fq + 4 * n); }
#pragma unroll
        for (int ai = 0; ai < 2; ++ai)
#pragma unroll
            for (int m = 0; m < 4; ++m) { const size_t slot = (size_t)mt * 256 + ai * 128 + wr * 64 + m * 16 + fr; float o[8];
#pragma unroll
                for (int n = 0; n < 2; ++n)
#pragma unroll
                    for (int j = 0; j < 4; ++j) { float g = acc[ai][0][m][n][j] + bg[n][j], up = acc[ai][1][m][n][j] + bu[n][j];
                        g = fminf(g, 7.0f); up = fminf(fmaxf(up, -7.0f), 7.0f); o[4 * n + j] = (up + 1.0f) * (g * __builtin_amdgcn_rcpf(1.0f + __expf(-1.702f * g))); }
                u32x2 w; w.x = pk4_fp8(o[0], o[1], o[2], o[3]); w.y = pk4_fp8(o[4], o[5], o[6], o[7]);
                *(GAS u32x2*)(act + slot * D + col0) = w; }
    }
};
struct SchedMoe2 {
    static constexpr bool SIDE = true; static constexpr bool XSYNC = false; static constexpr bool GATHER = false;
    const LAS int* M; unsigned act; unsigned w; int G, vcu; int nt; unsigned ldb; unsigned* xw; unsigned nloc; int rounds; __amdgpu_buffer_rsrc_t rsrcb;
    __device__ __forceinline__ bool side_src(const GU& u, int tid, unsigned& off) const { const int e = u.i0, pn = u.i2;
        if (tid < 256) { off = 0u; return false; }
        off = (unsigned)(e * D + pn * 256 + (tid - 256)) * 4u; return true; }
    __device__ __forceinline__ bool next(int i, GU& u) const { const int L = i * G + vcu; const int tt = M[16 + NE]; if (L >= tt * 4) return false; const int mt = L >> 2, pn = L & 3;
        const int e = ((const LAS unsigned char*)M)[448 + mt];
        u.a = act + (unsigned)((size_t)mt * 256 * D); u.b = w + (unsigned)(((size_t)e * 1024 + pn * 256) * 1024); u.i0 = e; u.i1 = mt; u.i2 = pn; u.i3 = 0; return true; }
    __device__ __forceinline__ void aoff(const GU&, const int (&R)[2], const int (&C)[2], unsigned (&v)[2][2]) const {
#pragma unroll
        for (int h = 0; h < 2; ++h)
#pragma unroll
            for (int i = 0; i < 2; ++i) v[h][i] = (unsigned)((h * 128 + R[i]) * D + 2 * C[i]); }
};
struct EpiMoe2 {
    static constexpr bool FP8 = true; static constexpr bool PERM = true;
    const float* bdn; bf16_t* y2;
    __device__ __forceinline__ void operator()(const f32x4 (&acc)[2][2][4][2], const GU& u, int wr, int wc, int fr, int fq, const LAS float* sb) const {
        const int e = u.i0, mt = u.i1, pn = u.i2; const int col0 = pn * 256 + wc * 32 + 8 * fq;
        f32x4 bv[2][2];
#pragma unroll
        for (int bj = 0; bj < 2; ++bj)
#pragma unroll
            for (int n = 0; n < 2; ++n) bv[bj][n] = *(const LAS f32x4*)(sb + bj * 128 + wc * 32 + 8 * fq + 4 * n);
#pragma unroll
        for (int ai = 0; ai < 2; ++ai)
#pragma unroll
            for (int m = 0; m < 4; ++m) { const size_t slot = (size_t)mt * 256 + ai * 128 + wr * 64 + m * 16 + fr;
#pragma unroll
                for (int bj = 0; bj < 2; ++bj) { const f32x4 v0 = acc[ai][bj][m][0] + bv[bj][0], v1 = acc[ai][bj][m][1] + bv[bj][1];
                    u32x4 w; w.x = cvt_pk_bf16(v0[0], v0[1]); w.y = cvt_pk_bf16(v0[2], v0[3]); w.z = cvt_pk_bf16(v1[0], v1[1]); w.w = cvt_pk_bf16(v1[2], v1[3]);
                    *(GAS u32x4*)(y2 + slot * D + col0 + bj * 128) = w; } }
    }
};
__device__ __forceinline__ void phase_moe1(const Frame& F, const Args& A, int l) {
    moe_prefix(F, l);
    SchedMoe1 S{(const LAS int*)(F.lds + MISC_OFF), (const int*)(F.ws + WS_LIST) + (size_t)l * NE * NTOK, (unsigned)WS_H2, (unsigned)(WS_WGU + (size_t)l * NE * 2048 * 1024), F.G, F.vcu, 8, 1024u,
                (unsigned*)(F.ws + WS_CTL + CTL_XSYNC) + ((l * 2 + 0) * 16 + xb_xcc_id()) * 32, ((volatile LAS unsigned*)(F.lds + MISC_OFF))[8], (((const LAS int*)(F.lds + MISC_OFF))[16 + NE] * 8 + F.G - 1) / F.G,
                __builtin_amdgcn_make_buffer_rsrc((void*)(A.in[I_BGU] + (size_t)l * NE * 2048), 0, NE * 2048 * 4, 0x00020000), (unsigned)(WS_LIST + (size_t)l * NE * NTOK * 4)};
    EpiMoe1 E{A.in[I_BGU] + (size_t)l * NE * 2048, F.ws + WS_ACT};
    pg8::gemm_phase<EpiMoe1, SchedMoe1>(F.scr, F.ws, S, E);
}
__device__ __forceinline__ void phase_moe2(const Frame& F, const Args& A, int l) {
    moe_prefix(F, l);
    SchedMoe2 S{(const LAS int*)(F.lds + MISC_OFF), (unsigned)WS_ACT, (unsigned)(WS_WDN + (size_t)l * NE * 1024 * 1024), F.G, F.vcu, 8, 1024u,
                (unsigned*)(F.ws + WS_CTL + CTL_XSYNC) + ((l * 2 + 1) * 16 + xb_xcc_id()) * 32, ((volatile LAS unsigned*)(F.lds + MISC_OFF))[8], (((const LAS int*)(F.lds + MISC_OFF))[16 + NE] * 4 + F.G - 1) / F.G,
                __builtin_amdgcn_make_buffer_rsrc((void*)(A.in[I_BDN] + (size_t)l * NE * D), 0, NE * D * 4, 0x00020000)};
    EpiMoe2 E{A.in[I_BDN] + (size_t)l * NE * D, (bf16_t*)(F.ws + WS_Y2)};
    pg8::gemm_phase<EpiMoe2, SchedMoe2>(F.scr, F.ws, S, E);
}
__device__ __forceinline__ void moe_combine_row(const Frame& F, int l, int n, f32x4 (&o)[4]) {
    const volatile LAS int* M = (const volatile LAS int*)(F.lds + MISC_OFF);
    const int* ti = (const int*)(F.ws + WS_TINFO) + ((size_t)l * NTOK + n) * 4; const float* tg = (const float*)(F.ws + WS_TGATE) + ((size_t)l * NTOK + n) * 4;
    const bf16_t* y2 = (const bf16_t*)(F.ws + WS_Y2);
#pragma unroll
    for (int q = 0; q < 4; ++q) o[q] = (f32x4){0.f, 0.f, 0.f, 0.f};
#pragma unroll
    for (int j = 0; j < 4; ++j) { const int inf = ti[j]; const float g = tg[j]; const int e = inf >> 16, pos = inf & 0xffff; const size_t slot = (size_t)M[16 + e] * 256 + pos;
#pragma unroll
        for (int q = 0; q < 4; ++q) { const u32x2 w = *(const GAS u32x2*)(y2 + slot * D + 4 * F.lane + 256 * q);
            o[q] += (f32x4){bf_lo(w.x), bf_hi(w.x), bf_lo(w.y), bf_hi(w.y)} * g; } }
}
__device__ __forceinline__ void phase_final(const Frame& F, const Args& A, int l, const float* xs) {
    moe_prefix(F, l);
    const int gw = blockIdx.x * NWAVES + F.wave, NGW = F.G * NWAVES;
    for (int n = gw; n < NL; n += NGW) { const float* xr = xs + (size_t)n * D; const float* gate = modp(F, l, n >> 14, 5); f32x4 v[4], mo[4]; float s = 0.f;
        moe_combine_row(F, l, n, mo);
#pragma unroll
        for (int q = 0; q < 4; ++q) { const int c = 4 * F.lane + 256 * q; v[q] = *(const GAS f32x4*)(xr + c) + *(const GAS f32x4*)(gate + c) * mo[q]; s += v[q][0] * v[q][0] + v[q][1] * v[q][1] + v[q][2] * v[q][2] + v[q][3] * v[q][3]; }
        s = wave_sum(s); const float r = 1.0f / sqrtf(s * (1.0f / D) + NORM_EPS);
#pragma unroll
        for (int q = 0; q < 4; ++q) { const f32x4 g = *(const GAS f32x4*)(A.in[I_FINALG] + 4 * F.lane + 256 * q); *(GAS f32x4*)(A.out + (size_t)n * D + 4 * F.lane + 256 * q) = v[q] * r * g; }
    }
}


__device__ __forceinline__ void phase_pre1(const Frame& F, const Args& A) {
    moe_prefix(F, 0);
    LAS float* hs = (LAS float*)F.scr;
    const float* xs0 = (const float*)(F.ws + WS_XS0); float* xs1 = (float*)(F.ws + WS_XS1);
    const float* ng = A.in[I_NORMG] + (size_t)(1 * 2 + 0) * D;
    for (int tile = blockIdx.x; tile < NTOK / 32; tile += F.G) {
        const int n0 = tile * 32, mrow = mrow_of(n0);
        const int sbeg = n0 < NL ? (n0 & ~(TSEQ - 1)) : (NL + ((n0 - NL) & ~(CT - 1))), send = sbeg + (n0 < NL ? TSEQ : CT);
        const float* gate5 = modp(F, 0, mrow, 5); const float* sc = modp(F, 1, mrow, 1); const float* sh = modp(F, 1, mrow, 0);
        for (int j = F.wave; j < 34; j += NWAVES) { const int n = n0 - 1 + j;
            if (n < sbeg || n >= send) {
#pragma unroll
                for (int q = 0; q < 4; ++q) *(LAS f32x4*)(hs + j * 1028 + 4 * F.lane + 256 * q) = (f32x4){0.f, 0.f, 0.f, 0.f};
                continue; }
            f32x4 mo[4], v[4]; float s = 0.f; moe_combine_row(F, 0, n, mo);
#pragma unroll
            for (int q = 0; q < 4; ++q) { const int c = 4 * F.lane + 256 * q; v[q] = *(const GAS f32x4*)(xs0 + (size_t)n * D + c) + *(const GAS f32x4*)(gate5 + c) * mo[q];
                s += v[q][0] * v[q][0] + v[q][1] * v[q][1] + v[q][2] * v[q][2] + v[q][3] * v[q][3]; }
            if (j >= 1 && j <= 32) {
#pragma unroll
                for (int q = 0; q < 4; ++q) *(GAS f32x4*)(xs1 + (size_t)n * D + 4 * F.lane + 256 * q) = v[q]; }
            s = wave_sum(s); const float r = 1.0f / sqrtf(s * (1.0f / D) + NORM_EPS);
#pragma unroll
            for (int q = 0; q < 4; ++q) { const int c = 4 * F.lane + 256 * q; const f32x4 g = *(const GAS f32x4*)(ng + c), a = *(const GAS f32x4*)(sc + c), b = *(const GAS f32x4*)(sh + c);
                *(LAS f32x4*)(hs + j * 1028 + c) = v[q] * r * g * (a + 1.0f) + b; } }
        __syncthreads();
#pragma unroll 1
        for (int q4 = 0; q4 < 4; ++q4) { const int t = F.wave * 4 + q4, j = t + 1, n = n0 + t;
#pragma unroll
            for (int q = 0; q < 4; ++q) { const int c = 4 * F.lane + 256 * q;
                const f32x4 hm = *(const LAS f32x4*)(hs + (j - 1) * 1028 + c), h0 = *(const LAS f32x4*)(hs + j * 1028 + c), hp = *(const LAS f32x4*)(hs + (j + 1) * 1028 + c);
                const f32x4 xx = (hm + hp) * 0.5f - h0;
#pragma unroll
                for (int i = 0; i < 6; ++i) { const f32x4 mu = *(const GAS f32x4*)(A.in[I_MU] + (size_t)i * D + c); const f32x4 o = h0 + xx * mu;
                    *(GAS unsigned*)(F.ws + WS_MIX + (size_t)i * NTOK * D + (size_t)n * D + c) = pk4_fp8(o[0], o[1], o[2], o[3]); } } }
        __syncthreads();
    }
}

struct SchedProj {
    static constexpr bool SIDE = false; static constexpr bool XSYNC = false; static constexpr bool GATHER = false;
    int G, vcu; int nt; unsigned ldb;
    __device__ __forceinline__ bool next(int i, GU& u) const { int L = i * G + vcu; if (L >= 1940) return false;
        int kind, mi, wi, pm, pn;
        if (L < 512) { kind = 0; mi = 0; wi = 0; pm = L >> 2; pn = L & 3; }
        else if (L < 1032) { L -= 512; kind = 0; mi = 2; wi = 1; pm = L >> 2; pn = L & 3; }
        else if (L < 1552) { L -= 1032; kind = 0; mi = 3; wi = 2; pm = L >> 2; pn = L & 3; }
        else if (L < 1682) { L -= 1552; kind = 1; mi = 1; wi = 0; pm = L; pn = 0; }
        else if (L < 1812) { L -= 1682; kind = 2; mi = 4; wi = 1; pm = L; pn = 0; }
        else { L -= 1812; kind = 3; mi = 5; wi = 2; pm = L; pn = 0; }
        u.a = (unsigned)(WS_MIX + (size_t)mi * NTOK * D + (size_t)pm * 256 * D);
        u.b = kind == 0 ? (unsigned)(WS_WRKV + ((size_t)wi * 1024 + pn * 256) * 1024) : (unsigned)(WS_WL1 + (size_t)wi * 256 * 1024);
        u.i0 = pm; u.i1 = pn; u.i2 = kind; u.i3 = wi; return true; }
    __device__ __forceinline__ void aoff(const GU&, const int (&R)[2], const int (&C)[2], unsigned (&v)[2][2]) const {
#pragma unroll
        for (int h = 0; h < 2; ++h)
#pragma unroll
            for (int i = 0; i < 2; ++i) v[h][i] = (unsigned)((h * 128 + R[i]) * D + 2 * C[i]); }
};
struct EpiProj {
    static constexpr bool FP8 = true; static constexpr bool PERM = true;
    unsigned char* ws;
    __device__ __forceinline__ void operator()(const f32x4 (&acc)[2][2][4][2], const GU& u, int wr, int wc, int fr, int fq, const LAS float* sb) const {
        const int pm = u.i0, pn = u.i1, kind = u.i2, wi = u.i3;
        if (kind == 0) { bf16_t* o = (bf16_t*)(ws + WS_RKV + (size_t)wi * ACTB); const int col0 = pn * 256 + wc * 32 + 8 * fq;
#pragma unroll
            for (int ai = 0; ai < 2; ++ai)
#pragma unroll
                for (int m = 0; m < 4; ++m) { const size_t n = (size_t)pm * 256 + ai * 128 + wr * 64 + m * 16 + fr;
#pragma unroll
                    for (int bj = 0; bj < 2; ++bj) { const f32x4 v0 = acc[ai][bj][m][0], v1 = acc[ai][bj][m][1];
                        u32x4 w; w.x = cvt_pk_bf16(v0[0], v0[1]); w.y = cvt_pk_bf16(v0[2], v0[3]); w.z = cvt_pk_bf16(v1[0], v1[1]); w.w = cvt_pk_bf16(v1[2], v1[3]);
                        *(GAS u32x4*)(o + n * D + col0 + bj * 128) = w; } }
        } else { bf16_t* o = (bf16_t*)(ws + WS_LACT + (size_t)(kind - 1) * NTOK * 128 * 2); const int col0 = wc * 32 + 8 * fq;
#pragma unroll
            for (int ai = 0; ai < 2; ++ai)
#pragma unroll
                for (int m = 0; m < 4; ++m) { const size_t n = (size_t)pm * 256 + ai * 128 + wr * 64 + m * 16 + fr; float t[8];
#pragma unroll
                    for (int nn = 0; nn < 2; ++nn)
#pragma unroll
                        for (int j = 0; j < 4; ++j) { const float x = acc[ai][0][m][nn][j]; t[4 * nn + j] = kind == 1 ? tanhf(x) : (kind == 2 ? x : sigmoidf_(x)); }
                    u32x4 w; w.x = cvt_pk_bf16(t[0], t[1]); w.y = cvt_pk_bf16(t[2], t[3]); w.z = cvt_pk_bf16(t[4], t[5]); w.w = cvt_pk_bf16(t[6], t[7]);
                    *(GAS u32x4*)(o + n * 128 + col0) = w; } }
    }
};
struct SchedLora2 {
    static constexpr bool SIDE = false; static constexpr bool XSYNC = false; static constexpr bool GATHER = false;
    int G, vcu; int nt; unsigned ldb;
    __device__ __forceinline__ bool next(int i, GU& u) const { int L = i * G + vcu; if (L >= 4 * 520 + 512) return false;
        const int o = L < 2080 ? L / 520 : 4; L -= o * 520; const int pm = L >> 2, pn = L & 3; const int oa = o < 4 ? (o >> 1) : 2;
        u.a = (unsigned)(WS_LACT + (size_t)oa * NTOK * 128 * 2 + (size_t)pm * 256 * 128 * 2); u.b = (unsigned)(WS_WL2 + ((size_t)o * 1024 + pn * 256) * 128 * 2);
        u.i0 = pm; u.i1 = pn; u.i2 = o; u.i3 = 0; return true; }
    __device__ __forceinline__ void aoff(const GU&, const int (&R)[2], const int (&C)[2], unsigned (&v)[2][2]) const {
#pragma unroll
        for (int h = 0; h < 2; ++h)
#pragma unroll
            for (int i = 0; i < 2; ++i) v[h][i] = (unsigned)((h * 128 + R[i]) * 128 + C[i]) * 2u; }
};
struct EpiLora2 {
    static constexpr bool FP8 = false; static constexpr bool PERM = false;
    unsigned char* ws; const float* w0; const float* a0;
    __device__ __forceinline__ void operator()(const f32x4 (&acc)[2][2][4][2], const GU& u, int wr, int wc, int fr, int fq, const LAS float* sb) const {
        const int pm = u.i0, pn = u.i1, o = u.i2; const int col0 = pn * 256 + wc * 32 + 4 * fq;
        const float* bp = (o < 2 ? w0 + (size_t)o * D : a0 + (size_t)(o & 1) * D) + col0; const float bsc = o < 4 ? 1.0f : 0.0f;
        f32x4 bv[2][2];
#pragma unroll
        for (int bj = 0; bj < 2; ++bj)
#pragma unroll
            for (int n = 0; n < 2; ++n) bv[bj][n] = *(const GAS f32x4*)(bp + bj * 128 + n * 16) * bsc;
        const size_t row0 = (size_t)pm * 256 + wr * 64 + fr;
        if (o < 2) { bf16_t* dst = (bf16_t*)(ws + WS_DEC + (size_t)o * ACTB) + row0 * D + col0;
#pragma unroll
            for (int ai = 0; ai < 2; ++ai)
#pragma unroll
                for (int m = 0; m < 4; ++m)
#pragma unroll
                    for (int bj = 0; bj < 2; ++bj)
#pragma unroll
                        for (int nn = 0; nn < 2; ++nn) { const f32x4 z = acc[ai][bj][m][nn] + bv[bj][nn]; f32x4 d;
#pragma unroll
                            for (int j = 0; j < 4; ++j) d[j] = -0.60653066f * sigmoidf_(z[j]);
                            u32x2 w; w.x = cvt_pk_bf16(d[0], d[1]); w.y = cvt_pk_bf16(d[2], d[3]);
                            *(GAS u32x2*)(dst + (size_t)(ai * 128 + m * 16) * D + bj * 128 + nn * 16) = w; }
        } else { bf16_t* dst = (o < 4 ? (bf16_t*)(ws + WS_ICL + (size_t)(o - 2) * ACTB) : (bf16_t*)(ws + WS_G)) + row0 * D + col0; const bool sg = o < 4;
#pragma unroll
            for (int ai = 0; ai < 2; ++ai)
#pragma unroll
                for (int m = 0; m < 4; ++m)
#pragma unroll
                    for (int bj = 0; bj < 2; ++bj)
#pragma unroll
                        for (int nn = 0; nn < 2; ++nn) { f32x4 z = acc[ai][bj][m][nn] + bv[bj][nn];
#pragma unroll
                            for (int j = 0; j < 4; ++j) z[j] = sg ? sigmoidf_(z[j]) : z[j];
                            u32x2 w; w.x = cvt_pk_bf16(z[0], z[1]); w.y = cvt_pk_bf16(z[2], z[3]);
                            *(GAS u32x2*)(dst + (size_t)(ai * 128 + m * 16) * D + bj * 128 + nn * 16) = w; }
        }
    }
};
__device__ __forceinline__ void ld16bf(const bf16_t* p, float (&o)[16]) { const u32x4 a = *(const GAS u32x4*)p, b = *(const GAS u32x4*)(p + 8);
    o[0] = bf_lo(a.x); o[1] = bf_hi(a.x); o[2] = bf_lo(a.y); o[3] = bf_hi(a.y); o[4] = bf_lo(a.z); o[5] = bf_hi(a.z); o[6] = bf_lo(a.w); o[7] = bf_hi(a.w);
    o[8] = bf_lo(b.x); o[9] = bf_hi(b.x); o[10] = bf_lo(b.y); o[11] = bf_hi(b.y); o[12] = bf_lo(b.z); o[13] = bf_hi(b.z); o[14] = bf_lo(b.w); o[15] = bf_hi(b.w); }
__device__ __forceinline__ void st16bf(bf16_t* p, const float (&o)[16]) { u32x4 a, b;
    a.x = cvt_pk_bf16(o[0], o[1]); a.y = cvt_pk_bf16(o[2], o[3]); a.z = cvt_pk_bf16(o[4], o[5]); a.w = cvt_pk_bf16(o[6], o[7]);
    b.x = cvt_pk_bf16(o[8], o[9]); b.y = cvt_pk_bf16(o[10], o[11]); b.z = cvt_pk_bf16(o[12], o[13]); b.w = cvt_pk_bf16(o[14], o[15]);
    *(GAS u32x4*)p = a; *(GAS u32x4*)(p + 8) = b; }
__device__ __forceinline__ void ld16f(const float* p, float (&o)[16]) {
#pragma unroll
    for (int q = 0; q < 4; ++q) { const f32x4 v = *(const GAS f32x4*)(p + 4 * q); o[4 * q] = v[0]; o[4 * q + 1] = v[1]; o[4 * q + 2] = v[2]; o[4 * q + 3] = v[3]; } }
__device__ __forceinline__ void phase_fin(const Frame& F, const Args& A) {
    const int gw = blockIdx.x * NWAVES + F.wave, NGW = F.G * NWAVES; const int c0 = 16 * F.lane;
    float kkw[16], kaw[16]; ld16f(A.in[I_KK] + c0, kkw); ld16f(A.in[I_KA] + c0, kaw);
    const bf16_t* Kp = (const bf16_t*)(F.ws + WS_RKV + 1 * ACTB);
    for (int n = gw; n < NTOK; n += NGW) { const size_t off = (size_t)n * D + c0; float k[16], i0[16], i1[16], kk[16], o[16];
        ld16bf(Kp + off, k); ld16bf((const bf16_t*)(F.ws + WS_ICL) + off, i0); ld16bf((const bf16_t*)(F.ws + WS_ICL + ACTB) + off, i1);
        float ss = 0.f;
#pragma unroll
        for (int j = 0; j < 16; ++j) { kk[j] = k[j] * kkw[j]; ss += kk[j] * kk[j]; }
        ss += __shfl_xor(ss, 1); ss += __shfl_xor(ss, 2);
        const float inv = 1.0f / fmaxf(sqrtf(ss), 1e-12f);
#pragma unroll
        for (int j = 0; j < 16; ++j) kk[j] *= inv;
        st16bf((bf16_t*)(F.ws + WS_KK) + off, kk);
#pragma unroll
        for (int j = 0; j < 16; ++j) o[j] = k[j] * (1.0f + (i0[j] - 1.0f) * kaw[j]);
        st16bf((bf16_t*)(F.ws + WS_KDIR) + off, o);
#pragma unroll
        for (int j = 0; j < 16; ++j) o[j] = k[j] * (1.0f + (i1[j] - 1.0f) * kaw[j]);
        st16bf((bf16_t*)(F.ws + WS_KDIR + ACTB) + off, o);
#pragma unroll
        for (int j = 0; j < 16; ++j) o[j] = kk[j] * i0[j];
        st16bf((bf16_t*)(F.ws + WS_BV) + off, o);
#pragma unroll
        for (int j = 0; j < 16; ++j) o[j] = kk[j] * i1[j];
        st16bf((bf16_t*)(F.ws + WS_BV + ACTB) + off, o);
    }
}
constexpr int CK = 32, SNS = CT + TSEQ, CNCH = SNS / CK;
constexpr int RS = 144, TS = 80;
constexpr int OS_A = 0, OS_R = 4608, OS_KT = 9216, OS_BT = 14336, OS_VT = 19456, OS_GAM = 20736, OS_BYTES = 20992;
constexpr int OG_B = 0, OG_K = 4608, OG_BYTES = 9216;
constexpr int GM_KA = 0, GM_KR = 2560, GM_BR = 5120, GM_TT = 7680, GM_BYTES = 10240;
constexpr int RAW_BYTES = 5 * 4096 + 1024;
constexpr int L_OS = 0, L_OG = 3 * OS_BYTES, L_GM = L_OG + 2 * OG_BYTES, L_TSCR = L_GM + 2 * GM_BYTES, L_SSCR = L_TSCR + 5120, L_RAW = L_SSCR + 4864, L_SCAN_END = L_RAW + 2 * RAW_BYTES;
static_assert(L_SCAN_END <= SCR_BYTES, "scan LDS");
__device__ __forceinline__ int scan_token(int sg, int d, int b) { if (sg < CT) { const int t = d ? (CT - 1 - sg) : sg; return NL + b * CT + t; } const int u = sg - CT; const int t = d ? (TSEQ - 1 - u) : u; return b * TSEQ + t; }
__device__ __forceinline__ unsigned short f2bf(float f) { return (unsigned short)(cvt_pk_bf16(f, 0.f) & 0xffffu); }
__device__ __forceinline__ int acc_row(int p, int lane) { return (p & 3) + 8 * (p >> 2) + 4 * (lane >> 5); }
__device__ __forceinline__ void st_acc32(LAS unsigned char* dst, const f32x16& a, int lane) {
#pragma unroll
    for (int p = 0; p < 16; ++p) *(LAS unsigned short*)(dst + acc_row(p, lane) * TS + 2 * (lane & 31)) = f2bf(a[p]);
}
__device__ __forceinline__ bf16x8 acc_bfrag(const f32x16& a, int s) { u32x4 w; w.x = cvt_pk_bf16(a[8 * s + 0], a[8 * s + 1]); w.y = cvt_pk_bf16(a[8 * s + 2], a[8 * s + 3]); w.z = cvt_pk_bf16(a[8 * s + 4], a[8 * s + 5]); w.w = cvt_pk_bf16(a[8 * s + 6], a[8 * s + 7]); return __builtin_bit_cast(bf16x8, w); }
__device__ __forceinline__ bf16x8 lds_afrag_perm(const LAS unsigned char* m, int s, int lane) { const LAS unsigned char* p = m + (lane & 31) * TS + 2 * (16 * s + 4 * (lane >> 5));
    const u32x2 lo = *(const LAS u32x2*)p, hi = *(const LAS u32x2*)(p + 16); u32x4 w; w.x = lo.x; w.y = lo.y; w.z = hi.x; w.w = hi.y; return __builtin_bit_cast(bf16x8, w); }
__device__ __forceinline__ f32x16 gram32(const LAS unsigned char* P, const LAS unsigned char* Q, int lane) {
    f32x16 c;
#pragma unroll
    for (int p = 0; p < 16; ++p) c[p] = 0.f;
#pragma unroll
    for (int s = 0; s < 4; ++s) { const bf16x8 a = *(const LAS bf16x8*)(P + (lane & 31) * RS + 32 * s + 16 * (lane >> 5)), b = *(const LAS bf16x8*)(Q + (lane & 31) * RS + 32 * s + 16 * (lane >> 5));
        c = __builtin_amdgcn_mfma_f32_32x32x16_bf16(a, b, c, 0, 0, 0); }
    return c;
}
__device__ __forceinline__ void phase_scan(const Frame& F, const Args& A) {
    LAS unsigned char* lds = F.scr;
    const int lane = F.lane, wave = F.wave;
    const __amdgpu_buffer_rsrc_t rsrc = __builtin_amdgcn_make_buffer_rsrc((void*)F.ws, 0, 0xffffffff, 0x00020000);
    for (int job = F.vcu; job < 256; job += F.G) {
        const int sd = job >> 2, rq = job & 3, d = sd & 1, bh = sd >> 1, b = bh >> 4, hd = bh & 15;
        f32x4 Xa[4];
#pragma unroll
        for (int t = 0; t < 4; ++t) Xa[t] = (f32x4){0.f, 0.f, 0.f, 0.f};
        const int pj = wave == 3 ? 0 : (wave == 4 ? 1 : (wave == 6 ? 2 : 3));
        const bool is_prep = wave == 3 || wave == 4 || wave == 6 || wave == 7;
#define SCAN_DMA(c) do { const int c_ = (c); LAS unsigned char* raw_ = lds + L_RAW + (c_ & 1) * RAW_BYTES; \
            _Pragma("unroll") for (int g = 0; g < 4; ++g) { const int row = 8 * g + (lane >> 3); const int sg = c_ * CK + row; const unsigned n = (unsigned)scan_token(sg, d, b); \
                const unsigned off = n * (unsigned)(D * 2) + (unsigned)(hd * 128 + (lane & 7) * 16); \
                __builtin_amdgcn_raw_ptr_buffer_load_lds(rsrc, (LAS void*)(raw_ + 0 * 4096 + g * 1024), 16, (int)(off + (unsigned)(WS_DEC + (size_t)d * ACTB)), 0, 0, 0); \
                __builtin_amdgcn_raw_ptr_buffer_load_lds(rsrc, (LAS void*)(raw_ + 1 * 4096 + g * 1024), 16, (int)(off + (unsigned)WS_KK), 0, 0, 0); \
                __builtin_amdgcn_raw_ptr_buffer_load_lds(rsrc, (LAS void*)(raw_ + 2 * 4096 + g * 1024), 16, (int)(off + (unsigned)(WS_BV + (size_t)d * ACTB)), 0, 0, 0); \
                __builtin_amdgcn_raw_ptr_buffer_load_lds(rsrc, (LAS void*)(raw_ + 3 * 4096 + g * 1024), 16, (int)(off + (unsigned)(WS_KDIR + (size_t)d * ACTB)), 0, 0, 0); \
                if (c_ >= CT / CK) __builtin_amdgcn_raw_ptr_buffer_load_lds(rsrc, (LAS void*)(raw_ + 4 * 4096 + g * 1024), 16, (int)(off + (unsigned)WS_RKV), 0, 0, 0); } \
            { const int row = lane >> 1; const unsigned n = (unsigned)scan_token(c_ * CK + row, d, b); \
              __builtin_amdgcn_raw_ptr_buffer_load_lds(rsrc, (LAS void*)(raw_ + 5 * 4096), 16, (int)(n * (unsigned)(D * 2) + (unsigned)(hd * 128 + rq * 32 + (lane & 1) * 16) + (unsigned)(WS_RKV + 2 * ACTB)), 0, 0, 0); } } while (0)
        __syncthreads();
        if (wave == 0) { for (int i = lane; i < 16 * RS / 4; i += 64) ((LAS unsigned*)(lds + L_SSCR))[i] = 0u; }
        if (wave == 5) { SCAN_DMA(0); SCAN_DMA(1); asm volatile("s_waitcnt vmcnt(0)" ::: "memory"); }
        __syncthreads();
        for (int it = -2; it < CNCH; ++it) {
            const int cs = it, cg = it + 1, cp = it + 2;
            if (is_prep) {
                if (cp < CNCH) {
                    const LAS unsigned char* raw = lds + L_RAW + (cp & 1) * RAW_BYTES;
                    LAS unsigned char* os = lds + L_OS + (cp % 3) * OS_BYTES; LAS unsigned char* og = lds + L_OG + (cp & 1) * OG_BYTES;
                    float Lpre = 0.f, Ltot = 0.f, lwv[8];
#pragma unroll
                    for (int m = 0; m < 32; ++m) { const float x = bf2f(*(const LAS unsigned short*)(raw + m * 128 + 2 * lane)); Ltot += x; if (m < 8 * pj) Lpre += x; if (m >= 8 * pj && m < 8 * pj + 8) lwv[m & 7] = x; }
                    const float gam = __expf(Ltot);
                    if (pj == 0) *(LAS float*)(os + OS_GAM + 4 * lane) = gam;
                    float Lr = Lpre, ep_prev = __expf(Lpre); float kt[8], bt[8]; const bool has_r = cp >= CT / CK;
#pragma unroll
                    for (int j = 0; j < 8; ++j) { const int m = 8 * pj + j; Lr += lwv[j];
                        const float ep = __expf(Lr), em = __builtin_amdgcn_rcpf(ep);
                        const float kk = bf2f(*(const LAS unsigned short*)(raw + 4096 + m * 128 + 2 * lane)), bb = bf2f(*(const LAS unsigned short*)(raw + 8192 + m * 128 + 2 * lane)),
                                    kd = bf2f(*(const LAS unsigned short*)(raw + 12288 + m * 128 + 2 * lane)), r = has_r ? bf2f(*(const LAS unsigned short*)(raw + 16384 + m * 128 + 2 * lane)) : 0.f;
                        const f32x2 ar = (f32x2){kk, r} * (f32x2){ep_prev, ep}, bk = (f32x2){bb, kd} * em, tb = (f32x2){bk[1], bk[0]} * (f32x2){gam, -gam};
                        const unsigned w1 = cvt_pk_bf16(ar[0], ar[1]), w2 = cvt_pk_bf16(bk[0], bk[1]);
                        *(LAS unsigned short*)(os + OS_A + m * RS + 2 * lane) = (unsigned short)(w1 & 0xffffu);
                        *(LAS unsigned short*)(os + OS_R + m * RS + 2 * lane) = (unsigned short)(w1 >> 16);
                        *(LAS unsigned short*)(og + OG_B + m * RS + 2 * lane) = (unsigned short)(w2 & 0xffffu);
                        *(LAS unsigned short*)(og + OG_K + m * RS + 2 * lane) = (unsigned short)(w2 >> 16);
                        kt[j] = tb[0]; bt[j] = tb[1]; ep_prev = ep; }
#pragma unroll
                    for (int g = 0; g < 2; ++g) { u32x2 w; w.x = cvt_pk_bf16(kt[4 * g], kt[4 * g + 1]); w.y = cvt_pk_bf16(kt[4 * g + 2], kt[4 * g + 3]);
                        *(LAS u32x2*)(os + OS_KT + lane * TS + 2 * (8 * pj + 4 * g)) = w;
                        w.x = cvt_pk_bf16(bt[4 * g], bt[4 * g + 1]); w.y = cvt_pk_bf16(bt[4 * g + 2], bt[4 * g + 3]);
                        *(LAS u32x2*)(os + OS_BT + lane * TS + 2 * (8 * pj + 4 * g)) = w; }
                }
            } else if (wave == 5) {
                if (cp + 1 < CNCH && it >= -1) SCAN_DMA(cp + 1);
                if (cp < CNCH) { const LAS unsigned char* raw = lds + L_RAW + (cp & 1) * RAW_BYTES; LAS unsigned char* os = lds + L_OS + (cp % 3) * OS_BYTES;
                    unsigned short rv[8];
#pragma unroll
                    for (int j = 0; j < 8; ++j) rv[j] = *(const LAS unsigned short*)(raw + 5 * 4096 + (8 * (lane >> 4) + j) * 32 + 2 * (lane & 15));
                    u32x4 w; w.x = (unsigned)rv[0] | ((unsigned)rv[1] << 16); w.y = (unsigned)rv[2] | ((unsigned)rv[3] << 16); w.z = (unsigned)rv[4] | ((unsigned)rv[5] << 16); w.w = (unsigned)rv[6] | ((unsigned)rv[7] << 16);
                    *(LAS u32x4*)(os + OS_VT + (lane & 15) * TS + 16 * (lane >> 4)) = w; }
                asm volatile("s_waitcnt vmcnt(0)" ::: "memory");
            } else if (wave == 2) {
                if (cg >= 0 && cg < CNCH) {
                    const LAS unsigned char* os = lds + L_OS + (cg % 3) * OS_BYTES; const LAS unsigned char* og = lds + L_OG + (cg & 1) * OG_BYTES; LAS unsigned char* gm = lds + L_GM + (cg & 1) * GM_BYTES;
                    f32x16 c = gram32(os + OS_A, og + OG_K, lane);
#pragma unroll
                    for (int p = 0; p < 16; ++p) c[p] = (lane & 31) < acc_row(p, lane) ? c[p] : 0.f;
                    st_acc32(gm + GM_KA, c, lane);
                    c = gram32(os + OS_R, og + OG_K, lane);
#pragma unroll
                    for (int p = 0; p < 16; ++p) c[p] = (lane & 31) <= acc_row(p, lane) ? c[p] : 0.f;
                    st_acc32(gm + GM_KR, c, lane);
                    c = gram32(os + OS_R, og + OG_B, lane);
#pragma unroll
                    for (int p = 0; p < 16; ++p) c[p] = (lane & 31) <= acc_row(p, lane) ? -c[p] : 0.f;
                    st_acc32(gm + GM_BR, c, lane);
                }
            } else if (wave == 1) {
                if (cg >= 0 && cg < CNCH) {
                    const LAS unsigned char* os = lds + L_OS + (cg % 3) * OS_BYTES; const LAS unsigned char* og = lds + L_OG + (cg & 1) * OG_BYTES; LAS unsigned char* gm = lds + L_GM + (cg & 1) * GM_BYTES;
                    f32x16 X = gram32(os + OS_A, og + OG_B, lane), Xt = gram32(og + OG_B, os + OS_A, lane), Rm;
#pragma unroll
                    for (int p = 0; p < 16; ++p) { const int row = acc_row(p, lane), col = lane & 31; X[p] = col < row ? -X[p] : 0.f; Xt[p] = row < col ? -Xt[p] : 0.f; Rm[p] = X[p] + (col == row ? 1.f : 0.f); }
#pragma unroll
                    for (int lev = 0; lev < 5; ++lev) {
                        const bf16x8 xt0 = acc_bfrag(Xt, 0), xt1 = acc_bfrag(Xt, 1);
                        if (lev >= 1) { const bf16x8 r0 = acc_bfrag(Rm, 0), r1 = acc_bfrag(Rm, 1);
                            Rm = __builtin_amdgcn_mfma_f32_32x32x16_bf16(xt0, r0, Rm, 0, 0, 0); Rm = __builtin_amdgcn_mfma_f32_32x32x16_bf16(xt1, r1, Rm, 0, 0, 0); }
                        if (lev < 4) { const bf16x8 x0 = acc_bfrag(X, 0), x1 = acc_bfrag(X, 1); f32x16 z, zt;
#pragma unroll
                            for (int p = 0; p < 16; ++p) { z[p] = 0.f; zt[p] = 0.f; }
                            z = __builtin_amdgcn_mfma_f32_32x32x16_bf16(xt0, x0, z, 0, 0, 0); zt = __builtin_amdgcn_mfma_f32_32x32x16_bf16(x0, xt0, zt, 0, 0, 0);
                            z = __builtin_amdgcn_mfma_f32_32x32x16_bf16(xt1, x1, z, 0, 0, 0); zt = __builtin_amdgcn_mfma_f32_32x32x16_bf16(x1, xt1, zt, 0, 0, 0);
                            X = z; Xt = zt; }
                    }
                    st_acc32(gm + GM_TT, Rm, lane);
                }
            } else {
                if (cs >= 0) {
                    const LAS unsigned char* os = lds + L_OS + (cs % 3) * OS_BYTES; const LAS unsigned char* gm = lds + L_GM + (cs & 1) * GM_BYTES;
                    LAS unsigned char* Xb = lds + L_SSCR; LAS unsigned char* Hb = lds + L_SSCR + 2304; LAS unsigned char* Ub = lds + L_SSCR + 2304 + 1280;
                    const int r16 = lane & 15, q = lane >> 4;
                    const bf16x8 xa0 = *(const LAS bf16x8*)(Xb + r16 * RS + 16 * q), xa1 = *(const LAS bf16x8*)(Xb + r16 * RS + 64 + 16 * q), va = *(const LAS bf16x8*)(os + OS_VT + r16 * TS + 16 * q);
                    f32x4 h[2];
#pragma unroll
                    for (int ti = 0; ti < 2; ++ti) { const int i = 16 * ti + r16; f32x4 c = {0.f, 0.f, 0.f, 0.f};
                        c = __builtin_amdgcn_mfma_f32_16x16x32_bf16(xa0, *(const LAS bf16x8*)(os + OS_A + i * RS + 16 * q), c, 0, 0, 0);
                        c = __builtin_amdgcn_mfma_f32_16x16x32_bf16(xa1, *(const LAS bf16x8*)(os + OS_A + i * RS + 64 + 16 * q), c, 0, 0, 0);
                        c = __builtin_amdgcn_mfma_f32_16x16x32_bf16(va, *(const LAS bf16x8*)(gm + GM_KA + i * TS + 16 * q), c, 0, 0, 0);
                        h[ti] = c; }
#pragma unroll
                    for (int ti = 0; ti < 2; ++ti)
#pragma unroll
                        for (int j = 0; j < 4; ++j) *(LAS unsigned short*)(Hb + (4 * q + j) * TS + 2 * (16 * ti + r16)) = f2bf(h[ti][j]);
                    LDS_WAIT();
                    const bf16x8 ha = *(const LAS bf16x8*)(Hb + r16 * TS + 16 * q);
                    f32x4 u[2];
#pragma unroll
                    for (int ti = 0; ti < 2; ++ti) { const int i = 16 * ti + r16; f32x4 c = {0.f, 0.f, 0.f, 0.f};
                        u[ti] = __builtin_amdgcn_mfma_f32_16x16x32_bf16(ha, *(const LAS bf16x8*)(gm + GM_TT + i * TS + 16 * q), c, 0, 0, 0); }
#pragma unroll
                    for (int ti = 0; ti < 2; ++ti)
#pragma unroll
                        for (int j = 0; j < 4; ++j) *(LAS unsigned short*)(Ub + (4 * q + j) * TS + 2 * (16 * ti + r16)) = f2bf(u[ti][j]);
                    LDS_WAIT();
                    const bf16x8 ua = *(const LAS bf16x8*)(Ub + r16 * TS + 16 * q);
#pragma unroll
                    for (int t = 0; t < 4; ++t) { const int k = 16 * t + r16; const float g = *(const LAS float*)(os + OS_GAM + 4 * k); f32x4 c = Xa[t] * g;
                        c = __builtin_amdgcn_mfma_f32_16x16x32_bf16(va, *(const LAS bf16x8*)(os + OS_KT + k * TS + 16 * q), c, 0, 0, 0);
                        c = __builtin_amdgcn_mfma_f32_16x16x32_bf16(ua, *(const LAS bf16x8*)(os + OS_BT + k * TS + 16 * q), c, 0, 0, 0);
                        Xa[t] = c; }
                    if (cs >= CT / CK) {
#pragma unroll
                        for (int ti = 0; ti < 2; ++ti) { const int i = 16 * ti + r16; f32x4 c = {0.f, 0.f, 0.f, 0.f};
                            c = __builtin_amdgcn_mfma_f32_16x16x32_bf16(xa0, *(const LAS bf16x8*)(os + OS_R + i * RS + 16 * q), c, 0, 0, 0);
                            c = __builtin_amdgcn_mfma_f32_16x16x32_bf16(xa1, *(const LAS bf16x8*)(os + OS_R + i * RS + 64 + 16 * q), c, 0, 0, 0);
                            c = __builtin_amdgcn_mfma_f32_16x16x32_bf16(va, *(const LAS bf16x8*)(gm + GM_KR + i * TS + 16 * q), c, 0, 0, 0);
                            c = __builtin_amdgcn_mfma_f32_16x16x32_bf16(ua, *(const LAS bf16x8*)(gm + GM_BR + i * TS + 16 * q), c, 0, 0, 0);
                            const int n = scan_token(cs * CK + i, d, b);
                            u32x2 w; w.x = cvt_pk_bf16(c[0], c[1]); w.y = cvt_pk_bf16(c[2], c[3]);
                            *(GAS u32x2*)((bf16_t*)(F.ws + WS_YD + (size_t)d * NL * D * 2) + (size_t)n * D + hd * 64 + rq * 16 + 4 * q) = w; }
                    }
#pragma unroll
                    for (int t = 0; t < 4; ++t)
#pragma unroll
                        for (int j = 0; j < 4; ++j) *(LAS unsigned short*)(Xb + (4 * q + j) * RS + 2 * (16 * t + r16)) = f2bf(Xa[t][j]);
                }
            }
            __syncthreads();
        }
#undef SCAN_DMA
    }
}
__device__ __forceinline__ void phase_readout(const Frame& F, const Args& A) {
    const int gw = blockIdx.x * NWAVES + F.wave, NGW = F.G * NWAVES; const int c0 = 16 * F.lane;
    float lng[16], lnb[16], rk[16]; ld16f(A.in[I_LNG] + c0, lng); ld16f(A.in[I_LNB] + c0, lnb); ld16f(A.in[I_RK] + c0, rk);
    for (int n = gw; n < NL; n += NGW) { const size_t off = (size_t)n * D + c0; float y[16], t[16], r[16], kd[16], v[16], g[16], o[16];
        ld16bf((const bf16_t*)(F.ws + WS_YD) + off, y); ld16bf((const bf16_t*)(F.ws + WS_YD + (size_t)NL * D * 2) + off, t);
        float s = 0.f;
#pragma unroll
        for (int j = 0; j < 16; ++j) { y[j] += t[j]; s += y[j]; }
        s += __shfl_xor(s, 1); s += __shfl_xor(s, 2); const float m = s * (1.0f / 64.0f); float q = 0.f;
#pragma unroll
        for (int j = 0; j < 16; ++j) { y[j] -= m; q += y[j] * y[j]; }
        q += __shfl_xor(q, 1); q += __shfl_xor(q, 2); const float rs = 1.0f / sqrtf(q * (1.0f / 64.0f) + GN_EPS);
        ld16bf((const bf16_t*)(F.ws + WS_RKV) + off, r); ld16bf((const bf16_t*)(F.ws + WS_KDIR) + off, kd); ld16bf((const bf16_t*)(F.ws + WS_KDIR + ACTB) + off, t);
        float bs = 0.f;
#pragma unroll
        for (int j = 0; j < 16; ++j) bs += r[j] * (kd[j] + t[j]) * rk[j];
        bs += __shfl_xor(bs, 1); bs += __shfl_xor(bs, 2);
        ld16bf((const bf16_t*)(F.ws + WS_RKV + 2 * ACTB) + off, v); ld16bf((const bf16_t*)(F.ws + WS_G) + off, g);
#pragma unroll
        for (int j = 0; j < 16; ++j) o[j] = (y[j] * rs * lng[j] + lnb[j] + bs * v[j]) * g[j];
        st16bf((bf16_t*)(F.ws + WS_RO) + off, o);
    }
}
struct SchedWo {
    static constexpr bool SIDE = false; static constexpr bool XSYNC = false; static constexpr bool GATHER = false;
    int G, vcu; int nt; unsigned ldb;
    __device__ __forceinline__ bool next(int i, GU& u) const { const int L = i * G + vcu; if (L >= 512) return false; const int pm = L >> 2, pn = L & 3;
        u.a = (unsigned)(WS_RO + (size_t)pm * 256 * D * 2); u.b = (unsigned)(WS_WO + (size_t)pn * 256 * 1024 * 2); u.i0 = pm; u.i1 = pn; u.i2 = 0; u.i3 = 0; return true; }
    __device__ __forceinline__ void aoff(const GU&, const int (&R)[2], const int (&C)[2], unsigned (&v)[2][2]) const {
#pragma unroll
        for (int h = 0; h < 2; ++h)
#pragma unroll
            for (int i = 0; i < 2; ++i) v[h][i] = (unsigned)((h * 128 + R[i]) * D + C[i]) * 2u; }
};
struct EpiWo {
    static constexpr bool FP8 = false; static constexpr bool PERM = false;
    const float* xin; float* xout; const float* gate_base;
    __device__ __forceinline__ void operator()(const f32x4 (&acc)[2][2][4][2], const GU& u, int wr, int wc, int fr, int fq, const LAS float* sb) const {
        const int pm = u.i0, pn = u.i1; const float* gate = gate_base + (size_t)(pm >> 6) * NMOD * D; const int col0 = pn * 256 + wc * 32 + 4 * fq;
        f32x4 gl[2][2];
#pragma unroll
        for (int bj = 0; bj < 2; ++bj)
#pragma unroll
            for (int n = 0; n < 2; ++n) gl[bj][n] = *(const GAS f32x4*)(gate + col0 + bj * 128 + n * 16);
#pragma unroll
        for (int ai = 0; ai < 2; ++ai)
#pragma unroll
            for (int m = 0; m < 4; ++m) { const size_t off = ((size_t)pm * 256 + ai * 128 + wr * 64 + m * 16 + fr) * D + col0;
#pragma unroll
                for (int bj = 0; bj < 2; ++bj)
#pragma unroll
                    for (int n = 0; n < 2; ++n) *(GAS f32x4*)(xout + off + bj * 128 + n * 16) = *(const GAS f32x4*)(xin + off + bj * 128 + n * 16) + gl[bj][n] * acc[ai][bj][m][n]; }
    }
};

constexpr int NPHASES = 3;
__global__ void __launch_bounds__(NTHREADS, 2) fwd_kernel(Args args) {
    extern __shared__ __attribute__((aligned(16))) unsigned char lds_raw[];
    Frame F;
    F.lds = (LAS unsigned char*)lds_raw; F.scr = F.lds + SCR_OFF; F.ws = args.ws;
    F.tid = threadIdx.x; F.lane = F.tid & 63; F.wave = __builtin_amdgcn_readfirstlane(F.tid >> 6);
    F.G = gridDim.x; { const int bx = blockIdx.x; F.vcu = (F.G % 8 == 0) ? (bx % 8) * (F.G / 8) + bx / 8 : bx; }
    volatile LAS unsigned* MISC = (volatile LAS unsigned*)(F.lds + MISC_OFF);
    if (F.tid < 64) MISC[F.tid] = 0u;
    __syncthreads();
    const int lo = args.ph_lo, hi = args.ph_hi;
    XcdBarrier bar; bar.bar = (unsigned*)(F.ws + WS_CTL); bar.x = 0; bar.st = MISC + 8;
    if (hi - lo > 1) {
        unsigned* barw = (unsigned*)(F.ws + WS_CTL);
        bar.bar = barw; bar.x = xb_xcc_id(); bar.st = MISC + 8;
        if (F.tid == 0) {
            const unsigned rank = xb_add(&barw[XB_XCNT(bar.x)], 1u);
            unsigned nloc, nx; xcd_barrier_complete(barw, bar.x, nloc, nx); MISC[8] = nloc; MISC[9] = nx;
            unsigned pre = 0;
            for (unsigned j = 0; j < 16; ++j) { const unsigned c = xb_ld(&barw[XB_XCNT(j)]); if (j < bar.x) pre += c; }
            MISC[10] = pre + rank;
        }
        __syncthreads();
        F.vcu = (int)MISC[10];
    }
#define IN(k) (lo <= (k) && (k) < hi)
#define SEAM(k) do { if (IN(k) && IN((k) + 1)) xcd_barrier(bar); } while (0)
#define PH(k, ...) do { if (IN(k)) { __VA_ARGS__; if constexpr (((REPEAT_MASK >> (k)) & 1) != 0) { xcd_barrier(bar); __VA_ARGS__; } } SEAM(k); } while (0)
    PH(0, phase_prep(F, args));
    PH(1, phase_pre0(F, args));
    PH(2, { SchedPool S{F.G, F.vcu, 4, 512u};
            EpiPool E{args.in[I_X], args.in[I_CTX], args.in[I_POOLLS], modp(F, 0, 0, 2), (float*)(F.ws + WS_XS0)};
            pg8::gemm_phase<EpiPool, SchedPool>(F.scr, F.ws, S, E); });
    PH(3, phase_post(F, args, 0, (const float*)(F.ws + WS_XS0), NTOK));
    PH(4, phase_moe1(F, args, 0));
    PH(5, phase_moe2(F, args, 0));
    PH(6, phase_pre1(F, args));
    PH(7, { SchedProj S{F.G, F.vcu, 8, 1024u}; EpiProj E{F.ws}; pg8::gemm_phase<EpiProj, SchedProj>(F.scr, F.ws, S, E); });
    PH(8, { SchedLora2 S{F.G, F.vcu, 2, 256u}; EpiLora2 E{F.ws, args.in[I_W0], args.in[I_A0]}; pg8::gemm_phase<EpiLora2, SchedLora2>(F.scr, F.ws, S, E); });
    PH(9, phase_fin(F, args));
    PH(10, phase_scan(F, args));
    PH(11, phase_readout(F, args));
    PH(12, { SchedWo S{F.G, F.vcu, 16, 2048u}; EpiWo E{(const float*)(F.ws + WS_XS1), (float*)(F.ws + WS_XS0), modp(F, 1, 0, 2)}; pg8::gemm_phase<EpiWo, SchedWo>(F.scr, F.ws, S, E); });
    PH(13, phase_post(F, args, 1, (const float*)(F.ws + WS_XS0), NL));
    PH(14, phase_moe1(F, args, 1));
    PH(15, phase_moe2(F, args, 1));
    PH(16, phase_final(F, args, 1, (const float*)(F.ws + WS_XS0)));
#undef PH
#undef SEAM
#undef IN
}

extern "C" void kernel_launch(void* const* d_in, const int* in_sizes, int n_in, void* d_out, int out_size, void* d_ws, size_t ws_size, hipStream_t stream) {
    static int grid = 0;
    if (grid == 0) {
        if (n_in != 32 || ws_size < WS_END) { fprintf(stderr, "kernel_launch: unexpected n_in %d / ws %zu (need %zu)\n", n_in, ws_size, (size_t)WS_END); grid = -1; return; }
        int dev = 0, cus = 0;
        if (hipGetDevice(&dev) != hipSuccess || hipDeviceGetAttribute(&cus, hipDeviceAttributeMultiprocessorCount, dev) != hipSuccess) { grid = -1; return; }
        if (hipFuncSetAttribute((const void*)fwd_kernel, hipFuncAttributeMaxDynamicSharedMemorySize, LDS_BYTES) != hipSuccess) { fprintf(stderr, "kernel_launch: hipFuncSetAttribute failed\n"); grid = -1; return; }
        (void)hipGetLastError();
        grid = cus;
    }
    if (grid < 0) return;
    (void)hipMemsetAsync((char*)d_ws + WS_CTL, 0, CTL_BYTES, stream);
    Args a{};
    for (int i = 0; i < 32; ++i) a.in[i] = (const float*)d_in[i];
    a.out = (float*)d_out; a.ws = (unsigned char*)d_ws;
    const int last = 16;
#if N_LAUNCH_MODE == 1
    a.ph_lo = 0; a.ph_hi = last + 1;
    hipLaunchKernelGGL(fwd_kernel, dim3(grid), dim3(NTHREADS), LDS_BYTES, stream, a);
#else
    for (int p = 0; p <= last; ++p) { a.ph_lo = p; a.ph_hi = p + 1; hipLaunchKernelGGL(fwd_kernel, dim3(grid), dim3(NTHREADS), LDS_BYTES, stream, a); }
#endif
}
```

```cpp
#include <hip/hip_runtime.h>
#include <cstdio>
#include <cstdint>

#define LAS __attribute__((address_space(3)))
#define GAS __attribute__((address_space(1)))
typedef unsigned short bf16_t;
typedef short bf16x8 __attribute__((ext_vector_type(8)));
typedef float f32x4 __attribute__((ext_vector_type(4)));
typedef float f32x2 __attribute__((ext_vector_type(2)));
typedef float f32x16 __attribute__((ext_vector_type(16)));
typedef unsigned u32x4 __attribute__((ext_vector_type(4)));
typedef unsigned u32x2 __attribute__((ext_vector_type(2)));

#ifndef N_LAUNCH_MODE
#define N_LAUNCH_MODE 1
#endif
#ifndef REPEAT_MASK
#define REPEAT_MASK 0
#endif

constexpr int D = 1024, NB = 2, TSEQ = 16384, CT = 256, NL = NB * TSEQ, NC = NB * CT, NTOK = NL + NC;
constexpr int NE = 32, TOPK = 4, NMOD = 6;
constexpr int NWAVES = 8, NTHREADS = 512;
constexpr int MAXSLOT = ((NTOK * TOPK + 255) / 256 + NE) * 256;
constexpr float NORM_EPS = 1e-6f, GN_EPS = 64e-5f;

constexpr size_t AL(size_t x) { return (x + 255) & ~(size_t)255; }
constexpr size_t WS_CTL = 0, CTL_BYTES = 65536;
constexpr size_t CTL_XSYNC = 32768;
constexpr size_t CTL_CNT = 16384;
constexpr size_t WS_MOD = WS_CTL + CTL_BYTES;
constexpr size_t WS_LIST = AL(WS_MOD + 2 * 3 * 6144 * 4);
constexpr size_t WS_TINFO = AL(WS_LIST + (size_t)2 * NE * NTOK * 4);
constexpr size_t WS_TGATE = AL(WS_TINFO + (size_t)2 * NTOK * 4 * 4);
constexpr size_t WS_WGU = AL(WS_TGATE + (size_t)2 * NTOK * 4 * 4);
constexpr size_t WS_WDN = AL(WS_WGU + (size_t)2 * NE * 2048 * 1024 * 2);
constexpr size_t WS_WRKV = AL(WS_WDN + (size_t)2 * NE * 1024 * 1024 * 2);
constexpr size_t WS_WO = AL(WS_WRKV + (size_t)3 * 1024 * 1024 * 2);
constexpr size_t WS_WL1 = AL(WS_WO + (size_t)1024 * 1024 * 2);
constexpr size_t WS_WL2 = AL(WS_WL1 + (size_t)3 * 256 * 1024 * 2);
constexpr size_t WS_WPOOL = AL(WS_WL2 + (size_t)5 * 1024 * 128 * 2);
constexpr size_t WS_XS0 = AL(WS_WPOOL + (size_t)4 * 256 * 256 * 2);
constexpr size_t WS_XS1 = AL(WS_XS0 + (size_t)NTOK * D * 4);
constexpr size_t WS_T = AL(WS_XS1 + (size_t)NTOK * D * 4);
constexpr size_t ACTB = (size_t)NTOK * D * 2;
constexpr size_t TA = WS_T;
constexpr size_t TA_BYTES = (size_t)432 << 20;
constexpr size_t WS_DBUF = TA, WS_H2 = TA + ACTB, WS_ACT = TA + 2 * ACTB;
constexpr size_t WS_MIX = TA;
constexpr size_t WS_KDIR = TA, WS_BV = TA + 2 * ACTB, WS_KK = TA + 4 * ACTB;
constexpr size_t TB = TA + TA_BYTES;
constexpr size_t TB_BYTES = (size_t)290 << 20;
constexpr size_t WS_Y2 = TB, WS_RKV = TB;
constexpr size_t TC = TB + TB_BYTES;
constexpr size_t WS_DEC = TC, WS_RO = TC;
constexpr size_t TD = AL(TC + (size_t)2 * NTOK * D * 4);
constexpr size_t WS_ICL = TD, WS_YD = TD;
constexpr size_t TE = AL(TD + 2 * ACTB);
constexpr size_t WS_G = TE;
constexpr size_t TF = AL(TE + ACTB);
constexpr size_t WS_LACT = TF;
constexpr size_t WS_END = AL(TF + (size_t)3 * NTOK * 128 * 2);
static_assert(WS_ACT + (size_t)MAXSLOT * D * 2 <= TA + TA_BYTES, "ACT overflows TA");
static_assert((size_t)MAXSLOT * D * 2 <= TB_BYTES, "Y2 overflows TB");
static_assert(WS_END <= ((size_t)2048 << 20), "workspace too large");

constexpr int MISC_OFF = 0, SCR_OFF = 1024, SCR_BYTES = 162816, LDS_BYTES = SCR_OFF + SCR_BYTES;

typedef __bf16 bf16x2_t __attribute__((ext_vector_type(2)));
__device__ __forceinline__ unsigned cvt_pk_bf16(float lo, float hi) { const f32x2 v = {lo, hi}; return __builtin_bit_cast(unsigned, __builtin_convertvector(v, bf16x2_t)); }
__device__ __forceinline__ float bf_lo(unsigned w) { return __uint_as_float(w << 16); }
__device__ __forceinline__ float bf_hi(unsigned w) { return __uint_as_float(w & 0xffff0000u); }
__device__ __forceinline__ float bf2f(bf16_t b) { return __uint_as_float(((unsigned)b) << 16); }
__device__ __forceinline__ float wave_sum(float v) {
#pragma unroll
    for (int o = 1; o < 64; o <<= 1) v += __shfl_xor(v, o);
    return v;
}
__device__ __forceinline__ float sigmoidf_(float x) { return 1.0f / (1.0f + __expf(-x)); }
#define LDS_WAIT() asm volatile("s_waitcnt lgkmcnt(0)" ::: "memory")
#define VM_WAIT() asm volatile("s_waitcnt vmcnt(0)" ::: "memory")

#define XB_TMO      128
#define XB_XCNT(j)  (256  + 64 * (j))
#define XB_XSUB(j)  (1280 + 64 * (j))
#define XB_XGEN(j)  (2304 + 64 * (j))
#define XB_TOP      3328
#define XB_TOPGEN   3392
#define XCD_BAR_WORDS 3456
#define XB_SPIN_CAP (1u << 22)
__device__ __forceinline__ unsigned xb_ld(unsigned* p)              { return __hip_atomic_load(p, __ATOMIC_RELAXED, __HIP_MEMORY_SCOPE_AGENT); }
__device__ __forceinline__ unsigned xb_add(unsigned* p, unsigned v) { return __hip_atomic_fetch_add(p, v, __ATOMIC_RELAXED, __HIP_MEMORY_SCOPE_AGENT); }
__device__ __forceinline__ unsigned xb_xcc_id() { return (unsigned)__builtin_amdgcn_s_getreg((3 << 11) | 20) & 0xFu; }
#define XB_SPIN(cond, bar) do { unsigned _sp = 0; while (cond) { __builtin_amdgcn_s_sleep(1); \
    if ((++_sp & 255u) == 0u) { if (xb_ld(&(bar)[XB_TMO])) break; if (_sp > XB_SPIN_CAP) { atomicAdd(&(bar)[XB_TMO], 1u); break; } } } } while (0)
struct XcdBarrier { unsigned* bar; unsigned x; volatile LAS unsigned* st; };
__device__ __forceinline__ XcdBarrier xcd_barrier_post(unsigned* bar, volatile LAS unsigned* st) {
    XcdBarrier b; b.bar = bar; b.x = xb_xcc_id(); b.st = st;
    if (threadIdx.x == 0) (void)xb_add(&bar[XB_XCNT(b.x)], 1u);
    return b;
}
__device__ __forceinline__ void xcd_barrier_complete(unsigned* bar, unsigned x, unsigned& nloc, unsigned& nx) {
    const unsigned G = gridDim.x * gridDim.y * gridDim.z;
    unsigned sum, cnt, mine, sp = 0u;
    for (;;) {
        sum = 0u; cnt = 0u; mine = 0u;
#pragma unroll
        for (unsigned j = 0; j < 16; ++j) { const unsigned c = xb_ld(&bar[XB_XCNT(j)]); sum += c; cnt += (c > 0u) ? 1u : 0u; mine = (j == x) ? c : mine; }
        if (sum == G) break;
        __builtin_amdgcn_s_sleep(1);
        if ((++sp & 255u) == 0u) { if (xb_ld(&bar[XB_TMO])) break; if (sp > XB_SPIN_CAP) { atomicAdd(&bar[XB_TMO], 1u); break; } }
    }
    nloc = mine > 0u ? mine : 1u; nx = cnt > 0u ? cnt : 1u;
}
__device__ __forceinline__ void xcd_barrier(const XcdBarrier& b) {
    asm volatile("s_waitcnt vmcnt(0)" ::: "memory");
    __syncthreads();
    if (threadIdx.x == 0) {
        unsigned* bar = b.bar;
        __builtin_amdgcn_s_waitcnt(0);
        unsigned nloc = b.st[0], nx = b.st[1];
        if (nloc == 0u) { xcd_barrier_complete(bar, b.x, nloc, nx); b.st[0] = nloc; b.st[1] = nx; }
        const unsigned old = xb_add(&bar[XB_XSUB(b.x)], 1u);
        const unsigned gen = old / nloc;
        if (old + 1u == (gen + 1u) * nloc) {
            __builtin_amdgcn_fence(__ATOMIC_RELEASE, "agent");
            asm volatile("s_waitcnt vmcnt(0)" ::: "memory");
            const unsigned og = xb_add(&bar[XB_TOP], 1u);
            const unsigned tg = og / nx;
            if (og + 1u == (tg + 1u) * nx) xb_add(&bar[XB_TOPGEN], 1u);
            else XB_SPIN(xb_ld(&bar[XB_TOPGEN]) == tg, bar);
            __builtin_amdgcn_fence(__ATOMIC_ACQUIRE, "agent");
            xb_add(&bar[XB_XGEN(b.x)], 1u);
            asm volatile("s_waitcnt vmcnt(0)" ::: "memory");
        } else {
            XB_SPIN(xb_ld(&bar[XB_XGEN(b.x)]) == gen, bar);
            __builtin_amdgcn_fence(__ATOMIC_ACQUIRE, "agent");
            asm volatile("s_waitcnt vmcnt(0)" ::: "memory");
        }
    }
    __syncthreads();
}

namespace pg8 {
constexpr int BM = 256, BK = 64, HALF = 128, HTB = HALF * BK * 2, STAGE_BYTES = 8 * HTB;
__host__ __device__ __forceinline__ int lds_byte(int r, int c) { const int st = (r >> 4) * 2 + (c >> 5), rr = r & 15, cc = c & 31, ob = rr * 64 + cc * 2; return st * 1024 + (ob ^ (((ob >> 9) & 1) << 5)); }
__host__ __device__ __forceinline__ void stage_rc(int b, int& R, int& C) { const int st = b / 1024, sb = b % 1024, swz = sb ^ (((sb >> 9) & 1) << 5); R = (st >> 1) * 16 + swz / 64; C = (st & 1) * 32 + (swz % 64) / 2; }
__host__ __device__ __forceinline__ int perm32(int rho) { const int n = rho >> 4, i = rho & 15; return 8 * (i >> 2) + 4 * n + (i & 3); }

struct GU { unsigned a, b; int i0, i1, i2, i3; };
typedef int v8i __attribute__((ext_vector_type(8)));
typedef int v4i __attribute__((ext_vector_type(4)));
__device__ __forceinline__ bf16x8 half8(v8i v, int h) { const v4i a = h ? __builtin_shufflevector(v, v, 4, 5, 6, 7) : __builtin_shufflevector(v, v, 0, 1, 2, 3); return __builtin_bit_cast(bf16x8, a); }
__device__ __forceinline__ v8i cat8(bf16x8 lo, bf16x8 hi) { const v4i a = __builtin_bit_cast(v4i, lo), b = __builtin_bit_cast(v4i, hi); return __builtin_shufflevector(a, b, 0, 1, 2, 3, 4, 5, 6, 7); }

template <class Epi, class Sched>
__device__ __forceinline__ void gemm_phase(LAS unsigned char* lds, unsigned char* wsbase, const Sched& S, const Epi& E) {
    const int tid = threadIdx.x, wid = __builtin_amdgcn_readfirstlane(tid >> 6), lane = tid & 63, wr = wid >> 2, wc = wid & 3, fr = lane & 15, fq = lane >> 4;
    const int nt = S.nt;
    const __amdgpu_buffer_rsrc_t rsrc = __builtin_amdgcn_make_buffer_rsrc((void*)wsbase, 0, 0xffffffff, 0x00020000);
    constexpr int SIDE_OFF = STAGE_BYTES;
#define PG8_SIDE(u, buf) do { if constexpr (Sched::SIDE) { unsigned so_; const bool isb_ = S.side_src((u), tid, so_); (void)isb_; \
        if (wid < 4) __builtin_amdgcn_raw_ptr_buffer_load_lds(rsrc, (LAS void*)(lds + SIDE_OFF + (buf) * 2048 + wid * 256), 4, (int)so_, 0, 0, 0); \
        else __builtin_amdgcn_raw_ptr_buffer_load_lds(S.rsrcb, (LAS void*)(lds + SIDE_OFF + (buf) * 2048 + wid * 256), 4, (int)so_, 0, 0, 0); } } while (0)
    int Rr[2], Cc[2]; unsigned voffB[2];
#pragma unroll
    for (int i = 0; i < 2; ++i) { int R, C; stage_rc(tid * 16 + i * 8192, R, C); Rr[i] = R; Cc[i] = C; const int Rb = Epi::PERM ? ((R & ~31) + perm32(R & 31)) : R;
        voffB[i] = (unsigned)Rb * S.ldb + 2u * (unsigned)C; }
    const unsigned kstep = 128u;
    const unsigned hstepB = (unsigned)HALF * S.ldb;
    const unsigned ldsw = (unsigned)wid * 1024u;
    const int aoff = lds_byte(wr * 64 + fr, fq * 8), boff = lds_byte(wc * 32 + fr, fq * 8);
#define PG8_SA(b, h) (((b) * 2 + (h)) * HTB)
#define PG8_SB(b, h) ((4 + (b) * 2 + (h)) * HTB)
#define PG8_STAGE(bufoff, soff, voff) do { _Pragma("unroll") for (int _i = 0; _i < 2; ++_i) \
        __builtin_amdgcn_raw_ptr_buffer_load_lds(rsrc, (LAS void*)(lds + (bufoff) + ldsw + _i * 8192), 16, (int)(voff)[_i], (int)(soff), 0, 0); } while (0)
#define PG8_LDA(dst, b, h) do { _Pragma("unroll") for (int m = 0; m < 4; ++m) dst[m] = cat8(*(const LAS bf16x8*)(lds + PG8_SA(b, h) + aoff + m * 2048), *(const LAS bf16x8*)(lds + PG8_SA(b, h) + aoff + m * 2048 + 1024)); } while (0)
#define PG8_LDB(dst, b, h) do { _Pragma("unroll") for (int n = 0; n < 2; ++n) dst[n] = cat8(*(const LAS bf16x8*)(lds + PG8_SB(b, h) + boff + n * 2048), *(const LAS bf16x8*)(lds + PG8_SB(b, h) + boff + n * 2048 + 1024)); } while (0)
#define PG8_MMA(ai, bj, At, Bt) do { __builtin_amdgcn_s_setprio(1); _Pragma("unroll") for (int m = 0; m < 4; ++m) _Pragma("unroll") for (int n = 0; n < 2; ++n) { \
        if constexpr (Epi::FP8) { asm volatile("v_mfma_scale_f32_16x16x128_f8f6f4 %0, %1, %2, %0, %3, %4 op_sel_hi:[0,0,0]" : "+v"(acc[ai][bj][m][n]) : "v"(Bt[n]), "v"(At[m]), "v"(sc_w), "v"(sc_a)); } \
        else { acc[ai][bj][m][n] = __builtin_amdgcn_mfma_f32_16x16x32_bf16(half8(Bt[n], 0), half8(At[m], 0), acc[ai][bj][m][n], 0, 0, 0); \
               acc[ai][bj][m][n] = __builtin_amdgcn_mfma_f32_16x16x32_bf16(half8(Bt[n], 1), half8(At[m], 1), acc[ai][bj][m][n], 0, 0, 0); } } \
        __builtin_amdgcn_s_setprio(0); } while (0)
#define PG8_WAIT_V(n) asm volatile("s_waitcnt vmcnt(" #n ")" ::: "memory")
#define PG8_WAIT_L(n) asm volatile("s_waitcnt lgkmcnt(" #n ")" ::: "memory")
#define PG8_BAR __builtin_amdgcn_s_barrier()
#define PG8_SCHED __builtin_amdgcn_sched_barrier(0)
#define PG8_RC() do { _Pragma("unroll") for (int i = 0; i < 2; ++i) { int R, C; stage_rc((int)threadIdx.x * 16 + i * 8192, R, C); Rr[i] = R; Cc[i] = C; } } while (0)
    GU cur, nxt; int ui = 0;
    if (!S.next(0, cur)) { if constexpr (Sched::XSYNC) { if (tid == 0) (void)xb_add(S.xw, (unsigned)S.rounds); } return; }
    f32x4 acc[2][2][4][2];
#pragma unroll
    for (int a = 0; a < 2; ++a)
#pragma unroll
        for (int b = 0; b < 2; ++b)
#pragma unroll
            for (int m = 0; m < 4; ++m)
#pragma unroll
                for (int n = 0; n < 2; ++n) acc[a][b][m][n] = (f32x4){0.f, 0.f, 0.f, 0.f};
    v8i At[4], B0[2], B1[2];
    int sc_w = 0x7a7a7a7a, sc_a = 0x7f7f7f7f; asm volatile("" : "+v"(sc_w), "+v"(sc_a));
    unsigned vA[2][2], nvA[2][2];
    S.aoff(cur, Rr, Cc, vA);
    unsigned cA = __builtin_amdgcn_readfirstlane(cur.a), cB = __builtin_amdgcn_readfirstlane(cur.b);
    PG8_SIDE(cur, 0);
    PG8_STAGE(PG8_SB(0, 0), cB, voffB); PG8_STAGE(PG8_SB(0, 1), cB + hstepB, voffB); PG8_STAGE(PG8_SA(0, 0), cA, vA[0]); PG8_STAGE(PG8_SA(0, 1), cA, vA[1]);
    if (wr == 1) PG8_BAR;
    PG8_WAIT_V(2); PG8_BAR;
    PG8_STAGE(PG8_SB(1, 0), cB + kstep, voffB); PG8_STAGE(PG8_SA(1, 0), cA + kstep, vA[0]); PG8_STAGE(PG8_SB(1, 1), cB + hstepB + kstep, voffB);
    PG8_WAIT_V(6); PG8_BAR;
    for (;;) {
        const bool has_next = S.next(ui + 1, nxt);
        const unsigned nA = has_next ? __builtin_amdgcn_readfirstlane(nxt.a) : cA, nB = has_next ? __builtin_amdgcn_readfirstlane(nxt.b) : cB;
        if (has_next) PG8_SIDE(nxt, (ui + 1) & 1);
        if constexpr (Sched::GATHER && !Sched::SIDE) {
            if (has_next) { PG8_RC(); S.aoff(nxt, Rr, Cc, nvA); }
            else { nvA[0][0] = vA[0][0]; nvA[0][1] = vA[0][1]; nvA[1][0] = vA[1][0]; nvA[1][1] = vA[1][1]; }
        }
#pragma unroll 1
        for (int t = 0; t < nt; t += 2) {
            const bool last = (t == nt - 2);
            const unsigned a1 = cA + (unsigned)(t + 1) * kstep;
            const unsigned a2 = last ? nA : cA + (unsigned)(t + 2) * kstep, b2 = last ? nB : cB + (unsigned)(t + 2) * kstep;
            const unsigned a3 = a2 + kstep, b3 = b2 + kstep;
            if constexpr (Sched::GATHER && Sched::SIDE) {
                if (last) { if (has_next) { PG8_RC(); const LAS int* tk = (const LAS int*)(lds + SIDE_OFF + ((ui + 1) & 1) * 2048);
#pragma unroll
                        for (int h = 0; h < 2; ++h)
#pragma unroll
                            for (int i = 0; i < 2; ++i) nvA[h][i] = S.tok_off(tk[h * 128 + Rr[i]], Cc[i]); }
                    else { nvA[0][0] = vA[0][0]; nvA[0][1] = vA[0][1]; nvA[1][0] = vA[1][0]; nvA[1][1] = vA[1][1]; } }
            }
            unsigned w0[2], w1[2];
            if constexpr (Sched::GATHER) { w0[0] = last ? nvA[0][0] : vA[0][0]; w0[1] = last ? nvA[0][1] : vA[0][1]; w1[0] = last ? nvA[1][0] : vA[1][0]; w1[1] = last ? nvA[1][1] : vA[1][1]; }
            else { w0[0] = vA[0][0]; w0[1] = vA[0][1]; w1[0] = vA[1][0]; w1[1] = vA[1][1]; }
            PG8_LDB(B0, 0, 0); PG8_LDB(B1, 0, 1); PG8_SCHED; PG8_LDA(At, 0, 0); PG8_STAGE(PG8_SA(1, 1), a1, vA[1]);
            PG8_WAIT_V(8); PG8_WAIT_L(0); PG8_BAR; PG8_MMA(0, 0, At, B0); PG8_MMA(0, 1, At, B1); PG8_BAR; PG8_SCHED;
            PG8_LDA(At, 0, 1); PG8_STAGE(PG8_SB(0, 0), b2, voffB); PG8_STAGE(PG8_SB(0, 1), b2 + hstepB, voffB); PG8_STAGE(PG8_SA(0, 0), a2, w0);
            PG8_WAIT_V(8); PG8_WAIT_L(0); PG8_BAR; PG8_MMA(1, 0, At, B0); PG8_MMA(1, 1, At, B1); PG8_BAR; PG8_SCHED;
            PG8_LDB(B0, 1, 0); PG8_LDB(B1, 1, 1); PG8_SCHED; PG8_LDA(At, 1, 0); PG8_STAGE(PG8_SA(0, 1), a2, w1);
            PG8_WAIT_V(8); PG8_WAIT_L(0); PG8_BAR; PG8_MMA(0, 0, At, B0); PG8_MMA(0, 1, At, B1); PG8_BAR; PG8_SCHED;
            PG8_LDA(At, 1, 1); PG8_STAGE(PG8_SB(1, 0), b3, voffB); PG8_STAGE(PG8_SB(1, 1), b3 + hstepB, voffB); PG8_STAGE(PG8_SA(1, 0), a3, w0);
            PG8_WAIT_V(8); PG8_WAIT_L(0); PG8_BAR; PG8_MMA(1, 0, At, B0); PG8_MMA(1, 1, At, B1); PG8_BAR; PG8_SCHED;
        }
        if (wr == 0) PG8_BAR;
        if constexpr (Epi::FP8) asm volatile("s_nop 15\n\ts_nop 7" ::: "memory");
        { int fr_ = fr, fq_ = fq; asm volatile("" : "+v"(fr_), "+v"(fq_)); E(acc, cur, wr, wc, fr_, fq_, (const LAS float*)(lds + SIDE_OFF + (ui & 1) * 2048 + 1024)); }
        if constexpr (Sched::XSYNC) {
            if (tid == 0) { (void)xb_add(S.xw, 1u); const unsigned tgt = (unsigned)(ui + 1) * S.nloc; unsigned sp = 0;
                while (xb_ld(S.xw) < tgt && ++sp < (1u << 16)) __builtin_amdgcn_s_sleep(1);
                if (!has_next && S.rounds > ui + 1) (void)xb_add(S.xw, (unsigned)(S.rounds - (ui + 1))); }
        }
        if constexpr (Sched::XSYNC || Sched::SIDE) PG8_BAR;
        if (!has_next) break;
#pragma unroll
        for (int a = 0; a < 2; ++a)
#pragma unroll
            for (int b = 0; b < 2; ++b)
#pragma unroll
                for (int m = 0; m < 4; ++m)
#pragma unroll
                    for (int n = 0; n < 2; ++n) acc[a][b][m][n] = (f32x4){0.f, 0.f, 0.f, 0.f};
        cur = nxt; cA = nA; cB = nB; ++ui;
        if constexpr (Sched::GATHER) { vA[0][0] = nvA[0][0]; vA[0][1] = nvA[0][1]; vA[1][0] = nvA[1][0]; vA[1][1] = nvA[1][1]; }
        if (wr == 1) PG8_BAR;
    }
    PG8_WAIT_V(0);
    PG8_BAR;
#undef PG8_RC
#undef PG8_SIDE
#undef PG8_SA
#undef PG8_SB
#undef PG8_STAGE
#undef PG8_LDA
#undef PG8_LDB
#undef PG8_MMA
#undef PG8_WAIT_V
#undef PG8_WAIT_L
#undef PG8_BAR
#undef PG8_SCHED
}
}
using pg8::GU;

struct Args { const float* in[32]; float* out; unsigned char* ws; int ph_lo, ph_hi; };
struct Frame {
    LAS unsigned char* lds;
    LAS unsigned char* scr;
    unsigned char* ws;
    int tid, lane, wave, G, vcu;
};
enum { I_X = 0, I_C, I_CTX, I_CCTX, I_NORMG, I_ADAW, I_ADAB, I_POOLW, I_POOLLS, I_MU, I_WRKV, I_W0, I_W1, I_W2, I_A0, I_A1, I_A2, I_G1, I_G2, I_KK, I_KA, I_RK, I_LNG, I_LNB, I_WO,
       I_RW, I_RB, I_WGU, I_BGU, I_WDN, I_BDN, I_FINALG };

__device__ __forceinline__ const float* modp(const Frame& F, int layer, int row, int k) { return (const float*)(F.ws + WS_MOD) + ((size_t)(layer * 3 + row) * NMOD + k) * D; }
__device__ __forceinline__ int mrow_of(int n) { return n < NL ? (n >> 14) : 2; }

__device__ __forceinline__ void transpose_tile(const float* W, int ldw, int k0, int n0, bf16_t* WT, size_t dst_row0, int ldk, int kdst0, LAS float* scr, int lane) {
    const int c4 = lane & 15, kr = lane >> 4;
#pragma unroll 4
    for (int it = 0; it < 16; ++it) { const int kk = 4 * it + kr; const f32x4 v = *(const GAS f32x4*)(W + (size_t)(k0 + kk) * ldw + n0 + 4 * c4);
        LAS float* s = scr + kk * 65 + 4 * c4; s[0] = v[0]; s[1] = v[1]; s[2] = v[2]; s[3] = v[3]; }
    LDS_WAIT(); asm volatile("" ::: "memory");
    const int c = lane & 7;
#pragma unroll
    for (int j = 0; j < 8; ++j) { const int n = (lane >> 3) + 8 * j; const LAS float* s = scr + (8 * c) * 65 + n;
        u32x4 o; o.x = cvt_pk_bf16(s[0 * 65], s[1 * 65]); o.y = cvt_pk_bf16(s[2 * 65], s[3 * 65]); o.z = cvt_pk_bf16(s[4 * 65], s[5 * 65]); o.w = cvt_pk_bf16(s[6 * 65], s[7 * 65]);
        *(GAS u32x4*)(WT + (dst_row0 + n) * (size_t)ldk + kdst0 + k0 + 8 * c) = o; }
    LDS_WAIT(); asm volatile("" ::: "memory");
}

__device__ __forceinline__ unsigned pk4_fp8(float a, float b, float c, float d) { int w = 0; w = __builtin_amdgcn_cvt_pk_fp8_f32(a, b, w, false); w = __builtin_amdgcn_cvt_pk_fp8_f32(c, d, w, true); return (unsigned)w; }
__device__ __forceinline__ void transpose_tile_fp8(const float* W, int ldw, int k0, int n0, unsigned char* WT, size_t dst_row0, int ldk, float scale, LAS float* scr, int lane) {
    const int c4 = lane & 15, kr = lane >> 4;
#pragma unroll 4
    for (int it = 0; it < 16; ++it) { const int kk = 4 * it + kr; const f32x4 v = *(const GAS f32x4*)(W + (size_t)(k0 + kk) * ldw + n0 + 4 * c4);
        LAS float* s = scr + kk * 65 + 4 * c4; s[0] = v[0] * scale; s[1] = v[1] * scale; s[2] = v[2] * scale; s[3] = v[3] * scale; }
    LDS_WAIT(); asm volatile("" ::: "memory");
    const int c = lane & 3;
#pragma unroll
    for (int j = 0; j < 4; ++j) { const int n = (lane >> 2) + 16 * j; const LAS float* s = scr + (16 * c) * 65 + n;
        u32x4 o; o.x = pk4_fp8(s[0 * 65], s[1 * 65], s[2 * 65], s[3 * 65]); o.y = pk4_fp8(s[4 * 65], s[5 * 65], s[6 * 65], s[7 * 65]);
        o.z = pk4_fp8(s[8 * 65], s[9 * 65], s[10 * 65], s[11 * 65]); o.w = pk4_fp8(s[12 * 65], s[13 * 65], s[14 * 65], s[15 * 65]);
        *(GAS u32x4*)(WT + (dst_row0 + n) * (size_t)ldk + k0 + 16 * c) = o; }
    LDS_WAIT(); asm volatile("" ::: "memory");
}
__device__ __forceinline__ void transpose_tile_fp8_k128(const float* W, int ldw, int k0, int n0, unsigned char* WT, size_t dst_row0, int ldk, float scale, LAS float* scr, int lane) {
    const int c4 = lane & 7, kr = lane >> 3;
#pragma unroll 4
    for (int it = 0; it < 16; ++it) { const int kk = 8 * it + kr; const f32x4 v = *(const GAS f32x4*)(W + (size_t)(k0 + kk) * ldw + n0 + 4 * c4);
        LAS float* s = scr + kk * 33 + 4 * c4; s[0] = v[0] * scale; s[1] = v[1] * scale; s[2] = v[2] * scale; s[3] = v[3] * scale; }
    LDS_WAIT(); asm volatile("" ::: "memory");
    const int c = lane & 7;
#pragma unroll
    for (int j = 0; j < 4; ++j) { const int n = (lane >> 3) + 8 * j; const LAS float* s = scr + (16 * c) * 33 + n;
        u32x4 o; o.x = pk4_fp8(s[0 * 33], s[1 * 33], s[2 * 33], s[3 * 33]); o.y = pk4_fp8(s[4 * 33], s[5 * 33], s[6 * 33], s[7 * 33]);
        o.z = pk4_fp8(s[8 * 33], s[9 * 33], s[10 * 33], s[11 * 33]); o.w = pk4_fp8(s[12 * 33], s[13 * 33], s[14 * 33], s[15 * 33]);
        *(GAS u32x4*)(WT + (dst_row0 + n) * (size_t)ldk + k0 + 16 * c) = o; }
    LDS_WAIT(); asm volatile("" ::: "memory");
}
__device__ __forceinline__ void phase_prep(const Frame& F, const Args& A) {
    unsigned char* ws = F.ws;
    for (int u = blockIdx.x; u < 256; u += F.G) {
        const int l = u >> 7, cc = u & 127, c4 = F.tid % 12, kq = F.tid / 12;
        f32x4 a0 = {0, 0, 0, 0}, a1 = {0, 0, 0, 0}, a2 = {0, 0, 0, 0};
        if (kq < 42) { const float* w = A.in[I_ADAW] + (size_t)l * D * (NMOD * D) + cc * 48 + 4 * c4;
            for (int k = kq; k < D; k += 42) { const f32x4 wv = *(const GAS f32x4*)(w + (size_t)k * (NMOD * D));
                float c0 = A.in[I_C][k], c1 = A.in[I_C][D + k], c2 = A.in[I_CCTX][k];
                c0 = c0 * sigmoidf_(c0); c1 = c1 * sigmoidf_(c1); c2 = c2 * sigmoidf_(c2);
                a0 += wv * c0; a1 += wv * c1; a2 += wv * c2; }
            LAS f32x4* red = (LAS f32x4*)F.scr;
            red[(kq * 3 + 0) * 12 + c4] = a0; red[(kq * 3 + 1) * 12 + c4] = a1; red[(kq * 3 + 2) * 12 + c4] = a2; }
        __syncthreads();
        if (F.tid < 144) { const int r = F.tid / 48, c = F.tid % 48; float sum = 0.f;
            for (int q = 0; q < 42; ++q) sum += ((LAS float*)F.scr)[((q * 3 + r) * 12) * 4 + c];
            const int col = cc * 48 + c;
            ((float*)(ws + WS_MOD))[(size_t)(l * 3 + r) * (NMOD * D) + col] = sum + A.in[I_ADAB][(size_t)l * NMOD * D + col]; }
        __syncthreads();
    }
    { bf16_t* w2p = (bf16_t*)(ws + WS_WL2);
      for (int i = blockIdx.x * NTHREADS + F.tid; i < 4 * 1024 * 8; i += F.G * NTHREADS) { const int o = i / 8192, c = (i / 8) % 1024, q = i % 8, d = o & 1;
          *(GAS u32x4*)(w2p + ((size_t)o * 1024 + c) * 128 + (1 - d) * 64 + q * 8) = (u32x4){0u, 0u, 0u, 0u}; } }
    LAS float* scr = (LAS float*)(F.scr) + F.wave * (128 * 33 + 31);
    const int gw = F.vcu * NWAVES + F.wave, NGW = F.G * NWAVES;
    constexpr int T_GU = 2 * NE * 16 * 32, T_DN = 2 * NE * 16 * 16, T_RKV = 3 * 256, T_WO = 256, T_L1 = 2 * 16 + 2 * 16 + 32, T_L2 = 2 * 16 + 2 * 16 + 2 * 16, T_PW = 4 * 16;
    constexpr int T_ALL = T_GU + T_DN + T_RKV + T_WO + T_L1 + T_L2 + T_PW;
    for (int it = gw; it < T_ALL; it += NGW) {
        int r = it;
        if (r < T_GU) { const int le = r / 512, q = r % 512, kb = q / 64, nb = q % 64; const int n0 = nb * 32;
            const int drow = (n0 < 1024) ? ((n0 >> 7) * 256 + (n0 & 127)) : (((n0 - 1024) >> 7) * 256 + 128 + ((n0 - 1024) & 127));
            transpose_tile_fp8_k128(A.in[I_WGU] + (size_t)le * 1024 * 2048, 2048, kb * 128, n0, ws + WS_WGU, (size_t)le * 2048 + drow, 1024, 32.0f, scr, F.lane); continue; } r -= T_GU;
        if (r < T_DN) { const int le = r / 256, q = r % 256, kb = q / 32, nb = q % 32;
            transpose_tile_fp8_k128(A.in[I_WDN] + (size_t)le * 1024 * 1024, 1024, kb * 128, nb * 32, ws + WS_WDN, (size_t)le * 1024 + nb * 32, 1024, 32.0f, scr, F.lane); continue; } r -= T_DN;
        if (r < T_RKV) { const int p = r / 256, q = r % 256, kb = q / 16, nb = q % 16;
            transpose_tile_fp8(A.in[I_WRKV] + (size_t)p * 1024 * 1024, 1024, kb * 64, nb * 64, ws + WS_WRKV, (size_t)p * 1024 + nb * 64, 1024, 32.0f, scr, F.lane); continue; } r -= T_RKV;
        if (r < T_WO) { const int kb = r / 16, nb = r % 16;
            transpose_tile(A.in[I_WO], 1024, kb * 64, nb * 64, (bf16_t*)(ws + WS_WO), (size_t)nb * 64, 1024, 0, scr, F.lane); continue; } r -= T_WO;
        if (r < T_L1) {
            if (r < 32) { const int d = r / 16, kb = r % 16; transpose_tile_fp8(A.in[I_W1] + (size_t)d * 1024 * 64, 64, kb * 64, 0, ws + WS_WL1, (size_t)0 * 256 + d * 64, 1024, 32.0f, scr, F.lane); continue; }
            r -= 32;
            if (r < 32) { const int d = r / 16, kb = r % 16; transpose_tile_fp8(A.in[I_A1] + (size_t)d * 1024 * 64, 64, kb * 64, 0, ws + WS_WL1, (size_t)1 * 256 + d * 64, 1024, 32.0f, scr, F.lane); continue; }
            r -= 32;
            { const int kb = r / 2, nb = r % 2; transpose_tile_fp8(A.in[I_G1], 128, kb * 64, nb * 64, ws + WS_WL1, (size_t)2 * 256 + nb * 64, 1024, 32.0f, scr, F.lane); continue; }
        } r -= T_L1;
        if (r < T_L2) {
            if (r < 32) { const int d = r / 16, nb = r % 16; transpose_tile(A.in[I_W2] + (size_t)d * 64 * 1024, 1024, 0, nb * 64, (bf16_t*)(ws + WS_WL2), (size_t)d * 1024 + nb * 64, 128, d * 64, scr, F.lane); continue; }
            r -= 32;
            if (r < 32) { const int d = r / 16, nb = r % 16; transpose_tile(A.in[I_A2] + (size_t)d * 64 * 1024, 1024, 0, nb * 64, (bf16_t*)(ws + WS_WL2), (size_t)(2 + d) * 1024 + nb * 64, 128, d * 64, scr, F.lane); continue; }
            r -= 32;
            { const int kb = r / 16, nb = r % 16; transpose_tile(A.in[I_G2], 1024, kb * 64, nb * 64, (bf16_t*)(ws + WS_WL2), (size_t)4 * 1024 + nb * 64, 128, 0, scr, F.lane); continue; }
        } r -= T_L2;
        { const int g = r / 16, q = r % 16, kb = q / 4, nb = q % 4;
          transpose_tile(A.in[I_POOLW] + (size_t)g * 256 * 256, 256, kb * 64, nb * 64, (bf16_t*)(ws + WS_WPOOL), (size_t)g * 256 + nb * 64, 256, 0, scr, F.lane); }
    }
}

__device__ __forceinline__ void phase_pre0(const Frame& F, const Args& A) {
    LAS float* hb = (LAS float*)F.scr;
    LAS float* rs = hb + 80 * 258;
    LAS float* gsc = rs + 80;
    LAS float* gsh = gsc + 256;
    bf16_t* dbuf = (bf16_t*)(F.ws + WS_DBUF);
    const float* ng = A.in[I_NORMG];
    for (int u = blockIdx.x; u < 520; u += F.G) {
        int tok0, nown = 64, hl = 0, hr = 0, L, pos0, row; const float* xsrc;
        if (u < 512) { tok0 = u * 64; L = 64; pos0 = 0; row = tok0 >> 14; xsrc = A.in[I_X] + (size_t)tok0 * D; }
        else { const int b = (u - 512) >> 2, q = (u - 512) & 3; tok0 = NL + b * CT + q * 64; L = CT; pos0 = q * 64; hl = q > 0 ? 8 : 0; hr = q < 3 ? 8 : 0; row = 2;
               xsrc = A.in[I_CTX] + (size_t)(b * CT + q * 64) * D; }
        const int nt = nown + hl + hr;
        for (int j = F.wave; j < nt; j += NWAVES) { const float* xr = xsrc + (ptrdiff_t)(j - hl) * D; float s = 0.f;
#pragma unroll
            for (int q = 0; q < 4; ++q) { const f32x4 v = *(const GAS f32x4*)(xr + 4 * F.lane + 256 * q); s += v[0] * v[0] + v[1] * v[1] + v[2] * v[2] + v[3] * v[3]; }
            s = wave_sum(s); if (F.lane == 0) rs[j] = 1.0f / sqrtf(s * (1.0f / D) + NORM_EPS); }
        for (int g = 0; g < 4; ++g) {
            __syncthreads();
            if (F.tid < 256) { const int c = g * 256 + F.tid; gsc[F.tid] = ng[c] * (1.0f + modp(F, 0, row, 1)[c]); gsh[F.tid] = modp(F, 0, row, 0)[c]; }
            __syncthreads();
            for (int i = F.tid; i < nt * 64; i += NTHREADS) { const int j = i >> 6, c4 = i & 63; const f32x4 v = *(const GAS f32x4*)(xsrc + (ptrdiff_t)(j - hl) * D + g * 256 + 4 * c4);
                const float r = rs[j]; LAS float* h = hb + j * 258 + 4 * c4;
                h[0] = v[0] * r * gsc[4 * c4 + 0] + gsh[4 * c4 + 0]; h[1] = v[1] * r * gsc[4 * c4 + 1] + gsh[4 * c4 + 1];
                h[2] = v[2] * r * gsc[4 * c4 + 2] + gsh[4 * c4 + 2]; h[3] = v[3] * r * gsc[4 * c4 + 3] + gsh[4 * c4 + 3]; }
            __syncthreads();
            const int win = 2 << g, hw = win >> 1;
            for (int i = F.tid; i < 64 * 128; i += NTHREADS) { const int cp = i & 127, t = i >> 7; const int p = pos0 + t;
                int lo = p - hw, hi = p + hw - 1; lo = lo < 0 ? 0 : lo; hi = hi > L - 1 ? L - 1 : hi;
                const int jlo = lo - (pos0 - hl), jhi = hi - (pos0 - hl);
                float s0 = 0.f, s1 = 0.f;
                for (int j = jlo; j <= jhi; ++j) { const f32x2 v = *(const LAS f32x2*)(hb + j * 258 + 2 * cp); s0 += v[0]; s1 += v[1]; }
                const float ic = 1.0f / (float)(hi - lo + 1); const f32x2 hv = *(const LAS f32x2*)(hb + (t + hl) * 258 + 2 * cp);
                *(GAS unsigned*)(dbuf + (size_t)(tok0 + t) * D + g * 256 + 2 * cp) = cvt_pk_bf16(s0 * ic - hv[0], s1 * ic - hv[1]); }
        }
        __syncthreads();
    }
}

struct SchedPool {
    static constexpr bool SIDE = false; static constexpr bool XSYNC = false; static constexpr bool GATHER = false;
    int G, vcu; int nt; unsigned ldb;
    __device__ __forceinline__ bool next(int i, GU& u) const { const int L = i * G + vcu; if (L >= 130 * 4) return false; const int pm = L >> 2, g = L & 3;
        u.a = (unsigned)(WS_DBUF + ((size_t)pm * 256 * D + g * 256) * 2); u.b = (unsigned)(WS_WPOOL + (size_t)g * 256 * 256 * 2); u.i0 = pm; u.i1 = g; u.i2 = 0; u.i3 = 0; return true; }
    __device__ __forceinline__ void aoff(const GU&, const int (&R)[2], const int (&C)[2], unsigned (&v)[2][2]) const {
#pragma unroll
        for (int h = 0; h < 2; ++h)
#pragma unroll
            for (int i = 0; i < 2; ++i) v[h][i] = (unsigned)((h * 128 + R[i]) * D + C[i]) * 2u; }
};
struct EpiPool {
    static constexpr bool FP8 = false; static constexpr bool PERM = false;
    const float* x; const float* ctx; const float* ls; const float* gate_base; float* xs;
    __device__ __forceinline__ void operator()(const f32x4 (&acc)[2][2][4][2], const GU& u, int wr, int wc, int fr, int fq, const LAS float* sb) const {
        const int pm = u.i0, g = u.i1; const int mrow = pm < 128 ? (pm >> 6) : 2;
        const float* gate = gate_base + (size_t)mrow * NMOD * D;
        const float* src = pm < 128 ? x + (size_t)pm * 256 * D : ctx + (size_t)(pm - 128) * 256 * D;
        const int col0 = g * 256 + wc * 32 + 4 * fq;
        f32x4 gl[2][2];
#pragma unroll
        for (int bj = 0; bj < 2; ++bj)
#pragma unroll
            for (int n = 0; n < 2; ++n) { const int c = col0 + bj * 128 + n * 16; gl[bj][n] = *(const GAS f32x4*)(gate + c) * *(const GAS f32x4*)(ls + c); }
#pragma unroll
        for (int ai = 0; ai < 2; ++ai)
#pragma unroll
            for (int m = 0; m < 4; ++m) { const int r = ai * 128 + wr * 64 + m * 16 + fr; const float* sp = src + (size_t)r * D + col0; float* op = xs + ((size_t)pm * 256 + r) * D + col0;
#pragma unroll
                for (int bj = 0; bj < 2; ++bj)
#pragma unroll
                    for (int n = 0; n < 2; ++n) *(GAS f32x4*)(op + bj * 128 + n * 16) = *(const GAS f32x4*)(sp + bj * 128 + n * 16) + gl[bj][n] * acc[ai][bj][m][n]; }
    }
};

__device__ __forceinline__ void phase_final_plain(const Frame& F, const Args& A, const float* xs) {
    const int gw = blockIdx.x * NWAVES + F.wave, NGW = F.G * NWAVES;
    for (int n = gw; n < NL; n += NGW) { const float* xr = xs + (size_t)n * D; f32x4 v[4]; float s = 0.f;
#pragma unroll
        for (int q = 0; q < 4; ++q) { v[q] = *(const GAS f32x4*)(xr + 4 * F.lane + 256 * q); s += v[q][0] * v[q][0] + v[q][1] * v[q][1] + v[q][2] * v[q][2] + v[q][3] * v[q][3]; }
        s = wave_sum(s); const float r = 1.0f / sqrtf(s * (1.0f / D) + NORM_EPS);
#pragma unroll
        for (int q = 0; q < 4; ++q) { const f32x4 g = *(const GAS f32x4*)(A.in[I_FINALG] + 4 * F.lane + 256 * q); *(GAS f32x4*)(A.out + (size_t)n * D + 4 * F.lane + 256 * q) = v[q] * r * g; }
    }
}


__device__ __forceinline__ int* cnt_word(const Frame& F, int l, int e) { return (int*)(F.ws + WS_CTL + CTL_CNT) + (l * NE + e) * 64; }
__device__ __forceinline__ void phase_post(const Frame& F, const Args& A, int l, const float* xs, int ntok) {
    LAS float* h2s = (LAS float*)F.scr;
    LAS float* part = (LAS float*)F.scr;
    LAS float* lgs = (LAS float*)(F.scr + 32 * 1028 * 4);
    LAS int* hist = (LAS int*)(lgs + 32 * 33);
    LAS int* base = hist + 32;
    LAS int* sel = base + 32;
    LAS int* lrank = sel + 128;
    unsigned char* H2 = F.ws + WS_H2;
    int* list = (int*)(F.ws + WS_LIST) + (size_t)l * NE * NTOK;
    int* tinfo = (int*)(F.ws + WS_TINFO) + (size_t)l * NTOK * 4;
    float* tgate = (float*)(F.ws + WS_TGATE) + (size_t)l * NTOK * 4;
    const float* ng = A.in[I_NORMG] + (size_t)(l * 2 + 1) * D;
    const float* rw = A.in[I_RW] + (size_t)l * D * NE;
    const float* rb = A.in[I_RB] + (size_t)l * NE;
    const int ntiles = ntok / 32;
    for (int tile = blockIdx.x; tile < ntiles; tile += F.G) {
        const int n0 = tile * 32, mrow = mrow_of(n0);
        const float* sc = modp(F, l, mrow, 4); const float* sh = modp(F, l, mrow, 3);
        if (F.tid < 32) hist[F.tid] = 0;
#pragma unroll 1
        for (int q = 0; q < 4; ++q) { const int tt = F.wave * 4 + q, n = n0 + tt; const float* xr = xs + (size_t)n * D; f32x4 v[4]; float s = 0.f;
#pragma unroll
            for (int jj = 0; jj < 4; ++jj) { v[jj] = *(const GAS f32x4*)(xr + 4 * F.lane + 256 * jj); s += v[jj][0] * v[jj][0] + v[jj][1] * v[jj][1] + v[jj][2] * v[jj][2] + v[jj][3] * v[jj][3]; }
            s = wave_sum(s); const float r = 1.0f / sqrtf(s * (1.0f / D) + NORM_EPS);
#pragma unroll
            for (int jj = 0; jj < 4; ++jj) { const int c = 4 * F.lane + 256 * jj; const f32x4 g = *(const GAS f32x4*)(ng + c), a = *(const GAS f32x4*)(sc + c), b = *(const GAS f32x4*)(sh + c);
                const f32x4 h = v[jj] * r * g * (a + 1.0f) + b;
                *(LAS f32x4*)(h2s + tt * 1028 + c) = h;
                *(GAS unsigned*)(H2 + (size_t)n * D + c) = pk4_fp8(h[0], h[1], h[2], h[3]); } }
        __syncthreads();
        f32x16 acc;
#pragma unroll
        for (int i = 0; i < 16; ++i) acc[i] = 0.f;
        { const int r = F.lane & 31, h = F.lane >> 5;
#pragma unroll 4
          for (int q = 0; q < 16; ++q) { const int kb = 128 * F.wave + 8 * q + 4 * h; const f32x4 a = *(const LAS f32x4*)(h2s + r * 1028 + kb);
              const float b0 = rw[(size_t)(kb + 0) * NE + r], b1 = rw[(size_t)(kb + 1) * NE + r], b2 = rw[(size_t)(kb + 2) * NE + r], b3 = rw[(size_t)(kb + 3) * NE + r];
              acc = __builtin_amdgcn_mfma_f32_32x32x2f32(a[0], b0, acc, 0, 0, 0); acc = __builtin_amdgcn_mfma_f32_32x32x2f32(a[1], b1, acc, 0, 0, 0);
              acc = __builtin_amdgcn_mfma_f32_32x32x2f32(a[2], b2, acc, 0, 0, 0); acc = __builtin_amdgcn_mfma_f32_32x32x2f32(a[3], b3, acc, 0, 0, 0); } }
        __syncthreads();
#pragma unroll
        for (int i = 0; i < 16; ++i) { const int row = (i & 3) + 8 * (i >> 2) + 4 * (F.lane >> 5), col = F.lane & 31; part[(F.wave * 32 + row) * 32 + col] = acc[i]; }
        __syncthreads();
        for (int i = F.tid; i < 1024; i += NTHREADS) { const int row = i >> 5, col = i & 31; float s = rb[col];
#pragma unroll
            for (int w = 0; w < 8; ++w) s += part[(w * 32 + row) * 32 + col];
            lgs[row * 33 + col] = s; }
        __syncthreads();
        if (F.tid < 32) { const int t = F.tid; float lv[32];
#pragma unroll
            for (int e = 0; e < 32; ++e) lv[e] = lgs[t * 33 + e];
            float tv[4]; int te[4];
#pragma unroll
            for (int j = 0; j < 4; ++j) { float best = -3.0e38f; int be = 0;
#pragma unroll
                for (int e = 0; e < 32; ++e) { const bool gt = lv[e] > best; best = gt ? lv[e] : best; be = gt ? e : be; }
                tv[j] = best; te[j] = be;
#pragma unroll
                for (int e = 0; e < 32; ++e) lv[e] = (e == be) ? -3.0e38f : lv[e]; }
            const float e1 = __expf(tv[1] - tv[0]), e2 = __expf(tv[2] - tv[0]), e3 = __expf(tv[3] - tv[0]); const float inv = 1.0f / (1.0f + e1 + e2 + e3);
            const float gt[4] = {inv, e1 * inv, e2 * inv, e3 * inv};
#pragma unroll
            for (int j = 0; j < 4; ++j) { sel[t * 4 + j] = te[j]; lrank[t * 4 + j] = __hip_atomic_fetch_add(&hist[te[j]], 1, __ATOMIC_RELAXED, __HIP_MEMORY_SCOPE_WORKGROUP);
                tgate[(size_t)(n0 + t) * 4 + j] = gt[j]; } }
        __syncthreads();
        if (F.tid < 32) { const int c = hist[F.tid]; base[F.tid] = c > 0 ? __hip_atomic_fetch_add(cnt_word(F, l, F.tid), c, __ATOMIC_RELAXED, __HIP_MEMORY_SCOPE_AGENT) : 0; }
        __syncthreads();
        if (F.tid < 128) { const int t = F.tid >> 2, e = sel[F.tid], pos = base[e] + lrank[F.tid]; list[(size_t)e * NTOK + pos] = n0 + t; tinfo[(size_t)(n0 + t) * 4 + (F.tid & 3)] = (e << 16) | pos; }
        __syncthreads();
    }
}

__device__ __forceinline__ void moe_prefix(const Frame& F, int l) {
    volatile LAS int* M = (volatile LAS int*)(F.lds + MISC_OFF);
    __syncthreads();
    if (F.tid == 0) { int acc = 0; for (int e = 0; e < NE; ++e) { const int c = __hip_atomic_load(cnt_word(F, l, e), __ATOMIC_RELAXED, __HIP_MEMORY_SCOPE_AGENT); M[64 + e] = c; M[16 + e] = acc; acc += (c + 255) >> 8; } M[16 + NE] = acc; }
    __syncthreads();
    { volatile LAS unsigned char* T2E = (volatile LAS unsigned char*)(F.lds + MISC_OFF + 448);
      for (int t = F.tid; t < 560; t += NTHREADS) { int e = 0; while (e < NE - 1 && M[16 + e + 1] <= t) ++e; T2E[t] = (unsigned char)e; } }
    __syncthreads();
}

struct SchedMoe1 {
    static constexpr bool SIDE = true; static constexpr bool XSYNC = false; static constexpr bool GATHER = true;
    const LAS int* M; const int* list; unsigned h2; unsigned w; int G, vcu; int nt; unsigned ldb; unsigned* xw; unsigned nloc; int rounds; __amdgpu_buffer_rsrc_t rsrcb; unsigned listoff;
    __device__ __forceinline__ bool side_src(const GU& u, int tid, unsigned& off) const { const int e = u.i0, pn = u.i2;
        if (tid < 256) { const int row0 = (u.i1 - M[16 + e]) * 256, nv = M[64 + e] - row0; off = listoff + (unsigned)(e * NTOK + row0 + (tid < nv ? tid : 0)) * 4u; return false; }
        const int j = tid - 256; off = (unsigned)(e * 2048 + (j < 128 ? 0 : 1024) + pn * 128 + (j & 127)) * 4u; return true; }
    __device__ __forceinline__ unsigned tok_off(int tok, int c) const { return (unsigned)(tok * D + 2 * c); }
    __device__ __forceinline__ bool next(int i, GU& u) const { const int L = i * G + vcu; const int tt = M[16 + NE]; if (L >= tt * 8) return false; const int mt = L >> 3, pn = L & 7;
        const int e = ((const LAS unsigned char*)M)[448 + mt];
        u.a = h2; u.b = w + (unsigned)(((size_t)e * 2048 + pn * 256) * 1024); u.i0 = e; u.i1 = mt; u.i2 = pn; u.i3 = 0; return true; }
    __device__ __forceinline__ void aoff(const GU& u, const int (&R)[2], const int (&C)[2], unsigned (&v)[2][2]) const {
        const int e = u.i0, row0 = (u.i1 - M[16 + e]) * 256, nv = M[64 + e] - row0; const int* lp = list + (size_t)e * NTOK + row0;
#pragma unroll
        for (int h = 0; h < 2; ++h)
#pragma unroll
            for (int i = 0; i < 2; ++i) { const int r = h * 128 + R[i]; const int tok = lp[r < nv ? r : 0]; v[h][i] = (unsigned)(tok * D + 2 * C[i]); } }
};
struct EpiMoe1 {
    static constexpr bool FP8 = true; static constexpr bool PERM = true;
    const float* bgu; unsigned char* act;
    __device__ __forceinline__ void operator()(const f32x4 (&acc)[2][2][4][2], const GU& u, int wr, int wc, int fr, int fq, const LAS float* sb) const {
        const int e = u.i0, mt = u.i1, pn = u.i2; const int col0 = pn * 128 + wc * 32 + 8 * fq;
        f32x4 bg[2], bu[2];
#pragma unroll
        for (int n = 0; n < 2; ++n) { bg[n] = *(const LAS f32x4*)(sb + wc * 32 + 8 * fq + 4 * n); bu[n] = *(const LAS f32x4*)(sb + 128 + wc * 32 + 8 * fq + 4 * n); }
#pragma unroll
        for (int ai = 0; ai < 2; ++ai)
#pragma unroll
            for (int m = 0; m < 4; ++m) { const size_t slot = (size_t)mt * 256 + ai * 128 + wr * 64 + m * 16 + fr; float o[8];
#pragma unroll
                for (int n = 0; n < 2; ++n)
#pragma unroll
                    for (int j = 0; j < 4; ++j) { float g = acc[ai][0][m][n][j] + bg[n][j], up = acc[ai][1][m][n][j] + bu[n][j];
                        g = fminf(g, 7.0f); up = fminf(fmaxf(up, -7.0f), 7.0f); o[4 * n + j] = (up + 1.0f) * (g * __builtin_amdgcn_rcpf(1.0f + __expf(-1.702f * g))); }
                u32x2 w; w.x = pk4_fp8(o[0], o[1], o[2], o[3]); w.y = pk4_fp8(o[4], o[5], o[6], o[7]);
                *(GAS u32x2*)(act + slot * D + col0) = w; }
    }
};
struct SchedMoe2 {
    static constexpr bool SIDE = true; static constexpr bool XSYNC = false; static constexpr bool GATHER = false;
    const LAS int* M; unsigned act; unsigned w; int G, vcu; int nt; unsigned ldb; unsigned* xw; unsigned nloc; int rounds; __amdgpu_buffer_rsrc_t rsrcb;
    __device__ __forceinline__ bool side_src(const GU& u, int tid, unsigned& off) const { const int e = u.i0, pn = u.i2;
        if (tid < 256) { off = 0u; return false; }
        off = (unsigned)(e * D + pn * 256 + (tid - 256)) * 4u; return true; }
    __device__ __forceinline__ bool next(int i, GU& u) const { const int L = i * G + vcu; const int tt = M[16 + NE]; if (L >= tt * 4) return false; const int mt = L >> 2, pn = L & 3;
        const int e = ((const LAS unsigned char*)M)[448 + mt];
        u.a = act + (unsigned)((size_t)mt * 256 * D); u.b = w + (unsigned)(((size_t)e * 1024 + pn * 256) * 1024); u.i0 = e; u.i1 = mt; u.i2 = pn; u.i3 = 0; return true; }
    __device__ __forceinline__ void aoff(const GU&, const int (&R)[2], const int (&C)[2], unsigned (&v)[2][2]) const {
#pragma unroll
        for (int h = 0; h < 2; ++h)
#pragma unroll
            for (int i = 0; i < 2; ++i) v[h][i] = (unsigned)((h * 128 + R[i]) * D + 2 * C[i]); }
};
struct EpiMoe2 {
    static constexpr bool FP8 = true; static constexpr bool PERM = true;
    const float* bdn; bf16_t* y2;
    __device__ __forceinline__ void operator()(const f32x4 (&acc)[2][2][4][2], const GU& u, int wr, int wc, int fr, int fq, const LAS float* sb) const {
        const int e = u.i0, mt = u.i1, pn = u.i2; const int col0 = pn * 256 + wc * 32 + 8 * fq;
        f32x4 bv[2][2];
#pragma unroll
        for (int bj = 0; bj < 2; ++bj)
#pragma unroll
            for (int n = 0; n < 2; ++n) bv[bj][n] = *(const LAS f32x4*)(sb + bj * 128 + wc * 32 + 8 * fq + 4 * n);
#pragma unroll
        for (int ai = 0; ai < 2; ++ai)
#pragma unroll
            for (int m = 0; m < 4; ++m) { const size_t slot = (size_t)mt * 256 + ai * 128 + wr * 64 + m * 16 + fr;
#pragma unroll
                for (int bj = 0; bj < 2; ++bj) { const f32x4 v0 = acc[ai][bj][m][0] + bv[bj][0], v1 = acc[ai][bj][m][1] + bv[bj][1];
                    u32x4 w; w.x = cvt_pk_bf16(v0[0], v0[1]); w.y = cvt_pk_bf16(v0[2], v0[3]); w.z = cvt_pk_bf16(v1[0], v1[1]); w.w = cvt_pk_bf16(v1[2], v1[3]);
                    *(GAS u32x4*)(y2 + slot * D + col0 + bj * 128) = w; } }
    }
};
__device__ __forceinline__ void phase_moe1(const Frame& F, const Args& A, int l) {
    moe_prefix(F, l);
    SchedMoe1 S{(const LAS int*)(F.lds + MISC_OFF), (const int*)(F.ws + WS_LIST) + (size_t)l * NE * NTOK, (unsigned)WS_H2, (unsigned)(WS_WGU + (size_t)l * NE * 2048 * 1024), F.G, F.vcu, 8, 1024u,
                (unsigned*)(F.ws + WS_CTL + CTL_XSYNC) + ((l * 2 + 0) * 16 + xb_xcc_id()) * 32, ((volatile LAS unsigned*)(F.lds + MISC_OFF))[8], (((const LAS int*)(F.lds + MISC_OFF))[16 + NE] * 8 + F.G - 1) / F.G,
                __builtin_amdgcn_make_buffer_rsrc((void*)(A.in[I_BGU] + (size_t)l * NE * 2048), 0, NE * 2048 * 4, 0x00020000), (unsigned)(WS_LIST + (size_t)l * NE * NTOK * 4)};
    EpiMoe1 E{A.in[I_BGU] + (size_t)l * NE * 2048, F.ws + WS_ACT};
    pg8::gemm_phase<EpiMoe1, SchedMoe1>(F.scr, F.ws, S, E);
}
__device__ __forceinline__ void phase_moe2(const Frame& F, const Args& A, int l) {
    moe_prefix(F, l);
    SchedMoe2 S{(const LAS int*)(F.lds + MISC_OFF), (unsigned)WS_ACT, (unsigned)(WS_WDN + (size_t)l * NE * 1024 * 1024), F.G, F.vcu, 8, 1024u,
                (unsigned*)(F.ws + WS_CTL + CTL_XSYNC) + ((l * 2 + 1) * 16 + xb_xcc_id()) * 32, ((volatile LAS unsigned*)(F.lds + MISC_OFF))[8], (((const LAS int*)(F.lds + MISC_OFF))[16 + NE] * 4 + F.G - 1) / F.G,
                __builtin_amdgcn_make_buffer_rsrc((void*)(A.in[I_BDN] + (size_t)l * NE * D), 0, NE * D * 4, 0x00020000)};
    EpiMoe2 E{A.in[I_BDN] + (size_t)l * NE * D, (bf16_t*)(F.ws + WS_Y2)};
    pg8::gemm_phase<EpiMoe2, SchedMoe2>(F.scr, F.ws, S, E);
}
__device__ __forceinline__ void moe_combine_row(const Frame& F, int l, int n, f32x4 (&o)[4]) {
    const volatile LAS int* M = (const volatile LAS int*)(F.lds + MISC_OFF);
    const int* ti = (const int*)(F.ws + WS_TINFO) + ((size_t)l * NTOK + n) * 4; const float* tg = (const float*)(F.ws + WS_TGATE) + ((size_t)l * NTOK + n) * 4;
    const bf16_t* y2 = (const bf16_t*)(F.ws + WS_Y2);
#pragma unroll
    for (int q = 0; q < 4; ++q) o[q] = (f32x4){0.f, 0.f, 0.f, 0.f};
#pragma unroll
    for (int j = 0; j < 4; ++j) { const int inf = ti[j]; const float g = tg[j]; const int e = inf >> 16, pos = inf & 0xffff; const size_t slot = (size_t)M[16 + e] * 256 + pos;
#pragma unroll
        for (int q = 0; q < 4; ++q) { const u32x2 w = *(const GAS u32x2*)(y2 + slot * D + 4 * F.lane + 256 * q);
            o[q] += (f32x4){bf_lo(w.x), bf_hi(w.x), bf_lo(w.y), bf_hi(w.y)} * g; } }
}
__device__ __forceinline__ void phase_final(const Frame& F, const Args& A, int l, const float* xs) {
    moe_prefix(F, l);
    const int gw = blockIdx.x * NWAVES + F.wave, NGW = F.G * NWAVES;
    for (int n = gw; n < NL; n += NGW) { const float* xr = xs + (size_t)n * D; const float* gate = modp(F, l, n >> 14, 5); f32x4 v[4], mo[4]; float s = 0.f;
        moe_combine_row(F, l, n, mo);
#pragma unroll
        for (int q = 0; q < 4; ++q) { const int c = 4 * F.lane + 256 * q; v[q] = *(const GAS f32x4*)(xr + c) + *(const GAS f32x4*)(gate + c) * mo[q]; s += v[q][0] * v[q][0] + v[q][1] * v[q][1] + v[q][2] * v[q][2] + v[q][3] * v[q][3]; }
        s = wave_sum(s); const float r = 1.0f / sqrtf(s * (1.0f / D) + NORM_EPS);
#pragma unroll
        for (int q = 0; q < 4; ++q) { const f32x4 g = *(const GAS f32x4*)(A.in[I_FINALG] + 4 * F.lane + 256 * q); *(GAS f32x4*)(A.out + (size_t)n * D + 4 * F.lane + 256 * q) = v[q] * r * g; }
    }
}


__device__ __forceinline__ void phase_pre1(const Frame& F, const Args& A) {
    moe_prefix(F, 0);
    LAS float* hs = (LAS float*)F.scr;
    const float* xs0 = (const float*)(F.ws + WS_XS0); float* xs1 = (float*)(F.ws + WS_XS1);
    const float* ng = A.in[I_NORMG] + (size_t)(1 * 2 + 0) * D;
    for (int tile = blockIdx.x; tile < NTOK / 32; tile += F.G) {
        const int n0 = tile * 32, mrow = mrow_of(n0);
        const int sbeg = n0 < NL ? (n0 & ~(TSEQ - 1)) : (NL + ((n0 - NL) & ~(CT - 1))), send = sbeg + (n0 < NL ? TSEQ : CT);
        const float* gate5 = modp(F, 0, mrow, 5); const float* sc = modp(F, 1, mrow, 1); const float* sh = modp(F, 1, mrow, 0);
        for (int j = F.wave; j < 34; j += NWAVES) { const int n = n0 - 1 + j;
            if (n < sbeg || n >= send) {
#pragma unroll
                for (int q = 0; q < 4; ++q) *(LAS f32x4*)(hs + j * 1028 + 4 * F.lane + 256 * q) = (f32x4){0.f, 0.f, 0.f, 0.f};
                continue; }
            f32x4 mo[4], v[4]; float s = 0.f; moe_combine_row(F, 0, n, mo);
#pragma unroll
            for (int q = 0; q < 4; ++q) { const int c = 4 * F.lane + 256 * q; v[q] = *(const GAS f32x4*)(xs0 + (size_t)n * D + c) + *(const GAS f32x4*)(gate5 + c) * mo[q];
                s += v[q][0] * v[q][0] + v[q][1] * v[q][1] + v[q][2] * v[q][2] + v[q][3] * v[q][3]; }
            if (j >= 1 && j <= 32) {
#pragma unroll
                for (int q = 0; q < 4; ++q) *(GAS f32x4*)(xs1 + (size_t)n * D + 4 * F.lane + 256 * q) = v[q]; }
            s = wave_sum(s); const float r = 1.0f / sqrtf(s * (1.0f / D) + NORM_EPS);
#pragma unroll
            for (int q = 0; q < 4; ++q) { const int c = 4 * F.lane + 256 * q; const f32x4 g = *(const GAS f32x4*)(ng + c), a = *(const GAS f32x4*)(sc + c), b = *(const GAS f32x4*)(sh + c);
                *(LAS f32x4*)(hs + j * 1028 + c) = v[q] * r * g * (a + 1.0f) + b; } }
        __syncthreads();
#pragma unroll 1
        for (int q4 = 0; q4 < 4; ++q4) { const int t = F.wave * 4 + q4, j = t + 1, n = n0 + t;
#pragma unroll
            for (int q = 0; q < 4; ++q) { const int c = 4 * F.lane + 256 * q;
                const f32x4 hm = *(const LAS f32x4*)(hs + (j - 1) * 1028 + c), h0 = *(const LAS f32x4*)(hs + j * 1028 + c), hp = *(const LAS f32x4*)(hs + (j + 1) * 1028 + c);
                const f32x4 xx = (hm + hp) * 0.5f - h0;
#pragma unroll
                for (int i = 0; i < 6; ++i) { const f32x4 mu = *(const GAS f32x4*)(A.in[I_MU] + (size_t)i * D + c); const f32x4 o = h0 + xx * mu;
                    *(GAS unsigned*)(F.ws + WS_MIX + (size_t)i * NTOK * D + (size_t)n * D + c) = pk4_fp8(o[0], o[1], o[2], o[3]); } } }
        __syncthreads();
    }
}

struct SchedProj {
    static constexpr bool SIDE = false; static constexpr bool XSYNC = false; static constexpr bool GATHER = false;
    int G, vcu; int nt; unsigned ldb;
    __device__ __forceinline__ bool next(int i, GU& u) const { int L = i * G + vcu; if (L >= 1940) return false;
        int kind, mi, wi, pm, pn;
        if (L < 512) { kind = 0; mi = 0; wi = 0; pm = L >> 2; pn = L & 3; }
        else if (L < 1032) { L -= 512; kind = 0; mi = 2; wi = 1; pm = L >> 2; pn = L & 3; }
        else if (L < 1552) { L -= 1032; kind = 0; mi = 3; wi = 2; pm = L >> 2; pn = L & 3; }
        else if (L < 1682) { L -= 1552; kind = 1; mi = 1; wi = 0; pm = L; pn = 0; }
        else if (L < 1812) { L -= 1682; kind = 2; mi = 4; wi = 1; pm = L; pn = 0; }
        else { L -= 1812; kind = 3; mi = 5; wi = 2; pm = L; pn = 0; }
        u.a = (unsigned)(WS_MIX + (size_t)mi * NTOK * D + (size_t)pm * 256 * D);
        u.b = kind == 0 ? (unsigned)(WS_WRKV + ((size_t)wi * 1024 + pn * 256) * 1024) : (unsigned)(WS_WL1 + (size_t)wi * 256 * 1024);
        u.i0 = pm; u.i1 = pn; u.i2 = kind; u.i3 = wi; return true; }
    __device__ __forceinline__ void aoff(const GU&, const int (&R)[2], const int (&C)[2], unsigned (&v)[2][2]) const {
#pragma unroll
        for (int h = 0; h < 2; ++h)
#pragma unroll
            for (int i = 0; i < 2; ++i) v[h][i] = (unsigned)((h * 128 + R[i]) * D + 2 * C[i]); }
};
struct EpiProj {
    static constexpr bool FP8 = true; static constexpr bool PERM = true;
    unsigned char* ws;
    __device__ __forceinline__ void operator()(const f32x4 (&acc)[2][2][4][2], const GU& u, int wr, int wc, int fr, int fq, const LAS float* sb) const {
        const int pm = u.i0, pn = u.i1, kind = u.i2, wi = u.i3;
        if (kind == 0) { bf16_t* o = (bf16_t*)(ws + WS_RKV + (size_t)wi * ACTB); const int col0 = pn * 256 + wc * 32 + 8 * fq;
#pragma unroll
            for (int ai = 0; ai < 2; ++ai)
#pragma unroll
                for (int m = 0; m < 4; ++m) { const size_t n = (size_t)pm * 256 + ai * 128 + wr * 64 + m * 16 + fr;
#pragma unroll
                    for (int bj = 0; bj < 2; ++bj) { const f32x4 v0 = acc[ai][bj][m][0], v1 = acc[ai][bj][m][1];
                        u32x4 w; w.x = cvt_pk_bf16(v0[0], v0[1]); w.y = cvt_pk_bf16(v0[2], v0[3]); w.z = cvt_pk_bf16(v1[0], v1[1]); w.w = cvt_pk_bf16(v1[2], v1[3]);
                        *(GAS u32x4*)(o + n * D + col0 + bj * 128) = w; } }
        } else { bf16_t* o = (bf16_t*)(ws + WS_LACT + (size_t)(kind - 1) * NTOK * 128 * 2); const int col0 = wc * 32 + 8 * fq;
#pragma unroll
            for (int ai = 0; ai < 2; ++ai)
#pragma unroll
                for (int m = 0; m < 4; ++m) { const size_t n = (size_t)pm * 256 + ai * 128 + wr * 64 + m * 16 + fr; float t[8];
#pragma unroll
                    for (int nn = 0; nn < 2; ++nn)
#pragma unroll
                        for (int j = 0; j < 4; ++j) { const float x = acc[ai][0][m][nn][j]; t[4 * nn + j] = kind == 1 ? tanhf(x) : (kind == 2 ? x : sigmoidf_(x)); }
                    u32x4 w; w.x = cvt_pk_bf16(t[0], t[1]); w.y = cvt_pk_bf16(t[2], t[3]); w.z = cvt_pk_bf16(t[4], t[5]); w.w = cvt_pk_bf16(t[6], t[7]);
                    *(GAS u32x4*)(o + n * 128 + col0) = w; } }
    }
};
struct SchedLora2 {
    static constexpr bool SIDE = false; static constexpr bool XSYNC = false; static constexpr bool GATHER = false;
    int G, vcu; int nt; unsigned ldb;
    __device__ __forceinline__ bool next(int i, GU& u) const { int L = i * G + vcu; if (L >= 4 * 520 + 512) return false;
        const int o = L < 2080 ? L / 520 : 4; L -= o * 520; const int pm = L >> 2, pn = L & 3; const int oa = o < 4 ? (o >> 1) : 2;
        u.a = (unsigned)(WS_LACT + (size_t)oa * NTOK * 128 * 2 + (size_t)pm * 256 * 128 * 2); u.b = (unsigned)(WS_WL2 + ((size_t)o * 1024 + pn * 256) * 128 * 2);
        u.i0 = pm; u.i1 = pn; u.i2 = o; u.i3 = 0; return true; }
    __device__ __forceinline__ void aoff(const GU&, const int (&R)[2], const int (&C)[2], unsigned (&v)[2][2]) const {
#pragma unroll
        for (int h = 0; h < 2; ++h)
#pragma unroll
            for (int i = 0; i < 2; ++i) v[h][i] = (unsigned)((h * 128 + R[i]) * 128 + C[i]) * 2u; }
};
struct EpiLora2 {
    static constexpr bool FP8 = false; static constexpr bool PERM = false;
    unsigned char* ws; const float* w0; const float* a0;
    __device__ __forceinline__ void operator()(const f32x4 (&acc)[2][2][4][2], const GU& u, int wr, int wc, int fr, int fq, const LAS float* sb) const {
        const int pm = u.i0, pn = u.i1, o = u.i2; const int col0 = pn * 256 + wc * 32 + 4 * fq;
        const float* bp = (o < 2 ? w0 + (size_t)o * D : a0 + (size_t)(o & 1) * D) + col0; const float bsc = o < 4 ? 1.0f : 0.0f;
        f32x4 bv[2][2];
#pragma unroll
        for (int bj = 0; bj < 2; ++bj)
#pragma unroll
            for (int n = 0; n < 2; ++n) bv[bj][n] = *(const GAS f32x4*)(bp + bj * 128 + n * 16) * bsc;
        const size_t row0 = (size_t)pm * 256 + wr * 64 + fr;
        if (o < 2) { bf16_t* dst = (bf16_t*)(ws + WS_DEC + (size_t)o * ACTB) + row0 * D + col0;
#pragma unroll
            for (int ai = 0; ai < 2; ++ai)
#pragma unroll
                for (int m = 0; m < 4; ++m)
#pragma unroll
                    for (int bj = 0; bj < 2; ++bj)
#pragma unroll
                        for (int nn = 0; nn < 2; ++nn) { const f32x4 z = acc[ai][bj][m][nn] + bv[bj][nn]; f32x4 d;
#pragma unroll
                            for (int j = 0; j < 4; ++j) d[j] = -0.60653066f * sigmoidf_(z[j]);
                            u32x2 w; w.x = cvt_pk_bf16(d[0], d[1]); w.y = cvt_pk_bf16(d[2], d[3]);
                            *(GAS u32x2*)(dst + (size_t)(ai * 128 + m * 16) * D + bj * 128 + nn * 16) = w; }
        } else { bf16_t* dst = (o < 4 ? (bf16_t*)(ws + WS_ICL + (size_t)(o - 2) * ACTB) : (bf16_t*)(ws + WS_G)) + row0 * D + col0; const bool sg = o < 4;
#pragma unroll
            for (int ai = 0; ai < 2; ++ai)
#pragma unroll
                for (int m = 0; m < 4; ++m)
#pragma unroll
                    for (int bj = 0; bj < 2; ++bj)
#pragma unroll
                        for (int nn = 0; nn < 2; ++nn) { f32x4 z = acc[ai][bj][m][nn] + bv[bj][nn];
#pragma unroll
                            for (int j = 0; j < 4; ++j) z[j] = sg ? sigmoidf_(z[j]) : z[j];
                            u32x2 w; w.x = cvt_pk_bf16(z[0], z[1]); w.y = cvt_pk_bf16(z[2], z[3]);
                            *(GAS u32x2*)(dst + (size_t)(ai * 128 + m * 16) * D + bj * 128 + nn * 16) = w; }
        }
    }
};
__device__ __forceinline__ void ld16bf(const bf16_t* p, float (&o)[16]) { const u32x4 a = *(const GAS u32x4*)p, b = *(const GAS u32x4*)(p + 8);
    o[0] = bf_lo(a.x); o[1] = bf_hi(a.x); o[2] = bf_lo(a.y); o[3] = bf_hi(a.y); o[4] = bf_lo(a.z); o[5] = bf_hi(a.z); o[6] = bf_lo(a.w); o[7] = bf_hi(a.w);
    o[8] = bf_lo(b.x); o[9] = bf_hi(b.x); o[10] = bf_lo(b.y); o[11] = bf_hi(b.y); o[12] = bf_lo(b.z); o[13] = bf_hi(b.z); o[14] = bf_lo(b.w); o[15] = bf_hi(b.w); }
__device__ __forceinline__ void st16bf(bf16_t* p, const float (&o)[16]) { u32x4 a, b;
    a.x = cvt_pk_bf16(o[0], o[1]); a.y = cvt_pk_bf16(o[2], o[3]); a.z = cvt_pk_bf16(o[4], o[5]); a.w = cvt_pk_bf16(o[6], o[7]);
    b.x = cvt_pk_bf16(o[8], o[9]); b.y = cvt_pk_bf16(o[10], o[11]); b.z = cvt_pk_bf16(o[12], o[13]); b.w = cvt_pk_bf16(o[14], o[15]);
    *(GAS u32x4*)p = a; *(GAS u32x4*)(p + 8) = b; }
__device__ __forceinline__ void ld16f(const float* p, float (&o)[16]) {
#pragma unroll
    for (int q = 0; q < 4; ++q) { const f32x4 v = *(const GAS f32x4*)(p + 4 * q); o[4 * q] = v[0]; o[4 * q + 1] = v[1]; o[4 * q + 2] = v[2]; o[4 * q + 3] = v[3]; } }
__device__ __forceinline__ void phase_fin(const Frame& F, const Args& A) {
    const int gw = blockIdx.x * NWAVES + F.wave, NGW = F.G * NWAVES; const int c0 = 16 * F.lane;
    float kkw[16], kaw[16]; ld16f(A.in[I_KK] + c0, kkw); ld16f(A.in[I_KA] + c0, kaw);
    const bf16_t* Kp = (const bf16_t*)(F.ws + WS_RKV + 1 * ACTB);
    for (int n = gw; n < NTOK; n += NGW) { const size_t off = (size_t)n * D + c0; float k[16], i0[16], i1[16], kk[16], o[16];
        ld16bf(Kp + off, k); ld16bf((const bf16_t*)(F.ws + WS_ICL) + off, i0); ld16bf((const bf16_t*)(F.ws + WS_ICL + ACTB) + off, i1);
        float ss = 0.f;
#pragma unroll
        for (int j = 0; j < 16; ++j) { kk[j] = k[j] * kkw[j]; ss += kk[j] * kk[j]; }
        ss += __shfl_xor(ss, 1); ss += __shfl_xor(ss, 2);
        const float inv = 1.0f / fmaxf(sqrtf(ss), 1e-12f);
#pragma unroll
        for (int j = 0; j < 16; ++j) kk[j] *= inv;
        st16bf((bf16_t*)(F.ws + WS_KK) + off, kk);
#pragma unroll
        for (int j = 0; j < 16; ++j) o[j] = k[j] * (1.0f + (i0[j] - 1.0f) * kaw[j]);
        st16bf((bf16_t*)(F.ws + WS_KDIR) + off, o);
#pragma unroll
        for (int j = 0; j < 16; ++j) o[j] = k[j] * (1.0f + (i1[j] - 1.0f) * kaw[j]);
        st16bf((bf16_t*)(F.ws + WS_KDIR + ACTB) + off, o);
#pragma unroll
        for (int j = 0; j < 16; ++j) o[j] = kk[j] * i0[j];
        st16bf((bf16_t*)(F.ws + WS_BV) + off, o);
#pragma unroll
        for (int j = 0; j < 16; ++j) o[j] = kk[j] * i1[j];
        st16bf((bf16_t*)(F.ws + WS_BV + ACTB) + off, o);
    }
}
constexpr int CK = 32, SNS = CT + TSEQ, CNCH = SNS / CK;
constexpr int RS = 144, TS = 80;
constexpr int OS_A = 0, OS_R = 4608, OS_KT = 9216, OS_BT = 14336, OS_VT = 19456, OS_GAM = 20736, OS_BYTES = 20992;
constexpr int OG_B = 0, OG_K = 4608, OG_BYTES = 9216;
constexpr int GM_KA = 0, GM_KR = 2560, GM_BR = 5120, GM_TT = 7680, GM_BYTES = 10240;
constexpr int RAW_BYTES = 5 * 4096 + 1024;
constexpr int L_OS = 0, L_OG = 3 * OS_BYTES, L_GM = L_OG + 2 * OG_BYTES, L_TSCR = L_GM + 2 * GM_BYTES, L_SSCR = L_TSCR + 5120, L_RAW = L_SSCR + 4864, L_SCAN_END = L_RAW + 2 * RAW_BYTES;
static_assert(L_SCAN_END <= SCR_BYTES, "scan LDS");
__device__ __forceinline__ int scan_token(int sg, int d, int b) { if (sg < CT) { const int t = d ? (CT - 1 - sg) : sg; return NL + b * CT + t; } const int u = sg - CT; const int t = d ? (TSEQ - 1 - u) : u; return b * TSEQ + t; }
__device__ __forceinline__ unsigned short f2bf(float f) { return (unsigned short)(cvt_pk_bf16(f, 0.f) & 0xffffu); }
__device__ __forceinline__ int acc_row(int p, int lane) { return (p & 3) + 8 * (p >> 2) + 4 * (lane >> 5); }
__device__ __forceinline__ void st_acc32(LAS unsigned char* dst, const f32x16& a, int lane) {
#pragma unroll
    for (int p = 0; p < 16; ++p) *(LAS unsigned short*)(dst + acc_row(p, lane) * TS + 2 * (lane & 31)) = f2bf(a[p]);
}
__device__ __forceinline__ bf16x8 acc_bfrag(const f32x16& a, int s) { u32x4 w; w.x = cvt_pk_bf16(a[8 * s + 0], a[8 * s + 1]); w.y = cvt_pk_bf16(a[8 * s + 2], a[8 * s + 3]); w.z = cvt_pk_bf16(a[8 * s + 4], a[8 * s + 5]); w.w = cvt_pk_bf16(a[8 * s + 6], a[8 * s + 7]); return __builtin_bit_cast(bf16x8, w); }
__device__ __forceinline__ bf16x8 lds_afrag_perm(const LAS unsigned char* m, int s, int lane) { const LAS unsigned char* p = m + (lane & 31) * TS + 2 * (16 * s + 4 * (lane >> 5));
    const u32x2 lo = *(const LAS u32x2*)p, hi = *(const LAS u32x2*)(p + 16); u32x4 w; w.x = lo.x; w.y = lo.y; w.z = hi.x; w.w = hi.y; return __builtin_bit_cast(bf16x8, w); }
__device__ __forceinline__ f32x16 gram32(const LAS unsigned char* P, const LAS unsigned char* Q, int lane) {
    f32x16 c;
#pragma unroll
    for (int p = 0; p < 16; ++p) c[p] = 0.f;
#pragma unroll
    for (int s = 0; s < 4; ++s) { const bf16x8 a = *(const LAS bf16x8*)(P + (lane & 31) * RS + 32 * s + 16 * (lane >> 5)), b = *(const LAS bf16x8*)(Q + (lane & 31) * RS + 32 * s + 16 * (lane >> 5));
        c = __builtin_amdgcn_mfma_f32_32x32x16_bf16(a, b, c, 0, 0, 0); }
    return c;
}
__device__ __forceinline__ void phase_scan(const Frame& F, const Args& A) {
    LAS unsigned char* lds = F.scr;
    const int lane = F.lane, wave = F.wave;
    const __amdgpu_buffer_rsrc_t rsrc = __builtin_amdgcn_make_buffer_rsrc((void*)F.ws, 0, 0xffffffff, 0x00020000);
    for (int job = F.vcu; job < 256; job += F.G) {
        const int sd = job >> 2, rq = job & 3, d = sd & 1, bh = sd >> 1, b = bh >> 4, hd = bh & 15;
        f32x4 Xa[4];
#pragma unroll
        for (int t = 0; t < 4; ++t) Xa[t] = (f32x4){0.f, 0.f, 0.f, 0.f};
        const int pj = wave == 3 ? 0 : (wave == 4 ? 1 : (wave == 6 ? 2 : 3));
        const bool is_prep = wave == 3 || wave == 4 || wave == 6 || wave == 7;
#define SCAN_DMA(c) do { const int c_ = (c); LAS unsigned char* raw_ = lds + L_RAW + (c_ & 1) * RAW_BYTES; \
            _Pragma("unroll") for (int g = 0; g < 4; ++g) { const int row = 8 * g + (lane >> 3); const int sg = c_ * CK + row; const unsigned n = (unsigned)scan_token(sg, d, b); \
                const unsigned off = n * (unsigned)(D * 2) + (unsigned)(hd * 128 + (lane & 7) * 16); \
                __builtin_amdgcn_raw_ptr_buffer_load_lds(rsrc, (LAS void*)(raw_ + 0 * 4096 + g * 1024), 16, (int)(off + (unsigned)(WS_DEC + (size_t)d * ACTB)), 0, 0, 0); \
                __builtin_amdgcn_raw_ptr_buffer_load_lds(rsrc, (LAS void*)(raw_ + 1 * 4096 + g * 1024), 16, (int)(off + (unsigned)WS_KK), 0, 0, 0); \
                __builtin_amdgcn_raw_ptr_buffer_load_lds(rsrc, (LAS void*)(raw_ + 2 * 4096 + g * 1024), 16, (int)(off + (unsigned)(WS_BV + (size_t)d * ACTB)), 0, 0, 0); \
                __builtin_amdgcn_raw_ptr_buffer_load_lds(rsrc, (LAS void*)(raw_ + 3 * 4096 + g * 1024), 16, (int)(off + (unsigned)(WS_KDIR + (size_t)d * ACTB)), 0, 0, 0); \
                if (c_ >= CT / CK) __builtin_amdgcn_raw_ptr_buffer_load_lds(rsrc, (LAS void*)(raw_ + 4 * 4096 + g * 1024), 16, (int)(off + (unsigned)WS_RKV), 0, 0, 0); } \
            { const int row = lane >> 1; const unsigned n = (unsigned)scan_token(c_ * CK + row, d, b); \
              __builtin_amdgcn_raw_ptr_buffer_load_lds(rsrc, (LAS void*)(raw_ + 5 * 4096), 16, (int)(n * (unsigned)(D * 2) + (unsigned)(hd * 128 + rq * 32 + (lane & 1) * 16) + (unsigned)(WS_RKV + 2 * ACTB)), 0, 0, 0); } } while (0)
        __syncthreads();
        if (wave == 0) { for (int i = lane; i < 16 * RS / 4; i += 64) ((LAS unsigned*)(lds + L_SSCR))[i] = 0u; }
        if (wave == 5) { SCAN_DMA(0); SCAN_DMA(1); asm volatile("s_waitcnt vmcnt(0)" ::: "memory"); }
        __syncthreads();
        for (int it = -2; it < CNCH; ++it) {
            const int cs = it, cg = it + 1, cp = it + 2;
            if (is_prep) {
                if (cp < CNCH) {
                    const LAS unsigned char* raw = lds + L_RAW + (cp & 1) * RAW_BYTES;
                    LAS unsigned char* os = lds + L_OS + (cp % 3) * OS_BYTES; LAS unsigned char* og = lds + L_OG + (cp & 1) * OG_BYTES;
                    float Lpre = 0.f, Ltot = 0.f, lwv[8];
#pragma unroll
                    for (int m = 0; m < 32; ++m) { const float x = bf2f(*(const LAS unsigned short*)(raw + m * 128 + 2 * lane)); Ltot += x; if (m < 8 * pj) Lpre += x; if (m >= 8 * pj && m < 8 * pj + 8) lwv[m & 7] = x; }
                    const float gam = __expf(Ltot);
                    if (pj == 0) *(LAS float*)(os + OS_GAM + 4 * lane) = gam;
                    float Lr = Lpre, ep_prev = __expf(Lpre); float kt[8], bt[8]; const bool has_r = cp >= CT / CK;
#pragma unroll
                    for (int j = 0; j < 8; ++j) { const int m = 8 * pj + j; Lr += lwv[j];
                        const float ep = __expf(Lr), em = __builtin_amdgcn_rcpf(ep);
                        const float kk = bf2f(*(const LAS unsigned short*)(raw + 4096 + m * 128 + 2 * lane)), bb = bf2f(*(const LAS unsigned short*)(raw + 8192 + m * 128 + 2 * lane)),
                                    kd = bf2f(*(const LAS unsigned short*)(raw + 12288 + m * 128 + 2 * lane)), r = has_r ? bf2f(*(const LAS unsigned short*)(raw + 16384 + m * 128 + 2 * lane)) : 0.f;
                        const f32x2 ar = (f32x2){kk, r} * (f32x2){ep_prev, ep}, bk = (f32x2){bb, kd} * em, tb = (f32x2){bk[1], bk[0]} * (f32x2){gam, -gam};
                        const unsigned w1 = cvt_pk_bf16(ar[0], ar[1]), w2 = cvt_pk_bf16(bk[0], bk[1]);
                        *(LAS unsigned short*)(os + OS_A + m * RS + 2 * lane) = (unsigned short)(w1 & 0xffffu);
                        *(LAS unsigned short*)(os + OS_R + m * RS + 2 * lane) = (unsigned short)(w1 >> 16);
                        *(LAS unsigned short*)(og + OG_B + m * RS + 2 * lane) = (unsigned short)(w2 & 0xffffu);
                        *(LAS unsigned short*)(og + OG_K + m * RS + 2 * lane) = (unsigned short)(w2 >> 16);
                        kt[j] = tb[0]; bt[j] = tb[1]; ep_prev = ep; }
#pragma unroll
                    for (int g = 0; g < 2; ++g) { u32x2 w; w.x = cvt_pk_bf16(kt[4 * g], kt[4 * g + 1]); w.y = cvt_pk_bf16(kt[4 * g + 2], kt[4 * g + 3]);
                        *(LAS u32x2*)(os + OS_KT + lane * TS + 2 * (8 * pj + 4 * g)) = w;
                        w.x = cvt_pk_bf16(bt[4 * g], bt[4 * g + 1]); w.y = cvt_pk_bf16(bt[4 * g + 2], bt[4 * g + 3]);
                        *(LAS u32x2*)(os + OS_BT + lane * TS + 2 * (8 * pj + 4 * g)) = w; }
                }
            } else if (wave == 5) {
                if (cp + 1 < CNCH && it >= -1) SCAN_DMA(cp + 1);
                if (cp < CNCH) { const LAS unsigned char* raw = lds + L_RAW + (cp & 1) * RAW_BYTES; LAS unsigned char* os = lds + L_OS + (cp % 3) * OS_BYTES;
                    unsigned short rv[8];
#pragma unroll
                    for (int j = 0; j < 8; ++j) rv[j] = *(const LAS unsigned short*)(raw + 5 * 4096 + (8 * (lane >> 4) + j) * 32 + 2 * (lane & 15));
                    u32x4 w; w.x = (unsigned)rv[0] | ((unsigned)rv[1] << 16); w.y = (unsigned)rv[2] | ((unsigned)rv[3] << 16); w.z = (unsigned)rv[4] | ((unsigned)rv[5] << 16); w.w = (unsigned)rv[6] | ((unsigned)rv[7] << 16);
                    *(LAS u32x4*)(os + OS_VT + (lane & 15) * TS + 16 * (lane >> 4)) = w; }
                asm volatile("s_waitcnt vmcnt(0)" ::: "memory");
            } else if (wave == 2) {
                if (cg >= 0 && cg < CNCH) {
                    const LAS unsigned char* os = lds + L_OS + (cg % 3) * OS_BYTES; const LAS unsigned char* og = lds + L_OG + (cg & 1) * OG_BYTES; LAS unsigned char* gm = lds + L_GM + (cg & 1) * GM_BYTES;
                    f32x16 c = gram32(os + OS_A, og + OG_K, lane);
#pragma unroll
                    for (int p = 0; p < 16; ++p) c[p] = (lane & 31) < acc_row(p, lane) ? c[p] : 0.f;
                    st_acc32(gm + GM_KA, c, lane);
                    c = gram32(os + OS_R, og + OG_K, lane);
#pragma unroll
                    for (int p = 0; p < 16; ++p) c[p] = (lane & 31) <= acc_row(p, lane) ? c[p] : 0.f;
                    st_acc32(gm + GM_KR, c, lane);
                    c = gram32(os + OS_R, og + OG_B, lane);
#pragma unroll
                    for (int p = 0; p < 16; ++p) c[p] = (lane & 31) <= acc_row(p, lane) ? -c[p] : 0.f;
                    st_acc32(gm + GM_BR, c, lane);
                }
            } else if (wave == 1) {
                if (cg >= 0 && cg < CNCH) {
                    const LAS unsigned char* os = lds + L_OS + (cg % 3) * OS_BYTES; const LAS unsigned char* og = lds + L_OG + (cg & 1) * OG_BYTES; LAS unsigned char* gm = lds + L_GM + (cg & 1) * GM_BYTES;
                    f32x16 X = gram32(os + OS_A, og + OG_B, lane), Xt = gram32(og + OG_B, os + OS_A, lane), Rm;
#pragma unroll
                    for (int p = 0; p < 16; ++p) { const int row = acc_row(p, lane), col = lane & 31; X[p] = col < row ? -X[p] : 0.f; Xt[p] = row < col ? -Xt[p] : 0.f; Rm[p] = X[p] + (col == row ? 1.f : 0.f); }
#pragma unroll
                    for (int lev = 0; lev < 5; ++lev) {
                        const bf16x8 xt0 = acc_bfrag(Xt, 0), xt1 = acc_bfrag(Xt, 1);
                        if (lev >= 1) { const bf16x8 r0 = acc_bfrag(Rm, 0), r1 = acc_bfrag(Rm, 1);
                            Rm = __builtin_amdgcn_mfma_f32_32x32x16_bf16(xt0, r0, Rm, 0, 0, 0); Rm = __builtin_amdgcn_mfma_f32_32x32x16_bf16(xt1, r1, Rm, 0, 0, 0); }
                        if (lev < 4) { const bf16x8 x0 = acc_bfrag(X, 0), x1 = acc_bfrag(X, 1); f32x16 z, zt;
#pragma unroll
                            for (int p = 0; p < 16; ++p) { z[p] = 0.f; zt[p] = 0.f; }
                            z = __builtin_amdgcn_mfma_f32_32x32x16_bf16(xt0, x0, z, 0, 0, 0); zt = __builtin_amdgcn_mfma_f32_32x32x16_bf16(x0, xt0, zt, 0, 0, 0);
                            z = __builtin_amdgcn_mfma_f32_32x32x16_bf16(xt1, x1, z, 0, 0, 0); zt = __builtin_amdgcn_mfma_f32_32x32x16_bf16(x1, xt1, zt, 0, 0, 0);
                            X = z; Xt = zt; }
                    }
                    st_acc32(gm + GM_TT, Rm, lane);
                }
            } else {
                if (cs >= 0) {
                    const LAS unsigned char* os = lds + L_OS + (cs % 3) * OS_BYTES; const LAS unsigned char* gm = lds + L_GM + (cs & 1) * GM_BYTES;
                    LAS unsigned char* Xb = lds + L_SSCR; LAS unsigned char* Hb = lds + L_SSCR + 2304; LAS unsigned char* Ub = lds + L_SSCR + 2304 + 1280;
                    const int r16 = lane & 15, q = lane >> 4;
                    const bf16x8 xa0 = *(const LAS bf16x8*)(Xb + r16 * RS + 16 * q), xa1 = *(const LAS bf16x8*)(Xb + r16 * RS + 64 + 16 * q), va = *(const LAS bf16x8*)(os + OS_VT + r16 * TS + 16 * q);
                    f32x4 h[2];
#pragma unroll
                    for (int ti = 0; ti < 2; ++ti) { const int i = 16 * ti + r16; f32x4 c = {0.f, 0.f, 0.f, 0.f};
                        c = __builtin_amdgcn_mfma_f32_16x16x32_bf16(xa0, *(const LAS bf16x8*)(os + OS_A + i * RS + 16 * q), c, 0, 0, 0);
                        c = __builtin_amdgcn_mfma_f32_16x16x32_bf16(xa1, *(const LAS bf16x8*)(os + OS_A + i * RS + 64 + 16 * q), c, 0, 0, 0);
                        c = __builtin_amdgcn_mfma_f32_16x16x32_bf16(va, *(const LAS bf16x8*)(gm + GM_KA + i * TS + 16 * q), c, 0, 0, 0);
                        h[ti] = c; }
#pragma unroll
                    for (int ti = 0; ti < 2; ++ti)
#pragma unroll
                        for (int j = 0; j < 4; ++j) *(LAS unsigned short*)(Hb + (4 * q + j) * TS + 2 * (16 * ti + r16)) = f2bf(h[ti][j]);
                    LDS_WAIT();
                    const bf16x8 ha = *(const LAS bf16x8*)(Hb + r16 * TS + 16 * q);
                    f32x4 u[2];
#pragma unroll
                    for (int ti = 0; ti < 2; ++ti) { const int i = 16 * ti + r16; f32x4 c = {0.f, 0.f, 0.f, 0.f};
                        u[ti] = __builtin_amdgcn_mfma_f32_16x16x32_bf16(ha, *(const LAS bf16x8*)(gm + GM_TT + i * TS + 16 * q), c, 0, 0, 0); }
#pragma unroll
                    for (int ti = 0; ti < 2; ++ti)
#pragma unroll
                        for (int j = 0; j < 4; ++j) *(LAS unsigned short*)(Ub + (4 * q + j) * TS + 2 * (16 * ti + r16)) = f2bf(u[ti][j]);
                    LDS_WAIT();
                    const bf16x8 ua = *(const LAS bf16x8*)(Ub + r16 * TS + 16 * q);
#pragma unroll
                    for (int t = 0; t < 4; ++t) { const int k = 16 * t + r16; const float g = *(const LAS float*)(os + OS_GAM + 4 * k); f32x4 c = Xa[t] * g;
                        c = __builtin_amdgcn_mfma_f32_16x16x32_bf16(va, *(const LAS bf16x8*)(os + OS_KT + k * TS + 16 * q), c, 0, 0, 0);
                        c = __builtin_amdgcn_mfma_f32_16x16x32_bf16(ua, *(const LAS bf16x8*)(os + OS_BT + k * TS + 16 * q), c, 0, 0, 0);
                        Xa[t] = c; }
                    if (cs >= CT / CK) {
#pragma unroll
                        for (int ti = 0; ti < 2; ++ti) { const int i = 16 * ti + r16; f32x4 c = {0.f, 0.f, 0.f, 0.f};
                            c = __builtin_amdgcn_mfma_f32_16x16x32_bf16(xa0, *(const LAS bf16x8*)(os + OS_R + i * RS + 16 * q), c, 0, 0, 0);
                            c = __builtin_amdgcn_mfma_f32_16x16x32_bf16(xa1, *(const LAS bf16x8*)(os + OS_R + i * RS + 64 + 16 * q), c, 0, 0, 0);
                            c = __builtin_amdgcn_mfma_f32_16x16x32_bf16(va, *(const LAS bf16x8*)(gm + GM_KR + i * TS + 16 * q), c, 0, 0, 0);
                            c = __builtin_amdgcn_mfma_f32_16x16x32_bf16(ua, *(const LAS bf16x8*)(gm + GM_BR + i * TS + 16 * q), c, 0, 0, 0);
                            const int n = scan_token(cs * CK + i, d, b);
                            u32x2 w; w.x = cvt_pk_bf16(c[0], c[1]); w.y = cvt_pk_bf16(c[2], c[3]);
                            *(GAS u32x2*)((bf16_t*)(F.ws + WS_YD + (size_t)d * NL * D * 2) + (size_t)n * D + hd * 64 + rq * 16 + 4 * q) = w; }
                    }
#pragma unroll
                    for (int t = 0; t < 4; ++t)
#pragma unroll
                        for (int j = 0; j < 4; ++j) *(LAS unsigned short*)(Xb + (4 * q + j) * RS + 2 * (16 * t + r16)) = f2bf(Xa[t][j]);
                }
            }
            __syncthreads();
        }
#undef SCAN_DMA
    }
}
__device__ __forceinline__ void phase_readout(const Frame& F, const Args& A) {
    const int gw = blockIdx.x * NWAVES + F.wave, NGW = F.G * NWAVES; const int c0 = 16 * F.lane;
    float lng[16], lnb[16], rk[16]; ld16f(A.in[I_LNG] + c0, lng); ld16f(A.in[I_LNB] + c0, lnb); ld16f(A.in[I_RK] + c0, rk);
    for (int n = gw; n < NL; n += NGW) { const size_t off = (size_t)n * D + c0; float y[16], t[16], r[16], kd[16], v[16], g[16], o[16];
        ld16bf((const bf16_t*)(F.ws + WS_YD) + off, y); ld16bf((const bf16_t*)(F.ws + WS_YD + (size_t)NL * D * 2) + off, t);
        float s = 0.f;
#pragma unroll
        for (int j = 0; j < 16; ++j) { y[j] += t[j]; s += y[j]; }
        s += __shfl_xor(s, 1); s += __shfl_xor(s, 2); const float m = s * (1.0f / 64.0f); float q = 0.f;
#pragma unroll
        for (int j = 0; j < 16; ++j) { y[j] -= m; q += y[j] * y[j]; }
        q += __shfl_xor(q, 1); q += __shfl_xor(q, 2); const float rs = 1.0f / sqrtf(q * (1.0f / 64.0f) + GN_EPS);
        ld16bf((const bf16_t*)(F.ws + WS_RKV) + off, r); ld16bf((const bf16_t*)(F.ws + WS_KDIR) + off, kd); ld16bf((const bf16_t*)(F.ws + WS_KDIR + ACTB) + off, t);
        float bs = 0.f;
#pragma unroll
        for (int j = 0; j < 16; ++j) bs += r[j] * (kd[j] + t[j]) * rk[j];
        bs += __shfl_xor(bs, 1); bs += __shfl_xor(bs, 2);
        ld16bf((const bf16_t*)(F.ws + WS_RKV + 2 * ACTB) + off, v); ld16bf((const bf16_t*)(F.ws + WS_G) + off, g);
#pragma unroll
        for (int j = 0; j < 16; ++j) o[j] = (y[j] * rs * lng[j] + lnb[j] + bs * v[j]) * g[j];
        st16bf((bf16_t*)(F.ws + WS_RO) + off, o);
    }
}
struct SchedWo {
    static constexpr bool SIDE = false; static constexpr bool XSYNC = false; static constexpr bool GATHER = false;
    int G, vcu; int nt; unsigned ldb;
    __device__ __forceinline__ bool next(int i, GU& u) const { const int L = i * G + vcu; if (L >= 512) return false; const int pm = L >> 2, pn = L & 3;
        u.a = (unsigned)(WS_RO + (size_t)pm * 256 * D * 2); u.b = (unsigned)(WS_WO + (size_t)pn * 256 * 1024 * 2); u.i0 = pm; u.i1 = pn; u.i2 = 0; u.i3 = 0; return true; }
    __device__ __forceinline__ void aoff(const GU&, const int (&R)[2], const int (&C)[2], unsigned (&v)[2][2]) const {
#pragma unroll
        for (int h = 0; h < 2; ++h)
#pragma unroll
            for (int i = 0; i < 2; ++i) v[h][i] = (unsigned)((h * 128 + R[i]) * D + C[i]) * 2u; }
};
struct EpiWo {
    static constexpr bool FP8 = false; static constexpr bool PERM = false;
    const float* xin; float* xout; const float* gate_base;
    __device__ __forceinline__ void operator()(const f32x4 (&acc)[2][2][4][2], const GU& u, int wr, int wc, int fr, int fq, const LAS float* sb) const {
        const int pm = u.i0, pn = u.i1; const float* gate = gate_base + (size_t)(pm >> 6) * NMOD * D; const int col0 = pn * 256 + wc * 32 + 4 * fq;
        f32x4 gl[2][2];
#pragma unroll
        for (int bj = 0; bj < 2; ++bj)
#pragma unroll
            for (int n = 0; n < 2; ++n) gl[bj][n] = *(const GAS f32x4*)(gate + col0 + bj * 128 + n * 16);
#pragma unroll
        for (int ai = 0; ai < 2; ++ai)
#pragma unroll
            for (int m = 0; m < 4; ++m) { const size_t off = ((size_t)pm * 256 + ai * 128 + wr * 64 + m * 16 + fr) * D + col0;
#pragma unroll
                for (int bj = 0; bj < 2; ++bj)
#pragma unroll
                    for (int n = 0; n < 2; ++n) *(GAS f32x4*)(xout + off + bj * 128 + n * 16) = *(const GAS f32x4*)(xin + off + bj * 128 + n * 16) + gl[bj][n] * acc[ai][bj][m][n]; }
    }
};

constexpr int NPHASES = 3;
__global__ void __launch_bounds__(NTHREADS, 2) fwd_kernel(Args args) {
    extern __shared__ __attribute__((aligned(16))) unsigned char lds_raw[];
    Frame F;
    F.lds = (LAS unsigned char*)lds_raw; F.scr = F.lds + SCR_OFF; F.ws = args.ws;
    F.tid = threadIdx.x; F.lane = F.tid & 63; F.wave = __builtin_amdgcn_readfirstlane(F.tid >> 6);
    F.G = gridDim.x; { const int bx = blockIdx.x; F.vcu = (F.G % 8 == 0) ? (bx % 8) * (F.G / 8) + bx / 8 : bx; }
    volatile LAS unsigned* MISC = (volatile LAS unsigned*)(F.lds + MISC_OFF);
    if (F.tid < 64) MISC[F.tid] = 0u;
    __syncthreads();
    const int lo = args.ph_lo, hi = args.ph_hi;
    XcdBarrier bar; bar.bar = (unsigned*)(F.ws + WS_CTL); bar.x = 0; bar.st = MISC + 8;
    if (hi - lo > 1) {
        unsigned* barw = (unsigned*)(F.ws + WS_CTL);
        bar.bar = barw; bar.x = xb_xcc_id(); bar.st = MISC + 8;
        if (F.tid == 0) {
            const unsigned rank = xb_add(&barw[XB_XCNT(bar.x)], 1u);
            unsigned nloc, nx; xcd_barrier_complete(barw, bar.x, nloc, nx); MISC[8] = nloc; MISC[9] = nx;
            unsigned pre = 0;
            for (unsigned j = 0; j < 16; ++j) { const unsigned c = xb_ld(&barw[XB_XCNT(j)]); if (j < bar.x) pre += c; }
            MISC[10] = pre + rank;
        }
        __syncthreads();
        F.vcu = (int)MISC[10];
    }
#define IN(k) (lo <= (k) && (k) < hi)
#define SEAM(k) do { if (IN(k) && IN((k) + 1)) xcd_barrier(bar); } while (0)
#define PH(k, ...) do { if (IN(k)) { __VA_ARGS__; if constexpr (((REPEAT_MASK >> (k)) & 1) != 0) { xcd_barrier(bar); __VA_ARGS__; } } SEAM(k); } while (0)
    PH(0, phase_prep(F, args));
    PH(1, phase_pre0(F, args));
    PH(2, { SchedPool S{F.G, F.vcu, 4, 512u};
            EpiPool E{args.in[I_X], args.in[I_CTX], args.in[I_POOLLS], modp(F, 0, 0, 2), (float*)(F.ws + WS_XS0)};
            pg8::gemm_phase<EpiPool, SchedPool>(F.scr, F.ws, S, E); });
    PH(3, phase_post(F, args, 0, (const float*)(F.ws + WS_XS0), NTOK));
    PH(4, phase_moe1(F, args, 0));
    PH(5, phase_moe2(F, args, 0));
    PH(6, phase_pre1(F, args));
    PH(7, { SchedProj S{F.G, F.vcu, 8, 1024u}; EpiProj E{F.ws}; pg8::gemm_phase<EpiProj, SchedProj>(F.scr, F.ws, S, E); });
    PH(8, { SchedLora2 S{F.G, F.vcu, 2, 256u}; EpiLora2 E{F.ws, args.in[I_W0], args.in[I_A0]}; pg8::gemm_phase<EpiLora2, SchedLora2>(F.scr, F.ws, S, E); });
    PH(9, phase_fin(F, args));
    PH(10, phase_scan(F, args));
    PH(11, phase_readout(F, args));
    PH(12, { SchedWo S{F.G, F.vcu, 16, 2048u}; EpiWo E{(const float*)(F.ws + WS_XS1), (float*)(F.ws + WS_XS0), modp(F, 1, 0, 2)}; pg8::gemm_phase<EpiWo, SchedWo>(F.scr, F.ws, S, E); });
    PH(13, phase_post(F, args, 1, (const float*)(F.ws + WS_XS0), NL));
    PH(14, phase_moe1(F, args, 1));
    PH(15, phase_moe2(F, args, 1));
    PH(16, phase_final(F, args, 1, (const float*)(F.ws + WS_XS0)));
#undef PH
#undef SEAM
#undef IN
}

extern "C" void kernel_launch(void* const* d_in, const int* in_sizes, int n_in, void* d_out, int out_size, void* d_ws, size_t ws_size, hipStream_t stream) {
    static int grid = 0;
    if (grid == 0) {
        if (n_in != 32 || ws_size < WS_END) { fprintf(stderr, "kernel_launch: unexpected n_in %d / ws %zu (need %zu)\n", n_in, ws_size, (size_t)WS_END); grid = -1; return; }
        int dev = 0, cus = 0;
        if (hipGetDevice(&dev) != hipSuccess || hipDeviceGetAttribute(&cus, hipDeviceAttributeMultiprocessorCount, dev) != hipSuccess) { grid = -1; return; }
        if (hipFuncSetAttribute((const void*)fwd_kernel, hipFuncAttributeMaxDynamicSharedMemorySize, LDS_BYTES) != hipSuccess) { fprintf(stderr, "kernel_launch: hipFuncSetAttribute failed\n"); grid = -1; return; }
        (void)hipGetLastError();
        grid = cus;
    }
    if (grid < 0) return;
    (void)hipMemsetAsync((char*)d_ws + WS_CTL, 0, CTL_BYTES, stream);
    Args a{};
    for (int i = 0; i < 32; ++i) a.in[i] = (const float*)d_in[i];
    a.out = (float*)d_out; a.ws = (unsigned char*)d_ws;
    const int last = 16;
#if N_LAUNCH_MODE == 1
    a.ph_lo = 0; a.ph_hi = last + 1;
    hipLaunchKernelGGL(fwd_kernel, dim3(grid), dim3(NTHREADS), LDS_BYTES, stream, a);
#else
    for (int p = 0; p <= last; ++p) { a.ph_lo = p; a.ph_hi = p + 1; hipLaunchKernelGGL(fwd_kernel, dim3(grid), dim3(NTHREADS), LDS_BYTES, stream, a); }
#endif
}
```

```cpp
#include <hip/hip_runtime.h>
#include <cstdio>
#include <cstdint>

#define LAS __attribute__((address_space(3)))
#define GAS __attribute__((address_space(1)))
typedef unsigned short bf16_t;
typedef short bf16x8 __attribute__((ext_vector_type(8)));
typedef float f32x4 __attribute__((ext_vector_type(4)));
typedef float f32x2 __attribute__((ext_vector_type(2)));
typedef float f32x16 __attribute__((ext_vector_type(16)));
typedef unsigned u32x4 __attribute__((ext_vector_type(4)));
typedef unsigned u32x2 __attribute__((ext_vector_type(2)));

#ifndef N_LAUNCH_MODE
#define N_LAUNCH_MODE 1
#endif
#ifndef SCAN_TSEL
#define SCAN_TSEL -1
#endif
#ifndef REPEAT_MASK
#define REPEAT_MASK 0
#endif

constexpr int D = 1024, NB = 2, TSEQ = 16384, CT = 256, NL = NB * TSEQ, NC = NB * CT, NTOK = NL + NC;
constexpr int NE = 32, TOPK = 4, NMOD = 6;
constexpr int NWAVES = 8, NTHREADS = 512;
constexpr int MAXSLOT = ((NTOK * TOPK + 255) / 256 + NE) * 256;
constexpr float NORM_EPS = 1e-6f, GN_EPS = 64e-5f;

constexpr size_t AL(size_t x) { return (x + 255) & ~(size_t)255; }
constexpr size_t WS_CTL = 0, CTL_BYTES = 65536;
constexpr size_t CTL_XSYNC = 32768;
constexpr size_t CTL_CNT = 16384;
constexpr size_t WS_MOD = WS_CTL + CTL_BYTES;
constexpr size_t WS_LIST = AL(WS_MOD + 2 * 3 * 6144 * 4);
constexpr size_t WS_TINFO = AL(WS_LIST + (size_t)2 * NE * NTOK * 4);
constexpr size_t WS_TGATE = AL(WS_TINFO + (size_t)2 * NTOK * 4 * 4);
constexpr size_t WS_WGU = AL(WS_TGATE + (size_t)2 * NTOK * 4 * 4);
constexpr size_t WS_WDN = AL(WS_WGU + (size_t)2 * NE * 2048 * 1024 * 2);
constexpr size_t WS_WRKV = AL(WS_WDN + (size_t)2 * NE * 1024 * 1024 * 2);
constexpr size_t WS_WO = AL(WS_WRKV + (size_t)3 * 1024 * 1024 * 2);
constexpr size_t WS_WL1 = AL(WS_WO + (size_t)1024 * 1024 * 2);
constexpr size_t WS_WL2 = AL(WS_WL1 + (size_t)3 * 256 * 1024 * 2);
constexpr size_t WS_WPOOL = AL(WS_WL2 + (size_t)5 * 1024 * 128 * 2);
constexpr size_t WS_XS0 = AL(WS_WPOOL + (size_t)4 * 256 * 256 * 2);
constexpr size_t WS_XS1 = AL(WS_XS0 + (size_t)NTOK * D * 4);
constexpr size_t WS_T = AL(WS_XS1 + (size_t)NTOK * D * 4);
constexpr size_t ACTB = (size_t)NTOK * D * 2;
constexpr size_t TA = WS_T;
constexpr size_t TA_BYTES = (size_t)432 << 20;
constexpr size_t WS_DBUF = TA, WS_H2 = TA + ACTB, WS_ACT = TA + 2 * ACTB;
constexpr size_t WS_MIX = TA;
constexpr size_t WS_KDIR = TA, WS_BV = TA + 2 * ACTB, WS_KK = TA + 4 * ACTB;
constexpr size_t TB = TA + TA_BYTES;
constexpr size_t TB_BYTES = (size_t)290 << 20;
constexpr size_t WS_Y2 = TB, WS_RKV = TB;
constexpr size_t TC = TB + TB_BYTES;
constexpr size_t WS_DEC = TC, WS_RO = TC;
constexpr size_t TD = AL(TC + (size_t)2 * NTOK * D * 4);
constexpr size_t WS_ICL = TD, WS_YD = TA;
constexpr size_t TE = AL(TD + 2 * ACTB);
constexpr size_t WS_G = TE;
constexpr size_t TF = AL(TE + ACTB);
constexpr size_t WS_LACT = TF;
constexpr size_t WS_END = AL(TF + (size_t)3 * NTOK * 128 * 2);
static_assert(WS_ACT + (size_t)MAXSLOT * D * 2 <= TA + TA_BYTES, "ACT overflows TA");
static_assert((size_t)MAXSLOT * D * 2 <= TB_BYTES, "Y2 overflows TB");
static_assert(WS_END <= ((size_t)2048 << 20), "workspace too large");

constexpr int MISC_OFF = 0, SCR_OFF = 1024, SCR_BYTES = 162816, LDS_BYTES = SCR_OFF + SCR_BYTES;

typedef __bf16 bf16x2_t __attribute__((ext_vector_type(2)));
__device__ __forceinline__ unsigned cvt_pk_bf16(float lo, float hi) { const f32x2 v = {lo, hi}; return __builtin_bit_cast(unsigned, __builtin_convertvector(v, bf16x2_t)); }
__device__ __forceinline__ void stx4(bf16_t* p, f32x4 v) { u32x2 w; w.x = cvt_pk_bf16(v[0], v[1]); w.y = cvt_pk_bf16(v[2], v[3]); *(GAS u32x2*)p = w; }
__device__ __forceinline__ float bf_lo(unsigned w) { return __uint_as_float(w << 16); }
__device__ __forceinline__ float bf_hi(unsigned w) { return __uint_as_float(w & 0xffff0000u); }
__device__ __forceinline__ float bf2f(bf16_t b) { return __uint_as_float(((unsigned)b) << 16); }
__device__ __forceinline__ f32x4 ldx4(const bf16_t* p) { const u32x2 w = *(const GAS u32x2*)p; return (f32x4){bf_lo(w.x), bf_hi(w.x), bf_lo(w.y), bf_hi(w.y)}; }
__device__ __forceinline__ float dpp_xadd(float v, const int sel) {
    const int x = __builtin_bit_cast(int, v); int y;
    if (sel == 0) y = __builtin_amdgcn_update_dpp(0, x, 0xB1, 0xF, 0xF, true);
    else if (sel == 1) y = __builtin_amdgcn_update_dpp(0, x, 0x4E, 0xF, 0xF, true);
    else if (sel == 2) y = __builtin_amdgcn_update_dpp(0, x, 0x141, 0xF, 0xF, true);
    else y = __builtin_amdgcn_update_dpp(0, x, 0x140, 0xF, 0xF, true);
    return v + __builtin_bit_cast(float, y);
}
__device__ __forceinline__ float wave_sum(float v) {
    v = dpp_xadd(v, 0); v = dpp_xadd(v, 1); v = dpp_xadd(v, 2); v = dpp_xadd(v, 3);
    const int x = __builtin_bit_cast(int, v);
    const float s0 = __builtin_bit_cast(float, __builtin_amdgcn_readlane(x, 0)), s1 = __builtin_bit_cast(float, __builtin_amdgcn_readlane(x, 16)),
                s2 = __builtin_bit_cast(float, __builtin_amdgcn_readlane(x, 32)), s3 = __builtin_bit_cast(float, __builtin_amdgcn_readlane(x, 48));
    return (s0 + s1) + (s2 + s3);
}
__device__ __forceinline__ float sigmoidf_(float x) { return 1.0f / (1.0f + __expf(-x)); }
#define LDS_WAIT() asm volatile("s_waitcnt lgkmcnt(0)" ::: "memory")
#define VM_WAIT() asm volatile("s_waitcnt vmcnt(0)" ::: "memory")

#define XB_TMO      128
#define XB_XCNT(j)  (256  + 64 * (j))
#define XB_XSUB(j)  (1280 + 64 * (j))
#define XB_XGEN(j)  (2304 + 64 * (j))
#define XB_TOP      3328
#define XB_TOPGEN   3392
#define XCD_BAR_WORDS 3456
#define XB_SPIN_CAP (1u << 22)
__device__ __forceinline__ unsigned xb_ld(unsigned* p)              { return __hip_atomic_load(p, __ATOMIC_RELAXED, __HIP_MEMORY_SCOPE_AGENT); }
__device__ __forceinline__ unsigned xb_add(unsigned* p, unsigned v) { return __hip_atomic_fetch_add(p, v, __ATOMIC_RELAXED, __HIP_MEMORY_SCOPE_AGENT); }
__device__ __forceinline__ unsigned xb_xcc_id() { return (unsigned)__builtin_amdgcn_s_getreg((3 << 11) | 20) & 0xFu; }
#define XB_SPIN(cond, bar) do { unsigned _sp = 0; while (cond) { __builtin_amdgcn_s_sleep(1); \
    if ((++_sp & 255u) == 0u) { if (xb_ld(&(bar)[XB_TMO])) break; if (_sp > XB_SPIN_CAP) { atomicAdd(&(bar)[XB_TMO], 1u); break; } } } } while (0)
struct XcdBarrier { unsigned* bar; unsigned x; volatile LAS unsigned* st; };
__device__ __forceinline__ XcdBarrier xcd_barrier_post(unsigned* bar, volatile LAS unsigned* st) {
    XcdBarrier b; b.bar = bar; b.x = xb_xcc_id(); b.st = st;
    if (threadIdx.x == 0) (void)xb_add(&bar[XB_XCNT(b.x)], 1u);
    return b;
}
__device__ __forceinline__ void xcd_barrier_complete(unsigned* bar, unsigned x, unsigned& nloc, unsigned& nx) {
    const unsigned G = gridDim.x * gridDim.y * gridDim.z;
    unsigned sum, cnt, mine, sp = 0u;
    for (;;) {
        sum = 0u; cnt = 0u; mine = 0u;
#pragma unroll
        for (unsigned j = 0; j < 16; ++j) { const unsigned c = xb_ld(&bar[XB_XCNT(j)]); sum += c; cnt += (c > 0u) ? 1u : 0u; mine = (j == x) ? c : mine; }
        if (sum == G) break;
        __builtin_amdgcn_s_sleep(1);
        if ((++sp & 255u) == 0u) { if (xb_ld(&bar[XB_TMO])) break; if (sp > XB_SPIN_CAP) { atomicAdd(&bar[XB_TMO], 1u); break; } }
    }
    nloc = mine > 0u ? mine : 1u; nx = cnt > 0u ? cnt : 1u;
}
__device__ __forceinline__ void xcd_barrier(const XcdBarrier& b) {
    asm volatile("s_waitcnt vmcnt(0)" ::: "memory");
    __syncthreads();
    if (threadIdx.x == 0) {
        unsigned* bar = b.bar;
        __builtin_amdgcn_s_waitcnt(0);
        unsigned nloc = b.st[0], nx = b.st[1];
        if (nloc == 0u) { xcd_barrier_complete(bar, b.x, nloc, nx); b.st[0] = nloc; b.st[1] = nx; }
        const unsigned old = xb_add(&bar[XB_XSUB(b.x)], 1u);
        const unsigned gen = old / nloc;
        if (old + 1u == (gen + 1u) * nloc) {
            __builtin_amdgcn_fence(__ATOMIC_RELEASE, "agent");
            asm volatile("s_waitcnt vmcnt(0)" ::: "memory");
            const unsigned og = xb_add(&bar[XB_TOP], 1u);
            const unsigned tg = og / nx;
            if (og + 1u == (tg + 1u) * nx) xb_add(&bar[XB_TOPGEN], 1u);
            else XB_SPIN(xb_ld(&bar[XB_TOPGEN]) == tg, bar);
            __builtin_amdgcn_fence(__ATOMIC_ACQUIRE, "agent");
            xb_add(&bar[XB_XGEN(b.x)], 1u);
            asm volatile("s_waitcnt vmcnt(0)" ::: "memory");
        } else {
            XB_SPIN(xb_ld(&bar[XB_XGEN(b.x)]) == gen, bar);
            __builtin_amdgcn_fence(__ATOMIC_ACQUIRE, "agent");
            asm volatile("s_waitcnt vmcnt(0)" ::: "memory");
        }
    }
    __syncthreads();
}

namespace pg8 {
constexpr int BM = 256, BK = 64, HALF = 128, HTB = HALF * BK * 2, STAGE_BYTES = 8 * HTB;
__host__ __device__ __forceinline__ int lds_byte(int r, int c) { const int st = (r >> 4) * 2 + (c >> 5), rr = r & 15, cc = c & 31, ob = rr * 64 + cc * 2; return st * 1024 + (ob ^ (((ob >> 9) & 1) << 5)); }
__host__ __device__ __forceinline__ void stage_rc(int b, int& R, int& C) { const int st = b / 1024, sb = b % 1024, swz = sb ^ (((sb >> 9) & 1) << 5); R = (st >> 1) * 16 + swz / 64; C = (st & 1) * 32 + (swz % 64) / 2; }
__host__ __device__ __forceinline__ int perm32(int rho) { const int n = rho >> 4, i = rho & 15; return 8 * (i >> 2) + 4 * n + (i & 3); }

struct GU { unsigned a, b; int i0, i1, i2, i3; };
typedef int v8i __attribute__((ext_vector_type(8)));
typedef int v4i __attribute__((ext_vector_type(4)));
__device__ __forceinline__ bf16x8 half8(v8i v, int h) { const v4i a = h ? __builtin_shufflevector(v, v, 4, 5, 6, 7) : __builtin_shufflevector(v, v, 0, 1, 2, 3); return __builtin_bit_cast(bf16x8, a); }
__device__ __forceinline__ v8i cat8(bf16x8 lo, bf16x8 hi) { const v4i a = __builtin_bit_cast(v4i, lo), b = __builtin_bit_cast(v4i, hi); return __builtin_shufflevector(a, b, 0, 1, 2, 3, 4, 5, 6, 7); }

template <class Epi, class Sched>
__device__ __forceinline__ void gemm_phase(LAS unsigned char* lds, unsigned char* wsbase, const Sched& S, const Epi& E) {
    const int tid = threadIdx.x, wid = __builtin_amdgcn_readfirstlane(tid >> 6), lane = tid & 63, wr = wid >> 2, wc = wid & 3, fr = lane & 15, fq = lane >> 4;
    const int nt = S.nt;
    const __amdgpu_buffer_rsrc_t rsrc = __builtin_amdgcn_make_buffer_rsrc((void*)wsbase, 0, 0xffffffff, 0x00020000);
    constexpr int SIDE_OFF = STAGE_BYTES;
#define PG8_SIDE(u, buf) do { if constexpr (Sched::SIDE) { unsigned so_; const bool isb_ = S.side_src((u), tid, so_); (void)isb_; \
        if (wid < 4) __builtin_amdgcn_raw_ptr_buffer_load_lds(rsrc, (LAS void*)(lds + SIDE_OFF + (buf) * 2048 + wid * 256), 4, (int)so_, 0, 0, 0); \
        else __builtin_amdgcn_raw_ptr_buffer_load_lds(S.rsrcb, (LAS void*)(lds + SIDE_OFF + (buf) * 2048 + wid * 256), 4, (int)so_, 0, 0, 0); } } while (0)
    int Rr[2], Cc[2]; unsigned voffB[2];
#pragma unroll
    for (int i = 0; i < 2; ++i) { int R, C; stage_rc(tid * 16 + i * 8192, R, C); Rr[i] = R; Cc[i] = C; const int Rb = Epi::PERM ? ((R & ~31) + perm32(R & 31)) : R;
        voffB[i] = (unsigned)Rb * S.ldb + 2u * (unsigned)C; }
    const unsigned kstep = 128u;
    const unsigned hstepB = (unsigned)HALF * S.ldb;
    const unsigned ldsw = (unsigned)wid * 1024u;
    const int aoff = lds_byte(wr * 64 + fr, fq * 8), boff = lds_byte(wc * 32 + fr, fq * 8);
#define PG8_SA(b, h) (((b) * 2 + (h)) * HTB)
#define PG8_SB(b, h) ((4 + (b) * 2 + (h)) * HTB)
#define PG8_STAGE(bufoff, soff, voff) do { _Pragma("unroll") for (int _i = 0; _i < 2; ++_i) \
        __builtin_amdgcn_raw_ptr_buffer_load_lds(rsrc, (LAS void*)(lds + (bufoff) + ldsw + _i * 8192), 16, (int)(voff)[_i], (int)(soff), 0, 0); } while (0)
#define PG8_LDA(dst, b, h) do { _Pragma("unroll") for (int m = 0; m < 4; ++m) dst[m] = cat8(*(const LAS bf16x8*)(lds + PG8_SA(b, h) + aoff + m * 2048), *(const LAS bf16x8*)(lds + PG8_SA(b, h) + aoff + m * 2048 + 1024)); } while (0)
#define PG8_LDB(dst, b, h) do { _Pragma("unroll") for (int n = 0; n < 2; ++n) dst[n] = cat8(*(const LAS bf16x8*)(lds + PG8_SB(b, h) + boff + n * 2048), *(const LAS bf16x8*)(lds + PG8_SB(b, h) + boff + n * 2048 + 1024)); } while (0)
#define PG8_MMA(ai, bj, At, Bt) do { __builtin_amdgcn_s_setprio(1); _Pragma("unroll") for (int m = 0; m < 4; ++m) _Pragma("unroll") for (int n = 0; n < 2; ++n) { \
        if constexpr (Epi::FP8) { asm volatile("v_mfma_scale_f32_16x16x128_f8f6f4 %0, %1, %2, %0, %3, %4 op_sel_hi:[0,0,0]" : "+v"(acc[ai][bj][m][n]) : "v"(Bt[n]), "v"(At[m]), "v"(sc_w), "v"(sc_a)); } \
        else { acc[ai][bj][m][n] = __builtin_amdgcn_mfma_f32_16x16x32_bf16(half8(Bt[n], 0), half8(At[m], 0), acc[ai][bj][m][n], 0, 0, 0); \
               acc[ai][bj][m][n] = __builtin_amdgcn_mfma_f32_16x16x32_bf16(half8(Bt[n], 1), half8(At[m], 1), acc[ai][bj][m][n], 0, 0, 0); } } \
        __builtin_amdgcn_s_setprio(0); } while (0)
#define PG8_WAIT_V(n) asm volatile("s_waitcnt vmcnt(" #n ")" ::: "memory")
#define PG8_WAIT_L(n) asm volatile("s_waitcnt lgkmcnt(" #n ")" ::: "memory")
#define PG8_BAR __builtin_amdgcn_s_barrier()
#define PG8_SCHED __builtin_amdgcn_sched_barrier(0)
#define PG8_RC() do { _Pragma("unroll") for (int i = 0; i < 2; ++i) { int R, C; stage_rc((int)threadIdx.x * 16 + i * 8192, R, C); Rr[i] = R; Cc[i] = C; } } while (0)
    long long tk_ = 0, te_ = 0, tt0_ = 0; const bool tprobe_ = (SCAN_TSEL >= 10) && Sched::SIDE && Sched::GATHER;
    GU cur, nxt; int ui = 0;
    if (!S.next(0, cur)) { if constexpr (Sched::XSYNC) { if (tid == 0) (void)xb_add(S.xw, (unsigned)S.rounds); } return; }
    f32x4 acc[2][2][4][2];
#pragma unroll
    for (int a = 0; a < 2; ++a)
#pragma unroll
        for (int b = 0; b < 2; ++b)
#pragma unroll
            for (int m = 0; m < 4; ++m)
#pragma unroll
                for (int n = 0; n < 2; ++n) acc[a][b][m][n] = (f32x4){0.f, 0.f, 0.f, 0.f};
    v8i At[4], B0[2], B1[2];
    int sc_w = 0x7a7a7a7a, sc_a = 0x7f7f7f7f; asm volatile("" : "+v"(sc_w), "+v"(sc_a));
    unsigned vA[2][2], nvA[2][2];
    S.aoff(cur, Rr, Cc, vA);
    unsigned cA = __builtin_amdgcn_readfirstlane(cur.a), cB = __builtin_amdgcn_readfirstlane(cur.b);
    PG8_SIDE(cur, 0);
    PG8_STAGE(PG8_SB(0, 0), cB, voffB); PG8_STAGE(PG8_SB(0, 1), cB + hstepB, voffB); PG8_STAGE(PG8_SA(0, 0), cA, vA[0]); PG8_STAGE(PG8_SA(0, 1), cA, vA[1]);
    if (wr == 1) PG8_BAR;
    PG8_WAIT_V(2); PG8_BAR;
    PG8_STAGE(PG8_SB(1, 0), cB + kstep, voffB); PG8_STAGE(PG8_SA(1, 0), cA + kstep, vA[0]); PG8_STAGE(PG8_SB(1, 1), cB + hstepB + kstep, voffB);
    PG8_WAIT_V(6); PG8_BAR;
    for (;;) {
        if (tprobe_) tt0_ = clock64();
        const bool has_next = S.next(ui + 1, nxt);
        const unsigned nA = has_next ? __builtin_amdgcn_readfirstlane(nxt.a) : cA, nB = has_next ? __builtin_amdgcn_readfirstlane(nxt.b) : cB;
        if (has_next) PG8_SIDE(nxt, (ui + 1) & 1);
        if constexpr (Sched::GATHER && !Sched::SIDE) {
            if (has_next) { PG8_RC(); S.aoff(nxt, Rr, Cc, nvA); }
            else { nvA[0][0] = vA[0][0]; nvA[0][1] = vA[0][1]; nvA[1][0] = vA[1][0]; nvA[1][1] = vA[1][1]; }
        }
#pragma unroll 1
        for (int t = 0; t < nt; t += 2) {
            const bool last = (t == nt - 2);
            const unsigned a1 = cA + (unsigned)(t + 1) * kstep;
            const unsigned a2 = last ? nA : cA + (unsigned)(t + 2) * kstep, b2 = last ? nB : cB + (unsigned)(t + 2) * kstep;
            const unsigned a3 = a2 + kstep, b3 = b2 + kstep;
            if constexpr (Sched::GATHER && Sched::SIDE) {
                if (last) { if (has_next) { PG8_RC(); const LAS int* tk = (const LAS int*)(lds + SIDE_OFF + ((ui + 1) & 1) * 2048);
#pragma unroll
                        for (int h = 0; h < 2; ++h)
#pragma unroll
                            for (int i = 0; i < 2; ++i) nvA[h][i] = S.tok_off(tk[h * 128 + Rr[i]], Cc[i]); }
                    else { nvA[0][0] = vA[0][0]; nvA[0][1] = vA[0][1]; nvA[1][0] = vA[1][0]; nvA[1][1] = vA[1][1]; } }
            }
            unsigned w0[2], w1[2];
            if constexpr (Sched::GATHER) { w0[0] = last ? nvA[0][0] : vA[0][0]; w0[1] = last ? nvA[0][1] : vA[0][1]; w1[0] = last ? nvA[1][0] : vA[1][0]; w1[1] = last ? nvA[1][1] : vA[1][1]; }
            else { w0[0] = vA[0][0]; w0[1] = vA[0][1]; w1[0] = vA[1][0]; w1[1] = vA[1][1]; }
            PG8_LDB(B0, 0, 0); PG8_LDB(B1, 0, 1); PG8_SCHED; PG8_LDA(At, 0, 0); PG8_STAGE(PG8_SA(1, 1), a1, vA[1]);
            PG8_WAIT_V(8); PG8_WAIT_L(0); PG8_BAR; PG8_MMA(0, 0, At, B0); PG8_MMA(0, 1, At, B1); PG8_BAR; PG8_SCHED;
            PG8_LDA(At, 0, 1); PG8_STAGE(PG8_SB(0, 0), b2, voffB); PG8_STAGE(PG8_SB(0, 1), b2 + hstepB, voffB); PG8_STAGE(PG8_SA(0, 0), a2, w0);
            PG8_WAIT_V(8); PG8_WAIT_L(0); PG8_BAR; PG8_MMA(1, 0, At, B0); PG8_MMA(1, 1, At, B1); PG8_BAR; PG8_SCHED;
            PG8_LDB(B0, 1, 0); PG8_LDB(B1, 1, 1); PG8_SCHED; PG8_LDA(At, 1, 0); PG8_STAGE(PG8_SA(0, 1), a2, w1);
            PG8_WAIT_V(8); PG8_WAIT_L(0); PG8_BAR; PG8_MMA(0, 0, At, B0); PG8_MMA(0, 1, At, B1); PG8_BAR; PG8_SCHED;
            PG8_LDA(At, 1, 1); PG8_STAGE(PG8_SB(1, 0), b3, voffB); PG8_STAGE(PG8_SB(1, 1), b3 + hstepB, voffB); PG8_STAGE(PG8_SA(1, 0), a3, w0);
            PG8_WAIT_V(8); PG8_WAIT_L(0); PG8_BAR; PG8_MMA(1, 0, At, B0); PG8_MMA(1, 1, At, B1); PG8_BAR; PG8_SCHED;
        }
        if (tprobe_) { const long long n_ = clock64(); tk_ += n_ - tt0_; tt0_ = n_; }
        if (wr == 0) PG8_BAR;
        if constexpr (Epi::FP8) asm volatile("s_nop 15\n\ts_nop 7" ::: "memory");
        { int fr_ = fr, fq_ = fq; asm volatile("" : "+v"(fr_), "+v"(fq_)); E(acc, cur, wr, wc, fr_, fq_, (const LAS float*)(lds + SIDE_OFF + (ui & 1) * 2048 + 1024)); }
        if constexpr (Sched::XSYNC) {
            if (tid == 0) { (void)xb_add(S.xw, 1u); const unsigned tgt = (unsigned)(ui + 1) * S.nloc; unsigned sp = 0;
                while (xb_ld(S.xw) < tgt && ++sp < (1u << 16)) __builtin_amdgcn_s_sleep(1);
                if (!has_next && S.rounds > ui + 1) (void)xb_add(S.xw, (unsigned)(S.rounds - (ui + 1))); }
        }
        if constexpr (Sched::XSYNC || Sched::SIDE) PG8_BAR;
        if (tprobe_) { te_ += clock64() - tt0_; }
        if (!has_next) break;
#pragma unroll
        for (int a = 0; a < 2; ++a)
#pragma unroll
            for (int b = 0; b < 2; ++b)
#pragma unroll
                for (int m = 0; m < 4; ++m)
#pragma unroll
                    for (int n = 0; n < 2; ++n) acc[a][b][m][n] = (f32x4){0.f, 0.f, 0.f, 0.f};
        cur = nxt; cA = nA; cB = nB; ++ui;
        if constexpr (Sched::GATHER) { vA[0][0] = nvA[0][0]; vA[0][1] = nvA[0][1]; vA[1][0] = nvA[1][0]; vA[1][1] = nvA[1][1]; }
        if (wr == 1) PG8_BAR;
    }
    PG8_WAIT_V(0);
    PG8_BAR;
    if (tprobe_ && S.vcu == 0 && tid == 0) { const long long v_ = (SCAN_TSEL == 10) ? tk_ : (SCAN_TSEL == 11 ? 4 * te_ : tk_ + te_); __hip_atomic_fetch_add((unsigned long long*)(wsbase + WS_CTL + 49152), (unsigned long long)v_, __ATOMIC_RELAXED, __HIP_MEMORY_SCOPE_AGENT); }
#undef PG8_RC
#undef PG8_SIDE
#undef PG8_SA
#undef PG8_SB
#undef PG8_STAGE
#undef PG8_LDA
#undef PG8_LDB
#undef PG8_MMA
#undef PG8_WAIT_V
#undef PG8_WAIT_L
#undef PG8_BAR
#undef PG8_SCHED
}
}
using pg8::GU;

struct Args { const float* in[32]; float* out; unsigned char* ws; int ph_lo, ph_hi; };
struct Frame {
    LAS unsigned char* lds;
    LAS unsigned char* scr;
    unsigned char* ws;
    int tid, lane, wave, G, vcu;
};
enum { I_X = 0, I_C, I_CTX, I_CCTX, I_NORMG, I_ADAW, I_ADAB, I_POOLW, I_POOLLS, I_MU, I_WRKV, I_W0, I_W1, I_W2, I_A0, I_A1, I_A2, I_G1, I_G2, I_KK, I_KA, I_RK, I_LNG, I_LNB, I_WO,
       I_RW, I_RB, I_WGU, I_BGU, I_WDN, I_BDN, I_FINALG };

__device__ __forceinline__ const float* modp(const Frame& F, int layer, int row, int k) { return (const float*)(F.ws + WS_MOD) + ((size_t)(layer * 3 + row) * NMOD + k) * D; }
__device__ __forceinline__ int mrow_of(int n) { return n < NL ? (n >> 14) : 2; }

__device__ __forceinline__ void transpose_tile(const float* W, int ldw, int k0, int n0, bf16_t* WT, size_t dst_row0, int ldk, int kdst0, LAS float* scr, int lane) {
    const int c4 = lane & 15, kr = lane >> 4;
#pragma unroll 4
    for (int it = 0; it < 16; ++it) { const int kk = 4 * it + kr; const f32x4 v = *(const GAS f32x4*)(W + (size_t)(k0 + kk) * ldw + n0 + 4 * c4);
        LAS float* s = scr + kk * 65 + 4 * c4; s[0] = v[0]; s[1] = v[1]; s[2] = v[2]; s[3] = v[3]; }
    LDS_WAIT(); asm volatile("" ::: "memory");
    const int c = lane & 7;
#pragma unroll
    for (int j = 0; j < 8; ++j) { const int n = (lane >> 3) + 8 * j; const LAS float* s = scr + (8 * c) * 65 + n;
        u32x4 o; o.x = cvt_pk_bf16(s[0 * 65], s[1 * 65]); o.y = cvt_pk_bf16(s[2 * 65], s[3 * 65]); o.z = cvt_pk_bf16(s[4 * 65], s[5 * 65]); o.w = cvt_pk_bf16(s[6 * 65], s[7 * 65]);
        *(GAS u32x4*)(WT + (dst_row0 + n) * (size_t)ldk + kdst0 + k0 + 8 * c) = o; }
    LDS_WAIT(); asm volatile("" ::: "memory");
}

__device__ __forceinline__ unsigned pk4_fp8(float a, float b, float c, float d) { int w = 0; w = __builtin_amdgcn_cvt_pk_fp8_f32(a, b, w, false); w = __builtin_amdgcn_cvt_pk_fp8_f32(c, d, w, true); return (unsigned)w; }
__device__ __forceinline__ void transpose_tile_fp8(const float* W, int ldw, int k0, int n0, unsigned char* WT, size_t dst_row0, int ldk, float scale, LAS float* scr, int lane) {
    const int c4 = lane & 15, kr = lane >> 4;
#pragma unroll 4
    for (int it = 0; it < 16; ++it) { const int kk = 4 * it + kr; const f32x4 v = *(const GAS f32x4*)(W + (size_t)(k0 + kk) * ldw + n0 + 4 * c4);
        LAS float* s = scr + kk * 65 + 4 * c4; s[0] = v[0] * scale; s[1] = v[1] * scale; s[2] = v[2] * scale; s[3] = v[3] * scale; }
    LDS_WAIT(); asm volatile("" ::: "memory");
    const int c = lane & 3;
#pragma unroll
    for (int j = 0; j < 4; ++j) { const int n = (lane >> 2) + 16 * j; const LAS float* s = scr + (16 * c) * 65 + n;
        u32x4 o; o.x = pk4_fp8(s[0 * 65], s[1 * 65], s[2 * 65], s[3 * 65]); o.y = pk4_fp8(s[4 * 65], s[5 * 65], s[6 * 65], s[7 * 65]);
        o.z = pk4_fp8(s[8 * 65], s[9 * 65], s[10 * 65], s[11 * 65]); o.w = pk4_fp8(s[12 * 65], s[13 * 65], s[14 * 65], s[15 * 65]);
        *(GAS u32x4*)(WT + (dst_row0 + n) * (size_t)ldk + k0 + 16 * c) = o; }
    LDS_WAIT(); asm volatile("" ::: "memory");
}
__device__ __forceinline__ void transpose_tile_fp8_k128(const float* W, int ldw, int k0, int n0, unsigned char* WT, size_t dst_row0, int ldk, float scale, LAS float* scr, int lane) {
    const int c4 = lane & 7, kr = lane >> 3;
#pragma unroll 4
    for (int it = 0; it < 16; ++it) { const int kk = 8 * it + kr; const f32x4 v = *(const GAS f32x4*)(W + (size_t)(k0 + kk) * ldw + n0 + 4 * c4);
        LAS float* s = scr + kk * 33 + 4 * c4; s[0] = v[0] * scale; s[1] = v[1] * scale; s[2] = v[2] * scale; s[3] = v[3] * scale; }
    LDS_WAIT(); asm volatile("" ::: "memory");
    const int c = lane & 7;
#pragma unroll
    for (int j = 0; j < 4; ++j) { const int n = (lane >> 3) + 8 * j; const LAS float* s = scr + (16 * c) * 33 + n;
        u32x4 o; o.x = pk4_fp8(s[0 * 33], s[1 * 33], s[2 * 33], s[3 * 33]); o.y = pk4_fp8(s[4 * 33], s[5 * 33], s[6 * 33], s[7 * 33]);
        o.z = pk4_fp8(s[8 * 33], s[9 * 33], s[10 * 33], s[11 * 33]); o.w = pk4_fp8(s[12 * 33], s[13 * 33], s[14 * 33], s[15 * 33]);
        *(GAS u32x4*)(WT + (dst_row0 + n) * (size_t)ldk + k0 + 16 * c) = o; }
    LDS_WAIT(); asm volatile("" ::: "memory");
}
__device__ __forceinline__ void phase_prep(const Frame& F, const Args& A) {
    unsigned char* ws = F.ws;
    for (int u = blockIdx.x; u < 256; u += F.G) {
        const int l = u >> 7, cc = u & 127, c4 = F.tid % 12, kq = F.tid / 12;
        f32x4 a0 = {0, 0, 0, 0}, a1 = {0, 0, 0, 0}, a2 = {0, 0, 0, 0};
        if (kq < 42) { const float* w = A.in[I_ADAW] + (size_t)l * D * (NMOD * D) + cc * 48 + 4 * c4;
            for (int k = kq; k < D; k += 42) { const f32x4 wv = *(const GAS f32x4*)(w + (size_t)k * (NMOD * D));
                float c0 = A.in[I_C][k], c1 = A.in[I_C][D + k], c2 = A.in[I_CCTX][k];
                c0 = c0 * sigmoidf_(c0); c1 = c1 * sigmoidf_(c1); c2 = c2 * sigmoidf_(c2);
                a0 += wv * c0; a1 += wv * c1; a2 += wv * c2; }
            LAS f32x4* red = (LAS f32x4*)F.scr;
            red[(kq * 3 + 0) * 12 + c4] = a0; red[(kq * 3 + 1) * 12 + c4] = a1; red[(kq * 3 + 2) * 12 + c4] = a2; }
        __syncthreads();
        if (F.tid < 144) { const int r = F.tid / 48, c = F.tid % 48; float sum = 0.f;
            for (int q = 0; q < 42; ++q) sum += ((LAS float*)F.scr)[((q * 3 + r) * 12) * 4 + c];
            const int col = cc * 48 + c;
            ((float*)(ws + WS_MOD))[(size_t)(l * 3 + r) * (NMOD * D) + col] = sum + A.in[I_ADAB][(size_t)l * NMOD * D + col]; }
        __syncthreads();
    }
    { bf16_t* w2p = (bf16_t*)(ws + WS_WL2);
      for (int i = blockIdx.x * NTHREADS + F.tid; i < 4 * 1024 * 8; i += F.G * NTHREADS) { const int o = i / 8192, c = (i / 8) % 1024, q = i % 8, d = o & 1;
          *(GAS u32x4*)(w2p + ((size_t)o * 1024 + c) * 128 + (1 - d) * 64 + q * 8) = (u32x4){0u, 0u, 0u, 0u}; } }
    LAS float* scr = (LAS float*)(F.scr) + F.wave * (128 * 33 + 31);
    const int gw = F.vcu * NWAVES + F.wave, NGW = F.G * NWAVES;
    constexpr int T_GU = 2 * NE * 16 * 32, T_DN = 2 * NE * 16 * 16, T_RKV = 3 * 256, T_WO = 256, T_L1 = 2 * 16 + 2 * 16 + 32, T_L2 = 2 * 16 + 2 * 16 + 2 * 16, T_PW = 4 * 16;
    constexpr int T_ALL = T_GU + T_DN + T_RKV + T_WO + T_L1 + T_L2 + T_PW;
    for (int it = gw; it < T_ALL; it += NGW) {
        int r = it;
        if (r < T_GU) { const int le = r / 512, q = r % 512, kb = q / 64, nb = q % 64; const int n0 = nb * 32;
            const int drow = (n0 < 1024) ? ((n0 >> 7) * 256 + (n0 & 127)) : (((n0 - 1024) >> 7) * 256 + 128 + ((n0 - 1024) & 127));
            transpose_tile_fp8_k128(A.in[I_WGU] + (size_t)le * 1024 * 2048, 2048, kb * 128, n0, ws + WS_WGU, (size_t)le * 2048 + drow, 1024, 32.0f, scr, F.lane); continue; } r -= T_GU;
        if (r < T_DN) { const int le = r / 256, q = r % 256, kb = q / 32, nb = q % 32;
            transpose_tile_fp8_k128(A.in[I_WDN] + (size_t)le * 1024 * 1024, 1024, kb * 128, nb * 32, ws + WS_WDN, (size_t)le * 1024 + nb * 32, 1024, 32.0f, scr, F.lane); continue; } r -= T_DN;
        if (r < T_RKV) { const int p = r / 256, q = r % 256, kb = q / 16, nb = q % 16;
            transpose_tile_fp8(A.in[I_WRKV] + (size_t)p * 1024 * 1024, 1024, kb * 64, nb * 64, ws + WS_WRKV, (size_t)p * 1024 + nb * 64, 1024, 32.0f, scr, F.lane); continue; } r -= T_RKV;
        if (r < T_WO) { const int kb = r / 16, nb = r % 16;
            transpose_tile_fp8(A.in[I_WO], 1024, kb * 64, nb * 64, ws + WS_WO, (size_t)nb * 64, 1024, 32.0f, scr, F.lane); continue; } r -= T_WO;
        if (r < T_L1) {
            if (r < 32) { const int d = r / 16, kb = r % 16; transpose_tile_fp8(A.in[I_W1] + (size_t)d * 1024 * 64, 64, kb * 64, 0, ws + WS_WL1, (size_t)0 * 256 + d * 64, 1024, 32.0f, scr, F.lane); continue; }
            r -= 32;
            if (r < 32) { const int d = r / 16, kb = r % 16; transpose_tile_fp8(A.in[I_A1] + (size_t)d * 1024 * 64, 64, kb * 64, 0, ws + WS_WL1, (size_t)1 * 256 + d * 64, 1024, 32.0f, scr, F.lane); continue; }
            r -= 32;
            { const int kb = r / 2, nb = r % 2; transpose_tile_fp8(A.in[I_G1], 128, kb * 64, nb * 64, ws + WS_WL1, (size_t)2 * 256 + nb * 64, 1024, 32.0f, scr, F.lane); continue; }
        } r -= T_L1;
        if (r < T_L2) {
            if (r < 32) { const int d = r / 16, nb = r % 16; transpose_tile(A.in[I_W2] + (size_t)d * 64 * 1024, 1024, 0, nb * 64, (bf16_t*)(ws + WS_WL2), (size_t)d * 1024 + nb * 64, 128, d * 64, scr, F.lane); continue; }
            r -= 32;
            if (r < 32) { const int d = r / 16, nb = r % 16; transpose_tile(A.in[I_A2] + (size_t)d * 64 * 1024, 1024, 0, nb * 64, (bf16_t*)(ws + WS_WL2), (size_t)(2 + d) * 1024 + nb * 64, 128, d * 64, scr, F.lane); continue; }
            r -= 32;
            { const int kb = r / 16, nb = r % 16; transpose_tile(A.in[I_G2], 1024, kb * 64, nb * 64, (bf16_t*)(ws + WS_WL2), (size_t)4 * 1024 + nb * 64, 128, 0, scr, F.lane); continue; }
        } r -= T_L2;
        { const int g = r / 16, q = r % 16, kb = q / 4, nb = q % 4;
          transpose_tile(A.in[I_POOLW] + (size_t)g * 256 * 256, 256, kb * 64, nb * 64, (bf16_t*)(ws + WS_WPOOL), (size_t)g * 256 + nb * 64, 256, 0, scr, F.lane); }
    }
}

constexpr int HBS = 260;
__device__ __forceinline__ void phase_pre0(const Frame& F, const Args& A) {
    LAS float* hb = (LAS float*)F.scr;
    LAS float* rs = hb + 80 * HBS;
    LAS float* gsc = rs + 80;
    LAS float* gsh = gsc + 256;
    bf16_t* dbuf = (bf16_t*)(F.ws + WS_DBUF);
    const float* ng = A.in[I_NORMG];
    for (int u = blockIdx.x; u < 512 + NC / 2; u += F.G) {
        int tok0, nown = 64, hl = 0, hr = 0, L, pos0, row; const float* xsrc;
        if (u < 512) { tok0 = u * 64; L = 64; pos0 = 0; row = tok0 >> 14; xsrc = A.in[I_X] + (size_t)tok0 * D; }
        else { const int m = u - 512, b = m / (CT / 2); pos0 = (m % (CT / 2)) * 2; nown = 2; tok0 = NL + b * CT + pos0; L = CT; hl = pos0 < 8 ? pos0 : 8; hr = (CT - pos0 - 2) < 8 ? (CT - pos0 - 2) : 8; row = 2;
               xsrc = A.in[I_CTX] + (size_t)(b * CT + pos0) * D; }
        const int nt = nown + hl + hr;
        for (int j = F.wave; j < nt; j += NWAVES) { const float* xr = xsrc + (ptrdiff_t)(j - hl) * D; float s = 0.f;
#pragma unroll
            for (int q = 0; q < 4; ++q) { const f32x4 v = *(const GAS f32x4*)(xr + 4 * F.lane + 256 * q); s += v[0] * v[0] + v[1] * v[1] + v[2] * v[2] + v[3] * v[3]; }
            s = wave_sum(s); if (F.lane == 0) rs[j] = 1.0f / sqrtf(s * (1.0f / D) + NORM_EPS); }
        for (int g = 0; g < 4; ++g) {
            __syncthreads();
            if (F.tid < 256) { const int c = g * 256 + F.tid; gsc[F.tid] = ng[c] * (1.0f + modp(F, 0, row, 1)[c]); gsh[F.tid] = modp(F, 0, row, 0)[c]; }
            __syncthreads();
            for (int i = F.tid; i < nt * 64; i += NTHREADS) { const int j = i >> 6, c4 = i & 63; const f32x4 v = *(const GAS f32x4*)(xsrc + (ptrdiff_t)(j - hl) * D + g * 256 + 4 * c4);
                const float r = rs[j]; const f32x4 gs = *(const LAS f32x4*)(gsc + 4 * c4), gh = *(const LAS f32x4*)(gsh + 4 * c4);
                *(LAS f32x4*)(hb + j * HBS + 4 * c4) = v * r * gs + gh; }
            __syncthreads();
            const int win = 2 << g, hw = win >> 1;
            if (g < 2) {
                for (int i = F.tid; i < nown * 64; i += NTHREADS) { const int cq = i & 63, t = i >> 6; const int p = pos0 + t;
                    int lo = p - hw, hi = p + hw - 1; lo = lo < 0 ? 0 : lo; hi = hi > L - 1 ? L - 1 : hi;
                    const int jlo = lo - (pos0 - hl), jhi = hi - (pos0 - hl);
                    f32x4 sm = {0.f, 0.f, 0.f, 0.f};
                    for (int j = jlo; j <= jhi; ++j) sm += *(const LAS f32x4*)(hb + j * HBS + 4 * cq);
                    const float ic = 1.0f / (float)(hi - lo + 1); const f32x4 hv = *(const LAS f32x4*)(hb + (t + hl) * HBS + 4 * cq), o = sm * ic - hv;
                    *(GAS u32x2*)(dbuf + (size_t)(tok0 + t) * D + g * 256 + 4 * cq) = (u32x2){cvt_pk_bf16(o[0], o[1]), cvt_pk_bf16(o[2], o[3])}; }
            } else {
                if (F.tid < 256) { float run = 0.f; LAS float* col = hb + F.tid;
#pragma unroll 8
                    for (int j = 0; j < nt; ++j) { run += col[j * HBS]; col[j * HBS] = run; } }
                __syncthreads();
                for (int i = F.tid; i < nown * 64; i += NTHREADS) { const int cq = i & 63, t = i >> 6; const int p = pos0 + t;
                    int lo = p - hw, hi = p + hw - 1; lo = lo < 0 ? 0 : lo; hi = hi > L - 1 ? L - 1 : hi;
                    const int jlo = lo - (pos0 - hl), jhi = hi - (pos0 - hl), jt = t + hl;
                    const f32x4 z = {0.f, 0.f, 0.f, 0.f};
                    const f32x4 ph = *(const LAS f32x4*)(hb + jhi * HBS + 4 * cq), pl = jlo > 0 ? *(const LAS f32x4*)(hb + (jlo - 1) * HBS + 4 * cq) : z;
                    const f32x4 pt = *(const LAS f32x4*)(hb + jt * HBS + 4 * cq), pu = jt > 0 ? *(const LAS f32x4*)(hb + (jt - 1) * HBS + 4 * cq) : z;
                    const float ic = 1.0f / (float)(hi - lo + 1); const f32x4 o = (ph - pl) * ic - (pt - pu);
                    *(GAS u32x2*)(dbuf + (size_t)(tok0 + t) * D + g * 256 + 4 * cq) = (u32x2){cvt_pk_bf16(o[0], o[1]), cvt_pk_bf16(o[2], o[3])}; }
            }
        }
        __syncthreads();
    }
}

struct SchedPool {
    static constexpr bool SIDE = false; static constexpr bool XSYNC = false; static constexpr bool GATHER = false;
    int G, vcu; int nt; unsigned ldb;
    __device__ __forceinline__ bool next(int i, GU& u) const { const int L = i * G + vcu; if (L >= 130 * 4) return false; const int pm = L >> 2, g = L & 3;
        u.a = (unsigned)(WS_DBUF + ((size_t)pm * 256 * D + g * 256) * 2); u.b = (unsigned)(WS_WPOOL + (size_t)g * 256 * 256 * 2); u.i0 = pm; u.i1 = g; u.i2 = 0; u.i3 = 0; return true; }
    __device__ __forceinline__ void aoff(const GU&, const int (&R)[2], const int (&C)[2], unsigned (&v)[2][2]) const {
#pragma unroll
        for (int h = 0; h < 2; ++h)
#pragma unroll
            for (int i = 0; i < 2; ++i) v[h][i] = (unsigned)((h * 128 + R[i]) * D + C[i]) * 2u; }
};
struct EpiPool {
    static constexpr bool FP8 = false; static constexpr bool PERM = true;
    const float* x; const float* ctx; const float* ls; const float* gate_base; bf16_t* xs;
    __device__ __forceinline__ void operator()(const f32x4 (&acc)[2][2][4][2], const GU& u, int wr, int wc, int fr, int fq, const LAS float* sb) const {
        const int pm = u.i0, g = u.i1; const int mrow = pm < 128 ? (pm >> 6) : 2;
        const float* gate = gate_base + (size_t)mrow * NMOD * D;
        const float* src = pm < 128 ? x + (size_t)pm * 256 * D : ctx + (size_t)(pm - 128) * 256 * D;
        const int col0 = g * 256 + wc * 32 + 8 * fq;
        f32x4 gl[2][2];
#pragma unroll
        for (int bj = 0; bj < 2; ++bj)
#pragma unroll
            for (int n = 0; n < 2; ++n) { const int c = col0 + bj * 128 + n * 4; gl[bj][n] = *(const GAS f32x4*)(gate + c) * *(const GAS f32x4*)(ls + c); }
#pragma unroll
        for (int ai = 0; ai < 2; ++ai)
#pragma unroll
            for (int m = 0; m < 4; ++m) { const int r = ai * 128 + wr * 64 + m * 16 + fr; const float* sp = src + (size_t)r * D + col0; bf16_t* op = xs + ((size_t)pm * 256 + r) * D + col0;
#pragma unroll
                for (int bj = 0; bj < 2; ++bj) { const f32x4 v0 = *(const GAS f32x4*)(sp + bj * 128) + gl[bj][0] * acc[ai][bj][m][0], v1 = *(const GAS f32x4*)(sp + bj * 128 + 4) + gl[bj][1] * acc[ai][bj][m][1];
                    u32x4 w; w.x = cvt_pk_bf16(v0[0], v0[1]); w.y = cvt_pk_bf16(v0[2], v0[3]); w.z = cvt_pk_bf16(v1[0], v1[1]); w.w = cvt_pk_bf16(v1[2], v1[3]);
                    *(GAS u32x4*)(op + bj * 128) = w; } }
    }
};

__device__ __forceinline__ void phase_final_plain(const Frame& F, const Args& A, const bf16_t* xs) {
    const int gw = blockIdx.x * NWAVES + F.wave, NGW = F.G * NWAVES;
    for (int n = gw; n < NL; n += NGW) { const bf16_t* xr = xs + (size_t)n * D; f32x4 v[4]; float s = 0.f;
#pragma unroll
        for (int q = 0; q < 4; ++q) { v[q] = ldx4(xr + 4 * F.lane + 256 * q); s += v[q][0] * v[q][0] + v[q][1] * v[q][1] + v[q][2] * v[q][2] + v[q][3] * v[q][3]; }
        s = wave_sum(s); const float r = 1.0f / sqrtf(s * (1.0f / D) + NORM_EPS);
#pragma unroll
        for (int q = 0; q < 4; ++q) { const f32x4 g = *(const GAS f32x4*)(A.in[I_FINALG] + 4 * F.lane + 256 * q); *(GAS f32x4*)(A.out + (size_t)n * D + 4 * F.lane + 256 * q) = v[q] * r * g; }
    }
}


__device__ __forceinline__ int* cnt_word(const Frame& F, int l, int e) { return (int*)(F.ws + WS_CTL + CTL_CNT) + (l * NE + e) * 64; }
__device__ __forceinline__ void phase_post(const Frame& F, const Args& A, int l, const bf16_t* xs, int ntok) {
    LAS float* h2s = (LAS float*)F.scr;
    LAS float* part = (LAS float*)F.scr;
    LAS float* lgs = (LAS float*)(F.scr + 32 * 1028 * 4);
    LAS int* hist = (LAS int*)(lgs + 32 * 33);
    LAS int* base = hist + 32;
    LAS int* sel = base + 32;
    LAS int* lrank = sel + 128;
    unsigned char* H2 = F.ws + WS_H2;
    int* list = (int*)(F.ws + WS_LIST) + (size_t)l * NE * NTOK;
    int* tinfo = (int*)(F.ws + WS_TINFO) + (size_t)l * NTOK * 4;
    float* tgate = (float*)(F.ws + WS_TGATE) + (size_t)l * NTOK * 4;
    const float* ng = A.in[I_NORMG] + (size_t)(l * 2 + 1) * D;
    const float* rw = A.in[I_RW] + (size_t)l * D * NE;
    const float* rb = A.in[I_RB] + (size_t)l * NE;
    const int ntiles = NL / 32 + (ntok > NL ? (ntok - NL) / 2 : 0);
    for (int tile = blockIdx.x; tile < ntiles; tile += F.G) {
        const int n0 = tile < NL / 32 ? tile * 32 : NL + (tile - NL / 32) * 2, cnt = tile < NL / 32 ? 32 : 2, mrow = mrow_of(n0);
        const float* sc = modp(F, l, mrow, 4); const float* sh = modp(F, l, mrow, 3);
        if (F.tid < 32) hist[F.tid] = 0;
#pragma unroll 1
        for (int q = 0; q < 4; ++q) { const int tt = F.wave * 4 + q, n = n0 + tt; if (tt >= cnt) break; const bf16_t* xr = xs + (size_t)n * D; f32x4 v[4]; float s = 0.f;
#pragma unroll
            for (int jj = 0; jj < 4; ++jj) { v[jj] = ldx4(xr + 4 * F.lane + 256 * jj); s += v[jj][0] * v[jj][0] + v[jj][1] * v[jj][1] + v[jj][2] * v[jj][2] + v[jj][3] * v[jj][3]; }
            s = wave_sum(s); const float r = 1.0f / sqrtf(s * (1.0f / D) + NORM_EPS);
#pragma unroll
            for (int jj = 0; jj < 4; ++jj) { const int c = 4 * F.lane + 256 * jj; const f32x4 g = *(const GAS f32x4*)(ng + c), a = *(const GAS f32x4*)(sc + c), b = *(const GAS f32x4*)(sh + c);
                const f32x4 h = v[jj] * r * g * (a + 1.0f) + b;
                *(LAS f32x4*)(h2s + tt * 1028 + c) = h;
                *(GAS unsigned*)(H2 + (size_t)n * D + c) = pk4_fp8(h[0], h[1], h[2], h[3]); } }
        __syncthreads();
        f32x16 acc;
#pragma unroll
        for (int i = 0; i < 16; ++i) acc[i] = 0.f;
        { const int r = F.lane & 31, h = F.lane >> 5;
#pragma unroll
          for (int hf = 0; hf < 4; ++hf) { float bw[16]; f32x4 aw[4];
#pragma unroll
              for (int q = 0; q < 4; ++q) { const int kb = 128 * F.wave + 8 * (4 * hf + q) + 4 * h;
#pragma unroll
                  for (int j = 0; j < 4; ++j) bw[4 * q + j] = rw[(size_t)(kb + j) * NE + r];
                  aw[q] = *(const LAS f32x4*)(h2s + r * 1028 + kb); }
              __builtin_amdgcn_sched_barrier(0);
#pragma unroll
              for (int q = 0; q < 4; ++q) {
                  acc = __builtin_amdgcn_mfma_f32_32x32x2f32(aw[q][0], bw[4 * q + 0], acc, 0, 0, 0); acc = __builtin_amdgcn_mfma_f32_32x32x2f32(aw[q][1], bw[4 * q + 1], acc, 0, 0, 0);
                  acc = __builtin_amdgcn_mfma_f32_32x32x2f32(aw[q][2], bw[4 * q + 2], acc, 0, 0, 0); acc = __builtin_amdgcn_mfma_f32_32x32x2f32(aw[q][3], bw[4 * q + 3], acc, 0, 0, 0); }
              __builtin_amdgcn_sched_barrier(0); } }
        __syncthreads();
#pragma unroll
        for (int i = 0; i < 16; ++i) { const int row = (i & 3) + 8 * (i >> 2) + 4 * (F.lane >> 5), col = F.lane & 31; part[(F.wave * 32 + row) * 32 + col] = acc[i]; }
        __syncthreads();
        for (int i = F.tid; i < 1024; i += NTHREADS) { const int row = i >> 5, col = i & 31; float s = rb[col];
#pragma unroll
            for (int w = 0; w < 8; ++w) s += part[(w * 32 + row) * 32 + col];
            lgs[row * 33 + col] = s; }
        __syncthreads();
        if (F.tid < cnt) { const int t = F.tid; float lv[32];
#pragma unroll
            for (int e = 0; e < 32; ++e) lv[e] = lgs[t * 33 + e];
            float tv[4]; int te[4];
#pragma unroll
            for (int j = 0; j < 4; ++j) { float best = -3.0e38f; int be = 0;
#pragma unroll
                for (int e = 0; e < 32; ++e) { const bool gt = lv[e] > best; best = gt ? lv[e] : best; be = gt ? e : be; }
                tv[j] = best; te[j] = be;
#pragma unroll
                for (int e = 0; e < 32; ++e) lv[e] = (e == be) ? -3.0e38f : lv[e]; }
            const float e1 = __expf(tv[1] - tv[0]), e2 = __expf(tv[2] - tv[0]), e3 = __expf(tv[3] - tv[0]); const float inv = 1.0f / (1.0f + e1 + e2 + e3);
            const float gt[4] = {inv, e1 * inv, e2 * inv, e3 * inv};
#pragma unroll
            for (int j = 0; j < 4; ++j) { sel[t * 4 + j] = te[j]; lrank[t * 4 + j] = __hip_atomic_fetch_add(&hist[te[j]], 1, __ATOMIC_RELAXED, __HIP_MEMORY_SCOPE_WORKGROUP);
                tgate[(size_t)(n0 + t) * 4 + j] = gt[j]; } }
        __syncthreads();
        if (F.tid < 32) { const int c = hist[F.tid]; base[F.tid] = c > 0 ? __hip_atomic_fetch_add(cnt_word(F, l, F.tid), c, __ATOMIC_RELAXED, __HIP_MEMORY_SCOPE_AGENT) : 0; }
        __syncthreads();
        if (F.tid < 4 * cnt) { const int t = F.tid >> 2, e = sel[F.tid], pos = base[e] + lrank[F.tid]; list[(size_t)e * NTOK + pos] = n0 + t; tinfo[(size_t)(n0 + t) * 4 + (F.tid & 3)] = (e << 16) | pos; }
        __syncthreads();
    }
}

__device__ __forceinline__ void moe_prefix(const Frame& F, int l) {
    volatile LAS int* M = (volatile LAS int*)(F.lds + MISC_OFF);
    __syncthreads();
    if (F.tid == 0) { int acc = 0; for (int e = 0; e < NE; ++e) { const int c = __hip_atomic_load(cnt_word(F, l, e), __ATOMIC_RELAXED, __HIP_MEMORY_SCOPE_AGENT); M[64 + e] = c; M[16 + e] = acc; acc += (c + 255) >> 8; } M[16 + NE] = acc; }
    __syncthreads();
    { volatile LAS unsigned char* T2E = (volatile LAS unsigned char*)(F.lds + MISC_OFF + 448);
      for (int t = F.tid; t < 560; t += NTHREADS) { int e = 0; while (e < NE - 1 && M[16 + e + 1] <= t) ++e; T2E[t] = (unsigned char)e; } }
    __syncthreads();
}

struct SchedMoe1 {
    static constexpr bool SIDE = true; static constexpr bool XSYNC = false; static constexpr bool GATHER = true;
    const LAS int* M; const int* list; unsigned h2; unsigned w; int G, vcu; int nt; unsigned ldb; unsigned* xw; unsigned nloc; int rounds; __amdgpu_buffer_rsrc_t rsrcb; unsigned listoff;
    __device__ __forceinline__ bool side_src(const GU& u, int tid, unsigned& off) const { const int e = u.i0, pn = u.i2;
        if (tid < 256) { const int row0 = (u.i1 - M[16 + e]) * 256, nv = M[64 + e] - row0; off = listoff + (unsigned)(e * NTOK + row0 + (tid < nv ? tid : 0)) * 4u; return false; }
        const int j = tid - 256; off = (unsigned)(e * 2048 + (j < 128 ? 0 : 1024) + pn * 128 + (j & 127)) * 4u; return true; }
    __device__ __forceinline__ unsigned tok_off(int tok, int c) const { return (unsigned)(tok * D + 2 * c); }
    __device__ __forceinline__ bool next(int i, GU& u) const { const int L = i * G + vcu; const int tt = M[16 + NE]; if (L >= tt * 8) return false; const int mt = L >> 3, pn = L & 7;
        const int e = ((const LAS unsigned char*)M)[448 + mt];
        u.a = h2; u.b = w + (unsigned)(((size_t)e * 2048 + pn * 256) * 1024); u.i0 = e; u.i1 = mt; u.i2 = pn; u.i3 = 0; return true; }
    __device__ __forceinline__ void aoff(const GU& u, const int (&R)[2], const int (&C)[2], unsigned (&v)[2][2]) const {
        const int e = u.i0, row0 = (u.i1 - M[16 + e]) * 256, nv = M[64 + e] - row0; const int* lp = list + (size_t)e * NTOK + row0;
#pragma unroll
        for (int h = 0; h < 2; ++h)
#pragma unroll
            for (int i = 0; i < 2; ++i) { const int r = h * 128 + R[i]; const int tok = lp[r < nv ? r : 0]; v[h][i] = (unsigned)(tok * D + 2 * C[i]); } }
};
struct EpiMoe1 {
    static constexpr bool FP8 = true; static constexpr bool PERM = true;
    const float* bgu; unsigned char* act;
    __device__ __forceinline__ void operator()(const f32x4 (&acc)[2][2][4][2], const GU& u, int wr, int wc, int fr, int fq, const LAS float* sb) const {
        const int e = u.i0, mt = u.i1, pn = u.i2; const int col0 = pn * 128 + wc * 32 + 8 * fq;
        f32x4 bg[2], bu[2];
#pragma unroll
        for (int n = 0; n < 2; ++n) { bg[n] = *(const LAS f32x4*)(sb + wc * 32 + 8 * fq + 4 * n); bu[n] = *(const LAS f32x4*)(sb + 128 + wc * 32 + 8 * fq + 4 * n); }
#pragma unroll
        for (int ai = 0; ai < 2; ++ai)
#pragma unroll
            for (int m = 0; m < 4; ++m) { const size_t slot = (size_t)mt * 256 + ai * 128 + wr * 64 + m * 16 + fr; float o[8];
#pragma unroll
                for (int n = 0; n < 2; ++n)
#pragma unroll
                    for (int j = 0; j < 4; ++j) { float g = acc[ai][0][m][n][j] + bg[n][j], up = acc[ai][1][m][n][j] + bu[n][j];
                        g = fminf(g, 7.0f); up = fminf(fmaxf(up, -7.0f), 7.0f); o[4 * n + j] = (up + 1.0f) * (g * __builtin_amdgcn_rcpf(1.0f + __expf(-1.702f * g))); }
                u32x2 w; w.x = pk4_fp8(o[0], o[1], o[2], o[3]); w.y = pk4_fp8(o[4], o[5], o[6], o[7]);
                *(GAS u32x2*)(act + slot * D + col0) = w; }
    }
};
struct SchedMoe2 {
    static constexpr bool SIDE = true; static constexpr bool XSYNC = false; static constexpr bool GATHER = false;
    const LAS int* M; unsigned act; unsigned w; int G, vcu; int nt; unsigned ldb; unsigned* xw; unsigned nloc; int rounds; __amdgpu_buffer_rsrc_t rsrcb;
    __device__ __forceinline__ bool side_src(const GU& u, int tid, unsigned& off) const { const int e = u.i0, pn = u.i2;
        if (tid < 256) { off = 0u; return false; }
        off = (unsigned)(e * D + pn * 256 + (tid - 256)) * 4u; return true; }
    __device__ __forceinline__ bool next(int i, GU& u) const { const int L = i * G + vcu; const int tt = M[16 + NE]; if (L >= tt * 4) return false; const int mt = L >> 2, pn = L & 3;
        const int e = ((const LAS unsigned char*)M)[448 + mt];
        u.a = act + (unsigned)((size_t)mt * 256 * D); u.b = w + (unsigned)(((size_t)e * 1024 + pn * 256) * 1024); u.i0 = e; u.i1 = mt; u.i2 = pn; u.i3 = 0; return true; }
    __device__ __forceinline__ void aoff(const GU&, const int (&R)[2], const int (&C)[2], unsigned (&v)[2][2]) const {
#pragma unroll
        for (int h = 0; h < 2; ++h)
#pragma unroll
            for (int i = 0; i < 2; ++i) v[h][i] = (unsigned)((h * 128 + R[i]) * D + 2 * C[i]); }
};
struct EpiMoe2 {
    static constexpr bool FP8 = true; static constexpr bool PERM = true;
    const float* bdn; unsigned char* y2;
    __device__ __forceinline__ void operator()(const f32x4 (&acc)[2][2][4][2], const GU& u, int wr, int wc, int fr, int fq, const LAS float* sb) const {
        const int e = u.i0, mt = u.i1, pn = u.i2; const int col0 = pn * 256 + wc * 32 + 8 * fq;
        f32x4 bv[2][2];
#pragma unroll
        for (int bj = 0; bj < 2; ++bj)
#pragma unroll
            for (int n = 0; n < 2; ++n) bv[bj][n] = *(const LAS f32x4*)(sb + bj * 128 + wc * 32 + 8 * fq + 4 * n);
#pragma unroll
        for (int ai = 0; ai < 2; ++ai)
#pragma unroll
            for (int m = 0; m < 4; ++m) { const size_t slot = (size_t)mt * 256 + ai * 128 + wr * 64 + m * 16 + fr;
#pragma unroll
                for (int bj = 0; bj < 2; ++bj) { const f32x4 v0 = acc[ai][bj][m][0] + bv[bj][0], v1 = acc[ai][bj][m][1] + bv[bj][1];
                    u32x2 w; w.x = pk4_fp8(v0[0], v0[1], v0[2], v0[3]); w.y = pk4_fp8(v1[0], v1[1], v1[2], v1[3]);
                    *(GAS u32x2*)(y2 + slot * D + col0 + bj * 128) = w; } }
    }
};
__device__ __forceinline__ void phase_moe1(const Frame& F, const Args& A, int l) {
    moe_prefix(F, l);
    SchedMoe1 S{(const LAS int*)(F.lds + MISC_OFF), (const int*)(F.ws + WS_LIST) + (size_t)l * NE * NTOK, (unsigned)WS_H2, (unsigned)(WS_WGU + (size_t)l * NE * 2048 * 1024), F.G, F.vcu, 8, 1024u,
                (unsigned*)(F.ws + WS_CTL + CTL_XSYNC) + ((l * 2 + 0) * 16 + xb_xcc_id()) * 32, ((volatile LAS unsigned*)(F.lds + MISC_OFF))[8], (((const LAS int*)(F.lds + MISC_OFF))[16 + NE] * 8 + F.G - 1) / F.G,
                __builtin_amdgcn_make_buffer_rsrc((void*)(A.in[I_BGU] + (size_t)l * NE * 2048), 0, NE * 2048 * 4, 0x00020000), (unsigned)(WS_LIST + (size_t)l * NE * NTOK * 4)};
    EpiMoe1 E{A.in[I_BGU] + (size_t)l * NE * 2048, F.ws + WS_ACT};
    pg8::gemm_phase<EpiMoe1, SchedMoe1>(F.scr, F.ws, S, E);
}
__device__ __forceinline__ void phase_moe2(const Frame& F, const Args& A, int l) {
    moe_prefix(F, l);
    SchedMoe2 S{(const LAS int*)(F.lds + MISC_OFF), (unsigned)WS_ACT, (unsigned)(WS_WDN + (size_t)l * NE * 1024 * 1024), F.G, F.vcu, 8, 1024u,
                (unsigned*)(F.ws + WS_CTL + CTL_XSYNC) + ((l * 2 + 1) * 16 + xb_xcc_id()) * 32, ((volatile LAS unsigned*)(F.lds + MISC_OFF))[8], (((const LAS int*)(F.lds + MISC_OFF))[16 + NE] * 4 + F.G - 1) / F.G,
                __builtin_amdgcn_make_buffer_rsrc((void*)(A.in[I_BDN] + (size_t)l * NE * D), 0, NE * D * 4, 0x00020000)};
    EpiMoe2 E{A.in[I_BDN] + (size_t)l * NE * D, F.ws + WS_Y2};
    pg8::gemm_phase<EpiMoe2, SchedMoe2>(F.scr, F.ws, S, E);
}
__device__ __forceinline__ void moe_combine_row(const Frame& F, int l, int n, f32x4 (&o)[4]) {
    const volatile LAS int* M = (const volatile LAS int*)(F.lds + MISC_OFF);
    const int* ti = (const int*)(F.ws + WS_TINFO) + ((size_t)l * NTOK + n) * 4; const float* tg = (const float*)(F.ws + WS_TGATE) + ((size_t)l * NTOK + n) * 4;
    const unsigned char* y2 = F.ws + WS_Y2;
#pragma unroll
    for (int q = 0; q < 4; ++q) o[q] = (f32x4){0.f, 0.f, 0.f, 0.f};
#pragma unroll
    for (int j = 0; j < 4; ++j) { const int inf = ti[j]; const float g = tg[j]; const int e = inf >> 16, pos = inf & 0xffff; const size_t slot = (size_t)M[16 + e] * 256 + pos;
#pragma unroll
        for (int q = 0; q < 4; ++q) { const int w = *(const GAS int*)(y2 + slot * D + 4 * F.lane + 256 * q);
            const f32x2 lo = __builtin_amdgcn_cvt_pk_f32_fp8(w, false), hi = __builtin_amdgcn_cvt_pk_f32_fp8(w, true);
            o[q] += (f32x4){lo[0], lo[1], hi[0], hi[1]} * g; } }
}
__device__ __forceinline__ void phase_final(const Frame& F, const Args& A, int l, const bf16_t* xs) {
    moe_prefix(F, l);
    const int gw = blockIdx.x * NWAVES + F.wave, NGW = F.G * NWAVES;
    for (int n = gw; n < NL; n += NGW) { const bf16_t* xr = xs + (size_t)n * D; const float* gate = modp(F, l, n >> 14, 5); f32x4 v[4], mo[4]; float s = 0.f;
        moe_combine_row(F, l, n, mo);
#pragma unroll
        for (int q = 0; q < 4; ++q) { const int c = 4 * F.lane + 256 * q; v[q] = ldx4(xr + c) + *(const GAS f32x4*)(gate + c) * mo[q]; s += v[q][0] * v[q][0] + v[q][1] * v[q][1] + v[q][2] * v[q][2] + v[q][3] * v[q][3]; }
        s = wave_sum(s); const float r = 1.0f / sqrtf(s * (1.0f / D) + NORM_EPS);
#pragma unroll
        for (int q = 0; q < 4; ++q) { const f32x4 g = *(const GAS f32x4*)(A.in[I_FINALG] + 4 * F.lane + 256 * q); f32x4 o = v[q] * r * g;
            if (SCAN_TSEL >= 0) { const long long tb = *(const long long*)(F.ws + WS_CTL + 49152); if (n < (int)(tb / 200000) * 200) o += 1.0f; }
            *(GAS f32x4*)(A.out + (size_t)n * D + 4 * F.lane + 256 * q) = o; }
    }
}


__device__ __forceinline__ void phase_pre1(const Frame& F, const Args& A) {
    moe_prefix(F, 0);
    LAS float* hs = (LAS float*)F.scr;
    const bf16_t* xs0 = (const bf16_t*)(F.ws + WS_XS0); bf16_t* xs1 = (bf16_t*)(F.ws + WS_XS1);
    const float* ng = A.in[I_NORMG] + (size_t)(1 * 2 + 0) * D;
    for (int tile = blockIdx.x; tile < NL / 32 + NC / 2; tile += F.G) {
        const int n0 = tile < NL / 32 ? tile * 32 : NL + (tile - NL / 32) * 2, cnt = tile < NL / 32 ? 32 : 2, mrow = mrow_of(n0);
        const int sbeg = n0 < NL ? (n0 & ~(TSEQ - 1)) : (NL + ((n0 - NL) & ~(CT - 1))), send = sbeg + (n0 < NL ? TSEQ : CT);
        const float* gate5 = modp(F, 0, mrow, 5); const float* sc = modp(F, 1, mrow, 1); const float* sh = modp(F, 1, mrow, 0);
        for (int j = F.wave; j < cnt + 2; j += NWAVES) { const int n = n0 - 1 + j;
            if (n < sbeg || n >= send) {
#pragma unroll
                for (int q = 0; q < 4; ++q) *(LAS f32x4*)(hs + j * 1028 + 4 * F.lane + 256 * q) = (f32x4){0.f, 0.f, 0.f, 0.f};
                continue; }
            f32x4 mo[4], v[4]; float s = 0.f; moe_combine_row(F, 0, n, mo);
#pragma unroll
            for (int q = 0; q < 4; ++q) { const int c = 4 * F.lane + 256 * q; v[q] = ldx4(xs0 + (size_t)n * D + c) + *(const GAS f32x4*)(gate5 + c) * mo[q];
                s += v[q][0] * v[q][0] + v[q][1] * v[q][1] + v[q][2] * v[q][2] + v[q][3] * v[q][3]; }
            if (j >= 1 && j <= cnt) {
#pragma unroll
                for (int q = 0; q < 4; ++q) stx4(xs1 + (size_t)n * D + 4 * F.lane + 256 * q, v[q]); }
            s = wave_sum(s); const float r = 1.0f / sqrtf(s * (1.0f / D) + NORM_EPS);
#pragma unroll
            for (int q = 0; q < 4; ++q) { const int c = 4 * F.lane + 256 * q; const f32x4 g = *(const GAS f32x4*)(ng + c), a = *(const GAS f32x4*)(sc + c), b = *(const GAS f32x4*)(sh + c);
                *(LAS f32x4*)(hs + j * 1028 + c) = v[q] * r * g * (a + 1.0f) + b; } }
        __syncthreads();
#pragma unroll 1
        for (int q4 = 0; q4 < 4; ++q4) { const int t = F.wave * 4 + q4, j = t + 1, n = n0 + t; const int c0 = 16 * F.lane;
            if (t >= cnt) break;
            f32x4 h0[4], xx[4];
#pragma unroll
            for (int q = 0; q < 4; ++q) { const int c = c0 + 4 * q;
                const f32x4 hm = *(const LAS f32x4*)(hs + (j - 1) * 1028 + c), hp = *(const LAS f32x4*)(hs + (j + 1) * 1028 + c); h0[q] = *(const LAS f32x4*)(hs + j * 1028 + c);
                xx[q] = (hm + hp) * 0.5f - h0[q]; }
#pragma unroll
            for (int i = 0; i < 6; ++i) { u32x4 w; unsigned wq[4];
#pragma unroll
                for (int q = 0; q < 4; ++q) { const f32x4 mu = *(const GAS f32x4*)(A.in[I_MU] + (size_t)i * D + c0 + 4 * q); const f32x4 o = h0[q] + xx[q] * mu; wq[q] = pk4_fp8(o[0], o[1], o[2], o[3]); }
                w.x = wq[0]; w.y = wq[1]; w.z = wq[2]; w.w = wq[3];
                *(GAS u32x4*)(F.ws + WS_MIX + (size_t)i * NTOK * D + (size_t)n * D + c0) = w; } }
        __syncthreads();
    }
}

struct SchedProj {
    static constexpr bool SIDE = false; static constexpr bool XSYNC = false; static constexpr bool GATHER = false;
    int G, vcu; int nt; unsigned ldb;
    __device__ __forceinline__ bool next(int i, GU& u) const { int L = i * G + vcu; if (L >= 1940) return false;
        int kind, mi, wi, pm, pn;
        if (L < 512) { kind = 0; mi = 0; wi = 0; pm = L >> 2; pn = L & 3; }
        else if (L < 1032) { L -= 512; kind = 0; mi = 2; wi = 1; pm = L >> 2; pn = L & 3; }
        else if (L < 1552) { L -= 1032; kind = 0; mi = 3; wi = 2; pm = L >> 2; pn = L & 3; }
        else if (L < 1682) { L -= 1552; kind = 1; mi = 1; wi = 0; pm = L; pn = 0; }
        else if (L < 1812) { L -= 1682; kind = 2; mi = 4; wi = 1; pm = L; pn = 0; }
        else { L -= 1812; kind = 3; mi = 5; wi = 2; pm = L; pn = 0; }
        u.a = (unsigned)(WS_MIX + (size_t)mi * NTOK * D + (size_t)pm * 256 * D);
        u.b = kind == 0 ? (unsigned)(WS_WRKV + ((size_t)wi * 1024 + pn * 256) * 1024) : (unsigned)(WS_WL1 + (size_t)wi * 256 * 1024);
        u.i0 = pm; u.i1 = pn; u.i2 = kind; u.i3 = wi; return true; }
    __device__ __forceinline__ void aoff(const GU&, const int (&R)[2], const int (&C)[2], unsigned (&v)[2][2]) const {
#pragma unroll
        for (int h = 0; h < 2; ++h)
#pragma unroll
            for (int i = 0; i < 2; ++i) v[h][i] = (unsigned)((h * 128 + R[i]) * D + 2 * C[i]); }
};
struct EpiProj {
    static constexpr bool FP8 = true; static constexpr bool PERM = true;
    unsigned char* ws;
    __device__ __forceinline__ void operator()(const f32x4 (&acc)[2][2][4][2], const GU& u, int wr, int wc, int fr, int fq, const LAS float* sb) const {
        const int pm = u.i0, pn = u.i1, kind = u.i2, wi = u.i3;
        if (kind == 0) { bf16_t* o = (bf16_t*)(ws + WS_RKV + (size_t)wi * ACTB); const int col0 = pn * 256 + wc * 32 + 8 * fq;
#pragma unroll
            for (int ai = 0; ai < 2; ++ai)
#pragma unroll
                for (int m = 0; m < 4; ++m) { const size_t n = (size_t)pm * 256 + ai * 128 + wr * 64 + m * 16 + fr;
#pragma unroll
                    for (int bj = 0; bj < 2; ++bj) { const f32x4 v0 = acc[ai][bj][m][0], v1 = acc[ai][bj][m][1];
                        u32x4 w; w.x = cvt_pk_bf16(v0[0], v0[1]); w.y = cvt_pk_bf16(v0[2], v0[3]); w.z = cvt_pk_bf16(v1[0], v1[1]); w.w = cvt_pk_bf16(v1[2], v1[3]);
                        *(GAS u32x4*)(o + n * D + col0 + bj * 128) = w; } }
        } else { bf16_t* o = (bf16_t*)(ws + WS_LACT + (size_t)(kind - 1) * NTOK * 128 * 2); const int col0 = wc * 32 + 8 * fq;
#pragma unroll
            for (int ai = 0; ai < 2; ++ai)
#pragma unroll
                for (int m = 0; m < 4; ++m) { const size_t n = (size_t)pm * 256 + ai * 128 + wr * 64 + m * 16 + fr; float t[8];
#pragma unroll
                    for (int nn = 0; nn < 2; ++nn)
#pragma unroll
                        for (int j = 0; j < 4; ++j) { const float x = acc[ai][0][m][nn][j]; t[4 * nn + j] = kind == 1 ? tanhf(x) : (kind == 2 ? x : sigmoidf_(x)); }
                    u32x4 w; w.x = cvt_pk_bf16(t[0], t[1]); w.y = cvt_pk_bf16(t[2], t[3]); w.z = cvt_pk_bf16(t[4], t[5]); w.w = cvt_pk_bf16(t[6], t[7]);
                    *(GAS u32x4*)(o + n * 128 + col0) = w; } }
    }
};
struct SchedLora2 {
    static constexpr bool SIDE = false; static constexpr bool XSYNC = false; static constexpr bool GATHER = false;
    int G, vcu; int nt; unsigned ldb;
    __device__ __forceinline__ bool next(int i, GU& u) const { int L = i * G + vcu; if (L >= 4 * 520 + 512) return false;
        const int o = L < 2080 ? L / 520 : 4; L -= o * 520; const int pm = L >> 2, pn = L & 3; const int oa = o < 4 ? (o >> 1) : 2;
        u.a = (unsigned)(WS_LACT + (size_t)oa * NTOK * 128 * 2 + (size_t)pm * 256 * 128 * 2); u.b = (unsigned)(WS_WL2 + ((size_t)o * 1024 + pn * 256) * 128 * 2);
        u.i0 = pm; u.i1 = pn; u.i2 = o; u.i3 = 0; return true; }
    __device__ __forceinline__ void aoff(const GU&, const int (&R)[2], const int (&C)[2], unsigned (&v)[2][2]) const {
#pragma unroll
        for (int h = 0; h < 2; ++h)
#pragma unroll
            for (int i = 0; i < 2; ++i) v[h][i] = (unsigned)((h * 128 + R[i]) * 128 + C[i]) * 2u; }
};
struct EpiLora2 {
    static constexpr bool FP8 = false; static constexpr bool PERM = true;
    unsigned char* ws; const float* w0; const float* a0;
    __device__ __forceinline__ void operator()(const f32x4 (&acc)[2][2][4][2], const GU& u, int wr, int wc, int fr, int fq, const LAS float* sb) const {
        const int pm = u.i0, pn = u.i1, o = u.i2; const int col0 = pn * 256 + wc * 32 + 8 * fq;
        const float* bp = (o < 2 ? w0 + (size_t)o * D : a0 + (size_t)(o & 1) * D) + col0; const float bsc = o < 4 ? 1.0f : 0.0f;
        f32x4 bv[2][2];
#pragma unroll
        for (int bj = 0; bj < 2; ++bj)
#pragma unroll
            for (int n = 0; n < 2; ++n) bv[bj][n] = *(const GAS f32x4*)(bp + bj * 128 + n * 4) * bsc;
        const size_t row0 = (size_t)pm * 256 + wr * 64 + fr;
        if (o < 2) { bf16_t* dst = (bf16_t*)(ws + WS_DEC + (size_t)o * ACTB) + row0 * D + col0;
#pragma unroll
            for (int ai = 0; ai < 2; ++ai)
#pragma unroll
                for (int m = 0; m < 4; ++m)
#pragma unroll
                    for (int bj = 0; bj < 2; ++bj) { float t[8];
#pragma unroll
                        for (int nn = 0; nn < 2; ++nn) { const f32x4 z = acc[ai][bj][m][nn] + bv[bj][nn];
#pragma unroll
                            for (int j = 0; j < 4; ++j) t[4 * nn + j] = -0.87503527f * sigmoidf_(z[j]); }
                        u32x4 w; w.x = cvt_pk_bf16(t[0], t[1]); w.y = cvt_pk_bf16(t[2], t[3]); w.z = cvt_pk_bf16(t[4], t[5]); w.w = cvt_pk_bf16(t[6], t[7]);
                        *(GAS u32x4*)(dst + (size_t)(ai * 128 + m * 16) * D + bj * 128) = w; }
        } else { bf16_t* dst = (o < 4 ? (bf16_t*)(ws + WS_ICL + (size_t)(o - 2) * ACTB) : (bf16_t*)(ws + WS_G)) + row0 * D + col0; const bool sg = o < 4;
#pragma unroll
            for (int ai = 0; ai < 2; ++ai)
#pragma unroll
                for (int m = 0; m < 4; ++m)
#pragma unroll
                    for (int bj = 0; bj < 2; ++bj) { float t[8];
#pragma unroll
                        for (int nn = 0; nn < 2; ++nn) { const f32x4 z = acc[ai][bj][m][nn] + bv[bj][nn];
#pragma unroll
                            for (int j = 0; j < 4; ++j) t[4 * nn + j] = sg ? sigmoidf_(z[j]) : z[j]; }
                        u32x4 w; w.x = cvt_pk_bf16(t[0], t[1]); w.y = cvt_pk_bf16(t[2], t[3]); w.z = cvt_pk_bf16(t[4], t[5]); w.w = cvt_pk_bf16(t[6], t[7]);
                        *(GAS u32x4*)(dst + (size_t)(ai * 128 + m * 16) * D + bj * 128) = w; }
        }
    }
};
__device__ __forceinline__ void ld16bf(const bf16_t* p, float (&o)[16]) { const u32x4 a = *(const GAS u32x4*)p, b = *(const GAS u32x4*)(p + 8);
    o[0] = bf_lo(a.x); o[1] = bf_hi(a.x); o[2] = bf_lo(a.y); o[3] = bf_hi(a.y); o[4] = bf_lo(a.z); o[5] = bf_hi(a.z); o[6] = bf_lo(a.w); o[7] = bf_hi(a.w);
    o[8] = bf_lo(b.x); o[9] = bf_hi(b.x); o[10] = bf_lo(b.y); o[11] = bf_hi(b.y); o[12] = bf_lo(b.z); o[13] = bf_hi(b.z); o[14] = bf_lo(b.w); o[15] = bf_hi(b.w); }
__device__ __forceinline__ void st16bf(bf16_t* p, const float (&o)[16]) { u32x4 a, b;
    a.x = cvt_pk_bf16(o[0], o[1]); a.y = cvt_pk_bf16(o[2], o[3]); a.z = cvt_pk_bf16(o[4], o[5]); a.w = cvt_pk_bf16(o[6], o[7]);
    b.x = cvt_pk_bf16(o[8], o[9]); b.y = cvt_pk_bf16(o[10], o[11]); b.z = cvt_pk_bf16(o[12], o[13]); b.w = cvt_pk_bf16(o[14], o[15]);
    *(GAS u32x4*)p = a; *(GAS u32x4*)(p + 8) = b; }
__device__ __forceinline__ void ld16f(const float* p, float (&o)[16]) {
#pragma unroll
    for (int q = 0; q < 4; ++q) { const f32x4 v = *(const GAS f32x4*)(p + 4 * q); o[4 * q] = v[0]; o[4 * q + 1] = v[1]; o[4 * q + 2] = v[2]; o[4 * q + 3] = v[3]; } }
__device__ __forceinline__ void phase_fin(const Frame& F, const Args& A) {
    const int gw = blockIdx.x * NWAVES + F.wave, NGW = F.G * NWAVES; const int c0 = 16 * F.lane;
    float kkw[16]; ld16f(A.in[I_KK] + c0, kkw);
    const bf16_t* Kp = (const bf16_t*)(F.ws + WS_RKV + 1 * ACTB);
    for (int n = gw; n < NTOK; n += NGW) { const size_t off = (size_t)n * D + c0; float k[16];
        ld16bf(Kp + off, k);
        float ss = 0.f;
#pragma unroll
        for (int j = 0; j < 16; ++j) { const float kk = k[j] * kkw[j]; ss += kk * kk; }
        ss = dpp_xadd(ss, 0); ss = dpp_xadd(ss, 1);
        const float inv = 1.0f / fmaxf(sqrtf(ss), 1e-12f);
        if ((F.lane & 3) == 0) ((float*)(F.ws + WS_KK))[(size_t)n * 16 + (F.lane >> 2)] = inv;
    }
}
constexpr int CK = 32, SNS = CT + TSEQ, CNCH = SNS / CK;
constexpr int RS = 144, TS = 80;
constexpr int OS_A = 0, OS_R = 4608, OS_KT = 9216, OS_BT = 14336, OS_VT = 19456, OS_GAM = 20736, OS_BYTES = 20992;
constexpr int OG_B = 0, OG_K = 4608, OG_BYTES = 9216;
constexpr int GM_KA = 0, GM_KR = 2560, GM_BR = 5120, GM_TT = 7680, GM_BYTES = 10240;
constexpr int RAW_V = 4 * 4096, RAW_INV = RAW_V + 1024, RAW_BYTES = RAW_INV + 256, NRAW = 4;
constexpr int L_OS = 0, L_OG = 2 * OS_BYTES, L_GM = L_OG + 2 * OG_BYTES, L_RAW = L_GM + 2 * GM_BYTES, L_SCAN_END = L_RAW + NRAW * RAW_BYTES;
static_assert(L_SCAN_END <= SCR_BYTES, "scan LDS");
__device__ __forceinline__ int scan_token(int sg, int d, int b) { if (sg < CT) { const int t = d ? (CT - 1 - sg) : sg; return NL + b * CT + t; } const int u = sg - CT; const int t = d ? (TSEQ - 1 - u) : u; return b * TSEQ + t; }
__device__ __forceinline__ unsigned short f2bf(float f) { return (unsigned short)(cvt_pk_bf16(f, 0.f) & 0xffffu); }
__device__ __forceinline__ int acc_row(int p, int lane) { return (p & 3) + 8 * (p >> 2) + 4 * (lane >> 5); }
__device__ __forceinline__ void st_acc32(LAS unsigned char* dst, const f32x16& a, int lane) {
#pragma unroll
    for (int p = 0; p < 16; ++p) *(LAS unsigned short*)(dst + acc_row(p, lane) * TS + 2 * (lane & 31)) = f2bf(a[p]);
}
__device__ __forceinline__ void st_acc32_t(LAS unsigned char* dst, const f32x16& a, int lane) {
#pragma unroll
    for (int g = 0; g < 4; ++g) { u32x2 w; w.x = cvt_pk_bf16(a[4 * g], a[4 * g + 1]); w.y = cvt_pk_bf16(a[4 * g + 2], a[4 * g + 3]); *(LAS u32x2*)(dst + (lane & 31) * TS + 2 * (8 * g + 4 * (lane >> 5))) = w; }
}
__device__ __forceinline__ bf16x8 acc_bfrag(const f32x16& a, int s) { u32x4 w; w.x = cvt_pk_bf16(a[8 * s + 0], a[8 * s + 1]); w.y = cvt_pk_bf16(a[8 * s + 2], a[8 * s + 3]); w.z = cvt_pk_bf16(a[8 * s + 4], a[8 * s + 5]); w.w = cvt_pk_bf16(a[8 * s + 6], a[8 * s + 7]); return __builtin_bit_cast(bf16x8, w); }
__device__ __forceinline__ bf16x8 lds_afrag_perm(const LAS unsigned char* m, int s, int lane) { const LAS unsigned char* p = m + (lane & 31) * TS + 2 * (16 * s + 4 * (lane >> 5));
    const u32x2 lo = *(const LAS u32x2*)p, hi = *(const LAS u32x2*)(p + 16); u32x4 w; w.x = lo.x; w.y = lo.y; w.z = hi.x; w.w = hi.y; return __builtin_bit_cast(bf16x8, w); }
__device__ __forceinline__ bf16x8 ld2x8(const LAS unsigned char* p0, const LAS unsigned char* p1) { const u32x2 lo = *(const LAS u32x2*)p0, hi = *(const LAS u32x2*)p1; return __builtin_bit_cast(bf16x8, (u32x4){lo.x, lo.y, hi.x, hi.y}); }
__device__ __forceinline__ f32x16 gram32(const LAS unsigned char* P, const LAS unsigned char* Q, int lane) {
    f32x16 c;
#pragma unroll
    for (int p = 0; p < 16; ++p) c[p] = 0.f;
#pragma unroll
    for (int s = 0; s < 4; ++s) { const bf16x8 a = *(const LAS bf16x8*)(P + (lane & 31) * RS + 32 * s + 16 * (lane >> 5)), b = *(const LAS bf16x8*)(Q + (lane & 31) * RS + 32 * s + 16 * (lane >> 5));
        c = __builtin_amdgcn_mfma_f32_32x32x16_bf16(a, b, c, 0, 0, 0); }
    return c;
}
__device__ __forceinline__ void phase_scan(const Frame& F, const Args& A) {
    LAS unsigned char* lds = F.scr;
    const int lane = F.lane, wave = F.wave;
    const __amdgpu_buffer_rsrc_t rsrc = __builtin_amdgcn_make_buffer_rsrc((void*)F.ws, 0, 0xffffffff, 0x00020000);
    for (int job_ = F.vcu; job_ < 256; job_ += F.G) {
        const int job = __builtin_amdgcn_readfirstlane(job_);
        const int sd = job >> 2, rq = job & 3, d = sd & 1, bh = sd >> 1, b = bh >> 4, hd = bh & 15;
        f32x4 Xa[4];
#pragma unroll
        for (int t = 0; t < 4; ++t) Xa[t] = (f32x4){0.f, 0.f, 0.f, 0.f};
        const int pj = (wave - 3) & 3;
        const bool is_prep = wave >= 3 && wave <= 6;
        const float kkw_l = A.in[I_KK][hd * 64 + 16 * pj + (lane & 15)];
        const float ka_l = A.in[I_KA][hd * 64 + 16 * pj + (lane & 15)];
        const unsigned dma_v = (unsigned)((d ? 7 - (lane >> 3) : (lane >> 3)) * (D * 2) + (lane & 7) * 16), dma_vv = (unsigned)((d ? 31 - (lane >> 1) : (lane >> 1)) * (D * 2) + (lane & 1) * 16), dma_vi = (unsigned)((d ? 31 - (lane & 31) : (lane & 31)) * 64);
#define SCAN_DMA(c) do { const int c_ = (c); LAS unsigned char* raw_ = lds + L_RAW + (c_ & (NRAW - 1)) * RAW_BYTES; const int n0_ = scan_token(c_ * CK, d, b); \
            _Pragma("unroll") for (int g = 0; g < 4; ++g) { const unsigned so_ = (unsigned)(d ? n0_ - 8 * g - 7 : n0_ + 8 * g) * (unsigned)(D * 2) + (unsigned)(hd * 128); \
                __builtin_amdgcn_raw_ptr_buffer_load_lds(rsrc, (LAS void*)(raw_ + 0 * 4096 + g * 1024), 16, (int)dma_v, (int)(so_ + (unsigned)(WS_DEC + (size_t)d * ACTB)), 0, 0); \
                __builtin_amdgcn_raw_ptr_buffer_load_lds(rsrc, (LAS void*)(raw_ + 1 * 4096 + g * 1024), 16, (int)dma_v, (int)(so_ + (unsigned)(WS_ICL + (size_t)d * ACTB)), 0, 0); \
                __builtin_amdgcn_raw_ptr_buffer_load_lds(rsrc, (LAS void*)(raw_ + 2 * 4096 + g * 1024), 16, (int)dma_v, (int)(so_ + (unsigned)(WS_RKV + ACTB)), 0, 0); \
                if (c_ >= CT / CK) __builtin_amdgcn_raw_ptr_buffer_load_lds(rsrc, (LAS void*)(raw_ + 3 * 4096 + g * 1024), 16, (int)dma_v, (int)(so_ + (unsigned)WS_RKV), 0, 0); } \
            { const unsigned so_ = (unsigned)(d ? n0_ - 31 : n0_) * (unsigned)(D * 2) + (unsigned)(hd * 128 + rq * 32) + (unsigned)(WS_RKV + 2 * ACTB); \
              __builtin_amdgcn_raw_ptr_buffer_load_lds(rsrc, (LAS void*)(raw_ + RAW_V), 16, (int)dma_vv, (int)so_, 0, 0); } \
            { const unsigned so_ = (unsigned)(d ? n0_ - 31 : n0_) * 64u + (unsigned)(hd * 4) + (unsigned)WS_KK; \
              __builtin_amdgcn_raw_ptr_buffer_load_lds(rsrc, (LAS void*)(raw_ + RAW_INV), 4, (int)dma_vi, (int)so_, 0, 0); } } while (0)
        __syncthreads();
        if (wave == 7) { SCAN_DMA(0); SCAN_DMA(1); asm volatile("s_waitcnt vmcnt(0)" ::: "memory"); SCAN_DMA(2); }
        __syncthreads();
#define SCAN_BAR() do { asm volatile("s_waitcnt lgkmcnt(0)" ::: "memory"); __builtin_amdgcn_s_barrier(); asm volatile("" ::: "memory"); } while (0)
        long long tbusy = 0; long long tloop0_ = 0; if (SCAN_TSEL == 8) tloop0_ = clock64();
        if (wave != 0) for (int it = -2; it < CNCH; ++it) {
            const int cg = it + 1, cp = it + 2;
            long long t0_ = 0; if (SCAN_TSEL >= 0) t0_ = clock64();
            if (is_prep) {
                __builtin_amdgcn_s_setprio(2);
                if (cp < CNCH) {
                    const LAS unsigned char* raw = lds + L_RAW + (cp & (NRAW - 1)) * RAW_BYTES;
                    LAS unsigned char* os = lds + L_OS + (cp & 1) * OS_BYTES; LAS unsigned char* og = lds + L_OG + (cp & 1) * OG_BYTES;
                    const int rg = lane >> 4, ch = 16 * pj + (lane & 15);
                    unsigned short rlw_[8], ric_[8], rkx_[8], rr_[8];
#pragma unroll
                    for (int j = 0; j < 8; ++j) { const LAS unsigned char* p = raw + (8 * rg + j) * 128 + 2 * ch; rlw_[j] = *(const LAS unsigned short*)p; ric_[j] = *(const LAS unsigned short*)(p + 4096);
                        rkx_[j] = *(const LAS unsigned short*)(p + 8192); rr_[j] = *(const LAS unsigned short*)(p + 12288); }
                    const f32x4 inv0 = *(const LAS f32x4*)(raw + RAW_INV + 32 * rg), inv1 = *(const LAS f32x4*)(raw + RAW_INV + 32 * rg + 16);
                    __builtin_amdgcn_sched_barrier(0);
                    float S = 0.f, lwv[8];
#pragma unroll
                    for (int j = 0; j < 8; ++j) { lwv[j] = bf2f(rlw_[j]); S += lwv[j]; }
                    const float S1 = __builtin_bit_cast(float, __builtin_amdgcn_ds_bpermute(((lane + 16) & 63) * 4, __builtin_bit_cast(int, S)));
                    const float S2 = __builtin_bit_cast(float, __builtin_amdgcn_ds_bpermute(((lane + 32) & 63) * 4, __builtin_bit_cast(int, S)));
                    const float S3 = __builtin_bit_cast(float, __builtin_amdgcn_ds_bpermute(((lane + 48) & 63) * 4, __builtin_bit_cast(int, S)));
                    const float Ltot = (S + S1) + (S2 + S3), Lpre = (rg >= 3 ? S1 : 0.f) + (rg >= 2 ? S2 : 0.f) + (rg >= 1 ? S3 : 0.f);
                    const float gam = __builtin_amdgcn_exp2f(Ltot);
                    if (rg == 0) *(LAS float*)(os + OS_GAM + 4 * ch) = gam;
                    float Lr = Lpre, ep_prev = __builtin_amdgcn_exp2f(Lpre); float kt[8], bt[8]; const bool has_r = cp >= CT / CK;
#pragma unroll
                    for (int j = 0; j < 8; ++j) { const int m = 8 * rg + j; Lr += lwv[j];
                        const float ep = __builtin_amdgcn_exp2f(Lr), em = __builtin_amdgcn_rcpf(ep);
                        const float icl = bf2f(ric_[j]), kx = bf2f(rkx_[j]), r = has_r ? bf2f(rr_[j]) : 0.f, kk = kx * kkw_l * (j < 4 ? inv0[j & 3] : inv1[j & 3]);
                        const float bb = kk * icl, kd = kx * (1.0f + (icl - 1.0f) * ka_l);
                        const f32x2 ar = (f32x2){kk, r} * (f32x2){ep_prev, ep}, bk = (f32x2){bb, kd} * em, tb = (f32x2){bk[1], bk[0]} * (f32x2){gam, -gam};
                        const unsigned w1 = cvt_pk_bf16(ar[0], ar[1]), w2 = cvt_pk_bf16(bk[0], bk[1]);
                        *(LAS unsigned short*)(os + OS_A + m * RS + 2 * ch) = (unsigned short)(w1 & 0xffffu);
                        *(LAS unsigned short*)(os + OS_R + m * RS + 2 * ch) = (unsigned short)(w1 >> 16);
                        *(LAS unsigned short*)(og + OG_B + m * RS + 2 * ch) = (unsigned short)(w2 & 0xffffu);
                        *(LAS unsigned short*)(og + OG_K + m * RS + 2 * ch) = (unsigned short)(w2 >> 16);
                        kt[j] = tb[0]; bt[j] = tb[1]; ep_prev = ep; }
#pragma unroll
                    for (int g = 0; g < 2; ++g) { u32x2 w; w.x = cvt_pk_bf16(kt[4 * g], kt[4 * g + 1]); w.y = cvt_pk_bf16(kt[4 * g + 2], kt[4 * g + 3]);
                        *(LAS u32x2*)(os + OS_KT + ch * TS + 2 * (8 * rg + 4 * g)) = w;
                        w.x = cvt_pk_bf16(bt[4 * g], bt[4 * g + 1]); w.y = cvt_pk_bf16(bt[4 * g + 2], bt[4 * g + 3]);
                        *(LAS u32x2*)(os + OS_BT + ch * TS + 2 * (8 * rg + 4 * g)) = w; }
                }
                __builtin_amdgcn_s_setprio(0);
            } else if (wave == 7) {
                const int c5 = it + 5;
                if (c5 < CNCH) SCAN_DMA(c5);
                if (cp < CNCH) { const LAS unsigned char* raw = lds + L_RAW + (cp & (NRAW - 1)) * RAW_BYTES; LAS unsigned char* os = lds + L_OS + (cp & 1) * OS_BYTES;
                    unsigned short rv[8];
#pragma unroll
                    for (int j = 0; j < 8; ++j) rv[j] = *(const LAS unsigned short*)(raw + RAW_V + (8 * (lane >> 4) + j) * 32 + 2 * (lane & 15));
                    u32x4 w; w.x = (unsigned)rv[0] | ((unsigned)rv[1] << 16); w.y = (unsigned)rv[2] | ((unsigned)rv[3] << 16); w.z = (unsigned)rv[4] | ((unsigned)rv[5] << 16); w.w = (unsigned)rv[6] | ((unsigned)rv[7] << 16);
                    *(LAS u32x4*)(os + OS_VT + (lane & 15) * TS + 16 * (lane >> 4)) = w; }
                if (cg >= 0 && cg < CNCH) {
                    f32x16 c = gram32(lds + L_OG + (cg & 1) * OG_BYTES + OG_B, lds + L_OS + (cg & 1) * OS_BYTES + OS_R, lane);
#pragma unroll
                    for (int p = 0; p < 16; ++p) c[p] = acc_row(p, lane) <= (lane & 31) ? -c[p] : 0.f;
                    st_acc32_t(lds + L_GM + (cg & 1) * GM_BYTES + GM_BR, c, lane);
                }
                { const int n1_ = (it + 4 >= 0 && it + 4 < CNCH) ? ((it + 4 >= CT / CK) ? 18 : 14) : 0, n2_ = (c5 < CNCH) ? ((c5 >= CT / CK) ? 18 : 14) : 0;
                  switch (n1_ + n2_) { case 36: asm volatile("s_waitcnt vmcnt(36)" ::: "memory"); break; case 32: asm volatile("s_waitcnt vmcnt(32)" ::: "memory"); break; case 28: asm volatile("s_waitcnt vmcnt(28)" ::: "memory"); break;
                      case 18: asm volatile("s_waitcnt vmcnt(18)" ::: "memory"); break; case 14: asm volatile("s_waitcnt vmcnt(14)" ::: "memory"); break; default: asm volatile("s_waitcnt vmcnt(0)" ::: "memory"); break; } }
            } else if (wave == 2) {
                if (cg >= 0 && cg < CNCH) {
                    const LAS unsigned char* os = lds + L_OS + (cg & 1) * OS_BYTES; const LAS unsigned char* og = lds + L_OG + (cg & 1) * OG_BYTES; LAS unsigned char* gm = lds + L_GM + (cg & 1) * GM_BYTES;
                    bf16x8 fk[4], fa[4], fr[4]; const int fo = (lane & 31) * RS + 16 * (lane >> 5);
#pragma unroll
                    for (int s4 = 0; s4 < 4; ++s4) { fk[s4] = *(const LAS bf16x8*)(og + OG_K + fo + 32 * s4); fa[s4] = *(const LAS bf16x8*)(os + OS_A + fo + 32 * s4); fr[s4] = *(const LAS bf16x8*)(os + OS_R + fo + 32 * s4); }
                    f32x16 c0, c1;
#pragma unroll
                    for (int p = 0; p < 16; ++p) { c0[p] = 0.f; c1[p] = 0.f; }
#pragma unroll
                    for (int s4 = 0; s4 < 4; ++s4) { c0 = __builtin_amdgcn_mfma_f32_32x32x16_bf16(fk[s4], fa[s4], c0, 0, 0, 0); c1 = __builtin_amdgcn_mfma_f32_32x32x16_bf16(fk[s4], fr[s4], c1, 0, 0, 0); }
#pragma unroll
                    for (int p = 0; p < 16; ++p) c0[p] = acc_row(p, lane) < (lane & 31) ? c0[p] : 0.f;
                    st_acc32_t(gm + GM_KA, c0, lane);
#pragma unroll
                    for (int p = 0; p < 16; ++p) c1[p] = acc_row(p, lane) <= (lane & 31) ? c1[p] : 0.f;
                    st_acc32_t(gm + GM_KR, c1, lane);
                }
            } else if (wave == 1) {
                if (cg >= 0 && cg < CNCH) {
                    const LAS unsigned char* os = lds + L_OS + (cg & 1) * OS_BYTES; const LAS unsigned char* og = lds + L_OG + (cg & 1) * OG_BYTES; LAS unsigned char* gm = lds + L_GM + (cg & 1) * GM_BYTES;
                    const int c16 = lane & 15, q = lane >> 4;
                    typedef short s4 __attribute__((ext_vector_type(4)));
#define P4(v) __builtin_bit_cast(s4, (u32x2){cvt_pk_bf16((v)[0], (v)[1]), cvt_pk_bf16((v)[2], (v)[3])})
#define MM16(a, b, c) __builtin_amdgcn_mfma_f32_16x16x16bf16_1k((a), (b), (c), 0, 0, 0)
#define GRAM16(P, p0, Q, q0, out) do { f32x4 c_ = {0.f, 0.f, 0.f, 0.f}; _Pragma("unroll") for (int s_ = 0; s_ < 2; ++s_) \
                        c_ = __builtin_amdgcn_mfma_f32_16x16x32_bf16(*(const LAS bf16x8*)((P) + ((p0) + c16) * RS + 64 * s_ + 16 * q), *(const LAS bf16x8*)((Q) + ((q0) + c16) * RS + 64 * s_ + 16 * q), c_, 0, 0, 0); (out) = c_; } while (0)
                    const LAS unsigned char* PA = os + OS_A; const LAS unsigned char* PB = og + OG_B;
                    f32x4 X1, Xt1, X2, Xt2, L21t, R1, R2, Rt2; const f32x4 z4 = {0.f, 0.f, 0.f, 0.f};
                    GRAM16(PA, 0, PB, 0, X1); GRAM16(PB, 0, PA, 0, Xt1); GRAM16(PA, 16, PB, 16, X2); GRAM16(PB, 16, PA, 16, Xt2); GRAM16(PB, 0, PA, 16, L21t);
#pragma unroll
                    for (int j = 0; j < 4; ++j) { const int row = 4 * q + j; const float dg = (row == c16) ? 1.f : 0.f;
                        X1[j] = c16 < row ? -X1[j] : 0.f; X2[j] = c16 < row ? -X2[j] : 0.f; Xt1[j] = row < c16 ? -Xt1[j] : 0.f; Xt2[j] = row < c16 ? -Xt2[j] : 0.f;
                        R1[j] = X1[j] + dg; R2[j] = X2[j] + dg; Rt2[j] = Xt2[j] + dg; }
#pragma unroll
                    for (int lev = 0; lev < 4; ++lev) {
                        const s4 fx1 = P4(X1), fxt1 = P4(Xt1), fx2 = P4(X2), fxt2 = P4(Xt2);
                        if (lev >= 1) { R1 = MM16(fxt1, P4(R1), R1); R2 = MM16(fxt2, P4(R2), R2); Rt2 = MM16(fx2, P4(Rt2), Rt2); }
                        if (lev < 3) { const f32x4 n1 = MM16(fxt1, fx1, z4), nt1 = MM16(fx1, fxt1, z4), n2 = MM16(fxt2, fx2, z4), nt2 = MM16(fx2, fxt2, z4); X1 = n1; Xt1 = nt1; X2 = n2; Xt2 = nt2; }
                    }
                    const f32x4 W = MM16(P4(L21t), P4(R1), z4);
                    f32x4 T21 = MM16(P4(Rt2), P4(W), z4);
#pragma unroll
                    for (int j = 0; j < 4; ++j) { const int row = 4 * q + j;
                        *(LAS unsigned short*)(gm + GM_TT + row * TS + 2 * c16) = f2bf(R1[j]); *(LAS unsigned short*)(gm + GM_TT + row * TS + 2 * (16 + c16)) = (unsigned short)0;
                        *(LAS unsigned short*)(gm + GM_TT + (16 + row) * TS + 2 * c16) = f2bf(-T21[j]); *(LAS unsigned short*)(gm + GM_TT + (16 + row) * TS + 2 * (16 + c16)) = f2bf(R2[j]); }
#undef P4
#undef MM16
#undef GRAM16
                }
            }
            if (SCAN_TSEL >= 0) { tbusy += clock64() - t0_; }
            SCAN_BAR();
        }
        else {
#define PACK8(v0, v1) __builtin_bit_cast(bf16x8, (u32x4){cvt_pk_bf16((v0)[0], (v0)[1]), cvt_pk_bf16((v0)[2], (v0)[3]), cvt_pk_bf16((v1)[0], (v1)[1]), cvt_pk_bf16((v1)[2], (v1)[3])})
#define LD2(p) ld2x8((p), (p) + 32)
#define MF32(afrag, bfrag, c) __builtin_amdgcn_mfma_f32_16x16x32_bf16((afrag), (bfrag), (c), 0, 0, 0)
            const int r16 = lane & 15, q = lane >> 4;
            const unsigned y_v = (unsigned)((d ? 3 - q : q) * 4 * (D * 2) + r16 * 2);
            bf16x8 sV = {0, 0, 0, 0, 0, 0, 0, 0}, sA[2][2], sKT[4], sBT[4], sR[2][2]; f32x4 sG[4];
#pragma unroll
            for (int t = 0; t < 4; ++t) { sKT[t] = sV; sBT[t] = sV; sG[t] = (f32x4){0.f, 0.f, 0.f, 0.f}; }
#pragma unroll
            for (int ti = 0; ti < 2; ++ti) { sA[ti][0] = sV; sA[ti][1] = sV; sR[ti][0] = sV; sR[ti][1] = sV; }
            for (int it = -2; it < CNCH; ++it) {
                const int cs = it;
                long long t0_ = 0; if (SCAN_TSEL >= 0) t0_ = clock64();
                if (cs >= 0) {
                    const LAS unsigned char* gm = lds + L_GM + (cs & 1) * GM_BYTES; const bool emit = cs >= CT / CK;
                    const int n0s = scan_token(cs * CK, d, b);
                    bf16x8 aKA[2], aTT[2];
#pragma unroll
                    for (int ti = 0; ti < 2; ++ti) { const int i = 16 * ti + r16; aKA[ti] = *(const LAS bf16x8*)(gm + GM_KA + i * TS + 16 * q); aTT[ti] = LD2(gm + GM_TT + i * TS + 8 * q); }
                    const bf16x8 xb01 = PACK8(Xa[0], Xa[1]), xb23 = PACK8(Xa[2], Xa[3]);
                    f32x4 h[2];
#pragma unroll
                    for (int ti = 0; ti < 2; ++ti) { f32x4 c = {0.f, 0.f, 0.f, 0.f}; c = MF32(sA[ti][0], xb01, c); c = MF32(sA[ti][1], xb23, c); h[ti] = MF32(aKA[ti], sV, c); }
                    const bf16x8 hb = PACK8(h[0], h[1]);
                    f32x4 u[2];
#pragma unroll
                    for (int ti = 0; ti < 2; ++ti) { const f32x4 z = {0.f, 0.f, 0.f, 0.f}; u[ti] = MF32(aTT[ti], hb, z); }
                    const bf16x8 ub = PACK8(u[0], u[1]);
                    f32x4 Xn[4];
#pragma unroll
                    for (int t = 0; t < 4; ++t) { f32x4 c = Xa[t] * sG[t]; c = MF32(sKT[t], sV, c); Xn[t] = MF32(sBT[t], ub, c); }
                    if (emit) {
#pragma unroll
                        for (int ti = 0; ti < 2; ++ti) { const int i = 16 * ti + r16; f32x4 c = {0.f, 0.f, 0.f, 0.f};
                            c = MF32(sR[ti][0], xb01, c); c = MF32(sR[ti][1], xb23, c);
                            c = MF32(*(const LAS bf16x8*)(gm + GM_KR + i * TS + 16 * q), sV, c); c = MF32(LD2(gm + GM_BR + i * TS + 8 * q), ub, c);
#pragma unroll
                            for (int j = 0; j < 4; ++j) { const unsigned so = (unsigned)(d ? n0s - 16 * ti - j - 12 : n0s + 16 * ti + j) * (unsigned)(D * 2) + (unsigned)((hd * 64 + rq * 16) * 2) + (unsigned)(WS_YD + (size_t)d * NL * D * 2);
                                __builtin_amdgcn_raw_buffer_store_b16(f2bf(c[j]), rsrc, (int)y_v, (int)so, 0); } }
                    }
#pragma unroll
                    for (int t = 0; t < 4; ++t) Xa[t] = Xn[t];
                }
                if (cs + 1 >= 0 && cs + 1 < CNCH) {
                    const LAS unsigned char* os = lds + L_OS + ((cs + 1) & 1) * OS_BYTES;
                    sV = *(const LAS bf16x8*)(os + OS_VT + r16 * TS + 16 * q);
#pragma unroll
                    for (int ti = 0; ti < 2; ++ti) { const int i = 16 * ti + r16; sA[ti][0] = LD2(os + OS_A + i * RS + 8 * q); sA[ti][1] = LD2(os + OS_A + i * RS + 64 + 8 * q); }
#pragma unroll
                    for (int t = 0; t < 4; ++t) { const int k = 16 * t + r16; sG[t] = *(const LAS f32x4*)(os + OS_GAM + 4 * (16 * t + 4 * q)); sKT[t] = *(const LAS bf16x8*)(os + OS_KT + k * TS + 16 * q); sBT[t] = LD2(os + OS_BT + k * TS + 8 * q); }
                    if (cs + 1 >= CT / CK) {
#pragma unroll
                        for (int ti = 0; ti < 2; ++ti) { const int i = 16 * ti + r16; sR[ti][0] = LD2(os + OS_R + i * RS + 8 * q); sR[ti][1] = LD2(os + OS_R + i * RS + 64 + 8 * q); }
                    }
                }
                if (SCAN_TSEL >= 0) { tbusy += clock64() - t0_; }
                SCAN_BAR();
            }
#undef PACK8
#undef LD2
#undef MF32
        }
        if (SCAN_TSEL >= 0 && SCAN_TSEL < 8 && F.vcu == 0 && lane == 0 && wave == (SCAN_TSEL & 7)) *(long long*)(F.ws + WS_CTL + 49152) = tbusy;
        if (SCAN_TSEL == 8 && F.vcu == 0 && lane == 0 && wave == 0) *(long long*)(F.ws + WS_CTL + 49152) = (clock64() - tloop0_) / 2;
#undef SCAN_DMA
#undef SCAN_BAR
    }
}
__device__ __forceinline__ void phase_readout(const Frame& F, const Args& A) {
    const int gw = blockIdx.x * NWAVES + F.wave, NGW = F.G * NWAVES; const int c0 = 16 * F.lane;
    float lng[16], lnb[16], rk[16], kaw[16]; ld16f(A.in[I_LNG] + c0, lng); ld16f(A.in[I_LNB] + c0, lnb); ld16f(A.in[I_RK] + c0, rk); ld16f(A.in[I_KA] + c0, kaw);
    for (int n = gw; n < NL; n += NGW) { const size_t off = (size_t)n * D + c0; float y[16], t[16], r[16], kd[16], v[16], g[16], o[16];
        ld16bf((const bf16_t*)(F.ws + WS_YD) + off, y); ld16bf((const bf16_t*)(F.ws + WS_YD + (size_t)NL * D * 2) + off, t);
        float s = 0.f;
#pragma unroll
        for (int j = 0; j < 16; ++j) { y[j] += t[j]; s += y[j]; }
        s = dpp_xadd(s, 0); s = dpp_xadd(s, 1); const float m = s * (1.0f / 64.0f); float q = 0.f;
#pragma unroll
        for (int j = 0; j < 16; ++j) { y[j] -= m; q += y[j] * y[j]; }
        q = dpp_xadd(q, 0); q = dpp_xadd(q, 1); const float rs = 1.0f / sqrtf(q * (1.0f / 64.0f) + GN_EPS);
        ld16bf((const bf16_t*)(F.ws + WS_RKV) + off, r); ld16bf((const bf16_t*)(F.ws + WS_ICL) + off, kd); ld16bf((const bf16_t*)(F.ws + WS_ICL + ACTB) + off, t); ld16bf((const bf16_t*)(F.ws + WS_RKV + ACTB) + off, v);
        float bs = 0.f;
#pragma unroll
        for (int j = 0; j < 16; ++j) bs += r[j] * (v[j] * (2.0f + (kd[j] + t[j] - 2.0f) * kaw[j])) * rk[j];
        bs = dpp_xadd(bs, 0); bs = dpp_xadd(bs, 1);
        ld16bf((const bf16_t*)(F.ws + WS_RKV + 2 * ACTB) + off, v); ld16bf((const bf16_t*)(F.ws + WS_G) + off, g);
#pragma unroll
        for (int j = 0; j < 16; ++j) o[j] = (y[j] * rs * lng[j] + lnb[j] + bs * v[j]) * g[j];
        { u32x4 w; w.x = pk4_fp8(o[0], o[1], o[2], o[3]); w.y = pk4_fp8(o[4], o[5], o[6], o[7]); w.z = pk4_fp8(o[8], o[9], o[10], o[11]); w.w = pk4_fp8(o[12], o[13], o[14], o[15]);
          *(GAS u32x4*)(F.ws + WS_RO + off) = w; }
    }
}
struct SchedWo {
    static constexpr bool SIDE = false; static constexpr bool XSYNC = false; static constexpr bool GATHER = false;
    int G, vcu; int nt; unsigned ldb;
    __device__ __forceinline__ bool next(int i, GU& u) const { const int L = i * G + vcu; if (L >= 512) return false; const int pm = L >> 2, pn = L & 3;
        u.a = (unsigned)(WS_RO + (size_t)pm * 256 * D); u.b = (unsigned)(WS_WO + (size_t)pn * 256 * 1024); u.i0 = pm; u.i1 = pn; u.i2 = 0; u.i3 = 0; return true; }
    __device__ __forceinline__ void aoff(const GU&, const int (&R)[2], const int (&C)[2], unsigned (&v)[2][2]) const {
#pragma unroll
        for (int h = 0; h < 2; ++h)
#pragma unroll
            for (int i = 0; i < 2; ++i) v[h][i] = (unsigned)((h * 128 + R[i]) * D + 2 * C[i]); }
};
struct EpiWo {
    static constexpr bool FP8 = true; static constexpr bool PERM = true;
    const bf16_t* xin; bf16_t* xout; const float* gate_base;
    __device__ __forceinline__ void operator()(const f32x4 (&acc)[2][2][4][2], const GU& u, int wr, int wc, int fr, int fq, const LAS float* sb) const {
        const int pm = u.i0, pn = u.i1; const float* gate = gate_base + (size_t)(pm >> 6) * NMOD * D; const int col0 = pn * 256 + wc * 32 + 8 * fq;
        f32x4 gl[2][2];
#pragma unroll
        for (int bj = 0; bj < 2; ++bj)
#pragma unroll
            for (int n = 0; n < 2; ++n) gl[bj][n] = *(const GAS f32x4*)(gate + col0 + bj * 128 + n * 4);
#pragma unroll
        for (int ai = 0; ai < 2; ++ai)
#pragma unroll
            for (int m = 0; m < 4; ++m) { const size_t off = ((size_t)pm * 256 + ai * 128 + wr * 64 + m * 16 + fr) * D + col0;
#pragma unroll
                for (int bj = 0; bj < 2; ++bj) { const u32x4 xi = *(const GAS u32x4*)(xin + off + bj * 128);
                    const f32x4 v0 = (f32x4){bf_lo(xi.x), bf_hi(xi.x), bf_lo(xi.y), bf_hi(xi.y)} + gl[bj][0] * acc[ai][bj][m][0], v1 = (f32x4){bf_lo(xi.z), bf_hi(xi.z), bf_lo(xi.w), bf_hi(xi.w)} + gl[bj][1] * acc[ai][bj][m][1];
                    u32x4 w; w.x = cvt_pk_bf16(v0[0], v0[1]); w.y = cvt_pk_bf16(v0[2], v0[3]); w.z = cvt_pk_bf16(v1[0], v1[1]); w.w = cvt_pk_bf16(v1[2], v1[3]);
                    *(GAS u32x4*)(xout + off + bj * 128) = w; } }
    }
};

constexpr int NPHASES = 3;
__global__ void __launch_bounds__(NTHREADS, 2) fwd_kernel(Args args) {
    extern __shared__ __attribute__((aligned(16))) unsigned char lds_raw[];
    Frame F;
    F.lds = (LAS unsigned char*)lds_raw; F.scr = F.lds + SCR_OFF; F.ws = args.ws;
    F.tid = threadIdx.x; F.lane = F.tid & 63; F.wave = __builtin_amdgcn_readfirstlane(F.tid >> 6);
    F.G = gridDim.x; { const int bx = blockIdx.x; F.vcu = (F.G % 8 == 0) ? (bx % 8) * (F.G / 8) + bx / 8 : bx; }
    volatile LAS unsigned* MISC = (volatile LAS unsigned*)(F.lds + MISC_OFF);
    if (F.tid < 64) MISC[F.tid] = 0u;
    __syncthreads();
    const int lo = args.ph_lo, hi = args.ph_hi;
    XcdBarrier bar; bar.bar = (unsigned*)(F.ws + WS_CTL); bar.x = 0; bar.st = MISC + 8;
    if (hi - lo > 1) {
        unsigned* barw = (unsigned*)(F.ws + WS_CTL);
        bar.bar = barw; bar.x = xb_xcc_id(); bar.st = MISC + 8;
        if (F.tid == 0) {
            const unsigned rank = xb_add(&barw[XB_XCNT(bar.x)], 1u);
            unsigned nloc, nx; xcd_barrier_complete(barw, bar.x, nloc, nx); MISC[8] = nloc; MISC[9] = nx;
            unsigned pre = 0;
            for (unsigned j = 0; j < 16; ++j) { const unsigned c = xb_ld(&barw[XB_XCNT(j)]); if (j < bar.x) pre += c; }
            MISC[10] = pre + rank;
        }
        __syncthreads();
        F.vcu = (int)MISC[10];
    }
#define IN(k) (lo <= (k) && (k) < hi)
#define SEAM(k) do { if (IN(k) && IN((k) + 1)) xcd_barrier(bar); } while (0)
#define PH(k, ...) do { if (IN(k)) { __VA_ARGS__; if constexpr (((REPEAT_MASK >> (k)) & 1) != 0) { xcd_barrier(bar); __VA_ARGS__; } } SEAM(k); } while (0)
    PH(0, phase_prep(F, args));
    PH(1, phase_pre0(F, args));
    PH(2, { SchedPool S{F.G, F.vcu, 4, 512u};
            EpiPool E{args.in[I_X], args.in[I_CTX], args.in[I_POOLLS], modp(F, 0, 0, 2), (bf16_t*)(F.ws + WS_XS0)};
            pg8::gemm_phase<EpiPool, SchedPool>(F.scr, F.ws, S, E); });
    PH(3, phase_post(F, args, 0, (const bf16_t*)(F.ws + WS_XS0), NTOK));
    PH(4, phase_moe1(F, args, 0));
    PH(5, phase_moe2(F, args, 0));
    PH(6, phase_pre1(F, args));
    PH(7, { SchedProj S{F.G, F.vcu, 8, 1024u}; EpiProj E{F.ws}; pg8::gemm_phase<EpiProj, SchedProj>(F.scr, F.ws, S, E); });
    PH(8, { SchedLora2 S{F.G, F.vcu, 2, 256u}; EpiLora2 E{F.ws, args.in[I_W0], args.in[I_A0]}; pg8::gemm_phase<EpiLora2, SchedLora2>(F.scr, F.ws, S, E); phase_fin(F, args); });
    PH(10, phase_scan(F, args));
    PH(11, phase_readout(F, args));
    PH(12, { SchedWo S{F.G, F.vcu, 8, 1024u}; EpiWo E{(const bf16_t*)(F.ws + WS_XS1), (bf16_t*)(F.ws + WS_XS0), modp(F, 1, 0, 2)}; pg8::gemm_phase<EpiWo, SchedWo>(F.scr, F.ws, S, E); });
    PH(13, phase_post(F, args, 1, (const bf16_t*)(F.ws + WS_XS0), NL));
    PH(14, phase_moe1(F, args, 1));
    PH(15, phase_moe2(F, args, 1));
    PH(16, phase_final(F, args, 1, (const bf16_t*)(F.ws + WS_XS0)));
#undef PH
#undef SEAM
#undef IN
}

extern "C" void kernel_launch(void* const* d_in, const int* in_sizes, int n_in, void* d_out, int out_size, void* d_ws, size_t ws_size, hipStream_t stream) {
    static int grid = 0;
    if (grid == 0) {
        if (n_in != 32 || ws_size < WS_END) { fprintf(stderr, "kernel_launch: unexpected n_in %d / ws %zu (need %zu)\n", n_in, ws_size, (size_t)WS_END); grid = -1; return; }
        int dev = 0, cus = 0;
        if (hipGetDevice(&dev) != hipSuccess || hipDeviceGetAttribute(&cus, hipDeviceAttributeMultiprocessorCount, dev) != hipSuccess) { grid = -1; return; }
        if (hipFuncSetAttribute((const void*)fwd_kernel, hipFuncAttributeMaxDynamicSharedMemorySize, LDS_BYTES) != hipSuccess) { fprintf(stderr, "kernel_launch: hipFuncSetAttribute failed\n"); grid = -1; return; }
        (void)hipGetLastError();
        grid = cus;
    }
    if (grid < 0) return;
    (void)hipMemsetAsync((char*)d_ws + WS_CTL, 0, CTL_BYTES, stream);
    Args a{};
    for (int i = 0; i < 32; ++i) a.in[i] = (const float*)d_in[i];
    a.out = (float*)d_out; a.ws = (unsigned char*)d_ws;
    const int last = 16;
#if N_LAUNCH_MODE == 1
    a.ph_lo = 0; a.ph_hi = last + 1;
    hipLaunchKernelGGL(fwd_kernel, dim3(grid), dim3(NTHREADS), LDS_BYTES, stream, a);
#else
    for (int p = 0; p <= last; ++p) { a.ph_lo = p; a.ph_hi = p + 1; hipLaunchKernelGGL(fwd_kernel, dim3(grid), dim3(NTHREADS), LDS_BYTES, stream, a); }
#endif
}
```

```cpp
#include <hip/hip_runtime.h>
#include <cstdio>
#include <cstdint>

#define LAS __attribute__((address_space(3)))
#define GAS __attribute__((address_space(1)))
typedef unsigned short bf16_t;
typedef short bf16x8 __attribute__((ext_vector_type(8)));
typedef float f32x4 __attribute__((ext_vector_type(4)));
typedef float f32x2 __attribute__((ext_vector_type(2)));
typedef float f32x16 __attribute__((ext_vector_type(16)));
typedef unsigned u32x4 __attribute__((ext_vector_type(4)));
typedef unsigned u32x2 __attribute__((ext_vector_type(2)));

#ifndef N_LAUNCH_MODE
#define N_LAUNCH_MODE 1
#endif
#ifndef SCAN_TSEL
#define SCAN_TSEL -1
#endif
#ifndef REPEAT_MASK
#define REPEAT_MASK 0
#endif

constexpr int D = 1024, NB = 2, TSEQ = 16384, CT = 256, NL = NB * TSEQ, NC = NB * CT, NTOK = NL + NC;
constexpr int NE = 32, TOPK = 4, NMOD = 6;
constexpr int NWAVES = 8, NTHREADS = 512;
constexpr int MAXSLOT = ((NTOK * TOPK + 255) / 256 + NE) * 256;
constexpr float NORM_EPS = 1e-6f, GN_EPS = 64e-5f;

constexpr size_t AL(size_t x) { return (x + 255) & ~(size_t)255; }
constexpr size_t WS_CTL = 0, CTL_BYTES = 65536;
constexpr size_t CTL_XSYNC = 32768;
constexpr size_t CTL_CNT = 16384;
constexpr size_t WS_MOD = WS_CTL + CTL_BYTES;
constexpr size_t WS_LIST = AL(WS_MOD + 2 * 3 * 6144 * 4);
constexpr size_t WS_TINFO = AL(WS_LIST + (size_t)2 * NE * NTOK * 4);
constexpr size_t WS_TGATE = AL(WS_TINFO + (size_t)2 * NTOK * 4 * 4);
constexpr size_t WS_WGU = AL(WS_TGATE + (size_t)2 * NTOK * 4 * 4);
constexpr size_t WS_WDN = AL(WS_WGU + (size_t)2 * NE * 2048 * 1024 * 2);
constexpr size_t WS_WRKV = AL(WS_WDN + (size_t)2 * NE * 1024 * 1024 * 2);
constexpr size_t WS_WO = AL(WS_WRKV + (size_t)3 * 1024 * 1024 * 2);
constexpr size_t WS_WL1 = AL(WS_WO + (size_t)1024 * 1024 * 2);
constexpr size_t WS_WL2 = AL(WS_WL1 + (size_t)3 * 256 * 1024 * 2);
constexpr size_t WS_WPOOL = AL(WS_WL2 + (size_t)5 * 1024 * 128 * 2);
constexpr size_t WS_XS0 = AL(WS_WPOOL + (size_t)4 * 256 * 256 * 2);
constexpr size_t WS_XS1 = AL(WS_XS0 + (size_t)NTOK * D * 4);
constexpr size_t WS_T = AL(WS_XS1 + (size_t)NTOK * D * 4);
constexpr size_t ACTB = (size_t)NTOK * D * 2;
constexpr size_t TA = WS_T;
constexpr size_t TA_BYTES = (size_t)432 << 20;
constexpr size_t WS_DBUF = TA, WS_H2 = TA + ACTB, WS_ACT = TA + 2 * ACTB;
constexpr size_t WS_MIX = TA;
constexpr size_t WS_KDIR = TA, WS_BV = TA + 2 * ACTB, WS_KK = TA + 4 * ACTB;
constexpr size_t TB = TA + TA_BYTES;
constexpr size_t TB_BYTES = (size_t)290 << 20;
constexpr size_t WS_Y2 = TB, WS_RKV = TB;
constexpr size_t TC = TB + TB_BYTES;
constexpr size_t WS_DEC = TC, WS_RO = TC;
constexpr size_t TD = AL(TC + (size_t)2 * NTOK * D * 4);
constexpr size_t WS_ICL = TD, WS_YD = TA;
constexpr size_t TE = AL(TD + 2 * ACTB);
constexpr size_t WS_G = TE;
constexpr size_t TF = AL(TE + ACTB);
constexpr size_t WS_LACT = TF;
constexpr size_t WS_END = AL(TF + (size_t)3 * NTOK * 128 * 2);
static_assert(WS_ACT + (size_t)MAXSLOT * D * 2 <= TA + TA_BYTES, "ACT overflows TA");
static_assert((size_t)MAXSLOT * D * 2 <= TB_BYTES, "Y2 overflows TB");
static_assert(WS_END <= ((size_t)2048 << 20), "workspace too large");

constexpr int MISC_OFF = 0, SCR_OFF = 1024, SCR_BYTES = 162816, LDS_BYTES = SCR_OFF + SCR_BYTES;

typedef __bf16 bf16x2_t __attribute__((ext_vector_type(2)));
__device__ __forceinline__ unsigned cvt_pk_bf16(float lo, float hi) { const f32x2 v = {lo, hi}; return __builtin_bit_cast(unsigned, __builtin_convertvector(v, bf16x2_t)); }
__device__ __forceinline__ void stx4(bf16_t* p, f32x4 v) { u32x2 w; w.x = cvt_pk_bf16(v[0], v[1]); w.y = cvt_pk_bf16(v[2], v[3]); *(GAS u32x2*)p = w; }
__device__ __forceinline__ float bf_lo(unsigned w) { return __uint_as_float(w << 16); }
__device__ __forceinline__ float bf_hi(unsigned w) { return __uint_as_float(w & 0xffff0000u); }
__device__ __forceinline__ float bf2f(bf16_t b) { return __uint_as_float(((unsigned)b) << 16); }
__device__ __forceinline__ f32x4 ldx4(const bf16_t* p) { const u32x2 w = *(const GAS u32x2*)p; return (f32x4){bf_lo(w.x), bf_hi(w.x), bf_lo(w.y), bf_hi(w.y)}; }
__device__ __forceinline__ float dpp_xadd(float v, const int sel) {
    const int x = __builtin_bit_cast(int, v); int y;
    if (sel == 0) y = __builtin_amdgcn_update_dpp(0, x, 0xB1, 0xF, 0xF, true);
    else if (sel == 1) y = __builtin_amdgcn_update_dpp(0, x, 0x4E, 0xF, 0xF, true);
    else if (sel == 2) y = __builtin_amdgcn_update_dpp(0, x, 0x141, 0xF, 0xF, true);
    else y = __builtin_amdgcn_update_dpp(0, x, 0x140, 0xF, 0xF, true);
    return v + __builtin_bit_cast(float, y);
}
__device__ __forceinline__ float wave_sum(float v) {
    v = dpp_xadd(v, 0); v = dpp_xadd(v, 1); v = dpp_xadd(v, 2); v = dpp_xadd(v, 3);
    const int x = __builtin_bit_cast(int, v);
    const float s0 = __builtin_bit_cast(float, __builtin_amdgcn_readlane(x, 0)), s1 = __builtin_bit_cast(float, __builtin_amdgcn_readlane(x, 16)),
                s2 = __builtin_bit_cast(float, __builtin_amdgcn_readlane(x, 32)), s3 = __builtin_bit_cast(float, __builtin_amdgcn_readlane(x, 48));
    return (s0 + s1) + (s2 + s3);
}
__device__ __forceinline__ float sigmoidf_(float x) { return 1.0f / (1.0f + __expf(-x)); }
#define LDS_WAIT() asm volatile("s_waitcnt lgkmcnt(0)" ::: "memory")
#define VM_WAIT() asm volatile("s_waitcnt vmcnt(0)" ::: "memory")

#define XB_TMO      128
#define XB_XCNT(j)  (256  + 64 * (j))
#define XB_XSUB(j)  (1280 + 64 * (j))
#define XB_XGEN(j)  (2304 + 64 * (j))
#define XB_TOP      3328
#define XB_TOPGEN   3392
#define XCD_BAR_WORDS 3456
#define XB_SPIN_CAP (1u << 22)
__device__ __forceinline__ unsigned xb_ld(unsigned* p)              { return __hip_atomic_load(p, __ATOMIC_RELAXED, __HIP_MEMORY_SCOPE_AGENT); }
__device__ __forceinline__ unsigned xb_add(unsigned* p, unsigned v) { return __hip_atomic_fetch_add(p, v, __ATOMIC_RELAXED, __HIP_MEMORY_SCOPE_AGENT); }
__device__ __forceinline__ unsigned xb_xcc_id() { return (unsigned)__builtin_amdgcn_s_getreg((3 << 11) | 20) & 0xFu; }
#define XB_SPIN(cond, bar) do { unsigned _sp = 0; while (cond) { __builtin_amdgcn_s_sleep(1); \
    if ((++_sp & 255u) == 0u) { if (xb_ld(&(bar)[XB_TMO])) break; if (_sp > XB_SPIN_CAP) { atomicAdd(&(bar)[XB_TMO], 1u); break; } } } } while (0)
struct XcdBarrier { unsigned* bar; unsigned x; volatile LAS unsigned* st; };
__device__ __forceinline__ XcdBarrier xcd_barrier_post(unsigned* bar, volatile LAS unsigned* st) {
    XcdBarrier b; b.bar = bar; b.x = xb_xcc_id(); b.st = st;
    if (threadIdx.x == 0) (void)xb_add(&bar[XB_XCNT(b.x)], 1u);
    return b;
}
__device__ __forceinline__ void xcd_barrier_complete(unsigned* bar, unsigned x, unsigned& nloc, unsigned& nx) {
    const unsigned G = gridDim.x * gridDim.y * gridDim.z;
    unsigned sum, cnt, mine, sp = 0u;
    for (;;) {
        sum = 0u; cnt = 0u; mine = 0u;
#pragma unroll
        for (unsigned j = 0; j < 16; ++j) { const unsigned c = xb_ld(&bar[XB_XCNT(j)]); sum += c; cnt += (c > 0u) ? 1u : 0u; mine = (j == x) ? c : mine; }
        if (sum == G) break;
        __builtin_amdgcn_s_sleep(1);
        if ((++sp & 255u) == 0u) { if (xb_ld(&bar[XB_TMO])) break; if (sp > XB_SPIN_CAP) { atomicAdd(&bar[XB_TMO], 1u); break; } }
    }
    nloc = mine > 0u ? mine : 1u; nx = cnt > 0u ? cnt : 1u;
}
__device__ __forceinline__ void xcd_barrier(const XcdBarrier& b) {
    asm volatile("s_waitcnt vmcnt(0)" ::: "memory");
    __syncthreads();
    if (threadIdx.x == 0) {
        unsigned* bar = b.bar;
        __builtin_amdgcn_s_waitcnt(0);
        unsigned nloc = b.st[0], nx = b.st[1];
        if (nloc == 0u) { xcd_barrier_complete(bar, b.x, nloc, nx); b.st[0] = nloc; b.st[1] = nx; }
        const unsigned old = xb_add(&bar[XB_XSUB(b.x)], 1u);
        const unsigned gen = old / nloc;
        if (old + 1u == (gen + 1u) * nloc) {
            __builtin_amdgcn_fence(__ATOMIC_RELEASE, "agent");
            asm volatile("s_waitcnt vmcnt(0)" ::: "memory");
            const unsigned og = xb_add(&bar[XB_TOP], 1u);
            const unsigned tg = og / nx;
            if (og + 1u == (tg + 1u) * nx) xb_add(&bar[XB_TOPGEN], 1u);
            else XB_SPIN(xb_ld(&bar[XB_TOPGEN]) == tg, bar);
            __builtin_amdgcn_fence(__ATOMIC_ACQUIRE, "agent");
            xb_add(&bar[XB_XGEN(b.x)], 1u);
            asm volatile("s_waitcnt vmcnt(0)" ::: "memory");
        } else {
            XB_SPIN(xb_ld(&bar[XB_XGEN(b.x)]) == gen, bar);
            __builtin_amdgcn_fence(__ATOMIC_ACQUIRE, "agent");
            asm volatile("s_waitcnt vmcnt(0)" ::: "memory");
        }
    }
    __syncthreads();
}

namespace pg8 {
constexpr int BM = 256, BK = 64, HALF = 128, HTB = HALF * BK * 2, STAGE_BYTES = 8 * HTB;
__host__ __device__ __forceinline__ int lds_byte(int r, int c) { const int st = (r >> 4) * 2 + (c >> 5), rr = r & 15, cc = c & 31, ob = rr * 64 + cc * 2; return st * 1024 + (ob ^ (((ob >> 9) & 1) << 5)); }
__host__ __device__ __forceinline__ void stage_rc(int b, int& R, int& C) { const int st = b / 1024, sb = b % 1024, swz = sb ^ (((sb >> 9) & 1) << 5); R = (st >> 1) * 16 + swz / 64; C = (st & 1) * 32 + (swz % 64) / 2; }
__host__ __device__ __forceinline__ int perm32(int rho) { const int n = rho >> 4, i = rho & 15; return 8 * (i >> 2) + 4 * n + (i & 3); }

struct GU { unsigned a, b; int i0, i1, i2, i3; };
typedef int v8i __attribute__((ext_vector_type(8)));
typedef int v4i __attribute__((ext_vector_type(4)));
__device__ __forceinline__ bf16x8 half8(v8i v, int h) { const v4i a = h ? __builtin_shufflevector(v, v, 4, 5, 6, 7) : __builtin_shufflevector(v, v, 0, 1, 2, 3); return __builtin_bit_cast(bf16x8, a); }
__device__ __forceinline__ v8i cat8(bf16x8 lo, bf16x8 hi) { const v4i a = __builtin_bit_cast(v4i, lo), b = __builtin_bit_cast(v4i, hi); return __builtin_shufflevector(a, b, 0, 1, 2, 3, 4, 5, 6, 7); }

template <class Epi, class Sched>
__device__ __forceinline__ void gemm_phase(LAS unsigned char* lds, unsigned char* wsbase, const Sched& S, const Epi& E) {
    const int tid = threadIdx.x, wid = __builtin_amdgcn_readfirstlane(tid >> 6), lane = tid & 63, wr = wid >> 2, wc = wid & 3, fr = lane & 15, fq = lane >> 4;
    const int nt = S.nt;
    const __amdgpu_buffer_rsrc_t rsrc = __builtin_amdgcn_make_buffer_rsrc((void*)wsbase, 0, 0xffffffff, 0x00020000);
    constexpr int SIDE_OFF = STAGE_BYTES;
#define PG8_SIDE(u, buf) do { if constexpr (Sched::SIDE) { unsigned so_; const bool isb_ = S.side_src((u), tid, so_); (void)isb_; \
        if (wid < 4) __builtin_amdgcn_raw_ptr_buffer_load_lds(rsrc, (LAS void*)(lds + SIDE_OFF + (buf) * 2048 + wid * 256), 4, (int)so_, 0, 0, 0); \
        else __builtin_amdgcn_raw_ptr_buffer_load_lds(S.rsrcb, (LAS void*)(lds + SIDE_OFF + (buf) * 2048 + wid * 256), 4, (int)so_, 0, 0, 0); } } while (0)
    int Rr[2], Cc[2]; unsigned voffB[2];
#pragma unroll
    for (int i = 0; i < 2; ++i) { int R, C; stage_rc(tid * 16 + i * 8192, R, C); Rr[i] = R; Cc[i] = C; const int Rb = Epi::PERM ? ((R & ~31) + perm32(R & 31)) : R;
        voffB[i] = (unsigned)Rb * S.ldb + 2u * (unsigned)C; }
    const unsigned kstep = 128u;
    const unsigned hstepB = (unsigned)HALF * S.ldb;
    const unsigned ldsw = (unsigned)wid * 1024u;
    const int aoff = lds_byte(wr * 64 + fr, fq * 8), boff = lds_byte(wc * 32 + fr, fq * 8);
#define PG8_SA(b, h) (((b) * 2 + (h)) * HTB)
#define PG8_SB(b, h) ((4 + (b) * 2 + (h)) * HTB)
#define PG8_STAGE(bufoff, soff, voff) do { _Pragma("unroll") for (int _i = 0; _i < 2; ++_i) \
        __builtin_amdgcn_raw_ptr_buffer_load_lds(rsrc, (LAS void*)(lds + (bufoff) + ldsw + _i * 8192), 16, (int)(voff)[_i], (int)(soff), 0, 0); } while (0)
#define PG8_LDA(dst, b, h) do { _Pragma("unroll") for (int m = 0; m < 4; ++m) dst[m] = cat8(*(const LAS bf16x8*)(lds + PG8_SA(b, h) + aoff + m * 2048), *(const LAS bf16x8*)(lds + PG8_SA(b, h) + aoff + m * 2048 + 1024)); } while (0)
#define PG8_LDB(dst, b, h) do { _Pragma("unroll") for (int n = 0; n < 2; ++n) dst[n] = cat8(*(const LAS bf16x8*)(lds + PG8_SB(b, h) + boff + n * 2048), *(const LAS bf16x8*)(lds + PG8_SB(b, h) + boff + n * 2048 + 1024)); } while (0)
#define PG8_MMA(ai, bj, At, Bt) do { __builtin_amdgcn_s_setprio(1); _Pragma("unroll") for (int m = 0; m < 4; ++m) _Pragma("unroll") for (int n = 0; n < 2; ++n) { \
        if constexpr (Epi::FP8) { asm volatile("v_mfma_scale_f32_16x16x128_f8f6f4 %0, %1, %2, %0, %3, %4 op_sel_hi:[0,0,0]" : "+v"(acc[ai][bj][m][n]) : "v"(Bt[n]), "v"(At[m]), "v"(sc_w), "v"(sc_a)); } \
        else { acc[ai][bj][m][n] = __builtin_amdgcn_mfma_f32_16x16x32_bf16(half8(Bt[n], 0), half8(At[m], 0), acc[ai][bj][m][n], 0, 0, 0); \
               acc[ai][bj][m][n] = __builtin_amdgcn_mfma_f32_16x16x32_bf16(half8(Bt[n], 1), half8(At[m], 1), acc[ai][bj][m][n], 0, 0, 0); } } \
        __builtin_amdgcn_s_setprio(0); } while (0)
#define PG8_WAIT_V(n) asm volatile("s_waitcnt vmcnt(" #n ")" ::: "memory")
#define PG8_WAIT_L(n) asm volatile("s_waitcnt lgkmcnt(" #n ")" ::: "memory")
#define PG8_BAR __builtin_amdgcn_s_barrier()
#define PG8_SCHED __builtin_amdgcn_sched_barrier(0)
#define PG8_RC() do { _Pragma("unroll") for (int i = 0; i < 2; ++i) { int R, C; stage_rc((int)threadIdx.x * 16 + i * 8192, R, C); Rr[i] = R; Cc[i] = C; } } while (0)
    long long tk_ = 0, te_ = 0, tt0_ = 0; const bool tprobe_ = (SCAN_TSEL >= 10) && Sched::SIDE && Sched::GATHER;
    GU cur, nxt; int ui = 0;
    if (!S.next(0, cur)) { if constexpr (Sched::XSYNC) { if (tid == 0) (void)xb_add(S.xw, (unsigned)S.rounds); } return; }
    f32x4 acc[2][2][4][2];
#pragma unroll
    for (int a = 0; a < 2; ++a)
#pragma unroll
        for (int b = 0; b < 2; ++b)
#pragma unroll
            for (int m = 0; m < 4; ++m)
#pragma unroll
                for (int n = 0; n < 2; ++n) acc[a][b][m][n] = (f32x4){0.f, 0.f, 0.f, 0.f};
    v8i At[4], B0[2], B1[2];
    int sc_w = 0x7a7a7a7a, sc_a = 0x7f7f7f7f; asm volatile("" : "+v"(sc_w), "+v"(sc_a));
    unsigned vA[2][2], nvA[2][2];
    S.aoff(cur, Rr, Cc, vA);
    unsigned cA = __builtin_amdgcn_readfirstlane(cur.a), cB = __builtin_amdgcn_readfirstlane(cur.b);
    PG8_SIDE(cur, 0);
    PG8_STAGE(PG8_SB(0, 0), cB, voffB); PG8_STAGE(PG8_SB(0, 1), cB + hstepB, voffB); PG8_STAGE(PG8_SA(0, 0), cA, vA[0]); PG8_STAGE(PG8_SA(0, 1), cA, vA[1]);
    if (wr == 1) PG8_BAR;
    PG8_WAIT_V(2); PG8_BAR;
    PG8_STAGE(PG8_SB(1, 0), cB + kstep, voffB); PG8_STAGE(PG8_SA(1, 0), cA + kstep, vA[0]); PG8_STAGE(PG8_SB(1, 1), cB + hstepB + kstep, voffB);
    PG8_WAIT_V(6); PG8_BAR;
    for (;;) {
        if (tprobe_) tt0_ = clock64();
        const bool has_next = S.next(ui + 1, nxt);
        const unsigned nA = has_next ? __builtin_amdgcn_readfirstlane(nxt.a) : cA, nB = has_next ? __builtin_amdgcn_readfirstlane(nxt.b) : cB;
        if (has_next) PG8_SIDE(nxt, (ui + 1) & 1);
        if constexpr (Sched::GATHER && !Sched::SIDE) {
            if (has_next) { PG8_RC(); S.aoff(nxt, Rr, Cc, nvA); }
            else { nvA[0][0] = vA[0][0]; nvA[0][1] = vA[0][1]; nvA[1][0] = vA[1][0]; nvA[1][1] = vA[1][1]; }
        }
#pragma unroll 1
        for (int t = 0; t < nt; t += 2) {
            const bool last = (t == nt - 2);
            const unsigned a1 = cA + (unsigned)(t + 1) * kstep;
            const unsigned a2 = last ? nA : cA + (unsigned)(t + 2) * kstep, b2 = last ? nB : cB + (unsigned)(t + 2) * kstep;
            const unsigned a3 = a2 + kstep, b3 = b2 + kstep;
            if constexpr (Sched::GATHER && Sched::SIDE) {
                if (last) { if (has_next) { PG8_RC(); const LAS int* tk = (const LAS int*)(lds + SIDE_OFF + ((ui + 1) & 1) * 2048);
#pragma unroll
                        for (int h = 0; h < 2; ++h)
#pragma unroll
                            for (int i = 0; i < 2; ++i) nvA[h][i] = S.tok_off(tk[h * 128 + Rr[i]], Cc[i]); }
                    else { nvA[0][0] = vA[0][0]; nvA[0][1] = vA[0][1]; nvA[1][0] = vA[1][0]; nvA[1][1] = vA[1][1]; } }
            }
            unsigned w0[2], w1[2];
            if constexpr (Sched::GATHER) { w0[0] = last ? nvA[0][0] : vA[0][0]; w0[1] = last ? nvA[0][1] : vA[0][1]; w1[0] = last ? nvA[1][0] : vA[1][0]; w1[1] = last ? nvA[1][1] : vA[1][1]; }
            else { w0[0] = vA[0][0]; w0[1] = vA[0][1]; w1[0] = vA[1][0]; w1[1] = vA[1][1]; }
            PG8_LDB(B0, 0, 0); PG8_LDB(B1, 0, 1); PG8_SCHED; PG8_LDA(At, 0, 0); PG8_STAGE(PG8_SA(1, 1), a1, vA[1]);
            PG8_WAIT_V(8); PG8_WAIT_L(0); PG8_BAR; PG8_MMA(0, 0, At, B0); PG8_MMA(0, 1, At, B1); PG8_BAR; PG8_SCHED;
            PG8_LDA(At, 0, 1); PG8_STAGE(PG8_SB(0, 0), b2, voffB); PG8_STAGE(PG8_SB(0, 1), b2 + hstepB, voffB); PG8_STAGE(PG8_SA(0, 0), a2, w0);
            PG8_WAIT_V(8); PG8_WAIT_L(0); PG8_BAR; PG8_MMA(1, 0, At, B0); PG8_MMA(1, 1, At, B1); PG8_BAR; PG8_SCHED;
            PG8_LDB(B0, 1, 0); PG8_LDB(B1, 1, 1); PG8_SCHED; PG8_LDA(At, 1, 0); PG8_STAGE(PG8_SA(0, 1), a2, w1);
            PG8_WAIT_V(8); PG8_WAIT_L(0); PG8_BAR; PG8_MMA(0, 0, At, B0); PG8_MMA(0, 1, At, B1); PG8_BAR; PG8_SCHED;
            PG8_LDA(At, 1, 1); PG8_STAGE(PG8_SB(1, 0), b3, voffB); PG8_STAGE(PG8_SB(1, 1), b3 + hstepB, voffB); PG8_STAGE(PG8_SA(1, 0), a3, w0);
            PG8_WAIT_V(8); PG8_WAIT_L(0); PG8_BAR; PG8_MMA(1, 0, At, B0); PG8_MMA(1, 1, At, B1); PG8_BAR; PG8_SCHED;
        }
        if (tprobe_) { const long long n_ = clock64(); tk_ += n_ - tt0_; tt0_ = n_; }
        if (wr == 0) PG8_BAR;
        if constexpr (Epi::FP8) asm volatile("s_nop 15\n\ts_nop 7" ::: "memory");
        { int fr_ = fr, fq_ = fq; asm volatile("" : "+v"(fr_), "+v"(fq_)); E(acc, cur, wr, wc, fr_, fq_, (const LAS float*)(lds + SIDE_OFF + (ui & 1) * 2048 + 1024)); }
        if constexpr (Sched::XSYNC) {
            if (tid == 0) { (void)xb_add(S.xw, 1u); const unsigned tgt = (unsigned)(ui + 1) * S.nloc; unsigned sp = 0;
                while (xb_ld(S.xw) < tgt && ++sp < (1u << 16)) __builtin_amdgcn_s_sleep(1);
                if (!has_next && S.rounds > ui + 1) (void)xb_add(S.xw, (unsigned)(S.rounds - (ui + 1))); }
        }
        if constexpr (Sched::XSYNC || Sched::SIDE) PG8_BAR;
        if (tprobe_) { te_ += clock64() - tt0_; }
        if (!has_next) break;
#pragma unroll
        for (int a = 0; a < 2; ++a)
#pragma unroll
            for (int b = 0; b < 2; ++b)
#pragma unroll
                for (int m = 0; m < 4; ++m)
#pragma unroll
                    for (int n = 0; n < 2; ++n) acc[a][b][m][n] = (f32x4){0.f, 0.f, 0.f, 0.f};
        cur = nxt; cA = nA; cB = nB; ++ui;
        if constexpr (Sched::GATHER) { vA[0][0] = nvA[0][0]; vA[0][1] = nvA[0][1]; vA[1][0] = nvA[1][0]; vA[1][1] = nvA[1][1]; }
        if (wr == 1) PG8_BAR;
    }
    PG8_WAIT_V(0);
    PG8_BAR;
    if (tprobe_ && S.vcu == 0 && tid == 0) { const long long v_ = (SCAN_TSEL == 10) ? tk_ : (SCAN_TSEL == 11 ? 4 * te_ : tk_ + te_); __hip_atomic_fetch_add((unsigned long long*)(wsbase + WS_CTL + 49152), (unsigned long long)v_, __ATOMIC_RELAXED, __HIP_MEMORY_SCOPE_AGENT); }
#undef PG8_RC
#undef PG8_SIDE
#undef PG8_SA
#undef PG8_SB
#undef PG8_STAGE
#undef PG8_LDA
#undef PG8_LDB
#undef PG8_MMA
#undef PG8_WAIT_V
#undef PG8_WAIT_L
#undef PG8_BAR
#undef PG8_SCHED
}
}
using pg8::GU;

struct Args { const float* in[32]; float* out; unsigned char* ws; int ph_lo, ph_hi; };
struct Frame {
    LAS unsigned char* lds;
    LAS unsigned char* scr;
    unsigned char* ws;
    int tid, lane, wave, G, vcu;
};
enum { I_X = 0, I_C, I_CTX, I_CCTX, I_NORMG, I_ADAW, I_ADAB, I_POOLW, I_POOLLS, I_MU, I_WRKV, I_W0, I_W1, I_W2, I_A0, I_A1, I_A2, I_G1, I_G2, I_KK, I_KA, I_RK, I_LNG, I_LNB, I_WO,
       I_RW, I_RB, I_WGU, I_BGU, I_WDN, I_BDN, I_FINALG };

__device__ __forceinline__ const float* modp(const Frame& F, int layer, int row, int k) { return (const float*)(F.ws + WS_MOD) + ((size_t)(layer * 3 + row) * NMOD + k) * D; }
__device__ __forceinline__ int mrow_of(int n) { return n < NL ? (n >> 14) : 2; }

__device__ __forceinline__ void transpose_tile(const float* W, int ldw, int k0, int n0, bf16_t* WT, size_t dst_row0, int ldk, int kdst0, LAS float* scr, int lane) {
    const int c4 = lane & 15, kr = lane >> 4;
#pragma unroll 4
    for (int it = 0; it < 16; ++it) { const int kk = 4 * it + kr; const f32x4 v = *(const GAS f32x4*)(W + (size_t)(k0 + kk) * ldw + n0 + 4 * c4);
        LAS float* s = scr + kk * 65 + 4 * c4; s[0] = v[0]; s[1] = v[1]; s[2] = v[2]; s[3] = v[3]; }
    LDS_WAIT(); asm volatile("" ::: "memory");
    const int c = lane & 7;
#pragma unroll
    for (int j = 0; j < 8; ++j) { const int n = (lane >> 3) + 8 * j; const LAS float* s = scr + (8 * c) * 65 + n;
        u32x4 o; o.x = cvt_pk_bf16(s[0 * 65], s[1 * 65]); o.y = cvt_pk_bf16(s[2 * 65], s[3 * 65]); o.z = cvt_pk_bf16(s[4 * 65], s[5 * 65]); o.w = cvt_pk_bf16(s[6 * 65], s[7 * 65]);
        *(GAS u32x4*)(WT + (dst_row0 + n) * (size_t)ldk + kdst0 + k0 + 8 * c) = o; }
    LDS_WAIT(); asm volatile("" ::: "memory");
}

__device__ __forceinline__ unsigned pk4_fp8(float a, float b, float c, float d) { int w = 0; w = __builtin_amdgcn_cvt_pk_fp8_f32(a, b, w, false); w = __builtin_amdgcn_cvt_pk_fp8_f32(c, d, w, true); return (unsigned)w; }
__device__ __forceinline__ void transpose_tile_fp8(const float* W, int ldw, int k0, int n0, unsigned char* WT, size_t dst_row0, int ldk, float scale, LAS float* scr, int lane) {
    const int c4 = lane & 15, kr = lane >> 4;
#pragma unroll 4
    for (int it = 0; it < 16; ++it) { const int kk = 4 * it + kr; const f32x4 v = *(const GAS f32x4*)(W + (size_t)(k0 + kk) * ldw + n0 + 4 * c4);
        LAS float* s = scr + kk * 65 + 4 * c4; s[0] = v[0] * scale; s[1] = v[1] * scale; s[2] = v[2] * scale; s[3] = v[3] * scale; }
    LDS_WAIT(); asm volatile("" ::: "memory");
    const int c = lane & 3;
#pragma unroll
    for (int j = 0; j < 4; ++j) { const int n = (lane >> 2) + 16 * j; const LAS float* s = scr + (16 * c) * 65 + n;
        u32x4 o; o.x = pk4_fp8(s[0 * 65], s[1 * 65], s[2 * 65], s[3 * 65]); o.y = pk4_fp8(s[4 * 65], s[5 * 65], s[6 * 65], s[7 * 65]);
        o.z = pk4_fp8(s[8 * 65], s[9 * 65], s[10 * 65], s[11 * 65]); o.w = pk4_fp8(s[12 * 65], s[13 * 65], s[14 * 65], s[15 * 65]);
        *(GAS u32x4*)(WT + (dst_row0 + n) * (size_t)ldk + k0 + 16 * c) = o; }
    LDS_WAIT(); asm volatile("" ::: "memory");
}
__device__ __forceinline__ void transpose_tile_fp8_k128(const float* W, int ldw, int k0, int n0, unsigned char* WT, size_t dst_row0, int ldk, float scale, LAS float* scr, int lane) {
    const int c4 = lane & 7, kr = lane >> 3;
#pragma unroll 4
    for (int it = 0; it < 16; ++it) { const int kk = 8 * it + kr; const f32x4 v = *(const GAS f32x4*)(W + (size_t)(k0 + kk) * ldw + n0 + 4 * c4);
        LAS float* s = scr + kk * 33 + 4 * c4; s[0] = v[0] * scale; s[1] = v[1] * scale; s[2] = v[2] * scale; s[3] = v[3] * scale; }
    LDS_WAIT(); asm volatile("" ::: "memory");
    const int c = lane & 7;
#pragma unroll
    for (int j = 0; j < 4; ++j) { const int n = (lane >> 3) + 8 * j; const LAS float* s = scr + (16 * c) * 33 + n;
        u32x4 o; o.x = pk4_fp8(s[0 * 33], s[1 * 33], s[2 * 33], s[3 * 33]); o.y = pk4_fp8(s[4 * 33], s[5 * 33], s[6 * 33], s[7 * 33]);
        o.z = pk4_fp8(s[8 * 33], s[9 * 33], s[10 * 33], s[11 * 33]); o.w = pk4_fp8(s[12 * 33], s[13 * 33], s[14 * 33], s[15 * 33]);
        *(GAS u32x4*)(WT + (dst_row0 + n) * (size_t)ldk + k0 + 16 * c) = o; }
    LDS_WAIT(); asm volatile("" ::: "memory");
}
__device__ __forceinline__ void phase_prep(const Frame& F, const Args& A) {
    unsigned char* ws = F.ws;
    for (int u = blockIdx.x; u < 256; u += F.G) {
        const int l = u >> 7, cc = u & 127, c4 = F.tid % 12, kq = F.tid / 12;
        f32x4 a0 = {0, 0, 0, 0}, a1 = {0, 0, 0, 0}, a2 = {0, 0, 0, 0};
        if (kq < 42) { const float* w = A.in[I_ADAW] + (size_t)l * D * (NMOD * D) + cc * 48 + 4 * c4;
            for (int k = kq; k < D; k += 42) { const f32x4 wv = *(const GAS f32x4*)(w + (size_t)k * (NMOD * D));
                float c0 = A.in[I_C][k], c1 = A.in[I_C][D + k], c2 = A.in[I_CCTX][k];
                c0 = c0 * sigmoidf_(c0); c1 = c1 * sigmoidf_(c1); c2 = c2 * sigmoidf_(c2);
                a0 += wv * c0; a1 += wv * c1; a2 += wv * c2; }
            LAS f32x4* red = (LAS f32x4*)F.scr;
            red[(kq * 3 + 0) * 12 + c4] = a0; red[(kq * 3 + 1) * 12 + c4] = a1; red[(kq * 3 + 2) * 12 + c4] = a2; }
        __syncthreads();
        if (F.tid < 144) { const int r = F.tid / 48, c = F.tid % 48; float sum = 0.f;
            for (int q = 0; q < 42; ++q) sum += ((LAS float*)F.scr)[((q * 3 + r) * 12) * 4 + c];
            const int col = cc * 48 + c;
            ((float*)(ws + WS_MOD))[(size_t)(l * 3 + r) * (NMOD * D) + col] = sum + A.in[I_ADAB][(size_t)l * NMOD * D + col]; }
        __syncthreads();
    }
    { bf16_t* w2p = (bf16_t*)(ws + WS_WL2);
      for (int i = blockIdx.x * NTHREADS + F.tid; i < 4 * 1024 * 8; i += F.G * NTHREADS) { const int o = i / 8192, c = (i / 8) % 1024, q = i % 8, d = o & 1;
          *(GAS u32x4*)(w2p + ((size_t)o * 1024 + c) * 128 + (1 - d) * 64 + q * 8) = (u32x4){0u, 0u, 0u, 0u}; } }
    LAS float* scr = (LAS float*)(F.scr) + F.wave * (128 * 33 + 31);
    const int gw = F.vcu * NWAVES + F.wave, NGW = F.G * NWAVES;
    constexpr int T_GU = 2 * NE * 16 * 32, T_DN = 2 * NE * 16 * 16, T_RKV = 3 * 256, T_WO = 256, T_L1 = 2 * 16 + 2 * 16 + 32, T_L2 = 2 * 16 + 2 * 16 + 2 * 16, T_PW = 4 * 16;
    constexpr int T_ALL = T_GU + T_DN + T_RKV + T_WO + T_L1 + T_L2 + T_PW;
    for (int it = gw; it < T_ALL; it += NGW) {
        int r = it;
        if (r < T_GU) { const int le = r / 512, q = r % 512, kb = q / 64, nb = q % 64; const int n0 = nb * 32;
            const int drow = (n0 < 1024) ? ((n0 >> 7) * 256 + (n0 & 127)) : (((n0 - 1024) >> 7) * 256 + 128 + ((n0 - 1024) & 127));
            transpose_tile_fp8_k128(A.in[I_WGU] + (size_t)le * 1024 * 2048, 2048, kb * 128, n0, ws + WS_WGU, (size_t)le * 2048 + drow, 1024, 32.0f, scr, F.lane); continue; } r -= T_GU;
        if (r < T_DN) { const int le = r / 256, q = r % 256, kb = q / 32, nb = q % 32;
            transpose_tile_fp8_k128(A.in[I_WDN] + (size_t)le * 1024 * 1024, 1024, kb * 128, nb * 32, ws + WS_WDN, (size_t)le * 1024 + nb * 32, 1024, 32.0f, scr, F.lane); continue; } r -= T_DN;
        if (r < T_RKV) { const int p = r / 256, q = r % 256, kb = q / 16, nb = q % 16;
            transpose_tile_fp8(A.in[I_WRKV] + (size_t)p * 1024 * 1024, 1024, kb * 64, nb * 64, ws + WS_WRKV, (size_t)p * 1024 + nb * 64, 1024, 32.0f, scr, F.lane); continue; } r -= T_RKV;
        if (r < T_WO) { const int kb = r / 16, nb = r % 16;
            transpose_tile_fp8(A.in[I_WO], 1024, kb * 64, nb * 64, ws + WS_WO, (size_t)nb * 64, 1024, 32.0f, scr, F.lane); continue; } r -= T_WO;
        if (r < T_L1) {
            if (r < 32) { const int d = r / 16, kb = r % 16; transpose_tile_fp8(A.in[I_W1] + (size_t)d * 1024 * 64, 64, kb * 64, 0, ws + WS_WL1, (size_t)0 * 256 + d * 64, 1024, 32.0f, scr, F.lane); continue; }
            r -= 32;
            if (r < 32) { const int d = r / 16, kb = r % 16; transpose_tile_fp8(A.in[I_A1] + (size_t)d * 1024 * 64, 64, kb * 64, 0, ws + WS_WL1, (size_t)1 * 256 + d * 64, 1024, 32.0f, scr, F.lane); continue; }
            r -= 32;
            { const int kb = r / 2, nb = r % 2; transpose_tile_fp8(A.in[I_G1], 128, kb * 64, nb * 64, ws + WS_WL1, (size_t)2 * 256 + nb * 64, 1024, 32.0f, scr, F.lane); continue; }
        } r -= T_L1;
        if (r < T_L2) {
            if (r < 32) { const int d = r / 16, nb = r % 16; transpose_tile(A.in[I_W2] + (size_t)d * 64 * 1024, 1024, 0, nb * 64, (bf16_t*)(ws + WS_WL2), (size_t)d * 1024 + nb * 64, 128, d * 64, scr, F.lane); continue; }
            r -= 32;
            if (r < 32) { const int d = r / 16, nb = r % 16; transpose_tile(A.in[I_A2] + (size_t)d * 64 * 1024, 1024, 0, nb * 64, (bf16_t*)(ws + WS_WL2), (size_t)(2 + d) * 1024 + nb * 64, 128, d * 64, scr, F.lane); continue; }
            r -= 32;
            { const int kb = r / 16, nb = r % 16; transpose_tile(A.in[I_G2], 1024, kb * 64, nb * 64, (bf16_t*)(ws + WS_WL2), (size_t)4 * 1024 + nb * 64, 128, 0, scr, F.lane); continue; }
        } r -= T_L2;
        { const int g = r / 16, q = r % 16, kb = q / 4, nb = q % 4;
          transpose_tile(A.in[I_POOLW] + (size_t)g * 256 * 256, 256, kb * 64, nb * 64, (bf16_t*)(ws + WS_WPOOL), (size_t)g * 256 + nb * 64, 256, 0, scr, F.lane); }
    }
}

__device__ __forceinline__ void phase_pre0(const Frame& F, const Args& A) {
    LAS float* hb = (LAS float*)F.scr;
    LAS float* rs = hb + 80 * 258;
    LAS float* gsc = rs + 80;
    LAS float* gsh = gsc + 256;
    bf16_t* dbuf = (bf16_t*)(F.ws + WS_DBUF);
    const float* ng = A.in[I_NORMG];
    for (int u = blockIdx.x; u < 512 + NC / 2; u += F.G) {
        int tok0, nown = 64, hl = 0, hr = 0, L, pos0, row; const float* xsrc;
        if (u < 512) { tok0 = u * 64; L = 64; pos0 = 0; row = tok0 >> 14; xsrc = A.in[I_X] + (size_t)tok0 * D; }
        else { const int m = u - 512, b = m / (CT / 2); pos0 = (m % (CT / 2)) * 2; nown = 2; tok0 = NL + b * CT + pos0; L = CT; hl = pos0 < 8 ? pos0 : 8; hr = (CT - pos0 - 2) < 8 ? (CT - pos0 - 2) : 8; row = 2;
               xsrc = A.in[I_CTX] + (size_t)(b * CT + pos0) * D; }
        const int nt = nown + hl + hr;
        for (int j = F.wave; j < nt; j += NWAVES) { const float* xr = xsrc + (ptrdiff_t)(j - hl) * D; float s = 0.f;
#pragma unroll
            for (int q = 0; q < 4; ++q) { const f32x4 v = *(const GAS f32x4*)(xr + 4 * F.lane + 256 * q); s += v[0] * v[0] + v[1] * v[1] + v[2] * v[2] + v[3] * v[3]; }
            s = wave_sum(s); if (F.lane == 0) rs[j] = 1.0f / sqrtf(s * (1.0f / D) + NORM_EPS); }
        for (int g = 0; g < 4; ++g) {
            __syncthreads();
            if (F.tid < 256) { const int c = g * 256 + F.tid; gsc[F.tid] = ng[c] * (1.0f + modp(F, 0, row, 1)[c]); gsh[F.tid] = modp(F, 0, row, 0)[c]; }
            __syncthreads();
            for (int i = F.tid; i < nt * 64; i += NTHREADS) { const int j = i >> 6, c4 = i & 63; const f32x4 v = *(const GAS f32x4*)(xsrc + (ptrdiff_t)(j - hl) * D + g * 256 + 4 * c4);
                const float r = rs[j]; LAS float* h = hb + j * 258 + 4 * c4;
                h[0] = v[0] * r * gsc[4 * c4 + 0] + gsh[4 * c4 + 0]; h[1] = v[1] * r * gsc[4 * c4 + 1] + gsh[4 * c4 + 1];
                h[2] = v[2] * r * gsc[4 * c4 + 2] + gsh[4 * c4 + 2]; h[3] = v[3] * r * gsc[4 * c4 + 3] + gsh[4 * c4 + 3]; }
            __syncthreads();
            const int win = 2 << g, hw = win >> 1;
            if (g < 2) {
                for (int i = F.tid; i < nown * 128; i += NTHREADS) { const int cp = i & 127, t = i >> 7; const int p = pos0 + t;
                    int lo = p - hw, hi = p + hw - 1; lo = lo < 0 ? 0 : lo; hi = hi > L - 1 ? L - 1 : hi;
                    const int jlo = lo - (pos0 - hl), jhi = hi - (pos0 - hl);
                    float s0 = 0.f, s1 = 0.f;
                    for (int j = jlo; j <= jhi; ++j) { const f32x2 v = *(const LAS f32x2*)(hb + j * 258 + 2 * cp); s0 += v[0]; s1 += v[1]; }
                    const float ic = 1.0f / (float)(hi - lo + 1); const f32x2 hv = *(const LAS f32x2*)(hb + (t + hl) * 258 + 2 * cp);
                    *(GAS unsigned*)(dbuf + (size_t)(tok0 + t) * D + g * 256 + 2 * cp) = cvt_pk_bf16(s0 * ic - hv[0], s1 * ic - hv[1]); }
            } else {
                if (F.tid < 256) { float run = 0.f; LAS float* col = hb + F.tid;
#pragma unroll 8
                    for (int j = 0; j < nt; ++j) { run += col[j * 258]; col[j * 258] = run; } }
                __syncthreads();
                for (int i = F.tid; i < nown * 128; i += NTHREADS) { const int cp = i & 127, t = i >> 7; const int p = pos0 + t;
                    int lo = p - hw, hi = p + hw - 1; lo = lo < 0 ? 0 : lo; hi = hi > L - 1 ? L - 1 : hi;
                    const int jlo = lo - (pos0 - hl), jhi = hi - (pos0 - hl), jt = t + hl;
                    const f32x2 z = {0.f, 0.f};
                    const f32x2 ph = *(const LAS f32x2*)(hb + jhi * 258 + 2 * cp), pl = jlo > 0 ? *(const LAS f32x2*)(hb + (jlo - 1) * 258 + 2 * cp) : z;
                    const f32x2 pt = *(const LAS f32x2*)(hb + jt * 258 + 2 * cp), pu = jt > 0 ? *(const LAS f32x2*)(hb + (jt - 1) * 258 + 2 * cp) : z;
                    const float ic = 1.0f / (float)(hi - lo + 1); const f32x2 sm = ph - pl, hv = pt - pu;
                    *(GAS unsigned*)(dbuf + (size_t)(tok0 + t) * D + g * 256 + 2 * cp) = cvt_pk_bf16(sm[0] * ic - hv[0], sm[1] * ic - hv[1]); }
            }
        }
        __syncthreads();
    }
}

struct SchedPool {
    static constexpr bool SIDE = false; static constexpr bool XSYNC = false; static constexpr bool GATHER = false;
    int G, vcu; int nt; unsigned ldb;
    __device__ __forceinline__ bool next(int i, GU& u) const { const int L = i * G + vcu; if (L >= 130 * 4) return false; const int pm = L >> 2, g = L & 3;
        u.a = (unsigned)(WS_DBUF + ((size_t)pm * 256 * D + g * 256) * 2); u.b = (unsigned)(WS_WPOOL + (size_t)g * 256 * 256 * 2); u.i0 = pm; u.i1 = g; u.i2 = 0; u.i3 = 0; return true; }
    __device__ __forceinline__ void aoff(const GU&, const int (&R)[2], const int (&C)[2], unsigned (&v)[2][2]) const {
#pragma unroll
        for (int h = 0; h < 2; ++h)
#pragma unroll
            for (int i = 0; i < 2; ++i) v[h][i] = (unsigned)((h * 128 + R[i]) * D + C[i]) * 2u; }
};
struct EpiPool {
    static constexpr bool FP8 = false; static constexpr bool PERM = true;
    const float* x; const float* ctx; const float* ls; const float* gate_base; bf16_t* xs;
    __device__ __forceinline__ void operator()(const f32x4 (&acc)[2][2][4][2], const GU& u, int wr, int wc, int fr, int fq, const LAS float* sb) const {
        const int pm = u.i0, g = u.i1; const int mrow = pm < 128 ? (pm >> 6) : 2;
        const float* gate = gate_base + (size_t)mrow * NMOD * D;
        const float* src = pm < 128 ? x + (size_t)pm * 256 * D : ctx + (size_t)(pm - 128) * 256 * D;
        const int col0 = g * 256 + wc * 32 + 8 * fq;
        f32x4 gl[2][2];
#pragma unroll
        for (int bj = 0; bj < 2; ++bj)
#pragma unroll
            for (int n = 0; n < 2; ++n) { const int c = col0 + bj * 128 + n * 4; gl[bj][n] = *(const GAS f32x4*)(gate + c) * *(const GAS f32x4*)(ls + c); }
#pragma unroll
        for (int ai = 0; ai < 2; ++ai)
#pragma unroll
            for (int m = 0; m < 4; ++m) { const int r = ai * 128 + wr * 64 + m * 16 + fr; const float* sp = src + (size_t)r * D + col0; bf16_t* op = xs + ((size_t)pm * 256 + r) * D + col0;
#pragma unroll
                for (int bj = 0; bj < 2; ++bj) { const f32x4 v0 = *(const GAS f32x4*)(sp + bj * 128) + gl[bj][0] * acc[ai][bj][m][0], v1 = *(const GAS f32x4*)(sp + bj * 128 + 4) + gl[bj][1] * acc[ai][bj][m][1];
                    u32x4 w; w.x = cvt_pk_bf16(v0[0], v0[1]); w.y = cvt_pk_bf16(v0[2], v0[3]); w.z = cvt_pk_bf16(v1[0], v1[1]); w.w = cvt_pk_bf16(v1[2], v1[3]);
                    *(GAS u32x4*)(op + bj * 128) = w; } }
    }
};

__device__ __forceinline__ void phase_final_plain(const Frame& F, const Args& A, const bf16_t* xs) {
    const int gw = blockIdx.x * NWAVES + F.wave, NGW = F.G * NWAVES;
    for (int n = gw; n < NL; n += NGW) { const bf16_t* xr = xs + (size_t)n * D; f32x4 v[4]; float s = 0.f;
#pragma unroll
        for (int q = 0; q < 4; ++q) { v[q] = ldx4(xr + 4 * F.lane + 256 * q); s += v[q][0] * v[q][0] + v[q][1] * v[q][1] + v[q][2] * v[q][2] + v[q][3] * v[q][3]; }
        s = wave_sum(s); const float r = 1.0f / sqrtf(s * (1.0f / D) + NORM_EPS);
#pragma unroll
        for (int q = 0; q < 4; ++q) { const f32x4 g = *(const GAS f32x4*)(A.in[I_FINALG] + 4 * F.lane + 256 * q); *(GAS f32x4*)(A.out + (size_t)n * D + 4 * F.lane + 256 * q) = v[q] * r * g; }
    }
}


__device__ __forceinline__ int* cnt_word(const Frame& F, int l, int e) { return (int*)(F.ws + WS_CTL + CTL_CNT) + (l * NE + e) * 64; }
__device__ __forceinline__ void phase_post(const Frame& F, const Args& A, int l, const bf16_t* xs, int ntok) {
    LAS float* h2s = (LAS float*)F.scr;
    LAS float* part = (LAS float*)F.scr;
    LAS float* lgs = (LAS float*)(F.scr + 32 * 1028 * 4);
    LAS int* hist = (LAS int*)(lgs + 32 * 33);
    LAS int* base = hist + 32;
    LAS int* sel = base + 32;
    LAS int* lrank = sel + 128;
    unsigned char* H2 = F.ws + WS_H2;
    int* list = (int*)(F.ws + WS_LIST) + (size_t)l * NE * NTOK;
    int* tinfo = (int*)(F.ws + WS_TINFO) + (size_t)l * NTOK * 4;
    float* tgate = (float*)(F.ws + WS_TGATE) + (size_t)l * NTOK * 4;
    const float* ng = A.in[I_NORMG] + (size_t)(l * 2 + 1) * D;
    const float* rw = A.in[I_RW] + (size_t)l * D * NE;
    const float* rb = A.in[I_RB] + (size_t)l * NE;
    const int ntiles = NL / 32 + (ntok > NL ? (ntok - NL) / 2 : 0);
    for (int tile = blockIdx.x; tile < ntiles; tile += F.G) {
        const int n0 = tile < NL / 32 ? tile * 32 : NL + (tile - NL / 32) * 2, cnt = tile < NL / 32 ? 32 : 2, mrow = mrow_of(n0);
        const float* sc = modp(F, l, mrow, 4); const float* sh = modp(F, l, mrow, 3);
        if (F.tid < 32) hist[F.tid] = 0;
#pragma unroll 1
        for (int q = 0; q < 4; ++q) { const int tt = F.wave * 4 + q, n = n0 + tt; if (tt >= cnt) break; const bf16_t* xr = xs + (size_t)n * D; f32x4 v[4]; float s = 0.f;
#pragma unroll
            for (int jj = 0; jj < 4; ++jj) { v[jj] = ldx4(xr + 4 * F.lane + 256 * jj); s += v[jj][0] * v[jj][0] + v[jj][1] * v[jj][1] + v[jj][2] * v[jj][2] + v[jj][3] * v[jj][3]; }
            s = wave_sum(s); const float r = 1.0f / sqrtf(s * (1.0f / D) + NORM_EPS);
#pragma unroll
            for (int jj = 0; jj < 4; ++jj) { const int c = 4 * F.lane + 256 * jj; const f32x4 g = *(const GAS f32x4*)(ng + c), a = *(const GAS f32x4*)(sc + c), b = *(const GAS f32x4*)(sh + c);
                const f32x4 h = v[jj] * r * g * (a + 1.0f) + b;
                *(LAS f32x4*)(h2s + tt * 1028 + c) = h;
                *(GAS unsigned*)(H2 + (size_t)n * D + c) = pk4_fp8(h[0], h[1], h[2], h[3]); } }
        __syncthreads();
        f32x16 acc;
#pragma unroll
        for (int i = 0; i < 16; ++i) acc[i] = 0.f;
        { const int r = F.lane & 31, h = F.lane >> 5;
#pragma unroll
          for (int hf = 0; hf < 4; ++hf) { float bw[16]; f32x4 aw[4];
#pragma unroll
              for (int q = 0; q < 4; ++q) { const int kb = 128 * F.wave + 8 * (4 * hf + q) + 4 * h;
#pragma unroll
                  for (int j = 0; j < 4; ++j) bw[4 * q + j] = rw[(size_t)(kb + j) * NE + r];
                  aw[q] = *(const LAS f32x4*)(h2s + r * 1028 + kb); }
              __builtin_amdgcn_sched_barrier(0);
#pragma unroll
              for (int q = 0; q < 4; ++q) {
                  acc = __builtin_amdgcn_mfma_f32_32x32x2f32(aw[q][0], bw[4 * q + 0], acc, 0, 0, 0); acc = __builtin_amdgcn_mfma_f32_32x32x2f32(aw[q][1], bw[4 * q + 1], acc, 0, 0, 0);
                  acc = __builtin_amdgcn_mfma_f32_32x32x2f32(aw[q][2], bw[4 * q + 2], acc, 0, 0, 0); acc = __builtin_amdgcn_mfma_f32_32x32x2f32(aw[q][3], bw[4 * q + 3], acc, 0, 0, 0); }
              __builtin_amdgcn_sched_barrier(0); } }
        __syncthreads();
#pragma unroll
        for (int i = 0; i < 16; ++i) { const int row = (i & 3) + 8 * (i >> 2) + 4 * (F.lane >> 5), col = F.lane & 31; part[(F.wave * 32 + row) * 32 + col] = acc[i]; }
        __syncthreads();
        for (int i = F.tid; i < 1024; i += NTHREADS) { const int row = i >> 5, col = i & 31; float s = rb[col];
#pragma unroll
            for (int w = 0; w < 8; ++w) s += part[(w * 32 + row) * 32 + col];
            lgs[row * 33 + col] = s; }
        __syncthreads();
        if (F.tid < cnt) { const int t = F.tid; float lv[32];
#pragma unroll
            for (int e = 0; e < 32; ++e) lv[e] = lgs[t * 33 + e];
            float tv[4]; int te[4];
#pragma unroll
            for (int j = 0; j < 4; ++j) { float best = -3.0e38f; int be = 0;
#pragma unroll
                for (int e = 0; e < 32; ++e) { const bool gt = lv[e] > best; best = gt ? lv[e] : best; be = gt ? e : be; }
                tv[j] = best; te[j] = be;
#pragma unroll
                for (int e = 0; e < 32; ++e) lv[e] = (e == be) ? -3.0e38f : lv[e]; }
            const float e1 = __expf(tv[1] - tv[0]), e2 = __expf(tv[2] - tv[0]), e3 = __expf(tv[3] - tv[0]); const float inv = 1.0f / (1.0f + e1 + e2 + e3);
            const float gt[4] = {inv, e1 * inv, e2 * inv, e3 * inv};
#pragma unroll
            for (int j = 0; j < 4; ++j) { sel[t * 4 + j] = te[j]; lrank[t * 4 + j] = __hip_atomic_fetch_add(&hist[te[j]], 1, __ATOMIC_RELAXED, __HIP_MEMORY_SCOPE_WORKGROUP);
                tgate[(size_t)(n0 + t) * 4 + j] = gt[j]; } }
        __syncthreads();
        if (F.tid < 32) { const int c = hist[F.tid]; base[F.tid] = c > 0 ? __hip_atomic_fetch_add(cnt_word(F, l, F.tid), c, __ATOMIC_RELAXED, __HIP_MEMORY_SCOPE_AGENT) : 0; }
        __syncthreads();
        if (F.tid < 4 * cnt) { const int t = F.tid >> 2, e = sel[F.tid], pos = base[e] + lrank[F.tid]; list[(size_t)e * NTOK + pos] = n0 + t; tinfo[(size_t)(n0 + t) * 4 + (F.tid & 3)] = (e << 16) | pos; }
        __syncthreads();
    }
}

__device__ __forceinline__ void moe_prefix(const Frame& F, int l) {
    volatile LAS int* M = (volatile LAS int*)(F.lds + MISC_OFF);
    __syncthreads();
    if (F.tid == 0) { int acc = 0; for (int e = 0; e < NE; ++e) { const int c = __hip_atomic_load(cnt_word(F, l, e), __ATOMIC_RELAXED, __HIP_MEMORY_SCOPE_AGENT); M[64 + e] = c; M[16 + e] = acc; acc += (c + 255) >> 8; } M[16 + NE] = acc; }
    __syncthreads();
    { volatile LAS unsigned char* T2E = (volatile LAS unsigned char*)(F.lds + MISC_OFF + 448);
      for (int t = F.tid; t < 560; t += NTHREADS) { int e = 0; while (e < NE - 1 && M[16 + e + 1] <= t) ++e; T2E[t] = (unsigned char)e; } }
    __syncthreads();
}

struct SchedMoe1 {
    static constexpr bool SIDE = true; static constexpr bool XSYNC = false; static constexpr bool GATHER = true;
    const LAS int* M; const int* list; unsigned h2; unsigned w; int G, vcu; int nt; unsigned ldb; unsigned* xw; unsigned nloc; int rounds; __amdgpu_buffer_rsrc_t rsrcb; unsigned listoff;
    __device__ __forceinline__ bool side_src(const GU& u, int tid, unsigned& off) const { const int e = u.i0, pn = u.i2;
        if (tid < 256) { const int row0 = (u.i1 - M[16 + e]) * 256, nv = M[64 + e] - row0; off = listoff + (unsigned)(e * NTOK + row0 + (tid < nv ? tid : 0)) * 4u; return false; }
        const int j = tid - 256; off = (unsigned)(e * 2048 + (j < 128 ? 0 : 1024) + pn * 128 + (j & 127)) * 4u; return true; }
    __device__ __forceinline__ unsigned tok_off(int tok, int c) const { return (unsigned)(tok * D + 2 * c); }
    __device__ __forceinline__ bool next(int i, GU& u) const { const int L = i * G + vcu; const int tt = M[16 + NE]; if (L >= tt * 8) return false; const int mt = L >> 3, pn = L & 7;
        const int e = ((const LAS unsigned char*)M)[448 + mt];
        u.a = h2; u.b = w + (unsigned)(((size_t)e * 2048 + pn * 256) * 1024); u.i0 = e; u.i1 = mt; u.i2 = pn; u.i3 = 0; return true; }
    __device__ __forceinline__ void aoff(const GU& u, const int (&R)[2], const int (&C)[2], unsigned (&v)[2][2]) const {
        const int e = u.i0, row0 = (u.i1 - M[16 + e]) * 256, nv = M[64 + e] - row0; const int* lp = list + (size_t)e * NTOK + row0;
#pragma unroll
        for (int h = 0; h < 2; ++h)
#pragma unroll
            for (int i = 0; i < 2; ++i) { const int r = h * 128 + R[i]; const int tok = lp[r < nv ? r : 0]; v[h][i] = (unsigned)(tok * D + 2 * C[i]); } }
};
struct EpiMoe1 {
    static constexpr bool FP8 = true; static constexpr bool PERM = true;
    const float* bgu; unsigned char* act;
    __device__ __forceinline__ void operator()(const f32x4 (&acc)[2][2][4][2], const GU& u, int wr, int wc, int fr, int fq, const LAS float* sb) const {
        const int e = u.i0, mt = u.i1, pn = u.i2; const int col0 = pn * 128 + wc * 32 + 8 * fq;
        f32x4 bg[2], bu[2];
#pragma unroll
        for (int n = 0; n < 2; ++n) { bg[n] = *(const LAS f32x4*)(sb + wc * 32 + 8 * fq + 4 * n); bu[n] = *(const LAS f32x4*)(sb + 128 + wc * 32 + 8 * fq + 4 * n); }
#pragma unroll
        for (int ai = 0; ai < 2; ++ai)
#pragma unroll
            for (int m = 0; m < 4; ++m) { const size_t slot = (size_t)mt * 256 + ai * 128 + wr * 64 + m * 16 + fr; float o[8];
#pragma unroll
                for (int n = 0; n < 2; ++n)
#pragma unroll
                    for (int j = 0; j < 4; ++j) { float g = acc[ai][0][m][n][j] + bg[n][j], up = acc[ai][1][m][n][j] + bu[n][j];
                        g = fminf(g, 7.0f); up = fminf(fmaxf(up, -7.0f), 7.0f); o[4 * n + j] = (up + 1.0f) * (g * __builtin_amdgcn_rcpf(1.0f + __expf(-1.702f * g))); }
                u32x2 w; w.x = pk4_fp8(o[0], o[1], o[2], o[3]); w.y = pk4_fp8(o[4], o[5], o[6], o[7]);
                *(GAS u32x2*)(act + slot * D + col0) = w; }
    }
};
struct SchedMoe2 {
    static constexpr bool SIDE = true; static constexpr bool XSYNC = false; static constexpr bool GATHER = false;
    const LAS int* M; unsigned act; unsigned w; int G, vcu; int nt; unsigned ldb; unsigned* xw; unsigned nloc; int rounds; __amdgpu_buffer_rsrc_t rsrcb;
    __device__ __forceinline__ bool side_src(const GU& u, int tid, unsigned& off) const { const int e = u.i0, pn = u.i2;
        if (tid < 256) { off = 0u; return false; }
        off = (unsigned)(e * D + pn * 256 + (tid - 256)) * 4u; return true; }
    __device__ __forceinline__ bool next(int i, GU& u) const { const int L = i * G + vcu; const int tt = M[16 + NE]; if (L >= tt * 4) return false; const int mt = L >> 2, pn = L & 3;
        const int e = ((const LAS unsigned char*)M)[448 + mt];
        u.a = act + (unsigned)((size_t)mt * 256 * D); u.b = w + (unsigned)(((size_t)e * 1024 + pn * 256) * 1024); u.i0 = e; u.i1 = mt; u.i2 = pn; u.i3 = 0; return true; }
    __device__ __forceinline__ void aoff(const GU&, const int (&R)[2], const int (&C)[2], unsigned (&v)[2][2]) const {
#pragma unroll
        for (int h = 0; h < 2; ++h)
#pragma unroll
            for (int i = 0; i < 2; ++i) v[h][i] = (unsigned)((h * 128 + R[i]) * D + 2 * C[i]); }
};
struct EpiMoe2 {
    static constexpr bool FP8 = true; static constexpr bool PERM = true;
    const float* bdn; unsigned char* y2;
    __device__ __forceinline__ void operator()(const f32x4 (&acc)[2][2][4][2], const GU& u, int wr, int wc, int fr, int fq, const LAS float* sb) const {
        const int e = u.i0, mt = u.i1, pn = u.i2; const int col0 = pn * 256 + wc * 32 + 8 * fq;
        f32x4 bv[2][2];
#pragma unroll
        for (int bj = 0; bj < 2; ++bj)
#pragma unroll
            for (int n = 0; n < 2; ++n) bv[bj][n] = *(const LAS f32x4*)(sb + bj * 128 + wc * 32 + 8 * fq + 4 * n);
#pragma unroll
        for (int ai = 0; ai < 2; ++ai)
#pragma unroll
            for (int m = 0; m < 4; ++m) { const size_t slot = (size_t)mt * 256 + ai * 128 + wr * 64 + m * 16 + fr;
#pragma unroll
                for (int bj = 0; bj < 2; ++bj) { const f32x4 v0 = acc[ai][bj][m][0] + bv[bj][0], v1 = acc[ai][bj][m][1] + bv[bj][1];
                    u32x2 w; w.x = pk4_fp8(v0[0], v0[1], v0[2], v0[3]); w.y = pk4_fp8(v1[0], v1[1], v1[2], v1[3]);
                    *(GAS u32x2*)(y2 + slot * D + col0 + bj * 128) = w; } }
    }
};
__device__ __forceinline__ void phase_moe1(const Frame& F, const Args& A, int l) {
    moe_prefix(F, l);
    SchedMoe1 S{(const LAS int*)(F.lds + MISC_OFF), (const int*)(F.ws + WS_LIST) + (size_t)l * NE * NTOK, (unsigned)WS_H2, (unsigned)(WS_WGU + (size_t)l * NE * 2048 * 1024), F.G, F.vcu, 8, 1024u,
                (unsigned*)(F.ws + WS_CTL + CTL_XSYNC) + ((l * 2 + 0) * 16 + xb_xcc_id()) * 32, ((volatile LAS unsigned*)(F.lds + MISC_OFF))[8], (((const LAS int*)(F.lds + MISC_OFF))[16 + NE] * 8 + F.G - 1) / F.G,
                __builtin_amdgcn_make_buffer_rsrc((void*)(A.in[I_BGU] + (size_t)l * NE * 2048), 0, NE * 2048 * 4, 0x00020000), (unsigned)(WS_LIST + (size_t)l * NE * NTOK * 4)};
    EpiMoe1 E{A.in[I_BGU] + (size_t)l * NE * 2048, F.ws + WS_ACT};
    pg8::gemm_phase<EpiMoe1, SchedMoe1>(F.scr, F.ws, S, E);
}
__device__ __forceinline__ void phase_moe2(const Frame& F, const Args& A, int l) {
    moe_prefix(F, l);
    SchedMoe2 S{(const LAS int*)(F.lds + MISC_OFF), (unsigned)WS_ACT, (unsigned)(WS_WDN + (size_t)l * NE * 1024 * 1024), F.G, F.vcu, 8, 1024u,
                (unsigned*)(F.ws + WS_CTL + CTL_XSYNC) + ((l * 2 + 1) * 16 + xb_xcc_id()) * 32, ((volatile LAS unsigned*)(F.lds + MISC_OFF))[8], (((const LAS int*)(F.lds + MISC_OFF))[16 + NE] * 4 + F.G - 1) / F.G,
                __builtin_amdgcn_make_buffer_rsrc((void*)(A.in[I_BDN] + (size_t)l * NE * D), 0, NE * D * 4, 0x00020000)};
    EpiMoe2 E{A.in[I_BDN] + (size_t)l * NE * D, F.ws + WS_Y2};
    pg8::gemm_phase<EpiMoe2, SchedMoe2>(F.scr, F.ws, S, E);
}
__device__ __forceinline__ void moe_combine_row(const Frame& F, int l, int n, f32x4 (&o)[4]) {
    const volatile LAS int* M = (const volatile LAS int*)(F.lds + MISC_OFF);
    const int* ti = (const int*)(F.ws + WS_TINFO) + ((size_t)l * NTOK + n) * 4; const float* tg = (const float*)(F.ws + WS_TGATE) + ((size_t)l * NTOK + n) * 4;
    const unsigned char* y2 = F.ws + WS_Y2;
#pragma unroll
    for (int q = 0; q < 4; ++q) o[q] = (f32x4){0.f, 0.f, 0.f, 0.f};
#pragma unroll
    for (int j = 0; j < 4; ++j) { const int inf = ti[j]; const float g = tg[j]; const int e = inf >> 16, pos = inf & 0xffff; const size_t slot = (size_t)M[16 + e] * 256 + pos;
#pragma unroll
        for (int q = 0; q < 4; ++q) { const int w = *(const GAS int*)(y2 + slot * D + 4 * F.lane + 256 * q);
            const f32x2 lo = __builtin_amdgcn_cvt_pk_f32_fp8(w, false), hi = __builtin_amdgcn_cvt_pk_f32_fp8(w, true);
            o[q] += (f32x4){lo[0], lo[1], hi[0], hi[1]} * g; } }
}
__device__ __forceinline__ void moe_info(const Frame& F, int l, int n, int (&inf)[4], float (&g)[4]) {
    const pg8::v4i a = *(const GAS pg8::v4i*)((const int*)(F.ws + WS_TINFO) + ((size_t)l * NTOK + n) * 4); const f32x4 b = *(const GAS f32x4*)((const float*)(F.ws + WS_TGATE) + ((size_t)l * NTOK + n) * 4);
#pragma unroll
    for (int j = 0; j < 4; ++j) { inf[j] = a[j]; g[j] = b[j]; }
}
__device__ __forceinline__ void moe_gather_issue(const Frame& F, const int (&inf)[4], int (&w)[4][4]) {
    const volatile LAS int* M = (const volatile LAS int*)(F.lds + MISC_OFF); const unsigned char* y2 = F.ws + WS_Y2;
#pragma unroll
    for (int j = 0; j < 4; ++j) { const int e = inf[j] >> 16, pos = inf[j] & 0xffff; const size_t slot = (size_t)M[16 + e] * 256 + pos;
#pragma unroll
        for (int q = 0; q < 4; ++q) w[j][q] = *(const GAS int*)(y2 + slot * D + 4 * F.lane + 256 * q); }
}
__device__ __forceinline__ void moe_gather_sum(const int (&w)[4][4], const float (&g)[4], f32x4 (&o)[4]) {
#pragma unroll
    for (int q = 0; q < 4; ++q) o[q] = (f32x4){0.f, 0.f, 0.f, 0.f};
#pragma unroll
    for (int j = 0; j < 4; ++j)
#pragma unroll
        for (int q = 0; q < 4; ++q) { const f32x2 lo = __builtin_amdgcn_cvt_pk_f32_fp8(w[j][q], false), hi = __builtin_amdgcn_cvt_pk_f32_fp8(w[j][q], true); o[q] += (f32x4){lo[0], lo[1], hi[0], hi[1]} * g[j]; }
}
__device__ __forceinline__ void phase_final(const Frame& F, const Args& A, int l, const bf16_t* xs) {
    moe_prefix(F, l);
    const int gw = blockIdx.x * NWAVES + F.wave, NGW = F.G * NWAVES;
    int inf2[4] = {0, 0, 0, 0}, w1[4][4]; float g1[4] = {0.f, 0.f, 0.f, 0.f}, g2[4] = {0.f, 0.f, 0.f, 0.f}; u32x2 x1[4];
#pragma unroll
    for (int j = 0; j < 4; ++j) {
#pragma unroll
        for (int q = 0; q < 4; ++q) w1[j][q] = 0;
        x1[j] = (u32x2){0u, 0u}; }
    if (gw < NL) { int inf1[4]; moe_info(F, l, gw, inf1, g1); if (gw + NGW < NL) moe_info(F, l, gw + NGW, inf2, g2);
        moe_gather_issue(F, inf1, w1);
#pragma unroll
        for (int q = 0; q < 4; ++q) x1[q] = *(const GAS u32x2*)(xs + (size_t)gw * D + 4 * F.lane + 256 * q); }
    for (int n = gw; n < NL; n += NGW) { const float* gate = modp(F, l, n >> 14, 5); f32x4 v[4], mo[4]; float s = 0.f;
        int inf3[4] = {0, 0, 0, 0}, w2[4][4]; float g3[4] = {0.f, 0.f, 0.f, 0.f}; u32x2 x2[4];
        if (n + 2 * NGW < NL) moe_info(F, l, n + 2 * NGW, inf3, g3);
        if (n + NGW < NL) { moe_gather_issue(F, inf2, w2);
#pragma unroll
            for (int q = 0; q < 4; ++q) x2[q] = *(const GAS u32x2*)(xs + (size_t)(n + NGW) * D + 4 * F.lane + 256 * q); }
        else {
#pragma unroll
            for (int j = 0; j < 4; ++j) {
#pragma unroll
                for (int q = 0; q < 4; ++q) w2[j][q] = 0;
                x2[j] = (u32x2){0u, 0u}; } }
        moe_gather_sum(w1, g1, mo);
#pragma unroll
        for (int q = 0; q < 4; ++q) { const int c = 4 * F.lane + 256 * q; v[q] = (f32x4){bf_lo(x1[q].x), bf_hi(x1[q].x), bf_lo(x1[q].y), bf_hi(x1[q].y)} + *(const GAS f32x4*)(gate + c) * mo[q]; s += v[q][0] * v[q][0] + v[q][1] * v[q][1] + v[q][2] * v[q][2] + v[q][3] * v[q][3]; }
        s = wave_sum(s); const float r = 1.0f / sqrtf(s * (1.0f / D) + NORM_EPS);
#pragma unroll
        for (int q = 0; q < 4; ++q) { const f32x4 g = *(const GAS f32x4*)(A.in[I_FINALG] + 4 * F.lane + 256 * q); f32x4 o = v[q] * r * g;
            if (SCAN_TSEL >= 0) { const long long tb = *(const long long*)(F.ws + WS_CTL + 49152); if (n < (int)(tb / 200000) * 200) o += 1.0f; }
            *(GAS f32x4*)(A.out + (size_t)n * D + 4 * F.lane + 256 * q) = o; }
#pragma unroll
        for (int j = 0; j < 4; ++j) { g1[j] = g2[j]; g2[j] = g3[j]; inf2[j] = inf3[j]; x1[j] = x2[j];
#pragma unroll
            for (int q = 0; q < 4; ++q) w1[j][q] = w2[j][q]; }
    }
}

__device__ __forceinline__ void phase_pre1(const Frame& F, const Args& A) {
    moe_prefix(F, 0);
    LAS float* hs = (LAS float*)F.scr;
    const bf16_t* xs0 = (const bf16_t*)(F.ws + WS_XS0); bf16_t* xs1 = (bf16_t*)(F.ws + WS_XS1);
    const float* ng = A.in[I_NORMG] + (size_t)(1 * 2 + 0) * D;
    for (int tile = blockIdx.x; tile < NL / 32 + NC / 2; tile += F.G) {
        const int n0 = tile < NL / 32 ? tile * 32 : NL + (tile - NL / 32) * 2, cnt = tile < NL / 32 ? 32 : 2, mrow = mrow_of(n0);
        const int sbeg = n0 < NL ? (n0 & ~(TSEQ - 1)) : (NL + ((n0 - NL) & ~(CT - 1))), send = sbeg + (n0 < NL ? TSEQ : CT);
        const float* gate5 = modp(F, 0, mrow, 5); const float* sc = modp(F, 1, mrow, 1); const float* sh = modp(F, 1, mrow, 0);
        for (int j = F.wave; j < cnt + 2; j += NWAVES) { const int n = n0 - 1 + j;
            if (n < sbeg || n >= send) {
#pragma unroll
                for (int q = 0; q < 4; ++q) *(LAS f32x4*)(hs + j * 1028 + 4 * F.lane + 256 * q) = (f32x4){0.f, 0.f, 0.f, 0.f};
                continue; }
            f32x4 mo[4], v[4]; float s = 0.f; moe_combine_row(F, 0, n, mo);
#pragma unroll
            for (int q = 0; q < 4; ++q) { const int c = 4 * F.lane + 256 * q; v[q] = ldx4(xs0 + (size_t)n * D + c) + *(const GAS f32x4*)(gate5 + c) * mo[q];
                s += v[q][0] * v[q][0] + v[q][1] * v[q][1] + v[q][2] * v[q][2] + v[q][3] * v[q][3]; }
            if (j >= 1 && j <= cnt) {
#pragma unroll
                for (int q = 0; q < 4; ++q) stx4(xs1 + (size_t)n * D + 4 * F.lane + 256 * q, v[q]); }
            s = wave_sum(s); const float r = 1.0f / sqrtf(s * (1.0f / D) + NORM_EPS);
#pragma unroll
            for (int q = 0; q < 4; ++q) { const int c = 4 * F.lane + 256 * q; const f32x4 g = *(const GAS f32x4*)(ng + c), a = *(const GAS f32x4*)(sc + c), b = *(const GAS f32x4*)(sh + c);
                *(LAS f32x4*)(hs + j * 1028 + c) = v[q] * r * g * (a + 1.0f) + b; } }
        __syncthreads();
#pragma unroll 1
        for (int q4 = 0; q4 < 4; ++q4) { const int t = F.wave * 4 + q4, j = t + 1, n = n0 + t; const int c0 = 16 * F.lane;
            if (t >= cnt) break;
            f32x4 h0[4], xx[4];
#pragma unroll
            for (int q = 0; q < 4; ++q) { const int c = c0 + 4 * q;
                const f32x4 hm = *(const LAS f32x4*)(hs + (j - 1) * 1028 + c), hp = *(const LAS f32x4*)(hs + (j + 1) * 1028 + c); h0[q] = *(const LAS f32x4*)(hs + j * 1028 + c);
                xx[q] = (hm + hp) * 0.5f - h0[q]; }
#pragma unroll
            for (int i = 0; i < 6; ++i) { u32x4 w; unsigned wq[4];
#pragma unroll
                for (int q = 0; q < 4; ++q) { const f32x4 mu = *(const GAS f32x4*)(A.in[I_MU] + (size_t)i * D + c0 + 4 * q); const f32x4 o = h0[q] + xx[q] * mu; wq[q] = pk4_fp8(o[0], o[1], o[2], o[3]); }
                w.x = wq[0]; w.y = wq[1]; w.z = wq[2]; w.w = wq[3];
                *(GAS u32x4*)(F.ws + WS_MIX + (size_t)i * NTOK * D + (size_t)n * D + c0) = w; } }
        __syncthreads();
    }
}

struct SchedProj {
    static constexpr bool SIDE = false; static constexpr bool XSYNC = false; static constexpr bool GATHER = false;
    int G, vcu; int nt; unsigned ldb;
    __device__ __forceinline__ bool next(int i, GU& u) const { int L = i * G + vcu; if (L >= 1940) return false;
        int kind, mi, wi, pm, pn;
        if (L < 512) { kind = 0; mi = 0; wi = 0; pm = L >> 2; pn = L & 3; }
        else if (L < 1032) { L -= 512; kind = 0; mi = 2; wi = 1; pm = L >> 2; pn = L & 3; }
        else if (L < 1552) { L -= 1032; kind = 0; mi = 3; wi = 2; pm = L >> 2; pn = L & 3; }
        else if (L < 1682) { L -= 1552; kind = 1; mi = 1; wi = 0; pm = L; pn = 0; }
        else if (L < 1812) { L -= 1682; kind = 2; mi = 4; wi = 1; pm = L; pn = 0; }
        else { L -= 1812; kind = 3; mi = 5; wi = 2; pm = L; pn = 0; }
        u.a = (unsigned)(WS_MIX + (size_t)mi * NTOK * D + (size_t)pm * 256 * D);
        u.b = kind == 0 ? (unsigned)(WS_WRKV + ((size_t)wi * 1024 + pn * 256) * 1024) : (unsigned)(WS_WL1 + (size_t)wi * 256 * 1024);
        u.i0 = pm; u.i1 = pn; u.i2 = kind; u.i3 = wi; return true; }
    __device__ __forceinline__ void aoff(const GU&, const int (&R)[2], const int (&C)[2], unsigned (&v)[2][2]) const {
#pragma unroll
        for (int h = 0; h < 2; ++h)
#pragma unroll
            for (int i = 0; i < 2; ++i) v[h][i] = (unsigned)((h * 128 + R[i]) * D + 2 * C[i]); }
};
struct EpiProj {
    static constexpr bool FP8 = true; static constexpr bool PERM = true;
    unsigned char* ws;
    __device__ __forceinline__ void operator()(const f32x4 (&acc)[2][2][4][2], const GU& u, int wr, int wc, int fr, int fq, const LAS float* sb) const {
        const int pm = u.i0, pn = u.i1, kind = u.i2, wi = u.i3;
        if (kind == 0) { bf16_t* o = (bf16_t*)(ws + WS_RKV + (size_t)wi * ACTB); const int col0 = pn * 256 + wc * 32 + 8 * fq;
#pragma unroll
            for (int ai = 0; ai < 2; ++ai)
#pragma unroll
                for (int m = 0; m < 4; ++m) { const size_t n = (size_t)pm * 256 + ai * 128 + wr * 64 + m * 16 + fr;
#pragma unroll
                    for (int bj = 0; bj < 2; ++bj) { const f32x4 v0 = acc[ai][bj][m][0], v1 = acc[ai][bj][m][1];
                        u32x4 w; w.x = cvt_pk_bf16(v0[0], v0[1]); w.y = cvt_pk_bf16(v0[2], v0[3]); w.z = cvt_pk_bf16(v1[0], v1[1]); w.w = cvt_pk_bf16(v1[2], v1[3]);
                        *(GAS u32x4*)(o + n * D + col0 + bj * 128) = w; } }
        } else { bf16_t* o = (bf16_t*)(ws + WS_LACT + (size_t)(kind - 1) * NTOK * 128 * 2); const int col0 = wc * 32 + 8 * fq;
#pragma unroll
            for (int ai = 0; ai < 2; ++ai)
#pragma unroll
                for (int m = 0; m < 4; ++m) { const size_t n = (size_t)pm * 256 + ai * 128 + wr * 64 + m * 16 + fr; float t[8];
#pragma unroll
                    for (int nn = 0; nn < 2; ++nn)
#pragma unroll
                        for (int j = 0; j < 4; ++j) { const float x = acc[ai][0][m][nn][j]; t[4 * nn + j] = kind == 1 ? tanhf(x) : (kind == 2 ? x : sigmoidf_(x)); }
                    u32x4 w; w.x = cvt_pk_bf16(t[0], t[1]); w.y = cvt_pk_bf16(t[2], t[3]); w.z = cvt_pk_bf16(t[4], t[5]); w.w = cvt_pk_bf16(t[6], t[7]);
                    *(GAS u32x4*)(o + n * 128 + col0) = w; } }
    }
};
struct SchedLora2 {
    static constexpr bool SIDE = false; static constexpr bool XSYNC = false; static constexpr bool GATHER = false;
    int G, vcu; int nt; unsigned ldb;
    __device__ __forceinline__ bool next(int i, GU& u) const { int L = i * G + vcu; if (L >= 4 * 520 + 512) return false;
        const int o = L < 2080 ? L / 520 : 4; L -= o * 520; const int pm = L >> 2, pn = L & 3; const int oa = o < 4 ? (o >> 1) : 2;
        u.a = (unsigned)(WS_LACT + (size_t)oa * NTOK * 128 * 2 + (size_t)pm * 256 * 128 * 2); u.b = (unsigned)(WS_WL2 + ((size_t)o * 1024 + pn * 256) * 128 * 2);
        u.i0 = pm; u.i1 = pn; u.i2 = o; u.i3 = 0; return true; }
    __device__ __forceinline__ void aoff(const GU&, const int (&R)[2], const int (&C)[2], unsigned (&v)[2][2]) const {
#pragma unroll
        for (int h = 0; h < 2; ++h)
#pragma unroll
            for (int i = 0; i < 2; ++i) v[h][i] = (unsigned)((h * 128 + R[i]) * 128 + C[i]) * 2u; }
};
struct EpiLora2 {
    static constexpr bool FP8 = false; static constexpr bool PERM = true;
    unsigned char* ws; const float* w0; const float* a0;
    __device__ __forceinline__ void operator()(const f32x4 (&acc)[2][2][4][2], const GU& u, int wr, int wc, int fr, int fq, const LAS float* sb) const {
        const int pm = u.i0, pn = u.i1, o = u.i2; const int col0 = pn * 256 + wc * 32 + 8 * fq;
        const float* bp = (o < 2 ? w0 + (size_t)o * D : a0 + (size_t)(o & 1) * D) + col0; const float bsc = o < 4 ? 1.0f : 0.0f;
        f32x4 bv[2][2];
#pragma unroll
        for (int bj = 0; bj < 2; ++bj)
#pragma unroll
            for (int n = 0; n < 2; ++n) bv[bj][n] = *(const GAS f32x4*)(bp + bj * 128 + n * 4) * bsc;
        const size_t row0 = (size_t)pm * 256 + wr * 64 + fr;
        if (o < 2) { bf16_t* dst = (bf16_t*)(ws + WS_DEC + (size_t)o * ACTB) + row0 * D + col0;
#pragma unroll
            for (int ai = 0; ai < 2; ++ai)
#pragma unroll
                for (int m = 0; m < 4; ++m)
#pragma unroll
                    for (int bj = 0; bj < 2; ++bj) { float t[8];
#pragma unroll
                        for (int nn = 0; nn < 2; ++nn) { const f32x4 z = acc[ai][bj][m][nn] + bv[bj][nn];
#pragma unroll
                            for (int j = 0; j < 4; ++j) t[4 * nn + j] = -0.87503527f * sigmoidf_(z[j]); }
                        u32x4 w; w.x = cvt_pk_bf16(t[0], t[1]); w.y = cvt_pk_bf16(t[2], t[3]); w.z = cvt_pk_bf16(t[4], t[5]); w.w = cvt_pk_bf16(t[6], t[7]);
                        *(GAS u32x4*)(dst + (size_t)(ai * 128 + m * 16) * D + bj * 128) = w; }
        } else { bf16_t* dst = (o < 4 ? (bf16_t*)(ws + WS_ICL + (size_t)(o - 2) * ACTB) : (bf16_t*)(ws + WS_G)) + row0 * D + col0; const bool sg = o < 4;
#pragma unroll
            for (int ai = 0; ai < 2; ++ai)
#pragma unroll
                for (int m = 0; m < 4; ++m)
#pragma unroll
                    for (int bj = 0; bj < 2; ++bj) { float t[8];
#pragma unroll
                        for (int nn = 0; nn < 2; ++nn) { const f32x4 z = acc[ai][bj][m][nn] + bv[bj][nn];
#pragma unroll
                            for (int j = 0; j < 4; ++j) t[4 * nn + j] = sg ? sigmoidf_(z[j]) : z[j]; }
                        u32x4 w; w.x = cvt_pk_bf16(t[0], t[1]); w.y = cvt_pk_bf16(t[2], t[3]); w.z = cvt_pk_bf16(t[4], t[5]); w.w = cvt_pk_bf16(t[6], t[7]);
                        *(GAS u32x4*)(dst + (size_t)(ai * 128 + m * 16) * D + bj * 128) = w; }
        }
    }
};
__device__ __forceinline__ void ld16bf(const bf16_t* p, float (&o)[16]) { const u32x4 a = *(const GAS u32x4*)p, b = *(const GAS u32x4*)(p + 8);
    o[0] = bf_lo(a.x); o[1] = bf_hi(a.x); o[2] = bf_lo(a.y); o[3] = bf_hi(a.y); o[4] = bf_lo(a.z); o[5] = bf_hi(a.z); o[6] = bf_lo(a.w); o[7] = bf_hi(a.w);
    o[8] = bf_lo(b.x); o[9] = bf_hi(b.x); o[10] = bf_lo(b.y); o[11] = bf_hi(b.y); o[12] = bf_lo(b.z); o[13] = bf_hi(b.z); o[14] = bf_lo(b.w); o[15] = bf_hi(b.w); }
__device__ __forceinline__ void st16bf(bf16_t* p, const float (&o)[16]) { u32x4 a, b;
    a.x = cvt_pk_bf16(o[0], o[1]); a.y = cvt_pk_bf16(o[2], o[3]); a.z = cvt_pk_bf16(o[4], o[5]); a.w = cvt_pk_bf16(o[6], o[7]);
    b.x = cvt_pk_bf16(o[8], o[9]); b.y = cvt_pk_bf16(o[10], o[11]); b.z = cvt_pk_bf16(o[12], o[13]); b.w = cvt_pk_bf16(o[14], o[15]);
    *(GAS u32x4*)p = a; *(GAS u32x4*)(p + 8) = b; }
__device__ __forceinline__ void ld16f(const float* p, float (&o)[16]) {
#pragma unroll
    for (int q = 0; q < 4; ++q) { const f32x4 v = *(const GAS f32x4*)(p + 4 * q); o[4 * q] = v[0]; o[4 * q + 1] = v[1]; o[4 * q + 2] = v[2]; o[4 * q + 3] = v[3]; } }
__device__ __forceinline__ void phase_fin(const Frame& F, const Args& A) {
    const int gw = blockIdx.x * NWAVES + F.wave, NGW = F.G * NWAVES; const int c0 = 16 * F.lane;
    float kkw[16]; ld16f(A.in[I_KK] + c0, kkw);
    const bf16_t* Kp = (const bf16_t*)(F.ws + WS_RKV + 1 * ACTB);
    for (int n = gw; n < NTOK; n += NGW) { const size_t off = (size_t)n * D + c0; float k[16];
        ld16bf(Kp + off, k);
        float ss = 0.f;
#pragma unroll
        for (int j = 0; j < 16; ++j) { const float kk = k[j] * kkw[j]; ss += kk * kk; }
        ss = dpp_xadd(ss, 0); ss = dpp_xadd(ss, 1);
        const float inv = 1.0f / fmaxf(sqrtf(ss), 1e-12f);
        if ((F.lane & 3) == 0) ((float*)(F.ws + WS_KK))[(size_t)n * 16 + (F.lane >> 2)] = inv;
    }
}
constexpr int CK = 32, SNS = CT + TSEQ, CNCH = SNS / CK;
constexpr int RS = 144, TS = 80;
constexpr int OS_A = 0, OS_R = 4608, OS_KT = 9216, OS_BT = 14336, OS_VT = 19456, OS_GAM = 20736, OS_BYTES = 20992;
constexpr int OG_B = 0, OG_K = 4608, OG_BYTES = 9216;
constexpr int GM_KA = 0, GM_KR = 2560, GM_BR = 5120, GM_TT = 7680, GM_BYTES = 10240;
constexpr int RAW_V = 4 * 4096, RAW_INV = RAW_V + 1024, RAW_BYTES = RAW_INV + 256, NRAW = 4;
constexpr int L_OS = 0, L_OG = 2 * OS_BYTES, L_GM = L_OG + 2 * OG_BYTES, L_RAW = L_GM + 2 * GM_BYTES, L_SCAN_END = L_RAW + NRAW * RAW_BYTES;
static_assert(L_SCAN_END <= SCR_BYTES, "scan LDS");
__device__ __forceinline__ int scan_token(int sg, int d, int b) { if (sg < CT) { const int t = d ? (CT - 1 - sg) : sg; return NL + b * CT + t; } const int u = sg - CT; const int t = d ? (TSEQ - 1 - u) : u; return b * TSEQ + t; }
__device__ __forceinline__ unsigned short f2bf(float f) { return (unsigned short)(cvt_pk_bf16(f, 0.f) & 0xffffu); }
__device__ __forceinline__ int acc_row(int p, int lane) { return (p & 3) + 8 * (p >> 2) + 4 * (lane >> 5); }
__device__ __forceinline__ void st_acc32(LAS unsigned char* dst, const f32x16& a, int lane) {
#pragma unroll
    for (int p = 0; p < 16; ++p) *(LAS unsigned short*)(dst + acc_row(p, lane) * TS + 2 * (lane & 31)) = f2bf(a[p]);
}
__device__ __forceinline__ void st_acc32_t(LAS unsigned char* dst, const f32x16& a, int lane) {
#pragma unroll
    for (int g = 0; g < 4; ++g) { u32x2 w; w.x = cvt_pk_bf16(a[4 * g], a[4 * g + 1]); w.y = cvt_pk_bf16(a[4 * g + 2], a[4 * g + 3]); *(LAS u32x2*)(dst + (lane & 31) * TS + 2 * (8 * g + 4 * (lane >> 5))) = w; }
}
__device__ __forceinline__ bf16x8 acc_bfrag(const f32x16& a, int s) { u32x4 w; w.x = cvt_pk_bf16(a[8 * s + 0], a[8 * s + 1]); w.y = cvt_pk_bf16(a[8 * s + 2], a[8 * s + 3]); w.z = cvt_pk_bf16(a[8 * s + 4], a[8 * s + 5]); w.w = cvt_pk_bf16(a[8 * s + 6], a[8 * s + 7]); return __builtin_bit_cast(bf16x8, w); }
__device__ __forceinline__ bf16x8 lds_afrag_perm(const LAS unsigned char* m, int s, int lane) { const LAS unsigned char* p = m + (lane & 31) * TS + 2 * (16 * s + 4 * (lane >> 5));
    const u32x2 lo = *(const LAS u32x2*)p, hi = *(const LAS u32x2*)(p + 16); u32x4 w; w.x = lo.x; w.y = lo.y; w.z = hi.x; w.w = hi.y; return __builtin_bit_cast(bf16x8, w); }
__device__ __forceinline__ bf16x8 ld2x8(const LAS unsigned char* p0, const LAS unsigned char* p1) { const u32x2 lo = *(const LAS u32x2*)p0, hi = *(const LAS u32x2*)p1; return __builtin_bit_cast(bf16x8, (u32x4){lo.x, lo.y, hi.x, hi.y}); }
__device__ __forceinline__ f32x16 gram32(const LAS unsigned char* P, const LAS unsigned char* Q, int lane) {
    f32x16 c;
#pragma unroll
    for (int p = 0; p < 16; ++p) c[p] = 0.f;
#pragma unroll
    for (int s = 0; s < 4; ++s) { const bf16x8 a = *(const LAS bf16x8*)(P + (lane & 31) * RS + 32 * s + 16 * (lane >> 5)), b = *(const LAS bf16x8*)(Q + (lane & 31) * RS + 32 * s + 16 * (lane >> 5));
        c = __builtin_amdgcn_mfma_f32_32x32x16_bf16(a, b, c, 0, 0, 0); }
    return c;
}
__device__ __forceinline__ void phase_scan(const Frame& F, const Args& A) {
    LAS unsigned char* lds = F.scr;
    const int lane = F.lane, wave = F.wave;
    const __amdgpu_buffer_rsrc_t rsrc = __builtin_amdgcn_make_buffer_rsrc((void*)F.ws, 0, 0xffffffff, 0x00020000);
    for (int job_ = F.vcu; job_ < 256; job_ += F.G) {
        const int job = __builtin_amdgcn_readfirstlane(job_);
        const int sd = job >> 2, rq = job & 3, d = sd & 1, bh = sd >> 1, b = bh >> 4, hd = bh & 15;
        f32x4 Xa[4];
#pragma unroll
        for (int t = 0; t < 4; ++t) Xa[t] = (f32x4){0.f, 0.f, 0.f, 0.f};
        const int pj = (wave - 3) & 3;
        const bool is_prep = wave >= 3 && wave <= 6;
        const float kkw_l = A.in[I_KK][hd * 64 + 16 * pj + (lane & 15)];
        const float ka_l = A.in[I_KA][hd * 64 + 16 * pj + (lane & 15)];
        const unsigned dma_v = (unsigned)((d ? 7 - (lane >> 3) : (lane >> 3)) * (D * 2) + (lane & 7) * 16), dma_vv = (unsigned)((d ? 31 - (lane >> 1) : (lane >> 1)) * (D * 2) + (lane & 1) * 16), dma_vi = (unsigned)((d ? 31 - (lane & 31) : (lane & 31)) * 64);
#define SCAN_DMA(c) do { const int c_ = (c); LAS unsigned char* raw_ = lds + L_RAW + (c_ & (NRAW - 1)) * RAW_BYTES; const int n0_ = scan_token(c_ * CK, d, b); \
            _Pragma("unroll") for (int g = 0; g < 4; ++g) { const unsigned so_ = (unsigned)(d ? n0_ - 8 * g - 7 : n0_ + 8 * g) * (unsigned)(D * 2) + (unsigned)(hd * 128); \
                __builtin_amdgcn_raw_ptr_buffer_load_lds(rsrc, (LAS void*)(raw_ + 0 * 4096 + g * 1024), 16, (int)dma_v, (int)(so_ + (unsigned)(WS_DEC + (size_t)d * ACTB)), 0, 0); \
                __builtin_amdgcn_raw_ptr_buffer_load_lds(rsrc, (LAS void*)(raw_ + 1 * 4096 + g * 1024), 16, (int)dma_v, (int)(so_ + (unsigned)(WS_ICL + (size_t)d * ACTB)), 0, 0); \
                __builtin_amdgcn_raw_ptr_buffer_load_lds(rsrc, (LAS void*)(raw_ + 2 * 4096 + g * 1024), 16, (int)dma_v, (int)(so_ + (unsigned)(WS_RKV + ACTB)), 0, 0); \
                if (c_ >= CT / CK) __builtin_amdgcn_raw_ptr_buffer_load_lds(rsrc, (LAS void*)(raw_ + 3 * 4096 + g * 1024), 16, (int)dma_v, (int)(so_ + (unsigned)WS_RKV), 0, 0); } \
            { const unsigned so_ = (unsigned)(d ? n0_ - 31 : n0_) * (unsigned)(D * 2) + (unsigned)(hd * 128 + rq * 32) + (unsigned)(WS_RKV + 2 * ACTB); \
              __builtin_amdgcn_raw_ptr_buffer_load_lds(rsrc, (LAS void*)(raw_ + RAW_V), 16, (int)dma_vv, (int)so_, 0, 0); } \
            { const unsigned so_ = (unsigned)(d ? n0_ - 31 : n0_) * 64u + (unsigned)(hd * 4) + (unsigned)WS_KK; \
              __builtin_amdgcn_raw_ptr_buffer_load_lds(rsrc, (LAS void*)(raw_ + RAW_INV), 4, (int)dma_vi, (int)so_, 0, 0); } } while (0)
        __syncthreads();
        if (wave == 7) { SCAN_DMA(0); SCAN_DMA(1); asm volatile("s_waitcnt vmcnt(0)" ::: "memory"); SCAN_DMA(2); }
        __syncthreads();
#define SCAN_BAR() do { asm volatile("s_waitcnt lgkmcnt(0)" ::: "memory"); __builtin_amdgcn_s_barrier(); asm volatile("" ::: "memory"); } while (0)
        long long tbusy = 0; long long tloop0_ = 0; if (SCAN_TSEL == 8) tloop0_ = clock64();
        if (wave != 0) for (int it = -2; it < CNCH; ++it) {
            const int cg = it + 1, cp = it + 2;
            long long t0_ = 0; if (SCAN_TSEL >= 0) t0_ = clock64();
            if (is_prep) {
                __builtin_amdgcn_s_setprio(2);
                if (cp < CNCH) {
                    const LAS unsigned char* raw = lds + L_RAW + (cp & (NRAW - 1)) * RAW_BYTES;
                    LAS unsigned char* os = lds + L_OS + (cp & 1) * OS_BYTES; LAS unsigned char* og = lds + L_OG + (cp & 1) * OG_BYTES;
                    const int rg = lane >> 4, ch = 16 * pj + (lane & 15);
                    unsigned short rlw_[8], ric_[8], rkx_[8], rr_[8];
#pragma unroll
                    for (int j = 0; j < 8; ++j) { const LAS unsigned char* p = raw + (8 * rg + j) * 128 + 2 * ch; rlw_[j] = *(const LAS unsigned short*)p; ric_[j] = *(const LAS unsigned short*)(p + 4096);
                        rkx_[j] = *(const LAS unsigned short*)(p + 8192); rr_[j] = *(const LAS unsigned short*)(p + 12288); }
                    const f32x4 inv0 = *(const LAS f32x4*)(raw + RAW_INV + 32 * rg), inv1 = *(const LAS f32x4*)(raw + RAW_INV + 32 * rg + 16);
                    __builtin_amdgcn_sched_barrier(0);
                    float S = 0.f, lwv[8];
#pragma unroll
                    for (int j = 0; j < 8; ++j) { lwv[j] = bf2f(rlw_[j]); S += lwv[j]; }
                    const float S1 = __builtin_bit_cast(float, __builtin_amdgcn_ds_bpermute(((lane + 16) & 63) * 4, __builtin_bit_cast(int, S)));
                    const float S2 = __builtin_bit_cast(float, __builtin_amdgcn_ds_bpermute(((lane + 32) & 63) * 4, __builtin_bit_cast(int, S)));
                    const float S3 = __builtin_bit_cast(float, __builtin_amdgcn_ds_bpermute(((lane + 48) & 63) * 4, __builtin_bit_cast(int, S)));
                    const float Ltot = (S + S1) + (S2 + S3), Lpre = (rg >= 3 ? S1 : 0.f) + (rg >= 2 ? S2 : 0.f) + (rg >= 1 ? S3 : 0.f);
                    const float gam = __builtin_amdgcn_exp2f(Ltot);
                    if (rg == 0) *(LAS float*)(os + OS_GAM + 4 * ch) = gam;
                    float Lr = Lpre, ep_prev = __builtin_amdgcn_exp2f(Lpre); float kt[8], bt[8]; const bool has_r = cp >= CT / CK;
#pragma unroll
                    for (int j = 0; j < 8; ++j) { const int m = 8 * rg + j; Lr += lwv[j];
                        const float ep = __builtin_amdgcn_exp2f(Lr), em = __builtin_amdgcn_rcpf(ep);
                        const float icl = bf2f(ric_[j]), kx = bf2f(rkx_[j]), r = has_r ? bf2f(rr_[j]) : 0.f, kk = kx * kkw_l * (j < 4 ? inv0[j & 3] : inv1[j & 3]);
                        const float bb = kk * icl, kd = kx * (1.0f + (icl - 1.0f) * ka_l);
                        const f32x2 ar = (f32x2){kk, r} * (f32x2){ep_prev, ep}, bk = (f32x2){bb, kd} * em, tb = (f32x2){bk[1], bk[0]} * (f32x2){gam, -gam};
                        const unsigned w1 = cvt_pk_bf16(ar[0], ar[1]), w2 = cvt_pk_bf16(bk[0], bk[1]);
                        *(LAS unsigned short*)(os + OS_A + m * RS + 2 * ch) = (unsigned short)(w1 & 0xffffu);
                        *(LAS unsigned short*)(os + OS_R + m * RS + 2 * ch) = (unsigned short)(w1 >> 16);
                        *(LAS unsigned short*)(og + OG_B + m * RS + 2 * ch) = (unsigned short)(w2 & 0xffffu);
                        *(LAS unsigned short*)(og + OG_K + m * RS + 2 * ch) = (unsigned short)(w2 >> 16);
                        kt[j] = tb[0]; bt[j] = tb[1]; ep_prev = ep; }
#pragma unroll
                    for (int g = 0; g < 2; ++g) { u32x2 w; w.x = cvt_pk_bf16(kt[4 * g], kt[4 * g + 1]); w.y = cvt_pk_bf16(kt[4 * g + 2], kt[4 * g + 3]);
                        *(LAS u32x2*)(os + OS_KT + ch * TS + 2 * (8 * rg + 4 * g)) = w;
                        w.x = cvt_pk_bf16(bt[4 * g], bt[4 * g + 1]); w.y = cvt_pk_bf16(bt[4 * g + 2], bt[4 * g + 3]);
                        *(LAS u32x2*)(os + OS_BT + ch * TS + 2 * (8 * rg + 4 * g)) = w; }
                }
                __builtin_amdgcn_s_setprio(0);
            } else if (wave == 7) {
                const int c5 = it + 5;
                if (c5 < CNCH) SCAN_DMA(c5);
                if (cp < CNCH) { const LAS unsigned char* raw = lds + L_RAW + (cp & (NRAW - 1)) * RAW_BYTES; LAS unsigned char* os = lds + L_OS + (cp & 1) * OS_BYTES;
                    unsigned short rv[8];
#pragma unroll
                    for (int j = 0; j < 8; ++j) rv[j] = *(const LAS unsigned short*)(raw + RAW_V + (8 * (lane >> 4) + j) * 32 + 2 * (lane & 15));
                    u32x4 w; w.x = (unsigned)rv[0] | ((unsigned)rv[1] << 16); w.y = (unsigned)rv[2] | ((unsigned)rv[3] << 16); w.z = (unsigned)rv[4] | ((unsigned)rv[5] << 16); w.w = (unsigned)rv[6] | ((unsigned)rv[7] << 16);
                    *(LAS u32x4*)(os + OS_VT + (lane & 15) * TS + 16 * (lane >> 4)) = w; }
                if (cg >= 0 && cg < CNCH) {
                    f32x16 c = gram32(lds + L_OG + (cg & 1) * OG_BYTES + OG_B, lds + L_OS + (cg & 1) * OS_BYTES + OS_R, lane);
#pragma unroll
                    for (int p = 0; p < 16; ++p) c[p] = acc_row(p, lane) <= (lane & 31) ? -c[p] : 0.f;
                    st_acc32_t(lds + L_GM + (cg & 1) * GM_BYTES + GM_BR, c, lane);
                }
                { const int n1_ = (it + 4 >= 0 && it + 4 < CNCH) ? ((it + 4 >= CT / CK) ? 18 : 14) : 0, n2_ = (c5 < CNCH) ? ((c5 >= CT / CK) ? 18 : 14) : 0;
                  switch (n1_ + n2_) { case 36: asm volatile("s_waitcnt vmcnt(36)" ::: "memory"); break; case 32: asm volatile("s_waitcnt vmcnt(32)" ::: "memory"); break; case 28: asm volatile("s_waitcnt vmcnt(28)" ::: "memory"); break;
                      case 18: asm volatile("s_waitcnt vmcnt(18)" ::: "memory"); break; case 14: asm volatile("s_waitcnt vmcnt(14)" ::: "memory"); break; default: asm volatile("s_waitcnt vmcnt(0)" ::: "memory"); break; } }
            } else if (wave == 2) {
                if (cg >= 0 && cg < CNCH) {
                    const LAS unsigned char* os = lds + L_OS + (cg & 1) * OS_BYTES; const LAS unsigned char* og = lds + L_OG + (cg & 1) * OG_BYTES; LAS unsigned char* gm = lds + L_GM + (cg & 1) * GM_BYTES;
                    bf16x8 fk[4], fa[4], fr[4]; const int fo = (lane & 31) * RS + 16 * (lane >> 5);
#pragma unroll
                    for (int s4 = 0; s4 < 4; ++s4) { fk[s4] = *(const LAS bf16x8*)(og + OG_K + fo + 32 * s4); fa[s4] = *(const LAS bf16x8*)(os + OS_A + fo + 32 * s4); fr[s4] = *(const LAS bf16x8*)(os + OS_R + fo + 32 * s4); }
                    f32x16 c0, c1;
#pragma unroll
                    for (int p = 0; p < 16; ++p) { c0[p] = 0.f; c1[p] = 0.f; }
#pragma unroll
                    for (int s4 = 0; s4 < 4; ++s4) { c0 = __builtin_amdgcn_mfma_f32_32x32x16_bf16(fk[s4], fa[s4], c0, 0, 0, 0); c1 = __builtin_amdgcn_mfma_f32_32x32x16_bf16(fk[s4], fr[s4], c1, 0, 0, 0); }
#pragma unroll
                    for (int p = 0; p < 16; ++p) c0[p] = acc_row(p, lane) < (lane & 31) ? c0[p] : 0.f;
                    st_acc32_t(gm + GM_KA, c0, lane);
#pragma unroll
                    for (int p = 0; p < 16; ++p) c1[p] = acc_row(p, lane) <= (lane & 31) ? c1[p] : 0.f;
                    st_acc32_t(gm + GM_KR, c1, lane);
                }
            } else if (wave == 1) {
                if (cg >= 0 && cg < CNCH) {
                    const LAS unsigned char* os = lds + L_OS + (cg & 1) * OS_BYTES; const LAS unsigned char* og = lds + L_OG + (cg & 1) * OG_BYTES; LAS unsigned char* gm = lds + L_GM + (cg & 1) * GM_BYTES;
                    const int c16 = lane & 15, q = lane >> 4;
                    typedef short s4 __attribute__((ext_vector_type(4)));
#define P4(v) __builtin_bit_cast(s4, (u32x2){cvt_pk_bf16((v)[0], (v)[1]), cvt_pk_bf16((v)[2], (v)[3])})
#define MM16(a, b, c) __builtin_amdgcn_mfma_f32_16x16x16bf16_1k((a), (b), (c), 0, 0, 0)
#define GRAM16(P, p0, Q, q0, out) do { f32x4 c_ = {0.f, 0.f, 0.f, 0.f}; _Pragma("unroll") for (int s_ = 0; s_ < 2; ++s_) \
                        c_ = __builtin_amdgcn_mfma_f32_16x16x32_bf16(*(const LAS bf16x8*)((P) + ((p0) + c16) * RS + 64 * s_ + 16 * q), *(const LAS bf16x8*)((Q) + ((q0) + c16) * RS + 64 * s_ + 16 * q), c_, 0, 0, 0); (out) = c_; } while (0)
                    const LAS unsigned char* PA = os + OS_A; const LAS unsigned char* PB = og + OG_B;
                    f32x4 X1, Xt1, X2, Xt2, L21t, R1, R2, Rt2; const f32x4 z4 = {0.f, 0.f, 0.f, 0.f};
                    GRAM16(PA, 0, PB, 0, X1); GRAM16(PB, 0, PA, 0, Xt1); GRAM16(PA, 16, PB, 16, X2); GRAM16(PB, 16, PA, 16, Xt2); GRAM16(PB, 0, PA, 16, L21t);
#pragma unroll
                    for (int j = 0; j < 4; ++j) { const int row = 4 * q + j; const float dg = (row == c16) ? 1.f : 0.f;
                        X1[j] = c16 < row ? -X1[j] : 0.f; X2[j] = c16 < row ? -X2[j] : 0.f; Xt1[j] = row < c16 ? -Xt1[j] : 0.f; Xt2[j] = row < c16 ? -Xt2[j] : 0.f;
                        R1[j] = X1[j] + dg; R2[j] = X2[j] + dg; Rt2[j] = Xt2[j] + dg; }
#pragma unroll
                    for (int lev = 0; lev < 4; ++lev) {
                        const s4 fx1 = P4(X1), fxt1 = P4(Xt1), fx2 = P4(X2), fxt2 = P4(Xt2);
                        if (lev >= 1) { R1 = MM16(fxt1, P4(R1), R1); R2 = MM16(fxt2, P4(R2), R2); Rt2 = MM16(fx2, P4(Rt2), Rt2); }
                        if (lev < 3) { const f32x4 n1 = MM16(fxt1, fx1, z4), nt1 = MM16(fx1, fxt1, z4), n2 = MM16(fxt2, fx2, z4), nt2 = MM16(fx2, fxt2, z4); X1 = n1; Xt1 = nt1; X2 = n2; Xt2 = nt2; }
                    }
                    const f32x4 W = MM16(P4(L21t), P4(R1), z4);
                    f32x4 T21 = MM16(P4(Rt2), P4(W), z4);
#pragma unroll
                    for (int j = 0; j < 4; ++j) { const int row = 4 * q + j;
                        *(LAS unsigned short*)(gm + GM_TT + row * TS + 2 * c16) = f2bf(R1[j]); *(LAS unsigned short*)(gm + GM_TT + row * TS + 2 * (16 + c16)) = (unsigned short)0;
                        *(LAS unsigned short*)(gm + GM_TT + (16 + row) * TS + 2 * c16) = f2bf(-T21[j]); *(LAS unsigned short*)(gm + GM_TT + (16 + row) * TS + 2 * (16 + c16)) = f2bf(R2[j]); }
#undef P4
#undef MM16
#undef GRAM16
                }
            }
            if (SCAN_TSEL >= 0) { tbusy += clock64() - t0_; }
            SCAN_BAR();
        }
        else {
#define PACK8(v0, v1) __builtin_bit_cast(bf16x8, (u32x4){cvt_pk_bf16((v0)[0], (v0)[1]), cvt_pk_bf16((v0)[2], (v0)[3]), cvt_pk_bf16((v1)[0], (v1)[1]), cvt_pk_bf16((v1)[2], (v1)[3])})
#define LD2(p) ld2x8((p), (p) + 32)
#define MF32(afrag, bfrag, c) __builtin_amdgcn_mfma_f32_16x16x32_bf16((afrag), (bfrag), (c), 0, 0, 0)
            const int r16 = lane & 15, q = lane >> 4;
            const unsigned y_v = (unsigned)((d ? 3 - q : q) * 4 * (D * 2) + r16 * 2);
            bf16x8 sV = {0, 0, 0, 0, 0, 0, 0, 0}, sA[2][2], sKT[4], sBT[4], sR[2][2]; f32x4 sG[4];
#pragma unroll
            for (int t = 0; t < 4; ++t) { sKT[t] = sV; sBT[t] = sV; sG[t] = (f32x4){0.f, 0.f, 0.f, 0.f}; }
#pragma unroll
            for (int ti = 0; ti < 2; ++ti) { sA[ti][0] = sV; sA[ti][1] = sV; sR[ti][0] = sV; sR[ti][1] = sV; }
            for (int it = -2; it < CNCH; ++it) {
                const int cs = it;
                long long t0_ = 0; if (SCAN_TSEL >= 0) t0_ = clock64();
                if (cs >= 0) {
                    const LAS unsigned char* gm = lds + L_GM + (cs & 1) * GM_BYTES; const bool emit = cs >= CT / CK;
                    const int n0s = scan_token(cs * CK, d, b);
                    bf16x8 aKA[2], aTT[2];
#pragma unroll
                    for (int ti = 0; ti < 2; ++ti) { const int i = 16 * ti + r16; aKA[ti] = *(const LAS bf16x8*)(gm + GM_KA + i * TS + 16 * q); aTT[ti] = LD2(gm + GM_TT + i * TS + 8 * q); }
                    const bf16x8 xb01 = PACK8(Xa[0], Xa[1]), xb23 = PACK8(Xa[2], Xa[3]);
                    f32x4 h[2];
#pragma unroll
                    for (int ti = 0; ti < 2; ++ti) { f32x4 c = {0.f, 0.f, 0.f, 0.f}; c = MF32(sA[ti][0], xb01, c); c = MF32(sA[ti][1], xb23, c); h[ti] = MF32(aKA[ti], sV, c); }
                    const bf16x8 hb = PACK8(h[0], h[1]);
                    f32x4 u[2];
#pragma unroll
                    for (int ti = 0; ti < 2; ++ti) { const f32x4 z = {0.f, 0.f, 0.f, 0.f}; u[ti] = MF32(aTT[ti], hb, z); }
                    const bf16x8 ub = PACK8(u[0], u[1]);
                    f32x4 Xn[4];
#pragma unroll
                    for (int t = 0; t < 4; ++t) { f32x4 c = Xa[t] * sG[t]; c = MF32(sKT[t], sV, c); Xn[t] = MF32(sBT[t], ub, c); }
                    if (emit) {
#pragma unroll
                        for (int ti = 0; ti < 2; ++ti) { const int i = 16 * ti + r16; f32x4 c = {0.f, 0.f, 0.f, 0.f};
                            c = MF32(sR[ti][0], xb01, c); c = MF32(sR[ti][1], xb23, c);
                            c = MF32(*(const LAS bf16x8*)(gm + GM_KR + i * TS + 16 * q), sV, c); c = MF32(LD2(gm + GM_BR + i * TS + 8 * q), ub, c);
#pragma unroll
                            for (int j = 0; j < 4; ++j) { const unsigned so = (unsigned)(d ? n0s - 16 * ti - j - 12 : n0s + 16 * ti + j) * (unsigned)(D * 2) + (unsigned)((hd * 64 + rq * 16) * 2) + (unsigned)(WS_YD + (size_t)d * NL * D * 2);
                                __builtin_amdgcn_raw_buffer_store_b16(f2bf(c[j]), rsrc, (int)y_v, (int)so, 0); } }
                    }
#pragma unroll
                    for (int t = 0; t < 4; ++t) Xa[t] = Xn[t];
                }
                if (cs + 1 >= 0 && cs + 1 < CNCH) {
                    const LAS unsigned char* os = lds + L_OS + ((cs + 1) & 1) * OS_BYTES;
                    sV = *(const LAS bf16x8*)(os + OS_VT + r16 * TS + 16 * q);
#pragma unroll
                    for (int ti = 0; ti < 2; ++ti) { const int i = 16 * ti + r16; sA[ti][0] = LD2(os + OS_A + i * RS + 8 * q); sA[ti][1] = LD2(os + OS_A + i * RS + 64 + 8 * q); }
#pragma unroll
                    for (int t = 0; t < 4; ++t) { const int k = 16 * t + r16; sG[t] = *(const LAS f32x4*)(os + OS_GAM + 4 * (16 * t + 4 * q)); sKT[t] = *(const LAS bf16x8*)(os + OS_KT + k * TS + 16 * q); sBT[t] = LD2(os + OS_BT + k * TS + 8 * q); }
                    if (cs + 1 >= CT / CK) {
#pragma unroll
                        for (int ti = 0; ti < 2; ++ti) { const int i = 16 * ti + r16; sR[ti][0] = LD2(os + OS_R + i * RS + 8 * q); sR[ti][1] = LD2(os + OS_R + i * RS + 64 + 8 * q); }
                    }
                }
                if (SCAN_TSEL >= 0) { tbusy += clock64() - t0_; }
                SCAN_BAR();
            }
#undef PACK8
#undef LD2
#undef MF32
        }
        if (SCAN_TSEL >= 0 && SCAN_TSEL < 8 && F.vcu == 0 && lane == 0 && wave == (SCAN_TSEL & 7)) *(long long*)(F.ws + WS_CTL + 49152) = tbusy;
        if (SCAN_TSEL == 8 && F.vcu == 0 && lane == 0 && wave == 0) *(long long*)(F.ws + WS_CTL + 49152) = (clock64() - tloop0_) / 2;
#undef SCAN_DMA
#undef SCAN_BAR
    }
}
__device__ __forceinline__ void phase_readout(const Frame& F, const Args& A) {
    const int gw = blockIdx.x * NWAVES + F.wave, NGW = F.G * NWAVES; const int c0 = 16 * F.lane;
    float lng[16], lnb[16], rk[16], kaw[16]; ld16f(A.in[I_LNG] + c0, lng); ld16f(A.in[I_LNB] + c0, lnb); ld16f(A.in[I_RK] + c0, rk); ld16f(A.in[I_KA] + c0, kaw);
    for (int n = gw; n < NL; n += NGW) { const size_t off = (size_t)n * D + c0; float y[16], t[16], r[16], kd[16], v[16], g[16], o[16];
        ld16bf((const bf16_t*)(F.ws + WS_YD) + off, y); ld16bf((const bf16_t*)(F.ws + WS_YD + (size_t)NL * D * 2) + off, t);
        float s = 0.f;
#pragma unroll
        for (int j = 0; j < 16; ++j) { y[j] += t[j]; s += y[j]; }
        s = dpp_xadd(s, 0); s = dpp_xadd(s, 1); const float m = s * (1.0f / 64.0f); float q = 0.f;
#pragma unroll
        for (int j = 0; j < 16; ++j) { y[j] -= m; q += y[j] * y[j]; }
        q = dpp_xadd(q, 0); q = dpp_xadd(q, 1); const float rs = 1.0f / sqrtf(q * (1.0f / 64.0f) + GN_EPS);
        ld16bf((const bf16_t*)(F.ws + WS_RKV) + off, r); ld16bf((const bf16_t*)(F.ws + WS_ICL) + off, kd); ld16bf((const bf16_t*)(F.ws + WS_ICL + ACTB) + off, t); ld16bf((const bf16_t*)(F.ws + WS_RKV + ACTB) + off, v);
        float bs = 0.f;
#pragma unroll
        for (int j = 0; j < 16; ++j) bs += r[j] * (v[j] * (2.0f + (kd[j] + t[j] - 2.0f) * kaw[j])) * rk[j];
        bs = dpp_xadd(bs, 0); bs = dpp_xadd(bs, 1);
        ld16bf((const bf16_t*)(F.ws + WS_RKV + 2 * ACTB) + off, v); ld16bf((const bf16_t*)(F.ws + WS_G) + off, g);
#pragma unroll
        for (int j = 0; j < 16; ++j) o[j] = (y[j] * rs * lng[j] + lnb[j] + bs * v[j]) * g[j];
        { u32x4 w; w.x = pk4_fp8(o[0], o[1], o[2], o[3]); w.y = pk4_fp8(o[4], o[5], o[6], o[7]); w.z = pk4_fp8(o[8], o[9], o[10], o[11]); w.w = pk4_fp8(o[12], o[13], o[14], o[15]);
          *(GAS u32x4*)(F.ws + WS_RO + off) = w; }
    }
}
struct SchedWo {
    static constexpr bool SIDE = false; static constexpr bool XSYNC = false; static constexpr bool GATHER = false;
    int G, vcu; int nt; unsigned ldb;
    __device__ __forceinline__ bool next(int i, GU& u) const { const int L = i * G + vcu; if (L >= 512) return false; const int pm = L >> 2, pn = L & 3;
        u.a = (unsigned)(WS_RO + (size_t)pm * 256 * D); u.b = (unsigned)(WS_WO + (size_t)pn * 256 * 1024); u.i0 = pm; u.i1 = pn; u.i2 = 0; u.i3 = 0; return true; }
    __device__ __forceinline__ void aoff(const GU&, const int (&R)[2], const int (&C)[2], unsigned (&v)[2][2]) const {
#pragma unroll
        for (int h = 0; h < 2; ++h)
#pragma unroll
            for (int i = 0; i < 2; ++i) v[h][i] = (unsigned)((h * 128 + R[i]) * D + 2 * C[i]); }
};
struct EpiWo {
    static constexpr bool FP8 = true; static constexpr bool PERM = true;
    const bf16_t* xin; bf16_t* xout; const float* gate_base;
    __device__ __forceinline__ void operator()(const f32x4 (&acc)[2][2][4][2], const GU& u, int wr, int wc, int fr, int fq, const LAS float* sb) const {
        const int pm = u.i0, pn = u.i1; const float* gate = gate_base + (size_t)(pm >> 6) * NMOD * D; const int col0 = pn * 256 + wc * 32 + 8 * fq;
        f32x4 gl[2][2];
#pragma unroll
        for (int bj = 0; bj < 2; ++bj)
#pragma unroll
            for (int n = 0; n < 2; ++n) gl[bj][n] = *(const GAS f32x4*)(gate + col0 + bj * 128 + n * 4);
#pragma unroll
        for (int ai = 0; ai < 2; ++ai)
#pragma unroll
            for (int m = 0; m < 4; ++m) { const size_t off = ((size_t)pm * 256 + ai * 128 + wr * 64 + m * 16 + fr) * D + col0;
#pragma unroll
                for (int bj = 0; bj < 2; ++bj) { const u32x4 xi = *(const GAS u32x4*)(xin + off + bj * 128);
                    const f32x4 v0 = (f32x4){bf_lo(xi.x), bf_hi(xi.x), bf_lo(xi.y), bf_hi(xi.y)} + gl[bj][0] * acc[ai][bj][m][0], v1 = (f32x4){bf_lo(xi.z), bf_hi(xi.z), bf_lo(xi.w), bf_hi(xi.w)} + gl[bj][1] * acc[ai][bj][m][1];
                    u32x4 w; w.x = cvt_pk_bf16(v0[0], v0[1]); w.y = cvt_pk_bf16(v0[2], v0[3]); w.z = cvt_pk_bf16(v1[0], v1[1]); w.w = cvt_pk_bf16(v1[2], v1[3]);
                    *(GAS u32x4*)(xout + off + bj * 128) = w; } }
    }
};

constexpr int NPHASES = 3;
__global__ void __launch_bounds__(NTHREADS, 2) fwd_kernel(Args args) {
    extern __shared__ __attribute__((aligned(16))) unsigned char lds_raw[];
    Frame F;
    F.lds = (LAS unsigned char*)lds_raw; F.scr = F.lds + SCR_OFF; F.ws = args.ws;
    F.tid = threadIdx.x; F.lane = F.tid & 63; F.wave = __builtin_amdgcn_readfirstlane(F.tid >> 6);
    F.G = gridDim.x; { const int bx = blockIdx.x; F.vcu = (F.G % 8 == 0) ? (bx % 8) * (F.G / 8) + bx / 8 : bx; }
    volatile LAS unsigned* MISC = (volatile LAS unsigned*)(F.lds + MISC_OFF);
    if (F.tid < 64) MISC[F.tid] = 0u;
    __syncthreads();
    const int lo = args.ph_lo, hi = args.ph_hi;
    XcdBarrier bar; bar.bar = (unsigned*)(F.ws + WS_CTL); bar.x = 0; bar.st = MISC + 8;
    if (hi - lo > 1) {
        unsigned* barw = (unsigned*)(F.ws + WS_CTL);
        bar.bar = barw; bar.x = xb_xcc_id(); bar.st = MISC + 8;
        if (F.tid == 0) {
            const unsigned rank = xb_add(&barw[XB_XCNT(bar.x)], 1u);
            unsigned nloc, nx; xcd_barrier_complete(barw, bar.x, nloc, nx); MISC[8] = nloc; MISC[9] = nx;
            unsigned pre = 0;
            for (unsigned j = 0; j < 16; ++j) { const unsigned c = xb_ld(&barw[XB_XCNT(j)]); if (j < bar.x) pre += c; }
            MISC[10] = pre + rank;
        }
        __syncthreads();
        F.vcu = (int)MISC[10];
    }
#define IN(k) (lo <= (k) && (k) < hi)
#define SEAM(k) do { if (IN(k) && IN((k) + 1)) xcd_barrier(bar); } while (0)
#define PH(k, ...) do { if (IN(k)) { __VA_ARGS__; if constexpr (((REPEAT_MASK >> (k)) & 1) != 0) { xcd_barrier(bar); __VA_ARGS__; } } SEAM(k); } while (0)
    PH(0, phase_prep(F, args));
    PH(1, phase_pre0(F, args));
    PH(2, { SchedPool S{F.G, F.vcu, 4, 512u};
            EpiPool E{args.in[I_X], args.in[I_CTX], args.in[I_POOLLS], modp(F, 0, 0, 2), (bf16_t*)(F.ws + WS_XS0)};
            pg8::gemm_phase<EpiPool, SchedPool>(F.scr, F.ws, S, E); });
    PH(3, phase_post(F, args, 0, (const bf16_t*)(F.ws + WS_XS0), NTOK));
    PH(4, phase_moe1(F, args, 0));
    PH(5, phase_moe2(F, args, 0));
    PH(6, phase_pre1(F, args));
    PH(7, { SchedProj S{F.G, F.vcu, 8, 1024u}; EpiProj E{F.ws}; pg8::gemm_phase<EpiProj, SchedProj>(F.scr, F.ws, S, E); });
    PH(8, { SchedLora2 S{F.G, F.vcu, 2, 256u}; EpiLora2 E{F.ws, args.in[I_W0], args.in[I_A0]}; pg8::gemm_phase<EpiLora2, SchedLora2>(F.scr, F.ws, S, E); phase_fin(F, args); });
    PH(10, phase_scan(F, args));
    PH(11, phase_readout(F, args));
    PH(12, { SchedWo S{F.G, F.vcu, 8, 1024u}; EpiWo E{(const bf16_t*)(F.ws + WS_XS1), (bf16_t*)(F.ws + WS_XS0), modp(F, 1, 0, 2)}; pg8::gemm_phase<EpiWo, SchedWo>(F.scr, F.ws, S, E); });
    PH(13, phase_post(F, args, 1, (const bf16_t*)(F.ws + WS_XS0), NL));
    PH(14, phase_moe1(F, args, 1));
    PH(15, phase_moe2(F, args, 1));
    PH(16, phase_final(F, args, 1, (const bf16_t*)(F.ws + WS_XS0)));
#undef PH
#undef SEAM
#undef IN
}

extern "C" void kernel_launch(void* const* d_in, const int* in_sizes, int n_in, void* d_out, int out_size, void* d_ws, size_t ws_size, hipStream_t stream) {
    static int grid = 0;
    if (grid == 0) {
        if (n_in != 32 || ws_size < WS_END) { fprintf(stderr, "kernel_launch: unexpected n_in %d / ws %zu (need %zu)\n", n_in, ws_size, (size_t)WS_END); grid = -1; return; }
        int dev = 0, cus = 0;
        if (hipGetDevice(&dev) != hipSuccess || hipDeviceGetAttribute(&cus, hipDeviceAttributeMultiprocessorCount, dev) != hipSuccess) { grid = -1; return; }
        if (hipFuncSetAttribute((const void*)fwd_kernel, hipFuncAttributeMaxDynamicSharedMemorySize, LDS_BYTES) != hipSuccess) { fprintf(stderr, "kernel_launch: hipFuncSetAttribute failed\n"); grid = -1; return; }
        (void)hipGetLastError();
        grid = cus;
    }
    if (grid < 0) return;
    (void)hipMemsetAsync((char*)d_ws + WS_CTL, 0, CTL_BYTES, stream);
    Args a{};
    for (int i = 0; i < 32; ++i) a.in[i] = (const float*)d_in[i];
    a.out = (float*)d_out; a.ws = (unsigned char*)d_ws;
    const int last = 16;
#if N_LAUNCH_MODE == 1
    a.ph_lo = 0; a.ph_hi = last + 1;
    hipLaunchKernelGGL(fwd_kernel, dim3(grid), dim3(NTHREADS), LDS_BYTES, stream, a);
#else
    for (int p = 0; p <= last; ++p) { a.ph_lo = p; a.ph_hi = p + 1; hipLaunchKernelGGL(fwd_kernel, dim3(grid), dim3(NTHREADS), LDS_BYTES, stream, a); }
#endif
}
```

```cpp
#include <hip/hip_runtime.h>
#include <cstdio>
#include <cstdint>

#define LAS __attribute__((address_space(3)))
#define GAS __attribute__((address_space(1)))
typedef unsigned short bf16_t;
typedef short bf16x8 __attribute__((ext_vector_type(8)));
typedef float f32x4 __attribute__((ext_vector_type(4)));
typedef float f32x2 __attribute__((ext_vector_type(2)));
typedef float f32x16 __attribute__((ext_vector_type(16)));
typedef unsigned u32x4 __attribute__((ext_vector_type(4)));
typedef unsigned u32x2 __attribute__((ext_vector_type(2)));

#ifndef N_LAUNCH_MODE
#define N_LAUNCH_MODE 1
#endif
#ifndef SCAN_TSEL
#define SCAN_TSEL -1
#endif
#ifndef REPEAT_MASK
#define REPEAT_MASK 0
#endif

constexpr int D = 1024, NB = 2, TSEQ = 16384, CT = 256, NL = NB * TSEQ, NC = NB * CT, NTOK = NL + NC;
constexpr int NE = 32, TOPK = 4, NMOD = 6;
constexpr int NWAVES = 8, NTHREADS = 512;
constexpr int MAXSLOT = ((NTOK * TOPK + 255) / 256 + NE) * 256;
constexpr float NORM_EPS = 1e-6f, GN_EPS = 64e-5f;

constexpr size_t AL(size_t x) { return (x + 255) & ~(size_t)255; }
constexpr size_t WS_CTL = 0, CTL_BYTES = 65536;
constexpr size_t CTL_XSYNC = 32768;
constexpr size_t CTL_CNT = 16384;
constexpr size_t WS_MOD = WS_CTL + CTL_BYTES;
constexpr size_t WS_LIST = AL(WS_MOD + 2 * 3 * 6144 * 4);
constexpr size_t WS_TINFO = AL(WS_LIST + (size_t)2 * NE * NTOK * 4);
constexpr size_t WS_TGATE = AL(WS_TINFO + (size_t)2 * NTOK * 4 * 4);
constexpr size_t WS_WGU = AL(WS_TGATE + (size_t)2 * NTOK * 4 * 4);
constexpr size_t WS_WDN = AL(WS_WGU + (size_t)2 * NE * 2048 * 1024 * 2);
constexpr size_t WS_WRKV = AL(WS_WDN + (size_t)2 * NE * 1024 * 1024 * 2);
constexpr size_t WS_WO = AL(WS_WRKV + (size_t)3 * 1024 * 1024 * 2);
constexpr size_t WS_WL1 = AL(WS_WO + (size_t)1024 * 1024 * 2);
constexpr size_t WS_WL2 = AL(WS_WL1 + (size_t)3 * 256 * 1024 * 2);
constexpr size_t WS_WPOOL = AL(WS_WL2 + (size_t)5 * 1024 * 128 * 2);
constexpr size_t WS_XS0 = AL(WS_WPOOL + (size_t)4 * 256 * 256 * 2);
constexpr size_t WS_XS1 = AL(WS_XS0 + (size_t)NTOK * D * 4);
constexpr size_t WS_T = AL(WS_XS1 + (size_t)NTOK * D * 4);
constexpr size_t ACTB = (size_t)NTOK * D * 2;
constexpr size_t TA = WS_T;
constexpr size_t TA_BYTES = (size_t)432 << 20;
constexpr size_t WS_DBUF = TA, WS_H2 = TA + ACTB, WS_ACT = TA + 2 * ACTB;
constexpr size_t WS_MIX = TA;
constexpr size_t WS_KDIR = TA, WS_BV = TA + 2 * ACTB, WS_KK = TA + 4 * ACTB;
constexpr size_t TB = TA + TA_BYTES;
constexpr size_t TB_BYTES = (size_t)290 << 20;
constexpr size_t WS_Y2 = TB, WS_RKV = TB;
constexpr size_t TC = TB + TB_BYTES;
constexpr size_t WS_DEC = TC, WS_RO = TC;
constexpr size_t TD = AL(TC + (size_t)2 * NTOK * D * 4);
constexpr size_t WS_ICL = TD, WS_YD = TA;
constexpr size_t TE = AL(TD + 2 * ACTB);
constexpr size_t WS_G = TE;
constexpr size_t TF = AL(TE + ACTB);
constexpr size_t WS_LACT = TF;
constexpr size_t WS_END = AL(TF + (size_t)3 * NTOK * 128 * 2);
static_assert(WS_ACT + (size_t)MAXSLOT * D * 2 <= TA + TA_BYTES, "ACT overflows TA");
static_assert((size_t)MAXSLOT * D * 2 <= TB_BYTES, "Y2 overflows TB");
static_assert(WS_END <= ((size_t)2048 << 20), "workspace too large");

constexpr int MISC_OFF = 0, SCR_OFF = 1024, SCR_BYTES = 162816, LDS_BYTES = SCR_OFF + SCR_BYTES;

typedef __bf16 bf16x2_t __attribute__((ext_vector_type(2)));
__device__ __forceinline__ unsigned cvt_pk_bf16(float lo, float hi) { const f32x2 v = {lo, hi}; return __builtin_bit_cast(unsigned, __builtin_convertvector(v, bf16x2_t)); }
__device__ __forceinline__ void stx4(bf16_t* p, f32x4 v) { u32x2 w; w.x = cvt_pk_bf16(v[0], v[1]); w.y = cvt_pk_bf16(v[2], v[3]); *(GAS u32x2*)p = w; }
__device__ __forceinline__ float bf_lo(unsigned w) { return __uint_as_float(w << 16); }
__device__ __forceinline__ float bf_hi(unsigned w) { return __uint_as_float(w & 0xffff0000u); }
__device__ __forceinline__ float bf2f(bf16_t b) { return __uint_as_float(((unsigned)b) << 16); }
__device__ __forceinline__ f32x4 ldx4(const bf16_t* p) { const u32x2 w = *(const GAS u32x2*)p; return (f32x4){bf_lo(w.x), bf_hi(w.x), bf_lo(w.y), bf_hi(w.y)}; }
__device__ __forceinline__ float dpp_xadd(float v, const int sel) {
    const int x = __builtin_bit_cast(int, v); int y;
    if (sel == 0) y = __builtin_amdgcn_update_dpp(0, x, 0xB1, 0xF, 0xF, true);
    else if (sel == 1) y = __builtin_amdgcn_update_dpp(0, x, 0x4E, 0xF, 0xF, true);
    else if (sel == 2) y = __builtin_amdgcn_update_dpp(0, x, 0x141, 0xF, 0xF, true);
    else y = __builtin_amdgcn_update_dpp(0, x, 0x140, 0xF, 0xF, true);
    return v + __builtin_bit_cast(float, y);
}
__device__ __forceinline__ float wave_sum(float v) {
    v = dpp_xadd(v, 0); v = dpp_xadd(v, 1); v = dpp_xadd(v, 2); v = dpp_xadd(v, 3);
    const int x = __builtin_bit_cast(int, v);
    const float s0 = __builtin_bit_cast(float, __builtin_amdgcn_readlane(x, 0)), s1 = __builtin_bit_cast(float, __builtin_amdgcn_readlane(x, 16)),
                s2 = __builtin_bit_cast(float, __builtin_amdgcn_readlane(x, 32)), s3 = __builtin_bit_cast(float, __builtin_amdgcn_readlane(x, 48));
    return (s0 + s1) + (s2 + s3);
}
__device__ __forceinline__ float sigmoidf_(float x) { return 1.0f / (1.0f + __expf(-x)); }
#define LDS_WAIT() asm volatile("s_waitcnt lgkmcnt(0)" ::: "memory")
#define VM_WAIT() asm volatile("s_waitcnt vmcnt(0)" ::: "memory")

#define XB_TMO      128
#define XB_XCNT(j)  (256  + 64 * (j))
#define XB_XSUB(j)  (1280 + 64 * (j))
#define XB_XGEN(j)  (2304 + 64 * (j))
#define XB_TOP      3328
#define XB_TOPGEN   3392
#define XCD_BAR_WORDS 3456
#define XB_SPIN_CAP (1u << 22)
__device__ __forceinline__ unsigned xb_ld(unsigned* p)              { return __hip_atomic_load(p, __ATOMIC_RELAXED, __HIP_MEMORY_SCOPE_AGENT); }
__device__ __forceinline__ unsigned xb_add(unsigned* p, unsigned v) { return __hip_atomic_fetch_add(p, v, __ATOMIC_RELAXED, __HIP_MEMORY_SCOPE_AGENT); }
__device__ __forceinline__ unsigned xb_xcc_id() { return (unsigned)__builtin_amdgcn_s_getreg((3 << 11) | 20) & 0xFu; }
#define XB_SPIN(cond, bar) do { unsigned _sp = 0; while (cond) { __builtin_amdgcn_s_sleep(1); \
    if ((++_sp & 255u) == 0u) { if (xb_ld(&(bar)[XB_TMO])) break; if (_sp > XB_SPIN_CAP) { atomicAdd(&(bar)[XB_TMO], 1u); break; } } } } while (0)
struct XcdBarrier { unsigned* bar; unsigned x; volatile LAS unsigned* st; };
__device__ __forceinline__ XcdBarrier xcd_barrier_post(unsigned* bar, volatile LAS unsigned* st) {
    XcdBarrier b; b.bar = bar; b.x = xb_xcc_id(); b.st = st;
    if (threadIdx.x == 0) (void)xb_add(&bar[XB_XCNT(b.x)], 1u);
    return b;
}
__device__ __forceinline__ void xcd_barrier_complete(unsigned* bar, unsigned x, unsigned& nloc, unsigned& nx) {
    const unsigned G = gridDim.x * gridDim.y * gridDim.z;
    unsigned sum, cnt, mine, sp = 0u;
    for (;;) {
        sum = 0u; cnt = 0u; mine = 0u;
#pragma unroll
        for (unsigned j = 0; j < 16; ++j) { const unsigned c = xb_ld(&bar[XB_XCNT(j)]); sum += c; cnt += (c > 0u) ? 1u : 0u; mine = (j == x) ? c : mine; }
        if (sum == G) break;
        __builtin_amdgcn_s_sleep(1);
        if ((++sp & 255u) == 0u) { if (xb_ld(&bar[XB_TMO])) break; if (sp > XB_SPIN_CAP) { atomicAdd(&bar[XB_TMO], 1u); break; } }
    }
    nloc = mine > 0u ? mine : 1u; nx = cnt > 0u ? cnt : 1u;
}
__device__ __forceinline__ void xcd_barrier(const XcdBarrier& b) {
    asm volatile("s_waitcnt vmcnt(0)" ::: "memory");
    __syncthreads();
    if (threadIdx.x == 0) {
        unsigned* bar = b.bar;
        __builtin_amdgcn_s_waitcnt(0);
        unsigned nloc = b.st[0], nx = b.st[1];
        if (nloc == 0u) { xcd_barrier_complete(bar, b.x, nloc, nx); b.st[0] = nloc; b.st[1] = nx; }
        const unsigned old = xb_add(&bar[XB_XSUB(b.x)], 1u);
        const unsigned gen = old / nloc;
        if (old + 1u == (gen + 1u) * nloc) {
            __builtin_amdgcn_fence(__ATOMIC_RELEASE, "agent");
            asm volatile("s_waitcnt vmcnt(0)" ::: "memory");
            const unsigned og = xb_add(&bar[XB_TOP], 1u);
            const unsigned tg = og / nx;
            if (og + 1u == (tg + 1u) * nx) xb_add(&bar[XB_TOPGEN], 1u);
            else XB_SPIN(xb_ld(&bar[XB_TOPGEN]) == tg, bar);
            __builtin_amdgcn_fence(__ATOMIC_ACQUIRE, "agent");
            xb_add(&bar[XB_XGEN(b.x)], 1u);
            asm volatile("s_waitcnt vmcnt(0)" ::: "memory");
        } else {
            XB_SPIN(xb_ld(&bar[XB_XGEN(b.x)]) == gen, bar);
            __builtin_amdgcn_fence(__ATOMIC_ACQUIRE, "agent");
            asm volatile("s_waitcnt vmcnt(0)" ::: "memory");
        }
    }
    __syncthreads();
}

namespace pg8 {
constexpr int BM = 256, BK = 64, HALF = 128, HTB = HALF * BK * 2, STAGE_BYTES = 8 * HTB;
__host__ __device__ __forceinline__ int lds_byte(int r, int c) { const int st = (r >> 4) * 2 + (c >> 5), rr = r & 15, cc = c & 31, ob = rr * 64 + cc * 2; return st * 1024 + (ob ^ (((ob >> 9) & 1) << 5)); }
__host__ __device__ __forceinline__ void stage_rc(int b, int& R, int& C) { const int st = b / 1024, sb = b % 1024, swz = sb ^ (((sb >> 9) & 1) << 5); R = (st >> 1) * 16 + swz / 64; C = (st & 1) * 32 + (swz % 64) / 2; }
__host__ __device__ __forceinline__ int perm32(int rho) { const int n = rho >> 4, i = rho & 15; return 8 * (i >> 2) + 4 * n + (i & 3); }

struct GU { unsigned a, b; int i0, i1, i2, i3; };
typedef int v8i __attribute__((ext_vector_type(8)));
typedef int v4i __attribute__((ext_vector_type(4)));
__device__ __forceinline__ bf16x8 half8(v8i v, int h) { const v4i a = h ? __builtin_shufflevector(v, v, 4, 5, 6, 7) : __builtin_shufflevector(v, v, 0, 1, 2, 3); return __builtin_bit_cast(bf16x8, a); }
__device__ __forceinline__ v8i cat8(bf16x8 lo, bf16x8 hi) { const v4i a = __builtin_bit_cast(v4i, lo), b = __builtin_bit_cast(v4i, hi); return __builtin_shufflevector(a, b, 0, 1, 2, 3, 4, 5, 6, 7); }

template <class Epi, class Sched>
__device__ __forceinline__ void gemm_phase(LAS unsigned char* lds, unsigned char* wsbase, const Sched& S, const Epi& E) {
    const int tid = threadIdx.x, wid = __builtin_amdgcn_readfirstlane(tid >> 6), lane = tid & 63, wr = wid >> 2, wc = wid & 3, fr = lane & 15, fq = lane >> 4;
    const int nt = S.nt;
    const __amdgpu_buffer_rsrc_t rsrc = __builtin_amdgcn_make_buffer_rsrc((void*)wsbase, 0, 0xffffffff, 0x00020000);
    constexpr int SIDE_OFF = STAGE_BYTES;
#define PG8_SIDE(u, buf) do { if constexpr (Sched::SIDE) { unsigned so_; const bool isb_ = S.side_src((u), tid, so_); (void)isb_; \
        if (wid < 4) __builtin_amdgcn_raw_ptr_buffer_load_lds(rsrc, (LAS void*)(lds + SIDE_OFF + (buf) * 2048 + wid * 256), 4, (int)so_, 0, 0, 0); \
        else __builtin_amdgcn_raw_ptr_buffer_load_lds(S.rsrcb, (LAS void*)(lds + SIDE_OFF + (buf) * 2048 + wid * 256), 4, (int)so_, 0, 0, 0); } } while (0)
    int Rr[2], Cc[2]; unsigned voffB[2];
#pragma unroll
    for (int i = 0; i < 2; ++i) { int R, C; stage_rc(tid * 16 + i * 8192, R, C); Rr[i] = R; Cc[i] = C; const int Rb = Epi::PERM ? ((R & ~31) + perm32(R & 31)) : R;
        voffB[i] = (unsigned)Rb * S.ldb + 2u * (unsigned)C; }
    const unsigned kstep = 128u;
    const unsigned hstepB = (unsigned)HALF * S.ldb;
    const unsigned ldsw = (unsigned)wid * 1024u;
    const int aoff = lds_byte(wr * 64 + fr, fq * 8), boff = lds_byte(wc * 32 + fr, fq * 8);
#define PG8_SA(b, h) (((b) * 2 + (h)) * HTB)
#define PG8_SB(b, h) ((4 + (b) * 2 + (h)) * HTB)
#define PG8_STAGE(bufoff, soff, voff) do { _Pragma("unroll") for (int _i = 0; _i < 2; ++_i) \
        __builtin_amdgcn_raw_ptr_buffer_load_lds(rsrc, (LAS void*)(lds + (bufoff) + ldsw + _i * 8192), 16, (int)(voff)[_i], (int)(soff), 0, 0); } while (0)
#define PG8_LDA(dst, b, h) do { _Pragma("unroll") for (int m = 0; m < 4; ++m) dst[m] = cat8(*(const LAS bf16x8*)(lds + PG8_SA(b, h) + aoff + m * 2048), *(const LAS bf16x8*)(lds + PG8_SA(b, h) + aoff + m * 2048 + 1024)); } while (0)
#define PG8_LDB(dst, b, h) do { _Pragma("unroll") for (int n = 0; n < 2; ++n) dst[n] = cat8(*(const LAS bf16x8*)(lds + PG8_SB(b, h) + boff + n * 2048), *(const LAS bf16x8*)(lds + PG8_SB(b, h) + boff + n * 2048 + 1024)); } while (0)
#define PG8_MMA(ai, bj, At, Bt) do { __builtin_amdgcn_s_setprio(1); _Pragma("unroll") for (int m = 0; m < 4; ++m) _Pragma("unroll") for (int n = 0; n < 2; ++n) { \
        if constexpr (Epi::FP8) { asm volatile("v_mfma_scale_f32_16x16x128_f8f6f4 %0, %1, %2, %0, %3, %4 op_sel_hi:[0,0,0]" : "+v"(acc[ai][bj][m][n]) : "v"(Bt[n]), "v"(At[m]), "v"(sc_w), "v"(sc_a)); } \
        else { acc[ai][bj][m][n] = __builtin_amdgcn_mfma_f32_16x16x32_bf16(half8(Bt[n], 0), half8(At[m], 0), acc[ai][bj][m][n], 0, 0, 0); \
               acc[ai][bj][m][n] = __builtin_amdgcn_mfma_f32_16x16x32_bf16(half8(Bt[n], 1), half8(At[m], 1), acc[ai][bj][m][n], 0, 0, 0); } } \
        __builtin_amdgcn_s_setprio(0); } while (0)
#define PG8_WAIT_V(n) asm volatile("s_waitcnt vmcnt(" #n ")" ::: "memory")
#define PG8_WAIT_L(n) asm volatile("s_waitcnt lgkmcnt(" #n ")" ::: "memory")
#define PG8_BAR __builtin_amdgcn_s_barrier()
#define PG8_SCHED __builtin_amdgcn_sched_barrier(0)
#define PG8_RC() do { _Pragma("unroll") for (int i = 0; i < 2; ++i) { int R, C; stage_rc((int)threadIdx.x * 16 + i * 8192, R, C); Rr[i] = R; Cc[i] = C; } } while (0)
    long long tk_ = 0, te_ = 0, tt0_ = 0; const bool tprobe_ = (SCAN_TSEL >= 10) && Sched::SIDE && Sched::GATHER;
    GU cur, nxt; int ui = 0;
    if (!S.next(0, cur)) { if constexpr (Sched::XSYNC) { if (tid == 0) (void)xb_add(S.xw, (unsigned)S.rounds); } return; }
    f32x4 acc[2][2][4][2];
#pragma unroll
    for (int a = 0; a < 2; ++a)
#pragma unroll
        for (int b = 0; b < 2; ++b)
#pragma unroll
            for (int m = 0; m < 4; ++m)
#pragma unroll
                for (int n = 0; n < 2; ++n) acc[a][b][m][n] = (f32x4){0.f, 0.f, 0.f, 0.f};
    v8i At[4], B0[2], B1[2];
    int sc_w = 0x7a7a7a7a, sc_a = 0x7f7f7f7f; asm volatile("" : "+v"(sc_w), "+v"(sc_a));
    unsigned vA[2][2], nvA[2][2];
    S.aoff(cur, Rr, Cc, vA);
    unsigned cA = __builtin_amdgcn_readfirstlane(cur.a), cB = __builtin_amdgcn_readfirstlane(cur.b);
    PG8_SIDE(cur, 0);
    PG8_STAGE(PG8_SB(0, 0), cB, voffB); PG8_STAGE(PG8_SB(0, 1), cB + hstepB, voffB); PG8_STAGE(PG8_SA(0, 0), cA, vA[0]); PG8_STAGE(PG8_SA(0, 1), cA, vA[1]);
    if (wr == 1) PG8_BAR;
    PG8_WAIT_V(2); PG8_BAR;
    PG8_STAGE(PG8_SB(1, 0), cB + kstep, voffB); PG8_STAGE(PG8_SA(1, 0), cA + kstep, vA[0]); PG8_STAGE(PG8_SB(1, 1), cB + hstepB + kstep, voffB);
    PG8_WAIT_V(6); PG8_BAR;
    for (;;) {
        if (tprobe_) tt0_ = clock64();
        const bool has_next = S.next(ui + 1, nxt);
        const unsigned nA = has_next ? __builtin_amdgcn_readfirstlane(nxt.a) : cA, nB = has_next ? __builtin_amdgcn_readfirstlane(nxt.b) : cB;
        if (has_next) PG8_SIDE(nxt, (ui + 1) & 1);
        if constexpr (Sched::GATHER && !Sched::SIDE) {
            if (has_next) { PG8_RC(); S.aoff(nxt, Rr, Cc, nvA); }
            else { nvA[0][0] = vA[0][0]; nvA[0][1] = vA[0][1]; nvA[1][0] = vA[1][0]; nvA[1][1] = vA[1][1]; }
        }
#pragma unroll 1
        for (int t = 0; t < nt; t += 2) {
            const bool last = (t == nt - 2);
            const unsigned a1 = cA + (unsigned)(t + 1) * kstep;
            const unsigned a2 = last ? nA : cA + (unsigned)(t + 2) * kstep, b2 = last ? nB : cB + (unsigned)(t + 2) * kstep;
            const unsigned a3 = a2 + kstep, b3 = b2 + kstep;
            if constexpr (Sched::GATHER && Sched::SIDE) {
                if (last) { if (has_next) { PG8_RC(); const LAS int* tk = (const LAS int*)(lds + SIDE_OFF + ((ui + 1) & 1) * 2048);
#pragma unroll
                        for (int h = 0; h < 2; ++h)
#pragma unroll
                            for (int i = 0; i < 2; ++i) nvA[h][i] = S.tok_off(tk[h * 128 + Rr[i]], Cc[i]); }
                    else { nvA[0][0] = vA[0][0]; nvA[0][1] = vA[0][1]; nvA[1][0] = vA[1][0]; nvA[1][1] = vA[1][1]; } }
            }
            unsigned w0[2], w1[2];
            if constexpr (Sched::GATHER) { w0[0] = last ? nvA[0][0] : vA[0][0]; w0[1] = last ? nvA[0][1] : vA[0][1]; w1[0] = last ? nvA[1][0] : vA[1][0]; w1[1] = last ? nvA[1][1] : vA[1][1]; }
            else { w0[0] = vA[0][0]; w0[1] = vA[0][1]; w1[0] = vA[1][0]; w1[1] = vA[1][1]; }
            PG8_LDB(B0, 0, 0); PG8_LDB(B1, 0, 1); PG8_SCHED; PG8_LDA(At, 0, 0); PG8_STAGE(PG8_SA(1, 1), a1, vA[1]);
            PG8_WAIT_V(8); PG8_WAIT_L(0); PG8_BAR; PG8_MMA(0, 0, At, B0); PG8_MMA(0, 1, At, B1); PG8_BAR; PG8_SCHED;
            PG8_LDA(At, 0, 1); PG8_STAGE(PG8_SB(0, 0), b2, voffB); PG8_STAGE(PG8_SB(0, 1), b2 + hstepB, voffB); PG8_STAGE(PG8_SA(0, 0), a2, w0);
            PG8_WAIT_V(8); PG8_WAIT_L(0); PG8_BAR; PG8_MMA(1, 0, At, B0); PG8_MMA(1, 1, At, B1); PG8_BAR; PG8_SCHED;
            PG8_LDB(B0, 1, 0); PG8_LDB(B1, 1, 1); PG8_SCHED; PG8_LDA(At, 1, 0); PG8_STAGE(PG8_SA(0, 1), a2, w1);
            PG8_WAIT_V(8); PG8_WAIT_L(0); PG8_BAR; PG8_MMA(0, 0, At, B0); PG8_MMA(0, 1, At, B1); PG8_BAR; PG8_SCHED;
            PG8_LDA(At, 1, 1); PG8_STAGE(PG8_SB(1, 0), b3, voffB); PG8_STAGE(PG8_SB(1, 1), b3 + hstepB, voffB); PG8_STAGE(PG8_SA(1, 0), a3, w0);
            PG8_WAIT_V(8); PG8_WAIT_L(0); PG8_BAR; PG8_MMA(1, 0, At, B0); PG8_MMA(1, 1, At, B1); PG8_BAR; PG8_SCHED;
        }
        if (tprobe_) { const long long n_ = clock64(); tk_ += n_ - tt0_; tt0_ = n_; }
        if (wr == 0) PG8_BAR;
        if constexpr (Epi::FP8) asm volatile("s_nop 15\n\ts_nop 7" ::: "memory");
        { int fr_ = fr, fq_ = fq; asm volatile("" : "+v"(fr_), "+v"(fq_)); E(acc, cur, wr, wc, fr_, fq_, (const LAS float*)(lds + SIDE_OFF + (ui & 1) * 2048 + 1024)); }
        if constexpr (Sched::XSYNC) {
            if (tid == 0) { (void)xb_add(S.xw, 1u); const unsigned tgt = (unsigned)(ui + 1) * S.nloc; unsigned sp = 0;
                while (xb_ld(S.xw) < tgt && ++sp < (1u << 16)) __builtin_amdgcn_s_sleep(1);
                if (!has_next && S.rounds > ui + 1) (void)xb_add(S.xw, (unsigned)(S.rounds - (ui + 1))); }
        }
        if constexpr (Sched::XSYNC || Sched::SIDE) PG8_BAR;
        if (tprobe_) { te_ += clock64() - tt0_; }
        if (!has_next) break;
#pragma unroll
        for (int a = 0; a < 2; ++a)
#pragma unroll
            for (int b = 0; b < 2; ++b)
#pragma unroll
                for (int m = 0; m < 4; ++m)
#pragma unroll
                    for (int n = 0; n < 2; ++n) acc[a][b][m][n] = (f32x4){0.f, 0.f, 0.f, 0.f};
        cur = nxt; cA = nA; cB = nB; ++ui;
        if constexpr (Sched::GATHER) { vA[0][0] = nvA[0][0]; vA[0][1] = nvA[0][1]; vA[1][0] = nvA[1][0]; vA[1][1] = nvA[1][1]; }
        if (wr == 1) PG8_BAR;
    }
    PG8_WAIT_V(0);
    PG8_BAR;
    if (tprobe_ && S.vcu == 0 && tid == 0) { const long long v_ = (SCAN_TSEL == 10) ? tk_ : (SCAN_TSEL == 11 ? 4 * te_ : tk_ + te_); __hip_atomic_fetch_add((unsigned long long*)(wsbase + WS_CTL + 49152), (unsigned long long)v_, __ATOMIC_RELAXED, __HIP_MEMORY_SCOPE_AGENT); }
#undef PG8_RC
#undef PG8_SIDE
#undef PG8_SA
#undef PG8_SB
#undef PG8_STAGE
#undef PG8_LDA
#undef PG8_LDB
#undef PG8_MMA
#undef PG8_WAIT_V
#undef PG8_WAIT_L
#undef PG8_BAR
#undef PG8_SCHED
}
}
using pg8::GU;

struct Args { const float* in[32]; float* out; unsigned char* ws; int ph_lo, ph_hi; };
struct Frame {
    LAS unsigned char* lds;
    LAS unsigned char* scr;
    unsigned char* ws;
    int tid, lane, wave, G, vcu;
};
enum { I_X = 0, I_C, I_CTX, I_CCTX, I_NORMG, I_ADAW, I_ADAB, I_POOLW, I_POOLLS, I_MU, I_WRKV, I_W0, I_W1, I_W2, I_A0, I_A1, I_A2, I_G1, I_G2, I_KK, I_KA, I_RK, I_LNG, I_LNB, I_WO,
       I_RW, I_RB, I_WGU, I_BGU, I_WDN, I_BDN, I_FINALG };

__device__ __forceinline__ const float* modp(const Frame& F, int layer, int row, int k) { return (const float*)(F.ws + WS_MOD) + ((size_t)(layer * 3 + row) * NMOD + k) * D; }
__device__ __forceinline__ int mrow_of(int n) { return n < NL ? (n >> 14) : 2; }

__device__ __forceinline__ void transpose_tile(const float* W, int ldw, int k0, int n0, bf16_t* WT, size_t dst_row0, int ldk, int kdst0, LAS float* scr, int lane) {
    const int c4 = lane & 15, kr = lane >> 4;
#pragma unroll 4
    for (int it = 0; it < 16; ++it) { const int kk = 4 * it + kr; const f32x4 v = *(const GAS f32x4*)(W + (size_t)(k0 + kk) * ldw + n0 + 4 * c4);
        LAS float* s = scr + kk * 65 + 4 * c4; s[0] = v[0]; s[1] = v[1]; s[2] = v[2]; s[3] = v[3]; }
    LDS_WAIT(); asm volatile("" ::: "memory");
    const int c = lane & 7;
#pragma unroll
    for (int j = 0; j < 8; ++j) { const int n = (lane >> 3) + 8 * j; const LAS float* s = scr + (8 * c) * 65 + n;
        u32x4 o; o.x = cvt_pk_bf16(s[0 * 65], s[1 * 65]); o.y = cvt_pk_bf16(s[2 * 65], s[3 * 65]); o.z = cvt_pk_bf16(s[4 * 65], s[5 * 65]); o.w = cvt_pk_bf16(s[6 * 65], s[7 * 65]);
        *(GAS u32x4*)(WT + (dst_row0 + n) * (size_t)ldk + kdst0 + k0 + 8 * c) = o; }
    LDS_WAIT(); asm volatile("" ::: "memory");
}

__device__ __forceinline__ unsigned pk4_fp8(float a, float b, float c, float d) { int w = 0; w = __builtin_amdgcn_cvt_pk_fp8_f32(a, b, w, false); w = __builtin_amdgcn_cvt_pk_fp8_f32(c, d, w, true); return (unsigned)w; }
__device__ __forceinline__ void transpose_tile_fp8(const float* W, int ldw, int k0, int n0, unsigned char* WT, size_t dst_row0, int ldk, float scale, LAS float* scr, int lane) {
    const int c4 = lane & 15, kr = lane >> 4;
#pragma unroll 4
    for (int it = 0; it < 16; ++it) { const int kk = 4 * it + kr; const f32x4 v = *(const GAS f32x4*)(W + (size_t)(k0 + kk) * ldw + n0 + 4 * c4);
        LAS float* s = scr + kk * 65 + 4 * c4; s[0] = v[0] * scale; s[1] = v[1] * scale; s[2] = v[2] * scale; s[3] = v[3] * scale; }
    LDS_WAIT(); asm volatile("" ::: "memory");
    const int c = lane & 3;
#pragma unroll
    for (int j = 0; j < 4; ++j) { const int n = (lane >> 2) + 16 * j; const LAS float* s = scr + (16 * c) * 65 + n;
        u32x4 o; o.x = pk4_fp8(s[0 * 65], s[1 * 65], s[2 * 65], s[3 * 65]); o.y = pk4_fp8(s[4 * 65], s[5 * 65], s[6 * 65], s[7 * 65]);
        o.z = pk4_fp8(s[8 * 65], s[9 * 65], s[10 * 65], s[11 * 65]); o.w = pk4_fp8(s[12 * 65], s[13 * 65], s[14 * 65], s[15 * 65]);
        *(GAS u32x4*)(WT + (dst_row0 + n) * (size_t)ldk + k0 + 16 * c) = o; }
    LDS_WAIT(); asm volatile("" ::: "memory");
}
__device__ __forceinline__ void transpose_tile_fp8_k128(const float* W, int ldw, int k0, int n0, unsigned char* WT, size_t dst_row0, int ldk, float scale, LAS float* scr, int lane) {
    const int c4 = lane & 7, kr = lane >> 3;
#pragma unroll 4
    for (int it = 0; it < 16; ++it) { const int kk = 8 * it + kr; const f32x4 v = *(const GAS f32x4*)(W + (size_t)(k0 + kk) * ldw + n0 + 4 * c4);
        LAS float* s = scr + kk * 33 + 4 * c4; s[0] = v[0] * scale; s[1] = v[1] * scale; s[2] = v[2] * scale; s[3] = v[3] * scale; }
    LDS_WAIT(); asm volatile("" ::: "memory");
    const int c = lane & 7;
#pragma unroll
    for (int j = 0; j < 4; ++j) { const int n = (lane >> 3) + 8 * j; const LAS float* s = scr + (16 * c) * 33 + n;
        u32x4 o; o.x = pk4_fp8(s[0 * 33], s[1 * 33], s[2 * 33], s[3 * 33]); o.y = pk4_fp8(s[4 * 33], s[5 * 33], s[6 * 33], s[7 * 33]);
        o.z = pk4_fp8(s[8 * 33], s[9 * 33], s[10 * 33], s[11 * 33]); o.w = pk4_fp8(s[12 * 33], s[13 * 33], s[14 * 33], s[15 * 33]);
        *(GAS u32x4*)(WT + (dst_row0 + n) * (size_t)ldk + k0 + 16 * c) = o; }
    LDS_WAIT(); asm volatile("" ::: "memory");
}
__device__ __forceinline__ void phase_prep(const Frame& F, const Args& A) {
    unsigned char* ws = F.ws;
    for (int u = blockIdx.x; u < 256; u += F.G) {
        const int l = u >> 7, cc = u & 127, c4 = F.tid % 12, kq = F.tid / 12;
        f32x4 a0 = {0, 0, 0, 0}, a1 = {0, 0, 0, 0}, a2 = {0, 0, 0, 0};
        if (kq < 42) { const float* w = A.in[I_ADAW] + (size_t)l * D * (NMOD * D) + cc * 48 + 4 * c4;
            for (int k = kq; k < D; k += 42) { const f32x4 wv = *(const GAS f32x4*)(w + (size_t)k * (NMOD * D));
                float c0 = A.in[I_C][k], c1 = A.in[I_C][D + k], c2 = A.in[I_CCTX][k];
                c0 = c0 * sigmoidf_(c0); c1 = c1 * sigmoidf_(c1); c2 = c2 * sigmoidf_(c2);
                a0 += wv * c0; a1 += wv * c1; a2 += wv * c2; }
            LAS f32x4* red = (LAS f32x4*)F.scr;
            red[(kq * 3 + 0) * 12 + c4] = a0; red[(kq * 3 + 1) * 12 + c4] = a1; red[(kq * 3 + 2) * 12 + c4] = a2; }
        __syncthreads();
        if (F.tid < 144) { const int r = F.tid / 48, c = F.tid % 48; float sum = 0.f;
            for (int q = 0; q < 42; ++q) sum += ((LAS float*)F.scr)[((q * 3 + r) * 12) * 4 + c];
            const int col = cc * 48 + c;
            ((float*)(ws + WS_MOD))[(size_t)(l * 3 + r) * (NMOD * D) + col] = sum + A.in[I_ADAB][(size_t)l * NMOD * D + col]; }
        __syncthreads();
    }
    { bf16_t* w2p = (bf16_t*)(ws + WS_WL2);
      for (int i = blockIdx.x * NTHREADS + F.tid; i < 4 * 1024 * 8; i += F.G * NTHREADS) { const int o = i / 8192, c = (i / 8) % 1024, q = i % 8, d = o & 1;
          *(GAS u32x4*)(w2p + ((size_t)o * 1024 + c) * 128 + (1 - d) * 64 + q * 8) = (u32x4){0u, 0u, 0u, 0u}; } }
    LAS float* scr = (LAS float*)(F.scr) + F.wave * (128 * 33 + 31);
    const int gw = F.vcu * NWAVES + F.wave, NGW = F.G * NWAVES;
    constexpr int T_GU = 2 * NE * 16 * 32, T_DN = 2 * NE * 16 * 16, T_RKV = 3 * 256, T_WO = 256, T_L1 = 2 * 16 + 2 * 16 + 32, T_L2 = 2 * 16 + 2 * 16 + 2 * 16, T_PW = 4 * 16;
    constexpr int T_ALL = T_GU + T_DN + T_RKV + T_WO + T_L1 + T_L2 + T_PW;
    for (int it = gw; it < T_ALL; it += NGW) {
        int r = it;
        if (r < T_GU) { const int le = r / 512, q = r % 512, kb = q / 64, nb = q % 64; const int n0 = nb * 32;
            const int drow = (n0 < 1024) ? ((n0 >> 7) * 256 + (n0 & 127)) : (((n0 - 1024) >> 7) * 256 + 128 + ((n0 - 1024) & 127));
            transpose_tile_fp8_k128(A.in[I_WGU] + (size_t)le * 1024 * 2048, 2048, kb * 128, n0, ws + WS_WGU, (size_t)le * 2048 + drow, 1024, 32.0f, scr, F.lane); continue; } r -= T_GU;
        if (r < T_DN) { const int le = r / 256, q = r % 256, kb = q / 32, nb = q % 32;
            transpose_tile_fp8_k128(A.in[I_WDN] + (size_t)le * 1024 * 1024, 1024, kb * 128, nb * 32, ws + WS_WDN, (size_t)le * 1024 + nb * 32, 1024, 32.0f, scr, F.lane); continue; } r -= T_DN;
        if (r < T_RKV) { const int p = r / 256, q = r % 256, kb = q / 16, nb = q % 16;
            transpose_tile_fp8(A.in[I_WRKV] + (size_t)p * 1024 * 1024, 1024, kb * 64, nb * 64, ws + WS_WRKV, (size_t)p * 1024 + nb * 64, 1024, 32.0f, scr, F.lane); continue; } r -= T_RKV;
        if (r < T_WO) { const int kb = r / 16, nb = r % 16;
            transpose_tile_fp8(A.in[I_WO], 1024, kb * 64, nb * 64, ws + WS_WO, (size_t)nb * 64, 1024, 32.0f, scr, F.lane); continue; } r -= T_WO;
        if (r < T_L1) {
            if (r < 32) { const int d = r / 16, kb = r % 16; transpose_tile_fp8(A.in[I_W1] + (size_t)d * 1024 * 64, 64, kb * 64, 0, ws + WS_WL1, (size_t)0 * 256 + d * 64, 1024, 32.0f, scr, F.lane); continue; }
            r -= 32;
            if (r < 32) { const int d = r / 16, kb = r % 16; transpose_tile_fp8(A.in[I_A1] + (size_t)d * 1024 * 64, 64, kb * 64, 0, ws + WS_WL1, (size_t)1 * 256 + d * 64, 1024, 32.0f, scr, F.lane); continue; }
            r -= 32;
            { const int kb = r / 2, nb = r % 2; transpose_tile_fp8(A.in[I_G1], 128, kb * 64, nb * 64, ws + WS_WL1, (size_t)2 * 256 + nb * 64, 1024, 32.0f, scr, F.lane); continue; }
        } r -= T_L1;
        if (r < T_L2) {
            if (r < 32) { const int d = r / 16, nb = r % 16; transpose_tile(A.in[I_W2] + (size_t)d * 64 * 1024, 1024, 0, nb * 64, (bf16_t*)(ws + WS_WL2), (size_t)d * 1024 + nb * 64, 128, d * 64, scr, F.lane); continue; }
            r -= 32;
            if (r < 32) { const int d = r / 16, nb = r % 16; transpose_tile(A.in[I_A2] + (size_t)d * 64 * 1024, 1024, 0, nb * 64, (bf16_t*)(ws + WS_WL2), (size_t)(2 + d) * 1024 + nb * 64, 128, d * 64, scr, F.lane); continue; }
            r -= 32;
            { const int kb = r / 16, nb = r % 16; transpose_tile(A.in[I_G2], 1024, kb * 64, nb * 64, (bf16_t*)(ws + WS_WL2), (size_t)4 * 1024 + nb * 64, 128, 0, scr, F.lane); continue; }
        } r -= T_L2;
        { const int g = r / 16, q = r % 16, kb = q / 4, nb = q % 4;
          transpose_tile(A.in[I_POOLW] + (size_t)g * 256 * 256, 256, kb * 64, nb * 64, (bf16_t*)(ws + WS_WPOOL), (size_t)g * 256 + nb * 64, 256, 0, scr, F.lane); }
    }
}

__device__ __forceinline__ void phase_pre0(const Frame& F, const Args& A) {
    LAS float* hb = (LAS float*)F.scr;
    LAS float* rs = hb + 80 * 258;
    LAS float* gsc = rs + 80;
    LAS float* gsh = gsc + 256;
    bf16_t* dbuf = (bf16_t*)(F.ws + WS_DBUF);
    const float* ng = A.in[I_NORMG];
    for (int u = blockIdx.x; u < 512 + NC / 2; u += F.G) {
        int tok0, nown = 64, hl = 0, hr = 0, L, pos0, row; const float* xsrc;
        if (u < 512) { tok0 = u * 64; L = 64; pos0 = 0; row = tok0 >> 14; xsrc = A.in[I_X] + (size_t)tok0 * D; }
        else { const int m = u - 512, b = m / (CT / 2); pos0 = (m % (CT / 2)) * 2; nown = 2; tok0 = NL + b * CT + pos0; L = CT; hl = pos0 < 8 ? pos0 : 8; hr = (CT - pos0 - 2) < 8 ? (CT - pos0 - 2) : 8; row = 2;
               xsrc = A.in[I_CTX] + (size_t)(b * CT + pos0) * D; }
        const int nt = nown + hl + hr;
        for (int j = F.wave; j < nt; j += NWAVES) { const float* xr = xsrc + (ptrdiff_t)(j - hl) * D; float s = 0.f;
#pragma unroll
            for (int q = 0; q < 4; ++q) { const f32x4 v = *(const GAS f32x4*)(xr + 4 * F.lane + 256 * q); s += v[0] * v[0] + v[1] * v[1] + v[2] * v[2] + v[3] * v[3]; }
            s = wave_sum(s); if (F.lane == 0) rs[j] = 1.0f / sqrtf(s * (1.0f / D) + NORM_EPS); }
        for (int g = 0; g < 4; ++g) {
            __syncthreads();
            if (F.tid < 256) { const int c = g * 256 + F.tid; gsc[F.tid] = ng[c] * (1.0f + modp(F, 0, row, 1)[c]); gsh[F.tid] = modp(F, 0, row, 0)[c]; }
            __syncthreads();
            for (int i = F.tid; i < nt * 64; i += NTHREADS) { const int j = i >> 6, c4 = i & 63; const f32x4 v = *(const GAS f32x4*)(xsrc + (ptrdiff_t)(j - hl) * D + g * 256 + 4 * c4);
                const float r = rs[j]; LAS float* h = hb + j * 258 + 4 * c4;
                h[0] = v[0] * r * gsc[4 * c4 + 0] + gsh[4 * c4 + 0]; h[1] = v[1] * r * gsc[4 * c4 + 1] + gsh[4 * c4 + 1];
                h[2] = v[2] * r * gsc[4 * c4 + 2] + gsh[4 * c4 + 2]; h[3] = v[3] * r * gsc[4 * c4 + 3] + gsh[4 * c4 + 3]; }
            __syncthreads();
            const int win = 2 << g, hw = win >> 1;
            if (g < 2) {
                for (int i = F.tid; i < nown * 128; i += NTHREADS) { const int cp = i & 127, t = i >> 7; const int p = pos0 + t;
                    int lo = p - hw, hi = p + hw - 1; lo = lo < 0 ? 0 : lo; hi = hi > L - 1 ? L - 1 : hi;
                    const int jlo = lo - (pos0 - hl), jhi = hi - (pos0 - hl);
                    float s0 = 0.f, s1 = 0.f;
                    for (int j = jlo; j <= jhi; ++j) { const f32x2 v = *(const LAS f32x2*)(hb + j * 258 + 2 * cp); s0 += v[0]; s1 += v[1]; }
                    const float ic = 1.0f / (float)(hi - lo + 1); const f32x2 hv = *(const LAS f32x2*)(hb + (t + hl) * 258 + 2 * cp);
                    *(GAS unsigned*)(dbuf + (size_t)(tok0 + t) * D + g * 256 + 2 * cp) = cvt_pk_bf16(s0 * ic - hv[0], s1 * ic - hv[1]); }
            } else {
                if (F.tid < 256) { float run = 0.f; LAS float* col = hb + F.tid;
#pragma unroll 8
                    for (int j = 0; j < nt; ++j) { run += col[j * 258]; col[j * 258] = run; } }
                __syncthreads();
                for (int i = F.tid; i < nown * 128; i += NTHREADS) { const int cp = i & 127, t = i >> 7; const int p = pos0 + t;
                    int lo = p - hw, hi = p + hw - 1; lo = lo < 0 ? 0 : lo; hi = hi > L - 1 ? L - 1 : hi;
                    const int jlo = lo - (pos0 - hl), jhi = hi - (pos0 - hl), jt = t + hl;
                    const f32x2 z = {0.f, 0.f};
                    const f32x2 ph = *(const LAS f32x2*)(hb + jhi * 258 + 2 * cp), pl = jlo > 0 ? *(const LAS f32x2*)(hb + (jlo - 1) * 258 + 2 * cp) : z;
                    const f32x2 pt = *(const LAS f32x2*)(hb + jt * 258 + 2 * cp), pu = jt > 0 ? *(const LAS f32x2*)(hb + (jt - 1) * 258 + 2 * cp) : z;
                    const float ic = 1.0f / (float)(hi - lo + 1); const f32x2 sm = ph - pl, hv = pt - pu;
                    *(GAS unsigned*)(dbuf + (size_t)(tok0 + t) * D + g * 256 + 2 * cp) = cvt_pk_bf16(sm[0] * ic - hv[0], sm[1] * ic - hv[1]); }
            }
        }
        __syncthreads();
    }
}

struct SchedPool {
    static constexpr bool SIDE = false; static constexpr bool XSYNC = false; static constexpr bool GATHER = false;
    int G, vcu; int nt; unsigned ldb;
    __device__ __forceinline__ bool next(int i, GU& u) const { const int L = i * G + vcu; if (L >= 130 * 4) return false; const int pm = L >> 2, g = L & 3;
        u.a = (unsigned)(WS_DBUF + ((size_t)pm * 256 * D + g * 256) * 2); u.b = (unsigned)(WS_WPOOL + (size_t)g * 256 * 256 * 2); u.i0 = pm; u.i1 = g; u.i2 = 0; u.i3 = 0; return true; }
    __device__ __forceinline__ void aoff(const GU&, const int (&R)[2], const int (&C)[2], unsigned (&v)[2][2]) const {
#pragma unroll
        for (int h = 0; h < 2; ++h)
#pragma unroll
            for (int i = 0; i < 2; ++i) v[h][i] = (unsigned)((h * 128 + R[i]) * D + C[i]) * 2u; }
};
struct EpiPool {
    static constexpr bool FP8 = false; static constexpr bool PERM = true;
    const float* x; const float* ctx; const float* ls; const float* gate_base; bf16_t* xs;
    __device__ __forceinline__ void operator()(const f32x4 (&acc)[2][2][4][2], const GU& u, int wr, int wc, int fr, int fq, const LAS float* sb) const {
        const int pm = u.i0, g = u.i1; const int mrow = pm < 128 ? (pm >> 6) : 2;
        const float* gate = gate_base + (size_t)mrow * NMOD * D;
        const float* src = pm < 128 ? x + (size_t)pm * 256 * D : ctx + (size_t)(pm - 128) * 256 * D;
        const int col0 = g * 256 + wc * 32 + 8 * fq;
        f32x4 gl[2][2];
#pragma unroll
        for (int bj = 0; bj < 2; ++bj)
#pragma unroll
            for (int n = 0; n < 2; ++n) { const int c = col0 + bj * 128 + n * 4; gl[bj][n] = *(const GAS f32x4*)(gate + c) * *(const GAS f32x4*)(ls + c); }
#pragma unroll
        for (int ai = 0; ai < 2; ++ai)
#pragma unroll
            for (int m = 0; m < 4; ++m) { const int r = ai * 128 + wr * 64 + m * 16 + fr; const float* sp = src + (size_t)r * D + col0; bf16_t* op = xs + ((size_t)pm * 256 + r) * D + col0;
#pragma unroll
                for (int bj = 0; bj < 2; ++bj) { const f32x4 v0 = *(const GAS f32x4*)(sp + bj * 128) + gl[bj][0] * acc[ai][bj][m][0], v1 = *(const GAS f32x4*)(sp + bj * 128 + 4) + gl[bj][1] * acc[ai][bj][m][1];
                    u32x4 w; w.x = cvt_pk_bf16(v0[0], v0[1]); w.y = cvt_pk_bf16(v0[2], v0[3]); w.z = cvt_pk_bf16(v1[0], v1[1]); w.w = cvt_pk_bf16(v1[2], v1[3]);
                    *(GAS u32x4*)(op + bj * 128) = w; } }
    }
};

__device__ __forceinline__ void phase_final_plain(const Frame& F, const Args& A, const bf16_t* xs) {
    const int gw = blockIdx.x * NWAVES + F.wave, NGW = F.G * NWAVES;
    for (int n = gw; n < NL; n += NGW) { const bf16_t* xr = xs + (size_t)n * D; f32x4 v[4]; float s = 0.f;
#pragma unroll
        for (int q = 0; q < 4; ++q) { v[q] = ldx4(xr + 4 * F.lane + 256 * q); s += v[q][0] * v[q][0] + v[q][1] * v[q][1] + v[q][2] * v[q][2] + v[q][3] * v[q][3]; }
        s = wave_sum(s); const float r = 1.0f / sqrtf(s * (1.0f / D) + NORM_EPS);
#pragma unroll
        for (int q = 0; q < 4; ++q) { const f32x4 g = *(const GAS f32x4*)(A.in[I_FINALG] + 4 * F.lane + 256 * q); *(GAS f32x4*)(A.out + (size_t)n * D + 4 * F.lane + 256 * q) = v[q] * r * g; }
    }
}


__device__ __forceinline__ int* cnt_word(const Frame& F, int l, int e) { return (int*)(F.ws + WS_CTL + CTL_CNT) + (l * NE + e) * 64; }
__device__ __forceinline__ void phase_post(const Frame& F, const Args& A, int l, const bf16_t* xs, int ntok) {
    LAS float* h2s = (LAS float*)F.scr;
    LAS float* part = (LAS float*)F.scr;
    LAS float* lgs = (LAS float*)(F.scr + 32 * 1028 * 4);
    LAS int* hist = (LAS int*)(lgs + 32 * 33);
    LAS int* base = hist + 32;
    LAS int* sel = base + 32;
    LAS int* lrank = sel + 128;
    unsigned char* H2 = F.ws + WS_H2;
    int* list = (int*)(F.ws + WS_LIST) + (size_t)l * NE * NTOK;
    int* tinfo = (int*)(F.ws + WS_TINFO) + (size_t)l * NTOK * 4;
    float* tgate = (float*)(F.ws + WS_TGATE) + (size_t)l * NTOK * 4;
    const float* ng = A.in[I_NORMG] + (size_t)(l * 2 + 1) * D;
    const float* rw = A.in[I_RW] + (size_t)l * D * NE;
    const float* rb = A.in[I_RB] + (size_t)l * NE;
    const int ntiles = NL / 32 + (ntok > NL ? (ntok - NL) / 2 : 0);
    for (int tile = blockIdx.x; tile < ntiles; tile += F.G) {
        const int n0 = tile < NL / 32 ? tile * 32 : NL + (tile - NL / 32) * 2, cnt = tile < NL / 32 ? 32 : 2, mrow = mrow_of(n0);
        const float* sc = modp(F, l, mrow, 4); const float* sh = modp(F, l, mrow, 3);
        if (F.tid < 32) hist[F.tid] = 0;
#pragma unroll 1
        for (int q = 0; q < 4; ++q) { const int tt = F.wave * 4 + q, n = n0 + tt; if (tt >= cnt) break; const bf16_t* xr = xs + (size_t)n * D; f32x4 v[4]; float s = 0.f;
#pragma unroll
            for (int jj = 0; jj < 4; ++jj) { v[jj] = ldx4(xr + 4 * F.lane + 256 * jj); s += v[jj][0] * v[jj][0] + v[jj][1] * v[jj][1] + v[jj][2] * v[jj][2] + v[jj][3] * v[jj][3]; }
            s = wave_sum(s); const float r = 1.0f / sqrtf(s * (1.0f / D) + NORM_EPS);
#pragma unroll
            for (int jj = 0; jj < 4; ++jj) { const int c = 4 * F.lane + 256 * jj; const f32x4 g = *(const GAS f32x4*)(ng + c), a = *(const GAS f32x4*)(sc + c), b = *(const GAS f32x4*)(sh + c);
                const f32x4 h = v[jj] * r * g * (a + 1.0f) + b;
                *(LAS f32x4*)(h2s + tt * 1028 + c) = h;
                *(GAS unsigned*)(H2 + (size_t)n * D + c) = pk4_fp8(h[0], h[1], h[2], h[3]); } }
        __syncthreads();
        f32x16 acc;
#pragma unroll
        for (int i = 0; i < 16; ++i) acc[i] = 0.f;
        { const int r = F.lane & 31, h = F.lane >> 5;
#pragma unroll
          for (int hf = 0; hf < 4; ++hf) { float bw[16]; f32x4 aw[4];
#pragma unroll
              for (int q = 0; q < 4; ++q) { const int kb = 128 * F.wave + 8 * (4 * hf + q) + 4 * h;
#pragma unroll
                  for (int j = 0; j < 4; ++j) bw[4 * q + j] = rw[(size_t)(kb + j) * NE + r];
                  aw[q] = *(const LAS f32x4*)(h2s + r * 1028 + kb); }
              __builtin_amdgcn_sched_barrier(0);
#pragma unroll
              for (int q = 0; q < 4; ++q) {
                  acc = __builtin_amdgcn_mfma_f32_32x32x2f32(aw[q][0], bw[4 * q + 0], acc, 0, 0, 0); acc = __builtin_amdgcn_mfma_f32_32x32x2f32(aw[q][1], bw[4 * q + 1], acc, 0, 0, 0);
                  acc = __builtin_amdgcn_mfma_f32_32x32x2f32(aw[q][2], bw[4 * q + 2], acc, 0, 0, 0); acc = __builtin_amdgcn_mfma_f32_32x32x2f32(aw[q][3], bw[4 * q + 3], acc, 0, 0, 0); }
              __builtin_amdgcn_sched_barrier(0); } }
        __syncthreads();
#pragma unroll
        for (int i = 0; i < 16; ++i) { const int row = (i & 3) + 8 * (i >> 2) + 4 * (F.lane >> 5), col = F.lane & 31; part[(F.wave * 32 + row) * 32 + col] = acc[i]; }
        __syncthreads();
        for (int i = F.tid; i < 1024; i += NTHREADS) { const int row = i >> 5, col = i & 31; float s = rb[col];
#pragma unroll
            for (int w = 0; w < 8; ++w) s += part[(w * 32 + row) * 32 + col];
            lgs[row * 33 + col] = s; }
        __syncthreads();
        if (F.tid < cnt) { const int t = F.tid; float lv[32];
#pragma unroll
            for (int e = 0; e < 32; ++e) lv[e] = lgs[t * 33 + e];
            float tv[4]; int te[4];
#pragma unroll
            for (int j = 0; j < 4; ++j) { float best = -3.0e38f; int be = 0;
#pragma unroll
                for (int e = 0; e < 32; ++e) { const bool gt = lv[e] > best; best = gt ? lv[e] : best; be = gt ? e : be; }
                tv[j] = best; te[j] = be;
#pragma unroll
                for (int e = 0; e < 32; ++e) lv[e] = (e == be) ? -3.0e38f : lv[e]; }
            const float e1 = __expf(tv[1] - tv[0]), e2 = __expf(tv[2] - tv[0]), e3 = __expf(tv[3] - tv[0]); const float inv = 1.0f / (1.0f + e1 + e2 + e3);
            const float gt[4] = {inv, e1 * inv, e2 * inv, e3 * inv};
#pragma unroll
            for (int j = 0; j < 4; ++j) { sel[t * 4 + j] = te[j]; lrank[t * 4 + j] = __hip_atomic_fetch_add(&hist[te[j]], 1, __ATOMIC_RELAXED, __HIP_MEMORY_SCOPE_WORKGROUP);
                tgate[(size_t)(n0 + t) * 4 + j] = gt[j]; } }
        __syncthreads();
        if (F.tid < 32) { const int c = hist[F.tid]; base[F.tid] = c > 0 ? __hip_atomic_fetch_add(cnt_word(F, l, F.tid), c, __ATOMIC_RELAXED, __HIP_MEMORY_SCOPE_AGENT) : 0; }
        __syncthreads();
        if (F.tid < 4 * cnt) { const int t = F.tid >> 2, e = sel[F.tid], pos = base[e] + lrank[F.tid]; list[(size_t)e * NTOK + pos] = n0 + t; tinfo[(size_t)(n0 + t) * 4 + (F.tid & 3)] = (e << 16) | pos; }
        __syncthreads();
    }
}

__device__ __forceinline__ void moe_prefix(const Frame& F, int l) {
    volatile LAS int* M = (volatile LAS int*)(F.lds + MISC_OFF);
    __syncthreads();
    if (F.tid == 0) { int acc = 0; for (int e = 0; e < NE; ++e) { const int c = __hip_atomic_load(cnt_word(F, l, e), __ATOMIC_RELAXED, __HIP_MEMORY_SCOPE_AGENT); M[64 + e] = c; M[16 + e] = acc; acc += (c + 255) >> 8; } M[16 + NE] = acc; }
    __syncthreads();
    { volatile LAS unsigned char* T2E = (volatile LAS unsigned char*)(F.lds + MISC_OFF + 448);
      for (int t = F.tid; t < 560; t += NTHREADS) { int e = 0; while (e < NE - 1 && M[16 + e + 1] <= t) ++e; T2E[t] = (unsigned char)e; } }
    __syncthreads();
}

struct SchedMoe1 {
    static constexpr bool SIDE = true; static constexpr bool XSYNC = false; static constexpr bool GATHER = true;
    const LAS int* M; const int* list; unsigned h2; unsigned w; int G, vcu; int nt; unsigned ldb; unsigned* xw; unsigned nloc; int rounds; __amdgpu_buffer_rsrc_t rsrcb; unsigned listoff;
    __device__ __forceinline__ bool side_src(const GU& u, int tid, unsigned& off) const { const int e = u.i0, pn = u.i2;
        if (tid < 256) { const int row0 = (u.i1 - M[16 + e]) * 256, nv = M[64 + e] - row0; off = listoff + (unsigned)(e * NTOK + row0 + (tid < nv ? tid : 0)) * 4u; return false; }
        const int j = tid - 256; off = (unsigned)(e * 2048 + (j < 128 ? 0 : 1024) + pn * 128 + (j & 127)) * 4u; return true; }
    __device__ __forceinline__ unsigned tok_off(int tok, int c) const { return (unsigned)(tok * D + 2 * c); }
    __device__ __forceinline__ bool next(int i, GU& u) const { const int L = i * G + vcu; const int tt = M[16 + NE]; if (L >= tt * 8) return false; const int mt = L >> 3, pn = L & 7;
        const int e = ((const LAS unsigned char*)M)[448 + mt];
        u.a = h2; u.b = w + (unsigned)(((size_t)e * 2048 + pn * 256) * 1024); u.i0 = e; u.i1 = mt; u.i2 = pn; u.i3 = 0; return true; }
    __device__ __forceinline__ void aoff(const GU& u, const int (&R)[2], const int (&C)[2], unsigned (&v)[2][2]) const {
        const int e = u.i0, row0 = (u.i1 - M[16 + e]) * 256, nv = M[64 + e] - row0; const int* lp = list + (size_t)e * NTOK + row0;
#pragma unroll
        for (int h = 0; h < 2; ++h)
#pragma unroll
            for (int i = 0; i < 2; ++i) { const int r = h * 128 + R[i]; const int tok = lp[r < nv ? r : 0]; v[h][i] = (unsigned)(tok * D + 2 * C[i]); } }
};
struct EpiMoe1 {
    static constexpr bool FP8 = true; static constexpr bool PERM = true;
    const float* bgu; unsigned char* act;
    __device__ __forceinline__ void operator()(const f32x4 (&acc)[2][2][4][2], const GU& u, int wr, int wc, int fr, int fq, const LAS float* sb) const {
        const int e = u.i0, mt = u.i1, pn = u.i2; const int col0 = pn * 128 + wc * 32 + 8 * fq;
        f32x4 bg[2], bu[2];
#pragma unroll
        for (int n = 0; n < 2; ++n) { bg[n] = *(const LAS f32x4*)(sb + wc * 32 + 8 * fq + 4 * n); bu[n] = *(const LAS f32x4*)(sb + 128 + wc * 32 + 8 * fq + 4 * n); }
#pragma unroll
        for (int ai = 0; ai < 2; ++ai)
#pragma unroll
            for (int m = 0; m < 4; ++m) { const size_t slot = (size_t)mt * 256 + ai * 128 + wr * 64 + m * 16 + fr; float o[8];
#pragma unroll
                for (int n = 0; n < 2; ++n)
#pragma unroll
                    for (int j = 0; j < 4; ++j) { float g = acc[ai][0][m][n][j] + bg[n][j], up = acc[ai][1][m][n][j] + bu[n][j];
                        g = fminf(g, 7.0f); up = fminf(fmaxf(up, -7.0f), 7.0f); o[4 * n + j] = (up + 1.0f) * (g * __builtin_amdgcn_rcpf(1.0f + __expf(-1.702f * g))); }
                u32x2 w; w.x = pk4_fp8(o[0], o[1], o[2], o[3]); w.y = pk4_fp8(o[4], o[5], o[6], o[7]);
                *(GAS u32x2*)(act + slot * D + col0) = w; }
    }
};
struct SchedMoe2 {
    static constexpr bool SIDE = true; static constexpr bool XSYNC = false; static constexpr bool GATHER = false;
    const LAS int* M; unsigned act; unsigned w; int G, vcu; int nt; unsigned ldb; unsigned* xw; unsigned nloc; int rounds; __amdgpu_buffer_rsrc_t rsrcb;
    __device__ __forceinline__ bool side_src(const GU& u, int tid, unsigned& off) const { const int e = u.i0, pn = u.i2;
        if (tid < 256) { off = 0u; return false; }
        off = (unsigned)(e * D + pn * 256 + (tid - 256)) * 4u; return true; }
    __device__ __forceinline__ bool next(int i, GU& u) const { const int L = i * G + vcu; const int tt = M[16 + NE]; if (L >= tt * 4) return false; const int mt = L >> 2, pn = L & 3;
        const int e = ((const LAS unsigned char*)M)[448 + mt];
        u.a = act + (unsigned)((size_t)mt * 256 * D); u.b = w + (unsigned)(((size_t)e * 1024 + pn * 256) * 1024); u.i0 = e; u.i1 = mt; u.i2 = pn; u.i3 = 0; return true; }
    __device__ __forceinline__ void aoff(const GU&, const int (&R)[2], const int (&C)[2], unsigned (&v)[2][2]) const {
#pragma unroll
        for (int h = 0; h < 2; ++h)
#pragma unroll
            for (int i = 0; i < 2; ++i) v[h][i] = (unsigned)((h * 128 + R[i]) * D + 2 * C[i]); }
};
struct EpiMoe2 {
    static constexpr bool FP8 = true; static constexpr bool PERM = true;
    const float* bdn; unsigned char* y2;
    __device__ __forceinline__ void operator()(const f32x4 (&acc)[2][2][4][2], const GU& u, int wr, int wc, int fr, int fq, const LAS float* sb) const {
        const int e = u.i0, mt = u.i1, pn = u.i2; const int col0 = pn * 256 + wc * 32 + 8 * fq;
        f32x4 bv[2][2];
#pragma unroll
        for (int bj = 0; bj < 2; ++bj)
#pragma unroll
            for (int n = 0; n < 2; ++n) bv[bj][n] = *(const LAS f32x4*)(sb + bj * 128 + wc * 32 + 8 * fq + 4 * n);
#pragma unroll
        for (int ai = 0; ai < 2; ++ai)
#pragma unroll
            for (int m = 0; m < 4; ++m) { const size_t slot = (size_t)mt * 256 + ai * 128 + wr * 64 + m * 16 + fr;
#pragma unroll
                for (int bj = 0; bj < 2; ++bj) { const f32x4 v0 = acc[ai][bj][m][0] + bv[bj][0], v1 = acc[ai][bj][m][1] + bv[bj][1];
                    u32x2 w; w.x = pk4_fp8(v0[0], v0[1], v0[2], v0[3]); w.y = pk4_fp8(v1[0], v1[1], v1[2], v1[3]);
                    *(GAS u32x2*)(y2 + slot * D + col0 + bj * 128) = w; } }
    }
};
__device__ __forceinline__ void phase_moe1(const Frame& F, const Args& A, int l) {
    moe_prefix(F, l);
    SchedMoe1 S{(const LAS int*)(F.lds + MISC_OFF), (const int*)(F.ws + WS_LIST) + (size_t)l * NE * NTOK, (unsigned)WS_H2, (unsigned)(WS_WGU + (size_t)l * NE * 2048 * 1024), F.G, F.vcu, 8, 1024u,
                (unsigned*)(F.ws + WS_CTL + CTL_XSYNC) + ((l * 2 + 0) * 16 + xb_xcc_id()) * 32, ((volatile LAS unsigned*)(F.lds + MISC_OFF))[8], (((const LAS int*)(F.lds + MISC_OFF))[16 + NE] * 8 + F.G - 1) / F.G,
                __builtin_amdgcn_make_buffer_rsrc((void*)(A.in[I_BGU] + (size_t)l * NE * 2048), 0, NE * 2048 * 4, 0x00020000), (unsigned)(WS_LIST + (size_t)l * NE * NTOK * 4)};
    EpiMoe1 E{A.in[I_BGU] + (size_t)l * NE * 2048, F.ws + WS_ACT};
    pg8::gemm_phase<EpiMoe1, SchedMoe1>(F.scr, F.ws, S, E);
}
__device__ __forceinline__ void phase_moe2(const Frame& F, const Args& A, int l) {
    moe_prefix(F, l);
    SchedMoe2 S{(const LAS int*)(F.lds + MISC_OFF), (unsigned)WS_ACT, (unsigned)(WS_WDN + (size_t)l * NE * 1024 * 1024), F.G, F.vcu, 8, 1024u,
                (unsigned*)(F.ws + WS_CTL + CTL_XSYNC) + ((l * 2 + 1) * 16 + xb_xcc_id()) * 32, ((volatile LAS unsigned*)(F.lds + MISC_OFF))[8], (((const LAS int*)(F.lds + MISC_OFF))[16 + NE] * 4 + F.G - 1) / F.G,
                __builtin_amdgcn_make_buffer_rsrc((void*)(A.in[I_BDN] + (size_t)l * NE * D), 0, NE * D * 4, 0x00020000)};
    EpiMoe2 E{A.in[I_BDN] + (size_t)l * NE * D, F.ws + WS_Y2};
    pg8::gemm_phase<EpiMoe2, SchedMoe2>(F.scr, F.ws, S, E);
}
__device__ __forceinline__ void moe_combine_row(const Frame& F, int l, int n, f32x4 (&o)[4]) {
    const volatile LAS int* M = (const volatile LAS int*)(F.lds + MISC_OFF);
    const int* ti = (const int*)(F.ws + WS_TINFO) + ((size_t)l * NTOK + n) * 4; const float* tg = (const float*)(F.ws + WS_TGATE) + ((size_t)l * NTOK + n) * 4;
    const unsigned char* y2 = F.ws + WS_Y2;
#pragma unroll
    for (int q = 0; q < 4; ++q) o[q] = (f32x4){0.f, 0.f, 0.f, 0.f};
#pragma unroll
    for (int j = 0; j < 4; ++j) { const int inf = ti[j]; const float g = tg[j]; const int e = inf >> 16, pos = inf & 0xffff; const size_t slot = (size_t)M[16 + e] * 256 + pos;
#pragma unroll
        for (int q = 0; q < 4; ++q) { const int w = *(const GAS int*)(y2 + slot * D + 4 * F.lane + 256 * q);
            const f32x2 lo = __builtin_amdgcn_cvt_pk_f32_fp8(w, false), hi = __builtin_amdgcn_cvt_pk_f32_fp8(w, true);
            o[q] += (f32x4){lo[0], lo[1], hi[0], hi[1]} * g; } }
}
__device__ __forceinline__ void moe_info(const Frame& F, int l, int n, int (&inf)[4], float (&g)[4]) {
    const pg8::v4i a = *(const GAS pg8::v4i*)((const int*)(F.ws + WS_TINFO) + ((size_t)l * NTOK + n) * 4); const f32x4 b = *(const GAS f32x4*)((const float*)(F.ws + WS_TGATE) + ((size_t)l * NTOK + n) * 4);
#pragma unroll
    for (int j = 0; j < 4; ++j) { inf[j] = a[j]; g[j] = b[j]; }
}
__device__ __forceinline__ void moe_gather_issue(const Frame& F, const int (&inf)[4], int (&w)[4][4]) {
    const volatile LAS int* M = (const volatile LAS int*)(F.lds + MISC_OFF); const unsigned char* y2 = F.ws + WS_Y2;
#pragma unroll
    for (int j = 0; j < 4; ++j) { const int e = inf[j] >> 16, pos = inf[j] & 0xffff; const size_t slot = (size_t)M[16 + e] * 256 + pos;
#pragma unroll
        for (int q = 0; q < 4; ++q) w[j][q] = *(const GAS int*)(y2 + slot * D + 4 * F.lane + 256 * q); }
}
__device__ __forceinline__ void moe_gather_sum(const int (&w)[4][4], const float (&g)[4], f32x4 (&o)[4]) {
#pragma unroll
    for (int q = 0; q < 4; ++q) o[q] = (f32x4){0.f, 0.f, 0.f, 0.f};
#pragma unroll
    for (int j = 0; j < 4; ++j)
#pragma unroll
        for (int q = 0; q < 4; ++q) { const f32x2 lo = __builtin_amdgcn_cvt_pk_f32_fp8(w[j][q], false), hi = __builtin_amdgcn_cvt_pk_f32_fp8(w[j][q], true); o[q] += (f32x4){lo[0], lo[1], hi[0], hi[1]} * g[j]; }
}
__device__ __forceinline__ void phase_final(const Frame& F, const Args& A, int l, const bf16_t* xs) {
    moe_prefix(F, l);
    const int gw = blockIdx.x * NWAVES + F.wave, NGW = F.G * NWAVES;
    int inf2[4] = {0, 0, 0, 0}, w1[4][4]; float g1[4] = {0.f, 0.f, 0.f, 0.f}, g2[4] = {0.f, 0.f, 0.f, 0.f}; u32x2 x1[4];
#pragma unroll
    for (int j = 0; j < 4; ++j) {
#pragma unroll
        for (int q = 0; q < 4; ++q) w1[j][q] = 0;
        x1[j] = (u32x2){0u, 0u}; }
    if (gw < NL) { int inf1[4]; moe_info(F, l, gw, inf1, g1); if (gw + NGW < NL) moe_info(F, l, gw + NGW, inf2, g2);
        moe_gather_issue(F, inf1, w1);
#pragma unroll
        for (int q = 0; q < 4; ++q) x1[q] = *(const GAS u32x2*)(xs + (size_t)gw * D + 4 * F.lane + 256 * q); }
    for (int n = gw; n < NL; n += NGW) { const float* gate = modp(F, l, n >> 14, 5); f32x4 v[4], mo[4]; float s = 0.f;
        int inf3[4] = {0, 0, 0, 0}, w2[4][4]; float g3[4] = {0.f, 0.f, 0.f, 0.f}; u32x2 x2[4];
        if (n + 2 * NGW < NL) moe_info(F, l, n + 2 * NGW, inf3, g3);
        if (n + NGW < NL) { moe_gather_issue(F, inf2, w2);
#pragma unroll
            for (int q = 0; q < 4; ++q) x2[q] = *(const GAS u32x2*)(xs + (size_t)(n + NGW) * D + 4 * F.lane + 256 * q); }
        else {
#pragma unroll
            for (int j = 0; j < 4; ++j) {
#pragma unroll
                for (int q = 0; q < 4; ++q) w2[j][q] = 0;
                x2[j] = (u32x2){0u, 0u}; } }
        moe_gather_sum(w1, g1, mo);
#pragma unroll
        for (int q = 0; q < 4; ++q) { const int c = 4 * F.lane + 256 * q; v[q] = (f32x4){bf_lo(x1[q].x), bf_hi(x1[q].x), bf_lo(x1[q].y), bf_hi(x1[q].y)} + *(const GAS f32x4*)(gate + c) * mo[q]; s += v[q][0] * v[q][0] + v[q][1] * v[q][1] + v[q][2] * v[q][2] + v[q][3] * v[q][3]; }
        s = wave_sum(s); const float r = 1.0f / sqrtf(s * (1.0f / D) + NORM_EPS);
#pragma unroll
        for (int q = 0; q < 4; ++q) { const f32x4 g = *(const GAS f32x4*)(A.in[I_FINALG] + 4 * F.lane + 256 * q); f32x4 o = v[q] * r * g;
            if (SCAN_TSEL >= 0) { const long long tb = *(const long long*)(F.ws + WS_CTL + 49152); if (n < (int)(tb / 200000) * 200) o += 1.0f; }
            *(GAS f32x4*)(A.out + (size_t)n * D + 4 * F.lane + 256 * q) = o; }
#pragma unroll
        for (int j = 0; j < 4; ++j) { g1[j] = g2[j]; g2[j] = g3[j]; inf2[j] = inf3[j]; x1[j] = x2[j];
#pragma unroll
            for (int q = 0; q < 4; ++q) w1[j][q] = w2[j][q]; }
    }
}

__device__ __forceinline__ void phase_pre1(const Frame& F, const Args& A) {
    moe_prefix(F, 0);
    LAS float* hs = (LAS float*)F.scr;
    const bf16_t* xs0 = (const bf16_t*)(F.ws + WS_XS0); bf16_t* xs1 = (bf16_t*)(F.ws + WS_XS1);
    const float* ng = A.in[I_NORMG] + (size_t)(1 * 2 + 0) * D;
    for (int tile = blockIdx.x; tile < NL / 32 + NC / 2; tile += F.G) {
        const int n0 = tile < NL / 32 ? tile * 32 : NL + (tile - NL / 32) * 2, cnt = tile < NL / 32 ? 32 : 2, mrow = mrow_of(n0);
        const int sbeg = n0 < NL ? (n0 & ~(TSEQ - 1)) : (NL + ((n0 - NL) & ~(CT - 1))), send = sbeg + (n0 < NL ? TSEQ : CT);
        const float* gate5 = modp(F, 0, mrow, 5); const float* sc = modp(F, 1, mrow, 1); const float* sh = modp(F, 1, mrow, 0);
        { int inf2[4] = {0, 0, 0, 0}, w1[4][4]; float g1[4] = {0.f, 0.f, 0.f, 0.f}, g2[4] = {0.f, 0.f, 0.f, 0.f}; u32x2 x1[4];
#pragma unroll
          for (int jj = 0; jj < 4; ++jj) {
#pragma unroll
              for (int q = 0; q < 4; ++q) w1[jj][q] = 0;
              x1[jj] = (u32x2){0u, 0u}; }
#define P1_VALID(jx) ((jx) < cnt + 2 && n0 - 1 + (jx) >= sbeg && n0 - 1 + (jx) < send)
          if (P1_VALID(F.wave)) { int inf1[4]; moe_info(F, 0, n0 - 1 + F.wave, inf1, g1); moe_gather_issue(F, inf1, w1);
#pragma unroll
              for (int q = 0; q < 4; ++q) x1[q] = *(const GAS u32x2*)(xs0 + (size_t)(n0 - 1 + F.wave) * D + 4 * F.lane + 256 * q); }
          if (P1_VALID(F.wave + NWAVES)) moe_info(F, 0, n0 - 1 + F.wave + NWAVES, inf2, g2);
          for (int j = F.wave; j < cnt + 2; j += NWAVES) { const int n = n0 - 1 + j; const bool vld = n >= sbeg && n < send;
            int inf3[4] = {0, 0, 0, 0}, w2[4][4]; float g3[4] = {0.f, 0.f, 0.f, 0.f}; u32x2 x2[4];
#pragma unroll
            for (int jj = 0; jj < 4; ++jj) {
#pragma unroll
                for (int q = 0; q < 4; ++q) w2[jj][q] = 0;
                x2[jj] = (u32x2){0u, 0u}; }
            if (P1_VALID(j + 2 * NWAVES)) moe_info(F, 0, n + 2 * NWAVES, inf3, g3);
            if (P1_VALID(j + NWAVES)) { moe_gather_issue(F, inf2, w2);
#pragma unroll
                for (int q = 0; q < 4; ++q) x2[q] = *(const GAS u32x2*)(xs0 + (size_t)(n + NWAVES) * D + 4 * F.lane + 256 * q); }
            if (!vld) {
#pragma unroll
                for (int q = 0; q < 4; ++q) *(LAS f32x4*)(hs + j * 1028 + 4 * F.lane + 256 * q) = (f32x4){0.f, 0.f, 0.f, 0.f};
            } else {
                f32x4 mo[4], v[4]; float s = 0.f; moe_gather_sum(w1, g1, mo);
#pragma unroll
                for (int q = 0; q < 4; ++q) { const int c = 4 * F.lane + 256 * q; v[q] = (f32x4){bf_lo(x1[q].x), bf_hi(x1[q].x), bf_lo(x1[q].y), bf_hi(x1[q].y)} + *(const GAS f32x4*)(gate5 + c) * mo[q];
                    s += v[q][0] * v[q][0] + v[q][1] * v[q][1] + v[q][2] * v[q][2] + v[q][3] * v[q][3]; }
                if (j >= 1 && j <= cnt) {
#pragma unroll
                    for (int q = 0; q < 4; ++q) stx4(xs1 + (size_t)n * D + 4 * F.lane + 256 * q, v[q]); }
                s = wave_sum(s); const float r = 1.0f / sqrtf(s * (1.0f / D) + NORM_EPS);
#pragma unroll
                for (int q = 0; q < 4; ++q) { const int c = 4 * F.lane + 256 * q; const f32x4 g = *(const GAS f32x4*)(ng + c), a = *(const GAS f32x4*)(sc + c), b = *(const GAS f32x4*)(sh + c);
                    *(LAS f32x4*)(hs + j * 1028 + c) = v[q] * r * g * (a + 1.0f) + b; }
            }
#pragma unroll
            for (int jj = 0; jj < 4; ++jj) { g1[jj] = g2[jj]; g2[jj] = g3[jj]; inf2[jj] = inf3[jj]; x1[jj] = x2[jj];
#pragma unroll
                for (int q = 0; q < 4; ++q) w1[jj][q] = w2[jj][q]; }
          }
#undef P1_VALID
        }
        __syncthreads();
#pragma unroll 1
        for (int q4 = 0; q4 < 4; ++q4) { const int t = F.wave * 4 + q4, j = t + 1, n = n0 + t; const int c0 = 16 * F.lane;
            if (t >= cnt) break;
            f32x4 h0[4], xx[4];
#pragma unroll
            for (int q = 0; q < 4; ++q) { const int c = c0 + 4 * q;
                const f32x4 hm = *(const LAS f32x4*)(hs + (j - 1) * 1028 + c), hp = *(const LAS f32x4*)(hs + (j + 1) * 1028 + c); h0[q] = *(const LAS f32x4*)(hs + j * 1028 + c);
                xx[q] = (hm + hp) * 0.5f - h0[q]; }
#pragma unroll
            for (int i = 0; i < 6; ++i) { u32x4 w; unsigned wq[4];
#pragma unroll
                for (int q = 0; q < 4; ++q) { const f32x4 mu = *(const GAS f32x4*)(A.in[I_MU] + (size_t)i * D + c0 + 4 * q); const f32x4 o = h0[q] + xx[q] * mu; wq[q] = pk4_fp8(o[0], o[1], o[2], o[3]); }
                w.x = wq[0]; w.y = wq[1]; w.z = wq[2]; w.w = wq[3];
                *(GAS u32x4*)(F.ws + WS_MIX + (size_t)i * NTOK * D + (size_t)n * D + c0) = w; } }
        __syncthreads();
    }
}

struct SchedProj {
    static constexpr bool SIDE = false; static constexpr bool XSYNC = false; static constexpr bool GATHER = false;
    int G, vcu; int nt; unsigned ldb;
    __device__ __forceinline__ bool next(int i, GU& u) const { int L = i * G + vcu; if (L >= 1940) return false;
        int kind, mi, wi, pm, pn;
        if (L < 512) { kind = 0; mi = 0; wi = 0; pm = L >> 2; pn = L & 3; }
        else if (L < 1032) { L -= 512; kind = 0; mi = 2; wi = 1; pm = L >> 2; pn = L & 3; }
        else if (L < 1552) { L -= 1032; kind = 0; mi = 3; wi = 2; pm = L >> 2; pn = L & 3; }
        else if (L < 1682) { L -= 1552; kind = 1; mi = 1; wi = 0; pm = L; pn = 0; }
        else if (L < 1812) { L -= 1682; kind = 2; mi = 4; wi = 1; pm = L; pn = 0; }
        else { L -= 1812; kind = 3; mi = 5; wi = 2; pm = L; pn = 0; }
        u.a = (unsigned)(WS_MIX + (size_t)mi * NTOK * D + (size_t)pm * 256 * D);
        u.b = kind == 0 ? (unsigned)(WS_WRKV + ((size_t)wi * 1024 + pn * 256) * 1024) : (unsigned)(WS_WL1 + (size_t)wi * 256 * 1024);
        u.i0 = pm; u.i1 = pn; u.i2 = kind; u.i3 = wi; return true; }
    __device__ __forceinline__ void aoff(const GU&, const int (&R)[2], const int (&C)[2], unsigned (&v)[2][2]) const {
#pragma unroll
        for (int h = 0; h < 2; ++h)
#pragma unroll
            for (int i = 0; i < 2; ++i) v[h][i] = (unsigned)((h * 128 + R[i]) * D + 2 * C[i]); }
};
struct EpiProj {
    static constexpr bool FP8 = true; static constexpr bool PERM = true;
    unsigned char* ws;
    __device__ __forceinline__ void operator()(const f32x4 (&acc)[2][2][4][2], const GU& u, int wr, int wc, int fr, int fq, const LAS float* sb) const {
        const int pm = u.i0, pn = u.i1, kind = u.i2, wi = u.i3;
        if (kind == 0) { bf16_t* o = (bf16_t*)(ws + WS_RKV + (size_t)wi * ACTB); const int col0 = pn * 256 + wc * 32 + 8 * fq;
#pragma unroll
            for (int ai = 0; ai < 2; ++ai)
#pragma unroll
                for (int m = 0; m < 4; ++m) { const size_t n = (size_t)pm * 256 + ai * 128 + wr * 64 + m * 16 + fr;
#pragma unroll
                    for (int bj = 0; bj < 2; ++bj) { const f32x4 v0 = acc[ai][bj][m][0], v1 = acc[ai][bj][m][1];
                        u32x4 w; w.x = cvt_pk_bf16(v0[0], v0[1]); w.y = cvt_pk_bf16(v0[2], v0[3]); w.z = cvt_pk_bf16(v1[0], v1[1]); w.w = cvt_pk_bf16(v1[2], v1[3]);
                        *(GAS u32x4*)(o + n * D + col0 + bj * 128) = w; } }
        } else { bf16_t* o = (bf16_t*)(ws + WS_LACT + (size_t)(kind - 1) * NTOK * 128 * 2); const int col0 = wc * 32 + 8 * fq;
#pragma unroll
            for (int ai = 0; ai < 2; ++ai)
#pragma unroll
                for (int m = 0; m < 4; ++m) { const size_t n = (size_t)pm * 256 + ai * 128 + wr * 64 + m * 16 + fr; float t[8];
#pragma unroll
                    for (int nn = 0; nn < 2; ++nn)
#pragma unroll
                        for (int j = 0; j < 4; ++j) { const float x = acc[ai][0][m][nn][j]; t[4 * nn + j] = kind == 1 ? tanhf(x) : (kind == 2 ? x : sigmoidf_(x)); }
                    u32x4 w; w.x = cvt_pk_bf16(t[0], t[1]); w.y = cvt_pk_bf16(t[2], t[3]); w.z = cvt_pk_bf16(t[4], t[5]); w.w = cvt_pk_bf16(t[6], t[7]);
                    *(GAS u32x4*)(o + n * 128 + col0) = w; } }
    }
};
struct SchedLora2 {
    static constexpr bool SIDE = false; static constexpr bool XSYNC = false; static constexpr bool GATHER = false;
    int G, vcu; int nt; unsigned ldb;
    __device__ __forceinline__ bool next(int i, GU& u) const { int L = i * G + vcu; if (L >= 4 * 520 + 512) return false;
        const int o = L < 2080 ? L / 520 : 4; L -= o * 520; const int pm = L >> 2, pn = L & 3; const int oa = o < 4 ? (o >> 1) : 2;
        u.a = (unsigned)(WS_LACT + (size_t)oa * NTOK * 128 * 2 + (size_t)pm * 256 * 128 * 2); u.b = (unsigned)(WS_WL2 + ((size_t)o * 1024 + pn * 256) * 128 * 2);
        u.i0 = pm; u.i1 = pn; u.i2 = o; u.i3 = 0; return true; }
    __device__ __forceinline__ void aoff(const GU&, const int (&R)[2], const int (&C)[2], unsigned (&v)[2][2]) const {
#pragma unroll
        for (int h = 0; h < 2; ++h)
#pragma unroll
            for (int i = 0; i < 2; ++i) v[h][i] = (unsigned)((h * 128 + R[i]) * 128 + C[i]) * 2u; }
};
struct EpiLora2 {
    static constexpr bool FP8 = false; static constexpr bool PERM = true;
    unsigned char* ws; const float* w0; const float* a0;
    __device__ __forceinline__ void operator()(const f32x4 (&acc)[2][2][4][2], const GU& u, int wr, int wc, int fr, int fq, const LAS float* sb) const {
        const int pm = u.i0, pn = u.i1, o = u.i2; const int col0 = pn * 256 + wc * 32 + 8 * fq;
        const float* bp = (o < 2 ? w0 + (size_t)o * D : a0 + (size_t)(o & 1) * D) + col0; const float bsc = o < 4 ? 1.0f : 0.0f;
        f32x4 bv[2][2];
#pragma unroll
        for (int bj = 0; bj < 2; ++bj)
#pragma unroll
            for (int n = 0; n < 2; ++n) bv[bj][n] = *(const GAS f32x4*)(bp + bj * 128 + n * 4) * bsc;
        const size_t row0 = (size_t)pm * 256 + wr * 64 + fr;
        if (o < 2) { bf16_t* dst = (bf16_t*)(ws + WS_DEC + (size_t)o * ACTB) + row0 * D + col0;
#pragma unroll
            for (int ai = 0; ai < 2; ++ai)
#pragma unroll
                for (int m = 0; m < 4; ++m)
#pragma unroll
                    for (int bj = 0; bj < 2; ++bj) { float t[8];
#pragma unroll
                        for (int nn = 0; nn < 2; ++nn) { const f32x4 z = acc[ai][bj][m][nn] + bv[bj][nn];
#pragma unroll
                            for (int j = 0; j < 4; ++j) t[4 * nn + j] = -0.87503527f * sigmoidf_(z[j]); }
                        u32x4 w; w.x = cvt_pk_bf16(t[0], t[1]); w.y = cvt_pk_bf16(t[2], t[3]); w.z = cvt_pk_bf16(t[4], t[5]); w.w = cvt_pk_bf16(t[6], t[7]);
                        *(GAS u32x4*)(dst + (size_t)(ai * 128 + m * 16) * D + bj * 128) = w; }
        } else { bf16_t* dst = (o < 4 ? (bf16_t*)(ws + WS_ICL + (size_t)(o - 2) * ACTB) : (bf16_t*)(ws + WS_G)) + row0 * D + col0; const bool sg = o < 4;
#pragma unroll
            for (int ai = 0; ai < 2; ++ai)
#pragma unroll
                for (int m = 0; m < 4; ++m)
#pragma unroll
                    for (int bj = 0; bj < 2; ++bj) { float t[8];
#pragma unroll
                        for (int nn = 0; nn < 2; ++nn) { const f32x4 z = acc[ai][bj][m][nn] + bv[bj][nn];
#pragma unroll
                            for (int j = 0; j < 4; ++j) t[4 * nn + j] = sg ? sigmoidf_(z[j]) : z[j]; }
                        u32x4 w; w.x = cvt_pk_bf16(t[0], t[1]); w.y = cvt_pk_bf16(t[2], t[3]); w.z = cvt_pk_bf16(t[4], t[5]); w.w = cvt_pk_bf16(t[6], t[7]);
                        *(GAS u32x4*)(dst + (size_t)(ai * 128 + m * 16) * D + bj * 128) = w; }
        }
    }
};
__device__ __forceinline__ void ld16bf(const bf16_t* p, float (&o)[16]) { const u32x4 a = *(const GAS u32x4*)p, b = *(const GAS u32x4*)(p + 8);
    o[0] = bf_lo(a.x); o[1] = bf_hi(a.x); o[2] = bf_lo(a.y); o[3] = bf_hi(a.y); o[4] = bf_lo(a.z); o[5] = bf_hi(a.z); o[6] = bf_lo(a.w); o[7] = bf_hi(a.w);
    o[8] = bf_lo(b.x); o[9] = bf_hi(b.x); o[10] = bf_lo(b.y); o[11] = bf_hi(b.y); o[12] = bf_lo(b.z); o[13] = bf_hi(b.z); o[14] = bf_lo(b.w); o[15] = bf_hi(b.w); }
__device__ __forceinline__ void st16bf(bf16_t* p, const float (&o)[16]) { u32x4 a, b;
    a.x = cvt_pk_bf16(o[0], o[1]); a.y = cvt_pk_bf16(o[2], o[3]); a.z = cvt_pk_bf16(o[4], o[5]); a.w = cvt_pk_bf16(o[6], o[7]);
    b.x = cvt_pk_bf16(o[8], o[9]); b.y = cvt_pk_bf16(o[10], o[11]); b.z = cvt_pk_bf16(o[12], o[13]); b.w = cvt_pk_bf16(o[14], o[15]);
    *(GAS u32x4*)p = a; *(GAS u32x4*)(p + 8) = b; }
__device__ __forceinline__ void ld16f(const float* p, float (&o)[16]) {
#pragma unroll
    for (int q = 0; q < 4; ++q) { const f32x4 v = *(const GAS f32x4*)(p + 4 * q); o[4 * q] = v[0]; o[4 * q + 1] = v[1]; o[4 * q + 2] = v[2]; o[4 * q + 3] = v[3]; } }
__device__ __forceinline__ void phase_fin(const Frame& F, const Args& A) {
    const int gw = blockIdx.x * NWAVES + F.wave, NGW = F.G * NWAVES; const int c0 = 16 * F.lane;
    float kkw[16]; ld16f(A.in[I_KK] + c0, kkw);
    const bf16_t* Kp = (const bf16_t*)(F.ws + WS_RKV + 1 * ACTB);
    for (int n = gw; n < NTOK; n += NGW) { const size_t off = (size_t)n * D + c0; float k[16];
        ld16bf(Kp + off, k);
        float ss = 0.f;
#pragma unroll
        for (int j = 0; j < 16; ++j) { const float kk = k[j] * kkw[j]; ss += kk * kk; }
        ss = dpp_xadd(ss, 0); ss = dpp_xadd(ss, 1);
        const float inv = 1.0f / fmaxf(sqrtf(ss), 1e-12f);
        if ((F.lane & 3) == 0) ((float*)(F.ws + WS_KK))[(size_t)n * 16 + (F.lane >> 2)] = inv;
    }
}
constexpr int CK = 32, SNS = CT + TSEQ, CNCH = SNS / CK;
constexpr int RS = 144, TS = 80;
constexpr int OS_A = 0, OS_R = 4608, OS_KT = 9216, OS_BT = 14336, OS_VT = 19456, OS_GAM = 20736, OS_BYTES = 20992;
constexpr int OG_B = 0, OG_K = 4608, OG_BYTES = 9216;
constexpr int GM_KA = 0, GM_KR = 2560, GM_BR = 5120, GM_TT = 7680, GM_BYTES = 10240;
constexpr int RAW_V = 4 * 4096, RAW_INV = RAW_V + 1024, RAW_BYTES = RAW_INV + 256, NRAW = 4;
constexpr int L_OS = 0, L_OG = 2 * OS_BYTES, L_GM = L_OG + 2 * OG_BYTES, L_RAW = L_GM + 2 * GM_BYTES, L_SCAN_END = L_RAW + NRAW * RAW_BYTES;
static_assert(L_SCAN_END <= SCR_BYTES, "scan LDS");
__device__ __forceinline__ int scan_token(int sg, int d, int b) { if (sg < CT) { const int t = d ? (CT - 1 - sg) : sg; return NL + b * CT + t; } const int u = sg - CT; const int t = d ? (TSEQ - 1 - u) : u; return b * TSEQ + t; }
__device__ __forceinline__ unsigned short f2bf(float f) { return (unsigned short)(cvt_pk_bf16(f, 0.f) & 0xffffu); }
__device__ __forceinline__ int acc_row(int p, int lane) { return (p & 3) + 8 * (p >> 2) + 4 * (lane >> 5); }
__device__ __forceinline__ void st_acc32(LAS unsigned char* dst, const f32x16& a, int lane) {
#pragma unroll
    for (int p = 0; p < 16; ++p) *(LAS unsigned short*)(dst + acc_row(p, lane) * TS + 2 * (lane & 31)) = f2bf(a[p]);
}
__device__ __forceinline__ void st_acc32_t(LAS unsigned char* dst, const f32x16& a, int lane) {
#pragma unroll
    for (int g = 0; g < 4; ++g) { u32x2 w; w.x = cvt_pk_bf16(a[4 * g], a[4 * g + 1]); w.y = cvt_pk_bf16(a[4 * g + 2], a[4 * g + 3]); *(LAS u32x2*)(dst + (lane & 31) * TS + 2 * (8 * g + 4 * (lane >> 5))) = w; }
}
__device__ __forceinline__ bf16x8 acc_bfrag(const f32x16& a, int s) { u32x4 w; w.x = cvt_pk_bf16(a[8 * s + 0], a[8 * s + 1]); w.y = cvt_pk_bf16(a[8 * s + 2], a[8 * s + 3]); w.z = cvt_pk_bf16(a[8 * s + 4], a[8 * s + 5]); w.w = cvt_pk_bf16(a[8 * s + 6], a[8 * s + 7]); return __builtin_bit_cast(bf16x8, w); }
__device__ __forceinline__ bf16x8 lds_afrag_perm(const LAS unsigned char* m, int s, int lane) { const LAS unsigned char* p = m + (lane & 31) * TS + 2 * (16 * s + 4 * (lane >> 5));
    const u32x2 lo = *(const LAS u32x2*)p, hi = *(const LAS u32x2*)(p + 16); u32x4 w; w.x = lo.x; w.y = lo.y; w.z = hi.x; w.w = hi.y; return __builtin_bit_cast(bf16x8, w); }
__device__ __forceinline__ bf16x8 ld2x8(const LAS unsigned char* p0, const LAS unsigned char* p1) { const u32x2 lo = *(const LAS u32x2*)p0, hi = *(const LAS u32x2*)p1; return __builtin_bit_cast(bf16x8, (u32x4){lo.x, lo.y, hi.x, hi.y}); }
__device__ __forceinline__ f32x16 gram32(const LAS unsigned char* P, const LAS unsigned char* Q, int lane) {
    f32x16 c;
#pragma unroll
    for (int p = 0; p < 16; ++p) c[p] = 0.f;
#pragma unroll
    for (int s = 0; s < 4; ++s) { const bf16x8 a = *(const LAS bf16x8*)(P + (lane & 31) * RS + 32 * s + 16 * (lane >> 5)), b = *(const LAS bf16x8*)(Q + (lane & 31) * RS + 32 * s + 16 * (lane >> 5));
        c = __builtin_amdgcn_mfma_f32_32x32x16_bf16(a, b, c, 0, 0, 0); }
    return c;
}
__device__ __forceinline__ void phase_scan(const Frame& F, const Args& A) {
    LAS unsigned char* lds = F.scr;
    const int lane = F.lane, wave = F.wave;
    const __amdgpu_buffer_rsrc_t rsrc = __builtin_amdgcn_make_buffer_rsrc((void*)F.ws, 0, 0xffffffff, 0x00020000);
    for (int job_ = F.vcu; job_ < 256; job_ += F.G) {
        const int job = __builtin_amdgcn_readfirstlane(job_);
        const int sd = job >> 2, rq = job & 3, d = sd & 1, bh = sd >> 1, b = bh >> 4, hd = bh & 15;
        f32x4 Xa[4];
#pragma unroll
        for (int t = 0; t < 4; ++t) Xa[t] = (f32x4){0.f, 0.f, 0.f, 0.f};
        const int pj = (wave - 3) & 3;
        const bool is_prep = wave >= 3 && wave <= 6;
        const float kkw_l = A.in[I_KK][hd * 64 + 16 * pj + (lane & 15)];
        const float ka_l = A.in[I_KA][hd * 64 + 16 * pj + (lane & 15)];
        const unsigned dma_v = (unsigned)((d ? 7 - (lane >> 3) : (lane >> 3)) * (D * 2) + (lane & 7) * 16), dma_vv = (unsigned)((d ? 31 - (lane >> 1) : (lane >> 1)) * (D * 2) + (lane & 1) * 16), dma_vi = (unsigned)((d ? 31 - (lane & 31) : (lane & 31)) * 64);
#define SCAN_DMA(c) do { const int c_ = (c); LAS unsigned char* raw_ = lds + L_RAW + (c_ & (NRAW - 1)) * RAW_BYTES; const int n0_ = scan_token(c_ * CK, d, b); \
            _Pragma("unroll") for (int g = 0; g < 4; ++g) { const unsigned so_ = (unsigned)(d ? n0_ - 8 * g - 7 : n0_ + 8 * g) * (unsigned)(D * 2) + (unsigned)(hd * 128); \
                __builtin_amdgcn_raw_ptr_buffer_load_lds(rsrc, (LAS void*)(raw_ + 0 * 4096 + g * 1024), 16, (int)dma_v, (int)(so_ + (unsigned)(WS_DEC + (size_t)d * ACTB)), 0, 0); \
                __builtin_amdgcn_raw_ptr_buffer_load_lds(rsrc, (LAS void*)(raw_ + 1 * 4096 + g * 1024), 16, (int)dma_v, (int)(so_ + (unsigned)(WS_ICL + (size_t)d * ACTB)), 0, 0); \
                __builtin_amdgcn_raw_ptr_buffer_load_lds(rsrc, (LAS void*)(raw_ + 2 * 4096 + g * 1024), 16, (int)dma_v, (int)(so_ + (unsigned)(WS_RKV + ACTB)), 0, 0); \
                if (c_ >= CT / CK) __builtin_amdgcn_raw_ptr_buffer_load_lds(rsrc, (LAS void*)(raw_ + 3 * 4096 + g * 1024), 16, (int)dma_v, (int)(so_ + (unsigned)WS_RKV), 0, 0); } \
            { const unsigned so_ = (unsigned)(d ? n0_ - 31 : n0_) * (unsigned)(D * 2) + (unsigned)(hd * 128 + rq * 32) + (unsigned)(WS_RKV + 2 * ACTB); \
              __builtin_amdgcn_raw_ptr_buffer_load_lds(rsrc, (LAS void*)(raw_ + RAW_V), 16, (int)dma_vv, (int)so_, 0, 0); } \
            { const unsigned so_ = (unsigned)(d ? n0_ - 31 : n0_) * 64u + (unsigned)(hd * 4) + (unsigned)WS_KK; \
              __builtin_amdgcn_raw_ptr_buffer_load_lds(rsrc, (LAS void*)(raw_ + RAW_INV), 4, (int)dma_vi, (int)so_, 0, 0); } } while (0)
        __syncthreads();
        if (wave == 7) { SCAN_DMA(0); SCAN_DMA(1); asm volatile("s_waitcnt vmcnt(0)" ::: "memory"); SCAN_DMA(2); }
        __syncthreads();
#define SCAN_BAR() do { asm volatile("s_waitcnt lgkmcnt(0)" ::: "memory"); __builtin_amdgcn_s_barrier(); asm volatile("" ::: "memory"); } while (0)
        long long tbusy = 0; long long tloop0_ = 0; if (SCAN_TSEL == 8) tloop0_ = clock64();
        if (wave != 0) for (int it = -2; it < CNCH; ++it) {
            const int cg = it + 1, cp = it + 2;
            long long t0_ = 0; if (SCAN_TSEL >= 0) t0_ = clock64();
            if (is_prep) {
                __builtin_amdgcn_s_setprio(2);
                if (cp < CNCH) {
                    const LAS unsigned char* raw = lds + L_RAW + (cp & (NRAW - 1)) * RAW_BYTES;
                    LAS unsigned char* os = lds + L_OS + (cp & 1) * OS_BYTES; LAS unsigned char* og = lds + L_OG + (cp & 1) * OG_BYTES;
                    const int rg = lane >> 4, ch = 16 * pj + (lane & 15);
                    unsigned short rlw_[8], ric_[8], rkx_[8], rr_[8];
#pragma unroll
                    for (int j = 0; j < 8; ++j) { const LAS unsigned char* p = raw + (8 * rg + j) * 128 + 2 * ch; rlw_[j] = *(const LAS unsigned short*)p; ric_[j] = *(const LAS unsigned short*)(p + 4096);
                        rkx_[j] = *(const LAS unsigned short*)(p + 8192); rr_[j] = *(const LAS unsigned short*)(p + 12288); }
                    const f32x4 inv0 = *(const LAS f32x4*)(raw + RAW_INV + 32 * rg), inv1 = *(const LAS f32x4*)(raw + RAW_INV + 32 * rg + 16);
                    __builtin_amdgcn_sched_barrier(0);
                    float S = 0.f, lwv[8];
#pragma unroll
                    for (int j = 0; j < 8; ++j) { lwv[j] = bf2f(rlw_[j]); S += lwv[j]; }
                    const float S1 = __builtin_bit_cast(float, __builtin_amdgcn_ds_bpermute(((lane + 16) & 63) * 4, __builtin_bit_cast(int, S)));
                    const float S2 = __builtin_bit_cast(float, __builtin_amdgcn_ds_bpermute(((lane + 32) & 63) * 4, __builtin_bit_cast(int, S)));
                    const float S3 = __builtin_bit_cast(float, __builtin_amdgcn_ds_bpermute(((lane + 48) & 63) * 4, __builtin_bit_cast(int, S)));
                    const float Ltot = (S + S1) + (S2 + S3), Lpre = (rg >= 3 ? S1 : 0.f) + (rg >= 2 ? S2 : 0.f) + (rg >= 1 ? S3 : 0.f);
                    const float gam = __builtin_amdgcn_exp2f(Ltot);
                    if (rg == 0) *(LAS float*)(os + OS_GAM + 4 * ch) = gam;
                    float Lr = Lpre, ep_prev = __builtin_amdgcn_exp2f(Lpre); float kt[8], bt[8]; const bool has_r = cp >= CT / CK;
#pragma unroll
                    for (int j = 0; j < 8; ++j) { const int m = 8 * rg + j; Lr += lwv[j];
                        const float ep = __builtin_amdgcn_exp2f(Lr), em = __builtin_amdgcn_rcpf(ep);
                        const float icl = bf2f(ric_[j]), kx = bf2f(rkx_[j]), r = has_r ? bf2f(rr_[j]) : 0.f, kk = kx * kkw_l * (j < 4 ? inv0[j & 3] : inv1[j & 3]);
                        const float bb = kk * icl, kd = kx * (1.0f + (icl - 1.0f) * ka_l);
                        const f32x2 ar = (f32x2){kk, r} * (f32x2){ep_prev, ep}, bk = (f32x2){bb, kd} * em, tb = (f32x2){bk[1], bk[0]} * (f32x2){gam, -gam};
                        const unsigned w1 = cvt_pk_bf16(ar[0], ar[1]), w2 = cvt_pk_bf16(bk[0], bk[1]);
                        *(LAS unsigned short*)(os + OS_A + m * RS + 2 * ch) = (unsigned short)(w1 & 0xffffu);
                        *(LAS unsigned short*)(os + OS_R + m * RS + 2 * ch) = (unsigned short)(w1 >> 16);
                        *(LAS unsigned short*)(og + OG_B + m * RS + 2 * ch) = (unsigned short)(w2 & 0xffffu);
                        *(LAS unsigned short*)(og + OG_K + m * RS + 2 * ch) = (unsigned short)(w2 >> 16);
                        kt[j] = tb[0]; bt[j] = tb[1]; ep_prev = ep; }
#pragma unroll
                    for (int g = 0; g < 2; ++g) { u32x2 w; w.x = cvt_pk_bf16(kt[4 * g], kt[4 * g + 1]); w.y = cvt_pk_bf16(kt[4 * g + 2], kt[4 * g + 3]);
                        *(LAS u32x2*)(os + OS_KT + ch * TS + 2 * (8 * rg + 4 * g)) = w;
                        w.x = cvt_pk_bf16(bt[4 * g], bt[4 * g + 1]); w.y = cvt_pk_bf16(bt[4 * g + 2], bt[4 * g + 3]);
                        *(LAS u32x2*)(os + OS_BT + ch * TS + 2 * (8 * rg + 4 * g)) = w; }
                }
                __builtin_amdgcn_s_setprio(0);
            } else if (wave == 7) {
                const int c5 = it + 5;
                if (c5 < CNCH) SCAN_DMA(c5);
                if (cp < CNCH) { const LAS unsigned char* raw = lds + L_RAW + (cp & (NRAW - 1)) * RAW_BYTES; LAS unsigned char* os = lds + L_OS + (cp & 1) * OS_BYTES;
                    unsigned short rv[8];
#pragma unroll
                    for (int j = 0; j < 8; ++j) rv[j] = *(const LAS unsigned short*)(raw + RAW_V + (8 * (lane >> 4) + j) * 32 + 2 * (lane & 15));
                    u32x4 w; w.x = (unsigned)rv[0] | ((unsigned)rv[1] << 16); w.y = (unsigned)rv[2] | ((unsigned)rv[3] << 16); w.z = (unsigned)rv[4] | ((unsigned)rv[5] << 16); w.w = (unsigned)rv[6] | ((unsigned)rv[7] << 16);
                    *(LAS u32x4*)(os + OS_VT + (lane & 15) * TS + 16 * (lane >> 4)) = w; }
                if (cg >= 0 && cg < CNCH) {
                    f32x16 c = gram32(lds + L_OG + (cg & 1) * OG_BYTES + OG_B, lds + L_OS + (cg & 1) * OS_BYTES + OS_R, lane);
#pragma unroll
                    for (int p = 0; p < 16; ++p) c[p] = acc_row(p, lane) <= (lane & 31) ? -c[p] : 0.f;
                    st_acc32_t(lds + L_GM + (cg & 1) * GM_BYTES + GM_BR, c, lane);
                }
                { const int n1_ = (it + 4 >= 0 && it + 4 < CNCH) ? ((it + 4 >= CT / CK) ? 18 : 14) : 0, n2_ = (c5 < CNCH) ? ((c5 >= CT / CK) ? 18 : 14) : 0;
                  switch (n1_ + n2_) { case 36: asm volatile("s_waitcnt vmcnt(36)" ::: "memory"); break; case 32: asm volatile("s_waitcnt vmcnt(32)" ::: "memory"); break; case 28: asm volatile("s_waitcnt vmcnt(28)" ::: "memory"); break;
                      case 18: asm volatile("s_waitcnt vmcnt(18)" ::: "memory"); break; case 14: asm volatile("s_waitcnt vmcnt(14)" ::: "memory"); break; default: asm volatile("s_waitcnt vmcnt(0)" ::: "memory"); break; } }
            } else if (wave == 2) {
                if (cg >= 0 && cg < CNCH) {
                    const LAS unsigned char* os = lds + L_OS + (cg & 1) * OS_BYTES; const LAS unsigned char* og = lds + L_OG + (cg & 1) * OG_BYTES; LAS unsigned char* gm = lds + L_GM + (cg & 1) * GM_BYTES;
                    bf16x8 fk[4], fa[4], fr[4]; const int fo = (lane & 31) * RS + 16 * (lane >> 5);
#pragma unroll
                    for (int s4 = 0; s4 < 4; ++s4) { fk[s4] = *(const LAS bf16x8*)(og + OG_K + fo + 32 * s4); fa[s4] = *(const LAS bf16x8*)(os + OS_A + fo + 32 * s4); fr[s4] = *(const LAS bf16x8*)(os + OS_R + fo + 32 * s4); }
                    f32x16 c0, c1;
#pragma unroll
                    for (int p = 0; p < 16; ++p) { c0[p] = 0.f; c1[p] = 0.f; }
#pragma unroll
                    for (int s4 = 0; s4 < 4; ++s4) { c0 = __builtin_amdgcn_mfma_f32_32x32x16_bf16(fk[s4], fa[s4], c0, 0, 0, 0); c1 = __builtin_amdgcn_mfma_f32_32x32x16_bf16(fk[s4], fr[s4], c1, 0, 0, 0); }
#pragma unroll
                    for (int p = 0; p < 16; ++p) c0[p] = acc_row(p, lane) < (lane & 31) ? c0[p] : 0.f;
                    st_acc32_t(gm + GM_KA, c0, lane);
#pragma unroll
                    for (int p = 0; p < 16; ++p) c1[p] = acc_row(p, lane) <= (lane & 31) ? c1[p] : 0.f;
                    st_acc32_t(gm + GM_KR, c1, lane);
                }
            } else if (wave == 1) {
                if (cg >= 0 && cg < CNCH) {
                    const LAS unsigned char* os = lds + L_OS + (cg & 1) * OS_BYTES; const LAS unsigned char* og = lds + L_OG + (cg & 1) * OG_BYTES; LAS unsigned char* gm = lds + L_GM + (cg & 1) * GM_BYTES;
                    const int c16 = lane & 15, q = lane >> 4;
                    typedef short s4 __attribute__((ext_vector_type(4)));
#define P4(v) __builtin_bit_cast(s4, (u32x2){cvt_pk_bf16((v)[0], (v)[1]), cvt_pk_bf16((v)[2], (v)[3])})
#define MM16(a, b, c) __builtin_amdgcn_mfma_f32_16x16x16bf16_1k((a), (b), (c), 0, 0, 0)
#define GRAM16(P, p0, Q, q0, out) do { f32x4 c_ = {0.f, 0.f, 0.f, 0.f}; _Pragma("unroll") for (int s_ = 0; s_ < 2; ++s_) \
                        c_ = __builtin_amdgcn_mfma_f32_16x16x32_bf16(*(const LAS bf16x8*)((P) + ((p0) + c16) * RS + 64 * s_ + 16 * q), *(const LAS bf16x8*)((Q) + ((q0) + c16) * RS + 64 * s_ + 16 * q), c_, 0, 0, 0); (out) = c_; } while (0)
                    const LAS unsigned char* PA = os + OS_A; const LAS unsigned char* PB = og + OG_B;
                    f32x4 X1, Xt1, X2, Xt2, L21t, R1, R2, Rt2; const f32x4 z4 = {0.f, 0.f, 0.f, 0.f};
                    GRAM16(PA, 0, PB, 0, X1); GRAM16(PB, 0, PA, 0, Xt1); GRAM16(PA, 16, PB, 16, X2); GRAM16(PB, 16, PA, 16, Xt2); GRAM16(PB, 0, PA, 16, L21t);
#pragma unroll
                    for (int j = 0; j < 4; ++j) { const int row = 4 * q + j; const float dg = (row == c16) ? 1.f : 0.f;
                        X1[j] = c16 < row ? -X1[j] : 0.f; X2[j] = c16 < row ? -X2[j] : 0.f; Xt1[j] = row < c16 ? -Xt1[j] : 0.f; Xt2[j] = row < c16 ? -Xt2[j] : 0.f;
                        R1[j] = X1[j] + dg; R2[j] = X2[j] + dg; Rt2[j] = Xt2[j] + dg; }
#pragma unroll
                    for (int lev = 0; lev < 4; ++lev) {
                        const s4 fx1 = P4(X1), fxt1 = P4(Xt1), fx2 = P4(X2), fxt2 = P4(Xt2);
                        if (lev >= 1) { R1 = MM16(fxt1, P4(R1), R1); R2 = MM16(fxt2, P4(R2), R2); Rt2 = MM16(fx2, P4(Rt2), Rt2); }
                        if (lev < 3) { const f32x4 n1 = MM16(fxt1, fx1, z4), nt1 = MM16(fx1, fxt1, z4), n2 = MM16(fxt2, fx2, z4), nt2 = MM16(fx2, fxt2, z4); X1 = n1; Xt1 = nt1; X2 = n2; Xt2 = nt2; }
                    }
                    const f32x4 W = MM16(P4(L21t), P4(R1), z4);
                    f32x4 T21 = MM16(P4(Rt2), P4(W), z4);
#pragma unroll
                    for (int j = 0; j < 4; ++j) { const int row = 4 * q + j;
                        *(LAS unsigned short*)(gm + GM_TT + row * TS + 2 * c16) = f2bf(R1[j]); *(LAS unsigned short*)(gm + GM_TT + row * TS + 2 * (16 + c16)) = (unsigned short)0;
                        *(LAS unsigned short*)(gm + GM_TT + (16 + row) * TS + 2 * c16) = f2bf(-T21[j]); *(LAS unsigned short*)(gm + GM_TT + (16 + row) * TS + 2 * (16 + c16)) = f2bf(R2[j]); }
#undef P4
#undef MM16
#undef GRAM16
                }
            }
            if (SCAN_TSEL >= 0) { tbusy += clock64() - t0_; }
            SCAN_BAR();
        }
        else {
#define PACK8(v0, v1) __builtin_bit_cast(bf16x8, (u32x4){cvt_pk_bf16((v0)[0], (v0)[1]), cvt_pk_bf16((v0)[2], (v0)[3]), cvt_pk_bf16((v1)[0], (v1)[1]), cvt_pk_bf16((v1)[2], (v1)[3])})
#define LD2(p) ld2x8((p), (p) + 32)
#define MF32(afrag, bfrag, c) __builtin_amdgcn_mfma_f32_16x16x32_bf16((afrag), (bfrag), (c), 0, 0, 0)
            const int r16 = lane & 15, q = lane >> 4;
            const unsigned y_v = (unsigned)((d ? 3 - q : q) * 4 * (D * 2) + r16 * 2);
            bf16x8 sV = {0, 0, 0, 0, 0, 0, 0, 0}, sA[2][2], sKT[4], sBT[4], sR[2][2]; f32x4 sG[4];
#pragma unroll
            for (int t = 0; t < 4; ++t) { sKT[t] = sV; sBT[t] = sV; sG[t] = (f32x4){0.f, 0.f, 0.f, 0.f}; }
#pragma unroll
            for (int ti = 0; ti < 2; ++ti) { sA[ti][0] = sV; sA[ti][1] = sV; sR[ti][0] = sV; sR[ti][1] = sV; }
            for (int it = -2; it < CNCH; ++it) {
                const int cs = it;
                long long t0_ = 0; if (SCAN_TSEL >= 0) t0_ = clock64();
                if (cs >= 0) {
                    const LAS unsigned char* gm = lds + L_GM + (cs & 1) * GM_BYTES; const bool emit = cs >= CT / CK;
                    const int n0s = scan_token(cs * CK, d, b);
                    bf16x8 aKA[2], aTT[2];
#pragma unroll
                    for (int ti = 0; ti < 2; ++ti) { const int i = 16 * ti + r16; aKA[ti] = *(const LAS bf16x8*)(gm + GM_KA + i * TS + 16 * q); aTT[ti] = LD2(gm + GM_TT + i * TS + 8 * q); }
                    const bf16x8 xb01 = PACK8(Xa[0], Xa[1]), xb23 = PACK8(Xa[2], Xa[3]);
                    f32x4 h[2];
#pragma unroll
                    for (int ti = 0; ti < 2; ++ti) { f32x4 c = {0.f, 0.f, 0.f, 0.f}; c = MF32(sA[ti][0], xb01, c); c = MF32(sA[ti][1], xb23, c); h[ti] = MF32(aKA[ti], sV, c); }
                    const bf16x8 hb = PACK8(h[0], h[1]);
                    f32x4 u[2];
#pragma unroll
                    for (int ti = 0; ti < 2; ++ti) { const f32x4 z = {0.f, 0.f, 0.f, 0.f}; u[ti] = MF32(aTT[ti], hb, z); }
                    const bf16x8 ub = PACK8(u[0], u[1]);
                    f32x4 Xn[4];
#pragma unroll
                    for (int t = 0; t < 4; ++t) { f32x4 c = Xa[t] * sG[t]; c = MF32(sKT[t], sV, c); Xn[t] = MF32(sBT[t], ub, c); }
                    if (emit) {
#pragma unroll
                        for (int ti = 0; ti < 2; ++ti) { const int i = 16 * ti + r16; f32x4 c = {0.f, 0.f, 0.f, 0.f};
                            c = MF32(sR[ti][0], xb01, c); c = MF32(sR[ti][1], xb23, c);
                            c = MF32(*(const LAS bf16x8*)(gm + GM_KR + i * TS + 16 * q), sV, c); c = MF32(LD2(gm + GM_BR + i * TS + 8 * q), ub, c);
#pragma unroll
                            for (int j = 0; j < 4; ++j) { const unsigned so = (unsigned)(d ? n0s - 16 * ti - j - 12 : n0s + 16 * ti + j) * (unsigned)(D * 2) + (unsigned)((hd * 64 + rq * 16) * 2) + (unsigned)(WS_YD + (size_t)d * NL * D * 2);
                                __builtin_amdgcn_raw_buffer_store_b16(f2bf(c[j]), rsrc, (int)y_v, (int)so, 0); } }
                    }
#pragma unroll
                    for (int t = 0; t < 4; ++t) Xa[t] = Xn[t];
                }
                if (cs + 1 >= 0 && cs + 1 < CNCH) {
                    const LAS unsigned char* os = lds + L_OS + ((cs + 1) & 1) * OS_BYTES;
                    sV = *(const LAS bf16x8*)(os + OS_VT + r16 * TS + 16 * q);
#pragma unroll
                    for (int ti = 0; ti < 2; ++ti) { const int i = 16 * ti + r16; sA[ti][0] = LD2(os + OS_A + i * RS + 8 * q); sA[ti][1] = LD2(os + OS_A + i * RS + 64 + 8 * q); }
#pragma unroll
                    for (int t = 0; t < 4; ++t) { const int k = 16 * t + r16; sG[t] = *(const LAS f32x4*)(os + OS_GAM + 4 * (16 * t + 4 * q)); sKT[t] = *(const LAS bf16x8*)(os + OS_KT + k * TS + 16 * q); sBT[t] = LD2(os + OS_BT + k * TS + 8 * q); }
                    if (cs + 1 >= CT / CK) {
#pragma unroll
                        for (int ti = 0; ti < 2; ++ti) { const int i = 16 * ti + r16; sR[ti][0] = LD2(os + OS_R + i * RS + 8 * q); sR[ti][1] = LD2(os + OS_R + i * RS + 64 + 8 * q); }
                    }
                }
                if (SCAN_TSEL >= 0) { tbusy += clock64() - t0_; }
                SCAN_BAR();
            }
#undef PACK8
#undef LD2
#undef MF32
        }
        if (SCAN_TSEL >= 0 && SCAN_TSEL < 8 && F.vcu == 0 && lane == 0 && wave == (SCAN_TSEL & 7)) *(long long*)(F.ws + WS_CTL + 49152) = tbusy;
        if (SCAN_TSEL == 8 && F.vcu == 0 && lane == 0 && wave == 0) *(long long*)(F.ws + WS_CTL + 49152) = (clock64() - tloop0_) / 2;
#undef SCAN_DMA
#undef SCAN_BAR
    }
}
__device__ __forceinline__ void phase_readout(const Frame& F, const Args& A) {
    const int gw = blockIdx.x * NWAVES + F.wave, NGW = F.G * NWAVES; const int c0 = 16 * F.lane;
    float lng[16], lnb[16], rk[16], kaw[16]; ld16f(A.in[I_LNG] + c0, lng); ld16f(A.in[I_LNB] + c0, lnb); ld16f(A.in[I_RK] + c0, rk); ld16f(A.in[I_KA] + c0, kaw);
    for (int n = gw; n < NL; n += NGW) { const size_t off = (size_t)n * D + c0; float y[16], t[16], r[16], kd[16], v[16], g[16], o[16];
        ld16bf((const bf16_t*)(F.ws + WS_YD) + off, y); ld16bf((const bf16_t*)(F.ws + WS_YD + (size_t)NL * D * 2) + off, t);
        float s = 0.f;
#pragma unroll
        for (int j = 0; j < 16; ++j) { y[j] += t[j]; s += y[j]; }
        s = dpp_xadd(s, 0); s = dpp_xadd(s, 1); const float m = s * (1.0f / 64.0f); float q = 0.f;
#pragma unroll
        for (int j = 0; j < 16; ++j) { y[j] -= m; q += y[j] * y[j]; }
        q = dpp_xadd(q, 0); q = dpp_xadd(q, 1); const float rs = 1.0f / sqrtf(q * (1.0f / 64.0f) + GN_EPS);
        ld16bf((const bf16_t*)(F.ws + WS_RKV) + off, r); ld16bf((const bf16_t*)(F.ws + WS_ICL) + off, kd); ld16bf((const bf16_t*)(F.ws + WS_ICL + ACTB) + off, t); ld16bf((const bf16_t*)(F.ws + WS_RKV + ACTB) + off, v);
        float bs = 0.f;
#pragma unroll
        for (int j = 0; j < 16; ++j) bs += r[j] * (v[j] * (2.0f + (kd[j] + t[j] - 2.0f) * kaw[j])) * rk[j];
        bs = dpp_xadd(bs, 0); bs = dpp_xadd(bs, 1);
        ld16bf((const bf16_t*)(F.ws + WS_RKV + 2 * ACTB) + off, v); ld16bf((const bf16_t*)(F.ws + WS_G) + off, g);
#pragma unroll
        for (int j = 0; j < 16; ++j) o[j] = (y[j] * rs * lng[j] + lnb[j] + bs * v[j]) * g[j];
        { u32x4 w; w.x = pk4_fp8(o[0], o[1], o[2], o[3]); w.y = pk4_fp8(o[4], o[5], o[6], o[7]); w.z = pk4_fp8(o[8], o[9], o[10], o[11]); w.w = pk4_fp8(o[12], o[13], o[14], o[15]);
          *(GAS u32x4*)(F.ws + WS_RO + off) = w; }
    }
}
struct SchedWo {
    static constexpr bool SIDE = false; static constexpr bool XSYNC = false; static constexpr bool GATHER = false;
    int G, vcu; int nt; unsigned ldb;
    __device__ __forceinline__ bool next(int i, GU& u) const { const int L = i * G + vcu; if (L >= 512) return false; const int pm = L >> 2, pn = L & 3;
        u.a = (unsigned)(WS_RO + (size_t)pm * 256 * D); u.b = (unsigned)(WS_WO + (size_t)pn * 256 * 1024); u.i0 = pm; u.i1 = pn; u.i2 = 0; u.i3 = 0; return true; }
    __device__ __forceinline__ void aoff(const GU&, const int (&R)[2], const int (&C)[2], unsigned (&v)[2][2]) const {
#pragma unroll
        for (int h = 0; h < 2; ++h)
#pragma unroll
            for (int i = 0; i < 2; ++i) v[h][i] = (unsigned)((h * 128 + R[i]) * D + 2 * C[i]); }
};
struct EpiWo {
    static constexpr bool FP8 = true; static constexpr bool PERM = true;
    const bf16_t* xin; bf16_t* xout; const float* gate_base;
    __device__ __forceinline__ void operator()(const f32x4 (&acc)[2][2][4][2], const GU& u, int wr, int wc, int fr, int fq, const LAS float* sb) const {
        const int pm = u.i0, pn = u.i1; const float* gate = gate_base + (size_t)(pm >> 6) * NMOD * D; const int col0 = pn * 256 + wc * 32 + 8 * fq;
        f32x4 gl[2][2];
#pragma unroll
        for (int bj = 0; bj < 2; ++bj)
#pragma unroll
            for (int n = 0; n < 2; ++n) gl[bj][n] = *(const GAS f32x4*)(gate + col0 + bj * 128 + n * 4);
#pragma unroll
        for (int ai = 0; ai < 2; ++ai)
#pragma unroll
            for (int m = 0; m < 4; ++m) { const size_t off = ((size_t)pm * 256 + ai * 128 + wr * 64 + m * 16 + fr) * D + col0;
#pragma unroll
                for (int bj = 0; bj < 2; ++bj) { const u32x4 xi = *(const GAS u32x4*)(xin + off + bj * 128);
                    const f32x4 v0 = (f32x4){bf_lo(xi.x), bf_hi(xi.x), bf_lo(xi.y), bf_hi(xi.y)} + gl[bj][0] * acc[ai][bj][m][0], v1 = (f32x4){bf_lo(xi.z), bf_hi(xi.z), bf_lo(xi.w), bf_hi(xi.w)} + gl[bj][1] * acc[ai][bj][m][1];
                    u32x4 w; w.x = cvt_pk_bf16(v0[0], v0[1]); w.y = cvt_pk_bf16(v0[2], v0[3]); w.z = cvt_pk_bf16(v1[0], v1[1]); w.w = cvt_pk_bf16(v1[2], v1[3]);
                    *(GAS u32x4*)(xout + off + bj * 128) = w; } }
    }
};

constexpr int NPHASES = 3;
__global__ void __launch_bounds__(NTHREADS, 2) fwd_kernel(Args args) {
    extern __shared__ __attribute__((aligned(16))) unsigned char lds_raw[];
    Frame F;
    F.lds = (LAS unsigned char*)lds_raw; F.scr = F.lds + SCR_OFF; F.ws = args.ws;
    F.tid = threadIdx.x; F.lane = F.tid & 63; F.wave = __builtin_amdgcn_readfirstlane(F.tid >> 6);
    F.G = gridDim.x; { const int bx = blockIdx.x; F.vcu = (F.G % 8 == 0) ? (bx % 8) * (F.G / 8) + bx / 8 : bx; }
    volatile LAS unsigned* MISC = (volatile LAS unsigned*)(F.lds + MISC_OFF);
    if (F.tid < 64) MISC[F.tid] = 0u;
    __syncthreads();
    const int lo = args.ph_lo, hi = args.ph_hi;
    XcdBarrier bar; bar.bar = (unsigned*)(F.ws + WS_CTL); bar.x = 0; bar.st = MISC + 8;
    if (hi - lo > 1) {
        unsigned* barw = (unsigned*)(F.ws + WS_CTL);
        bar.bar = barw; bar.x = xb_xcc_id(); bar.st = MISC + 8;
        if (F.tid == 0) {
            const unsigned rank = xb_add(&barw[XB_XCNT(bar.x)], 1u);
            unsigned nloc, nx; xcd_barrier_complete(barw, bar.x, nloc, nx); MISC[8] = nloc; MISC[9] = nx;
            unsigned pre = 0;
            for (unsigned j = 0; j < 16; ++j) { const unsigned c = xb_ld(&barw[XB_XCNT(j)]); if (j < bar.x) pre += c; }
            MISC[10] = pre + rank;
        }
        __syncthreads();
        F.vcu = (int)MISC[10];
    }
#define IN(k) (lo <= (k) && (k) < hi)
#define SEAM(k) do { if (IN(k) && IN((k) + 1)) xcd_barrier(bar); } while (0)
#define PH(k, ...) do { if (IN(k)) { __VA_ARGS__; if constexpr (((REPEAT_MASK >> (k)) & 1) != 0) { xcd_barrier(bar); __VA_ARGS__; } } SEAM(k); } while (0)
    PH(0, phase_prep(F, args));
    PH(1, phase_pre0(F, args));
    PH(2, { SchedPool S{F.G, F.vcu, 4, 512u};
            EpiPool E{args.in[I_X], args.in[I_CTX], args.in[I_POOLLS], modp(F, 0, 0, 2), (bf16_t*)(F.ws + WS_XS0)};
            pg8::gemm_phase<EpiPool, SchedPool>(F.scr, F.ws, S, E); });
    PH(3, phase_post(F, args, 0, (const bf16_t*)(F.ws + WS_XS0), NTOK));
    PH(4, phase_moe1(F, args, 0));
    PH(5, phase_moe2(F, args, 0));
    PH(6, phase_pre1(F, args));
    PH(7, { SchedProj S{F.G, F.vcu, 8, 1024u}; EpiProj E{F.ws}; pg8::gemm_phase<EpiProj, SchedProj>(F.scr, F.ws, S, E); });
    PH(8, { SchedLora2 S{F.G, F.vcu, 2, 256u}; EpiLora2 E{F.ws, args.in[I_W0], args.in[I_A0]}; pg8::gemm_phase<EpiLora2, SchedLora2>(F.scr, F.ws, S, E); phase_fin(F, args); });
    PH(10, phase_scan(F, args));
    PH(11, phase_readout(F, args));
    PH(12, { SchedWo S{F.G, F.vcu, 8, 1024u}; EpiWo E{(const bf16_t*)(F.ws + WS_XS1), (bf16_t*)(F.ws + WS_XS0), modp(F, 1, 0, 2)}; pg8::gemm_phase<EpiWo, SchedWo>(F.scr, F.ws, S, E); });
    PH(13, phase_post(F, args, 1, (const bf16_t*)(F.ws + WS_XS0), NL));
    PH(14, phase_moe1(F, args, 1));
    PH(15, phase_moe2(F, args, 1));
    PH(16, phase_final(F, args, 1, (const bf16_t*)(F.ws + WS_XS0)));
#undef PH
#undef SEAM
#undef IN
}

extern "C" void kernel_launch(void* const* d_in, const int* in_sizes, int n_in, void* d_out, int out_size, void* d_ws, size_t ws_size, hipStream_t stream) {
    static int grid = 0;
    if (grid == 0) {
        if (n_in != 32 || ws_size < WS_END) { fprintf(stderr, "kernel_launch: unexpected n_in %d / ws %zu (need %zu)\n", n_in, ws_size, (size_t)WS_END); grid = -1; return; }
        int dev = 0, cus = 0;
        if (hipGetDevice(&dev) != hipSuccess || hipDeviceGetAttribute(&cus, hipDeviceAttributeMultiprocessorCount, dev) != hipSuccess) { grid = -1; return; }
        if (hipFuncSetAttribute((const void*)fwd_kernel, hipFuncAttributeMaxDynamicSharedMemorySize, LDS_BYTES) != hipSuccess) { fprintf(stderr, "kernel_launch: hipFuncSetAttribute failed\n"); grid = -1; return; }
        (void)hipGetLastError();
        grid = cus;
    }
    if (grid < 0) return;
    (void)hipMemsetAsync((char*)d_ws + WS_CTL, 0, CTL_BYTES, stream);
    Args a{};
    for (int i = 0; i < 32; ++i) a.in[i] = (const float*)d_in[i];
    a.out = (float*)d_out; a.ws = (unsigned char*)d_ws;
    const int last = 16;
#if N_LAUNCH_MODE == 1
    a.ph_lo = 0; a.ph_hi = last + 1;
    hipLaunchKernelGGL(fwd_kernel, dim3(grid), dim3(NTHREADS), LDS_BYTES, stream, a);
#else
    for (int p = 0; p <= last; ++p) { a.ph_lo = p; a.ph_hi = p + 1; hipLaunchKernelGGL(fwd_kernel, dim3(grid), dim3(NTHREADS), LDS_BYTES, stream, a); }
#endif
}
```

```cpp
#include <hip/hip_runtime.h>
#include <cstdio>
#include <cstdint>

#define LAS __attribute__((address_space(3)))
#define GAS __attribute__((address_space(1)))
typedef unsigned short bf16_t;
typedef short bf16x8 __attribute__((ext_vector_type(8)));
typedef float f32x4 __attribute__((ext_vector_type(4)));
typedef float f32x2 __attribute__((ext_vector_type(2)));
typedef float f32x16 __attribute__((ext_vector_type(16)));
typedef unsigned u32x4 __attribute__((ext_vector_type(4)));
typedef unsigned u32x2 __attribute__((ext_vector_type(2)));

#ifndef N_LAUNCH_MODE
#define N_LAUNCH_MODE 1
#endif
#ifndef SCAN_TSEL
#define SCAN_TSEL -1
#endif
#ifndef REPEAT_MASK
#define REPEAT_MASK 0
#endif

constexpr int D = 1024, NB = 2, TSEQ = 16384, CT = 256, NL = NB * TSEQ, NC = NB * CT, NTOK = NL + NC;
constexpr int NE = 32, TOPK = 4, NMOD = 6;
constexpr int NWAVES = 8, NTHREADS = 512;
constexpr int MAXSLOT = ((NTOK * TOPK + 255) / 256 + NE) * 256;
constexpr float NORM_EPS = 1e-6f, GN_EPS = 64e-5f;

constexpr size_t AL(size_t x) { return (x + 255) & ~(size_t)255; }
constexpr size_t WS_CTL = 0, CTL_BYTES = 65536;
constexpr size_t CTL_XSYNC = 32768;
constexpr size_t CTL_CNT = 16384;
constexpr size_t WS_MOD = WS_CTL + CTL_BYTES;
constexpr size_t WS_LIST = AL(WS_MOD + 2 * 3 * 6144 * 4);
constexpr size_t WS_TINFO = AL(WS_LIST + (size_t)2 * NE * NTOK * 4);
constexpr size_t WS_TGATE = AL(WS_TINFO + (size_t)2 * NTOK * 4 * 4);
constexpr size_t WS_WGU = AL(WS_TGATE + (size_t)2 * NTOK * 4 * 4);
constexpr size_t WS_WDN = AL(WS_WGU + (size_t)2 * NE * 2048 * 1024 * 2);
constexpr size_t WS_WRKV = AL(WS_WDN + (size_t)2 * NE * 1024 * 1024 * 2);
constexpr size_t WS_WO = AL(WS_WRKV + (size_t)3 * 1024 * 1024 * 2);
constexpr size_t WS_WL1 = AL(WS_WO + (size_t)1024 * 1024 * 2);
constexpr size_t WS_WL2 = AL(WS_WL1 + (size_t)3 * 256 * 1024 * 2);
constexpr size_t WS_WPOOL = AL(WS_WL2 + (size_t)5 * 1024 * 128 * 2);
constexpr size_t WS_XS0 = AL(WS_WPOOL + (size_t)4 * 256 * 256 * 2);
constexpr size_t WS_XS1 = AL(WS_XS0 + (size_t)NTOK * D * 4);
constexpr size_t WS_T = AL(WS_XS1 + (size_t)NTOK * D * 4);
constexpr size_t ACTB = (size_t)NTOK * D * 2;
constexpr size_t TA = WS_T;
constexpr size_t TA_BYTES = (size_t)432 << 20;
constexpr size_t WS_DBUF = TA, WS_H2 = TA + ACTB, WS_ACT = TA + 2 * ACTB;
constexpr size_t WS_MIX = TA;
constexpr size_t WS_KDIR = TA, WS_BV = TA + 2 * ACTB, WS_KK = TA + 4 * ACTB;
constexpr size_t TB = TA + TA_BYTES;
constexpr size_t TB_BYTES = (size_t)290 << 20;
constexpr size_t WS_Y2 = TB, WS_RKV = TB;
constexpr size_t TC = TB + TB_BYTES;
constexpr size_t WS_DEC = TC, WS_RO = TC;
constexpr size_t TD = AL(TC + (size_t)2 * NTOK * D * 4);
constexpr size_t WS_ICL = TD, WS_YD = TA;
constexpr size_t TE = AL(TD + 2 * ACTB);
constexpr size_t WS_G = TE;
constexpr size_t TF = AL(TE + ACTB);
constexpr size_t WS_LACT = TF;
constexpr size_t WS_END = AL(TF + (size_t)3 * NTOK * 128 * 2);
static_assert(WS_ACT + (size_t)MAXSLOT * D * 2 <= TA + TA_BYTES, "ACT overflows TA");
static_assert((size_t)MAXSLOT * D * 2 <= TB_BYTES, "Y2 overflows TB");
static_assert(WS_END <= ((size_t)2048 << 20), "workspace too large");

constexpr int MISC_OFF = 0, SCR_OFF = 1024, SCR_BYTES = 162816, LDS_BYTES = SCR_OFF + SCR_BYTES;

typedef __bf16 bf16x2_t __attribute__((ext_vector_type(2)));
__device__ __forceinline__ unsigned cvt_pk_bf16(float lo, float hi) { const f32x2 v = {lo, hi}; return __builtin_bit_cast(unsigned, __builtin_convertvector(v, bf16x2_t)); }
__device__ __forceinline__ void stx4(bf16_t* p, f32x4 v) { u32x2 w; w.x = cvt_pk_bf16(v[0], v[1]); w.y = cvt_pk_bf16(v[2], v[3]); *(GAS u32x2*)p = w; }
__device__ __forceinline__ float bf_lo(unsigned w) { return __uint_as_float(w << 16); }
__device__ __forceinline__ float bf_hi(unsigned w) { return __uint_as_float(w & 0xffff0000u); }
__device__ __forceinline__ float bf2f(bf16_t b) { return __uint_as_float(((unsigned)b) << 16); }
__device__ __forceinline__ f32x4 ldx4(const bf16_t* p) { const u32x2 w = *(const GAS u32x2*)p; return (f32x4){bf_lo(w.x), bf_hi(w.x), bf_lo(w.y), bf_hi(w.y)}; }
__device__ __forceinline__ float dpp_xadd(float v, const int sel) {
    const int x = __builtin_bit_cast(int, v); int y;
    if (sel == 0) y = __builtin_amdgcn_update_dpp(0, x, 0xB1, 0xF, 0xF, true);
    else if (sel == 1) y = __builtin_amdgcn_update_dpp(0, x, 0x4E, 0xF, 0xF, true);
    else if (sel == 2) y = __builtin_amdgcn_update_dpp(0, x, 0x141, 0xF, 0xF, true);
    else y = __builtin_amdgcn_update_dpp(0, x, 0x140, 0xF, 0xF, true);
    return v + __builtin_bit_cast(float, y);
}
__device__ __forceinline__ float wave_sum(float v) {
    v = dpp_xadd(v, 0); v = dpp_xadd(v, 1); v = dpp_xadd(v, 2); v = dpp_xadd(v, 3);
    const int x = __builtin_bit_cast(int, v);
    const float s0 = __builtin_bit_cast(float, __builtin_amdgcn_readlane(x, 0)), s1 = __builtin_bit_cast(float, __builtin_amdgcn_readlane(x, 16)),
                s2 = __builtin_bit_cast(float, __builtin_amdgcn_readlane(x, 32)), s3 = __builtin_bit_cast(float, __builtin_amdgcn_readlane(x, 48));
    return (s0 + s1) + (s2 + s3);
}
__device__ __forceinline__ float sigmoidf_(float x) { return __builtin_amdgcn_rcpf(1.0f + __builtin_amdgcn_exp2f(-1.44269504f * x)); }
__device__ __forceinline__ float tanhf_(float x) { return 1.0f - 2.0f * __builtin_amdgcn_rcpf(1.0f + __builtin_amdgcn_exp2f(2.88539008f * x)); }
#define LDS_WAIT() asm volatile("s_waitcnt lgkmcnt(0)" ::: "memory")
#define VM_WAIT() asm volatile("s_waitcnt vmcnt(0)" ::: "memory")

#define XB_TMO      128
#define XB_XCNT(j)  (256  + 64 * (j))
#define XB_XSUB(j)  (1280 + 64 * (j))
#define XB_XGEN(j)  (2304 + 64 * (j))
#define XB_TOP      3328
#define XB_TOPGEN   3392
#define XCD_BAR_WORDS 3456
#define XB_SPIN_CAP (1u << 22)
__device__ __forceinline__ unsigned xb_ld(unsigned* p)              { return __hip_atomic_load(p, __ATOMIC_RELAXED, __HIP_MEMORY_SCOPE_AGENT); }
__device__ __forceinline__ unsigned xb_add(unsigned* p, unsigned v) { return __hip_atomic_fetch_add(p, v, __ATOMIC_RELAXED, __HIP_MEMORY_SCOPE_AGENT); }
__device__ __forceinline__ unsigned xb_xcc_id() { return (unsigned)__builtin_amdgcn_s_getreg((3 << 11) | 20) & 0xFu; }
#define XB_SPIN(cond, bar) do { unsigned _sp = 0; while (cond) { __builtin_amdgcn_s_sleep(1); \
    if ((++_sp & 255u) == 0u) { if (xb_ld(&(bar)[XB_TMO])) break; if (_sp > XB_SPIN_CAP) { atomicAdd(&(bar)[XB_TMO], 1u); break; } } } } while (0)
struct XcdBarrier { unsigned* bar; unsigned x; volatile LAS unsigned* st; };
__device__ __forceinline__ XcdBarrier xcd_barrier_post(unsigned* bar, volatile LAS unsigned* st) {
    XcdBarrier b; b.bar = bar; b.x = xb_xcc_id(); b.st = st;
    if (threadIdx.x == 0) (void)xb_add(&bar[XB_XCNT(b.x)], 1u);
    return b;
}
__device__ __forceinline__ void xcd_barrier_complete(unsigned* bar, unsigned x, unsigned& nloc, unsigned& nx) {
    const unsigned G = gridDim.x * gridDim.y * gridDim.z;
    unsigned sum, cnt, mine, sp = 0u;
    for (;;) {
        sum = 0u; cnt = 0u; mine = 0u;
#pragma unroll
        for (unsigned j = 0; j < 16; ++j) { const unsigned c = xb_ld(&bar[XB_XCNT(j)]); sum += c; cnt += (c > 0u) ? 1u : 0u; mine = (j == x) ? c : mine; }
        if (sum == G) break;
        __builtin_amdgcn_s_sleep(1);
        if ((++sp & 255u) == 0u) { if (xb_ld(&bar[XB_TMO])) break; if (sp > XB_SPIN_CAP) { atomicAdd(&bar[XB_TMO], 1u); break; } }
    }
    nloc = mine > 0u ? mine : 1u; nx = cnt > 0u ? cnt : 1u;
}
__device__ __forceinline__ void xcd_barrier(const XcdBarrier& b) {
    asm volatile("s_waitcnt vmcnt(0)" ::: "memory");
    __syncthreads();
    if (threadIdx.x == 0) {
        unsigned* bar = b.bar;
        __builtin_amdgcn_s_waitcnt(0);
        unsigned nloc = b.st[0], nx = b.st[1];
        if (nloc == 0u) { xcd_barrier_complete(bar, b.x, nloc, nx); b.st[0] = nloc; b.st[1] = nx; }
        const unsigned old = xb_add(&bar[XB_XSUB(b.x)], 1u);
        const unsigned gen = old / nloc;
        if (old + 1u == (gen + 1u) * nloc) {
            __builtin_amdgcn_fence(__ATOMIC_RELEASE, "agent");
            asm volatile("s_waitcnt vmcnt(0)" ::: "memory");
            const unsigned og = xb_add(&bar[XB_TOP], 1u);
            const unsigned tg = og / nx;
            if (og + 1u == (tg + 1u) * nx) xb_add(&bar[XB_TOPGEN], 1u);
            else XB_SPIN(xb_ld(&bar[XB_TOPGEN]) == tg, bar);
            __builtin_amdgcn_fence(__ATOMIC_ACQUIRE, "agent");
            xb_add(&bar[XB_XGEN(b.x)], 1u);
            asm volatile("s_waitcnt vmcnt(0)" ::: "memory");
        } else {
            XB_SPIN(xb_ld(&bar[XB_XGEN(b.x)]) == gen, bar);
            __builtin_amdgcn_fence(__ATOMIC_ACQUIRE, "agent");
            asm volatile("s_waitcnt vmcnt(0)" ::: "memory");
        }
    }
    __syncthreads();
}

namespace pg8 {
constexpr int BM = 256, BK = 64, HALF = 128, HTB = HALF * BK * 2, STAGE_BYTES = 8 * HTB;
__host__ __device__ __forceinline__ int lds_byte(int r, int c) { const int st = (r >> 4) * 2 + (c >> 5), rr = r & 15, cc = c & 31, ob = rr * 64 + cc * 2; return st * 1024 + (ob ^ (((ob >> 9) & 1) << 5)); }
__host__ __device__ __forceinline__ void stage_rc(int b, int& R, int& C) { const int st = b / 1024, sb = b % 1024, swz = sb ^ (((sb >> 9) & 1) << 5); R = (st >> 1) * 16 + swz / 64; C = (st & 1) * 32 + (swz % 64) / 2; }
__host__ __device__ __forceinline__ int perm32(int rho) { const int n = rho >> 4, i = rho & 15; return 8 * (i >> 2) + 4 * n + (i & 3); }

struct GU { unsigned a, b; int i0, i1, i2, i3; };
typedef int v8i __attribute__((ext_vector_type(8)));
typedef int v4i __attribute__((ext_vector_type(4)));
__device__ __forceinline__ bf16x8 half8(v8i v, int h) { const v4i a = h ? __builtin_shufflevector(v, v, 4, 5, 6, 7) : __builtin_shufflevector(v, v, 0, 1, 2, 3); return __builtin_bit_cast(bf16x8, a); }
__device__ __forceinline__ v8i cat8(bf16x8 lo, bf16x8 hi) { const v4i a = __builtin_bit_cast(v4i, lo), b = __builtin_bit_cast(v4i, hi); return __builtin_shufflevector(a, b, 0, 1, 2, 3, 4, 5, 6, 7); }

template <class Epi, class Sched>
__device__ __forceinline__ void gemm_phase(LAS unsigned char* lds, unsigned char* wsbase, const Sched& S, const Epi& E) {
    const int tid = threadIdx.x, wid = __builtin_amdgcn_readfirstlane(tid >> 6), lane = tid & 63, wr = wid >> 2, wc = wid & 3, fr = lane & 15, fq = lane >> 4;
    const int nt = S.nt;
    const __amdgpu_buffer_rsrc_t rsrc = __builtin_amdgcn_make_buffer_rsrc((void*)wsbase, 0, 0xffffffff, 0x00020000);
    constexpr int SIDE_OFF = STAGE_BYTES;
#define PG8_SIDE(u, buf) do { if constexpr (Sched::SIDE) { unsigned so_; const bool isb_ = S.side_src((u), tid, so_); (void)isb_; \
        if (wid < 4) __builtin_amdgcn_raw_ptr_buffer_load_lds(rsrc, (LAS void*)(lds + SIDE_OFF + (buf) * 2048 + wid * 256), 4, (int)so_, 0, 0, 0); \
        else __builtin_amdgcn_raw_ptr_buffer_load_lds(S.rsrcb, (LAS void*)(lds + SIDE_OFF + (buf) * 2048 + wid * 256), 4, (int)so_, 0, 0, 0); } } while (0)
    int Rr[2], Cc[2]; unsigned voffB[2];
#pragma unroll
    for (int i = 0; i < 2; ++i) { int R, C; stage_rc(tid * 16 + i * 8192, R, C); Rr[i] = R; Cc[i] = C; const int Rb = Epi::PERM ? ((R & ~31) + perm32(R & 31)) : R;
        voffB[i] = (unsigned)Rb * S.ldb + 2u * (unsigned)C; }
    const unsigned kstep = 128u;
    const unsigned hstepB = (unsigned)HALF * S.ldb;
    const unsigned ldsw = (unsigned)wid * 1024u;
    const int aoff = lds_byte(wr * 64 + fr, fq * 8), boff = lds_byte(wc * 32 + fr, fq * 8);
#define PG8_SA(b, h) (((b) * 2 + (h)) * HTB)
#define PG8_SB(b, h) ((4 + (b) * 2 + (h)) * HTB)
#define PG8_STAGE(bufoff, soff, voff) do { _Pragma("unroll") for (int _i = 0; _i < 2; ++_i) \
        __builtin_amdgcn_raw_ptr_buffer_load_lds(rsrc, (LAS void*)(lds + (bufoff) + ldsw + _i * 8192), 16, (int)(voff)[_i], (int)(soff), 0, 0); } while (0)
#define PG8_LDA(dst, b, h) do { _Pragma("unroll") for (int m = 0; m < 4; ++m) dst[m] = cat8(*(const LAS bf16x8*)(lds + PG8_SA(b, h) + aoff + m * 2048), *(const LAS bf16x8*)(lds + PG8_SA(b, h) + aoff + m * 2048 + 1024)); } while (0)
#define PG8_LDB(dst, b, h) do { _Pragma("unroll") for (int n = 0; n < 2; ++n) dst[n] = cat8(*(const LAS bf16x8*)(lds + PG8_SB(b, h) + boff + n * 2048), *(const LAS bf16x8*)(lds + PG8_SB(b, h) + boff + n * 2048 + 1024)); } while (0)
#define PG8_MMA(ai, bj, At, Bt) do { __builtin_amdgcn_s_setprio(1); _Pragma("unroll") for (int m = 0; m < 4; ++m) _Pragma("unroll") for (int n = 0; n < 2; ++n) { \
        if constexpr (Epi::FP8) { asm volatile("v_mfma_scale_f32_16x16x128_f8f6f4 %0, %1, %2, %0, %3, %4 op_sel_hi:[0,0,0]" : "+v"(acc[ai][bj][m][n]) : "v"(Bt[n]), "v"(At[m]), "v"(sc_w), "v"(sc_a)); } \
        else { acc[ai][bj][m][n] = __builtin_amdgcn_mfma_f32_16x16x32_bf16(half8(Bt[n], 0), half8(At[m], 0), acc[ai][bj][m][n], 0, 0, 0); \
               acc[ai][bj][m][n] = __builtin_amdgcn_mfma_f32_16x16x32_bf16(half8(Bt[n], 1), half8(At[m], 1), acc[ai][bj][m][n], 0, 0, 0); } } \
        __builtin_amdgcn_s_setprio(0); } while (0)
#define PG8_WAIT_V(n) asm volatile("s_waitcnt vmcnt(" #n ")" ::: "memory")
#define PG8_WAIT_L(n) asm volatile("s_waitcnt lgkmcnt(" #n ")" ::: "memory")
#define PG8_BAR __builtin_amdgcn_s_barrier()
#define PG8_SCHED __builtin_amdgcn_sched_barrier(0)
#define PG8_RC() do { _Pragma("unroll") for (int i = 0; i < 2; ++i) { int R, C; stage_rc((int)threadIdx.x * 16 + i * 8192, R, C); Rr[i] = R; Cc[i] = C; } } while (0)
    long long tk_ = 0, te_ = 0, tt0_ = 0; const bool tprobe_ = (SCAN_TSEL >= 10) && Sched::SIDE && Sched::GATHER;
    GU cur, nxt; int ui = 0;
    if (!S.next(0, cur)) { if constexpr (Sched::XSYNC) { if (tid == 0) (void)xb_add(S.xw, (unsigned)S.rounds); } return; }
    f32x4 acc[2][2][4][2];
#pragma unroll
    for (int a = 0; a < 2; ++a)
#pragma unroll
        for (int b = 0; b < 2; ++b)
#pragma unroll
            for (int m = 0; m < 4; ++m)
#pragma unroll
                for (int n = 0; n < 2; ++n) acc[a][b][m][n] = (f32x4){0.f, 0.f, 0.f, 0.f};
    v8i At[4], B0[2], B1[2];
    int sc_w = 0x7a7a7a7a, sc_a = 0x7f7f7f7f; asm volatile("" : "+v"(sc_w), "+v"(sc_a));
    unsigned vA[2][2], nvA[2][2];
    S.aoff(cur, Rr, Cc, vA);
    unsigned cA = __builtin_amdgcn_readfirstlane(cur.a), cB = __builtin_amdgcn_readfirstlane(cur.b);
    PG8_SIDE(cur, 0);
    PG8_STAGE(PG8_SB(0, 0), cB, voffB); PG8_STAGE(PG8_SB(0, 1), cB + hstepB, voffB); PG8_STAGE(PG8_SA(0, 0), cA, vA[0]); PG8_STAGE(PG8_SA(0, 1), cA, vA[1]);
    if (wr == 1) PG8_BAR;
    PG8_WAIT_V(2); PG8_BAR;
    PG8_STAGE(PG8_SB(1, 0), cB + kstep, voffB); PG8_STAGE(PG8_SA(1, 0), cA + kstep, vA[0]); PG8_STAGE(PG8_SB(1, 1), cB + hstepB + kstep, voffB);
    PG8_WAIT_V(6); PG8_BAR;
    for (;;) {
        if (tprobe_) tt0_ = clock64();
        const bool has_next = S.next(ui + 1, nxt);
        const unsigned nA = has_next ? __builtin_amdgcn_readfirstlane(nxt.a) : cA, nB = has_next ? __builtin_amdgcn_readfirstlane(nxt.b) : cB;
        if (has_next) PG8_SIDE(nxt, (ui + 1) & 1);
        if constexpr (Sched::GATHER && !Sched::SIDE) {
            if (has_next) { PG8_RC(); S.aoff(nxt, Rr, Cc, nvA); }
            else { nvA[0][0] = vA[0][0]; nvA[0][1] = vA[0][1]; nvA[1][0] = vA[1][0]; nvA[1][1] = vA[1][1]; }
        }
#pragma unroll 1
        for (int t = 0; t < nt; t += 2) {
            const bool last = (t == nt - 2);
            const unsigned a1 = cA + (unsigned)(t + 1) * kstep;
            const unsigned a2 = last ? nA : cA + (unsigned)(t + 2) * kstep, b2 = last ? nB : cB + (unsigned)(t + 2) * kstep;
            const unsigned a3 = a2 + kstep, b3 = b2 + kstep;
            if constexpr (Sched::GATHER && Sched::SIDE) {
                if (last) { if (has_next) { PG8_RC(); const LAS int* tk = (const LAS int*)(lds + SIDE_OFF + ((ui + 1) & 1) * 2048);
#pragma unroll
                        for (int h = 0; h < 2; ++h)
#pragma unroll
                            for (int i = 0; i < 2; ++i) nvA[h][i] = S.tok_off(tk[h * 128 + Rr[i]], Cc[i]); }
                    else { nvA[0][0] = vA[0][0]; nvA[0][1] = vA[0][1]; nvA[1][0] = vA[1][0]; nvA[1][1] = vA[1][1]; } }
            }
            unsigned w0[2], w1[2];
            if constexpr (Sched::GATHER) { w0[0] = last ? nvA[0][0] : vA[0][0]; w0[1] = last ? nvA[0][1] : vA[0][1]; w1[0] = last ? nvA[1][0] : vA[1][0]; w1[1] = last ? nvA[1][1] : vA[1][1]; }
            else { w0[0] = vA[0][0]; w0[1] = vA[0][1]; w1[0] = vA[1][0]; w1[1] = vA[1][1]; }
            PG8_LDB(B0, 0, 0); PG8_LDB(B1, 0, 1); PG8_SCHED; PG8_LDA(At, 0, 0); PG8_STAGE(PG8_SA(1, 1), a1, vA[1]);
            PG8_WAIT_V(8); PG8_WAIT_L(0); PG8_BAR; PG8_MMA(0, 0, At, B0); PG8_MMA(0, 1, At, B1); PG8_BAR; PG8_SCHED;
            PG8_LDA(At, 0, 1); PG8_STAGE(PG8_SB(0, 0), b2, voffB); PG8_STAGE(PG8_SB(0, 1), b2 + hstepB, voffB); PG8_STAGE(PG8_SA(0, 0), a2, w0);
            PG8_WAIT_V(8); PG8_WAIT_L(0); PG8_BAR; PG8_MMA(1, 0, At, B0); PG8_MMA(1, 1, At, B1); PG8_BAR; PG8_SCHED;
            PG8_LDB(B0, 1, 0); PG8_LDB(B1, 1, 1); PG8_SCHED; PG8_LDA(At, 1, 0); PG8_STAGE(PG8_SA(0, 1), a2, w1);
            PG8_WAIT_V(8); PG8_WAIT_L(0); PG8_BAR; PG8_MMA(0, 0, At, B0); PG8_MMA(0, 1, At, B1); PG8_BAR; PG8_SCHED;
            PG8_LDA(At, 1, 1); PG8_STAGE(PG8_SB(1, 0), b3, voffB); PG8_STAGE(PG8_SB(1, 1), b3 + hstepB, voffB); PG8_STAGE(PG8_SA(1, 0), a3, w0);
            PG8_WAIT_V(8); PG8_WAIT_L(0); PG8_BAR; PG8_MMA(1, 0, At, B0); PG8_MMA(1, 1, At, B1); PG8_BAR; PG8_SCHED;
        }
        if (tprobe_) { const long long n_ = clock64(); tk_ += n_ - tt0_; tt0_ = n_; }
        if (wr == 0) PG8_BAR;
        if constexpr (Epi::FP8) asm volatile("s_nop 15\n\ts_nop 7" ::: "memory");
        { int fr_ = fr, fq_ = fq; asm volatile("" : "+v"(fr_), "+v"(fq_)); E(acc, cur, wr, wc, fr_, fq_, (const LAS float*)(lds + SIDE_OFF + (ui & 1) * 2048 + 1024)); }
        if constexpr (Sched::XSYNC) {
            if (tid == 0) { (void)xb_add(S.xw, 1u); const unsigned tgt = (unsigned)(ui + 1) * S.nloc; unsigned sp = 0;
                while (xb_ld(S.xw) < tgt && ++sp < (1u << 16)) __builtin_amdgcn_s_sleep(1);
                if (!has_next && S.rounds > ui + 1) (void)xb_add(S.xw, (unsigned)(S.rounds - (ui + 1))); }
        }
        if constexpr (Sched::XSYNC || Sched::SIDE) PG8_BAR;
        if (tprobe_) { te_ += clock64() - tt0_; }
        if (!has_next) break;
#pragma unroll
        for (int a = 0; a < 2; ++a)
#pragma unroll
            for (int b = 0; b < 2; ++b)
#pragma unroll
                for (int m = 0; m < 4; ++m)
#pragma unroll
                    for (int n = 0; n < 2; ++n) acc[a][b][m][n] = (f32x4){0.f, 0.f, 0.f, 0.f};
        cur = nxt; cA = nA; cB = nB; ++ui;
        if constexpr (Sched::GATHER) { vA[0][0] = nvA[0][0]; vA[0][1] = nvA[0][1]; vA[1][0] = nvA[1][0]; vA[1][1] = nvA[1][1]; }
        if (wr == 1) PG8_BAR;
    }
    PG8_WAIT_V(0);
    PG8_BAR;
    if (tprobe_ && S.vcu == 0 && tid == 0) { const long long v_ = (SCAN_TSEL == 10) ? tk_ : (SCAN_TSEL == 11 ? 4 * te_ : tk_ + te_); __hip_atomic_fetch_add((unsigned long long*)(wsbase + WS_CTL + 49152), (unsigned long long)v_, __ATOMIC_RELAXED, __HIP_MEMORY_SCOPE_AGENT); }
#undef PG8_RC
#undef PG8_SIDE
#undef PG8_SA
#undef PG8_SB
#undef PG8_STAGE
#undef PG8_LDA
#undef PG8_LDB
#undef PG8_MMA
#undef PG8_WAIT_V
#undef PG8_WAIT_L
#undef PG8_BAR
#undef PG8_SCHED
}
}
using pg8::GU;

struct Args { const float* in[32]; float* out; unsigned char* ws; int ph_lo, ph_hi; };
struct Frame {
    LAS unsigned char* lds;
    LAS unsigned char* scr;
    unsigned char* ws;
    int tid, lane, wave, G, vcu;
};
enum { I_X = 0, I_C, I_CTX, I_CCTX, I_NORMG, I_ADAW, I_ADAB, I_POOLW, I_POOLLS, I_MU, I_WRKV, I_W0, I_W1, I_W2, I_A0, I_A1, I_A2, I_G1, I_G2, I_KK, I_KA, I_RK, I_LNG, I_LNB, I_WO,
       I_RW, I_RB, I_WGU, I_BGU, I_WDN, I_BDN, I_FINALG };

__device__ __forceinline__ const float* modp(const Frame& F, int layer, int row, int k) { return (const float*)(F.ws + WS_MOD) + ((size_t)(layer * 3 + row) * NMOD + k) * D; }
__device__ __forceinline__ int mrow_of(int n) { return n < NL ? (n >> 14) : 2; }

__device__ __forceinline__ void transpose_tile(const float* W, int ldw, int k0, int n0, bf16_t* WT, size_t dst_row0, int ldk, int kdst0, LAS float* scr, int lane) {
    const int c4 = lane & 15, kr = lane >> 4;
#pragma unroll 4
    for (int it = 0; it < 16; ++it) { const int kk = 4 * it + kr; const f32x4 v = *(const GAS f32x4*)(W + (size_t)(k0 + kk) * ldw + n0 + 4 * c4);
        LAS float* s = scr + kk * 65 + 4 * c4; s[0] = v[0]; s[1] = v[1]; s[2] = v[2]; s[3] = v[3]; }
    LDS_WAIT(); asm volatile("" ::: "memory");
    const int c = lane & 7;
#pragma unroll
    for (int j = 0; j < 8; ++j) { const int n = (lane >> 3) + 8 * j; const LAS float* s = scr + (8 * c) * 65 + n;
        u32x4 o; o.x = cvt_pk_bf16(s[0 * 65], s[1 * 65]); o.y = cvt_pk_bf16(s[2 * 65], s[3 * 65]); o.z = cvt_pk_bf16(s[4 * 65], s[5 * 65]); o.w = cvt_pk_bf16(s[6 * 65], s[7 * 65]);
        *(GAS u32x4*)(WT + (dst_row0 + n) * (size_t)ldk + kdst0 + k0 + 8 * c) = o; }
    LDS_WAIT(); asm volatile("" ::: "memory");
}

__device__ __forceinline__ unsigned pk4_fp8(float a, float b, float c, float d) { int w = 0; w = __builtin_amdgcn_cvt_pk_fp8_f32(a, b, w, false); w = __builtin_amdgcn_cvt_pk_fp8_f32(c, d, w, true); return (unsigned)w; }
__device__ __forceinline__ void transpose_tile_fp8(const float* W, int ldw, int k0, int n0, unsigned char* WT, size_t dst_row0, int ldk, float scale, LAS float* scr, int lane) {
    const int c4 = lane & 15, kr = lane >> 4;
#pragma unroll 4
    for (int it = 0; it < 16; ++it) { const int kk = 4 * it + kr; const f32x4 v = __builtin_nontemporal_load((const GAS f32x4*)(W + (size_t)(k0 + kk) * ldw + n0 + 4 * c4));
        LAS float* s = scr + kk * 65 + 4 * c4; s[0] = v[0] * scale; s[1] = v[1] * scale; s[2] = v[2] * scale; s[3] = v[3] * scale; }
    LDS_WAIT(); asm volatile("" ::: "memory");
    const int c = lane & 3;
#pragma unroll
    for (int j = 0; j < 4; ++j) { const int n = (lane >> 2) + 16 * j; const LAS float* s = scr + (16 * c) * 65 + n;
        u32x4 o; o.x = pk4_fp8(s[0 * 65], s[1 * 65], s[2 * 65], s[3 * 65]); o.y = pk4_fp8(s[4 * 65], s[5 * 65], s[6 * 65], s[7 * 65]);
        o.z = pk4_fp8(s[8 * 65], s[9 * 65], s[10 * 65], s[11 * 65]); o.w = pk4_fp8(s[12 * 65], s[13 * 65], s[14 * 65], s[15 * 65]);
        __builtin_nontemporal_store(o, (GAS u32x4*)(WT + (dst_row0 + n) * (size_t)ldk + k0 + 16 * c)); }
    LDS_WAIT(); asm volatile("" ::: "memory");
}
__device__ __forceinline__ void transpose_tile_fp8_k128(const float* W, int ldw, int k0, int n0, unsigned char* WT, size_t dst_row0, int ldk, float scale, LAS float* scr, int lane, bool late = false) {
    const int c4 = lane & 7, kr = lane >> 3;
#pragma unroll 4
    for (int it = 0; it < 16; ++it) { const int kk = 8 * it + kr; const f32x4 v = __builtin_nontemporal_load((const GAS f32x4*)(W + (size_t)(k0 + kk) * ldw + n0 + 4 * c4));
        LAS float* s = scr + kk * 33 + 4 * c4; s[0] = v[0] * scale; s[1] = v[1] * scale; s[2] = v[2] * scale; s[3] = v[3] * scale; }
    LDS_WAIT(); asm volatile("" ::: "memory");
    const int c = lane & 7;
#pragma unroll
    for (int j = 0; j < 4; ++j) { const int n = (lane >> 3) + 8 * j; const LAS float* s = scr + (16 * c) * 33 + n;
        u32x4 o; o.x = pk4_fp8(s[0 * 33], s[1 * 33], s[2 * 33], s[3 * 33]); o.y = pk4_fp8(s[4 * 33], s[5 * 33], s[6 * 33], s[7 * 33]);
        o.z = pk4_fp8(s[8 * 33], s[9 * 33], s[10 * 33], s[11 * 33]); o.w = pk4_fp8(s[12 * 33], s[13 * 33], s[14 * 33], s[15 * 33]);
        if (late) __builtin_nontemporal_store(o, (GAS u32x4*)(WT + (dst_row0 + n) * (size_t)ldk + k0 + 16 * c)); else *(GAS u32x4*)(WT + (dst_row0 + n) * (size_t)ldk + k0 + 16 * c) = o; }
    LDS_WAIT(); asm volatile("" ::: "memory");
}
__device__ __forceinline__ void phase_prep(const Frame& F, const Args& A) {
    unsigned char* ws = F.ws;
    for (int u = blockIdx.x; u < 256; u += F.G) {
        const int l = u >> 7, cc = u & 127, c4 = F.tid % 12, kq = F.tid / 12;
        f32x4 a0 = {0, 0, 0, 0}, a1 = {0, 0, 0, 0}, a2 = {0, 0, 0, 0};
        if (kq < 42) { const float* w = A.in[I_ADAW] + (size_t)l * D * (NMOD * D) + cc * 48 + 4 * c4;
            for (int k = kq; k < D; k += 42) { const f32x4 wv = __builtin_nontemporal_load((const GAS f32x4*)(w + (size_t)k * (NMOD * D)));
                float c0 = A.in[I_C][k], c1 = A.in[I_C][D + k], c2 = A.in[I_CCTX][k];
                c0 = c0 * sigmoidf_(c0); c1 = c1 * sigmoidf_(c1); c2 = c2 * sigmoidf_(c2);
                a0 += wv * c0; a1 += wv * c1; a2 += wv * c2; }
            LAS f32x4* red = (LAS f32x4*)F.scr;
            red[(kq * 3 + 0) * 12 + c4] = a0; red[(kq * 3 + 1) * 12 + c4] = a1; red[(kq * 3 + 2) * 12 + c4] = a2; }
        __syncthreads();
        if (F.tid < 144) { const int r = F.tid / 48, c = F.tid % 48; float sum = 0.f;
            for (int q = 0; q < 42; ++q) sum += ((LAS float*)F.scr)[((q * 3 + r) * 12) * 4 + c];
            const int col = cc * 48 + c;
            ((float*)(ws + WS_MOD))[(size_t)(l * 3 + r) * (NMOD * D) + col] = sum + A.in[I_ADAB][(size_t)l * NMOD * D + col]; }
        __syncthreads();
    }
    { bf16_t* w2p = (bf16_t*)(ws + WS_WL2);
      for (int i = blockIdx.x * NTHREADS + F.tid; i < 4 * 1024 * 8; i += F.G * NTHREADS) { const int o = i / 8192, c = (i / 8) % 1024, q = i % 8, d = o & 1;
          *(GAS u32x4*)(w2p + ((size_t)o * 1024 + c) * 128 + (1 - d) * 64 + q * 8) = (u32x4){0u, 0u, 0u, 0u}; } }
    LAS float* scr = (LAS float*)(F.scr) + F.wave * (128 * 33 + 31);
    const int gw = F.vcu * NWAVES + F.wave, NGW = F.G * NWAVES;
    constexpr int T_GU = 2 * NE * 16 * 32, T_DN = 2 * NE * 16 * 16, T_RKV = 3 * 256, T_WO = 256, T_L1 = 2 * 16 + 2 * 16 + 32, T_L2 = 2 * 16 + 2 * 16 + 2 * 16, T_PW = 4 * 16;
    constexpr int T_ALL = T_GU + T_DN + T_RKV + T_WO + T_L1 + T_L2 + T_PW;
    for (int it = gw; it < T_ALL; it += NGW) {
        int r = it;
        if (r < T_GU) { const int le = r / 512, q = r % 512, kb = q / 64, nb = q % 64; const int n0 = nb * 32;
            const int drow = (n0 < 1024) ? ((n0 >> 7) * 256 + (n0 & 127)) : (((n0 - 1024) >> 7) * 256 + 128 + ((n0 - 1024) & 127));
            transpose_tile_fp8_k128(A.in[I_WGU] + (size_t)le * 1024 * 2048, 2048, kb * 128, n0, ws + WS_WGU, (size_t)le * 2048 + drow, 1024, 32.0f, scr, F.lane, true); continue; } r -= T_GU;
        if (r < T_DN) { const int le = r / 256, q = r % 256, kb = q / 32, nb = q % 32;
            transpose_tile_fp8_k128(A.in[I_WDN] + (size_t)le * 1024 * 1024, 1024, kb * 128, nb * 32, ws + WS_WDN, (size_t)le * 1024 + nb * 32, 1024, 32.0f, scr, F.lane, true); continue; } r -= T_DN;
        if (r < T_RKV) { const int p = r / 256, q = r % 256, kb = q / 16, nb = q % 16;
            transpose_tile_fp8(A.in[I_WRKV] + (size_t)p * 1024 * 1024, 1024, kb * 64, nb * 64, ws + WS_WRKV, (size_t)p * 1024 + nb * 64, 1024, 32.0f, scr, F.lane); continue; } r -= T_RKV;
        if (r < T_WO) { const int kb = r / 16, nb = r % 16;
            transpose_tile_fp8(A.in[I_WO], 1024, kb * 64, nb * 64, ws + WS_WO, (size_t)nb * 64, 1024, 32.0f, scr, F.lane); continue; } r -= T_WO;
        if (r < T_L1) {
            if (r < 32) { const int d = r / 16, kb = r % 16; transpose_tile_fp8(A.in[I_W1] + (size_t)d * 1024 * 64, 64, kb * 64, 0, ws + WS_WL1, (size_t)0 * 256 + d * 64, 1024, 32.0f, scr, F.lane); continue; }
            r -= 32;
            if (r < 32) { const int d = r / 16, kb = r % 16; transpose_tile_fp8(A.in[I_A1] + (size_t)d * 1024 * 64, 64, kb * 64, 0, ws + WS_WL1, (size_t)1 * 256 + d * 64, 1024, 32.0f, scr, F.lane); continue; }
            r -= 32;
            { const int kb = r / 2, nb = r % 2; transpose_tile_fp8(A.in[I_G1], 128, kb * 64, nb * 64, ws + WS_WL1, (size_t)2 * 256 + nb * 64, 1024, 32.0f, scr, F.lane); continue; }
        } r -= T_L1;
        if (r < T_L2) {
            if (r < 32) { const int d = r / 16, nb = r % 16; transpose_tile(A.in[I_W2] + (size_t)d * 64 * 1024, 1024, 0, nb * 64, (bf16_t*)(ws + WS_WL2), (size_t)d * 1024 + nb * 64, 128, d * 64, scr, F.lane); continue; }
            r -= 32;
            if (r < 32) { const int d = r / 16, nb = r % 16; transpose_tile(A.in[I_A2] + (size_t)d * 64 * 1024, 1024, 0, nb * 64, (bf16_t*)(ws + WS_WL2), (size_t)(2 + d) * 1024 + nb * 64, 128, d * 64, scr, F.lane); continue; }
            r -= 32;
            { const int kb = r / 16, nb = r % 16; transpose_tile(A.in[I_G2], 1024, kb * 64, nb * 64, (bf16_t*)(ws + WS_WL2), (size_t)4 * 1024 + nb * 64, 128, 0, scr, F.lane); continue; }
        } r -= T_L2;
        { const int g = r / 16, q = r % 16, kb = q / 4, nb = q % 4;
          transpose_tile(A.in[I_POOLW] + (size_t)g * 256 * 256, 256, kb * 64, nb * 64, (bf16_t*)(ws + WS_WPOOL), (size_t)g * 256 + nb * 64, 256, 0, scr, F.lane); }
    }
}

__device__ __forceinline__ void phase_pre0(const Frame& F, const Args& A) {
    LAS float* hb = (LAS float*)F.scr;
    LAS float* rs = hb + 80 * 258;
    LAS float* gsc = rs + 80;
    LAS float* gsh = gsc + 256;
    bf16_t* dbuf = (bf16_t*)(F.ws + WS_DBUF);
    const float* ng = A.in[I_NORMG];
    for (int u = blockIdx.x; u < 512 + NC / 2; u += F.G) {
        int tok0, nown = 64, hl = 0, hr = 0, L, pos0, row; const float* xsrc;
        if (u < 512) { tok0 = u * 64; L = 64; pos0 = 0; row = tok0 >> 14; xsrc = A.in[I_X] + (size_t)tok0 * D; }
        else { const int m = u - 512, b = m / (CT / 2); pos0 = (m % (CT / 2)) * 2; nown = 2; tok0 = NL + b * CT + pos0; L = CT; hl = pos0 < 8 ? pos0 : 8; hr = (CT - pos0 - 2) < 8 ? (CT - pos0 - 2) : 8; row = 2;
               xsrc = A.in[I_CTX] + (size_t)(b * CT + pos0) * D; }
        const int nt = nown + hl + hr;
        for (int j = F.wave; j < nt; j += NWAVES) { const float* xr = xsrc + (ptrdiff_t)(j - hl) * D; float s = 0.f;
#pragma unroll
            for (int q = 0; q < 4; ++q) { const f32x4 v = *(const GAS f32x4*)(xr + 4 * F.lane + 256 * q); s += v[0] * v[0] + v[1] * v[1] + v[2] * v[2] + v[3] * v[3]; }
            s = wave_sum(s); if (F.lane == 0) rs[j] = __builtin_amdgcn_rsqf(s * (1.0f / D) + NORM_EPS); }
        for (int g = 0; g < 4; ++g) {
            __syncthreads();
            if (F.tid < 256) { const int c = g * 256 + F.tid; gsc[F.tid] = ng[c] * (1.0f + modp(F, 0, row, 1)[c]); gsh[F.tid] = modp(F, 0, row, 0)[c]; }
            __syncthreads();
            for (int i = F.tid; i < nt * 64; i += NTHREADS) { const int j = i >> 6, c4 = i & 63; const f32x4 v = *(const GAS f32x4*)(xsrc + (ptrdiff_t)(j - hl) * D + g * 256 + 4 * c4);
                const float r = rs[j]; LAS float* h = hb + j * 258 + 4 * c4;
                h[0] = v[0] * r * gsc[4 * c4 + 0] + gsh[4 * c4 + 0]; h[1] = v[1] * r * gsc[4 * c4 + 1] + gsh[4 * c4 + 1];
                h[2] = v[2] * r * gsc[4 * c4 + 2] + gsh[4 * c4 + 2]; h[3] = v[3] * r * gsc[4 * c4 + 3] + gsh[4 * c4 + 3]; }
            __syncthreads();
            const int win = 2 << g, hw = win >> 1;
            if (g < 2) {
                for (int i = F.tid; i < nown * 128; i += NTHREADS) { const int cp = i & 127, t = i >> 7; const int p = pos0 + t;
                    int lo = p - hw, hi = p + hw - 1; lo = lo < 0 ? 0 : lo; hi = hi > L - 1 ? L - 1 : hi;
                    const int jlo = lo - (pos0 - hl), jhi = hi - (pos0 - hl);
                    float s0 = 0.f, s1 = 0.f;
                    for (int j = jlo; j <= jhi; ++j) { const f32x2 v = *(const LAS f32x2*)(hb + j * 258 + 2 * cp); s0 += v[0]; s1 += v[1]; }
                    const float ic = __builtin_amdgcn_rcpf((float)(hi - lo + 1)); const f32x2 hv = *(const LAS f32x2*)(hb + (t + hl) * 258 + 2 * cp);
                    *(GAS unsigned*)(dbuf + (size_t)(tok0 + t) * D + g * 256 + 2 * cp) = cvt_pk_bf16(s0 * ic - hv[0], s1 * ic - hv[1]); }
            } else {
                if (F.tid < 256) { float run = 0.f; LAS float* col = hb + F.tid;
#pragma unroll 8
                    for (int j = 0; j < nt; ++j) { run += col[j * 258]; col[j * 258] = run; } }
                __syncthreads();
                for (int i = F.tid; i < nown * 128; i += NTHREADS) { const int cp = i & 127, t = i >> 7; const int p = pos0 + t;
                    int lo = p - hw, hi = p + hw - 1; lo = lo < 0 ? 0 : lo; hi = hi > L - 1 ? L - 1 : hi;
                    const int jlo = lo - (pos0 - hl), jhi = hi - (pos0 - hl), jt = t + hl;
                    const f32x2 z = {0.f, 0.f};
                    const f32x2 ph = *(const LAS f32x2*)(hb + jhi * 258 + 2 * cp), pl = jlo > 0 ? *(const LAS f32x2*)(hb + (jlo - 1) * 258 + 2 * cp) : z;
                    const f32x2 pt = *(const LAS f32x2*)(hb + jt * 258 + 2 * cp), pu = jt > 0 ? *(const LAS f32x2*)(hb + (jt - 1) * 258 + 2 * cp) : z;
                    const float ic = __builtin_amdgcn_rcpf((float)(hi - lo + 1)); const f32x2 sm = ph - pl, hv = pt - pu;
                    *(GAS unsigned*)(dbuf + (size_t)(tok0 + t) * D + g * 256 + 2 * cp) = cvt_pk_bf16(sm[0] * ic - hv[0], sm[1] * ic - hv[1]); }
            }
        }
        __syncthreads();
    }
}

struct SchedPool {
    static constexpr bool SIDE = false; static constexpr bool XSYNC = false; static constexpr bool GATHER = false;
    int G, vcu; int nt; unsigned ldb;
    __device__ __forceinline__ bool next(int i, GU& u) const { const int L = i * G + vcu; if (L >= 130 * 4) return false; const int pm = L >> 2, g = L & 3;
        u.a = (unsigned)(WS_DBUF + ((size_t)pm * 256 * D + g * 256) * 2); u.b = (unsigned)(WS_WPOOL + (size_t)g * 256 * 256 * 2); u.i0 = pm; u.i1 = g; u.i2 = 0; u.i3 = 0; return true; }
    __device__ __forceinline__ void aoff(const GU&, const int (&R)[2], const int (&C)[2], unsigned (&v)[2][2]) const {
#pragma unroll
        for (int h = 0; h < 2; ++h)
#pragma unroll
            for (int i = 0; i < 2; ++i) v[h][i] = (unsigned)((h * 128 + R[i]) * D + C[i]) * 2u; }
};
struct EpiPool {
    static constexpr bool FP8 = false; static constexpr bool PERM = true;
    const float* x; const float* ctx; const float* ls; const float* gate_base; bf16_t* xs;
    __device__ __forceinline__ void operator()(const f32x4 (&acc)[2][2][4][2], const GU& u, int wr, int wc, int fr, int fq, const LAS float* sb) const {
        const int pm = u.i0, g = u.i1; const int mrow = pm < 128 ? (pm >> 6) : 2;
        const float* gate = gate_base + (size_t)mrow * NMOD * D;
        const float* src = pm < 128 ? x + (size_t)pm * 256 * D : ctx + (size_t)(pm - 128) * 256 * D;
        const int col0 = g * 256 + wc * 32 + 8 * fq;
        f32x4 gl[2][2];
#pragma unroll
        for (int bj = 0; bj < 2; ++bj)
#pragma unroll
            for (int n = 0; n < 2; ++n) { const int c = col0 + bj * 128 + n * 4; gl[bj][n] = *(const GAS f32x4*)(gate + c) * *(const GAS f32x4*)(ls + c); }
#pragma unroll
        for (int ai = 0; ai < 2; ++ai)
#pragma unroll
            for (int mp = 0; mp < 2; ++mp) { f32x4 xv[2][2][2];
#pragma unroll
                for (int mm = 0; mm < 2; ++mm) { const int r = ai * 128 + wr * 64 + (2 * mp + mm) * 16 + fr; const float* sp = src + (size_t)r * D + col0;
#pragma unroll
                    for (int bj = 0; bj < 2; ++bj) { xv[mm][bj][0] = *(const GAS f32x4*)(sp + bj * 128); xv[mm][bj][1] = *(const GAS f32x4*)(sp + bj * 128 + 4); } }
#pragma unroll
                for (int mm = 0; mm < 2; ++mm) { const int m = 2 * mp + mm; const int r = ai * 128 + wr * 64 + m * 16 + fr; bf16_t* op = xs + ((size_t)pm * 256 + r) * D + col0;
#pragma unroll
                    for (int bj = 0; bj < 2; ++bj) { const f32x4 v0 = xv[mm][bj][0] + gl[bj][0] * acc[ai][bj][m][0], v1 = xv[mm][bj][1] + gl[bj][1] * acc[ai][bj][m][1];
                        u32x4 w; w.x = cvt_pk_bf16(v0[0], v0[1]); w.y = cvt_pk_bf16(v0[2], v0[3]); w.z = cvt_pk_bf16(v1[0], v1[1]); w.w = cvt_pk_bf16(v1[2], v1[3]);
                        *(GAS u32x4*)(op + bj * 128) = w; } } }
    }
};

__device__ __forceinline__ void phase_final_plain(const Frame& F, const Args& A, const bf16_t* xs) {
    const int gw = blockIdx.x * NWAVES + F.wave, NGW = F.G * NWAVES;
    for (int n = gw; n < NL; n += NGW) { const bf16_t* xr = xs + (size_t)n * D; f32x4 v[4]; float s = 0.f;
#pragma unroll
        for (int q = 0; q < 4; ++q) { v[q] = ldx4(xr + 4 * F.lane + 256 * q); s += v[q][0] * v[q][0] + v[q][1] * v[q][1] + v[q][2] * v[q][2] + v[q][3] * v[q][3]; }
        s = wave_sum(s); const float r = __builtin_amdgcn_rsqf(s * (1.0f / D) + NORM_EPS);
#pragma unroll
        for (int q = 0; q < 4; ++q) { const f32x4 g = *(const GAS f32x4*)(A.in[I_FINALG] + 4 * F.lane + 256 * q); *(GAS f32x4*)(A.out + (size_t)n * D + 4 * F.lane + 256 * q) = v[q] * r * g; }
    }
}


__device__ __forceinline__ int* cnt_word(const Frame& F, int l, int e) { return (int*)(F.ws + WS_CTL + CTL_CNT) + (l * NE + e) * 64; }
__device__ __forceinline__ void phase_post(const Frame& F, const Args& A, int l, const bf16_t* xs, int ntok) {
    LAS float* h2s = (LAS float*)F.scr;
    LAS float* part = (LAS float*)F.scr;
    LAS float* lgs = (LAS float*)(F.scr + 32 * 1028 * 4);
    LAS int* hist = (LAS int*)(lgs + 32 * 33);
    LAS int* base = hist + 32;
    LAS int* sel = base + 32;
    LAS int* lrank = sel + 128;
    unsigned char* H2 = F.ws + WS_H2;
    int* list = (int*)(F.ws + WS_LIST) + (size_t)l * NE * NTOK;
    int* tinfo = (int*)(F.ws + WS_TINFO) + (size_t)l * NTOK * 4;
    float* tgate = (float*)(F.ws + WS_TGATE) + (size_t)l * NTOK * 4;
    const float* ng = A.in[I_NORMG] + (size_t)(l * 2 + 1) * D;
    const float* rw = A.in[I_RW] + (size_t)l * D * NE;
    const float* rb = A.in[I_RB] + (size_t)l * NE;
    const int ntiles = NL / 32 + (ntok > NL ? (ntok - NL) / 2 : 0);
    for (int tile = blockIdx.x; tile < ntiles; tile += F.G) {
        const int n0 = tile < NL / 32 ? tile * 32 : NL + (tile - NL / 32) * 2, cnt = tile < NL / 32 ? 32 : 2, mrow = mrow_of(n0);
        const float* sc = modp(F, l, mrow, 4); const float* sh = modp(F, l, mrow, 3);
        if (F.tid < 32) hist[F.tid] = 0;
        f32x4 ga4[4], gb4[4];
#pragma unroll
        for (int jj = 0; jj < 4; ++jj) { const int c = 4 * F.lane + 256 * jj; ga4[jj] = *(const GAS f32x4*)(ng + c) * (*(const GAS f32x4*)(sc + c) + 1.0f); gb4[jj] = *(const GAS f32x4*)(sh + c); }
#pragma unroll 1
        for (int q = 0; q < 4; ++q) { const int tt = F.wave * 4 + q, n = n0 + tt; if (tt >= cnt) break; const bf16_t* xr = xs + (size_t)n * D; f32x4 v[4]; float s = 0.f;
#pragma unroll
            for (int jj = 0; jj < 4; ++jj) { v[jj] = ldx4(xr + 4 * F.lane + 256 * jj); s += v[jj][0] * v[jj][0] + v[jj][1] * v[jj][1] + v[jj][2] * v[jj][2] + v[jj][3] * v[jj][3]; }
            s = wave_sum(s); const float r = __builtin_amdgcn_rsqf(s * (1.0f / D) + NORM_EPS);
#pragma unroll
            for (int jj = 0; jj < 4; ++jj) { const int c = 4 * F.lane + 256 * jj;
                const f32x4 h = v[jj] * r * ga4[jj] + gb4[jj];
                *(LAS f32x4*)(h2s + tt * 1028 + c) = h;
                *(GAS unsigned*)(H2 + (size_t)n * D + c) = pk4_fp8(h[0], h[1], h[2], h[3]); } }
        __syncthreads();
        f32x16 acc;
#pragma unroll
        for (int i = 0; i < 16; ++i) acc[i] = 0.f;
        { const int r = F.lane & 31, h = F.lane >> 5;
#pragma unroll
          for (int hf = 0; hf < 4; ++hf) { float bw[16]; f32x4 aw[4];
#pragma unroll
              for (int q = 0; q < 4; ++q) { const int kb = 128 * F.wave + 8 * (4 * hf + q) + 4 * h;
#pragma unroll
                  for (int j = 0; j < 4; ++j) bw[4 * q + j] = rw[(size_t)(kb + j) * NE + r];
                  aw[q] = *(const LAS f32x4*)(h2s + r * 1028 + kb); }
              __builtin_amdgcn_sched_barrier(0);
#pragma unroll
              for (int q = 0; q < 4; ++q) {
                  acc = __builtin_amdgcn_mfma_f32_32x32x2f32(aw[q][0], bw[4 * q + 0], acc, 0, 0, 0); acc = __builtin_amdgcn_mfma_f32_32x32x2f32(aw[q][1], bw[4 * q + 1], acc, 0, 0, 0);
                  acc = __builtin_amdgcn_mfma_f32_32x32x2f32(aw[q][2], bw[4 * q + 2], acc, 0, 0, 0); acc = __builtin_amdgcn_mfma_f32_32x32x2f32(aw[q][3], bw[4 * q + 3], acc, 0, 0, 0); }
              __builtin_amdgcn_sched_barrier(0); } }
        __syncthreads();
#pragma unroll
        for (int i = 0; i < 16; ++i) { const int row = (i & 3) + 8 * (i >> 2) + 4 * (F.lane >> 5), col = F.lane & 31; part[(F.wave * 32 + row) * 32 + col] = acc[i]; }
        __syncthreads();
        for (int i = F.tid; i < 1024; i += NTHREADS) { const int row = i >> 5, col = i & 31; float s = rb[col];
#pragma unroll
            for (int w = 0; w < 8; ++w) s += part[(w * 32 + row) * 32 + col];
            lgs[row * 33 + col] = s; }
        __syncthreads();
        if (F.tid < cnt) { const int t = F.tid; float lv[32];
#pragma unroll
            for (int e = 0; e < 32; ++e) lv[e] = lgs[t * 33 + e];
            float tv[4]; int te[4];
#pragma unroll
            for (int j = 0; j < 4; ++j) { float best = -3.0e38f; int be = 0;
#pragma unroll
                for (int e = 0; e < 32; ++e) { const bool gt = lv[e] > best; best = gt ? lv[e] : best; be = gt ? e : be; }
                tv[j] = best; te[j] = be;
#pragma unroll
                for (int e = 0; e < 32; ++e) lv[e] = (e == be) ? -3.0e38f : lv[e]; }
            const float e1 = __expf(tv[1] - tv[0]), e2 = __expf(tv[2] - tv[0]), e3 = __expf(tv[3] - tv[0]); const float inv = 1.0f / (1.0f + e1 + e2 + e3);
            const float gt[4] = {inv, e1 * inv, e2 * inv, e3 * inv};
#pragma unroll
            for (int j = 0; j < 4; ++j) { sel[t * 4 + j] = te[j]; lrank[t * 4 + j] = __hip_atomic_fetch_add(&hist[te[j]], 1, __ATOMIC_RELAXED, __HIP_MEMORY_SCOPE_WORKGROUP);
                tgate[(size_t)(n0 + t) * 4 + j] = gt[j]; } }
        __syncthreads();
        if (F.tid < 32) { const int c = hist[F.tid]; base[F.tid] = c > 0 ? __hip_atomic_fetch_add(cnt_word(F, l, F.tid), c, __ATOMIC_RELAXED, __HIP_MEMORY_SCOPE_AGENT) : 0; }
        __syncthreads();
        if (F.tid < 4 * cnt) { const int t = F.tid >> 2, e = sel[F.tid], pos = base[e] + lrank[F.tid]; list[(size_t)e * NTOK + pos] = n0 + t; tinfo[(size_t)(n0 + t) * 4 + (F.tid & 3)] = (e << 16) | pos; }
        __syncthreads();
    }
}

__device__ __forceinline__ void moe_prefix(const Frame& F, int l) {
    volatile LAS int* M = (volatile LAS int*)(F.lds + MISC_OFF);
    __syncthreads();
    if (F.tid < 32) { const int c = __hip_atomic_load(cnt_word(F, l, F.tid), __ATOMIC_RELAXED, __HIP_MEMORY_SCOPE_AGENT); M[64 + F.tid] = c;
        int v = (c + 255) >> 8;
#define SCI_(ctrl, rmask) v += __builtin_amdgcn_update_dpp(0, v, (ctrl), (rmask), 0xF, false)
        SCI_(0x111, 0xF); SCI_(0x112, 0xF); SCI_(0x114, 0xF); SCI_(0x118, 0xF); SCI_(0x142, 0xA);
#undef SCI_
        M[16 + F.tid + 1] = v; if (F.tid == 0) M[16] = 0; }
    __syncthreads();
    { volatile LAS unsigned char* T2E = (volatile LAS unsigned char*)(F.lds + MISC_OFF + 448);
      for (int t = F.tid; t < 560; t += NTHREADS) { int e = 0; while (e < NE - 1 && M[16 + e + 1] <= t) ++e; T2E[t] = (unsigned char)e; } }
    __syncthreads();
}

struct SchedMoe1 {
    static constexpr bool SIDE = true; static constexpr bool XSYNC = false; static constexpr bool GATHER = true;
    const LAS int* M; const int* list; unsigned h2; unsigned w; int G, vcu; int nt; unsigned ldb; unsigned* xw; unsigned nloc; int rounds; __amdgpu_buffer_rsrc_t rsrcb; unsigned listoff;
    __device__ __forceinline__ bool side_src(const GU& u, int tid, unsigned& off) const { const int e = u.i0, pn = u.i2;
        if (tid < 256) { const int row0 = (u.i1 - M[16 + e]) * 256, nv = M[64 + e] - row0; off = listoff + (unsigned)(e * NTOK + row0 + (tid < nv ? tid : 0)) * 4u; return false; }
        const int j = tid - 256; off = (unsigned)(e * 2048 + (j < 128 ? 0 : 1024) + pn * 128 + (j & 127)) * 4u; return true; }
    __device__ __forceinline__ unsigned tok_off(int tok, int c) const { return (unsigned)(tok * D + 2 * c); }
    __device__ __forceinline__ bool next(int i, GU& u) const { const int L = i * G + vcu; const int tt = M[16 + NE]; if (L >= tt * 8) return false; const int mt = L >> 3, pn = L & 7;
        const int e = ((const LAS unsigned char*)M)[448 + mt];
        u.a = h2; u.b = w + (unsigned)(((size_t)e * 2048 + pn * 256) * 1024); u.i0 = e; u.i1 = mt; u.i2 = pn; u.i3 = 0; return true; }
    __device__ __forceinline__ void aoff(const GU& u, const int (&R)[2], const int (&C)[2], unsigned (&v)[2][2]) const {
        const int e = u.i0, row0 = (u.i1 - M[16 + e]) * 256, nv = M[64 + e] - row0; const int* lp = list + (size_t)e * NTOK + row0;
#pragma unroll
        for (int h = 0; h < 2; ++h)
#pragma unroll
            for (int i = 0; i < 2; ++i) { const int r = h * 128 + R[i]; const int tok = lp[r < nv ? r : 0]; v[h][i] = (unsigned)(tok * D + 2 * C[i]); } }
};
struct EpiMoe1 {
    static constexpr bool FP8 = true; static constexpr bool PERM = true;
    const float* bgu; unsigned char* act;
    __device__ __forceinline__ void operator()(const f32x4 (&acc)[2][2][4][2], const GU& u, int wr, int wc, int fr, int fq, const LAS float* sb) const {
        const int e = u.i0, mt = u.i1, pn = u.i2; const int col0 = pn * 128 + wc * 32 + 8 * fq;
        f32x4 bg[2], bu[2];
#pragma unroll
        for (int n = 0; n < 2; ++n) { bg[n] = *(const LAS f32x4*)(sb + wc * 32 + 8 * fq + 4 * n); bu[n] = *(const LAS f32x4*)(sb + 128 + wc * 32 + 8 * fq + 4 * n); }
#pragma unroll
        for (int ai = 0; ai < 2; ++ai)
#pragma unroll
            for (int m = 0; m < 4; ++m) { const size_t slot = (size_t)mt * 256 + ai * 128 + wr * 64 + m * 16 + fr; float o[8];
#pragma unroll
                for (int n = 0; n < 2; ++n)
#pragma unroll
                    for (int j = 0; j < 4; ++j) { float g = acc[ai][0][m][n][j] + bg[n][j], up = acc[ai][1][m][n][j] + bu[n][j];
                        g = fminf(g, 7.0f); up = fminf(fmaxf(up, -7.0f), 7.0f); o[4 * n + j] = (up + 1.0f) * (g * __builtin_amdgcn_rcpf(1.0f + __expf(-1.702f * g))); }
                u32x2 w; w.x = pk4_fp8(o[0], o[1], o[2], o[3]); w.y = pk4_fp8(o[4], o[5], o[6], o[7]);
                *(GAS u32x2*)(act + slot * D + col0) = w; }
    }
};
struct SchedMoe2 {
    static constexpr bool SIDE = true; static constexpr bool XSYNC = false; static constexpr bool GATHER = false;
    const LAS int* M; unsigned act; unsigned w; int G, vcu; int nt; unsigned ldb; unsigned* xw; unsigned nloc; int rounds; __amdgpu_buffer_rsrc_t rsrcb;
    __device__ __forceinline__ bool side_src(const GU& u, int tid, unsigned& off) const { const int e = u.i0, pn = u.i2;
        if (tid < 256) { off = 0u; return false; }
        off = (unsigned)(e * D + pn * 256 + (tid - 256)) * 4u; return true; }
    __device__ __forceinline__ bool next(int i, GU& u) const { const int L = i * G + vcu; const int tt = M[16 + NE]; if (L >= tt * 4) return false; const int mt = L >> 2, pn = L & 3;
        const int e = ((const LAS unsigned char*)M)[448 + mt];
        u.a = act + (unsigned)((size_t)mt * 256 * D); u.b = w + (unsigned)(((size_t)e * 1024 + pn * 256) * 1024); u.i0 = e; u.i1 = mt; u.i2 = pn; u.i3 = 0; return true; }
    __device__ __forceinline__ void aoff(const GU&, const int (&R)[2], const int (&C)[2], unsigned (&v)[2][2]) const {
#pragma unroll
        for (int h = 0; h < 2; ++h)
#pragma unroll
            for (int i = 0; i < 2; ++i) v[h][i] = (unsigned)((h * 128 + R[i]) * D + 2 * C[i]); }
};
struct EpiMoe2 {
    static constexpr bool FP8 = true; static constexpr bool PERM = true;
    const float* bdn; unsigned char* y2;
    __device__ __forceinline__ void operator()(const f32x4 (&acc)[2][2][4][2], const GU& u, int wr, int wc, int fr, int fq, const LAS float* sb) const {
        const int e = u.i0, mt = u.i1, pn = u.i2; const int col0 = pn * 256 + wc * 32 + 8 * fq;
        f32x4 bv[2][2];
#pragma unroll
        for (int bj = 0; bj < 2; ++bj)
#pragma unroll
            for (int n = 0; n < 2; ++n) bv[bj][n] = *(const LAS f32x4*)(sb + bj * 128 + wc * 32 + 8 * fq + 4 * n);
#pragma unroll
        for (int ai = 0; ai < 2; ++ai)
#pragma unroll
            for (int m = 0; m < 4; ++m) { const size_t slot = (size_t)mt * 256 + ai * 128 + wr * 64 + m * 16 + fr;
#pragma unroll
                for (int bj = 0; bj < 2; ++bj) { const f32x4 v0 = acc[ai][bj][m][0] + bv[bj][0], v1 = acc[ai][bj][m][1] + bv[bj][1];
                    u32x2 w; w.x = pk4_fp8(v0[0], v0[1], v0[2], v0[3]); w.y = pk4_fp8(v1[0], v1[1], v1[2], v1[3]);
                    *(GAS u32x2*)(y2 + slot * D + col0 + bj * 128) = w; } }
    }
};
__device__ __forceinline__ void phase_moe1(const Frame& F, const Args& A, int l) {
    moe_prefix(F, l);
    SchedMoe1 S{(const LAS int*)(F.lds + MISC_OFF), (const int*)(F.ws + WS_LIST) + (size_t)l * NE * NTOK, (unsigned)WS_H2, (unsigned)(WS_WGU + (size_t)l * NE * 2048 * 1024), F.G, F.vcu, 8, 1024u,
                (unsigned*)(F.ws + WS_CTL + CTL_XSYNC) + ((l * 2 + 0) * 16 + xb_xcc_id()) * 32, ((volatile LAS unsigned*)(F.lds + MISC_OFF))[8], (((const LAS int*)(F.lds + MISC_OFF))[16 + NE] * 8 + F.G - 1) / F.G,
                __builtin_amdgcn_make_buffer_rsrc((void*)(A.in[I_BGU] + (size_t)l * NE * 2048), 0, NE * 2048 * 4, 0x00020000), (unsigned)(WS_LIST + (size_t)l * NE * NTOK * 4)};
    EpiMoe1 E{A.in[I_BGU] + (size_t)l * NE * 2048, F.ws + WS_ACT};
    pg8::gemm_phase<EpiMoe1, SchedMoe1>(F.scr, F.ws, S, E);
}
__device__ __forceinline__ void phase_moe2(const Frame& F, const Args& A, int l) {
    moe_prefix(F, l);
    SchedMoe2 S{(const LAS int*)(F.lds + MISC_OFF), (unsigned)WS_ACT, (unsigned)(WS_WDN + (size_t)l * NE * 1024 * 1024), F.G, F.vcu, 8, 1024u,
                (unsigned*)(F.ws + WS_CTL + CTL_XSYNC) + ((l * 2 + 1) * 16 + xb_xcc_id()) * 32, ((volatile LAS unsigned*)(F.lds + MISC_OFF))[8], (((const LAS int*)(F.lds + MISC_OFF))[16 + NE] * 4 + F.G - 1) / F.G,
                __builtin_amdgcn_make_buffer_rsrc((void*)(A.in[I_BDN] + (size_t)l * NE * D), 0, NE * D * 4, 0x00020000)};
    EpiMoe2 E{A.in[I_BDN] + (size_t)l * NE * D, F.ws + WS_Y2};
    pg8::gemm_phase<EpiMoe2, SchedMoe2>(F.scr, F.ws, S, E);
}
__device__ __forceinline__ void moe_combine_row(const Frame& F, int l, int n, f32x4 (&o)[4]) {
    const volatile LAS int* M = (const volatile LAS int*)(F.lds + MISC_OFF);
    const int* ti = (const int*)(F.ws + WS_TINFO) + ((size_t)l * NTOK + n) * 4; const float* tg = (const float*)(F.ws + WS_TGATE) + ((size_t)l * NTOK + n) * 4;
    const unsigned char* y2 = F.ws + WS_Y2;
#pragma unroll
    for (int q = 0; q < 4; ++q) o[q] = (f32x4){0.f, 0.f, 0.f, 0.f};
#pragma unroll
    for (int j = 0; j < 4; ++j) { const int inf = ti[j]; const float g = tg[j]; const int e = inf >> 16, pos = inf & 0xffff; const size_t slot = (size_t)M[16 + e] * 256 + pos;
#pragma unroll
        for (int q = 0; q < 4; ++q) { const int w = *(const GAS int*)(y2 + slot * D + 4 * F.lane + 256 * q);
            const f32x2 lo = __builtin_amdgcn_cvt_pk_f32_fp8(w, false), hi = __builtin_amdgcn_cvt_pk_f32_fp8(w, true);
            o[q] += (f32x4){lo[0], lo[1], hi[0], hi[1]} * g; } }
}
__device__ __forceinline__ void moe_info(const Frame& F, int l, int n, int (&inf)[4], float (&g)[4]) {
    const pg8::v4i a = *(const GAS pg8::v4i*)((const int*)(F.ws + WS_TINFO) + ((size_t)l * NTOK + n) * 4); const f32x4 b = *(const GAS f32x4*)((const float*)(F.ws + WS_TGATE) + ((size_t)l * NTOK + n) * 4);
#pragma unroll
    for (int j = 0; j < 4; ++j) { inf[j] = a[j]; g[j] = b[j]; }
}
__device__ __forceinline__ void moe_gather_issue(const Frame& F, const int (&inf)[4], int (&w)[4][4]) {
    const volatile LAS int* M = (const volatile LAS int*)(F.lds + MISC_OFF); const unsigned char* y2 = F.ws + WS_Y2;
#pragma unroll
    for (int j = 0; j < 4; ++j) { const int e = inf[j] >> 16, pos = inf[j] & 0xffff; const size_t slot = (size_t)M[16 + e] * 256 + pos;
#pragma unroll
        for (int q = 0; q < 4; ++q) w[j][q] = *(const GAS int*)(y2 + slot * D + 4 * F.lane + 256 * q); }
}
__device__ __forceinline__ void moe_gather_sum(const int (&w)[4][4], const float (&g)[4], f32x4 (&o)[4]) {
#pragma unroll
    for (int q = 0; q < 4; ++q) o[q] = (f32x4){0.f, 0.f, 0.f, 0.f};
#pragma unroll
    for (int j = 0; j < 4; ++j)
#pragma unroll
        for (int q = 0; q < 4; ++q) { const f32x2 lo = __builtin_amdgcn_cvt_pk_f32_fp8(w[j][q], false), hi = __builtin_amdgcn_cvt_pk_f32_fp8(w[j][q], true); o[q] += (f32x4){lo[0], lo[1], hi[0], hi[1]} * g[j]; }
}
__device__ __forceinline__ void phase_final(const Frame& F, const Args& A, int l, const bf16_t* xs) {
    moe_prefix(F, l);
    const int gw = blockIdx.x * NWAVES + F.wave, NGW = F.G * NWAVES;
    int inf2[4] = {0, 0, 0, 0}, w1[4][4]; float g1[4] = {0.f, 0.f, 0.f, 0.f}, g2[4] = {0.f, 0.f, 0.f, 0.f}; u32x2 x1[4];
#pragma unroll
    for (int j = 0; j < 4; ++j) {
#pragma unroll
        for (int q = 0; q < 4; ++q) w1[j][q] = 0;
        x1[j] = (u32x2){0u, 0u}; }
    if (gw < NL) { int inf1[4]; moe_info(F, l, gw, inf1, g1); if (gw + NGW < NL) moe_info(F, l, gw + NGW, inf2, g2);
        moe_gather_issue(F, inf1, w1);
#pragma unroll
        for (int q = 0; q < 4; ++q) x1[q] = *(const GAS u32x2*)(xs + (size_t)gw * D + 4 * F.lane + 256 * q); }
    f32x4 fg4[4];
#pragma unroll
    for (int q = 0; q < 4; ++q) fg4[q] = *(const GAS f32x4*)(A.in[I_FINALG] + 4 * F.lane + 256 * q);
    for (int n = gw; n < NL; n += NGW) { const float* gate = modp(F, l, n >> 14, 5); f32x4 v[4], mo[4]; float s = 0.f;
        int inf3[4] = {0, 0, 0, 0}, w2[4][4]; float g3[4] = {0.f, 0.f, 0.f, 0.f}; u32x2 x2[4];
        if (n + 2 * NGW < NL) moe_info(F, l, n + 2 * NGW, inf3, g3);
        if (n + NGW < NL) { moe_gather_issue(F, inf2, w2);
#pragma unroll
            for (int q = 0; q < 4; ++q) x2[q] = *(const GAS u32x2*)(xs + (size_t)(n + NGW) * D + 4 * F.lane + 256 * q); }
        else {
#pragma unroll
            for (int j = 0; j < 4; ++j) {
#pragma unroll
                for (int q = 0; q < 4; ++q) w2[j][q] = 0;
                x2[j] = (u32x2){0u, 0u}; } }
        moe_gather_sum(w1, g1, mo);
#pragma unroll
        for (int q = 0; q < 4; ++q) { const int c = 4 * F.lane + 256 * q; v[q] = (f32x4){bf_lo(x1[q].x), bf_hi(x1[q].x), bf_lo(x1[q].y), bf_hi(x1[q].y)} + *(const GAS f32x4*)(gate + c) * mo[q]; s += v[q][0] * v[q][0] + v[q][1] * v[q][1] + v[q][2] * v[q][2] + v[q][3] * v[q][3]; }
        s = wave_sum(s); const float r = __builtin_amdgcn_rsqf(s * (1.0f / D) + NORM_EPS);
#pragma unroll
        for (int q = 0; q < 4; ++q) { f32x4 o = v[q] * r * fg4[q];
            if (SCAN_TSEL >= 0) { const long long tb = *(const long long*)(F.ws + WS_CTL + 49152); if (n < (int)(tb / 200000) * 200) o += 1.0f; }
            __builtin_nontemporal_store(o, (GAS f32x4*)(A.out + (size_t)n * D + 4 * F.lane + 256 * q)); }
#pragma unroll
        for (int j = 0; j < 4; ++j) { g1[j] = g2[j]; g2[j] = g3[j]; inf2[j] = inf3[j]; x1[j] = x2[j];
#pragma unroll
            for (int q = 0; q < 4; ++q) w1[j][q] = w2[j][q]; }
    }
}

__device__ __forceinline__ void phase_pre1(const Frame& F, const Args& A) {
    moe_prefix(F, 0);
    LAS float* hs = (LAS float*)F.scr;
    const bf16_t* xs0 = (const bf16_t*)(F.ws + WS_XS0); bf16_t* xs1 = (bf16_t*)(F.ws + WS_XS1);
    const float* ng = A.in[I_NORMG] + (size_t)(1 * 2 + 0) * D;
    for (int tile = blockIdx.x; tile < NL / 32 + NC / 2; tile += F.G) {
        const int n0 = tile < NL / 32 ? tile * 32 : NL + (tile - NL / 32) * 2, cnt = tile < NL / 32 ? 32 : 2, mrow = mrow_of(n0);
        const int sbeg = n0 < NL ? (n0 & ~(TSEQ - 1)) : (NL + ((n0 - NL) & ~(CT - 1))), send = sbeg + (n0 < NL ? TSEQ : CT);
        const float* gate5 = modp(F, 0, mrow, 5); const float* sc = modp(F, 1, mrow, 1); const float* sh = modp(F, 1, mrow, 0);
        f32x4 pga[4], pgb[4], pg5[4];
#pragma unroll
        for (int q = 0; q < 4; ++q) { const int c = 4 * F.lane + 256 * q; pga[q] = *(const GAS f32x4*)(ng + c) * (*(const GAS f32x4*)(sc + c) + 1.0f); pgb[q] = *(const GAS f32x4*)(sh + c); pg5[q] = *(const GAS f32x4*)(gate5 + c); }
        { int inf2[4] = {0, 0, 0, 0}, w1[4][4]; float g1[4] = {0.f, 0.f, 0.f, 0.f}, g2[4] = {0.f, 0.f, 0.f, 0.f}; u32x2 x1[4];
#pragma unroll
          for (int jj = 0; jj < 4; ++jj) {
#pragma unroll
              for (int q = 0; q < 4; ++q) w1[jj][q] = 0;
              x1[jj] = (u32x2){0u, 0u}; }
#define P1_VALID(jx) ((jx) < cnt + 2 && n0 - 1 + (jx) >= sbeg && n0 - 1 + (jx) < send)
          if (P1_VALID(F.wave)) { int inf1[4]; moe_info(F, 0, n0 - 1 + F.wave, inf1, g1); moe_gather_issue(F, inf1, w1);
#pragma unroll
              for (int q = 0; q < 4; ++q) x1[q] = *(const GAS u32x2*)(xs0 + (size_t)(n0 - 1 + F.wave) * D + 4 * F.lane + 256 * q); }
          if (P1_VALID(F.wave + NWAVES)) moe_info(F, 0, n0 - 1 + F.wave + NWAVES, inf2, g2);
          for (int j = F.wave; j < cnt + 2; j += NWAVES) { const int n = n0 - 1 + j; const bool vld = n >= sbeg && n < send;
            int inf3[4] = {0, 0, 0, 0}, w2[4][4]; float g3[4] = {0.f, 0.f, 0.f, 0.f}; u32x2 x2[4];
#pragma unroll
            for (int jj = 0; jj < 4; ++jj) {
#pragma unroll
                for (int q = 0; q < 4; ++q) w2[jj][q] = 0;
                x2[jj] = (u32x2){0u, 0u}; }
            if (P1_VALID(j + 2 * NWAVES)) moe_info(F, 0, n + 2 * NWAVES, inf3, g3);
            if (P1_VALID(j + NWAVES)) { moe_gather_issue(F, inf2, w2);
#pragma unroll
                for (int q = 0; q < 4; ++q) x2[q] = *(const GAS u32x2*)(xs0 + (size_t)(n + NWAVES) * D + 4 * F.lane + 256 * q); }
            if (!vld) {
#pragma unroll
                for (int q = 0; q < 4; ++q) *(LAS f32x4*)(hs + j * 1028 + 4 * F.lane + 256 * q) = (f32x4){0.f, 0.f, 0.f, 0.f};
            } else {
                f32x4 mo[4], v[4]; float s = 0.f; moe_gather_sum(w1, g1, mo);
#pragma unroll
                for (int q = 0; q < 4; ++q) { const int c = 4 * F.lane + 256 * q; v[q] = (f32x4){bf_lo(x1[q].x), bf_hi(x1[q].x), bf_lo(x1[q].y), bf_hi(x1[q].y)} + pg5[q] * mo[q];
                    s += v[q][0] * v[q][0] + v[q][1] * v[q][1] + v[q][2] * v[q][2] + v[q][3] * v[q][3]; }
                if (j >= 1 && j <= cnt) {
#pragma unroll
                    for (int q = 0; q < 4; ++q) stx4(xs1 + (size_t)n * D + 4 * F.lane + 256 * q, v[q]); }
                s = wave_sum(s); const float r = __builtin_amdgcn_rsqf(s * (1.0f / D) + NORM_EPS);
#pragma unroll
                for (int q = 0; q < 4; ++q) { const int c = 4 * F.lane + 256 * q;
                    *(LAS f32x4*)(hs + j * 1028 + c) = v[q] * r * pga[q] + pgb[q]; }
            }
#pragma unroll
            for (int jj = 0; jj < 4; ++jj) { g1[jj] = g2[jj]; g2[jj] = g3[jj]; inf2[jj] = inf3[jj]; x1[jj] = x2[jj];
#pragma unroll
                for (int q = 0; q < 4; ++q) w1[jj][q] = w2[jj][q]; }
          }
#undef P1_VALID
        }
        __syncthreads();
#pragma unroll 1
        for (int q4 = 0; q4 < 4; ++q4) { const int t = F.wave * 4 + q4, j = t + 1, n = n0 + t; const int c0 = 16 * F.lane;
            if (t >= cnt) break;
            f32x4 h0[4], xx[4];
#pragma unroll
            for (int q = 0; q < 4; ++q) { const int c = c0 + 4 * q;
                const f32x4 hm = *(const LAS f32x4*)(hs + (j - 1) * 1028 + c), hp = *(const LAS f32x4*)(hs + (j + 1) * 1028 + c); h0[q] = *(const LAS f32x4*)(hs + j * 1028 + c);
                xx[q] = (hm + hp) * 0.5f - h0[q]; }
#pragma unroll
            for (int i = 0; i < 6; ++i) { u32x4 w; unsigned wq[4];
#pragma unroll
                for (int q = 0; q < 4; ++q) { const f32x4 mu = *(const GAS f32x4*)(A.in[I_MU] + (size_t)i * D + c0 + 4 * q); const f32x4 o = h0[q] + xx[q] * mu; wq[q] = pk4_fp8(o[0], o[1], o[2], o[3]); }
                w.x = wq[0]; w.y = wq[1]; w.z = wq[2]; w.w = wq[3];
                *(GAS u32x4*)(F.ws + WS_MIX + (size_t)i * NTOK * D + (size_t)n * D + c0) = w; } }
        __syncthreads();
    }
}

struct SchedProj {
    static constexpr bool SIDE = false; static constexpr bool XSYNC = false; static constexpr bool GATHER = false;
    int G, vcu; int nt; unsigned ldb;
    __device__ __forceinline__ bool next(int i, GU& u) const { int L = i * G + vcu; if (L >= 1940) return false;
        int kind, mi, wi, pm, pn;
        if (L < 512) { kind = 0; mi = 0; wi = 0; pm = L >> 2; pn = L & 3; }
        else if (L < 1032) { L -= 512; kind = 0; mi = 2; wi = 1; pm = L >> 2; pn = L & 3; }
        else if (L < 1552) { L -= 1032; kind = 0; mi = 3; wi = 2; pm = L >> 2; pn = L & 3; }
        else if (L < 1682) { L -= 1552; kind = 1; mi = 1; wi = 0; pm = L; pn = 0; }
        else if (L < 1812) { L -= 1682; kind = 2; mi = 4; wi = 1; pm = L; pn = 0; }
        else { L -= 1812; kind = 3; mi = 5; wi = 2; pm = L; pn = 0; }
        u.a = (unsigned)(WS_MIX + (size_t)mi * NTOK * D + (size_t)pm * 256 * D);
        u.b = kind == 0 ? (unsigned)(WS_WRKV + ((size_t)wi * 1024 + pn * 256) * 1024) : (unsigned)(WS_WL1 + (size_t)wi * 256 * 1024);
        u.i0 = pm; u.i1 = pn; u.i2 = kind; u.i3 = wi; return true; }
    __device__ __forceinline__ void aoff(const GU&, const int (&R)[2], const int (&C)[2], unsigned (&v)[2][2]) const {
#pragma unroll
        for (int h = 0; h < 2; ++h)
#pragma unroll
            for (int i = 0; i < 2; ++i) v[h][i] = (unsigned)((h * 128 + R[i]) * D + 2 * C[i]); }
};
struct EpiProj {
    static constexpr bool FP8 = true; static constexpr bool PERM = true;
    unsigned char* ws;
    __device__ __forceinline__ void operator()(const f32x4 (&acc)[2][2][4][2], const GU& u, int wr, int wc, int fr, int fq, const LAS float* sb) const {
        const int pm = u.i0, pn = u.i1, kind = u.i2, wi = u.i3;
        if (kind == 0) { bf16_t* o = (bf16_t*)(ws + WS_RKV + (size_t)wi * ACTB); const int col0 = pn * 256 + wc * 32 + 8 * fq;
#pragma unroll
            for (int ai = 0; ai < 2; ++ai)
#pragma unroll
                for (int m = 0; m < 4; ++m) { const size_t n = (size_t)pm * 256 + ai * 128 + wr * 64 + m * 16 + fr;
#pragma unroll
                    for (int bj = 0; bj < 2; ++bj) { const f32x4 v0 = acc[ai][bj][m][0], v1 = acc[ai][bj][m][1];
                        u32x4 w; w.x = cvt_pk_bf16(v0[0], v0[1]); w.y = cvt_pk_bf16(v0[2], v0[3]); w.z = cvt_pk_bf16(v1[0], v1[1]); w.w = cvt_pk_bf16(v1[2], v1[3]);
                        *(GAS u32x4*)(o + n * D + col0 + bj * 128) = w; } }
        } else { bf16_t* o = (bf16_t*)(ws + WS_LACT + (size_t)(kind - 1) * NTOK * 128 * 2); const int col0 = wc * 32 + 8 * fq;
#pragma unroll
            for (int ai = 0; ai < 2; ++ai)
#pragma unroll
                for (int m = 0; m < 4; ++m) { const size_t n = (size_t)pm * 256 + ai * 128 + wr * 64 + m * 16 + fr; float t[8];
#pragma unroll
                    for (int nn = 0; nn < 2; ++nn)
#pragma unroll
                        for (int j = 0; j < 4; ++j) { const float x = acc[ai][0][m][nn][j]; t[4 * nn + j] = kind == 1 ? tanhf_(x) : (kind == 2 ? x : sigmoidf_(x)); }
                    u32x4 w; w.x = cvt_pk_bf16(t[0], t[1]); w.y = cvt_pk_bf16(t[2], t[3]); w.z = cvt_pk_bf16(t[4], t[5]); w.w = cvt_pk_bf16(t[6], t[7]);
                    *(GAS u32x4*)(o + n * 128 + col0) = w; } }
    }
};
struct SchedLora2 {
    static constexpr bool SIDE = false; static constexpr bool XSYNC = false; static constexpr bool GATHER = false;
    int G, vcu; int nt; unsigned ldb;
    __device__ __forceinline__ bool next(int i, GU& u) const { int L = i * G + vcu; if (L >= 4 * 520 + 512) return false;
        const int o = L < 2080 ? L / 520 : 4; L -= o * 520; const int pm = L >> 2, pn = L & 3; const int oa = o < 4 ? (o >> 1) : 2;
        u.a = (unsigned)(WS_LACT + (size_t)oa * NTOK * 128 * 2 + (size_t)pm * 256 * 128 * 2); u.b = (unsigned)(WS_WL2 + ((size_t)o * 1024 + pn * 256) * 128 * 2);
        u.i0 = pm; u.i1 = pn; u.i2 = o; u.i3 = 0; return true; }
    __device__ __forceinline__ void aoff(const GU&, const int (&R)[2], const int (&C)[2], unsigned (&v)[2][2]) const {
#pragma unroll
        for (int h = 0; h < 2; ++h)
#pragma unroll
            for (int i = 0; i < 2; ++i) v[h][i] = (unsigned)((h * 128 + R[i]) * 128 + C[i]) * 2u; }
};
struct EpiLora2 {
    static constexpr bool FP8 = false; static constexpr bool PERM = true;
    unsigned char* ws; const float* w0; const float* a0;
    __device__ __forceinline__ void operator()(const f32x4 (&acc)[2][2][4][2], const GU& u, int wr, int wc, int fr, int fq, const LAS float* sb) const {
        const int pm = u.i0, pn = u.i1, o = u.i2; const int col0 = pn * 256 + wc * 32 + 8 * fq;
        const float* bp = (o < 2 ? w0 + (size_t)o * D : a0 + (size_t)(o & 1) * D) + col0; const float bsc = o < 4 ? 1.0f : 0.0f;
        f32x4 bv[2][2];
#pragma unroll
        for (int bj = 0; bj < 2; ++bj)
#pragma unroll
            for (int n = 0; n < 2; ++n) bv[bj][n] = *(const GAS f32x4*)(bp + bj * 128 + n * 4) * bsc;
        const size_t row0 = (size_t)pm * 256 + wr * 64 + fr;
        if (o < 2) { bf16_t* dst = (bf16_t*)(ws + WS_DEC + (size_t)o * ACTB) + row0 * D + col0;
#pragma unroll
            for (int ai = 0; ai < 2; ++ai)
#pragma unroll
                for (int m = 0; m < 4; ++m)
#pragma unroll
                    for (int bj = 0; bj < 2; ++bj) { float t[8];
#pragma unroll
                        for (int nn = 0; nn < 2; ++nn) { const f32x4 z = acc[ai][bj][m][nn] + bv[bj][nn];
#pragma unroll
                            for (int j = 0; j < 4; ++j) t[4 * nn + j] = -0.87503527f * sigmoidf_(z[j]); }
                        u32x4 w; w.x = cvt_pk_bf16(t[0], t[1]); w.y = cvt_pk_bf16(t[2], t[3]); w.z = cvt_pk_bf16(t[4], t[5]); w.w = cvt_pk_bf16(t[6], t[7]);
                        *(GAS u32x4*)(dst + (size_t)(ai * 128 + m * 16) * D + bj * 128) = w; }
        } else { bf16_t* dst = (o < 4 ? (bf16_t*)(ws + WS_ICL + (size_t)(o - 2) * ACTB) : (bf16_t*)(ws + WS_G)) + row0 * D + col0; const bool sg = o < 4;
#pragma unroll
            for (int ai = 0; ai < 2; ++ai)
#pragma unroll
                for (int m = 0; m < 4; ++m)
#pragma unroll
                    for (int bj = 0; bj < 2; ++bj) { float t[8];
#pragma unroll
                        for (int nn = 0; nn < 2; ++nn) { const f32x4 z = acc[ai][bj][m][nn] + bv[bj][nn];
#pragma unroll
                            for (int j = 0; j < 4; ++j) t[4 * nn + j] = sg ? sigmoidf_(z[j]) : z[j]; }
                        u32x4 w; w.x = cvt_pk_bf16(t[0], t[1]); w.y = cvt_pk_bf16(t[2], t[3]); w.z = cvt_pk_bf16(t[4], t[5]); w.w = cvt_pk_bf16(t[6], t[7]);
                        *(GAS u32x4*)(dst + (size_t)(ai * 128 + m * 16) * D + bj * 128) = w; }
        }
    }
};
__device__ __forceinline__ void ld16bf(const bf16_t* p, float (&o)[16]) { const u32x4 a = *(const GAS u32x4*)p, b = *(const GAS u32x4*)(p + 8);
    o[0] = bf_lo(a.x); o[1] = bf_hi(a.x); o[2] = bf_lo(a.y); o[3] = bf_hi(a.y); o[4] = bf_lo(a.z); o[5] = bf_hi(a.z); o[6] = bf_lo(a.w); o[7] = bf_hi(a.w);
    o[8] = bf_lo(b.x); o[9] = bf_hi(b.x); o[10] = bf_lo(b.y); o[11] = bf_hi(b.y); o[12] = bf_lo(b.z); o[13] = bf_hi(b.z); o[14] = bf_lo(b.w); o[15] = bf_hi(b.w); }
__device__ __forceinline__ void ld16bf_nt(const bf16_t* p, float (&o)[16]) { const u32x4 a = __builtin_nontemporal_load((const GAS u32x4*)p), b = __builtin_nontemporal_load((const GAS u32x4*)(p + 8));
    o[0] = bf_lo(a.x); o[1] = bf_hi(a.x); o[2] = bf_lo(a.y); o[3] = bf_hi(a.y); o[4] = bf_lo(a.z); o[5] = bf_hi(a.z); o[6] = bf_lo(a.w); o[7] = bf_hi(a.w);
    o[8] = bf_lo(b.x); o[9] = bf_hi(b.x); o[10] = bf_lo(b.y); o[11] = bf_hi(b.y); o[12] = bf_lo(b.z); o[13] = bf_hi(b.z); o[14] = bf_lo(b.w); o[15] = bf_hi(b.w); }
__device__ __forceinline__ void st16bf(bf16_t* p, const float (&o)[16]) { u32x4 a, b;
    a.x = cvt_pk_bf16(o[0], o[1]); a.y = cvt_pk_bf16(o[2], o[3]); a.z = cvt_pk_bf16(o[4], o[5]); a.w = cvt_pk_bf16(o[6], o[7]);
    b.x = cvt_pk_bf16(o[8], o[9]); b.y = cvt_pk_bf16(o[10], o[11]); b.z = cvt_pk_bf16(o[12], o[13]); b.w = cvt_pk_bf16(o[14], o[15]);
    *(GAS u32x4*)p = a; *(GAS u32x4*)(p + 8) = b; }
__device__ __forceinline__ void ld16f(const float* p, float (&o)[16]) {
#pragma unroll
    for (int q = 0; q < 4; ++q) { const f32x4 v = *(const GAS f32x4*)(p + 4 * q); o[4 * q] = v[0]; o[4 * q + 1] = v[1]; o[4 * q + 2] = v[2]; o[4 * q + 3] = v[3]; } }
__device__ __forceinline__ void phase_fin(const Frame& F, const Args& A) {
    const int gw = blockIdx.x * NWAVES + F.wave, NGW = F.G * NWAVES; const int c0 = 16 * F.lane;
    float kkw[16]; ld16f(A.in[I_KK] + c0, kkw);
    const bf16_t* Kp = (const bf16_t*)(F.ws + WS_RKV + 1 * ACTB);
    for (int n = gw; n < NTOK; n += NGW) { const size_t off = (size_t)n * D + c0; float k[16];
        ld16bf(Kp + off, k);
        float ss = 0.f;
#pragma unroll
        for (int j = 0; j < 16; ++j) { const float kk = k[j] * kkw[j]; ss += kk * kk; }
        ss = dpp_xadd(ss, 0); ss = dpp_xadd(ss, 1);
        const float inv = __builtin_amdgcn_rsqf(fmaxf(ss, 1e-24f));
        if ((F.lane & 3) == 0) ((float*)(F.ws + WS_KK))[(size_t)n * 16 + (F.lane >> 2)] = inv;
    }
}
constexpr int CK = 32, SNS = CT + TSEQ, CNCH = SNS / CK;
constexpr int RS = 144, TS = 80;
constexpr int OS_A = 0, OS_R = 4608, OS_KT = 9216, OS_BT = 14336, OS_VT = 19456, OS_GAM = 20736, OS_BYTES = 20992;
constexpr int OG_B = 0, OG_K = 4608, OG_BYTES = 9216;
constexpr int GM_KA = 0, GM_KR = 2560, GM_BR = 5120, GM_TT = 7680, GM_BYTES = 10240;
constexpr int RAW_V = 4 * 4096, RAW_INV = RAW_V + 1024, RAW_BYTES = RAW_INV + 256, NRAW = 4;
constexpr int L_OS = 0, L_OG = 2 * OS_BYTES, L_GM = L_OG + 2 * OG_BYTES, L_RAW = L_GM + 2 * GM_BYTES, L_SCAN_END = L_RAW + NRAW * RAW_BYTES;
static_assert(L_SCAN_END <= SCR_BYTES, "scan LDS");
__device__ __forceinline__ int scan_token(int sg, int d, int b) { if (sg < CT) { const int t = d ? (CT - 1 - sg) : sg; return NL + b * CT + t; } const int u = sg - CT; const int t = d ? (TSEQ - 1 - u) : u; return b * TSEQ + t; }
__device__ __forceinline__ unsigned short f2bf(float f) { return (unsigned short)(cvt_pk_bf16(f, 0.f) & 0xffffu); }
__device__ __forceinline__ int acc_row(int p, int lane) { return (p & 3) + 8 * (p >> 2) + 4 * (lane >> 5); }
__device__ __forceinline__ void st_acc32(LAS unsigned char* dst, const f32x16& a, int lane) {
#pragma unroll
    for (int p = 0; p < 16; ++p) *(LAS unsigned short*)(dst + acc_row(p, lane) * TS + 2 * (lane & 31)) = f2bf(a[p]);
}
__device__ __forceinline__ void st_acc32_t(LAS unsigned char* dst, const f32x16& a, int lane) {
#pragma unroll
    for (int g = 0; g < 4; ++g) { u32x2 w; w.x = cvt_pk_bf16(a[4 * g], a[4 * g + 1]); w.y = cvt_pk_bf16(a[4 * g + 2], a[4 * g + 3]); *(LAS u32x2*)(dst + (lane & 31) * TS + 2 * (8 * g + 4 * (lane >> 5))) = w; }
}
__device__ __forceinline__ bf16x8 acc_bfrag(const f32x16& a, int s) { u32x4 w; w.x = cvt_pk_bf16(a[8 * s + 0], a[8 * s + 1]); w.y = cvt_pk_bf16(a[8 * s + 2], a[8 * s + 3]); w.z = cvt_pk_bf16(a[8 * s + 4], a[8 * s + 5]); w.w = cvt_pk_bf16(a[8 * s + 6], a[8 * s + 7]); return __builtin_bit_cast(bf16x8, w); }
__device__ __forceinline__ bf16x8 lds_afrag_perm(const LAS unsigned char* m, int s, int lane) { const LAS unsigned char* p = m + (lane & 31) * TS + 2 * (16 * s + 4 * (lane >> 5));
    const u32x2 lo = *(const LAS u32x2*)p, hi = *(const LAS u32x2*)(p + 16); u32x4 w; w.x = lo.x; w.y = lo.y; w.z = hi.x; w.w = hi.y; return __builtin_bit_cast(bf16x8, w); }
__device__ __forceinline__ bf16x8 ld2x8(const LAS unsigned char* p0, const LAS unsigned char* p1) { const u32x2 lo = *(const LAS u32x2*)p0, hi = *(const LAS u32x2*)p1; return __builtin_bit_cast(bf16x8, (u32x4){lo.x, lo.y, hi.x, hi.y}); }
__device__ __forceinline__ f32x16 gram32(const LAS unsigned char* P, const LAS unsigned char* Q, int lane) {
    f32x16 c;
#pragma unroll
    for (int p = 0; p < 16; ++p) c[p] = 0.f;
#pragma unroll
    for (int s = 0; s < 4; ++s) { const bf16x8 a = *(const LAS bf16x8*)(P + (lane & 31) * RS + 32 * s + 16 * (lane >> 5)), b = *(const LAS bf16x8*)(Q + (lane & 31) * RS + 32 * s + 16 * (lane >> 5));
        c = __builtin_amdgcn_mfma_f32_32x32x16_bf16(a, b, c, 0, 0, 0); }
    return c;
}
__device__ __forceinline__ void phase_scan(const Frame& F, const Args& A) {
    LAS unsigned char* lds = F.scr;
    const int lane = F.lane, wave = F.wave;
    const __amdgpu_buffer_rsrc_t rsrc = __builtin_amdgcn_make_buffer_rsrc((void*)F.ws, 0, 0xffffffff, 0x00020000);
    for (int job_ = F.vcu; job_ < 256; job_ += F.G) {
        const int job = __builtin_amdgcn_readfirstlane(job_);
        const int sd = job >> 2, rq = job & 3, d = sd & 1, bh = sd >> 1, b = bh >> 4, hd = bh & 15;
        f32x4 Xa[4];
#pragma unroll
        for (int t = 0; t < 4; ++t) Xa[t] = (f32x4){0.f, 0.f, 0.f, 0.f};
        const int pj = (wave - 3) & 3;
        const bool is_prep = wave >= 3 && wave <= 6;
        const float kkw_l = A.in[I_KK][hd * 64 + 16 * pj + (lane & 15)];
        const float ka_l = A.in[I_KA][hd * 64 + 16 * pj + (lane & 15)];
        const unsigned dma_v = (unsigned)((d ? 7 - (lane >> 3) : (lane >> 3)) * (D * 2) + (lane & 7) * 16), dma_vv = (unsigned)((d ? 31 - (lane >> 1) : (lane >> 1)) * (D * 2) + (lane & 1) * 16), dma_vi = (unsigned)((d ? 31 - (lane & 31) : (lane & 31)) * 64);
#define SCAN_DMA(c) do { const int c_ = (c); LAS unsigned char* raw_ = lds + L_RAW + (c_ & (NRAW - 1)) * RAW_BYTES; const int n0_ = scan_token(c_ * CK, d, b); \
            _Pragma("unroll") for (int g = 0; g < 4; ++g) { const unsigned so_ = (unsigned)(d ? n0_ - 8 * g - 7 : n0_ + 8 * g) * (unsigned)(D * 2) + (unsigned)(hd * 128); \
                __builtin_amdgcn_raw_ptr_buffer_load_lds(rsrc, (LAS void*)(raw_ + 0 * 4096 + g * 1024), 16, (int)dma_v, (int)(so_ + (unsigned)(WS_DEC + (size_t)d * ACTB)), 0, 0); \
                __builtin_amdgcn_raw_ptr_buffer_load_lds(rsrc, (LAS void*)(raw_ + 1 * 4096 + g * 1024), 16, (int)dma_v, (int)(so_ + (unsigned)(WS_ICL + (size_t)d * ACTB)), 0, 0); \
                __builtin_amdgcn_raw_ptr_buffer_load_lds(rsrc, (LAS void*)(raw_ + 2 * 4096 + g * 1024), 16, (int)dma_v, (int)(so_ + (unsigned)(WS_RKV + ACTB)), 0, 0); \
                if (c_ >= CT / CK) __builtin_amdgcn_raw_ptr_buffer_load_lds(rsrc, (LAS void*)(raw_ + 3 * 4096 + g * 1024), 16, (int)dma_v, (int)(so_ + (unsigned)WS_RKV), 0, 0); } \
            { const unsigned so_ = (unsigned)(d ? n0_ - 31 : n0_) * (unsigned)(D * 2) + (unsigned)(hd * 128 + rq * 32) + (unsigned)(WS_RKV + 2 * ACTB); \
              __builtin_amdgcn_raw_ptr_buffer_load_lds(rsrc, (LAS void*)(raw_ + RAW_V), 16, (int)dma_vv, (int)so_, 0, 0); } \
            { const unsigned so_ = (unsigned)(d ? n0_ - 31 : n0_) * 64u + (unsigned)(hd * 4) + (unsigned)WS_KK; \
              __builtin_amdgcn_raw_ptr_buffer_load_lds(rsrc, (LAS void*)(raw_ + RAW_INV), 4, (int)dma_vi, (int)so_, 0, 0); } } while (0)
        __syncthreads();
        if (wave == 7) { SCAN_DMA(0); SCAN_DMA(1); asm volatile("s_waitcnt vmcnt(0)" ::: "memory"); SCAN_DMA(2); }
        __syncthreads();
#define SCAN_BAR() do { asm volatile("s_waitcnt lgkmcnt(0)" ::: "memory"); __builtin_amdgcn_s_barrier(); asm volatile("" ::: "memory"); } while (0)
        long long tbusy = 0; long long tloop0_ = 0; if (SCAN_TSEL == 8) tloop0_ = clock64();
        if (wave != 0) for (int it = -2; it < CNCH; ++it) {
            const int cg = it + 1, cp = it + 2;
            long long t0_ = 0; if (SCAN_TSEL >= 0) t0_ = clock64();
            if (is_prep) {
                __builtin_amdgcn_s_setprio(2);
                if (cp < CNCH) {
                    const LAS unsigned char* raw = lds + L_RAW + (cp & (NRAW - 1)) * RAW_BYTES;
                    LAS unsigned char* os = lds + L_OS + (cp & 1) * OS_BYTES; LAS unsigned char* og = lds + L_OG + (cp & 1) * OG_BYTES;
                    const int rg = lane >> 4, ch = 16 * pj + (lane & 15);
                    unsigned short rlw_[8], ric_[8], rkx_[8], rr_[8];
#pragma unroll
                    for (int j = 0; j < 8; ++j) { const LAS unsigned char* p = raw + (8 * rg + j) * 128 + 2 * ch; rlw_[j] = *(const LAS unsigned short*)p; ric_[j] = *(const LAS unsigned short*)(p + 4096);
                        rkx_[j] = *(const LAS unsigned short*)(p + 8192); rr_[j] = *(const LAS unsigned short*)(p + 12288); }
                    const f32x4 inv0 = *(const LAS f32x4*)(raw + RAW_INV + 32 * rg), inv1 = *(const LAS f32x4*)(raw + RAW_INV + 32 * rg + 16);
                    __builtin_amdgcn_sched_barrier(0);
                    float S = 0.f, lwv[8];
#pragma unroll
                    for (int j = 0; j < 8; ++j) { lwv[j] = bf2f(rlw_[j]); S += lwv[j]; }
                    const float S1 = __builtin_bit_cast(float, __builtin_amdgcn_ds_bpermute(((lane + 16) & 63) * 4, __builtin_bit_cast(int, S)));
                    const float S2 = __builtin_bit_cast(float, __builtin_amdgcn_ds_bpermute(((lane + 32) & 63) * 4, __builtin_bit_cast(int, S)));
                    const float S3 = __builtin_bit_cast(float, __builtin_amdgcn_ds_bpermute(((lane + 48) & 63) * 4, __builtin_bit_cast(int, S)));
                    const float Ltot = (S + S1) + (S2 + S3), Lpre = (rg >= 3 ? S1 : 0.f) + (rg >= 2 ? S2 : 0.f) + (rg >= 1 ? S3 : 0.f);
                    const float gam = __builtin_amdgcn_exp2f(Ltot);
                    if (rg == 0) *(LAS float*)(os + OS_GAM + 4 * ch) = gam;
                    float Lr = Lpre, ep_prev = __builtin_amdgcn_exp2f(Lpre); float kt[8], bt[8]; const bool has_r = cp >= CT / CK;
#pragma unroll
                    for (int j = 0; j < 8; ++j) { const int m = 8 * rg + j; Lr += lwv[j];
                        const float ep = __builtin_amdgcn_exp2f(Lr), em = __builtin_amdgcn_rcpf(ep);
                        const float icl = bf2f(ric_[j]), kx = bf2f(rkx_[j]), r = has_r ? bf2f(rr_[j]) : 0.f, kk = kx * kkw_l * (j < 4 ? inv0[j & 3] : inv1[j & 3]);
                        const float bb = kk * icl, kd = kx * (1.0f + (icl - 1.0f) * ka_l);
                        const f32x2 ar = (f32x2){kk, r} * (f32x2){ep_prev, ep}, bk = (f32x2){bb, kd} * em, tb = (f32x2){bk[1], bk[0]} * (f32x2){gam, -gam};
                        const unsigned w1 = cvt_pk_bf16(ar[0], ar[1]), w2 = cvt_pk_bf16(bk[0], bk[1]);
                        *(LAS unsigned short*)(os + OS_A + m * RS + 2 * ch) = (unsigned short)(w1 & 0xffffu);
                        *(LAS unsigned short*)(os + OS_R + m * RS + 2 * ch) = (unsigned short)(w1 >> 16);
                        *(LAS unsigned short*)(og + OG_B + m * RS + 2 * ch) = (unsigned short)(w2 & 0xffffu);
                        *(LAS unsigned short*)(og + OG_K + m * RS + 2 * ch) = (unsigned short)(w2 >> 16);
                        kt[j] = tb[0]; bt[j] = tb[1]; ep_prev = ep; }
#pragma unroll
                    for (int g = 0; g < 2; ++g) { u32x2 w; w.x = cvt_pk_bf16(kt[4 * g], kt[4 * g + 1]); w.y = cvt_pk_bf16(kt[4 * g + 2], kt[4 * g + 3]);
                        *(LAS u32x2*)(os + OS_KT + ch * TS + 2 * (8 * rg + 4 * g)) = w;
                        w.x = cvt_pk_bf16(bt[4 * g], bt[4 * g + 1]); w.y = cvt_pk_bf16(bt[4 * g + 2], bt[4 * g + 3]);
                        *(LAS u32x2*)(os + OS_BT + ch * TS + 2 * (8 * rg + 4 * g)) = w; }
                }
                __builtin_amdgcn_s_setprio(0);
            } else if (wave == 7) {
                const int c5 = it + 5;
                if (c5 < CNCH) SCAN_DMA(c5);
                if (cp < CNCH) { const LAS unsigned char* raw = lds + L_RAW + (cp & (NRAW - 1)) * RAW_BYTES; LAS unsigned char* os = lds + L_OS + (cp & 1) * OS_BYTES;
                    unsigned short rv[8];
#pragma unroll
                    for (int j = 0; j < 8; ++j) rv[j] = *(const LAS unsigned short*)(raw + RAW_V + (8 * (lane >> 4) + j) * 32 + 2 * (lane & 15));
                    u32x4 w; w.x = (unsigned)rv[0] | ((unsigned)rv[1] << 16); w.y = (unsigned)rv[2] | ((unsigned)rv[3] << 16); w.z = (unsigned)rv[4] | ((unsigned)rv[5] << 16); w.w = (unsigned)rv[6] | ((unsigned)rv[7] << 16);
                    *(LAS u32x4*)(os + OS_VT + (lane & 15) * TS + 16 * (lane >> 4)) = w; }
                if (cg >= 0 && cg < CNCH) {
                    f32x16 c = gram32(lds + L_OG + (cg & 1) * OG_BYTES + OG_B, lds + L_OS + (cg & 1) * OS_BYTES + OS_R, lane);
#pragma unroll
                    for (int p = 0; p < 16; ++p) c[p] = acc_row(p, lane) <= (lane & 31) ? -c[p] : 0.f;
                    st_acc32_t(lds + L_GM + (cg & 1) * GM_BYTES + GM_BR, c, lane);
                }
                { const int n1_ = (it + 4 >= 0 && it + 4 < CNCH) ? ((it + 4 >= CT / CK) ? 18 : 14) : 0, n2_ = (c5 < CNCH) ? ((c5 >= CT / CK) ? 18 : 14) : 0;
                  switch (n1_ + n2_) { case 36: asm volatile("s_waitcnt vmcnt(36)" ::: "memory"); break; case 32: asm volatile("s_waitcnt vmcnt(32)" ::: "memory"); break; case 28: asm volatile("s_waitcnt vmcnt(28)" ::: "memory"); break;
                      case 18: asm volatile("s_waitcnt vmcnt(18)" ::: "memory"); break; case 14: asm volatile("s_waitcnt vmcnt(14)" ::: "memory"); break; default: asm volatile("s_waitcnt vmcnt(0)" ::: "memory"); break; } }
            } else if (wave == 2) {
                if (cg >= 0 && cg < CNCH) {
                    const LAS unsigned char* os = lds + L_OS + (cg & 1) * OS_BYTES; const LAS unsigned char* og = lds + L_OG + (cg & 1) * OG_BYTES; LAS unsigned char* gm = lds + L_GM + (cg & 1) * GM_BYTES;
                    bf16x8 fk[4], fa[4], fr[4]; const int fo = (lane & 31) * RS + 16 * (lane >> 5);
#pragma unroll
                    for (int s4 = 0; s4 < 4; ++s4) { fk[s4] = *(const LAS bf16x8*)(og + OG_K + fo + 32 * s4); fa[s4] = *(const LAS bf16x8*)(os + OS_A + fo + 32 * s4); fr[s4] = *(const LAS bf16x8*)(os + OS_R + fo + 32 * s4); }
                    f32x16 c0, c1;
#pragma unroll
                    for (int p = 0; p < 16; ++p) { c0[p] = 0.f; c1[p] = 0.f; }
#pragma unroll
                    for (int s4 = 0; s4 < 4; ++s4) { c0 = __builtin_amdgcn_mfma_f32_32x32x16_bf16(fk[s4], fa[s4], c0, 0, 0, 0); c1 = __builtin_amdgcn_mfma_f32_32x32x16_bf16(fk[s4], fr[s4], c1, 0, 0, 0); }
#pragma unroll
                    for (int p = 0; p < 16; ++p) c0[p] = acc_row(p, lane) < (lane & 31) ? c0[p] : 0.f;
                    st_acc32_t(gm + GM_KA, c0, lane);
#pragma unroll
                    for (int p = 0; p < 16; ++p) c1[p] = acc_row(p, lane) <= (lane & 31) ? c1[p] : 0.f;
                    st_acc32_t(gm + GM_KR, c1, lane);
                }
            } else if (wave == 1) {
                if (cg >= 0 && cg < CNCH) {
                    const LAS unsigned char* os = lds + L_OS + (cg & 1) * OS_BYTES; const LAS unsigned char* og = lds + L_OG + (cg & 1) * OG_BYTES; LAS unsigned char* gm = lds + L_GM + (cg & 1) * GM_BYTES;
                    const int c16 = lane & 15, q = lane >> 4;
                    typedef short s4 __attribute__((ext_vector_type(4)));
#define P4(v) __builtin_bit_cast(s4, (u32x2){cvt_pk_bf16((v)[0], (v)[1]), cvt_pk_bf16((v)[2], (v)[3])})
#define MM16(a, b, c) __builtin_amdgcn_mfma_f32_16x16x16bf16_1k((a), (b), (c), 0, 0, 0)
#define GRAM16(P, p0, Q, q0, out) do { f32x4 c_ = {0.f, 0.f, 0.f, 0.f}; _Pragma("unroll") for (int s_ = 0; s_ < 2; ++s_) \
                        c_ = __builtin_amdgcn_mfma_f32_16x16x32_bf16(*(const LAS bf16x8*)((P) + ((p0) + c16) * RS + 64 * s_ + 16 * q), *(const LAS bf16x8*)((Q) + ((q0) + c16) * RS + 64 * s_ + 16 * q), c_, 0, 0, 0); (out) = c_; } while (0)
                    const LAS unsigned char* PA = os + OS_A; const LAS unsigned char* PB = og + OG_B;
                    f32x4 X1, Xt1, X2, Xt2, L21t, R1, R2, Rt2; const f32x4 z4 = {0.f, 0.f, 0.f, 0.f};
                    GRAM16(PA, 0, PB, 0, X1); GRAM16(PB, 0, PA, 0, Xt1); GRAM16(PA, 16, PB, 16, X2); GRAM16(PB, 16, PA, 16, Xt2); GRAM16(PB, 0, PA, 16, L21t);
#pragma unroll
                    for (int j = 0; j < 4; ++j) { const int row = 4 * q + j; const float dg = (row == c16) ? 1.f : 0.f;
                        X1[j] = c16 < row ? -X1[j] : 0.f; X2[j] = c16 < row ? -X2[j] : 0.f; Xt1[j] = row < c16 ? -Xt1[j] : 0.f; Xt2[j] = row < c16 ? -Xt2[j] : 0.f;
                        R1[j] = X1[j] + dg; R2[j] = X2[j] + dg; Rt2[j] = Xt2[j] + dg; }
#pragma unroll
                    for (int lev = 0; lev < 4; ++lev) {
                        const s4 fx1 = P4(X1), fxt1 = P4(Xt1), fx2 = P4(X2), fxt2 = P4(Xt2);
                        if (lev >= 1) { R1 = MM16(fxt1, P4(R1), R1); R2 = MM16(fxt2, P4(R2), R2); Rt2 = MM16(fx2, P4(Rt2), Rt2); }
                        if (lev < 3) { const f32x4 n1 = MM16(fxt1, fx1, z4), nt1 = MM16(fx1, fxt1, z4), n2 = MM16(fxt2, fx2, z4), nt2 = MM16(fx2, fxt2, z4); X1 = n1; Xt1 = nt1; X2 = n2; Xt2 = nt2; }
                    }
                    const f32x4 W = MM16(P4(L21t), P4(R1), z4);
                    f32x4 T21 = MM16(P4(Rt2), P4(W), z4);
#pragma unroll
                    for (int j = 0; j < 4; ++j) { const int row = 4 * q + j;
                        *(LAS unsigned short*)(gm + GM_TT + row * TS + 2 * c16) = f2bf(R1[j]); *(LAS unsigned short*)(gm + GM_TT + row * TS + 2 * (16 + c16)) = (unsigned short)0;
                        *(LAS unsigned short*)(gm + GM_TT + (16 + row) * TS + 2 * c16) = f2bf(-T21[j]); *(LAS unsigned short*)(gm + GM_TT + (16 + row) * TS + 2 * (16 + c16)) = f2bf(R2[j]); }
#undef P4
#undef MM16
#undef GRAM16
                }
            }
            if (SCAN_TSEL >= 0) { tbusy += clock64() - t0_; }
            SCAN_BAR();
        }
        else {
#define PACK8(v0, v1) __builtin_bit_cast(bf16x8, (u32x4){cvt_pk_bf16((v0)[0], (v0)[1]), cvt_pk_bf16((v0)[2], (v0)[3]), cvt_pk_bf16((v1)[0], (v1)[1]), cvt_pk_bf16((v1)[2], (v1)[3])})
#define LD2(p) ld2x8((p), (p) + 32)
#define MF32(afrag, bfrag, c) __builtin_amdgcn_mfma_f32_16x16x32_bf16((afrag), (bfrag), (c), 0, 0, 0)
            const int r16 = lane & 15, q = lane >> 4;
            const unsigned y_v = (unsigned)((d ? 3 - q : q) * 4 * (D * 2) + r16 * 2);
            bf16x8 sV = {0, 0, 0, 0, 0, 0, 0, 0}, sA[2][2], sKT[4], sBT[4], sR[2][2]; f32x4 sG[4];
#pragma unroll
            for (int t = 0; t < 4; ++t) { sKT[t] = sV; sBT[t] = sV; sG[t] = (f32x4){0.f, 0.f, 0.f, 0.f}; }
#pragma unroll
            for (int ti = 0; ti < 2; ++ti) { sA[ti][0] = sV; sA[ti][1] = sV; sR[ti][0] = sV; sR[ti][1] = sV; }
            for (int it = -2; it < CNCH; ++it) {
                const int cs = it;
                long long t0_ = 0; if (SCAN_TSEL >= 0) t0_ = clock64();
                if (cs >= 0) {
                    const LAS unsigned char* gm = lds + L_GM + (cs & 1) * GM_BYTES; const bool emit = cs >= CT / CK;
                    const int n0s = scan_token(cs * CK, d, b);
                    bf16x8 aKA[2], aTT[2];
#pragma unroll
                    for (int ti = 0; ti < 2; ++ti) { const int i = 16 * ti + r16; aKA[ti] = *(const LAS bf16x8*)(gm + GM_KA + i * TS + 16 * q); aTT[ti] = LD2(gm + GM_TT + i * TS + 8 * q); }
                    const bf16x8 xb01 = PACK8(Xa[0], Xa[1]), xb23 = PACK8(Xa[2], Xa[3]);
                    f32x4 h[2];
#pragma unroll
                    for (int ti = 0; ti < 2; ++ti) { f32x4 c = {0.f, 0.f, 0.f, 0.f}; c = MF32(sA[ti][0], xb01, c); c = MF32(sA[ti][1], xb23, c); h[ti] = MF32(aKA[ti], sV, c); }
                    const bf16x8 hb = PACK8(h[0], h[1]);
                    f32x4 u[2];
#pragma unroll
                    for (int ti = 0; ti < 2; ++ti) { const f32x4 z = {0.f, 0.f, 0.f, 0.f}; u[ti] = MF32(aTT[ti], hb, z); }
                    const bf16x8 ub = PACK8(u[0], u[1]);
                    f32x4 Xn[4];
#pragma unroll
                    for (int t = 0; t < 4; ++t) { f32x4 c = Xa[t] * sG[t]; c = MF32(sKT[t], sV, c); Xn[t] = MF32(sBT[t], ub, c); }
                    if (emit) {
#pragma unroll
                        for (int ti = 0; ti < 2; ++ti) { const int i = 16 * ti + r16; f32x4 c = {0.f, 0.f, 0.f, 0.f};
                            c = MF32(sR[ti][0], xb01, c); c = MF32(sR[ti][1], xb23, c);
                            c = MF32(*(const LAS bf16x8*)(gm + GM_KR + i * TS + 16 * q), sV, c); c = MF32(LD2(gm + GM_BR + i * TS + 8 * q), ub, c);
#pragma unroll
                            for (int j = 0; j < 4; ++j) { const unsigned so = (unsigned)(d ? n0s - 16 * ti - j - 12 : n0s + 16 * ti + j) * (unsigned)(D * 2) + (unsigned)((hd * 64 + rq * 16) * 2) + (unsigned)(WS_YD + (size_t)d * NL * D * 2);
                                __builtin_amdgcn_raw_buffer_store_b16(f2bf(c[j]), rsrc, (int)y_v, (int)so, 0); } }
                    }
#pragma unroll
                    for (int t = 0; t < 4; ++t) Xa[t] = Xn[t];
                }
                if (cs + 1 >= 0 && cs + 1 < CNCH) {
                    const LAS unsigned char* os = lds + L_OS + ((cs + 1) & 1) * OS_BYTES;
                    sV = *(const LAS bf16x8*)(os + OS_VT + r16 * TS + 16 * q);
#pragma unroll
                    for (int ti = 0; ti < 2; ++ti) { const int i = 16 * ti + r16; sA[ti][0] = LD2(os + OS_A + i * RS + 8 * q); sA[ti][1] = LD2(os + OS_A + i * RS + 64 + 8 * q); }
#pragma unroll
                    for (int t = 0; t < 4; ++t) { const int k = 16 * t + r16; sG[t] = *(const LAS f32x4*)(os + OS_GAM + 4 * (16 * t + 4 * q)); sKT[t] = *(const LAS bf16x8*)(os + OS_KT + k * TS + 16 * q); sBT[t] = LD2(os + OS_BT + k * TS + 8 * q); }
                    if (cs + 1 >= CT / CK) {
#pragma unroll
                        for (int ti = 0; ti < 2; ++ti) { const int i = 16 * ti + r16; sR[ti][0] = LD2(os + OS_R + i * RS + 8 * q); sR[ti][1] = LD2(os + OS_R + i * RS + 64 + 8 * q); }
                    }
                }
                if (SCAN_TSEL >= 0) { tbusy += clock64() - t0_; }
                SCAN_BAR();
            }
#undef PACK8
#undef LD2
#undef MF32
        }
        if (SCAN_TSEL >= 0 && SCAN_TSEL < 8 && F.vcu == 0 && lane == 0 && wave == (SCAN_TSEL & 7)) *(long long*)(F.ws + WS_CTL + 49152) = tbusy;
        if (SCAN_TSEL == 8 && F.vcu == 0 && lane == 0 && wave == 0) *(long long*)(F.ws + WS_CTL + 49152) = (clock64() - tloop0_) / 2;
#undef SCAN_DMA
#undef SCAN_BAR
    }
}
__device__ __forceinline__ void phase_readout(const Frame& F, const Args& A) {
    const int gw = blockIdx.x * NWAVES + F.wave, NGW = F.G * NWAVES; const int c0 = 16 * F.lane;
    float lng[16], lnb[16], rk[16], kaw[16]; ld16f(A.in[I_LNG] + c0, lng); ld16f(A.in[I_LNB] + c0, lnb); ld16f(A.in[I_RK] + c0, rk); ld16f(A.in[I_KA] + c0, kaw);
    for (int n = gw; n < NL; n += NGW) { const size_t off = (size_t)n * D + c0; float y[16], t[16], r[16], kd[16], v[16], g[16], o[16];
        ld16bf_nt((const bf16_t*)(F.ws + WS_YD) + off, y); ld16bf_nt((const bf16_t*)(F.ws + WS_YD + (size_t)NL * D * 2) + off, t);
        float s = 0.f;
#pragma unroll
        for (int j = 0; j < 16; ++j) { y[j] += t[j]; s += y[j]; }
        s = dpp_xadd(s, 0); s = dpp_xadd(s, 1); const float m = s * (1.0f / 64.0f); float q = 0.f;
#pragma unroll
        for (int j = 0; j < 16; ++j) { y[j] -= m; q += y[j] * y[j]; }
        q = dpp_xadd(q, 0); q = dpp_xadd(q, 1); const float rs = __builtin_amdgcn_rsqf(q * (1.0f / 64.0f) + GN_EPS);
        ld16bf_nt((const bf16_t*)(F.ws + WS_RKV) + off, r); ld16bf_nt((const bf16_t*)(F.ws + WS_ICL) + off, kd); ld16bf_nt((const bf16_t*)(F.ws + WS_ICL + ACTB) + off, t); ld16bf_nt((const bf16_t*)(F.ws + WS_RKV + ACTB) + off, v);
        float bs = 0.f;
#pragma unroll
        for (int j = 0; j < 16; ++j) bs += r[j] * (v[j] * (2.0f + (kd[j] + t[j] - 2.0f) * kaw[j])) * rk[j];
        bs = dpp_xadd(bs, 0); bs = dpp_xadd(bs, 1);
        ld16bf_nt((const bf16_t*)(F.ws + WS_RKV + 2 * ACTB) + off, v); ld16bf_nt((const bf16_t*)(F.ws + WS_G) + off, g);
#pragma unroll
        for (int j = 0; j < 16; ++j) o[j] = (y[j] * rs * lng[j] + lnb[j] + bs * v[j]) * g[j];
        { u32x4 w; w.x = pk4_fp8(o[0], o[1], o[2], o[3]); w.y = pk4_fp8(o[4], o[5], o[6], o[7]); w.z = pk4_fp8(o[8], o[9], o[10], o[11]); w.w = pk4_fp8(o[12], o[13], o[14], o[15]);
          *(GAS u32x4*)(F.ws + WS_RO + off) = w; }
    }
}
struct SchedWo {
    static constexpr bool SIDE = false; static constexpr bool XSYNC = false; static constexpr bool GATHER = false;
    int G, vcu; int nt; unsigned ldb;
    __device__ __forceinline__ bool next(int i, GU& u) const { const int L = i * G + vcu; if (L >= 512) return false; const int pm = L >> 2, pn = L & 3;
        u.a = (unsigned)(WS_RO + (size_t)pm * 256 * D); u.b = (unsigned)(WS_WO + (size_t)pn * 256 * 1024); u.i0 = pm; u.i1 = pn; u.i2 = 0; u.i3 = 0; return true; }
    __device__ __forceinline__ void aoff(const GU&, const int (&R)[2], const int (&C)[2], unsigned (&v)[2][2]) const {
#pragma unroll
        for (int h = 0; h < 2; ++h)
#pragma unroll
            for (int i = 0; i < 2; ++i) v[h][i] = (unsigned)((h * 128 + R[i]) * D + 2 * C[i]); }
};
struct EpiWo {
    static constexpr bool FP8 = true; static constexpr bool PERM = true;
    const bf16_t* xin; bf16_t* xout; const float* gate_base;
    __device__ __forceinline__ void operator()(const f32x4 (&acc)[2][2][4][2], const GU& u, int wr, int wc, int fr, int fq, const LAS float* sb) const {
        const int pm = u.i0, pn = u.i1; const float* gate = gate_base + (size_t)(pm >> 6) * NMOD * D; const int col0 = pn * 256 + wc * 32 + 8 * fq;
        f32x4 gl[2][2];
#pragma unroll
        for (int bj = 0; bj < 2; ++bj)
#pragma unroll
            for (int n = 0; n < 2; ++n) gl[bj][n] = *(const GAS f32x4*)(gate + col0 + bj * 128 + n * 4);
#pragma unroll
        for (int ai = 0; ai < 2; ++ai)
            { u32x4 xv[4][2];
#pragma unroll
              for (int m = 0; m < 4; ++m) { const size_t off = ((size_t)pm * 256 + ai * 128 + wr * 64 + m * 16 + fr) * D + col0;
#pragma unroll
                  for (int bj = 0; bj < 2; ++bj) xv[m][bj] = *(const GAS u32x4*)(xin + off + bj * 128); }
#pragma unroll
              for (int m = 0; m < 4; ++m) { const size_t off = ((size_t)pm * 256 + ai * 128 + wr * 64 + m * 16 + fr) * D + col0;
#pragma unroll
                  for (int bj = 0; bj < 2; ++bj) { const u32x4 xi = xv[m][bj];
                    const f32x4 v0 = (f32x4){bf_lo(xi.x), bf_hi(xi.x), bf_lo(xi.y), bf_hi(xi.y)} + gl[bj][0] * acc[ai][bj][m][0], v1 = (f32x4){bf_lo(xi.z), bf_hi(xi.z), bf_lo(xi.w), bf_hi(xi.w)} + gl[bj][1] * acc[ai][bj][m][1];
                    u32x4 w; w.x = cvt_pk_bf16(v0[0], v0[1]); w.y = cvt_pk_bf16(v0[2], v0[3]); w.z = cvt_pk_bf16(v1[0], v1[1]); w.w = cvt_pk_bf16(v1[2], v1[3]);
                    *(GAS u32x4*)(xout + off + bj * 128) = w; } } }
    }
};

constexpr int NPHASES = 3;
__global__ void __launch_bounds__(NTHREADS, 2) fwd_kernel(Args args) {
    extern __shared__ __attribute__((aligned(16))) unsigned char lds_raw[];
    Frame F;
    F.lds = (LAS unsigned char*)lds_raw; F.scr = F.lds + SCR_OFF; F.ws = args.ws;
    F.tid = threadIdx.x; F.lane = F.tid & 63; F.wave = __builtin_amdgcn_readfirstlane(F.tid >> 6);
    F.G = gridDim.x; { const int bx = blockIdx.x; F.vcu = (F.G % 8 == 0) ? (bx % 8) * (F.G / 8) + bx / 8 : bx; }
    volatile LAS unsigned* MISC = (volatile LAS unsigned*)(F.lds + MISC_OFF);
    if (F.tid < 64) MISC[F.tid] = 0u;
    __syncthreads();
    const int lo = args.ph_lo, hi = args.ph_hi;
    XcdBarrier bar; bar.bar = (unsigned*)(F.ws + WS_CTL); bar.x = 0; bar.st = MISC + 8;
    if (hi - lo > 1) {
        unsigned* barw = (unsigned*)(F.ws + WS_CTL);
        bar.bar = barw; bar.x = xb_xcc_id(); bar.st = MISC + 8;
        if (F.tid == 0) {
            const unsigned rank = xb_add(&barw[XB_XCNT(bar.x)], 1u);
            unsigned nloc, nx; xcd_barrier_complete(barw, bar.x, nloc, nx); MISC[8] = nloc; MISC[9] = nx;
            unsigned pre = 0;
            for (unsigned j = 0; j < 16; ++j) { const unsigned c = xb_ld(&barw[XB_XCNT(j)]); if (j < bar.x) pre += c; }
            MISC[10] = pre + rank;
        }
        __syncthreads();
        F.vcu = (int)MISC[10];
    }
#define IN(k) (lo <= (k) && (k) < hi)
#define SEAM(k) do { if (IN(k) && IN((k) + 1)) xcd_barrier(bar); } while (0)
#define PH(k, ...) do { if (IN(k)) { __VA_ARGS__; if constexpr (((REPEAT_MASK >> (k)) & 1) != 0) { xcd_barrier(bar); __VA_ARGS__; } } SEAM(k); } while (0)
    PH(0, phase_prep(F, args));
    PH(1, phase_pre0(F, args));
    PH(2, { SchedPool S{F.G, F.vcu, 4, 512u};
            EpiPool E{args.in[I_X], args.in[I_CTX], args.in[I_POOLLS], modp(F, 0, 0, 2), (bf16_t*)(F.ws + WS_XS0)};
            pg8::gemm_phase<EpiPool, SchedPool>(F.scr, F.ws, S, E); });
    PH(3, phase_post(F, args, 0, (const bf16_t*)(F.ws + WS_XS0), NTOK));
    PH(4, phase_moe1(F, args, 0));
    PH(5, phase_moe2(F, args, 0));
    PH(6, phase_pre1(F, args));
    PH(7, { SchedProj S{F.G, F.vcu, 8, 1024u}; EpiProj E{F.ws}; pg8::gemm_phase<EpiProj, SchedProj>(F.scr, F.ws, S, E); });
    PH(8, { SchedLora2 S{F.G, F.vcu, 2, 256u}; EpiLora2 E{F.ws, args.in[I_W0], args.in[I_A0]}; pg8::gemm_phase<EpiLora2, SchedLora2>(F.scr, F.ws, S, E); phase_fin(F, args); });
    PH(10, phase_scan(F, args));
    PH(11, phase_readout(F, args));
    PH(12, { SchedWo S{F.G, F.vcu, 8, 1024u}; EpiWo E{(const bf16_t*)(F.ws + WS_XS1), (bf16_t*)(F.ws + WS_XS0), modp(F, 1, 0, 2)}; pg8::gemm_phase<EpiWo, SchedWo>(F.scr, F.ws, S, E); });
    PH(13, phase_post(F, args, 1, (const bf16_t*)(F.ws + WS_XS0), NL));
    PH(14, phase_moe1(F, args, 1));
    PH(15, phase_moe2(F, args, 1));
    PH(16, phase_final(F, args, 1, (const bf16_t*)(F.ws + WS_XS0)));
#undef PH
#undef SEAM
#undef IN
}

extern "C" void kernel_launch(void* const* d_in, const int* in_sizes, int n_in, void* d_out, int out_size, void* d_ws, size_t ws_size, hipStream_t stream) {
    static int grid = 0;
    if (grid == 0) {
        if (n_in != 32 || ws_size < WS_END) { fprintf(stderr, "kernel_launch: unexpected n_in %d / ws %zu (need %zu)\n", n_in, ws_size, (size_t)WS_END); grid = -1; return; }
        int dev = 0, cus = 0;
        if (hipGetDevice(&dev) != hipSuccess || hipDeviceGetAttribute(&cus, hipDeviceAttributeMultiprocessorCount, dev) != hipSuccess) { grid = -1; return; }
        if (hipFuncSetAttribute((const void*)fwd_kernel, hipFuncAttributeMaxDynamicSharedMemorySize, LDS_BYTES) != hipSuccess) { fprintf(stderr, "kernel_launch: hipFuncSetAttribute failed\n"); grid = -1; return; }
        (void)hipGetLastError();
        grid = cus;
    }
    if (grid < 0) return;
    (void)hipMemsetAsync((char*)d_ws + WS_CTL, 0, CTL_BYTES, stream);
    Args a{};
    for (int i = 0; i < 32; ++i) a.in[i] = (const float*)d_in[i];
    a.out = (float*)d_out; a.ws = (unsigned char*)d_ws;
    const int last = 16;
#if N_LAUNCH_MODE == 1
    a.ph_lo = 0; a.ph_hi = last + 1;
    hipLaunchKernelGGL(fwd_kernel, dim3(grid), dim3(NTHREADS), LDS_BYTES, stream, a);
#else
    for (int p = 0; p <= last; ++p) { a.ph_lo = p; a.ph_hi = p + 1; hipLaunchKernelGGL(fwd_kernel, dim3(grid), dim3(NTHREADS), LDS_BYTES, stream, a); }
#endif
}
```
